# Optimizing an MI355X kernel written in HIP

```python
import jax, jax.numpy as jnp
from jax import lax
import numpy as np

D_MODEL = 1024
BATCH = 16
SEQ = 4096
DEPTH = 2

GRID_W = 64
CTX_LEN = 256
NA_HEAD_DIM = 64
NA_HEADS = (D_MODEL // 2) // NA_HEAD_DIM
NA_WIDTH = NA_HEADS * NA_HEAD_DIM
NA_WIN_H = 8
NA_WIN_W = 16
NA_QBLK_W = 16
NA_KBLK_W = 32
RET_HEAD_DIM = 128
RET_HEADS = (D_MODEL // 2) // RET_HEAD_DIM
RET_WIDTH = RET_HEADS * RET_HEAD_DIM
RET_CHUNK = 128
MIX_WIDTH = NA_WIDTH + RET_WIDTH
IN_COLS = 3 * NA_WIDTH + 5 * RET_WIDTH
ROPE_BASE = 10000.0
N_EXPERTS = 32
N_GROUPS = 8
EXPERTS_PER_GROUP = N_EXPERTS // N_GROUPS
TOP_K = 2
D_FF_EXPERT = D_MODEL // 2
MOE_BLOCK = 128
NORM_EPS = 1e-6
NEG_INF = -1e30

kernel_name = 'hybrid_na_retention_moe_dit'


def _rmsnorm(x, w):
    xf = x.astype(jnp.float32)
    y = xf * lax.rsqrt(jnp.mean(xf * xf, axis=-1, keepdims=True) + NORM_EPS)
    return (y * w.astype(jnp.float32)).astype(x.dtype)


def _modulate(x, w, shift, scale):
    return _rmsnorm(x, w) * (1.0 + scale) + shift


def _head_norm(o):
    mu = jnp.mean(o, axis=-1, keepdims=True)
    var = jnp.mean(jnp.square(o - mu), axis=-1, keepdims=True)
    return (o - mu) * lax.rsqrt(var + 1e-5)


def _axial_rope(x):
    B, L, H, d = x.shape
    half = d // 4
    t = jnp.arange(L)
    rows = (t // GRID_W).astype(jnp.float32)
    cols = (t % GRID_W).astype(jnp.float32)
    freqs = ROPE_BASE ** (-jnp.arange(half, dtype=jnp.float32) / half)
    ang = jnp.stack([rows[:, None] * freqs, cols[:, None] * freqs], axis=1)
    cos = jnp.cos(ang)[None, :, None]
    sin = jnp.sin(ang)[None, :, None]
    xr = x.astype(jnp.float32).reshape(B, L, H, 2, 2, half)
    x1, x2 = xr[..., 0, :], xr[..., 1, :]
    out = jnp.stack([x1 * cos - x2 * sin, x1 * sin + x2 * cos], axis=-2)
    return out.reshape(B, L, H, d).astype(x.dtype)


def _na_tables():
    n_cb = GRID_W // NA_QBLK_W
    qcol = np.arange(GRID_W).reshape(n_cb, NA_QBLK_W)
    kstart = np.clip(np.arange(n_cb) * NA_QBLK_W - NA_WIN_W // 2, 0, GRID_W - NA_KBLK_W)
    kcol = kstart[:, None] + np.arange(NA_KBLK_W)
    c0 = np.clip(qcol - NA_WIN_W // 2, 0, GRID_W - NA_WIN_W)
    valid = (kcol[:, None, :] >= c0[:, :, None]) & (kcol[:, None, :] < c0[:, :, None] + NA_WIN_W)
    dc_idx = np.clip(kcol[:, None, :] - qcol[:, :, None] + NA_WIN_W - 1, 0, 2 * NA_WIN_W - 2)
    return kcol, valid, dc_idx


def _neighborhood_attention(q, k, v, k_ctx, v_ctx, rpb):
    B, L, H, d = q.shape
    rows = L // GRID_W
    kh = min(NA_WIN_H, rows)
    kcol, valid, dc_idx = _na_tables()
    n_cb = GRID_W // NA_QBLK_W
    qg = q.reshape(B, rows, n_cb, NA_QBLK_W, H, d)
    kg = k.reshape(B, rows, GRID_W, H, d)
    vg = v.reshape(B, rows, GRID_W, H, d)
    scale = d ** -0.5
    mask = jnp.asarray(valid)[:, :, None, :]
    rpb_c = rpb[:, :, jnp.asarray(dc_idx)]
    n_lat = kh * NA_KBLK_W

    def row(r):
        r0 = jnp.clip(r - kh // 2, 0, rows - kh)
        kr = lax.dynamic_slice_in_dim(kg, r0, kh, axis=1)[:, :, kcol]
        vr = lax.dynamic_slice_in_dim(vg, r0, kh, axis=1)[:, :, kcol]
        qr = qg[:, r]
        s_lat = jnp.einsum('bjqhd,bkjnhd->bhjqkn', qr, kr).astype(jnp.float32) * scale
        dr_idx = r0 + jnp.arange(kh) - r + (NA_WIN_H - 1)
        bias = jnp.transpose(rpb_c[:, dr_idx], (0, 2, 3, 1, 4)).astype(jnp.float32)
        s_lat = jnp.where(mask, s_lat + bias, NEG_INF).reshape(B, H, n_cb, NA_QBLK_W, n_lat)
        s_ctx = jnp.einsum('bjqhd,bmhd->bhjqm', qr, k_ctx).astype(jnp.float32) * scale
        p = jax.nn.softmax(jnp.concatenate([s_lat, s_ctx], axis=-1), axis=-1).astype(v.dtype)
        p_lat = p[..., :n_lat].reshape(B, H, n_cb, NA_QBLK_W, kh, NA_KBLK_W)
        o = (jnp.einsum('bhjqkn,bkjnhd->bjqhd', p_lat, vr)
             + jnp.einsum('bhjqm,bmhd->bjqhd', p[..., n_lat:], v_ctx))
        return o.reshape(B, GRID_W, H, d)

    out = lax.map(row, jnp.arange(rows))
    return jnp.transpose(out, (1, 0, 2, 3, 4)).reshape(B, L, H, d)


def _ctx_attention(q, k, v):
    s = jnp.einsum('bqhd,bkhd->bhqk', q, k).astype(jnp.float32) * (q.shape[-1] ** -0.5)
    p = jax.nn.softmax(s, axis=-1).astype(v.dtype)
    return jnp.einsum('bhqk,bkhd->bqhd', p, v)


def _retention_final_state(k, v, log_g):
    L = k.shape[1]
    w = jnp.exp((L - 1.0 - jnp.arange(L, dtype=jnp.float32))[:, None] * log_g[None, :])
    return jnp.einsum('bmhd,bmhe->bhde', k * w[None, :, :, None], v)


def _retention_chunkwise(q, k, v, log_g, s0):
    B, L, H, d = q.shape
    C = RET_CHUNK
    n = L // C
    pos = jnp.arange(C, dtype=jnp.float32)
    diff = pos[:, None] - pos[None, :]
    intra = jnp.where(diff >= 0, jnp.exp(jnp.maximum(diff, 0.0)[None] * log_g[:, None, None]), 0.0)
    q_dec = jnp.exp((pos[:, None] + 1.0) * log_g[None, :])[None, :, :, None]
    k_dec = jnp.exp((C - 1.0 - pos)[:, None] * log_g[None, :])[None, :, :, None]
    c_dec = jnp.exp(C * log_g)[None, :, None, None]

    def chunks(a):
        return a.reshape(B, n, C, H, a.shape[-1]).swapaxes(0, 1)

    def step(s, blk):
        qb, kb, vb = blk
        scores = jnp.einsum('bihd,bjhd->bhij', qb, kb) * intra
        o = jnp.einsum('bhij,bjhe->bihe', scores, vb) + jnp.einsum('bihd,bhde->bihe', qb, s) * q_dec
        s = s * c_dec + jnp.einsum('bjhd,bjhe->bhde', kb * k_dec, vb)
        return s, o

    _, o = lax.scan(step, s0, (chunks(q), chunks(k), chunks(v)))
    return o.swapaxes(0, 1).reshape(B, L, H, v.shape[-1])


def _bidir_retention(q, k, v, g_f, g_b, log_g, s_f, s_b):
    B, L = q.shape[:2]
    o_f = _retention_chunkwise(q, k, v, log_g[0], s_f)
    o_b = jnp.flip(_retention_chunkwise(jnp.flip(q, 1), jnp.flip(k, 1), jnp.flip(v, 1), log_g[1], s_b), 1)
    o_f = _head_norm(o_f).reshape(B, L, RET_WIDTH).astype(g_f.dtype)
    o_b = _head_norm(o_b).reshape(B, L, RET_WIDTH).astype(g_b.dtype)
    return o_f * jax.nn.silu(g_f) + o_b * jax.nn.silu(g_b)


def _moe(h, router_w, router_bias, w_gate, w_up, w_down):
    T, D = h.shape
    s = jax.nn.sigmoid((h @ router_w).astype(jnp.float32))
    s_sel = (s + router_bias.astype(jnp.float32)).reshape(T, N_GROUPS, EXPERTS_PER_GROUP)
    grp = jnp.argmax(jnp.sum(lax.top_k(s_sel, 2)[0], axis=-1), axis=-1)
    in_grp = jnp.take_along_axis(s_sel, grp[:, None, None], axis=1)[:, 0]
    _, loc = lax.top_k(in_grp, TOP_K)
    eid = grp[:, None] * EXPERTS_PER_GROUP + loc
    gate = jnp.take_along_axis(s, eid, axis=1)
    gate = gate / jnp.sum(gate, axis=-1, keepdims=True)
    A = T * TOP_K
    e_flat = eid.reshape(A)
    tok_flat = jnp.repeat(jnp.arange(T, dtype=jnp.int32), TOP_K)
    order = jnp.argsort(e_flat)
    e_s, tok_s, w_s = e_flat[order], tok_flat[order], gate.reshape(A)[order]
    counts = jax.ops.segment_sum(jnp.ones((A,), jnp.int32), e_flat, num_segments=N_EXPERTS)
    start = jnp.cumsum(counts) - counts
    pcounts = (counts + MOE_BLOCK - 1) // MOE_BLOCK * MOE_BLOCK
    pend = jnp.cumsum(pcounts)
    pstart = pend - pcounts
    pos = pstart[e_s] + (jnp.arange(A, dtype=jnp.int32) - start[e_s])
    nb = (A + MOE_BLOCK - 1) // MOE_BLOCK + N_EXPERTS
    P = nb * MOE_BLOCK
    buf_tok = jnp.full((P,), T, jnp.int32).at[pos].set(tok_s)
    buf_w = jnp.zeros((P,), jnp.float32).at[pos].set(w_s)
    blk_start = jnp.arange(nb, dtype=jnp.int32) * MOE_BLOCK
    blk_exp = jnp.minimum(jnp.sum(blk_start[:, None] >= pend[None, :], axis=1), N_EXPERTS - 1)
    h_pad = jnp.concatenate([h, jnp.zeros((1, D), h.dtype)], axis=0)

    def run(args):
        tok_b, e_b = args
        xb = h_pad[tok_b]
        return (jax.nn.silu(xb @ w_gate[e_b]) * (xb @ w_up[e_b])) @ w_down[e_b]

    y = lax.map(run, (buf_tok.reshape(nb, MOE_BLOCK), blk_exp)).reshape(P, D)
    out = jnp.zeros((T + 1, D), h.dtype).at[buf_tok].add(y * buf_w[:, None].astype(y.dtype))
    return out[:T]


def _layer(x, ctx, c, c_ctx, ada_w, ada_b, norm_mix_w, norm_ffn_w, w_in, na_q_norm, na_k_norm,
           na_rpb, ret_decay, w_out, router_w, router_bias, w_gate, w_up, w_down, last):
    B, L, D = x.shape
    Lc = ctx.shape[1]
    mod = jax.nn.silu(c) @ ada_w + ada_b
    mod_c = jax.nn.silu(c_ctx) @ ada_w + ada_b
    sh_a, sc_a, g_a, sh_f, sc_f, g_f = jnp.split(mod[:, None, :], 6, axis=-1)
    sh_ac, sc_ac, g_ac, sh_fc, sc_fc, g_fc = jnp.split(mod_c, 6)
    splits = list(np.cumsum([NA_WIDTH] * 3 + [RET_WIDTH] * 4))

    def project(h):
        Bx, Lx = h.shape[:2]
        qa, ka, va, qb, kb, vb, gfw, gbw = jnp.split(h @ w_in, splits, axis=-1)
        na = [a.reshape(Bx, Lx, NA_HEADS, NA_HEAD_DIM) for a in (qa, ka, va)]
        rt = [a.reshape(Bx, Lx, RET_HEADS, RET_HEAD_DIM) for a in (qb, kb, vb)]
        na[0] = _rmsnorm(na[0], na_q_norm)
        na[1] = _rmsnorm(na[1], na_k_norm)
        return na, rt, gfw, gbw

    h = _modulate(x, norm_mix_w, sh_a, sc_a)
    hc = _modulate(ctx, norm_mix_w, sh_ac, sc_ac)
    (qa, ka, va), (qb, kb, vb), gfw, gbw = project(h)
    (qac, kac, vac), (qbc, kbc, vbc), gfc, gbc = project(hc)
    ret_scale = RET_HEAD_DIM ** -0.5
    qb = _axial_rope(qb).astype(jnp.float32)
    kb = _axial_rope(kb).astype(jnp.float32) * ret_scale
    vb = vb.astype(jnp.float32)
    qbc = qbc.astype(jnp.float32)
    kbc = kbc.astype(jnp.float32) * ret_scale
    vbc = vbc.astype(jnp.float32)
    log_g = -jnp.exp(ret_decay.astype(jnp.float32))
    s_f = _retention_final_state(kbc, vbc, log_g[0])
    s_b = _retention_final_state(jnp.flip(kbc, 1), jnp.flip(vbc, 1), log_g[1])

    na_lat = _neighborhood_attention(qa, ka, va, kac, vac, na_rpb).reshape(B, L, NA_WIDTH)
    ret_lat = _bidir_retention(qb, kb, vb, gfw, gbw, log_g, s_f, s_b)
    x = x + g_a * (jnp.concatenate([na_lat, ret_lat], axis=-1) @ w_out)
    if not last:
        zero = jnp.zeros_like(s_f)
        na_ctx = _ctx_attention(qac, kac, vac).reshape(B, Lc, NA_WIDTH)
        ret_ctx = _bidir_retention(qbc, kbc, vbc, gfc, gbc, log_g, zero, zero)
        ctx = ctx + g_ac * (jnp.concatenate([na_ctx, ret_ctx], axis=-1) @ w_out)

    tokens = _modulate(x, norm_ffn_w, sh_f, sc_f).reshape(B * L, D)
    if not last:
        tokens_c = _modulate(ctx, norm_ffn_w, sh_fc, sc_fc).reshape(B * Lc, D)
        tokens = jnp.concatenate([tokens, tokens_c], axis=0)
    y = _moe(tokens, router_w, router_bias, w_gate, w_up, w_down)
    x = x + g_f * y[:B * L].reshape(B, L, D)
    if not last:
        ctx = ctx + g_fc * y[B * L:].reshape(B, Lc, D)
    return x, ctx


def setup_inputs(seed: int = 0) -> dict:
    key = jax.random.key(seed)
    ks = jax.random.split(key, 20)
    f32 = jnp.float32
    nrm = lambda k, shape, s: jax.random.normal(k, shape, f32) * s
    base_decay = np.log(-np.log(1.0 - 2.0 ** (-5.0 - np.arange(RET_HEADS)))).astype(np.float32)
    return {
        'x': nrm(ks[0], (BATCH, SEQ, D_MODEL), 1.0),
        'c': nrm(ks[1], (BATCH, D_MODEL), 1.0),
        'ctx': nrm(ks[2], (BATCH, CTX_LEN, D_MODEL), 1.0),
        'c_ctx': nrm(ks[3], (D_MODEL,), 1.0),
        'ada_w': nrm(ks[4], (DEPTH, D_MODEL, 6 * D_MODEL), 0.5 * D_MODEL ** -0.5),
        'ada_b': nrm(ks[5], (DEPTH, 6 * D_MODEL), 0.02),
        'norm_mix_w': 1.0 + nrm(ks[6], (DEPTH, D_MODEL), 0.02),
        'norm_ffn_w': 1.0 + nrm(ks[7], (DEPTH, D_MODEL), 0.02),
        'w_in': nrm(ks[8], (DEPTH, D_MODEL, IN_COLS), D_MODEL ** -0.5),
        'na_q_norm': 1.0 + nrm(ks[9], (DEPTH, NA_HEAD_DIM), 0.02),
        'na_k_norm': 1.0 + nrm(ks[10], (DEPTH, NA_HEAD_DIM), 0.02),
        'na_rpb': nrm(ks[11], (DEPTH, NA_HEADS, 2 * NA_WIN_H - 1, 2 * NA_WIN_W - 1), 0.02),
        'ret_decay': jnp.asarray(base_decay)[None, None, :] + nrm(ks[12], (DEPTH, 2, RET_HEADS), 0.05),
        'w_out': nrm(ks[13], (DEPTH, MIX_WIDTH, D_MODEL), MIX_WIDTH ** -0.5),
        'router_w': nrm(ks[14], (D_MODEL, N_EXPERTS), D_MODEL ** -0.5),
        'router_bias': nrm(ks[15], (N_EXPERTS,), 0.01),
        'exp_w_gate': nrm(ks[16], (DEPTH, N_EXPERTS, D_MODEL, D_FF_EXPERT), D_MODEL ** -0.5),
        'exp_w_up': nrm(ks[17], (DEPTH, N_EXPERTS, D_MODEL, D_FF_EXPERT), D_MODEL ** -0.5),
        'exp_w_down': nrm(ks[18], (DEPTH, N_EXPERTS, D_FF_EXPERT, D_MODEL), D_FF_EXPERT ** -0.5),
    }


def reference(x, c, ctx, c_ctx, ada_w, ada_b, norm_mix_w, norm_ffn_w, w_in, na_q_norm, na_k_norm,
              na_rpb, ret_decay, w_out, router_w, router_bias, exp_w_gate, exp_w_up, exp_w_down):
    for l in range(DEPTH):
        x, ctx = _layer(x, ctx, c, c_ctx, ada_w[l], ada_b[l], norm_mix_w[l], norm_ffn_w[l], w_in[l],
                        na_q_norm[l], na_k_norm[l], na_rpb[l], ret_decay[l], w_out[l],
                        router_w, router_bias, exp_w_gate[l], exp_w_up[l], exp_w_down[l],
                        l == DEPTH - 1)
    return x
```

```cpp
#include <hip/hip_runtime.h>
#include <cstdio>
#include <cstdint>

#define XB_TMO      128
#define XB_XCNT(j)  (256  + 64 * (j))
#define XB_XSUB(j)  (1280 + 64 * (j))
#define XB_XGEN(j)  (2304 + 64 * (j))
#define XB_TOP      3328
#define XB_TOPGEN   3392
#define XCD_BAR_WORDS 3456
#define XB_SPIN_CAP (1u << 18)
#define LAS __attribute__((address_space(3)))

__device__ __forceinline__ unsigned xb_ld(unsigned* p)              { return __hip_atomic_load(p, __ATOMIC_RELAXED, __HIP_MEMORY_SCOPE_AGENT); }
__device__ __forceinline__ unsigned xb_add(unsigned* p, unsigned v) { return __hip_atomic_fetch_add(p, v, __ATOMIC_RELAXED, __HIP_MEMORY_SCOPE_AGENT); }
__device__ __forceinline__ unsigned xb_xcc_id() { return (unsigned)__builtin_amdgcn_s_getreg((3 << 11) | 20) & 0xFu; }
#define XB_SPIN(cond, bar) do { unsigned _sp = 0; while (cond) { __builtin_amdgcn_s_sleep(1); \
    if ((++_sp & 255u) == 0u) { if (xb_ld(&(bar)[XB_TMO])) break; if (_sp > XB_SPIN_CAP) { atomicAdd(&(bar)[XB_TMO], 1u); break; } } } } while (0)

struct XcdBarrier {
    unsigned* bar; unsigned x;
    volatile LAS unsigned* st;
};

__device__ __forceinline__ XcdBarrier xcd_barrier_post(unsigned* bar, volatile LAS unsigned* st) {
    XcdBarrier b; b.bar = bar; b.x = xb_xcc_id(); b.st = st;
    if (threadIdx.x == 0) (void)xb_add(&bar[XB_XCNT(b.x)], 1u);
    return b;
}
__device__ __forceinline__ void xcd_barrier_complete(unsigned* bar, unsigned x, unsigned& nloc, unsigned& nx) {
    const unsigned G = gridDim.x * gridDim.y * gridDim.z;
    unsigned sum, cnt, mine, sp = 0u;
    for (;;) {
        sum = 0u; cnt = 0u; mine = 0u;
#pragma unroll
        for (unsigned j = 0; j < 16; ++j) { const unsigned c = xb_ld(&bar[XB_XCNT(j)]); sum += c; cnt += (c > 0u) ? 1u : 0u; mine = (j == x) ? c : mine; }
        if (sum == G) break;
        __builtin_amdgcn_s_sleep(1);
        if ((++sp & 255u) == 0u) { if (xb_ld(&bar[XB_TMO])) break; if (sp > XB_SPIN_CAP) { atomicAdd(&bar[XB_TMO], 1u); break; } }
    }
    nloc = mine > 0u ? mine : 1u; nx = cnt > 0u ? cnt : 1u;
}

__device__ __forceinline__ void xcd_barrier(const XcdBarrier& b) {
    asm volatile("s_waitcnt vmcnt(0)" ::: "memory");
    __syncthreads();
    if (threadIdx.x == 0) {
        unsigned* bar = b.bar;
        __builtin_amdgcn_s_waitcnt(0);
        unsigned nloc = b.st[0], nx = b.st[1];
        if (nloc == 0u) { xcd_barrier_complete(bar, b.x, nloc, nx); b.st[0] = nloc; b.st[1] = nx; }
        const unsigned old = xb_add(&bar[XB_XSUB(b.x)], 1u);
        const unsigned gen = old / nloc;
        if (old + 1u == (gen + 1u) * nloc) {
            __builtin_amdgcn_fence(__ATOMIC_RELEASE, "agent");
            asm volatile("s_waitcnt vmcnt(0)" ::: "memory");
            const unsigned og = xb_add(&bar[XB_TOP], 1u);
            const unsigned tg = og / nx;
            if (og + 1u == (tg + 1u) * nx) xb_add(&bar[XB_TOPGEN], 1u);
            else XB_SPIN(xb_ld(&bar[XB_TOPGEN]) == tg, bar);
            __builtin_amdgcn_fence(__ATOMIC_ACQUIRE, "agent");
            xb_add(&bar[XB_XGEN(b.x)], 1u);
            asm volatile("s_waitcnt vmcnt(0)" ::: "memory");
        } else {
            XB_SPIN(xb_ld(&bar[XB_XGEN(b.x)]) == gen, bar);
            __builtin_amdgcn_fence(__ATOMIC_ACQUIRE, "agent");
            asm volatile("s_waitcnt vmcnt(0)" ::: "memory");
        }
    }
    __syncthreads();
}
namespace pg8 {
#define PG8_LAS __attribute__((address_space(3)))
typedef unsigned short bf16_t;
typedef short bf16x8 __attribute__((ext_vector_type(8)));
typedef float f32x4 __attribute__((ext_vector_type(4)));
typedef unsigned u32x4 __attribute__((ext_vector_type(4)));
constexpr int BM = 256, BK = 64, HALF = 128, HTB = HALF * BK * 2  , STAGE_BYTES = 8 * HTB, NXCD = 8, WGM = 8;

__host__ __device__ __forceinline__ int lds_byte(int r, int c) { const int st = (r >> 4) * 2 + (c >> 5), rr = r & 15, cc = c & 31, ob = rr * 64 + cc * 2; return st * 1024 + (ob ^ (((ob >> 9) & 1) << 5)); }
__host__ __device__ __forceinline__ void stage_rc(int b, int& R, int& C) { const int st = b / 1024, sb = b % 1024, swz = sb ^ (((sb >> 9) & 1) << 5); R = (st >> 1) * 16 + swz / 64; C = (st & 1) * 32 + (swz % 64) / 2; }
__host__ __device__ __forceinline__ int perm32(int rho) { const int n = rho >> 4, i = rho & 15; return 8 * (i >> 2) + 4 * n + (i & 3); }

struct Unit { int pm, pn; };
struct Gemm { const bf16_t* A; const bf16_t* Bt; int M, N, K; };

struct StaticOrder {
    int nM, nN, nwg, G, c;
    __host__ __device__ void init(int M, int N, int G_, int c_) { nM = M / BM; nN = N / BM; nwg = nM * nN; G = G_; c = c_; }
    __host__ __device__ bool next(int i, Unit& u) const {
        const long L = (long)i * G + c; if (L >= nwg) return false;
        int wgid = (int)L; { const int q = nwg / NXCD, r = nwg % NXCD, xcd = wgid % NXCD, off = wgid / NXCD; wgid = (xcd < r ? xcd * (q + 1) : r * (q + 1) + (xcd - r) * q) + off; }
        const int nig = WGM * nN, gid = wgid / nig, fm = gid * WGM, gsz = (nM - fm) < WGM ? (nM - fm) : WGM;
        u.pm = fm + ((wgid % nig) % gsz); u.pn = (wgid % nig) / gsz; return true;
    }
    __device__ __forceinline__ void a_ready(const Unit&) const {}
    __device__ __forceinline__ void done(const Unit&) const {}
};
__device__ __forceinline__ unsigned cvt_pk_bf16(float lo, float hi) { unsigned r; asm volatile("v_cvt_pk_bf16_f32 %0, %1, %2" : "=v"(r) : "v"(lo), "v"(hi)); return r; }
typedef float f32x2 __attribute__((ext_vector_type(2)));
template <class Epi, class Sched, bool STAMP = false>
__device__ __forceinline__ void gemm_phase(PG8_LAS unsigned char* lds, const Gemm g, const Sched& S, const Epi& E, unsigned long long* stamps) {
    int tid_o_ = threadIdx.x; asm volatile("" : "+v"(tid_o_)); const int tid = tid_o_, wid = __builtin_amdgcn_readfirstlane(tid >> 6), lane = tid & 63, wr = wid >> 2, wc = wid & 3, fr = lane & 15, fq = lane >> 4;
    const int K = g.K, nt = K / BK;
    int ts_lo = 0, ts_hi = 0, nts = 0; const unsigned long long rt_entry = STAMP ? (unsigned long long)wall_clock64() : 0ull;
#define PG8_STAMP() do { if (STAMP && wid == 0 && nts < 64) { const unsigned long long _c = (unsigned long long)clock64(); \
        ts_lo = (lane == nts) ? (int)(unsigned)_c : ts_lo; ts_hi = (lane == nts) ? (int)(unsigned)(_c >> 32) : ts_hi; ++nts; } } while (0)
    PG8_STAMP();
    unsigned voffA[2], voffB[2];
#pragma unroll
    for (int i = 0; i < 2; ++i) { int R, C; stage_rc(tid * 16 + i * 8192, R, C); const int Rb = Epi::PERM ? ((R & ~31) + perm32(R & 31)) : R;
        voffA[i] = (unsigned)(R * K + C) * 2u; voffB[i] = (unsigned)(Rb * K + C) * 2u; }
    const size_t kstep = (size_t)(BK * 2);
    const size_t hstep = (size_t)HALF * K * 2;
    const size_t tstep = 2 * hstep;
    const unsigned ldsw = (unsigned)wid * 1024u;
    const int aoff = lds_byte(wr * 64 + fr, fq * 8), boff = lds_byte(wc * 32 + fr, fq * 8);
#define PG8_SA(b, h) (((b) * 2 + (h)) * HTB)
#define PG8_SB(b, h) ((4 + (b) * 2 + (h)) * HTB)
#define PG8_STAGE(bufoff, gbase, voff) do { _Pragma("unroll") for (int _i = 0; _i < 2; ++_i) \
        __builtin_amdgcn_global_load_lds((const unsigned*)((const char*)(gbase) + (voff)[_i]), (PG8_LAS unsigned*)(lds + (bufoff) + ldsw + _i * 8192), 16, 0, 0); } while (0)
#define PG8_LDA(dst, b, h) do { _Pragma("unroll") for (int m = 0; m < 4; ++m) _Pragma("unroll") for (int k = 0; k < 2; ++k) dst[m][k] = *(const PG8_LAS bf16x8*)(lds + PG8_SA(b, h) + aoff + m * 2048 + k * 1024); } while (0)
#define PG8_LDB(dst, b, h) do { _Pragma("unroll") for (int n = 0; n < 2; ++n) _Pragma("unroll") for (int k = 0; k < 2; ++k) dst[n][k] = *(const PG8_LAS bf16x8*)(lds + PG8_SB(b, h) + boff + n * 2048 + k * 1024); } while (0)
#define PG8_MMA(ai, bj, At, Bt) do { __builtin_amdgcn_s_setprio(1); _Pragma("unroll") for (int m = 0; m < 4; ++m) _Pragma("unroll") for (int n = 0; n < 2; ++n) _Pragma("unroll") for (int k = 0; k < 2; ++k) \
        acc[ai][bj][m][n] = __builtin_amdgcn_mfma_f32_16x16x32_bf16(Bt[n][k], At[m][k], acc[ai][bj][m][n], 0, 0, 0); __builtin_amdgcn_s_setprio(0); } while (0)
#define PG8_WAIT_V(n) asm volatile("s_waitcnt vmcnt(" #n ")" ::: "memory")
#define PG8_WAIT_L(n) asm volatile("s_waitcnt lgkmcnt(" #n ")" ::: "memory")
#define PG8_BAR __builtin_amdgcn_s_barrier()
#define PG8_SCHED __builtin_amdgcn_sched_barrier(0)
    Unit cur, nxt; int ui = 0;
    if (!S.next(0, cur)) return;
    f32x4 acc[2][2][4][2];
#pragma unroll
    for (int a = 0; a < 2; ++a)
#pragma unroll
        for (int b = 0; b < 2; ++b)
#pragma unroll
            for (int m = 0; m < 4; ++m)
#pragma unroll
                for (int n = 0; n < 2; ++n) acc[a][b][m][n] = (f32x4){0.f, 0.f, 0.f, 0.f};
    bf16x8 At[4][2], B0[2][2], B1[2][2];
    const char* cA = (const char*)g.A + (size_t)cur.pm * tstep; const char* cB = (const char*)g.Bt + (size_t)cur.pn * tstep;
    S.a_ready(cur);
    PG8_STAGE(PG8_SB(0, 0), cB, voffB); PG8_STAGE(PG8_SA(0, 0), cA, voffA); PG8_STAGE(PG8_SB(0, 1), cB + hstep, voffB); PG8_STAGE(PG8_SA(0, 1), cA + hstep, voffA);
    if (wr == 1) PG8_BAR;
    PG8_WAIT_V(4); PG8_BAR;
    PG8_STAGE(PG8_SB(1, 0), cB + kstep, voffB); PG8_STAGE(PG8_SA(1, 0), cA + kstep, voffA); PG8_STAGE(PG8_SB(1, 1), cB + hstep + kstep, voffB);
    PG8_WAIT_V(6); PG8_BAR;
    PG8_STAMP();
    for (;;) {
        const bool has_next = S.next(ui + 1, nxt);
        const char* nA = has_next ? (const char*)g.A + (size_t)nxt.pm * tstep : cA; const char* nB = has_next ? (const char*)g.Bt + (size_t)nxt.pn * tstep : cB;
        for (int t = 0; t < nt; t += 2) {
            const bool last = (t == nt - 2);
            const char* a1 = cA + (size_t)(t + 1) * kstep;
            const char* a2 = last ? nA : cA + (size_t)(t + 2) * kstep; const char* b2 = last ? nB : cB + (size_t)(t + 2) * kstep;
            const char* a3 = a2 + kstep; const char* b3 = b2 + kstep;
            if (last && has_next) S.a_ready(nxt);
            PG8_LDB(B0, 0, 0); PG8_SCHED; PG8_LDA(At, 0, 0); PG8_STAGE(PG8_SA(1, 1), a1 + hstep, voffA);
            PG8_WAIT_L(8); PG8_BAR; PG8_WAIT_L(0); PG8_MMA(0, 0, At, B0); PG8_BAR; PG8_SCHED;
            PG8_LDB(B1, 0, 1); PG8_STAGE(PG8_SB(0, 0), b2, voffB);
            PG8_BAR; PG8_WAIT_L(0); PG8_MMA(0, 1, At, B1); PG8_BAR;
            PG8_LDA(At, 0, 1); PG8_STAGE(PG8_SA(0, 0), a2, voffA);
            PG8_BAR; PG8_WAIT_L(0); PG8_MMA(1, 0, At, B0); PG8_BAR; PG8_SCHED;
            PG8_STAGE(PG8_SB(0, 1), b2 + hstep, voffB);
            PG8_WAIT_V(6); PG8_BAR; PG8_MMA(1, 1, At, B1); PG8_BAR;
            PG8_LDB(B0, 1, 0); PG8_SCHED; PG8_LDA(At, 1, 0); PG8_STAGE(PG8_SA(0, 1), a2 + hstep, voffA);
            PG8_WAIT_L(8); PG8_BAR; PG8_WAIT_L(0); PG8_MMA(0, 0, At, B0); PG8_BAR; PG8_SCHED;
            PG8_LDB(B1, 1, 1); PG8_STAGE(PG8_SB(1, 0), b3, voffB);
            PG8_BAR; PG8_WAIT_L(0); PG8_MMA(0, 1, At, B1); PG8_BAR;
            PG8_LDA(At, 1, 1); PG8_STAGE(PG8_SA(1, 0), a3, voffA);
            PG8_BAR; PG8_WAIT_L(0); PG8_MMA(1, 0, At, B0); PG8_BAR; PG8_SCHED;
            PG8_STAGE(PG8_SB(1, 1), b3 + hstep, voffB);
            PG8_WAIT_V(6); PG8_BAR; PG8_MMA(1, 1, At, B1); PG8_BAR;
        }
        PG8_STAMP();
        if constexpr (!Epi::AFTER_DRAIN) { E(acc, cur, wr, wc, fr, fq); S.done(cur); }
        PG8_STAMP();
        if (!has_next) break;
#pragma unroll
        for (int a = 0; a < 2; ++a)
#pragma unroll
            for (int b = 0; b < 2; ++b)
#pragma unroll
                for (int m = 0; m < 4; ++m)
#pragma unroll
                    for (int n = 0; n < 2; ++n) acc[a][b][m][n] = (f32x4){0.f, 0.f, 0.f, 0.f};
        cur = nxt; cA = nA; cB = nB; ++ui;
    }
    PG8_WAIT_V(0);
    if (wr == 0) PG8_BAR;
    PG8_BAR;
    if constexpr (Epi::AFTER_DRAIN) { E.fused(acc, cur, wr, wc, fr, fq, lds, wid, lane); S.done(cur); }
    PG8_STAMP();
    if (STAMP && wid == 0) { stamps[lane] = lane < nts ? (((unsigned long long)(unsigned)ts_hi << 32) | (unsigned)ts_lo) : 0ull;
        if (lane == 62) stamps[62] = rt_entry; if (lane == 63) stamps[63] = (unsigned long long)wall_clock64(); }
#undef PG8_STAMP
#undef PG8_SA
#undef PG8_SB
#undef PG8_STAGE
#undef PG8_LDA
#undef PG8_LDB
#undef PG8_MMA
#undef PG8_WAIT_V
#undef PG8_WAIT_L
#undef PG8_BAR
#undef PG8_SCHED
}
}

namespace mk {
#define MLAS __attribute__((address_space(3)))
typedef unsigned short bf16_t;
typedef float f32x4 __attribute__((ext_vector_type(4)));
typedef unsigned u32x4 __attribute__((ext_vector_type(4)));
typedef unsigned u32x2 __attribute__((ext_vector_type(2)));

constexpr int D = 1024, NB = 16, SEQ = 4096, LC = 256, TL = NB * SEQ, TC = NB * LC, TT = TL + TC;
constexpr int INC = 4096, NE = 32, DFF = 512, NCH = 34, PMAX = 147456, NT = 512;
constexpr int LDS_BYTES = 150 * 1024, LDS_CTL = LDS_BYTES - 256;
constexpr int C_QA = 0, C_KA = 512, C_VA = 1024, C_QB = 1536, C_KB = 2048, C_VB = 2560, C_GF = 3072, C_GB = 3584;

constexpr size_t al256(size_t x) { return (x + 255) & ~(size_t)255; }
constexpr size_t WS_BAR = 0;
constexpr size_t WS_CNT = 16384;
constexpr size_t WS_ZERO_BYTES = 16384 + 4096;
constexpr size_t WS_MOD = WS_ZERO_BYTES;
constexpr size_t WS_WIN = al256(WS_MOD + (size_t)2 * 17 * 6144 * 4);
constexpr size_t WS_WOUT = WS_WIN + (size_t)2 * 4096 * 1024 * 2;
constexpr size_t WS_WGU = WS_WOUT + (size_t)2 * 1024 * 1024 * 2;
constexpr size_t WS_WDN = WS_WGU + (size_t)32 * 1024 * 1024 * 2;
constexpr size_t WS_CTX = WS_WDN + (size_t)32 * 1024 * 512 * 2;
constexpr size_t WS_H = WS_CTX + (size_t)TC * D * 4;
constexpr size_t WS_PROJ = WS_H + (size_t)TT * D * 2;
constexpr size_t WS_XS = WS_PROJ;
constexpr size_t WS_ACT = WS_PROJ + (size_t)PMAX * D * 2;
constexpr size_t WS_ST = WS_PROJ + (size_t)TT * INC * 2;
constexpr size_t WS_TOKE = WS_ST + (size_t)NB * 4 * 2 * NCH * 16384 * 2;
constexpr size_t WS_TOKR = WS_TOKE + (size_t)TT * 2 * 4;
constexpr size_t WS_TOKW = WS_TOKR + (size_t)TT * 2 * 4;
constexpr size_t WS_RINFO = WS_TOKW + (size_t)TT * 2 * 4;
constexpr size_t WS_RW = WS_RINFO + (size_t)PMAX * 4;
constexpr size_t WS_BLKE = WS_RW + (size_t)PMAX * 4;
constexpr size_t WS_END = WS_BLKE + 4096;
static_assert(WS_ACT + (size_t)PMAX * DFF * 2 <= WS_ST, "act fits in proj region");
static_assert((size_t)TT * 2 * D * 2 <= (size_t)PMAX * D * 2, "y2 fits in xs region");
static_assert(WS_END <= (size_t)1 << 30, "workspace must fit in 1 GiB");

struct Args {
    const float* x; const float* c; const float* ctx; const float* c_ctx; const float* ada_w; const float* ada_b;
    const float* norm_mix_w; const float* norm_ffn_w; const float* w_in; const float* na_q_norm; const float* na_k_norm;
    const float* na_rpb; const float* ret_decay; const float* w_out; const float* router_w; const float* router_bias;
    const float* w_gate; const float* w_up; const float* w_down;
    float* out; unsigned char* ws; int ph_lo, ph_hi;
};

__device__ __forceinline__ int otid() { int t = threadIdx.x; asm volatile("" : "+v"(t)); return t; }
__device__ __forceinline__ float bf2f(bf16_t v) { return __uint_as_float(((unsigned)v) << 16); }
__device__ __forceinline__ bf16_t f2bf(float f) { unsigned u = __float_as_uint(f); u += 0x7FFFu + ((u >> 16) & 1u); return (bf16_t)(u >> 16); }
__device__ __forceinline__ unsigned pack2(float lo, float hi) { return (unsigned)f2bf(lo) | ((unsigned)f2bf(hi) << 16); }
__device__ __forceinline__ float lo16(unsigned w) { return __uint_as_float(w << 16); }
__device__ __forceinline__ float hi16(unsigned w) { return __uint_as_float(w & 0xffff0000u); }
__device__ __forceinline__ float siluf(float v) { return v / (1.0f + __expf(-v)); }
__device__ __forceinline__ float wave_sum(float v) {
#pragma unroll
    for (int o = 32; o >= 1; o >>= 1) v += __shfl_xor(v, o);
    return v;
}
__device__ __forceinline__ const float* modp(const Args& a, int l, int r, int k6) { return (const float*)(a.ws + WS_MOD) + ((size_t)l * 17 + r) * 6144 + k6 * 1024; }

__device__ __forceinline__ void cvt_tile(const float* __restrict__ src, int ldn, int k0, int n0, bf16_t* __restrict__ dst, int ldk, int nd0, MLAS float* tl, int tid) {
    {
        const int kk = tid >> 3, nn0 = (tid & 7) * 8;
        const f32x4 v0 = *(const f32x4*)(src + (size_t)(k0 + kk) * ldn + n0 + nn0), v1 = *(const f32x4*)(src + (size_t)(k0 + kk) * ldn + n0 + nn0 + 4);
#pragma unroll
        for (int j = 0; j < 4; ++j) { tl[kk * 65 + nn0 + j] = v0[j]; tl[kk * 65 + nn0 + 4 + j] = v1[j]; }
    }
    __syncthreads();
    {
        const int n = tid >> 3, kc = (tid & 7) * 8;
        u32x4 w;
        w.x = pack2(tl[(kc + 0) * 65 + n], tl[(kc + 1) * 65 + n]); w.y = pack2(tl[(kc + 2) * 65 + n], tl[(kc + 3) * 65 + n]);
        w.z = pack2(tl[(kc + 4) * 65 + n], tl[(kc + 5) * 65 + n]); w.w = pack2(tl[(kc + 6) * 65 + n], tl[(kc + 7) * 65 + n]);
        *(u32x4*)(dst + (size_t)(nd0 + n) * ldk + k0 + kc) = w;
    }
    __syncthreads();
}
__device__ void convert_dense(const Args& a, MLAS unsigned char* lds, int bid, int nb) {
    MLAS float* tl = (MLAS float*)lds; const int tid = otid();
    for (int t = bid; t < 2 * 1024 + 2 * 256; t += nb) {
        if (t < 2048) { const int l = t >> 10, tt = t & 1023, kt = tt >> 6, nt = tt & 63;
            cvt_tile(a.w_in + (size_t)l * D * INC, INC, kt * 64, nt * 64, (bf16_t*)(a.ws + WS_WIN) + (size_t)l * INC * D, D, nt * 64, tl, tid); }
        else { const int t2 = t - 2048, l = t2 >> 8, tt = t2 & 255, kt = tt >> 4, nt = tt & 15;
            cvt_tile(a.w_out + (size_t)l * D * D, D, kt * 64, nt * 64, (bf16_t*)(a.ws + WS_WOUT) + (size_t)l * D * D, D, nt * 64, tl, tid); }
    }
}
__device__ void convert_experts(const Args& a, int l, MLAS unsigned char* lds, int bid, int nb) {
    MLAS float* tl = (MLAS float*)lds; const int tid = otid();
    for (int t = bid; t < 3 * 4096; t += nb) {
        const int which = t >> 12, tt = t & 4095, e = tt >> 7, r = tt & 127;
        if (which < 2) {
            const int kt = r >> 3, nt = r & 7, n0 = nt * 64;
            const float* src = (which == 0 ? a.w_gate : a.w_up) + ((size_t)l * NE + e) * D * DFF;
            const int nd0 = (n0 >> 7) * 256 + which * 128 + (n0 & 127);
            cvt_tile(src, DFF, kt * 64, n0, (bf16_t*)(a.ws + WS_WGU) + (size_t)e * 1024 * D, D, nd0, tl, tid);
        } else {
            const int kt = r >> 4, nt = r & 15;
            const float* src = a.w_down + ((size_t)l * NE + e) * DFF * D;
            cvt_tile(src, D, kt * 64, nt * 64, (bf16_t*)(a.ws + WS_WDN) + (size_t)e * 1024 * DFF, DFF, nt * 64, tl, tid);
        }
    }
}
__device__ void compute_mod(const Args& a, MLAS unsigned char* lds, int bid, int nb) {
    MLAS float* sc = (MLAS float*)lds;
    MLAS float* red = (MLAS float*)(lds + 17 * 1024 * 4);
    const int tid = otid();
    if (bid >= 192) return;
    for (int i = tid; i < 17 * 1024; i += NT) { const int r = i >> 10, k = i & 1023; const float v = r < 16 ? a.c[r * 1024 + k] : a.c_ctx[k]; sc[i] = v / (1.0f + expf(-v)); }
    __syncthreads();
    for (int u = bid; u < 192; u += nb) {
        const int l = u / 96, n = (u % 96) * 64 + (tid & 63), kp = tid >> 6;
        float acc[17];
#pragma unroll
        for (int r = 0; r < 17; ++r) acc[r] = 0.f;
        const float* w = a.ada_w + (size_t)l * D * 6144 + n;
        for (int k = kp * 128; k < kp * 128 + 128; ++k) { const float wv = w[(size_t)k * 6144];
#pragma unroll
            for (int r = 0; r < 17; ++r) acc[r] += sc[r * 1024 + k] * wv; }
#pragma unroll
        for (int r = 0; r < 17; ++r) red[(kp * 17 + r) * 64 + (tid & 63)] = acc[r];
        __syncthreads();
        for (int i = tid; i < 17 * 64; i += NT) { const int r = i >> 6, cc = i & 63, nn = (u % 96) * 64 + cc; float s = a.ada_b[l * 6144 + nn];
#pragma unroll
            for (int p = 0; p < 8; ++p) s += red[(p * 17 + r) * 64 + cc];
            ((float*)(a.ws + WS_MOD))[((size_t)l * 17 + r) * 6144 + nn] = s; }
        __syncthreads();
    }
}

__device__ void phase_norm1(const Args& a, int l, int bid, int nb) {
    const int tid = otid(), lane = tid & 63, wave = tid >> 6;
    const int e0 = lane * 8, e1 = 512 + lane * 8;
    float wn[16];
    { const float* w = a.norm_mix_w + l * D;
#pragma unroll
      for (int j = 0; j < 8; ++j) { wn[j] = w[e0 + j]; wn[8 + j] = w[e1 + j]; } }
    float msc[16], msh[16], mg[16]; int cur_r = -1;
    bf16_t* hb = (bf16_t*)(a.ws + WS_H);
    const bf16_t* y2 = (const bf16_t*)(a.ws + WS_XS);
    for (int row = bid * 8 + wave; row < TT; row += nb * 8) {
        const int r = row < TL ? row / SEQ : 16;
        if (r != cur_r) { cur_r = r; const float* sh = modp(a, l, r, 0); const float* sc = modp(a, l, r, 1);
#pragma unroll
            for (int j = 0; j < 8; ++j) { msh[j] = sh[e0 + j]; msh[8 + j] = sh[e1 + j]; msc[j] = 1.0f + sc[e0 + j]; msc[8 + j] = 1.0f + sc[e1 + j]; }
            if (l > 0) { const float* g = modp(a, l - 1, r, 5);
#pragma unroll
                for (int j = 0; j < 8; ++j) { mg[j] = g[e0 + j]; mg[8 + j] = g[e1 + j]; } } }
        const float* src = l == 0 ? (row < TL ? a.x + (size_t)row * D : a.ctx + (size_t)(row - TL) * D)
                                  : (row < TL ? a.out + (size_t)row * D : (const float*)(a.ws + WS_CTX) + (size_t)(row - TL) * D);
        float v[16];
        { const f32x4 x0 = *(const f32x4*)(src + e0), x1 = *(const f32x4*)(src + e0 + 4), x2 = *(const f32x4*)(src + e1), x3 = *(const f32x4*)(src + e1 + 4);
#pragma unroll
          for (int j = 0; j < 4; ++j) { v[j] = x0[j]; v[4 + j] = x1[j]; v[8 + j] = x2[j]; v[12 + j] = x3[j]; } }
        if (l > 0) {
            const bf16_t* ya = y2 + (size_t)row * 2 * D; const bf16_t* yb = ya + D;
            const u32x4 a0 = *(const u32x4*)(ya + e0), a1 = *(const u32x4*)(ya + e1), b0 = *(const u32x4*)(yb + e0), b1 = *(const u32x4*)(yb + e1);
#pragma unroll
            for (int j = 0; j < 4; ++j) {
                v[2 * j] += mg[2 * j] * (lo16(a0[j]) + lo16(b0[j])); v[2 * j + 1] += mg[2 * j + 1] * (hi16(a0[j]) + hi16(b0[j]));
                v[8 + 2 * j] += mg[8 + 2 * j] * (lo16(a1[j]) + lo16(b1[j])); v[8 + 2 * j + 1] += mg[8 + 2 * j + 1] * (hi16(a1[j]) + hi16(b1[j])); }
            if (row < TL) { float* dst = a.out + (size_t)row * D;
                *(f32x4*)(dst + e0) = (f32x4){v[0], v[1], v[2], v[3]}; *(f32x4*)(dst + e0 + 4) = (f32x4){v[4], v[5], v[6], v[7]};
                *(f32x4*)(dst + e1) = (f32x4){v[8], v[9], v[10], v[11]}; *(f32x4*)(dst + e1 + 4) = (f32x4){v[12], v[13], v[14], v[15]}; }
        }
        float ss = 0.f;
#pragma unroll
        for (int j = 0; j < 16; ++j) ss += v[j] * v[j];
        ss = wave_sum(ss);
        const float rs = rsqrtf(ss * (1.0f / D) + 1e-6f);
        float y[16];
#pragma unroll
        for (int j = 0; j < 16; ++j) y[j] = v[j] * rs * wn[j] * msc[j] + msh[j];
        bf16_t* hp = hb + (size_t)row * D;
        *(u32x4*)(hp + e0) = (u32x4){pack2(y[0], y[1]), pack2(y[2], y[3]), pack2(y[4], y[5]), pack2(y[6], y[7])};
        *(u32x4*)(hp + e1) = (u32x4){pack2(y[8], y[9]), pack2(y[10], y[11]), pack2(y[12], y[13]), pack2(y[14], y[15])};
    }
}
__device__ void phase_final(const Args& a, int bid, int nb) {
    const int tid = otid(), lane = tid & 63, wave = tid >> 6;
    const int e0 = lane * 8, e1 = 512 + lane * 8;
    float mg[16]; int cur_r = -1;
    const bf16_t* y2 = (const bf16_t*)(a.ws + WS_XS);
    for (int row = bid * 8 + wave; row < TL; row += nb * 8) {
        const int r = row / SEQ;
        if (r != cur_r) { cur_r = r; const float* g = modp(a, 1, r, 5);
#pragma unroll
            for (int j = 0; j < 8; ++j) { mg[j] = g[e0 + j]; mg[8 + j] = g[e1 + j]; } }
        float* src = a.out + (size_t)row * D;
        float v[16];
        { const f32x4 x0 = *(const f32x4*)(src + e0), x1 = *(const f32x4*)(src + e0 + 4), x2 = *(const f32x4*)(src + e1), x3 = *(const f32x4*)(src + e1 + 4);
#pragma unroll
          for (int j = 0; j < 4; ++j) { v[j] = x0[j]; v[4 + j] = x1[j]; v[8 + j] = x2[j]; v[12 + j] = x3[j]; } }
        const bf16_t* ya = y2 + (size_t)row * 2 * D; const bf16_t* yb = ya + D;
        const u32x4 a0 = *(const u32x4*)(ya + e0), a1 = *(const u32x4*)(ya + e1), b0 = *(const u32x4*)(yb + e0), b1 = *(const u32x4*)(yb + e1);
#pragma unroll
        for (int j = 0; j < 4; ++j) {
            v[2 * j] += mg[2 * j] * (lo16(a0[j]) + lo16(b0[j])); v[2 * j + 1] += mg[2 * j + 1] * (hi16(a0[j]) + hi16(b0[j]));
            v[8 + 2 * j] += mg[8 + 2 * j] * (lo16(a1[j]) + lo16(b1[j])); v[8 + 2 * j + 1] += mg[8 + 2 * j + 1] * (hi16(a1[j]) + hi16(b1[j])); }
        *(f32x4*)(src + e0) = (f32x4){v[0], v[1], v[2], v[3]}; *(f32x4*)(src + e0 + 4) = (f32x4){v[4], v[5], v[6], v[7]};
        *(f32x4*)(src + e1) = (f32x4){v[8], v[9], v[10], v[11]}; *(f32x4*)(src + e1 + 4) = (f32x4){v[12], v[13], v[14], v[15]};
    }
}

__device__ void phase_prep(const Args& a, int l, int bid, int nb) {
    const int tid = otid(), lane = tid & 63, wave = tid >> 6;
    bf16_t* proj = (bf16_t*)(a.ws + WS_PROJ);
    float wq[16];
    { const float* w = (lane < 32 ? a.na_q_norm : a.na_k_norm) + l * 64 + (lane & 3) * 16; const float s = lane < 32 ? 0.125f : 1.0f;
#pragma unroll
      for (int j = 0; j < 16; ++j) wq[j] = w[j] * s; }
    const int g = lane >> 2, f0 = (lane & 3) * 8, axis = g & 1;
    const float kscale = g >= 8 ? 0.08838834764831845f : 1.0f;
    float fr[8];
#pragma unroll
    for (int j = 0; j < 8; ++j) fr[j] = exp2f(-(float)(f0 + j) * (13.287712379549449f / 32.0f));
    for (int row = bid * 8 + wave; row < TT; row += nb * 8) {
        bf16_t* p = proj + (size_t)row * INC;
        {
            u32x4 w0 = *(const u32x4*)(p + lane * 16), w1 = *(const u32x4*)(p + lane * 16 + 8);
            float f[16];
#pragma unroll
            for (int j = 0; j < 4; ++j) { f[2 * j] = lo16(w0[j]); f[2 * j + 1] = hi16(w0[j]); f[8 + 2 * j] = lo16(w1[j]); f[8 + 2 * j + 1] = hi16(w1[j]); }
            float ss = 0.f;
#pragma unroll
            for (int j = 0; j < 16; ++j) ss += f[j] * f[j];
            ss += __shfl_xor(ss, 1); ss += __shfl_xor(ss, 2);
            const float rs = rsqrtf(ss * (1.0f / 64.0f) + 1e-6f);
#pragma unroll
            for (int j = 0; j < 16; ++j) f[j] = f[j] * rs * wq[j];
            *(u32x4*)(p + lane * 16) = (u32x4){pack2(f[0], f[1]), pack2(f[2], f[3]), pack2(f[4], f[5]), pack2(f[6], f[7])};
            *(u32x4*)(p + lane * 16 + 8) = (u32x4){pack2(f[8], f[9]), pack2(f[10], f[11]), pack2(f[12], f[13]), pack2(f[14], f[15])};
        }
        {
            bf16_t* q = p + C_QB + g * 64 + f0;
            const u32x4 w0 = *(const u32x4*)q, w1 = *(const u32x4*)(q + 32);
            float x1[8], x2[8];
#pragma unroll
            for (int j = 0; j < 4; ++j) { x1[2 * j] = lo16(w0[j]); x1[2 * j + 1] = hi16(w0[j]); x2[2 * j] = lo16(w1[j]); x2[2 * j + 1] = hi16(w1[j]); }
            if (row < TL) {
                const int t = row & (SEQ - 1); const float pos = (float)(axis == 0 ? (t >> 6) : (t & 63));
#pragma unroll
                for (int j = 0; j < 8; ++j) { float sn, cs; sincosf(pos * fr[j], &sn, &cs); const float u = x1[j] * cs - x2[j] * sn, v = x1[j] * sn + x2[j] * cs; x1[j] = u; x2[j] = v; }
            }
#pragma unroll
            for (int j = 0; j < 8; ++j) { x1[j] *= kscale; x2[j] *= kscale; }
            *(u32x4*)q = (u32x4){pack2(x1[0], x1[1]), pack2(x1[2], x1[3]), pack2(x1[4], x1[5]), pack2(x1[6], x1[7])};
            *(u32x4*)(q + 32) = (u32x4){pack2(x2[0], x2[1]), pack2(x2[2], x2[3]), pack2(x2[4], x2[5]), pack2(x2[6], x2[7])};
        }
    }
}

__device__ __forceinline__ int chunk_row0(int b, int c) { return c < 2 ? TL + b * LC + c * 128 : b * SEQ + (c - 2) * 128; }
__device__ __forceinline__ size_t st_index(int b, int h, int dir, int c) { return ((((size_t)b * 4 + h) * 2 + dir) * NCH + c) * 16384; }
constexpr int RP = 136;
__device__ __forceinline__ void stage_tile(const bf16_t* proj, int row0, int col0, MLAS bf16_t* dst, int tid) {
#pragma unroll
    for (int i = 0; i < 4; ++i) { const int ch = tid + i * NT, r = ch >> 4, cc = (ch & 15) * 8;
        *(MLAS u32x4*)(dst + r * RP + cc) = *(const u32x4*)(proj + (size_t)(row0 + r) * INC + col0 + cc); }
}
__device__ void phase_ret_a(const Args& a, int l, MLAS unsigned char* lds, int bid, int nb) {
    const int tid = otid();
    const bf16_t* proj = (const bf16_t*)(a.ws + WS_PROJ); bf16_t* st = (bf16_t*)(a.ws + WS_ST);
    MLAS bf16_t* Ks = (MLAS bf16_t*)lds; MLAS bf16_t* Vs = Ks + 128 * RP; MLAS float* pw = (MLAS float*)(Vs + 128 * RP);
    for (int u = bid; u < NB * NCH * 4; u += nb) {
        const int b = u / (NCH * 4), c = (u >> 2) % NCH, h = u & 3, row0 = chunk_row0(b, c);
        const float lgf = -expf(a.ret_decay[l * 8 + h]), lgb = -expf(a.ret_decay[l * 8 + 4 + h]);
        __syncthreads();
        stage_tile(proj, row0, C_KB + h * 128, Ks, tid); stage_tile(proj, row0, C_VB + h * 128, Vs, tid);
        if (tid < 128) pw[tid] = expf((float)(127 - tid) * lgf); else if (tid < 256) pw[tid] = expf((float)(tid - 128) * lgb);
        __syncthreads();
        const int d = tid >> 2, eb = (tid & 3) * 32;
        float af[32], ab[32];
#pragma unroll
        for (int e = 0; e < 32; ++e) { af[e] = 0.f; ab[e] = 0.f; }
        for (int j = 0; j < 128; ++j) {
            const float kv = bf2f(Ks[j * RP + d]), kf = kv * pw[j], kb = kv * pw[128 + j];
#pragma unroll
            for (int e8 = 0; e8 < 4; ++e8) { const u32x4 w = *(const MLAS u32x4*)(Vs + j * RP + eb + e8 * 8);
#pragma unroll
                for (int q = 0; q < 4; ++q) { const float v0 = lo16(w[q]), v1 = hi16(w[q]);
                    af[e8 * 8 + 2 * q] += kf * v0; af[e8 * 8 + 2 * q + 1] += kf * v1; ab[e8 * 8 + 2 * q] += kb * v0; ab[e8 * 8 + 2 * q + 1] += kb * v1; } }
        }
        bf16_t* of = st + st_index(b, h, 0, c) + d * 128 + eb; bf16_t* ob = st + st_index(b, h, 1, c) + d * 128 + eb;
#pragma unroll
        for (int e8 = 0; e8 < 4; ++e8) {
            *(u32x4*)(of + e8 * 8) = (u32x4){pack2(af[e8 * 8], af[e8 * 8 + 1]), pack2(af[e8 * 8 + 2], af[e8 * 8 + 3]), pack2(af[e8 * 8 + 4], af[e8 * 8 + 5]), pack2(af[e8 * 8 + 6], af[e8 * 8 + 7])};
            *(u32x4*)(ob + e8 * 8) = (u32x4){pack2(ab[e8 * 8], ab[e8 * 8 + 1]), pack2(ab[e8 * 8 + 2], ab[e8 * 8 + 3]), pack2(ab[e8 * 8 + 4], ab[e8 * 8 + 5]), pack2(ab[e8 * 8 + 6], ab[e8 * 8 + 7])}; }
    }
}
__device__ void phase_scan(const Args& a, int l, int bid, int nb) {
    bf16_t* st = (bf16_t*)(a.ws + WS_ST);
    for (int idx = bid * NT + otid(); idx < NB * 4 * 2 * 16384; idx += nb * NT) {
        const int chain = idx >> 14, el = idx & 16383, dir = chain & 1, h = (chain >> 1) & 3;
        const float dec = expf(-128.0f * expf(a.ret_decay[l * 8 + dir * 4 + h]));
        bf16_t* p = st + (size_t)chain * NCH * 16384 + el;
        float S = 0.f;
        for (int i = 0; i < NCH; ++i) {
            const int c = dir == 0 ? i : (i < 2 ? 1 - i : NCH + 1 - i);
            const float ls = bf2f(p[(size_t)c * 16384]);
            p[(size_t)c * 16384] = f2bf(S);
            S = S * dec + ls;
        }
    }
}
__device__ void phase_ret_b(const Args& a, int l, MLAS unsigned char* lds, int bid, int nb) {
    const int tid = otid();
    const bf16_t* proj = (const bf16_t*)(a.ws + WS_PROJ); const bf16_t* st = (const bf16_t*)(a.ws + WS_ST); bf16_t* mix = (bf16_t*)(a.ws + WS_H);
    MLAS bf16_t* Qs = (MLAS bf16_t*)lds; MLAS bf16_t* Ks = Qs + 128 * RP; MLAS bf16_t* Vs = Ks + 128 * RP; MLAS bf16_t* Ss = Vs + 128 * RP;
    MLAS float* pw = (MLAS float*)(Ss + 128 * RP);
    const int c_lo = l == 0 ? 0 : 2, ncu = NCH - c_lo;
    for (int u = bid; u < NB * ncu * 4; u += nb) {
        const int b = u / (ncu * 4), c = c_lo + (u >> 2) % ncu, h = u & 3, row0 = chunk_row0(b, c);
        const float lgf = -expf(a.ret_decay[l * 8 + h]), lgb = -expf(a.ret_decay[l * 8 + 4 + h]);
        __syncthreads();
        stage_tile(proj, row0, C_QB + h * 128, Qs, tid); stage_tile(proj, row0, C_KB + h * 128, Ks, tid); stage_tile(proj, row0, C_VB + h * 128, Vs, tid);
        if (tid < 129) pw[tid] = expf((float)tid * lgf); else if (tid < 258) pw[tid] = expf((float)(tid - 129) * lgb);
        __syncthreads();
        const int i = tid >> 2, q4 = tid & 3;
        {
            float s[32];
#pragma unroll
            for (int j = 0; j < 32; ++j) s[j] = 0.f;
            for (int d8 = 0; d8 < 16; ++d8) {
                const u32x4 qw = *(const MLAS u32x4*)(Qs + i * RP + d8 * 8);
                float qf[8];
#pragma unroll
                for (int t = 0; t < 4; ++t) { qf[2 * t] = lo16(qw[t]); qf[2 * t + 1] = hi16(qw[t]); }
#pragma unroll
                for (int j = 0; j < 32; ++j) { const u32x4 kw = *(const MLAS u32x4*)(Ks + (q4 * 32 + j) * RP + d8 * 8);
#pragma unroll
                    for (int t = 0; t < 4; ++t) s[j] += qf[2 * t] * lo16(kw[t]) + qf[2 * t + 1] * hi16(kw[t]); }
            }
#pragma unroll
            for (int j = 0; j < 32; j += 2) *(MLAS unsigned*)(Ss + i * RP + q4 * 32 + j) = pack2(s[j], s[j + 1]);
        }
        __syncthreads();
        const int eb = q4 * 32;
        float af[32], ab[32];
#pragma unroll
        for (int e = 0; e < 32; ++e) { af[e] = 0.f; ab[e] = 0.f; }
        for (int j = 0; j < 128; ++j) {
            const float s = bf2f(Ss[i * RP + j]);
            const float wf = j <= i ? s * pw[i - j] : 0.f, wb = j >= i ? s * pw[129 + j - i] : 0.f;
#pragma unroll
            for (int e8 = 0; e8 < 4; ++e8) { const u32x4 w = *(const MLAS u32x4*)(Vs + j * RP + eb + e8 * 8);
#pragma unroll
                for (int q = 0; q < 4; ++q) { const float v0 = lo16(w[q]), v1 = hi16(w[q]);
                    af[e8 * 8 + 2 * q] += wf * v0; af[e8 * 8 + 2 * q + 1] += wf * v1; ab[e8 * 8 + 2 * q] += wb * v0; ab[e8 * 8 + 2 * q + 1] += wb * v1; } }
        }
        {
            const bf16_t* Sf = st + st_index(b, h, 0, c) + eb; const bf16_t* Sb = st + st_index(b, h, 1, c) + eb;
            const float qdf = pw[i + 1], qdb = pw[129 + 128 - i];
            for (int d = 0; d < 128; ++d) {
                const float qv = bf2f(Qs[i * RP + d]), qf = qv * qdf, qb = qv * qdb;
#pragma unroll
                for (int e8 = 0; e8 < 4; ++e8) { const u32x4 wf = *(const u32x4*)(Sf + d * 128 + e8 * 8), wb = *(const u32x4*)(Sb + d * 128 + e8 * 8);
#pragma unroll
                    for (int q = 0; q < 4; ++q) { af[e8 * 8 + 2 * q] += qf * lo16(wf[q]); af[e8 * 8 + 2 * q + 1] += qf * hi16(wf[q]); ab[e8 * 8 + 2 * q] += qb * lo16(wb[q]); ab[e8 * 8 + 2 * q + 1] += qb * hi16(wb[q]); } }
            }
        }
        float sf = 0.f, sb = 0.f;
#pragma unroll
        for (int e = 0; e < 32; ++e) { sf += af[e]; sb += ab[e]; }
        sf += __shfl_xor(sf, 1); sf += __shfl_xor(sf, 2); sb += __shfl_xor(sb, 1); sb += __shfl_xor(sb, 2);
        const float mf = sf * (1.0f / 128.0f), mb = sb * (1.0f / 128.0f);
        float vf = 0.f, vb = 0.f;
#pragma unroll
        for (int e = 0; e < 32; ++e) { const float df = af[e] - mf, db = ab[e] - mb; vf += df * df; vb += db * db; }
        vf += __shfl_xor(vf, 1); vf += __shfl_xor(vf, 2); vb += __shfl_xor(vb, 1); vb += __shfl_xor(vb, 2);
        const float rf = rsqrtf(vf * (1.0f / 128.0f) + 1e-5f), rb = rsqrtf(vb * (1.0f / 128.0f) + 1e-5f);
        const bf16_t* gf = proj + (size_t)(row0 + i) * INC + C_GF + h * 128 + eb; const bf16_t* gb = proj + (size_t)(row0 + i) * INC + C_GB + h * 128 + eb;
        bf16_t* o = mix + (size_t)(row0 + i) * D + 512 + h * 128 + eb;
#pragma unroll
        for (int e8 = 0; e8 < 4; ++e8) { const u32x4 wf = *(const u32x4*)(gf + e8 * 8), wb = *(const u32x4*)(gb + e8 * 8); float r[8];
#pragma unroll
            for (int q = 0; q < 4; ++q) {
                r[2 * q] = (af[e8 * 8 + 2 * q] - mf) * rf * siluf(lo16(wf[q])) + (ab[e8 * 8 + 2 * q] - mb) * rb * siluf(lo16(wb[q]));
                r[2 * q + 1] = (af[e8 * 8 + 2 * q + 1] - mf) * rf * siluf(hi16(wf[q])) + (ab[e8 * 8 + 2 * q + 1] - mb) * rb * siluf(hi16(wb[q])); }
            *(u32x4*)(o + e8 * 8) = (u32x4){pack2(r[0], r[1]), pack2(r[2], r[3]), pack2(r[4], r[5]), pack2(r[6], r[7])}; }
    }
}

__device__ void phase_na(const Args& a, int l, MLAS unsigned char* lds, int bid, int nb) {
    const int tid = otid();
    const bf16_t* proj = (const bf16_t*)(a.ws + WS_PROJ); bf16_t* mix = (bf16_t*)(a.ws + WS_H);
    MLAS bf16_t* Kw = (MLAS bf16_t*)lds; MLAS bf16_t* Vw = Kw + 8 * 64 * 64;
    const int n_lat = NB * 64 * 8, n_ctx = l == 0 ? NB * 4 * 8 : 0;
    const int q = tid >> 3, k8 = tid & 7;
    for (int u = bid; u < n_lat + n_ctx; u += nb) {
        const bool is_ctx = u >= n_lat;
        int b, r, h, qrow, r0 = 0;
        if (!is_ctx) { b = u >> 9; r = (u >> 3) & 63; h = u & 7; qrow = b * SEQ + r * 64 + q; r0 = min(max(r - 4, 0), 56); }
        else { const int v = u - n_lat; b = v >> 5; r = (v >> 3) & 3; h = v & 7; qrow = TL + b * LC + r * 64 + q; }
        __syncthreads();
        if (!is_ctx) {
#pragma unroll
            for (int i = 0; i < 8; ++i) { const int ch = tid + i * NT, tok = ch >> 3, cc = (ch & 7) * 8;
                const bf16_t* src = proj + (size_t)(b * SEQ + r0 * 64 + tok) * INC + h * 64 + cc;
                *(MLAS u32x4*)(Kw + tok * 64 + cc) = *(const u32x4*)(src + C_KA); *(MLAS u32x4*)(Vw + tok * 64 + cc) = *(const u32x4*)(src + C_VA); }
        }
        __syncthreads();
        unsigned qp[32];
        { const bf16_t* qs = proj + (size_t)qrow * INC + C_QA + h * 64;
#pragma unroll
          for (int i = 0; i < 8; ++i) { const u32x4 w = *(const u32x4*)(qs + i * 8); qp[4 * i] = w.x; qp[4 * i + 1] = w.y; qp[4 * i + 2] = w.z; qp[4 * i + 3] = w.w; } }
        float mx = -1e30f;
        const int c0 = min(max(q - 8, 0), 48);
        const float* rp = a.na_rpb + (((size_t)l * 8 + h) * 15 + (is_ctx ? 0 : (r0 + k8 - r + 7))) * 31 + (c0 - q + 15);
        const bf16_t* kc = proj + (size_t)(TL + b * LC + k8 * 32) * INC + C_KA + h * 64;
        const bf16_t* vc = proj + (size_t)(TL + b * LC + k8 * 32) * INC + C_VA + h * 64;
        if (!is_ctx) {
#pragma unroll 1
            for (int n = 0; n < 16; ++n) {
                const MLAS bf16_t* kp = Kw + (k8 * 64 + c0 + n) * 64; float s = 0.f;
#pragma unroll
                for (int i = 0; i < 8; ++i) { const u32x4 w = *(const MLAS u32x4*)(kp + i * 8);
#pragma unroll
                    for (int t = 0; t < 4; ++t) s += lo16(qp[4 * i + t]) * lo16(w[t]) + hi16(qp[4 * i + t]) * hi16(w[t]); }
                mx = fmaxf(mx, s + rp[n]);
            }
        }
#pragma unroll 1
        for (int n = 0; n < 32; ++n) { float s = 0.f;
#pragma unroll
            for (int i = 0; i < 8; ++i) { const u32x4 w = *(const u32x4*)(kc + (size_t)n * INC + i * 8);
#pragma unroll
                for (int t = 0; t < 4; ++t) s += lo16(qp[4 * i + t]) * lo16(w[t]) + hi16(qp[4 * i + t]) * hi16(w[t]); }
            mx = fmaxf(mx, s); }
        mx = fmaxf(mx, __shfl_xor(mx, 1)); mx = fmaxf(mx, __shfl_xor(mx, 2)); mx = fmaxf(mx, __shfl_xor(mx, 4));
        float o[64], sum = 0.f;
#pragma unroll
        for (int i = 0; i < 64; ++i) o[i] = 0.f;
        if (!is_ctx) {
#pragma unroll 1
            for (int n = 0; n < 16; ++n) {
                const MLAS bf16_t* kp = Kw + (k8 * 64 + c0 + n) * 64; float s = 0.f;
#pragma unroll
                for (int i = 0; i < 8; ++i) { const u32x4 w = *(const MLAS u32x4*)(kp + i * 8);
#pragma unroll
                    for (int t = 0; t < 4; ++t) s += lo16(qp[4 * i + t]) * lo16(w[t]) + hi16(qp[4 * i + t]) * hi16(w[t]); }
                const float p = __expf(s + rp[n] - mx); sum += p; const MLAS bf16_t* vp = Vw + (k8 * 64 + c0 + n) * 64;
#pragma unroll
                for (int i = 0; i < 8; ++i) { const u32x4 w = *(const MLAS u32x4*)(vp + i * 8);
#pragma unroll
                    for (int t = 0; t < 4; ++t) { o[8 * i + 2 * t] += p * lo16(w[t]); o[8 * i + 2 * t + 1] += p * hi16(w[t]); } }
            }
        }
#pragma unroll 1
        for (int n = 0; n < 32; ++n) { float s = 0.f;
#pragma unroll
            for (int i = 0; i < 8; ++i) { const u32x4 w = *(const u32x4*)(kc + (size_t)n * INC + i * 8);
#pragma unroll
                for (int t = 0; t < 4; ++t) s += lo16(qp[4 * i + t]) * lo16(w[t]) + hi16(qp[4 * i + t]) * hi16(w[t]); }
            const float p = __expf(s - mx); sum += p;
#pragma unroll
            for (int i = 0; i < 8; ++i) { const u32x4 w = *(const u32x4*)(vc + (size_t)n * INC + i * 8);
#pragma unroll
                for (int t = 0; t < 4; ++t) { o[8 * i + 2 * t] += p * lo16(w[t]); o[8 * i + 2 * t + 1] += p * hi16(w[t]); } } }
        sum += __shfl_xor(sum, 1); sum += __shfl_xor(sum, 2); sum += __shfl_xor(sum, 4);
#pragma unroll
        for (int i = 0; i < 64; ++i) { o[i] += __shfl_xor(o[i], 1); o[i] += __shfl_xor(o[i], 2); o[i] += __shfl_xor(o[i], 4); }
        const float inv = 1.0f / sum;
        bf16_t* op = mix + (size_t)qrow * D + h * 64;
#pragma unroll
        for (int kk = 0; kk < 8; ++kk) if (k8 == kk)
            *(u32x4*)(op + kk * 8) = (u32x4){pack2(o[kk * 8] * inv, o[kk * 8 + 1] * inv), pack2(o[kk * 8 + 2] * inv, o[kk * 8 + 3] * inv), pack2(o[kk * 8 + 4] * inv, o[kk * 8 + 5] * inv), pack2(o[kk * 8 + 6] * inv, o[kk * 8 + 7] * inv)};
    }
}

__device__ void phase_norm2(const Args& a, int l, MLAS unsigned char* lds, int bid, int nb) {
    const int tid = otid(), lane = tid & 63, wave = tid >> 6;
    const int e0 = lane * 8, e1 = 512 + lane * 8;
    MLAS float* hv = (MLAS float*)lds + wave * 1024;
    float wn[16];
    { const float* w = a.norm_ffn_w + l * D;
#pragma unroll
      for (int j = 0; j < 8; ++j) { wn[j] = w[e0 + j]; wn[8 + j] = w[e1 + j]; } }
    float msc[16], msh[16]; int cur_r = -1;
    bf16_t* hb = (bf16_t*)(a.ws + WS_H);
    int* tok_e = (int*)(a.ws + WS_TOKE); int* tok_r = (int*)(a.ws + WS_TOKR); float* tok_w = (float*)(a.ws + WS_TOKW);
    unsigned* cnt = (unsigned*)(a.ws + WS_CNT) + l * 64;
    const int nrows = l == 0 ? TT : TL;
    const int ex = lane & 31, kh = lane >> 5;
    const float rbias = a.router_bias[ex];
    for (int row = bid * 8 + wave; row < nrows; row += nb * 8) {
        const int r = row < TL ? row / SEQ : 16;
        if (r != cur_r) { cur_r = r; const float* sh = modp(a, l, r, 3); const float* sc = modp(a, l, r, 4);
#pragma unroll
            for (int j = 0; j < 8; ++j) { msh[j] = sh[e0 + j]; msh[8 + j] = sh[e1 + j]; msc[j] = 1.0f + sc[e0 + j]; msc[8 + j] = 1.0f + sc[e1 + j]; } }
        const float* src = row < TL ? a.out + (size_t)row * D : (const float*)(a.ws + WS_CTX) + (size_t)(row - TL) * D;
        float v[16];
        { const f32x4 x0 = *(const f32x4*)(src + e0), x1 = *(const f32x4*)(src + e0 + 4), x2 = *(const f32x4*)(src + e1), x3 = *(const f32x4*)(src + e1 + 4);
#pragma unroll
          for (int j = 0; j < 4; ++j) { v[j] = x0[j]; v[4 + j] = x1[j]; v[8 + j] = x2[j]; v[12 + j] = x3[j]; } }
        float ss = 0.f;
#pragma unroll
        for (int j = 0; j < 16; ++j) ss += v[j] * v[j];
        ss = wave_sum(ss);
        const float rs = rsqrtf(ss * (1.0f / D) + 1e-6f);
        float y[16];
#pragma unroll
        for (int j = 0; j < 16; ++j) y[j] = v[j] * rs * wn[j] * msc[j] + msh[j];
        bf16_t* hp = hb + (size_t)row * D;
        *(u32x4*)(hp + e0) = (u32x4){pack2(y[0], y[1]), pack2(y[2], y[3]), pack2(y[4], y[5]), pack2(y[6], y[7])};
        *(u32x4*)(hp + e1) = (u32x4){pack2(y[8], y[9]), pack2(y[10], y[11]), pack2(y[12], y[13]), pack2(y[14], y[15])};
#pragma unroll
        for (int j = 0; j < 8; ++j) { hv[e0 + j] = y[j]; hv[e1 + j] = y[8 + j]; }
        float acc = 0.f;
        { const float* rw = a.router_w + (size_t)(kh * 512) * NE + ex; const MLAS float* hq = hv + kh * 512;
#pragma unroll 8
          for (int k = 0; k < 512; ++k) acc += hq[k] * rw[(size_t)k * NE]; }
        acc += __shfl_xor(acc, 32);
        const float sg = 1.0f / (1.0f + expf(-acc)), ssel = sg + rbias;
        float best = -1e30f; int grp = 0;
#pragma unroll
        for (int g = 0; g < 8; ++g) {
            const float v0 = __shfl(ssel, g * 4), v1 = __shfl(ssel, g * 4 + 1), v2 = __shfl(ssel, g * 4 + 2), v3 = __shfl(ssel, g * 4 + 3);
            const float hi01 = fmaxf(v0, v1), lo01 = fminf(v0, v1), hi23 = fmaxf(v2, v3), lo23 = fminf(v2, v3);
            const float top = fmaxf(hi01, hi23), second = fmaxf(fminf(hi01, hi23), hi01 >= hi23 ? lo01 : lo23);
            const float gs = top + second;
            if (gs > best) { best = gs; grp = g; }
        }
        float w4[4], s4[4];
#pragma unroll
        for (int j = 0; j < 4; ++j) { w4[j] = __shfl(ssel, grp * 4 + j); s4[j] = __shfl(sg, grp * 4 + j); }
        int i0 = 0;
#pragma unroll
        for (int j = 1; j < 4; ++j) if (w4[j] > w4[i0]) i0 = j;
        int i1 = i0 == 0 ? 1 : 0;
#pragma unroll
        for (int j = 0; j < 4; ++j) if (j != i0 && j != i1 && w4[j] > w4[i1]) i1 = j;
        float g0 = 0.f, g1 = 0.f;
#pragma unroll
        for (int j = 0; j < 4; ++j) { g0 = (j == i0) ? s4[j] : g0; g1 = (j == i1) ? s4[j] : g1; }
        const float inv = 1.0f / (g0 + g1);
        if (lane < 2) {
            const int e = grp * 4 + (lane == 0 ? i0 : i1);
            const unsigned rank = atomicAdd(cnt + e, 1u);
            tok_e[row * 2 + lane] = e; tok_r[row * 2 + lane] = (int)rank; tok_w[row * 2 + lane] = (lane == 0 ? g0 : g1) * inv;
        }
    }
}
__device__ void phase_gather(const Args& a, int l, MLAS unsigned char* lds, int bid, int nb) {
    const int tid = otid(), lane = tid & 63, wave = tid >> 6;
    MLAS int* pbase = (MLAS int*)lds;
    MLAS int* cn = pbase + 64;
    const unsigned* cnt = (const unsigned*)(a.ws + WS_CNT) + l * 64;
    if (tid == 0) { int acc = 0; for (int e = 0; e < NE; ++e) { const int c = (int)__hip_atomic_load(cnt + e, __ATOMIC_RELAXED, __HIP_MEMORY_SCOPE_AGENT); cn[e] = c; pbase[e] = acc; acc += (c + 255) & ~255; } pbase[NE] = acc; }
    __syncthreads();
    int* rinfo = (int*)(a.ws + WS_RINFO); float* rw = (float*)(a.ws + WS_RW); int* blke = (int*)(a.ws + WS_BLKE);
    if (bid == 0) {
        for (int e = 0; e < NE; ++e) {
            for (int p = pbase[e] + cn[e] + tid; p < pbase[e + 1]; p += NT) { rinfo[p] = -1; rw[p] = 0.f; }
            for (int blk = (pbase[e] >> 8) + tid; blk < (pbase[e + 1] >> 8); blk += NT) blke[blk] = e;
        }
        if (tid == 0) blke[1023] = (pbase[NE] >> 8) * 4;
    }
    const int* tok_e = (const int*)(a.ws + WS_TOKE); const int* tok_r = (const int*)(a.ws + WS_TOKR); const float* tok_w = (const float*)(a.ws + WS_TOKW);
    const bf16_t* hb = (const bf16_t*)(a.ws + WS_H); bf16_t* xs = (bf16_t*)(a.ws + WS_XS);
    const int nas = (l == 0 ? TT : TL) * 2;
    for (int as = bid * 8 + wave; as < nas; as += nb * 8) {
        const int e = tok_e[as], pos = pbase[e] + tok_r[as], t = as >> 1;
        const u32x4 w0 = *(const u32x4*)(hb + (size_t)t * D + lane * 16), w1 = *(const u32x4*)(hb + (size_t)t * D + lane * 16 + 8);
        *(u32x4*)(xs + (size_t)pos * D + lane * 16) = w0; *(u32x4*)(xs + (size_t)pos * D + lane * 16 + 8) = w1;
        if (lane == 0) { rinfo[pos] = as; rw[pos] = tok_w[as]; }
    }
}

using pg8::Unit;
struct EpiStoreBf16 {
    static constexpr bool PERM = true, AFTER_DRAIN = false;
    bf16_t* O; int ldc;
    __device__ __forceinline__ void operator()(const f32x4 (&acc)[2][2][4][2], const Unit& u, int wr, int wc, int fr, int fq) const {
        const int row0 = u.pm * 256 + wr * 64 + fr, col0 = u.pn * 256 + wc * 32 + 8 * fq;
#pragma unroll
        for (int ai = 0; ai < 2; ++ai)
#pragma unroll
            for (int m = 0; m < 4; ++m) { bf16_t* rowp = O + (size_t)(row0 + ai * 128 + m * 16) * ldc + col0;
#pragma unroll
                for (int bj = 0; bj < 2; ++bj) { const f32x4 v0 = acc[ai][bj][m][0], v1 = acc[ai][bj][m][1];
                    *(u32x4*)(rowp + bj * 128) = (u32x4){pg8::cvt_pk_bf16(v0[0], v0[1]), pg8::cvt_pk_bf16(v0[2], v0[3]), pg8::cvt_pk_bf16(v1[0], v1[1]), pg8::cvt_pk_bf16(v1[2], v1[3])}; } }
    }
};
struct EpiResGate {
    static constexpr bool PERM = false, AFTER_DRAIN = false;
    const float* xin_lat; const float* xin_ctx; float* out_lat; float* out_ctx; const float* modl;
    __device__ __forceinline__ void operator()(const f32x4 (&acc)[2][2][4][2], const Unit& u, int wr, int wc, int fr, int fq) const {
        const bool lat = u.pm < 256; const int r = lat ? (u.pm >> 4) : 16;
        const int rowt = (lat ? u.pm : u.pm - 256) * 256 + wr * 64 + fr, col0 = u.pn * 256 + wc * 32 + 4 * fq;
        const float* xin = lat ? xin_lat : xin_ctx; float* out = lat ? out_lat : out_ctx;
        const float* g = modl + (size_t)r * 6144 + 2 * 1024 + col0;
        f32x4 gv[2][2];
#pragma unroll
        for (int bj = 0; bj < 2; ++bj)
#pragma unroll
            for (int n = 0; n < 2; ++n) gv[bj][n] = *(const f32x4*)(g + bj * 128 + n * 16);
#pragma unroll
        for (int ai = 0; ai < 2; ++ai)
#pragma unroll
            for (int m = 0; m < 4; ++m) { const size_t off = (size_t)(rowt + ai * 128 + m * 16) * D + col0;
#pragma unroll
                for (int bj = 0; bj < 2; ++bj)
#pragma unroll
                    for (int n = 0; n < 2; ++n) { const f32x4 xv = *(const f32x4*)(xin + off + bj * 128 + n * 16); *(f32x4*)(out + off + bj * 128 + n * 16) = xv + gv[bj][n] * acc[ai][bj][m][n]; } }
    }
};
struct EpiSwiglu {
    static constexpr bool PERM = true, AFTER_DRAIN = false;
    bf16_t* act;
    __device__ __forceinline__ void operator()(const f32x4 (&acc)[2][2][4][2], const Unit& u, int wr, int wc, int fr, int fq) const {
        const int row0 = u.pm * 256 + wr * 64 + fr, col0 = (u.pn & 3) * 128 + wc * 32 + 8 * fq;
#pragma unroll
        for (int ai = 0; ai < 2; ++ai)
#pragma unroll
            for (int m = 0; m < 4; ++m) { float r[8];
#pragma unroll
                for (int n = 0; n < 2; ++n)
#pragma unroll
                    for (int j = 0; j < 4; ++j) { const float gt = acc[ai][0][m][n][j]; r[n * 4 + j] = gt / (1.0f + __expf(-gt)) * acc[ai][1][m][n][j]; }
                *(u32x4*)(act + (size_t)(row0 + ai * 128 + m * 16) * DFF + col0) = (u32x4){pg8::cvt_pk_bf16(r[0], r[1]), pg8::cvt_pk_bf16(r[2], r[3]), pg8::cvt_pk_bf16(r[4], r[5]), pg8::cvt_pk_bf16(r[6], r[7])}; }
    }
};
struct EpiDown {
    static constexpr bool PERM = true, AFTER_DRAIN = false;
    bf16_t* y2; const int* rinfo; const float* rw;
    __device__ __forceinline__ void operator()(const f32x4 (&acc)[2][2][4][2], const Unit& u, int wr, int wc, int fr, int fq) const {
        const int row0 = u.pm * 256 + wr * 64 + fr, col0 = (u.pn & 3) * 256 + wc * 32 + 8 * fq;
#pragma unroll
        for (int ai = 0; ai < 2; ++ai)
#pragma unroll
            for (int m = 0; m < 4; ++m) { const int prow = row0 + ai * 128 + m * 16; const int info = rinfo[prow]; const float w = rw[prow];
                if (info >= 0) { bf16_t* rowp = y2 + (size_t)info * D + col0;
#pragma unroll
                    for (int bj = 0; bj < 2; ++bj) { const f32x4 v0 = acc[ai][bj][m][0] * w, v1 = acc[ai][bj][m][1] * w;
                        *(u32x4*)(rowp + bj * 128) = (u32x4){pg8::cvt_pk_bf16(v0[0], v0[1]), pg8::cvt_pk_bf16(v0[2], v0[3]), pg8::cvt_pk_bf16(v1[0], v1[1]), pg8::cvt_pk_bf16(v1[2], v1[3])}; } } }
    }
};
struct MoeOrder {
    const int* blke; int nunits, G, c;
    __device__ __forceinline__ bool next(int i, Unit& u) const { const int L = i * G + c; if (L >= nunits) return false; u.pm = L >> 2; u.pn = blke[L >> 2] * 4 + (L & 3); return true; }
    __device__ __forceinline__ void a_ready(const Unit&) const {}
    __device__ __forceinline__ void done(const Unit&) const {}
};

constexpr int NPHASES = 24;
__global__ void __launch_bounds__(NT, 2) fwd(Args ka) {
    extern __shared__ __attribute__((aligned(16))) unsigned char lds_raw[];
    MLAS unsigned char* lds = (MLAS unsigned char*)lds_raw;
    const int tid = threadIdx.x, nb = gridDim.x;
    volatile MLAS unsigned* ctl = (volatile MLAS unsigned*)(lds + LDS_CTL);
    if (tid < 4) ctl[tid] = 0u;
    __syncthreads();
    const bool multi = (ka.ph_hi - ka.ph_lo) > 1;
    XcdBarrier bar; bar.bar = (unsigned*)(ka.ws + WS_BAR); bar.x = 0; bar.st = ctl;
    if (multi) bar = xcd_barrier_post((unsigned*)(ka.ws + WS_BAR), ctl);
    int ph = 0;
#define PHASE(...) do { if (ph >= ka.ph_lo && ph < ka.ph_hi) { Args a = ka; { unsigned char* w_ = a.ws; asm volatile("" : "+s"(w_)); a.ws = w_; } int bid = blockIdx.x; asm volatile("" : "+s"(bid)); { __VA_ARGS__; } if (ph + 1 < ka.ph_hi) xcd_barrier(bar); } ++ph; } while (0)
    PHASE({ convert_dense(a, lds, bid, nb); convert_experts(a, 0, lds, bid, nb); compute_mod(a, lds, bid, nb); });
    for (int l = 0; l < 2; ++l) {
        PHASE({ phase_norm1(a, l, bid, nb); if (l == 1) convert_experts(a, 1, lds, bid, nb); });
        PHASE({ pg8::Gemm g{(const bf16_t*)(a.ws + WS_H), (const bf16_t*)(a.ws + WS_WIN) + (size_t)l * INC * D, TT, INC, D};
                pg8::StaticOrder S; S.init(TT, INC, nb, bid);
                EpiStoreBf16 E{(bf16_t*)(a.ws + WS_PROJ), INC};
                pg8::gemm_phase<EpiStoreBf16, pg8::StaticOrder>(lds, g, S, E, nullptr); });
        PHASE(phase_prep(a, l, bid, nb));
        PHASE(phase_ret_a(a, l, lds, bid, nb));
        PHASE({ phase_scan(a, l, bid, nb); phase_na(a, l, lds, bid, nb); });
        PHASE(phase_ret_b(a, l, lds, bid, nb));
        PHASE({ const int M = l == 0 ? TT : TL;
                pg8::Gemm g{(const bf16_t*)(a.ws + WS_H), (const bf16_t*)(a.ws + WS_WOUT) + (size_t)l * D * D, M, D, D};
                pg8::StaticOrder S; S.init(M, D, nb, bid);
                EpiResGate E{l == 0 ? a.x : a.out, l == 0 ? a.ctx : (const float*)(a.ws + WS_CTX), a.out, (float*)(a.ws + WS_CTX), (const float*)(a.ws + WS_MOD) + (size_t)l * 17 * 6144};
                pg8::gemm_phase<EpiResGate, pg8::StaticOrder>(lds, g, S, E, nullptr); });
        PHASE(phase_norm2(a, l, lds, bid, nb));
        PHASE(phase_gather(a, l, lds, bid, nb));
        PHASE({ const int* blke = (const int*)(a.ws + WS_BLKE);
                pg8::Gemm g{(const bf16_t*)(a.ws + WS_XS), (const bf16_t*)(a.ws + WS_WGU), PMAX, NE * 1024, D};
                MoeOrder S{blke, blke[1023], nb, bid};
                EpiSwiglu E{(bf16_t*)(a.ws + WS_ACT)};
                pg8::gemm_phase<EpiSwiglu, MoeOrder>(lds, g, S, E, nullptr); });
        PHASE({ const int* blke = (const int*)(a.ws + WS_BLKE);
                pg8::Gemm g{(const bf16_t*)(a.ws + WS_ACT), (const bf16_t*)(a.ws + WS_WDN), PMAX, NE * 1024, DFF};
                MoeOrder S{blke, blke[1023], nb, bid};
                EpiDown E{(bf16_t*)(a.ws + WS_XS), (const int*)(a.ws + WS_RINFO), (const float*)(a.ws + WS_RW)};
                pg8::gemm_phase<EpiDown, MoeOrder>(lds, g, S, E, nullptr); });
    }
    PHASE(phase_final(a, bid, nb));
#undef PHASE
}
}

#ifndef MK_SINGLE
#define MK_SINGLE 0
#endif
extern "C" void kernel_launch(void* const* d_in, const int* in_sizes, int n_in, void* d_out, int out_size, void* d_ws, size_t ws_size, hipStream_t stream) {
    using namespace mk;
    static int grid = 0;
    if (grid == 0) {
        if (n_in != 19 || in_sizes[0] != TL * D || out_size != TL * D || ws_size < WS_END) {
            fprintf(stderr, "kernel_launch: unexpected shapes / workspace (n_in %d, in0 %d, out %d, ws %zu, need %zu); nothing launched\n", n_in, n_in > 0 ? in_sizes[0] : -1, out_size, ws_size, (size_t)WS_END);
            grid = -1; return; }
        int dev = 0, cus = 0, per_cu = 0;
        if (hipGetDevice(&dev) != hipSuccess || hipDeviceGetAttribute(&cus, hipDeviceAttributeMultiprocessorCount, dev) != hipSuccess) { grid = -1; return; }
        if (hipFuncSetAttribute((const void*)fwd, hipFuncAttributeMaxDynamicSharedMemorySize, LDS_BYTES) != hipSuccess) { fprintf(stderr, "kernel_launch: hipFuncSetAttribute failed\n"); grid = -1; return; }
        if (hipOccupancyMaxActiveBlocksPerMultiprocessor(&per_cu, (const void*)fwd, NT, LDS_BYTES) != hipSuccess || per_cu < 1) { fprintf(stderr, "kernel_launch: occupancy query says %d\n", per_cu); (void)hipGetLastError(); grid = -1; return; }
        grid = cus;
    }
    if (grid < 0) return;
    (void)hipMemsetAsync((char*)d_ws + WS_BAR, 0, WS_ZERO_BYTES, stream);
    Args a{};
    a.x = (const float*)d_in[0]; a.c = (const float*)d_in[1]; a.ctx = (const float*)d_in[2]; a.c_ctx = (const float*)d_in[3]; a.ada_w = (const float*)d_in[4]; a.ada_b = (const float*)d_in[5];
    a.norm_mix_w = (const float*)d_in[6]; a.norm_ffn_w = (const float*)d_in[7]; a.w_in = (const float*)d_in[8]; a.na_q_norm = (const float*)d_in[9]; a.na_k_norm = (const float*)d_in[10];
    a.na_rpb = (const float*)d_in[11]; a.ret_decay = (const float*)d_in[12]; a.w_out = (const float*)d_in[13]; a.router_w = (const float*)d_in[14]; a.router_bias = (const float*)d_in[15];
    a.w_gate = (const float*)d_in[16]; a.w_up = (const float*)d_in[17]; a.w_down = (const float*)d_in[18];
    a.out = (float*)d_out; a.ws = (unsigned char*)d_ws;
#if MK_SINGLE
    a.ph_lo = 0; a.ph_hi = NPHASES;
    hipLaunchKernelGGL(fwd, dim3(grid), dim3(NT), LDS_BYTES, stream, a);
#else
    for (int ph = 0; ph < NPHASES; ++ph) { a.ph_lo = ph; a.ph_hi = ph + 1; hipLaunchKernelGGL(fwd, dim3(grid), dim3(NT), LDS_BYTES, stream, a); }
#endif
}
```

```cpp
#include <hip/hip_runtime.h>
#include <cstdio>
#include <cstdint>

#define XB_TMO      128
#define XB_XCNT(j)  (256  + 64 * (j))
#define XB_XSUB(j)  (1280 + 64 * (j))
#define XB_XGEN(j)  (2304 + 64 * (j))
#define XB_TOP      3328
#define XB_TOPGEN   3392
#define XCD_BAR_WORDS 3456
#define XB_SPIN_CAP (1u << 18)
#define LAS __attribute__((address_space(3)))

__device__ __forceinline__ unsigned xb_ld(unsigned* p)              { return __hip_atomic_load(p, __ATOMIC_RELAXED, __HIP_MEMORY_SCOPE_AGENT); }
__device__ __forceinline__ unsigned xb_add(unsigned* p, unsigned v) { return __hip_atomic_fetch_add(p, v, __ATOMIC_RELAXED, __HIP_MEMORY_SCOPE_AGENT); }
__device__ __forceinline__ unsigned xb_xcc_id() { return (unsigned)__builtin_amdgcn_s_getreg((3 << 11) | 20) & 0xFu; }
#define XB_SPIN(cond, bar) do { unsigned _sp = 0; while (cond) { __builtin_amdgcn_s_sleep(1); \
    if ((++_sp & 255u) == 0u) { if (xb_ld(&(bar)[XB_TMO])) break; if (_sp > XB_SPIN_CAP) { atomicAdd(&(bar)[XB_TMO], 1u); break; } } } } while (0)

struct XcdBarrier {
    unsigned* bar; unsigned x;
    volatile LAS unsigned* st;
};

__device__ __forceinline__ XcdBarrier xcd_barrier_post(unsigned* bar, volatile LAS unsigned* st) {
    XcdBarrier b; b.bar = bar; b.x = xb_xcc_id(); b.st = st;
    if (threadIdx.x == 0) (void)xb_add(&bar[XB_XCNT(b.x)], 1u);
    return b;
}
__device__ __forceinline__ void xcd_barrier_complete(unsigned* bar, unsigned x, unsigned& nloc, unsigned& nx) {
    const unsigned G = gridDim.x * gridDim.y * gridDim.z;
    unsigned sum, cnt, mine, sp = 0u;
    for (;;) {
        sum = 0u; cnt = 0u; mine = 0u;
#pragma unroll
        for (unsigned j = 0; j < 16; ++j) { const unsigned c = xb_ld(&bar[XB_XCNT(j)]); sum += c; cnt += (c > 0u) ? 1u : 0u; mine = (j == x) ? c : mine; }
        if (sum == G) break;
        __builtin_amdgcn_s_sleep(1);
        if ((++sp & 255u) == 0u) { if (xb_ld(&bar[XB_TMO])) break; if (sp > XB_SPIN_CAP) { atomicAdd(&bar[XB_TMO], 1u); break; } }
    }
    nloc = mine > 0u ? mine : 1u; nx = cnt > 0u ? cnt : 1u;
}

__device__ __forceinline__ void xcd_barrier(const XcdBarrier& b) {
    asm volatile("s_waitcnt vmcnt(0)" ::: "memory");
    __syncthreads();
    if (threadIdx.x == 0) {
        unsigned* bar = b.bar;
        __builtin_amdgcn_s_waitcnt(0);
        unsigned nloc = b.st[0], nx = b.st[1];
        if (nloc == 0u) { xcd_barrier_complete(bar, b.x, nloc, nx); b.st[0] = nloc; b.st[1] = nx; }
        const unsigned old = xb_add(&bar[XB_XSUB(b.x)], 1u);
        const unsigned gen = old / nloc;
        if (old + 1u == (gen + 1u) * nloc) {
            __builtin_amdgcn_fence(__ATOMIC_RELEASE, "agent");
            asm volatile("s_waitcnt vmcnt(0)" ::: "memory");
            const unsigned og = xb_add(&bar[XB_TOP], 1u);
            const unsigned tg = og / nx;
            if (og + 1u == (tg + 1u) * nx) xb_add(&bar[XB_TOPGEN], 1u);
            else XB_SPIN(xb_ld(&bar[XB_TOPGEN]) == tg, bar);
            __builtin_amdgcn_fence(__ATOMIC_ACQUIRE, "agent");
            xb_add(&bar[XB_XGEN(b.x)], 1u);
            asm volatile("s_waitcnt vmcnt(0)" ::: "memory");
        } else {
            XB_SPIN(xb_ld(&bar[XB_XGEN(b.x)]) == gen, bar);
            __builtin_amdgcn_fence(__ATOMIC_ACQUIRE, "agent");
            asm volatile("s_waitcnt vmcnt(0)" ::: "memory");
        }
    }
    __syncthreads();
}
namespace pg8 {
#define PG8_LAS __attribute__((address_space(3)))
typedef unsigned short bf16_t;
typedef short bf16x8 __attribute__((ext_vector_type(8)));
typedef float f32x4 __attribute__((ext_vector_type(4)));
typedef unsigned u32x4 __attribute__((ext_vector_type(4)));
constexpr int BM = 256, BK = 64, HALF = 128, HTB = HALF * BK * 2  , STAGE_BYTES = 8 * HTB, NXCD = 8, WGM = 8;

__host__ __device__ __forceinline__ int lds_byte(int r, int c) { const int st = (r >> 4) * 2 + (c >> 5), rr = r & 15, cc = c & 31, ob = rr * 64 + cc * 2; return st * 1024 + (ob ^ (((ob >> 9) & 1) << 5)); }
__host__ __device__ __forceinline__ void stage_rc(int b, int& R, int& C) { const int st = b / 1024, sb = b % 1024, swz = sb ^ (((sb >> 9) & 1) << 5); R = (st >> 1) * 16 + swz / 64; C = (st & 1) * 32 + (swz % 64) / 2; }
__host__ __device__ __forceinline__ int perm32(int rho) { const int n = rho >> 4, i = rho & 15; return 8 * (i >> 2) + 4 * n + (i & 3); }

struct Unit { int pm, pn; };
struct Gemm { const bf16_t* A; const bf16_t* Bt; int M, N, K; const int* rows = nullptr; };

struct StaticOrder {
    int nM, nN, nwg, G, c;
    __host__ __device__ void init(int M, int N, int G_, int c_) { nM = M / BM; nN = N / BM; nwg = nM * nN; G = G_; c = c_; }
    __host__ __device__ bool next(int i, Unit& u) const {
        const long L = (long)i * G + c; if (L >= nwg) return false;
        int wgid = (int)L; { const int q = nwg / NXCD, r = nwg % NXCD, xcd = wgid % NXCD, off = wgid / NXCD; wgid = (xcd < r ? xcd * (q + 1) : r * (q + 1) + (xcd - r) * q) + off; }
        const int nig = WGM * nN, gid = wgid / nig, fm = gid * WGM, gsz = (nM - fm) < WGM ? (nM - fm) : WGM;
        u.pm = fm + ((wgid % nig) % gsz); u.pn = (wgid % nig) / gsz; return true;
    }
    __device__ __forceinline__ void a_ready(const Unit&) const {}
    __device__ __forceinline__ void done(const Unit&) const {}
};
__device__ __forceinline__ unsigned cvt_pk_bf16(float lo, float hi) { unsigned r; asm volatile("v_cvt_pk_bf16_f32 %0, %1, %2" : "=v"(r) : "v"(lo), "v"(hi)); return r; }
typedef float f32x2 __attribute__((ext_vector_type(2)));
template <class Epi, class Sched, bool STAMP = false, bool GATHER = false>
__device__ __forceinline__ void gemm_phase(PG8_LAS unsigned char* lds, const Gemm g, const Sched& S, const Epi& E, unsigned long long* stamps) {
    int tid_o_ = threadIdx.x; asm volatile("" : "+v"(tid_o_)); const int tid = tid_o_, wid = __builtin_amdgcn_readfirstlane(tid >> 6), lane = tid & 63, wr = wid >> 2, wc = wid & 3, fr = lane & 15, fq = lane >> 4;
    const int K = g.K, nt = K / BK;
    int ts_lo = 0, ts_hi = 0, nts = 0; const unsigned long long rt_entry = STAMP ? (unsigned long long)wall_clock64() : 0ull;
#define PG8_STAMP() do { if (STAMP && wid == 0 && nts < 64) { const unsigned long long _c = (unsigned long long)clock64(); \
        ts_lo = (lane == nts) ? (int)(unsigned)_c : ts_lo; ts_hi = (lane == nts) ? (int)(unsigned)(_c >> 32) : ts_hi; ++nts; } } while (0)
    PG8_STAMP();
    unsigned voffA[2], voffB[2]; int rA_[2]; unsigned cA_[2];
#pragma unroll
    for (int i = 0; i < 2; ++i) { int R, C; stage_rc(tid * 16 + i * 8192, R, C); const int Rb = Epi::PERM ? ((R & ~31) + perm32(R & 31)) : R;
        voffA[i] = (unsigned)(R * K + C) * 2u; voffB[i] = (unsigned)(Rb * K + C) * 2u; rA_[i] = R; cA_[i] = (unsigned)C * 2u; }
    unsigned gA[2][2], gN[2][2];
#define PG8_ROWS(u, dst) do { _Pragma("unroll") for (int h_ = 0; h_ < 2; ++h_) _Pragma("unroll") for (int i_ = 0; i_ < 2; ++i_) { const int as_ = g.rows[(u).pm * BM + h_ * HALF + rA_[i_]]; \
        dst[h_][i_] = (unsigned)(as_ < 0 ? 0 : as_ >> 1) * (unsigned)(K * 2) + cA_[i_]; } } while (0)
    const size_t kstep = (size_t)(BK * 2);
    const size_t hstep = (size_t)HALF * K * 2;
    const size_t tstep = 2 * hstep;
    const unsigned ldsw = (unsigned)wid * 1024u;
    const int aoff = lds_byte(wr * 64 + fr, fq * 8), boff = lds_byte(wc * 32 + fr, fq * 8);
#define PG8_SA(b, h) (((b) * 2 + (h)) * HTB)
#define PG8_SB(b, h) ((4 + (b) * 2 + (h)) * HTB)
#define PG8_STAGE(bufoff, gbase, voff) do { _Pragma("unroll") for (int _i = 0; _i < 2; ++_i) \
        __builtin_amdgcn_global_load_lds((const unsigned*)((const char*)(gbase) + (voff)[_i]), (PG8_LAS unsigned*)(lds + (bufoff) + ldsw + _i * 8192), 16, 0, 0); } while (0)
#define PG8_LDA(dst, b, h) do { _Pragma("unroll") for (int m = 0; m < 4; ++m) _Pragma("unroll") for (int k = 0; k < 2; ++k) dst[m][k] = *(const PG8_LAS bf16x8*)(lds + PG8_SA(b, h) + aoff + m * 2048 + k * 1024); } while (0)
#define PG8_LDB(dst, b, h) do { _Pragma("unroll") for (int n = 0; n < 2; ++n) _Pragma("unroll") for (int k = 0; k < 2; ++k) dst[n][k] = *(const PG8_LAS bf16x8*)(lds + PG8_SB(b, h) + boff + n * 2048 + k * 1024); } while (0)
#define PG8_MMA(ai, bj, At, Bt) do { __builtin_amdgcn_s_setprio(1); _Pragma("unroll") for (int m = 0; m < 4; ++m) _Pragma("unroll") for (int n = 0; n < 2; ++n) _Pragma("unroll") for (int k = 0; k < 2; ++k) \
        acc[ai][bj][m][n] = __builtin_amdgcn_mfma_f32_16x16x32_bf16(Bt[n][k], At[m][k], acc[ai][bj][m][n], 0, 0, 0); __builtin_amdgcn_s_setprio(0); } while (0)
#define PG8_WAIT_V(n) asm volatile("s_waitcnt vmcnt(" #n ")" ::: "memory")
#define PG8_WAIT_L(n) asm volatile("s_waitcnt lgkmcnt(" #n ")" ::: "memory")
#define PG8_BAR __builtin_amdgcn_s_barrier()
#define PG8_SCHED __builtin_amdgcn_sched_barrier(0)
    Unit cur, nxt; int ui = 0;
    if (!S.next(0, cur)) return;
    f32x4 acc[2][2][4][2];
#pragma unroll
    for (int a = 0; a < 2; ++a)
#pragma unroll
        for (int b = 0; b < 2; ++b)
#pragma unroll
            for (int m = 0; m < 4; ++m)
#pragma unroll
                for (int n = 0; n < 2; ++n) acc[a][b][m][n] = (f32x4){0.f, 0.f, 0.f, 0.f};
    bf16x8 At[4][2], B0[2][2], B1[2][2];
    const char* cA = (const char*)g.A + (GATHER ? (size_t)0 : (size_t)cur.pm * tstep); const char* cB = (const char*)g.Bt + (size_t)cur.pn * tstep;
    S.a_ready(cur);
    if (GATHER) { PG8_ROWS(cur, gA); _Pragma("unroll") for (int h_ = 0; h_ < 2; ++h_) _Pragma("unroll") for (int i_ = 0; i_ < 2; ++i_) gN[h_][i_] = gA[h_][i_]; }
    const size_t hstepA = GATHER ? (size_t)0 : hstep;
#define PG8_VA(h) (GATHER ? gA[h] : voffA)
    PG8_STAGE(PG8_SB(0, 0), cB, voffB); PG8_STAGE(PG8_SA(0, 0), cA, PG8_VA(0)); PG8_STAGE(PG8_SB(0, 1), cB + hstep, voffB); PG8_STAGE(PG8_SA(0, 1), cA + hstepA, PG8_VA(1));
    if (wr == 1) PG8_BAR;
    PG8_WAIT_V(4); PG8_BAR;
    PG8_STAGE(PG8_SB(1, 0), cB + kstep, voffB); PG8_STAGE(PG8_SA(1, 0), cA + kstep, PG8_VA(0)); PG8_STAGE(PG8_SB(1, 1), cB + hstep + kstep, voffB);
    PG8_WAIT_V(6); PG8_BAR;
    PG8_STAMP();
    for (;;) {
        const bool has_next = S.next(ui + 1, nxt);
        if (GATHER && has_next && wid == 0) __builtin_amdgcn_global_load_lds((const unsigned*)(g.rows + (size_t)nxt.pm * BM + lane * 4), (PG8_LAS unsigned*)(lds + STAGE_BYTES + 4096 + ((ui + 1) & 1) * 1024), 16, 0, 0);
        const char* nA = (has_next && !GATHER) ? (const char*)g.A + (size_t)nxt.pm * tstep : cA; const char* nB = has_next ? (const char*)g.Bt + (size_t)nxt.pn * tstep : cB;
        for (int t = 0; t < nt; t += 2) {
            const bool last = (t == nt - 2);
            const char* a1 = cA + (size_t)(t + 1) * kstep;
            const char* a2 = last ? nA : cA + (size_t)(t + 2) * kstep; const char* b2 = last ? nB : cB + (size_t)(t + 2) * kstep;
            const char* a3 = a2 + kstep; const char* b3 = b2 + kstep;
            if (last && has_next) S.a_ready(nxt);
            if (GATHER && last && has_next) { const PG8_LAS int* rl_ = (const PG8_LAS int*)(lds + STAGE_BYTES + 4096 + ((ui + 1) & 1) * 1024);
                _Pragma("unroll") for (int h_ = 0; h_ < 2; ++h_) _Pragma("unroll") for (int i_ = 0; i_ < 2; ++i_) { const int as_ = rl_[h_ * HALF + rA_[i_]]; gN[h_][i_] = (unsigned)(as_ < 0 ? 0 : as_ >> 1) * (unsigned)(K * 2) + cA_[i_]; } }
            unsigned v2_[2][2];
            if (GATHER) { _Pragma("unroll") for (int h_ = 0; h_ < 2; ++h_) _Pragma("unroll") for (int i_ = 0; i_ < 2; ++i_) v2_[h_][i_] = last ? gN[h_][i_] : gA[h_][i_]; }
#define PG8_V2(h) (GATHER ? v2_[h] : voffA)
            PG8_LDB(B0, 0, 0); PG8_SCHED; PG8_LDA(At, 0, 0); PG8_STAGE(PG8_SA(1, 1), a1 + hstepA, PG8_VA(1));
            PG8_WAIT_L(8); PG8_BAR; PG8_WAIT_L(0); PG8_MMA(0, 0, At, B0); PG8_BAR; PG8_SCHED;
            PG8_LDB(B1, 0, 1); PG8_STAGE(PG8_SB(0, 0), b2, voffB);
            PG8_BAR; PG8_WAIT_L(0); PG8_MMA(0, 1, At, B1); PG8_BAR;
            PG8_LDA(At, 0, 1); PG8_STAGE(PG8_SA(0, 0), a2, PG8_V2(0));
            PG8_BAR; PG8_WAIT_L(0); PG8_MMA(1, 0, At, B0); PG8_BAR; PG8_SCHED;
            PG8_STAGE(PG8_SB(0, 1), b2 + hstep, voffB);
            PG8_WAIT_V(6); PG8_BAR; PG8_MMA(1, 1, At, B1); PG8_BAR;
            PG8_LDB(B0, 1, 0); PG8_SCHED; PG8_LDA(At, 1, 0); PG8_STAGE(PG8_SA(0, 1), a2 + hstepA, PG8_V2(1));
            PG8_WAIT_L(8); PG8_BAR; PG8_WAIT_L(0); PG8_MMA(0, 0, At, B0); PG8_BAR; PG8_SCHED;
            PG8_LDB(B1, 1, 1); PG8_STAGE(PG8_SB(1, 0), b3, voffB);
            PG8_BAR; PG8_WAIT_L(0); PG8_MMA(0, 1, At, B1); PG8_BAR;
            PG8_LDA(At, 1, 1); PG8_STAGE(PG8_SA(1, 0), a3, PG8_V2(0));
            PG8_BAR; PG8_WAIT_L(0); PG8_MMA(1, 0, At, B0); PG8_BAR; PG8_SCHED;
            PG8_STAGE(PG8_SB(1, 1), b3 + hstep, voffB);
            PG8_WAIT_V(6); PG8_BAR; PG8_MMA(1, 1, At, B1); PG8_BAR;
        }
        PG8_STAMP();
        if constexpr (!Epi::AFTER_DRAIN) { E(acc, cur, wr, wc, fr, fq); S.done(cur); }
        PG8_STAMP();
        if (!has_next) break;
#pragma unroll
        for (int a = 0; a < 2; ++a)
#pragma unroll
            for (int b = 0; b < 2; ++b)
#pragma unroll
                for (int m = 0; m < 4; ++m)
#pragma unroll
                    for (int n = 0; n < 2; ++n) acc[a][b][m][n] = (f32x4){0.f, 0.f, 0.f, 0.f};
        cur = nxt; cA = nA; cB = nB; ++ui;
        if (GATHER) { _Pragma("unroll") for (int h_ = 0; h_ < 2; ++h_) _Pragma("unroll") for (int i_ = 0; i_ < 2; ++i_) gA[h_][i_] = gN[h_][i_]; }
    }
    PG8_WAIT_V(0);
    if (wr == 0) PG8_BAR;
    PG8_BAR;
    if constexpr (Epi::AFTER_DRAIN) { E.fused(acc, cur, wr, wc, fr, fq, lds, wid, lane); S.done(cur); }
    PG8_STAMP();
    if (STAMP && wid == 0) { stamps[lane] = lane < nts ? (((unsigned long long)(unsigned)ts_hi << 32) | (unsigned)ts_lo) : 0ull;
        if (lane == 62) stamps[62] = rt_entry; if (lane == 63) stamps[63] = (unsigned long long)wall_clock64(); }
#undef PG8_STAMP
#undef PG8_SA
#undef PG8_SB
#undef PG8_STAGE
#undef PG8_LDA
#undef PG8_LDB
#undef PG8_MMA
#undef PG8_WAIT_V
#undef PG8_WAIT_L
#undef PG8_BAR
#undef PG8_SCHED
#undef PG8_ROWS
#undef PG8_VA
#undef PG8_V2
}
}

namespace mk {
#define MLAS __attribute__((address_space(3)))
typedef unsigned short bf16_t;
typedef float f32x4 __attribute__((ext_vector_type(4)));
typedef unsigned u32x4 __attribute__((ext_vector_type(4)));
typedef unsigned u32x2 __attribute__((ext_vector_type(2)));

constexpr int D = 1024, NB = 16, SEQ = 4096, LC = 256, TL = NB * SEQ, TC = NB * LC, TT = TL + TC;
constexpr int INC = 4096, NE = 32, DFF = 512, NCH = 34, PMAX = 147456, NT = 512;
constexpr int LDS_BYTES = 150 * 1024, LDS_CTL = LDS_BYTES - 256;
constexpr int C_QA = 0, C_KA = 512, C_VA = 1024, C_QB = 1536, C_KB = 2048, C_VB = 2560, C_GF = 3072, C_GB = 3584;

constexpr size_t al256(size_t x) { return (x + 255) & ~(size_t)255; }
constexpr size_t WS_BAR = 0;
constexpr size_t WS_CNT = 16384;
constexpr size_t WS_ZERO_BYTES = 16384 + 16384;
constexpr size_t WS_MOD = WS_ZERO_BYTES;
constexpr size_t WS_WIN = al256(WS_MOD + (size_t)2 * 17 * 6144 * 4);
constexpr size_t WS_WOUT = WS_WIN + (size_t)2 * 4096 * 1024 * 2;
constexpr size_t WS_WGU = WS_WOUT + (size_t)2 * 1024 * 1024 * 2;
constexpr size_t WS_WDN = WS_WGU + (size_t)32 * 1024 * 1024 * 2;
constexpr size_t WS_CTX = WS_WDN + (size_t)32 * 1024 * 512 * 2;
constexpr size_t WS_H = WS_CTX + (size_t)TC * D * 4;
constexpr size_t WS_PROJ = WS_H + (size_t)TT * D * 2;
constexpr size_t WS_XS = WS_PROJ;
constexpr size_t WS_ACT = WS_PROJ + (size_t)PMAX * D * 2;
constexpr size_t WS_XB = WS_PROJ + (size_t)TT * INC * 2;
constexpr size_t WS_ST = WS_PROJ + (size_t)TT * INC * 2;
constexpr size_t WS_KC = WS_ST;
constexpr size_t WS_VT = WS_KC + (size_t)128 * 4096 * 64 * 2;
constexpr size_t WS_KCC = WS_VT + (size_t)128 * 4096 * 64 * 2;
constexpr size_t WS_VTC = WS_KCC + (size_t)128 * 256 * 64 * 2;
static_assert(WS_VTC + (size_t)128 * 256 * 64 * 2 <= WS_ST + (size_t)NB * 4 * 2 * NCH * 16384 * 2, "NA operand copies fit in the state region");
constexpr size_t WS_TOKE = WS_ST + (size_t)NB * 4 * 2 * NCH * 16384 * 2;
constexpr size_t WS_TOKR = WS_TOKE + (size_t)TT * 2 * 4;
constexpr size_t WS_TOKW = WS_TOKR + (size_t)TT * 2 * 4;
constexpr size_t WS_RINFO = WS_TOKW + (size_t)TT * 2 * 4;
constexpr size_t WS_RW = WS_RINFO + (size_t)PMAX * 4;
constexpr size_t WS_BLKE = WS_RW + (size_t)PMAX * 4;
constexpr size_t WS_RWT = WS_BLKE + 4096;
constexpr size_t WS_BLKB = WS_RWT + (size_t)2 * 32 * 1024 * 2;
constexpr size_t WS_ROPE = WS_BLKB + (size_t)1024 * 32 * 4;
constexpr size_t WS_END = WS_ROPE + (size_t)64 * 32 * 8;
static_assert(WS_ACT + (size_t)PMAX * DFF * 2 <= WS_ST && WS_XB == WS_ST && (size_t)TL * D * 2 <= (size_t)NB * 4 * 2 * NCH * 16384 * 2, "ys | act fit in the proj region, xb in the state region");
static_assert((size_t)TT * 2 * D * 2 <= (size_t)PMAX * D * 2, "y2 fits in xs region");
static_assert(WS_END <= (size_t)1 << 30, "workspace must fit in 1 GiB");

struct Args {
    const float* x; const float* c; const float* ctx; const float* c_ctx; const float* ada_w; const float* ada_b;
    const float* norm_mix_w; const float* norm_ffn_w; const float* w_in; const float* na_q_norm; const float* na_k_norm;
    const float* na_rpb; const float* ret_decay; const float* w_out; const float* router_w; const float* router_bias;
    const float* w_gate; const float* w_up; const float* w_down;
    float* out; unsigned char* ws; int ph_lo, ph_hi;
};

#define LDS_BARRIER() do { asm volatile("s_waitcnt lgkmcnt(0)" ::: "memory"); __builtin_amdgcn_s_barrier(); asm volatile("" ::: "memory"); } while (0)
__device__ __forceinline__ int otid() { int t = threadIdx.x; asm volatile("" : "+v"(t)); return t; }
__device__ __forceinline__ float bf2f(bf16_t v) { return __uint_as_float(((unsigned)v) << 16); }
__device__ __forceinline__ bf16_t f2bf(float f) { unsigned u = __float_as_uint(f); u += 0x7FFFu + ((u >> 16) & 1u); return (bf16_t)(u >> 16); }
typedef float f32x2_t __attribute__((ext_vector_type(2)));
typedef __bf16 bf16x2_t __attribute__((ext_vector_type(2)));
__device__ __forceinline__ unsigned pack2(float lo, float hi) { const f32x2_t v = {lo, hi}; return __builtin_bit_cast(unsigned, __builtin_convertvector(v, bf16x2_t)); }
__device__ __forceinline__ float lo16(unsigned w) { return __uint_as_float(w << 16); }
__device__ __forceinline__ float hi16(unsigned w) { return __uint_as_float(w & 0xffff0000u); }
__device__ __forceinline__ float siluf(float v) { return v * __builtin_amdgcn_rcpf(1.0f + __builtin_amdgcn_exp2f(-1.4426950408889634f * v)); }
__device__ __forceinline__ float wave_sum(float v) {
#pragma unroll
    for (int o = 32; o >= 1; o >>= 1) v += __shfl_xor(v, o);
    return v;
}

typedef short bf16x8 __attribute__((ext_vector_type(8)));
typedef float f32x16 __attribute__((ext_vector_type(16)));
__device__ __forceinline__ unsigned off_b(unsigned row, unsigned ch) { return 256u * row + 16u * (ch ^ (((row & 3) << 2) | ((row >> 2) & 3))); }
__device__ __forceinline__ unsigned tr_addr(unsigned row0, unsigned c, unsigned lane) { const unsigned blk = (lane >> 4) & 1, q = (lane & 15) >> 2, p = lane & 3; return off_b(row0 + q, 4 * c + 2 * blk + (p >> 1)) + 8 * (p & 1); }
__device__ __forceinline__ bf16x8 mkfrag(u32x2 lo, u32x2 hi) { const u32x4 w = {lo.x, lo.y, hi.x, hi.y}; return __builtin_bit_cast(bf16x8, w); }
__device__ __forceinline__ int st_frag_idx(int d, int e) { return (((d >> 5) * 4 + (e >> 5)) * 64 + (e & 31) + 32 * ((d >> 2) & 1)) * 16 + (d & 3) + 4 * ((d & 31) >> 3); }
__device__ __forceinline__ const float* modp(const Args& a, int l, int r, int k6) { return (const float*)(a.ws + WS_MOD) + ((size_t)l * 17 + r) * 6144 + k6 * 1024; }

__device__ __forceinline__ void cvt_addr(const Args& a, bool with_dense, int le, bf16_t* wgu, bf16_t* wdn, int t, int tid, const float*& lp, bf16_t*& sp) {
    const float* src; bf16_t* dst; int ldn, ldk, k0, n0, nd0;
    if (with_dense && t < 2560) {
        if (t < 2048) { const int l = t >> 10, tt = t & 1023; k0 = (tt >> 6) * 64; n0 = (tt & 63) * 64; nd0 = n0; src = a.w_in + (size_t)l * D * INC; ldn = INC; dst = (bf16_t*)(a.ws + WS_WIN) + (size_t)l * INC * D; ldk = D; }
        else { const int t2 = t - 2048, l = t2 >> 8, tt = t2 & 255; k0 = (tt >> 4) * 64; n0 = (tt & 15) * 64; nd0 = n0; src = a.w_out + (size_t)l * D * D; ldn = D; dst = (bf16_t*)(a.ws + WS_WOUT) + (size_t)l * D * D; ldk = D; }
    } else {
        const int te = with_dense ? t - 2560 : t, which = te >> 12, tt = te & 4095, e = tt >> 7, r = tt & 127;
        if (which < 2) { k0 = (r >> 3) * 64; n0 = (r & 7) * 64; nd0 = (n0 >> 7) * 256 + which * 128 + (n0 & 127); src = (which == 0 ? a.w_gate : a.w_up) + ((size_t)le * NE + e) * D * DFF; ldn = DFF; dst = wgu + (size_t)e * 1024 * D; ldk = D; }
        else { k0 = (r >> 4) * 64; n0 = (r & 15) * 64; nd0 = n0; src = a.w_down + ((size_t)le * NE + e) * DFF * D; ldn = D; dst = wdn + (size_t)e * 1024 * DFF; ldk = DFF; }
    }
    lp = src + (size_t)(k0 + (tid >> 3)) * ldn + n0 + (tid & 7) * 8;
    sp = dst + (size_t)(nd0 + (tid >> 3)) * ldk + k0 + (tid & 7) * 8;
}
__device__ __forceinline__ void convert_weights(const Args& a, bool with_dense, int le, MLAS unsigned char* lds, int idx, int stride, int t_lo, int t_hi, bf16_t* wgu, bf16_t* wdn) {
    MLAS float* tl = (MLAS float*)lds; const int tid = otid();
    const int N = t_hi;
    const float* lp; bf16_t* sp;
    f32x4 v0 = {0.f, 0.f, 0.f, 0.f}, v1 = v0;
    if (t_lo + idx < N) { cvt_addr(a, with_dense, le, wgu, wdn, t_lo + idx, tid, lp, sp); v0 = *(const f32x4*)lp; v1 = *(const f32x4*)(lp + 4); }
    for (int t = t_lo + idx; t < N; t += stride) {
        cvt_addr(a, with_dense, le, wgu, wdn, t, tid, lp, sp);
        LDS_BARRIER();
        { const int kk = tid >> 3, nn0 = (tid & 7) * 8;
#pragma unroll
          for (int j = 0; j < 4; ++j) { tl[kk * 65 + nn0 + j] = v0[j]; tl[kk * 65 + nn0 + 4 + j] = v1[j]; } }
        { const int tn = t + stride < N ? t + stride : t; const float* lpn; bf16_t* spn; cvt_addr(a, with_dense, le, wgu, wdn, tn, tid, lpn, spn); (void)spn; v0 = *(const f32x4*)lpn; v1 = *(const f32x4*)(lpn + 4); }
        LDS_BARRIER();
        { const int n = tid >> 3, kc = (tid & 7) * 8;
          u32x4 w;
          w.x = pack2(tl[(kc + 0) * 65 + n], tl[(kc + 1) * 65 + n]); w.y = pack2(tl[(kc + 2) * 65 + n], tl[(kc + 3) * 65 + n]);
          w.z = pack2(tl[(kc + 4) * 65 + n], tl[(kc + 5) * 65 + n]); w.w = pack2(tl[(kc + 6) * 65 + n], tl[(kc + 7) * 65 + n]);
          *(u32x4*)sp = w; }
    }
    __syncthreads();
}
#ifndef CV_BUB
#define CV_BUB 40
#endif
__device__ __forceinline__ bf16_t* wgu_of(const Args& a, int l) { return l == 0 ? (bf16_t*)(a.ws + WS_WGU) : (bf16_t*)a.out + (size_t)TL * D; }
__device__ __forceinline__ bf16_t* wdn_of(const Args& a, int l) { return l == 0 ? (bf16_t*)(a.ws + WS_WDN) : (bf16_t*)a.out + (size_t)TL * D + (size_t)NE * 1024 * D; }
__device__ __forceinline__ int cv_rem(int nb) { return (TT / 256) * (D / 256) % nb; }
__device__ __forceinline__ int cv_nbub(int nb) { const int rem = cv_rem(nb); const int n = rem > 0 ? (nb - rem) * CV_BUB : 0; return n < 3 * 4096 ? n : 3 * 4096; }
__device__ __forceinline__ void convert_small(const Args& a, int bid, int nb) {
    const int tid = otid();
    if (bid == nb - 2) { float* rt = (float*)(a.ws + WS_ROPE);
        for (int i = tid; i < 64 * 32; i += NT) { const float ang = (float)(i >> 5) * exp2f(-(float)(i & 31) * (13.287712379549449f / 32.0f)); float sn, cs; sincosf(ang, &sn, &cs); rt[2 * i] = cs; rt[2 * i + 1] = sn; } }
    if (bid == nb - 1) { bf16_t* rh = (bf16_t*)(a.ws + WS_RWT); bf16_t* rl = rh + 32 * 1024;
        for (int i = tid; i < 32 * 1024; i += NT) { const int e = i >> 10, k = i & 1023; const float w = a.router_w[k * NE + e]; const bf16_t hi = f2bf(w); rh[i] = hi; rl[i] = f2bf(w - bf2f(hi)); } }
}
__device__ __forceinline__ void compute_mod(const Args& a, MLAS unsigned char* lds, int bid, int nb) {
    MLAS float* sc = (MLAS float*)lds;
    MLAS float* red = (MLAS float*)(lds + 17 * 1024 * 4);
    const int tid = otid();
    if (bid >= 192) return;
    for (int i = tid; i < 17 * 1024; i += NT) { const int r = i >> 10, k = i & 1023; const float v = r < 16 ? a.c[r * 1024 + k] : a.c_ctx[k]; sc[i] = v / (1.0f + expf(-v)); }
    __syncthreads();
    for (int u = bid; u < 192; u += nb) {
        const int l = u / 96, n = (u % 96) * 64 + (tid & 63), kp = tid >> 6;
        float acc[17];
#pragma unroll
        for (int r = 0; r < 17; ++r) acc[r] = 0.f;
        const float* w = a.ada_w + (size_t)l * D * 6144 + n;
        for (int k = kp * 128; k < kp * 128 + 128; ++k) { const float wv = w[(size_t)k * 6144];
#pragma unroll
            for (int r = 0; r < 17; ++r) acc[r] += sc[r * 1024 + k] * wv; }
#pragma unroll
        for (int r = 0; r < 17; ++r) red[(kp * 17 + r) * 64 + (tid & 63)] = acc[r];
        __syncthreads();
        for (int i = tid; i < 17 * 64; i += NT) { const int r = i >> 6, cc = i & 63, nn = (u % 96) * 64 + cc; float s = a.ada_b[l * 6144 + nn];
#pragma unroll
            for (int p = 0; p < 8; ++p) s += red[(p * 17 + r) * 64 + cc];
            ((float*)(a.ws + WS_MOD))[((size_t)l * 17 + r) * 6144 + nn] = s; }
        __syncthreads();
    }
}

__device__ __forceinline__ void load_row_f32(const float* src, int e0, int e1, float (&v)[16]) {
    const f32x4 x0 = *(const f32x4*)(src + e0), x1 = *(const f32x4*)(src + e0 + 4), x2 = *(const f32x4*)(src + e1), x3 = *(const f32x4*)(src + e1 + 4);
#pragma unroll
    for (int j = 0; j < 4; ++j) { v[j] = x0[j]; v[4 + j] = x1[j]; v[8 + j] = x2[j]; v[12 + j] = x3[j]; }
}
__device__ __forceinline__ void load_row_bf16(const bf16_t* src, int e0, int e1, float (&v)[16]) {
    const u32x4 w0 = *(const u32x4*)(src + e0), w1 = *(const u32x4*)(src + e1);
#pragma unroll
    for (int j = 0; j < 4; ++j) { v[2 * j] = lo16(w0[j]); v[2 * j + 1] = hi16(w0[j]); v[8 + 2 * j] = lo16(w1[j]); v[8 + 2 * j + 1] = hi16(w1[j]); }
}
__device__ __forceinline__ void moe_combine(const bf16_t* ys, int2 pp, float2 ww, int i, const float (&mg)[16], int e0, int e1, float (&v)[16]) {
    const int p0 = __builtin_amdgcn_readlane(pp.x, i), p1 = __builtin_amdgcn_readlane(pp.y, i);
    const float w0 = __uint_as_float(__builtin_amdgcn_readlane(__float_as_uint(ww.x), i)), w1 = __uint_as_float(__builtin_amdgcn_readlane(__float_as_uint(ww.y), i));
    const bf16_t* ya = ys + (size_t)p0 * D; const bf16_t* yb = ys + (size_t)p1 * D;
    const u32x4 a0 = *(const u32x4*)(ya + e0), a1 = *(const u32x4*)(ya + e1), b0 = *(const u32x4*)(yb + e0), b1 = *(const u32x4*)(yb + e1);
#pragma unroll
    for (int j = 0; j < 4; ++j) {
        v[2 * j] += mg[2 * j] * (w0 * lo16(a0[j]) + w1 * lo16(b0[j])); v[2 * j + 1] += mg[2 * j + 1] * (w0 * hi16(a0[j]) + w1 * hi16(b0[j]));
        v[8 + 2 * j] += mg[8 + 2 * j] * (w0 * lo16(a1[j]) + w1 * lo16(b1[j])); v[8 + 2 * j + 1] += mg[8 + 2 * j + 1] * (w0 * hi16(a1[j]) + w1 * hi16(b1[j])); }
}
__device__ __forceinline__ void phase_norm1(const Args& a, int l, int bid, int nb) {
    const int tid = otid(), lane = tid & 63, wave = __builtin_amdgcn_readfirstlane(tid >> 6);
    const int e0 = lane * 8, e1 = 512 + lane * 8;
    float wn[16];
    { const float* w = a.norm_mix_w + l * D;
#pragma unroll
      for (int j = 0; j < 8; ++j) { wn[j] = w[e0 + j]; wn[8 + j] = w[e1 + j]; } }
    float msc[16], msh[16], mg[16]; int cur_r = -1;
    bf16_t* hb = (bf16_t*)(a.ws + WS_H);
    const bf16_t* y2 = (const bf16_t*)(a.ws + WS_XS);
    const int rper = (TT + nb * 8 - 1) / (nb * 8), row_lo = (bid * 8 + wave) * rper, row_hi = min(row_lo + rper, TT);
    int2 pp = {0, 0}; float2 ww = {0.f, 0.f};
    if (l > 0 && row_lo + lane < row_hi) { pp = *(const int2*)((const int*)(a.ws + WS_TOKR) + (size_t)(row_lo + lane) * 2); ww = *(const float2*)((const float*)(a.ws + WS_TOKW) + (size_t)(row_lo + lane) * 2); }
    for (int row = row_lo; row < row_hi; ++row) {
        const int r = row < TL ? row / SEQ : 16;
        if (r != cur_r) { cur_r = r; const float* sh = modp(a, l, r, 0); const float* sc = modp(a, l, r, 1);
#pragma unroll
            for (int j = 0; j < 8; ++j) { msh[j] = sh[e0 + j]; msh[8 + j] = sh[e1 + j]; msc[j] = 1.0f + sc[e0 + j]; msc[8 + j] = 1.0f + sc[e1 + j]; }
            if (l > 0) { const float* g = modp(a, l - 1, r, 5);
#pragma unroll
                for (int j = 0; j < 8; ++j) { mg[j] = g[e0 + j]; mg[8 + j] = g[e1 + j]; } } }
        float v[16];
        if (l == 0) load_row_f32(row < TL ? a.x + (size_t)row * D : a.ctx + (size_t)(row - TL) * D, e0, e1, v);
        else if (row < TL) load_row_bf16((const bf16_t*)(a.ws + WS_XB) + (size_t)row * D, e0, e1, v);
        else load_row_f32((const float*)(a.ws + WS_CTX) + (size_t)(row - TL) * D, e0, e1, v);
        if (l > 0) {
            moe_combine(y2, pp, ww, row - row_lo, mg, e0, e1, v);
            if (row < TL) { bf16_t* dst = (bf16_t*)a.out + (size_t)row * D;
                *(u32x4*)(dst + e0) = (u32x4){pack2(v[0], v[1]), pack2(v[2], v[3]), pack2(v[4], v[5]), pack2(v[6], v[7])};
                *(u32x4*)(dst + e1) = (u32x4){pack2(v[8], v[9]), pack2(v[10], v[11]), pack2(v[12], v[13]), pack2(v[14], v[15])}; }
        }
        float ss = 0.f;
#pragma unroll
        for (int j = 0; j < 16; ++j) ss += v[j] * v[j];
        ss = wave_sum(ss);
        const float rs = rsqrtf(ss * (1.0f / D) + 1e-6f);
        float y[16];
#pragma unroll
        for (int j = 0; j < 16; ++j) y[j] = v[j] * rs * wn[j] * msc[j] + msh[j];
        bf16_t* hp = hb + (size_t)row * D;
        *(u32x4*)(hp + e0) = (u32x4){pack2(y[0], y[1]), pack2(y[2], y[3]), pack2(y[4], y[5]), pack2(y[6], y[7])};
        *(u32x4*)(hp + e1) = (u32x4){pack2(y[8], y[9]), pack2(y[10], y[11]), pack2(y[12], y[13]), pack2(y[14], y[15])};
    }
}
__device__ __forceinline__ void phase_final(const Args& a, int bid, int nb) {
    const int tid = otid(), lane = tid & 63, wave = __builtin_amdgcn_readfirstlane(tid >> 6);
    const int e0 = lane * 8, e1 = 512 + lane * 8;
    float mg[16]; int cur_r = -1;
    const bf16_t* y2 = (const bf16_t*)(a.ws + WS_XS);
    const int rper = (TL + nb * 8 - 1) / (nb * 8), row_lo = (bid * 8 + wave) * rper, row_hi = min(row_lo + rper, TL);
    int2 pp = {0, 0}; float2 ww = {0.f, 0.f};
    if (row_lo + lane < row_hi) { pp = *(const int2*)((const int*)(a.ws + WS_TOKR) + (size_t)(row_lo + lane) * 2); ww = *(const float2*)((const float*)(a.ws + WS_TOKW) + (size_t)(row_lo + lane) * 2); }
    for (int row = row_lo; row < row_hi; ++row) {
        const int r = row / SEQ;
        if (r != cur_r) { cur_r = r; const float* g = modp(a, 1, r, 5);
#pragma unroll
            for (int j = 0; j < 8; ++j) { mg[j] = g[e0 + j]; mg[8 + j] = g[e1 + j]; } }
        float* src = a.out + (size_t)row * D;
        float v[16];
        load_row_bf16((const bf16_t*)(a.ws + WS_XB) + (size_t)row * D, e0, e1, v);
        moe_combine(y2, pp, ww, row - row_lo, mg, e0, e1, v);
        *(f32x4*)(src + e0) = (f32x4){v[0], v[1], v[2], v[3]}; *(f32x4*)(src + e0 + 4) = (f32x4){v[4], v[5], v[6], v[7]};
        *(f32x4*)(src + e1) = (f32x4){v[8], v[9], v[10], v[11]}; *(f32x4*)(src + e1 + 4) = (f32x4){v[12], v[13], v[14], v[15]};
    }
}

constexpr int VP = 516;
__device__ __forceinline__ void phase_prep(const Args& a, int l, MLAS unsigned char* lds, int bid, int nb) {
    const int tid = otid(), lane = tid & 63, wave = tid >> 6;
    const bf16_t* proj = (const bf16_t*)(a.ws + WS_PROJ);
    MLAS bf16_t* Vs = (MLAS bf16_t*)lds;
    float wk[8];
    { const float* w = a.na_k_norm + l * 64 + (lane & 7) * 8;
#pragma unroll
      for (int j = 0; j < 8; ++j) wk[j] = w[j]; }
    for (int u = bid; u < TT / 64; u += nb) {
        const int R0 = u * 64; const bool lat = R0 < TL;
        const int b = lat ? R0 / SEQ : (R0 - TL) / LC, t0 = lat ? R0 % SEQ : (R0 - TL) % LC, tlen = lat ? SEQ : LC;
        bf16_t* kc = (bf16_t*)(a.ws + (lat ? WS_KC : WS_KCC)); bf16_t* vt = (bf16_t*)(a.ws + (lat ? WS_VT : WS_VTC));
        __syncthreads();
#pragma unroll
        for (int rr = 0; rr < 8; ++rr) {
            const int rl = wave * 8 + rr, row = R0 + rl, t = t0 + rl;
            const bf16_t* p = proj + (size_t)row * INC;
            const u32x4 kw = *(const u32x4*)(p + C_KA + lane * 8), vw = *(const u32x4*)(p + C_VA + lane * 8);
            float f[8];
#pragma unroll
            for (int j = 0; j < 4; ++j) { f[2 * j] = lo16(kw[j]); f[2 * j + 1] = hi16(kw[j]); }
            float ss = 0.f;
#pragma unroll
            for (int j = 0; j < 8; ++j) ss += f[j] * f[j];
            ss += __shfl_xor(ss, 1); ss += __shfl_xor(ss, 2); ss += __shfl_xor(ss, 4);
            const float rs = rsqrtf(ss * (1.0f / 64.0f) + 1e-6f);
            *(u32x4*)(kc + (((size_t)b * 8 + (lane >> 3)) * tlen + t) * 64 + (lane & 7) * 8) =
                (u32x4){pack2(f[0] * rs * wk[0], f[1] * rs * wk[1]), pack2(f[2] * rs * wk[2], f[3] * rs * wk[3]), pack2(f[4] * rs * wk[4], f[5] * rs * wk[5]), pack2(f[6] * rs * wk[6], f[7] * rs * wk[7])};
            *(MLAS u32x2*)(Vs + rl * VP + lane * 8) = (u32x2){vw.x, vw.y}; *(MLAS u32x2*)(Vs + rl * VP + lane * 8 + 4) = (u32x2){vw.z, vw.w};
        }
        __syncthreads();
#pragma unroll
        for (int i = 0; i < 8; ++i) { const int idx = tid + i * NT, d = idx & 63, tc = (idx >> 6) & 7, h = idx >> 9;
            const MLAS bf16_t* vp = Vs + (tc * 8) * VP + h * 64 + d;
            const u32x4 w = {(unsigned)vp[0] | ((unsigned)vp[VP] << 16), (unsigned)vp[2 * VP] | ((unsigned)vp[3 * VP] << 16), (unsigned)vp[4 * VP] | ((unsigned)vp[5 * VP] << 16), (unsigned)vp[6 * VP] | ((unsigned)vp[7 * VP] << 16)};
            const int tk = t0 + tc * 8;
            *(u32x4*)(vt + ((((size_t)b * 8 + h) * (tlen >> 4) + (tk >> 4)) * 64 + d) * 16 + (tk & 15)) = w; }
    }
}

__device__ __forceinline__ int chunk_row0(int b, int c) { return c < 2 ? TL + b * LC + c * 128 : b * SEQ + (c - 2) * 128; }
__device__ __forceinline__ size_t st_index(int b, int h, int dir, int c) { return ((((size_t)b * 4 + h) * 2 + dir) * NCH + c) * 16384; }
constexpr int RP = 136;
__device__ __forceinline__ void load_rope_pair(const bf16_t* p, int a2, int fc, int tok, const MLAS float* rope, float (&y1)[8], float (&y2)[8]) {
    const u32x4 w0 = *(const u32x4*)(p + (a2 * 8 + fc) * 8), w1 = *(const u32x4*)(p + (a2 * 8 + fc + 4) * 8);
#pragma unroll
    for (int j = 0; j < 4; ++j) { y1[2 * j] = lo16(w0[j]); y1[2 * j + 1] = hi16(w0[j]); y2[2 * j] = lo16(w1[j]); y2[2 * j + 1] = hi16(w1[j]); }
    if (tok >= 0) {
        const int pos = a2 == 0 ? (tok >> 6) : (tok & 63);
        const MLAS f32x4* tp = (const MLAS f32x4*)(rope + (pos * 32 + fc * 8) * 2);
#pragma unroll
        for (int q = 0; q < 4; ++q) { const f32x4 cs = tp[q];
            const float u0 = y1[2 * q] * cs[0] - y2[2 * q] * cs[1], v0 = y1[2 * q] * cs[1] + y2[2 * q] * cs[0];
            const float u1 = y1[2 * q + 1] * cs[2] - y2[2 * q + 1] * cs[3], v1 = y1[2 * q + 1] * cs[3] + y2[2 * q + 1] * cs[2];
            y1[2 * q] = u0; y2[2 * q] = v0; y1[2 * q + 1] = u1; y2[2 * q + 1] = v1; }
    }
}
__device__ __forceinline__ void rope_pair_regs(const u32x4 w0, const u32x4 w1, int a2, int fc, int tok, const MLAS float* rope, float (&y1)[8], float (&y2)[8]) {
#pragma unroll
    for (int j = 0; j < 4; ++j) { y1[2 * j] = lo16(w0[j]); y1[2 * j + 1] = hi16(w0[j]); y2[2 * j] = lo16(w1[j]); y2[2 * j + 1] = hi16(w1[j]); }
    if (tok >= 0) {
        const int pos = a2 == 0 ? (tok >> 6) : (tok & 63);
        const MLAS f32x4* tp = (const MLAS f32x4*)(rope + (pos * 32 + fc * 8) * 2);
#pragma unroll
        for (int q = 0; q < 4; ++q) { const f32x4 cs = tp[q];
            const float u0 = y1[2 * q] * cs[0] - y2[2 * q] * cs[1], v0 = y1[2 * q] * cs[1] + y2[2 * q] * cs[0];
            const float u1 = y1[2 * q + 1] * cs[2] - y2[2 * q + 1] * cs[3], v1 = y1[2 * q + 1] * cs[3] + y2[2 * q + 1] * cs[2];
            y1[2 * q] = u0; y2[2 * q] = v0; y1[2 * q + 1] = u1; y2[2 * q + 1] = v1; }
    }
}
__device__ __forceinline__ u32x4 pack8(const float (&y)[8], float sc) { return (u32x4){pack2(y[0] * sc, y[1] * sc), pack2(y[2] * sc, y[3] * sc), pack2(y[4] * sc, y[5] * sc), pack2(y[6] * sc, y[7] * sc)}; }
constexpr float RET_KSCALE = 0.08838834764831845f;
constexpr int LDS_ROPE = 98304;
__device__ __forceinline__ void phase_ret_a(const Args& a, int l, MLAS unsigned char* lds, int bid, int nb) {
    const int tid = otid(), lane = tid & 63, wave = __builtin_amdgcn_readfirstlane(tid >> 6);
    const bf16_t* proj = (const bf16_t*)(a.ws + WS_PROJ); bf16_t* st = (bf16_t*)(a.ws + WS_ST);
    const unsigned ldsb = (unsigned)(size_t)lds;
    const int dir = wave >> 2, dt = wave & 3, hh = lane >> 5;
    MLAS float* rope = (MLAS float*)(lds + LDS_ROPE);
    for (int i = tid; i < 64 * 32 * 2; i += NT) rope[i] = ((const float*)(a.ws + WS_ROPE))[i];
#define RA_LOAD(u_) do { const int b_ = (u_) / (NCH * 4), c_ = ((u_) >> 2) % NCH, h_ = (u_) & 3, row0_ = chunk_row0(b_, c_); _Pragma("unroll") for (int i = 0; i < 2; ++i) { const int idx = tid + i * NT, row = idx >> 3, ch0 = ((idx >> 2) & 1) * 8 + (idx & 3); \
        const bf16_t* src = proj + (size_t)(row0_ + row) * INC + h_ * 128; \
        raw[i][0] = *(const u32x4*)(src + C_KB + ch0 * 8); raw[i][1] = *(const u32x4*)(src + C_KB + (ch0 + 4) * 8); raw[i][2] = *(const u32x4*)(src + C_VB + ch0 * 8); raw[i][3] = *(const u32x4*)(src + C_VB + (ch0 + 4) * 8); } } while (0)
    u32x4 raw[2][4];
    if (bid < NB * NCH * 4) RA_LOAD(bid);
    LDS_BARRIER();
    for (int u = bid; u < NB * NCH * 4; u += nb) {
        const int b = u / (NCH * 4), c = (u >> 2) % NCH, h = u & 3;
        const float lgf = -expf(a.ret_decay[l * 8 + h]), lgb = -expf(a.ret_decay[l * 8 + 4 + h]);
        LDS_BARRIER();
#pragma unroll
        for (int i = 0; i < 2; ++i) { const int idx = tid + i * NT, row = idx >> 3, a2 = (idx >> 2) & 1, fc = idx & 3, ch0 = a2 * 8 + fc;
            float y1[8], y2[8];
            rope_pair_regs(raw[i][0], raw[i][1], a2, fc, c >= 2 ? (c - 2) * 128 + row : -1, rope, y1, y2);
            const float wf = __expf((float)(127 - row) * lgf) * RET_KSCALE, wb = __expf((float)row * lgb) * RET_KSCALE;
            const unsigned o0 = off_b(row, ch0), o1 = off_b(row, ch0 + 4);
            *(MLAS u32x4*)(lds + o0) = pack8(y1, wf); *(MLAS u32x4*)(lds + o1) = pack8(y2, wf);
            *(MLAS u32x4*)(lds + 32768 + o0) = pack8(y1, wb); *(MLAS u32x4*)(lds + 32768 + o1) = pack8(y2, wb);
            *(MLAS u32x4*)(lds + 65536 + o0) = raw[i][2]; *(MLAS u32x4*)(lds + 65536 + o1) = raw[i][3]; }
        { const int un_ = u + nb < NB * NCH * 4 ? u + nb : u; RA_LOAD(un_); }
        LDS_BARRIER();
        f32x16 acc[4];
#pragma unroll
        for (int et = 0; et < 4; ++et)
#pragma unroll
            for (int r = 0; r < 16; ++r) acc[et][r] = 0.f;
        unsigned aK[2], aV[4][2];
#pragma unroll
        for (int t = 0; t < 2; ++t) { aK[t] = ldsb + dir * 32768 + tr_addr(8 * hh + 4 * t, dt, lane);
#pragma unroll
            for (int et = 0; et < 4; ++et) aV[et][t] = ldsb + 65536 + tr_addr(8 * hh + 4 * t, et, lane); }
#pragma unroll
        for (int ks = 0; ks < 8; ++ks) {
            u32x2 r0, r1, r2, r3, r4, r5, r6, r7, r8, r9; const unsigned ko = ks * 4096;
            asm volatile("ds_read_b64_tr_b16 %0, %10\n\tds_read_b64_tr_b16 %1, %11\n\tds_read_b64_tr_b16 %2, %12\n\tds_read_b64_tr_b16 %3, %13\n\tds_read_b64_tr_b16 %4, %14\n\t"
                         "ds_read_b64_tr_b16 %5, %15\n\tds_read_b64_tr_b16 %6, %16\n\tds_read_b64_tr_b16 %7, %17\n\tds_read_b64_tr_b16 %8, %18\n\tds_read_b64_tr_b16 %9, %19\n\ts_waitcnt lgkmcnt(0)"
                         : "=&v"(r0), "=&v"(r1), "=&v"(r2), "=&v"(r3), "=&v"(r4), "=&v"(r5), "=&v"(r6), "=&v"(r7), "=&v"(r8), "=&v"(r9)
                         : "v"(aK[0] + ko), "v"(aK[1] + ko), "v"(aV[0][0] + ko), "v"(aV[0][1] + ko), "v"(aV[1][0] + ko), "v"(aV[1][1] + ko), "v"(aV[2][0] + ko), "v"(aV[2][1] + ko), "v"(aV[3][0] + ko), "v"(aV[3][1] + ko) : "memory");
            const bf16x8 A = mkfrag(r0, r1);
            acc[0] = __builtin_amdgcn_mfma_f32_32x32x16_bf16(A, mkfrag(r2, r3), acc[0], 0, 0, 0);
            acc[1] = __builtin_amdgcn_mfma_f32_32x32x16_bf16(A, mkfrag(r4, r5), acc[1], 0, 0, 0);
            acc[2] = __builtin_amdgcn_mfma_f32_32x32x16_bf16(A, mkfrag(r6, r7), acc[2], 0, 0, 0);
            acc[3] = __builtin_amdgcn_mfma_f32_32x32x16_bf16(A, mkfrag(r8, r9), acc[3], 0, 0, 0);
        }
        bf16_t* o = st + st_index(b, h, dir, c);
#pragma unroll
        for (int et = 0; et < 4; ++et) { bf16_t* p = o + ((dt * 4 + et) * 64 + lane) * 16;
            *(u32x4*)p = (u32x4){pack2(acc[et][0], acc[et][1]), pack2(acc[et][2], acc[et][3]), pack2(acc[et][4], acc[et][5]), pack2(acc[et][6], acc[et][7])};
            *(u32x4*)(p + 8) = (u32x4){pack2(acc[et][8], acc[et][9]), pack2(acc[et][10], acc[et][11]), pack2(acc[et][12], acc[et][13]), pack2(acc[et][14], acc[et][15])}; }
    }
#undef RA_LOAD
}
__device__ __forceinline__ void phase_scan(const Args& a, int l, int bid, int nb) {
    bf16_t* st = (bf16_t*)(a.ws + WS_ST);
#pragma unroll 1
    for (int idx = bid * NT + otid(); idx < NB * 4 * 2 * 2048; idx += nb * NT) {
        const int chain = idx >> 11, v8 = idx & 2047, dir = chain & 1, h = (chain >> 1) & 3;
        const float dec = expf(-128.0f * expf(a.ret_decay[l * 8 + dir * 4 + h]));
        bf16_t* p = st + (size_t)chain * NCH * 16384 + v8 * 8;
        float S[8];
#pragma unroll
        for (int j = 0; j < 8; ++j) S[j] = 0.f;
#pragma unroll 1
        for (int half = 0; half < 2; ++half) {
            u32x4 ls[NCH / 2];
#pragma unroll
            for (int i = 0; i < NCH / 2; ++i) { const int ii = half * (NCH / 2) + i, c = dir == 0 ? ii : (ii < 2 ? 1 - ii : NCH + 1 - ii); ls[i] = *(const u32x4*)(p + (size_t)c * 16384); }
#pragma unroll
            for (int i = 0; i < NCH / 2; ++i) { const int ii = half * (NCH / 2) + i, c = dir == 0 ? ii : (ii < 2 ? 1 - ii : NCH + 1 - ii);
                *(u32x4*)(p + (size_t)c * 16384) = (u32x4){pack2(S[0], S[1]), pack2(S[2], S[3]), pack2(S[4], S[5]), pack2(S[6], S[7])};
#pragma unroll
                for (int t = 0; t < 4; ++t) { S[2 * t] = S[2 * t] * dec + lo16(ls[i][t]); S[2 * t + 1] = S[2 * t + 1] * dec + hi16(ls[i][t]); } }
        }
    }
}
__device__ __forceinline__ void phase_ret_b(const Args& a, int l, MLAS unsigned char* lds, int bid, int nb) {
    const int tid = otid(), lane = tid & 63, wave = __builtin_amdgcn_readfirstlane(tid >> 6);
    const bf16_t* proj = (const bf16_t*)(a.ws + WS_PROJ); const bf16_t* st = (const bf16_t*)(a.ws + WS_ST); bf16_t* mix = (bf16_t*)(a.ws + WS_H);
    const unsigned ldsb = (unsigned)(size_t)lds;
    const int dir = wave >> 2, it = wave & 3, hh = lane >> 5, il = it * 32 + (lane & 31);
    const int c_lo = l == 0 ? 0 : 2, ncu = NCH - c_lo;
    MLAS float* rope = (MLAS float*)(lds + LDS_ROPE);
    for (int i = tid; i < 64 * 32 * 2; i += NT) rope[i] = ((const float*)(a.ws + WS_ROPE))[i];
#define RB_DECODE(u_, b_, c_, h_, row0_) const int b_ = (u_) / (ncu * 4), c_ = c_lo + ((u_) >> 2) % ncu, h_ = (u_) & 3, row0_ = chunk_row0(b_, c_)
#define RB_LOAD(u_) do { RB_DECODE(u_, b_, c_, h_, row0_); (void)c_; _Pragma("unroll") for (int i = 0; i < 2; ++i) { const int idx = tid + i * NT, row = idx >> 3, ch0 = ((idx >> 2) & 1) * 8 + (idx & 3); \
        const bf16_t* src = proj + (size_t)(row0_ + row) * INC + h_ * 128; \
        raw[i][0] = *(const u32x4*)(src + C_QB + ch0 * 8); raw[i][1] = *(const u32x4*)(src + C_QB + (ch0 + 4) * 8); raw[i][2] = *(const u32x4*)(src + C_KB + ch0 * 8); raw[i][3] = *(const u32x4*)(src + C_KB + (ch0 + 4) * 8); \
        raw[i][4] = *(const u32x4*)(src + C_VB + ch0 * 8); raw[i][5] = *(const u32x4*)(src + C_VB + (ch0 + 4) * 8); } } while (0)
    u32x4 raw[2][6];
    if (bid < NB * ncu * 4) RB_LOAD(bid);
    LDS_BARRIER();
    for (int u = bid; u < NB * ncu * 4; u += nb) {
        RB_DECODE(u, b, c, h, row0);
        const float lg = -expf(a.ret_decay[l * 8 + dir * 4 + h]);
        LDS_BARRIER();
#pragma unroll
        for (int i = 0; i < 2; ++i) { const int idx = tid + i * NT, row = idx >> 3, a2 = (idx >> 2) & 1, fc = idx & 3, ch0 = a2 * 8 + fc;
            const int tok = c >= 2 ? (c - 2) * 128 + row : -1;
            const unsigned o0 = off_b(row, ch0), o1 = off_b(row, ch0 + 4);
            float y1[8], y2[8];
            rope_pair_regs(raw[i][0], raw[i][1], a2, fc, tok, rope, y1, y2);
            *(MLAS u32x4*)(lds + o0) = pack8(y1, 1.0f); *(MLAS u32x4*)(lds + o1) = pack8(y2, 1.0f);
            rope_pair_regs(raw[i][2], raw[i][3], a2, fc, tok, rope, y1, y2);
            *(MLAS u32x4*)(lds + 32768 + o0) = pack8(y1, RET_KSCALE); *(MLAS u32x4*)(lds + 32768 + o1) = pack8(y2, RET_KSCALE);
            *(MLAS u32x4*)(lds + 65536 + o0) = raw[i][4]; *(MLAS u32x4*)(lds + 65536 + o1) = raw[i][5]; }
        LDS_BARRIER();
        f32x16 acc[4];
#pragma unroll
        for (int et = 0; et < 4; ++et)
#pragma unroll
            for (int r = 0; r < 16; ++r) acc[et][r] = 0.f;
        {
            const bf16_t* sp = st + st_index(b, h, dir, c) + lane * 16;
#pragma unroll
            for (int dt = 0; dt < 4; ++dt)
#pragma unroll
                for (int s2 = 0; s2 < 2; ++s2) {
                    const u32x2 q0 = *(const MLAS u32x2*)(lds + off_b(il, 4 * dt + 2 * s2) + 8 * hh), q1 = *(const MLAS u32x2*)(lds + off_b(il, 4 * dt + 2 * s2 + 1) + 8 * hh);
                    const bf16x8 Bq = mkfrag(q0, q1);
#pragma unroll
                    for (int et = 0; et < 4; ++et) { const bf16x8 A = __builtin_bit_cast(bf16x8, *(const u32x4*)(sp + (dt * 4 + et) * 1024 + 8 * s2));
                        acc[et] = __builtin_amdgcn_mfma_f32_32x32x16_bf16(A, Bq, acc[et], 0, 0, 0); }
                }
            const float qdec = __expf((float)(dir == 0 ? il + 1 : 128 - il) * lg);
#pragma unroll
            for (int et = 0; et < 4; ++et)
#pragma unroll
                for (int r = 0; r < 16; ++r) acc[et][r] *= qdec;
        }
        bf16x8 Qn[8];
#pragma unroll
        for (int ks = 0; ks < 8; ++ks) Qn[ks] = *(const MLAS bf16x8*)(lds + off_b(il, 2 * ks + hh));
        const int jt_lo = dir == 0 ? 0 : it, jt_hi = dir == 0 ? it : 3;
        for (int jt = jt_lo; jt <= jt_hi; ++jt) {
            f32x16 sc;
#pragma unroll
            for (int r = 0; r < 16; ++r) sc[r] = 0.f;
#pragma unroll
            for (int ks = 0; ks < 8; ++ks) { const bf16x8 A = *(const MLAS bf16x8*)(lds + 32768 + off_b(jt * 32 + (lane & 31), 2 * ks + hh));
                sc = __builtin_amdgcn_mfma_f32_32x32x16_bf16(A, Qn[ks], sc, 0, 0, 0); }
            unsigned pk[8];
#pragma unroll
            for (int r = 0; r < 16; r += 2) {
                const int j0 = jt * 32 + (r & 3) + 8 * (r >> 2) + 4 * hh, j1 = j0 + 1;
                const int d0 = dir == 0 ? il - j0 : j0 - il, d1 = dir == 0 ? il - j1 : j1 - il;
                const float p0 = d0 >= 0 ? sc[r] * __expf((float)d0 * lg) : 0.f, p1 = d1 >= 0 ? sc[r + 1] * __expf((float)d1 * lg) : 0.f;
                pk[r >> 1] = pack2(p0, p1);
            }
            const bf16x8 P0 = __builtin_bit_cast(bf16x8, (u32x4){pk[0], pk[1], pk[2], pk[3]}), P1 = __builtin_bit_cast(bf16x8, (u32x4){pk[4], pk[5], pk[6], pk[7]});
#pragma unroll
            for (int et = 0; et < 4; ++et) {
                u32x2 r0, r1, r2, r3;
                const unsigned a0 = ldsb + 65536 + tr_addr(jt * 32 + 4 * hh, et, lane), a1 = ldsb + 65536 + tr_addr(jt * 32 + 8 + 4 * hh, et, lane);
                const unsigned a2 = ldsb + 65536 + tr_addr(jt * 32 + 16 + 4 * hh, et, lane), a3 = ldsb + 65536 + tr_addr(jt * 32 + 24 + 4 * hh, et, lane);
                asm volatile("ds_read_b64_tr_b16 %0, %4\n\tds_read_b64_tr_b16 %1, %5\n\tds_read_b64_tr_b16 %2, %6\n\tds_read_b64_tr_b16 %3, %7\n\ts_waitcnt lgkmcnt(0)"
                             : "=&v"(r0), "=&v"(r1), "=&v"(r2), "=&v"(r3) : "v"(a0), "v"(a1), "v"(a2), "v"(a3) : "memory");
                acc[et] = __builtin_amdgcn_mfma_f32_32x32x16_bf16(mkfrag(r0, r1), P0, acc[et], 0, 0, 0);
                acc[et] = __builtin_amdgcn_mfma_f32_32x32x16_bf16(mkfrag(r2, r3), P1, acc[et], 0, 0, 0);
            }
        }
        u32x4 gfr[4], gbr[4];
        { const bf16_t* gp = proj + (size_t)(row0 + (tid >> 2)) * INC + h * 128;
#pragma unroll
          for (int k = 0; k < 4; ++k) { const int ch = (tid & 3) * 4 + k; gfr[k] = *(const u32x4*)(gp + C_GF + ch * 8); gbr[k] = *(const u32x4*)(gp + C_GB + ch * 8); } }
        float s1 = 0.f;
#pragma unroll
        for (int et = 0; et < 4; ++et)
#pragma unroll
            for (int r = 0; r < 16; ++r) s1 += acc[et][r];
        s1 += __shfl_xor(s1, 32);
        const float mean = s1 * (1.0f / 128.0f);
        float s2 = 0.f;
#pragma unroll
        for (int et = 0; et < 4; ++et)
#pragma unroll
            for (int r = 0; r < 16; ++r) { const float dlt = acc[et][r] - mean; s2 += dlt * dlt; }
        s2 += __shfl_xor(s2, 32);
        const float rstd = rsqrtf(s2 * (1.0f / 128.0f) + 1e-5f);
        LDS_BARRIER();
#pragma unroll
        for (int et = 0; et < 4; ++et)
#pragma unroll
            for (int g = 0; g < 4; ++g) {
                const u32x2 w = {pack2((acc[et][4 * g] - mean) * rstd, (acc[et][4 * g + 1] - mean) * rstd), pack2((acc[et][4 * g + 2] - mean) * rstd, (acc[et][4 * g + 3] - mean) * rstd)};
                *(MLAS u32x2*)(lds + dir * 32768 + off_b(il, 4 * et + g) + 8 * hh) = w; }
        { const int un_ = u + nb < NB * ncu * 4 ? u + nb : u; RB_LOAD(un_); }
        LDS_BARRIER();
        {
            const int i = tid >> 2, part = tid & 3;
            bf16_t* op = mix + (size_t)(row0 + i) * D + 512 + h * 128;
#pragma unroll
            for (int k = 0; k < 4; ++k) { const int ch = part * 4 + k;
                const u32x4 of = *(const MLAS u32x4*)(lds + off_b(i, ch)), ob = *(const MLAS u32x4*)(lds + 32768 + off_b(i, ch));
                const u32x4 gf = gfr[k], gb = gbr[k];
                u32x4 o;
#pragma unroll
                for (int t = 0; t < 4; ++t) o[t] = pack2(lo16(of[t]) * siluf(lo16(gf[t])) + lo16(ob[t]) * siluf(lo16(gb[t])), hi16(of[t]) * siluf(hi16(gf[t])) + hi16(ob[t]) * siluf(hi16(gb[t])));
                *(u32x4*)(op + ch * 8) = o; }
        }
    }
#undef RB_DECODE
#undef RB_LOAD
}

constexpr int NA_OP = 72;
__device__ __forceinline__ int perm16(int x) { return (x & 3) | ((x & 4) << 1) | ((x & 8) >> 1); }
__device__ __forceinline__ void phase_na(const Args& a, int l, MLAS unsigned char* lds, int bid, int nb) {
    const int tid = otid(), lane = tid & 63, wave = __builtin_amdgcn_readfirstlane(tid >> 6);
    const bf16_t* proj = (const bf16_t*)(a.ws + WS_PROJ); bf16_t* mix = (bf16_t*)(a.ws + WS_H);
    const bf16_t* KC = (const bf16_t*)(a.ws + WS_KC); const bf16_t* VT = (const bf16_t*)(a.ws + WS_VT);
    const bf16_t* KCC = (const bf16_t*)(a.ws + WS_KCC); const bf16_t* VTC = (const bf16_t*)(a.ws + WS_VTC);
    MLAS float* rpb = (MLAS float*)lds;
    MLAS bf16_t* ost = (MLAS bf16_t*)(lds + 8192) + wave * 64 * NA_OP;
    const int n_lat = NB * 8 * 8, n_ctx = l == 0 ? NB * 4 : 0;
    const int hh = lane >> 5, ql = lane & 31;
    for (int u0 = bid; u0 < n_lat + n_ctx; u0 += nb) {
        int u = u0;
        if (nb == 256 && u0 < n_lat) { const int x = bid & 7, j = bid >> 3, i = u0 >> 8; u = ((i * 32 + x * 4 + (j >> 3)) << 3) + (j & 7); }
        const bool is_ctx = u >= n_lat;
        const int v = is_ctx ? u - n_lat : u;
        const int b = is_ctx ? v >> 2 : v >> 6, h = is_ctx ? 2 * (v & 3) + (wave >> 2) : (v >> 3) & 7;
        const int r = (v & 7) * 8 + wave;
        const int qrow0 = is_ctx ? TL + b * LC + (wave & 3) * 64 : b * SEQ + r * 64;
        const size_t bh = (size_t)b * 8 + h;
        __syncthreads();
        if (!is_ctx) for (int i = tid; i < 15 * 128; i += NT) { const int dr = i >> 7, x = (i & 127) - 48; rpb[i] = (x >= 0 && x < 31) ? a.na_rpb[((size_t)l * 8 + h) * 465 + dr * 31 + x] * 1.4426950408889634f : 0.f; }
        __syncthreads();
        bf16x8 Qf[2][4];
#pragma unroll
        for (int qt = 0; qt < 2; ++qt) {
            u32x4 qw[4]; float ss = 0.f;
#pragma unroll
            for (int ks = 0; ks < 4; ++ks) { qw[ks] = *(const u32x4*)(proj + (size_t)(qrow0 + 32 * qt + ql) * INC + C_QA + h * 64 + 16 * ks + 8 * hh);
#pragma unroll
                for (int t = 0; t < 4; ++t) { const float x0 = lo16(qw[ks][t]), x1 = hi16(qw[ks][t]); ss += x0 * x0 + x1 * x1; } }
            ss += __shfl_xor(ss, 32);
            const float rs = rsqrtf(ss * (1.0f / 64.0f) + 1e-6f) * 0.18033688011112042f;
#pragma unroll
            for (int ks = 0; ks < 4; ++ks) { const f32x4 w0 = *(const f32x4*)(a.na_q_norm + l * 64 + 16 * ks + 8 * hh), w1 = *(const f32x4*)(a.na_q_norm + l * 64 + 16 * ks + 8 * hh + 4);
                const u32x4 o = {pack2(lo16(qw[ks][0]) * rs * w0[0], hi16(qw[ks][0]) * rs * w0[1]), pack2(lo16(qw[ks][1]) * rs * w0[2], hi16(qw[ks][1]) * rs * w0[3]),
                                 pack2(lo16(qw[ks][2]) * rs * w1[0], hi16(qw[ks][2]) * rs * w1[1]), pack2(lo16(qw[ks][3]) * rs * w1[2], hi16(qw[ks][3]) * rs * w1[3])};
                Qf[qt][ks] = __builtin_bit_cast(bf16x8, o); }
        }
        f32x16 O[2][2];
#pragma unroll
        for (int qt = 0; qt < 2; ++qt)
#pragma unroll
            for (int i = 0; i < 16; ++i) { O[qt][0][i] = 0.f; O[qt][1][i] = 0.f; }
        float lsum[2] = {0.f, 0.f};
        const int r0 = min(max(r - 4, 0), 56);
        const int kslot = 16 * (ql >> 4) + perm16(ql & 15);
        const bf16_t* kl = KC + (bh * SEQ + (size_t)(r0 + (ql >> 4)) * 64 + perm16(ql & 15)) * 64 + 8 * hh;
        const bf16_t* vl = VT + ((bh * 256 + (size_t)r0 * 4) * 64 + ql) * 16 + 8 * hh;
        const bf16_t* kx = KCC + (bh * LC + kslot) * 64 + 8 * hh;
        const bf16_t* vx = VTC + ((bh * 16) * 64 + ql) * 16 + 8 * hh;
#define NA_PTRS(t, kp, vp, vstep) do { if ((t) < 16) { const int ip_ = (t) >> 2, ct_ = (t) & 3; kp = kl + (size_t)(2 * ip_ * 64 + 16 * ct_) * 64; vp = vl + (2 * ip_ * 4 + ct_) * 1024; vstep = 4096; } \
        else { kp = kx + (size_t)(32 * ((t) - 16)) * 64; vp = vx + ((t) - 16) * 2048; vstep = 1024; } } while (0)
#define NA_LOADS(kp, vp, vstep, Kd, Vd) do { _Pragma("unroll") for (int ks_ = 0; ks_ < 4; ++ks_) Kd[ks_] = *(const u32x4*)(kp + 16 * ks_); \
        Vd[0] = *(const u32x4*)(vp); Vd[1] = *(const u32x4*)(vp + vstep); Vd[2] = *(const u32x4*)(vp + 512); Vd[3] = *(const u32x4*)(vp + 512 + vstep); } while (0)
        const int t_lo = is_ctx ? 16 : 0;
        u32x4 Kn[4], Vn[4];
        { const bf16_t* kp; const bf16_t* vp; int vstep; NA_PTRS(t_lo, kp, vp, vstep); NA_LOADS(kp, vp, vstep, Kn, Vn); }
#pragma unroll 1
        for (int t = t_lo; t < 24; ++t) {
            u32x4 Kc[4], Vc[4];
#pragma unroll
            for (int i = 0; i < 4; ++i) { Kc[i] = Kn[i]; Vc[i] = Vn[i]; }
            if (t + 1 < 24) { const bf16_t* kp; const bf16_t* vp; int vstep; NA_PTRS(t + 1, kp, vp, vstep); NA_LOADS(kp, vp, vstep, Kn, Vn); }
            const int ip = t >> 2, ct = t & 3;
#pragma unroll
            for (int qt = 0; qt < 2; ++qt) {
                if (t < 16 && (unsigned)(ct - qt) > 2u) continue;
                f32x16 sc;
#pragma unroll
                for (int i = 0; i < 16; ++i) sc[i] = 0.f;
#pragma unroll
                for (int ks = 0; ks < 4; ++ks) sc = __builtin_amdgcn_mfma_f32_32x32x16_bf16(__builtin_bit_cast(bf16x8, Kc[ks]), Qf[qt][ks], sc, 0, 0, 0);
                unsigned pk[8];
                if (t < 16) {
                    const int q = qt * 32 + ql, c0 = min(max(q - 8, 0), 48);
#pragma unroll
                    for (int rr = 0; rr < 16; rr += 2) {
                        const int wi = 2 * ip + (rr >> 3), col = 16 * ct + (rr & 3) + 4 * ((rr >> 2) & 1) + 8 * hh;
                        const MLAS float* bp = rpb + (r0 + wi - r + 7) * 128 + (col - q + 63);
                        const float b0 = bp[0], b1 = bp[1];
                        const float e0 = __builtin_amdgcn_exp2f(sc[rr] + b0), e1 = __builtin_amdgcn_exp2f(sc[rr + 1] + b1);
                        const float p0 = (unsigned)(col - c0) < 16u ? e0 : 0.f, p1 = (unsigned)(col + 1 - c0) < 16u ? e1 : 0.f;
                        lsum[qt] += p0 + p1; pk[rr >> 1] = pack2(p0, p1);
                    }
                } else {
#pragma unroll
                    for (int rr = 0; rr < 16; rr += 2) { const float p0 = __builtin_amdgcn_exp2f(sc[rr]), p1 = __builtin_amdgcn_exp2f(sc[rr + 1]); lsum[qt] += p0 + p1; pk[rr >> 1] = pack2(p0, p1); }
                }
                const bf16x8 P0 = __builtin_bit_cast(bf16x8, (u32x4){pk[0], pk[1], pk[2], pk[3]}), P1 = __builtin_bit_cast(bf16x8, (u32x4){pk[4], pk[5], pk[6], pk[7]});
                O[qt][0] = __builtin_amdgcn_mfma_f32_32x32x16_bf16(__builtin_bit_cast(bf16x8, Vc[0]), P0, O[qt][0], 0, 0, 0);
                O[qt][0] = __builtin_amdgcn_mfma_f32_32x32x16_bf16(__builtin_bit_cast(bf16x8, Vc[1]), P1, O[qt][0], 0, 0, 0);
                O[qt][1] = __builtin_amdgcn_mfma_f32_32x32x16_bf16(__builtin_bit_cast(bf16x8, Vc[2]), P0, O[qt][1], 0, 0, 0);
                O[qt][1] = __builtin_amdgcn_mfma_f32_32x32x16_bf16(__builtin_bit_cast(bf16x8, Vc[3]), P1, O[qt][1], 0, 0, 0);
            }
        }
#undef NA_PTRS
#undef NA_LOADS
#pragma unroll
        for (int qt = 0; qt < 2; ++qt) {
            const float inv = 1.0f / (lsum[qt] + __shfl_xor(lsum[qt], 32));
#pragma unroll
            for (int g4 = 0; g4 < 4; ++g4) {
                *(MLAS u32x2*)(ost + (32 * qt + ql) * NA_OP + 8 * g4 + 4 * hh) = (u32x2){pack2(O[qt][0][4 * g4] * inv, O[qt][0][4 * g4 + 1] * inv), pack2(O[qt][0][4 * g4 + 2] * inv, O[qt][0][4 * g4 + 3] * inv)};
                *(MLAS u32x2*)(ost + (32 * qt + ql) * NA_OP + 32 + 8 * g4 + 4 * hh) = (u32x2){pack2(O[qt][1][4 * g4] * inv, O[qt][1][4 * g4 + 1] * inv), pack2(O[qt][1][4 * g4 + 2] * inv, O[qt][1][4 * g4 + 3] * inv)};
            }
        }
#pragma unroll
        for (int k = 0; k < 8; ++k) { const int idx = lane + 64 * k, row = idx >> 3, ch = idx & 7;
            *(u32x4*)(mix + (size_t)(qrow0 + row) * D + h * 64 + ch * 8) = *(const MLAS u32x4*)(ost + row * NA_OP + ch * 8); }
    }
}

constexpr int N2P = 1032;
typedef float f32x4v __attribute__((ext_vector_type(4)));
__device__ __forceinline__ void phase_norm2(const Args& a, int l, MLAS unsigned char* lds, int bid, int nb) {
    const int tid = otid(), lane = tid & 63, wave = __builtin_amdgcn_readfirstlane(tid >> 6);
    const int e0 = lane * 8, e1 = 512 + lane * 8;
    MLAS bf16_t* Ahi = (MLAS bf16_t*)lds; MLAS bf16_t* Alo = Ahi + 16 * N2P; MLAS float* part = (MLAS float*)(Alo + 16 * N2P);
    MLAS float* tsc = part + 8 * 16 * 32; MLAS float* tsh = tsc + 1024; int cur_r = -1;
    bf16_t* hb = (bf16_t*)(a.ws + WS_H);
    int* tok_e = (int*)(a.ws + WS_TOKE); int* tok_r = (int*)(a.ws + WS_TOKR); float* tok_w = (float*)(a.ws + WS_TOKW);
    unsigned* cnt = (unsigned*)(a.ws + WS_CNT) + l * 2048;
    MLAS unsigned* lcnt = (MLAS unsigned*)(tsh + 1024);
    if (tid < NE) lcnt[tid] = 0u;
    const int nrows = l == 0 ? TT : TL;
    bf16x8 Bh[4][2], Bl[4][2];
    { const bf16_t* rh = (const bf16_t*)(a.ws + WS_RWT); const bf16_t* rl = rh + 32 * 1024;
#pragma unroll
      for (int ks = 0; ks < 4; ++ks)
#pragma unroll
        for (int nt = 0; nt < 2; ++nt) { const int o = (nt * 16 + (lane & 15)) * 1024 + 128 * wave + 32 * ks + 8 * (lane >> 4);
            Bh[ks][nt] = __builtin_bit_cast(bf16x8, *(const u32x4*)(rh + o)); Bl[ks][nt] = __builtin_bit_cast(bf16x8, *(const u32x4*)(rl + o)); } }
    const float rbias = a.router_bias[lane & 31];
#define N2_BAR() do { asm volatile("s_waitcnt lgkmcnt(0)" ::: "memory"); __builtin_amdgcn_s_barrier(); asm volatile("" ::: "memory"); } while (0)
#define N2_LOAD(bt, dst) do { _Pragma("unroll") for (int jr_ = 0; jr_ < 2; ++jr_) { const int row_ = (bt) * 16 + 2 * wave + jr_; \
        if (row_ < TL) { const bf16_t* sb_ = (const bf16_t*)(a.ws + WS_XB) + (size_t)row_ * D; dst[jr_][0] = __builtin_bit_cast(f32x4, *(const u32x4*)(sb_ + e0)); dst[jr_][1] = __builtin_bit_cast(f32x4, *(const u32x4*)(sb_ + e1)); } \
        else { const float* src_ = (const float*)(a.ws + WS_CTX) + (size_t)(row_ - TL) * D; \
        dst[jr_][0] = *(const f32x4*)(src_ + e0); dst[jr_][1] = *(const f32x4*)(src_ + e0 + 4); dst[jr_][2] = *(const f32x4*)(src_ + e1); dst[jr_][3] = *(const f32x4*)(src_ + e1 + 4); } } } while (0)
    f32x4 vc[2][4];
    const int nbatch = nrows / 16;
    const int per = (nbatch + nb - 1) / nb, b_lo = bid * per, b_hi = min(b_lo + per, nbatch);
    if (b_lo < b_hi) N2_LOAD(b_lo, vc);
    for (int batch = b_lo; batch < b_hi; ++batch) {
        const int R0 = batch * 16, r = R0 < TL ? R0 / SEQ : 16;
        N2_BAR();
        if (r != cur_r) { cur_r = r; const float* sh = modp(a, l, r, 3); const float* sc = modp(a, l, r, 4); const float* w = a.norm_ffn_w + l * D;
            for (int k = tid; k < D; k += NT) { tsc[k] = (1.0f + sc[k]) * w[k]; tsh[k] = sh[k]; }
            N2_BAR(); }
#pragma unroll
        for (int jr = 0; jr < 2; ++jr) {
            const int m = 2 * wave + jr, row = R0 + m;
            float v[16];
            if (R0 < TL) { const u32x4 w0 = __builtin_bit_cast(u32x4, vc[jr][0]), w1 = __builtin_bit_cast(u32x4, vc[jr][1]);
#pragma unroll
                for (int j = 0; j < 4; ++j) { v[2 * j] = lo16(w0[j]); v[2 * j + 1] = hi16(w0[j]); v[8 + 2 * j] = lo16(w1[j]); v[8 + 2 * j + 1] = hi16(w1[j]); } }
            else {
#pragma unroll
                for (int j = 0; j < 4; ++j) { v[j] = vc[jr][0][j]; v[4 + j] = vc[jr][1][j]; v[8 + j] = vc[jr][2][j]; v[12 + j] = vc[jr][3][j]; } }
            float ss = 0.f;
#pragma unroll
            for (int j = 0; j < 16; ++j) ss += v[j] * v[j];
            ss = wave_sum(ss);
            const float rs = rsqrtf(ss * (1.0f / D) + 1e-6f);
            unsigned ph[8], pl[8];
            float msc[16], msh[16];
#pragma unroll
            for (int q = 0; q < 2; ++q) { const f32x4 c0 = *(const MLAS f32x4*)(tsc + e0 + 4 * q), c1 = *(const MLAS f32x4*)(tsc + e1 + 4 * q), h0 = *(const MLAS f32x4*)(tsh + e0 + 4 * q), h1 = *(const MLAS f32x4*)(tsh + e1 + 4 * q);
#pragma unroll
                for (int j = 0; j < 4; ++j) { msc[4 * q + j] = c0[j]; msc[8 + 4 * q + j] = c1[j]; msh[4 * q + j] = h0[j]; msh[8 + 4 * q + j] = h1[j]; } }
#pragma unroll
            for (int j = 0; j < 16; j += 2) {
                const float y0 = v[j] * rs * msc[j] + msh[j], y1 = v[j + 1] * rs * msc[j + 1] + msh[j + 1];
                const bf16_t h0 = f2bf(y0), h1 = f2bf(y1);
                ph[j >> 1] = (unsigned)h0 | ((unsigned)h1 << 16); pl[j >> 1] = pack2(y0 - bf2f(h0), y1 - bf2f(h1)); }
            bf16_t* hp = hb + (size_t)row * D;
            *(u32x4*)(hp + e0) = (u32x4){ph[0], ph[1], ph[2], ph[3]}; *(u32x4*)(hp + e1) = (u32x4){ph[4], ph[5], ph[6], ph[7]};
            *(MLAS u32x4*)(Ahi + m * N2P + e0) = (u32x4){ph[0], ph[1], ph[2], ph[3]}; *(MLAS u32x4*)(Ahi + m * N2P + e1) = (u32x4){ph[4], ph[5], ph[6], ph[7]};
            *(MLAS u32x4*)(Alo + m * N2P + e0) = (u32x4){pl[0], pl[1], pl[2], pl[3]}; *(MLAS u32x4*)(Alo + m * N2P + e1) = (u32x4){pl[4], pl[5], pl[6], pl[7]};
        }
        if (batch + 1 < b_hi) N2_LOAD(batch + 1, vc);
        N2_BAR();
        {
            f32x4v acc0 = {0.f, 0.f, 0.f, 0.f}, acc1 = {0.f, 0.f, 0.f, 0.f};
#pragma unroll
            for (int ks = 0; ks < 4; ++ks) {
                const int o = (lane & 15) * N2P + 128 * wave + 32 * ks + 8 * (lane >> 4);
                const bf16x8 ah = *(const MLAS bf16x8*)(Ahi + o), al = *(const MLAS bf16x8*)(Alo + o);
                acc0 = __builtin_amdgcn_mfma_f32_16x16x32_bf16(ah, Bh[ks][0], acc0, 0, 0, 0); acc0 = __builtin_amdgcn_mfma_f32_16x16x32_bf16(al, Bh[ks][0], acc0, 0, 0, 0); acc0 = __builtin_amdgcn_mfma_f32_16x16x32_bf16(ah, Bl[ks][0], acc0, 0, 0, 0);
                acc1 = __builtin_amdgcn_mfma_f32_16x16x32_bf16(ah, Bh[ks][1], acc1, 0, 0, 0); acc1 = __builtin_amdgcn_mfma_f32_16x16x32_bf16(al, Bh[ks][1], acc1, 0, 0, 0); acc1 = __builtin_amdgcn_mfma_f32_16x16x32_bf16(ah, Bl[ks][1], acc1, 0, 0, 0);
            }
#pragma unroll
            for (int rg = 0; rg < 4; ++rg) { const int m = 4 * (lane >> 4) + rg; part[(wave * 16 + m) * 32 + (lane & 15)] = acc0[rg]; part[(wave * 16 + m) * 32 + 16 + (lane & 15)] = acc1[rg]; }
        }
        N2_BAR();
        {
            const int m = tid >> 5, ex = tid & 31, hb32 = lane & 32, row = R0 + m;
            float acc = 0.f;
#pragma unroll
            for (int w8 = 0; w8 < 8; ++w8) acc += part[(w8 * 16 + m) * 32 + ex];
            const float sg = 1.0f / (1.0f + __expf(-acc)), ssel = sg + rbias;
            float best = -1e30f; int grp = 0;
#pragma unroll
            for (int g = 0; g < 8; ++g) {
                const float v0 = __shfl(ssel, hb32 + g * 4), v1 = __shfl(ssel, hb32 + g * 4 + 1), v2 = __shfl(ssel, hb32 + g * 4 + 2), v3 = __shfl(ssel, hb32 + g * 4 + 3);
                const float hi01 = fmaxf(v0, v1), lo01 = fminf(v0, v1), hi23 = fmaxf(v2, v3), lo23 = fminf(v2, v3);
                const float top = fmaxf(hi01, hi23), second = fmaxf(fminf(hi01, hi23), hi01 >= hi23 ? lo01 : lo23);
                const float gs = top + second;
                if (gs > best) { best = gs; grp = g; }
            }
            float w4[4], s4[4];
#pragma unroll
            for (int j = 0; j < 4; ++j) { w4[j] = __shfl(ssel, hb32 + grp * 4 + j); s4[j] = __shfl(sg, hb32 + grp * 4 + j); }
            int i0 = 0;
#pragma unroll
            for (int j = 1; j < 4; ++j) if (w4[j] > w4[i0]) i0 = j;
            int i1 = i0 == 0 ? 1 : 0;
#pragma unroll
            for (int j = 0; j < 4; ++j) if (j != i0 && j != i1 && w4[j] > w4[i1]) i1 = j;
            float g0 = 0.f, g1 = 0.f;
#pragma unroll
            for (int j = 0; j < 4; ++j) { g0 = (j == i0) ? s4[j] : g0; g1 = (j == i1) ? s4[j] : g1; }
            const float inv = 1.0f / (g0 + g1);
            if (ex < 2) {
                const int e = grp * 4 + (ex == 0 ? i0 : i1);
                const unsigned rank = __hip_atomic_fetch_add(lcnt + e, 1u, __ATOMIC_RELAXED, __HIP_MEMORY_SCOPE_WORKGROUP);
                tok_e[row * 2 + ex] = e; tok_r[row * 2 + ex] = (int)rank; tok_w[row * 2 + ex] = (ex == 0 ? g0 : g1) * inv;
            }
        }
    }
    N2_BAR();
    if (tid < NE) ((int*)(a.ws + WS_BLKB))[bid * NE + tid] = (int)atomicAdd(cnt + tid * 32, lcnt[tid]);
#undef N2_BAR
#undef N2_LOAD
}
__device__ __forceinline__ void phase_gather(const Args& a, int l, MLAS unsigned char* lds, int bid, int nb) {
    const int tid = otid(), lane = tid & 63, wave = tid >> 6;
    MLAS int* pbase = (MLAS int*)lds;
    MLAS int* cn = pbase + 64;
    const unsigned* cnt = (const unsigned*)(a.ws + WS_CNT) + l * 2048; const int* blkb = (const int*)(a.ws + WS_BLKB);
    if (tid == 0) { int acc = 0; for (int e = 0; e < NE; ++e) { const int c = (int)__hip_atomic_load(cnt + e * 32, __ATOMIC_RELAXED, __HIP_MEMORY_SCOPE_AGENT); cn[e] = c; pbase[e] = acc; acc += (c + 255) & ~255; } pbase[NE] = acc; }
    __syncthreads();
    int* rinfo = (int*)(a.ws + WS_RINFO); float* rw = (float*)(a.ws + WS_RW); int* blke = (int*)(a.ws + WS_BLKE);
    if (bid == 0) {
        for (int e = 0; e < NE; ++e) {
            for (int p = pbase[e] + cn[e] + tid; p < pbase[e + 1]; p += NT) { rinfo[p] = -1; rw[p] = 0.f; }
            for (int blk = (pbase[e] >> 8) + tid; blk < (pbase[e + 1] >> 8); blk += NT) blke[blk] = e;
        }
        if (tid == 0) blke[1023] = (pbase[NE] >> 8) * 4;
    }
    const int* tok_e = (const int*)(a.ws + WS_TOKE); const int* tok_r = (const int*)(a.ws + WS_TOKR); const float* tok_w = (const float*)(a.ws + WS_TOKW);
    const int nas = (l == 0 ? TT : TL) * 2, per_ = ((l == 0 ? TT : TL) / 16 + nb - 1) / nb;
    for (int as = bid * NT + tid; as < nas; as += nb * NT) {
        const int t = as >> 1, e = tok_e[as], pos = pbase[e] + blkb[((t >> 4) / per_) * NE + e] + tok_r[as];
        rinfo[pos] = as; ((int*)(a.ws + WS_TOKR))[as] = pos;
    }
}

using pg8::Unit;
struct EpiStoreBf16 {
    static constexpr bool PERM = true, AFTER_DRAIN = false;
    bf16_t* O; int ldc; bf16_t* kc_lat; bf16_t* vt_lat; bf16_t* kc_ctx; bf16_t* vt_ctx; const float* knw; MLAS unsigned char* sp;
    __device__ __forceinline__ void operator()(const f32x4 (&acc)[2][2][4][2], const Unit& u, int wr, int wc, int fr, int fq) const {
        const int row0 = u.pm * 256 + wr * 64 + fr;
        if (u.pn < 2 || u.pn > 5) {
            const int col0 = u.pn * 256 + wc * 32 + 8 * fq;
#pragma unroll
            for (int ai = 0; ai < 2; ++ai)
#pragma unroll
                for (int m = 0; m < 4; ++m) { bf16_t* rowp = O + (size_t)(row0 + ai * 128 + m * 16) * ldc + col0;
#pragma unroll
                    for (int bj = 0; bj < 2; ++bj) { const f32x4 v0 = acc[ai][bj][m][0], v1 = acc[ai][bj][m][1];
                        *(u32x4*)(rowp + bj * 128) = (u32x4){pg8::cvt_pk_bf16(v0[0], v0[1]), pg8::cvt_pk_bf16(v0[2], v0[3]), pg8::cvt_pk_bf16(v1[0], v1[1]), pg8::cvt_pk_bf16(v1[2], v1[3])}; } }
            return;
        }
        const bool lat = u.pm < 256;
        if (u.pn < 4) {
            MLAS float* part = (MLAS float*)sp;
            float ss[2][4][2];
#pragma unroll
            for (int ai = 0; ai < 2; ++ai)
#pragma unroll
                for (int m = 0; m < 4; ++m)
#pragma unroll
                    for (int bj = 0; bj < 2; ++bj) { const f32x4 v0 = acc[ai][bj][m][0], v1 = acc[ai][bj][m][1];
                        float q = (v0[0] * v0[0] + v0[1] * v0[1]) + (v0[2] * v0[2] + v0[3] * v0[3]) + (v1[0] * v1[0] + v1[1] * v1[1]) + (v1[2] * v1[2] + v1[3] * v1[3]);
                        q += __shfl_xor(q, 16); q += __shfl_xor(q, 32); ss[ai][m][bj] = q;
                        if (fq == 0) part[((((ai * 4 + m) * 2 + bj) * 2 + wr) * 16 + fr) * 4 + wc] = q; }
            asm volatile("s_waitcnt lgkmcnt(0)" ::: "memory"); __builtin_amdgcn_s_barrier(); asm volatile("" ::: "memory");
            const f32x4 w0 = *(const f32x4*)(knw + (wc & 1) * 32 + 8 * fq), w1 = *(const f32x4*)(knw + (wc & 1) * 32 + 8 * fq + 4);
#pragma unroll
            for (int ai = 0; ai < 2; ++ai)
#pragma unroll
                for (int m = 0; m < 4; ++m) { const int row = row0 + ai * 128 + m * 16;
                    const int b = lat ? row >> 12 : (row - TL) >> 8, t = lat ? row & (SEQ - 1) : (row - TL) & (LC - 1), tlen = lat ? SEQ : LC;
                    bf16_t* kb = (lat ? kc_lat : kc_ctx);
#pragma unroll
                    for (int bj = 0; bj < 2; ++bj) {
                        const float other = part[((((ai * 4 + m) * 2 + bj) * 2 + wr) * 16 + fr) * 4 + (wc ^ 1)];
                        const float rs = rsqrtf((ss[ai][m][bj] + other) * (1.0f / 64.0f) + 1e-6f);
                        const f32x4 v0 = acc[ai][bj][m][0] * rs * w0, v1 = acc[ai][bj][m][1] * rs * w1;
                        const int head = (u.pn - 2) * 4 + 2 * bj + (wc >> 1);
                        *(u32x4*)(kb + (((size_t)b * 8 + head) * tlen + t) * 64 + (wc & 1) * 32 + 8 * fq) = (u32x4){pg8::cvt_pk_bf16(v0[0], v0[1]), pg8::cvt_pk_bf16(v0[2], v0[3]), pg8::cvt_pk_bf16(v1[0], v1[1]), pg8::cvt_pk_bf16(v1[2], v1[3])}; } }
            return;
        }
        {
            MLAS bf16_t* gb = (MLAS bf16_t*)(sp + wr * 8192);
            bf16_t* vb = lat ? vt_lat : vt_ctx; const int ngrp = lat ? SEQ / 16 : LC / 16;
#pragma unroll
            for (int ai = 0; ai < 2; ++ai)
#pragma unroll
                for (int m = 0; m < 4; ++m) {
#pragma unroll
                    for (int bj = 0; bj < 2; ++bj)
#pragma unroll
                        for (int n = 0; n < 2; ++n) { const f32x4 v = acc[ai][bj][m][n]; const int c = bj * 128 + wc * 32 + 8 * fq + 4 * n;
                            const unsigned p01 = pg8::cvt_pk_bf16(v[0], v[1]), p23 = pg8::cvt_pk_bf16(v[2], v[3]);
                            gb[(c + 0) * 16 + fr] = (bf16_t)(p01 & 0xffffu); gb[(c + 1) * 16 + fr] = (bf16_t)(p01 >> 16);
                            gb[(c + 2) * 16 + fr] = (bf16_t)(p23 & 0xffffu); gb[(c + 3) * 16 + fr] = (bf16_t)(p23 >> 16); }
                    asm volatile("s_waitcnt lgkmcnt(0)" ::: "memory"); __builtin_amdgcn_s_barrier(); asm volatile("" ::: "memory");
                    const int rowb = u.pm * 256 + ai * 128 + wr * 64 + m * 16;
                    const int b = lat ? rowb >> 12 : (rowb - TL) >> 8, g16 = (lat ? rowb & (SEQ - 1) : (rowb - TL) & (LC - 1)) >> 4;
#pragma unroll
                    for (int k = 0; k < 2; ++k) { const int qd = wc * 64 + fr + 16 * fq + 256 * k, c = qd >> 1, half = qd & 1;
                        const u32x4 w = *(const MLAS u32x4*)(gb + c * 16 + 8 * half);
                        const int head = (u.pn - 4) * 4 + (c >> 6), d = c & 63;
                        *(u32x4*)(vb + ((((size_t)b * 8 + head) * ngrp + g16) * 64 + d) * 16 + 8 * half) = w; }
                    asm volatile("s_waitcnt lgkmcnt(0)" ::: "memory"); __builtin_amdgcn_s_barrier(); asm volatile("" ::: "memory");
                }
        }
    }
};
struct EpiResGate {
    static constexpr bool PERM = true, AFTER_DRAIN = false;
    const void* xin_lat; const float* xin_ctx; bf16_t* out_lat; float* out_ctx; const float* modl; int in_bf16;
    __device__ __forceinline__ void operator()(const f32x4 (&acc)[2][2][4][2], const Unit& u, int wr, int wc, int fr, int fq) const {
        const bool lat = u.pm < 256; const int r = lat ? (u.pm >> 4) : 16;
        const int rowt = (lat ? u.pm : u.pm - 256) * 256 + wr * 64 + fr, col0 = u.pn * 256 + wc * 32 + 8 * fq;
        const float* g = modl + (size_t)r * 6144 + 2 * 1024 + col0;
        f32x4 gv[2][2];
#pragma unroll
        for (int bj = 0; bj < 2; ++bj)
#pragma unroll
            for (int n = 0; n < 2; ++n) gv[bj][n] = *(const f32x4*)(g + bj * 128 + 4 * n);
#pragma unroll
        for (int ai = 0; ai < 2; ++ai)
#pragma unroll
            for (int m = 0; m < 4; ++m) { const size_t off = (size_t)(rowt + ai * 128 + m * 16) * D + col0;
#pragma unroll
                for (int bj = 0; bj < 2; ++bj) {
                    f32x4 x0, x1;
                    if (!lat) { x0 = *(const f32x4*)(xin_ctx + off + bj * 128); x1 = *(const f32x4*)(xin_ctx + off + bj * 128 + 4); }
                    else if (in_bf16) { const u32x4 w = *(const u32x4*)((const bf16_t*)xin_lat + off + bj * 128); x0 = (f32x4){lo16(w.x), hi16(w.x), lo16(w.y), hi16(w.y)}; x1 = (f32x4){lo16(w.z), hi16(w.z), lo16(w.w), hi16(w.w)}; }
                    else { x0 = *(const f32x4*)((const float*)xin_lat + off + bj * 128); x1 = *(const f32x4*)((const float*)xin_lat + off + bj * 128 + 4); }
                    x0 += gv[bj][0] * acc[ai][bj][m][0]; x1 += gv[bj][1] * acc[ai][bj][m][1];
                    if (lat) *(u32x4*)(out_lat + off + bj * 128) = (u32x4){pack2(x0[0], x0[1]), pack2(x0[2], x0[3]), pack2(x1[0], x1[1]), pack2(x1[2], x1[3])};
                    else { *(f32x4*)(out_ctx + off + bj * 128) = x0; *(f32x4*)(out_ctx + off + bj * 128 + 4) = x1; } } }
    }
};
struct EpiSwiglu {
    static constexpr bool PERM = true, AFTER_DRAIN = false;
    bf16_t* act;
    __device__ __forceinline__ void operator()(const f32x4 (&acc)[2][2][4][2], const Unit& u, int wr, int wc, int fr, int fq) const {
        const int row0 = u.pm * 256 + wr * 64 + fr, col0 = (u.pn & 3) * 128 + wc * 32 + 8 * fq;
#pragma unroll
        for (int ai = 0; ai < 2; ++ai)
#pragma unroll
            for (int m = 0; m < 4; ++m) { float r[8];
#pragma unroll
                for (int n = 0; n < 2; ++n)
#pragma unroll
                    for (int j = 0; j < 4; ++j) { const float gt = acc[ai][0][m][n][j]; r[n * 4 + j] = siluf(gt) * acc[ai][1][m][n][j]; }
                *(u32x4*)(act + (size_t)(row0 + ai * 128 + m * 16) * DFF + col0) = (u32x4){pg8::cvt_pk_bf16(r[0], r[1]), pg8::cvt_pk_bf16(r[2], r[3]), pg8::cvt_pk_bf16(r[4], r[5]), pg8::cvt_pk_bf16(r[6], r[7])}; }
    }
};
struct EpiDown {
    static constexpr bool PERM = true, AFTER_DRAIN = false;
    bf16_t* ys;
    __device__ __forceinline__ void operator()(const f32x4 (&acc)[2][2][4][2], const Unit& u, int wr, int wc, int fr, int fq) const {
        const int row0 = u.pm * 256 + wr * 64 + fr, col0 = (u.pn & 3) * 256 + wc * 32 + 8 * fq;
#pragma unroll
        for (int ai = 0; ai < 2; ++ai)
#pragma unroll
            for (int m = 0; m < 4; ++m) { bf16_t* rowp = ys + (size_t)(row0 + ai * 128 + m * 16) * D + col0;
#pragma unroll
                for (int bj = 0; bj < 2; ++bj) { const f32x4 v0 = acc[ai][bj][m][0], v1 = acc[ai][bj][m][1];
                    *(u32x4*)(rowp + bj * 128) = (u32x4){pg8::cvt_pk_bf16(v0[0], v0[1]), pg8::cvt_pk_bf16(v0[2], v0[3]), pg8::cvt_pk_bf16(v1[0], v1[1]), pg8::cvt_pk_bf16(v1[2], v1[3])}; } }
    }
};
struct MoeOrder {
    const MLAS int* blke; int nunits, G, c;
    __device__ __forceinline__ bool next(int i, Unit& u) const { const int x = c & 7, j = c >> 3; int L;
        if (G == 256) { const int rb = i * 64 + (j >> 2) * 8 + x; L = rb * 4 + (j & 3); } else L = i * G + c;
        if (L >= nunits) return false; u.pm = L >> 2; u.pn = blke[L >> 2] * 4 + (L & 3); return true; }
    __device__ __forceinline__ void a_ready(const Unit&) const {}
    __device__ __forceinline__ void done(const Unit&) const {}
};

typedef const Args __attribute__((address_space(4))) CArgs;
#define MK_LOAD_ARGS(a, p) do { (a).x = (p)->x; (a).c = (p)->c; (a).ctx = (p)->ctx; (a).c_ctx = (p)->c_ctx; (a).ada_w = (p)->ada_w; (a).ada_b = (p)->ada_b; (a).norm_mix_w = (p)->norm_mix_w; (a).norm_ffn_w = (p)->norm_ffn_w; (a).w_in = (p)->w_in; (a).na_q_norm = (p)->na_q_norm; (a).na_k_norm = (p)->na_k_norm; (a).na_rpb = (p)->na_rpb; (a).ret_decay = (p)->ret_decay; (a).w_out = (p)->w_out; (a).router_w = (p)->router_w; (a).router_bias = (p)->router_bias; (a).w_gate = (p)->w_gate; (a).w_up = (p)->w_up; (a).w_down = (p)->w_down; (a).out = (p)->out; (a).ws = (p)->ws; (a).ph_lo = (p)->ph_lo; (a).ph_hi = (p)->ph_hi; } while (0)
#ifndef MK_SINGLE
#define MK_SINGLE 1
#endif
constexpr int NPHASES = 24;
#ifndef MK_PROBE_MASK
#define MK_PROBE_MASK 0
#endif
#ifndef MK_BAR2
#define MK_BAR2 0
#endif
#ifndef MK_PROBE_MULT
#define MK_PROBE_MULT 4
#endif
enum { K_PRO = 0, K_NORM1, K_GEMM_IN, K_PREP, K_NA, K_RET_A, K_SCAN, K_RET_B, K_GEMM_OUT, K_NORM2, K_GATHER, K_MOE1, K_MOE2, K_FINAL };
__global__ void __launch_bounds__(NT, 2) fwd(Args ka) {
    extern __shared__ __attribute__((aligned(16))) unsigned char lds_raw[];
    MLAS unsigned char* lds = (MLAS unsigned char*)lds_raw;
    const int tid = threadIdx.x, nb = gridDim.x;
    volatile MLAS unsigned* ctl = (volatile MLAS unsigned*)(lds + LDS_CTL);
    if (tid < 4) ctl[tid] = 0u;
    __syncthreads();
    const bool multi = MK_SINGLE != 0;
    XcdBarrier bar; bar.bar = (unsigned*)(ka.ws + WS_BAR); bar.x = 0; bar.st = ctl;
    if (multi) bar = xcd_barrier_post((unsigned*)(ka.ws + WS_BAR), ctl);
    int ph = 0;
#if MK_SINGLE
#define MK_GUARD 1
#define MK_SEAM(kind) ((kind) != K_FINAL)
#else
#define MK_GUARD (ph >= ka.ph_lo && ph < ka.ph_hi)
#define MK_SEAM(kind) (ph + 1 < ka.ph_hi)
#endif
#define PHASE(kind, ...) do { if (MK_GUARD) { CArgs* ap_ = (CArgs*)__builtin_amdgcn_kernarg_segment_ptr(); asm volatile("" : "+s"(ap_)); Args a; MK_LOAD_ARGS(a, ap_); int bid = blockIdx.x; asm volatile("" : "+s"(bid)); unsigned long long t0_ = 0; if ((MK_PROBE_MASK >> (kind)) & 1) t0_ = wall_clock64(); { __VA_ARGS__; } if ((MK_PROBE_MASK >> (kind)) & 1) { const unsigned long long d_ = wall_clock64() - t0_; while (wall_clock64() - t0_ < d_ * (MK_PROBE_MULT + 1)) __builtin_amdgcn_s_sleep(8); } if (MK_SEAM(kind)) { XcdBarrier b_ = bar; asm volatile("" : "+s"(b_.bar), "+s"(b_.x)); xcd_barrier(b_); if (MK_BAR2) { xcd_barrier(b_); xcd_barrier(b_); } } } ++ph; } while (0)
    PHASE(K_PRO, { convert_small(a, bid, nb); convert_weights(a, true, 0, lds, bid, nb, 0, 2560 + 3 * 4096, wgu_of(a, 0), wdn_of(a, 0)); compute_mod(a, lds, bid, nb); });
#define MK_LAYER(l) do { \
        PHASE(K_NORM1, { phase_norm1(a, l, bid, nb); if (l == 1) convert_weights(a, false, 1, lds, bid, nb, cv_nbub(nb), 3 * 4096, wgu_of(a, 1), wdn_of(a, 1)); }); \
        PHASE(K_GEMM_IN, { pg8::Gemm g{(const bf16_t*)(a.ws + WS_H), (const bf16_t*)(a.ws + WS_WIN) + (size_t)l * INC * D, TT, INC, D}; \
                pg8::StaticOrder S; S.init(TT, INC, nb, bid); \
                EpiStoreBf16 E{(bf16_t*)(a.ws + WS_PROJ), INC, (bf16_t*)(a.ws + WS_KC), (bf16_t*)(a.ws + WS_VT), (bf16_t*)(a.ws + WS_KCC), (bf16_t*)(a.ws + WS_VTC), a.na_k_norm + l * 64, lds + 131072}; \
                pg8::gemm_phase<EpiStoreBf16, pg8::StaticOrder>(lds, g, S, E, nullptr); }); \
        PHASE(K_NA, phase_na(a, l, lds, bid, nb)); \
        PHASE(K_RET_A, phase_ret_a(a, l, lds, bid, nb)); \
        PHASE(K_SCAN, phase_scan(a, l, bid, nb)); \
        PHASE(K_RET_B, phase_ret_b(a, l, lds, bid, nb)); \
        PHASE(K_GEMM_OUT, { const int M = l == 0 ? TT : TL; \
                pg8::Gemm g{(const bf16_t*)(a.ws + WS_H), (const bf16_t*)(a.ws + WS_WOUT) + (size_t)l * D * D, M, D, D}; \
                pg8::StaticOrder S; S.init(M, D, nb, bid); \
                EpiResGate E{l == 0 ? (const void*)a.x : (const void*)a.out, a.ctx, (bf16_t*)(a.ws + WS_XB), (float*)(a.ws + WS_CTX), (const float*)(a.ws + WS_MOD) + (size_t)l * 17 * 6144, l}; \
                pg8::gemm_phase<EpiResGate, pg8::StaticOrder>(lds, g, S, E, nullptr); \
                if (l == 0 && bid >= cv_rem(nb)) convert_weights(a, false, 1, lds, bid - cv_rem(nb), nb - cv_rem(nb), 0, cv_nbub(nb), wgu_of(a, 1), wdn_of(a, 1)); }); \
        PHASE(K_NORM2, phase_norm2(a, l, lds, bid, nb)); \
        PHASE(K_GATHER, phase_gather(a, l, lds, bid, nb)); \
        PHASE(K_MOE1, { MLAS int* blke = (MLAS int*)(lds + 131072); { const int* gb_ = (const int*)(a.ws + WS_BLKE); for (int i_ = otid(); i_ < 1024; i_ += NT) blke[i_] = gb_[i_]; __syncthreads(); } \
                pg8::Gemm g{(const bf16_t*)(a.ws + WS_H), (const bf16_t*)wgu_of(a, l), PMAX, NE * 1024, D, (const int*)(a.ws + WS_RINFO)}; \
                MoeOrder S{blke, blke[1023], nb, bid}; \
                EpiSwiglu E{(bf16_t*)(a.ws + WS_ACT)}; \
                pg8::gemm_phase<EpiSwiglu, MoeOrder, false, true>(lds, g, S, E, nullptr); }); \
        PHASE(K_MOE2, { MLAS int* blke = (MLAS int*)(lds + 131072); { const int* gb_ = (const int*)(a.ws + WS_BLKE); for (int i_ = otid(); i_ < 1024; i_ += NT) blke[i_] = gb_[i_]; __syncthreads(); } \
                pg8::Gemm g{(const bf16_t*)(a.ws + WS_ACT), (const bf16_t*)wdn_of(a, l), PMAX, NE * 1024, DFF}; \
                MoeOrder S{blke, blke[1023], nb, bid}; \
                EpiDown E{(bf16_t*)(a.ws + WS_XS)}; \
                pg8::gemm_phase<EpiDown, MoeOrder>(lds, g, S, E, nullptr); }); \
    } while (0)
    MK_LAYER(0);
    MK_LAYER(1);
#undef MK_LAYER
    PHASE(K_FINAL, phase_final(a, bid, nb));
#undef PHASE
}
}

extern "C" void kernel_launch(void* const* d_in, const int* in_sizes, int n_in, void* d_out, int out_size, void* d_ws, size_t ws_size, hipStream_t stream) {
    using namespace mk;
    static int grid = 0;
    if (grid == 0) {
        if (n_in != 19 || in_sizes[0] != TL * D || out_size != TL * D || ws_size < WS_END) {
            fprintf(stderr, "kernel_launch: unexpected shapes / workspace (n_in %d, in0 %d, out %d, ws %zu, need %zu); nothing launched\n", n_in, n_in > 0 ? in_sizes[0] : -1, out_size, ws_size, (size_t)WS_END);
            grid = -1; return; }
        int dev = 0, cus = 0, per_cu = 0;
        if (hipGetDevice(&dev) != hipSuccess || hipDeviceGetAttribute(&cus, hipDeviceAttributeMultiprocessorCount, dev) != hipSuccess) { grid = -1; return; }
        if (hipFuncSetAttribute((const void*)fwd, hipFuncAttributeMaxDynamicSharedMemorySize, LDS_BYTES) != hipSuccess) { fprintf(stderr, "kernel_launch: hipFuncSetAttribute failed\n"); grid = -1; return; }
        if (hipOccupancyMaxActiveBlocksPerMultiprocessor(&per_cu, (const void*)fwd, NT, LDS_BYTES) != hipSuccess || per_cu < 1) { fprintf(stderr, "kernel_launch: occupancy query says %d\n", per_cu); (void)hipGetLastError(); grid = -1; return; }
        grid = cus;
    }
    if (grid < 0) return;
    (void)hipMemsetAsync((char*)d_ws + WS_BAR, 0, WS_ZERO_BYTES, stream);
    Args a{};
    a.x = (const float*)d_in[0]; a.c = (const float*)d_in[1]; a.ctx = (const float*)d_in[2]; a.c_ctx = (const float*)d_in[3]; a.ada_w = (const float*)d_in[4]; a.ada_b = (const float*)d_in[5];
    a.norm_mix_w = (const float*)d_in[6]; a.norm_ffn_w = (const float*)d_in[7]; a.w_in = (const float*)d_in[8]; a.na_q_norm = (const float*)d_in[9]; a.na_k_norm = (const float*)d_in[10];
    a.na_rpb = (const float*)d_in[11]; a.ret_decay = (const float*)d_in[12]; a.w_out = (const float*)d_in[13]; a.router_w = (const float*)d_in[14]; a.router_bias = (const float*)d_in[15];
    a.w_gate = (const float*)d_in[16]; a.w_up = (const float*)d_in[17]; a.w_down = (const float*)d_in[18];
    a.out = (float*)d_out; a.ws = (unsigned char*)d_ws;
#if MK_SINGLE
    a.ph_lo = 0; a.ph_hi = NPHASES;
    hipLaunchKernelGGL(fwd, dim3(grid), dim3(NT), LDS_BYTES, stream, a);
#else
    for (int ph = 0; ph < NPHASES; ++ph) { a.ph_lo = ph; a.ph_hi = ph + 1; hipLaunchKernelGGL(fwd, dim3(grid), dim3(NT), LDS_BYTES, stream, a); }
#endif
}
```

```cpp
#include <hip/hip_runtime.h>
#include <cstdio>
#include <cstdint>

#define XB_TMO      128
#define XB_XCNT(j)  (256  + 64 * (j))
#define XB_XSUB(j)  (1280 + 64 * (j))
#define XB_XGEN(j)  (2304 + 64 * (j))
#define XB_TOP      3328
#define XB_TOPGEN   3392
#define XCD_BAR_WORDS 3456
#define XB_SPIN_CAP (1u << 18)
#define LAS __attribute__((address_space(3)))

__device__ __forceinline__ unsigned xb_ld(unsigned* p)              { return __hip_atomic_load(p, __ATOMIC_RELAXED, __HIP_MEMORY_SCOPE_AGENT); }
__device__ __forceinline__ unsigned xb_add(unsigned* p, unsigned v) { return __hip_atomic_fetch_add(p, v, __ATOMIC_RELAXED, __HIP_MEMORY_SCOPE_AGENT); }
__device__ __forceinline__ unsigned xb_xcc_id() { return (unsigned)__builtin_amdgcn_s_getreg((3 << 11) | 20) & 0xFu; }
#define XB_SPIN(cond, bar) do { unsigned _sp = 0; while (cond) { __builtin_amdgcn_s_sleep(1); \
    if ((++_sp & 255u) == 0u) { if (xb_ld(&(bar)[XB_TMO])) break; if (_sp > XB_SPIN_CAP) { atomicAdd(&(bar)[XB_TMO], 1u); break; } } } } while (0)

struct XcdBarrier {
    unsigned* bar; unsigned x;
    volatile LAS unsigned* st;
};

__device__ __forceinline__ XcdBarrier xcd_barrier_post(unsigned* bar, volatile LAS unsigned* st) {
    XcdBarrier b; b.bar = bar; b.x = xb_xcc_id(); b.st = st;
    if (threadIdx.x == 0) (void)xb_add(&bar[XB_XCNT(b.x)], 1u);
    return b;
}
__device__ __forceinline__ void xcd_barrier_complete(unsigned* bar, unsigned x, unsigned& nloc, unsigned& nx) {
    const unsigned G = gridDim.x * gridDim.y * gridDim.z;
    unsigned sum, cnt, mine, sp = 0u;
    for (;;) {
        sum = 0u; cnt = 0u; mine = 0u;
#pragma unroll
        for (unsigned j = 0; j < 16; ++j) { const unsigned c = xb_ld(&bar[XB_XCNT(j)]); sum += c; cnt += (c > 0u) ? 1u : 0u; mine = (j == x) ? c : mine; }
        if (sum == G) break;
        __builtin_amdgcn_s_sleep(1);
        if ((++sp & 255u) == 0u) { if (xb_ld(&bar[XB_TMO])) break; if (sp > XB_SPIN_CAP) { atomicAdd(&bar[XB_TMO], 1u); break; } }
    }
    nloc = mine > 0u ? mine : 1u; nx = cnt > 0u ? cnt : 1u;
}

__device__ __forceinline__ void xcd_barrier(const XcdBarrier& b) {
    asm volatile("s_waitcnt vmcnt(0)" ::: "memory");
    __syncthreads();
    if (threadIdx.x == 0) {
        unsigned* bar = b.bar;
        __builtin_amdgcn_s_waitcnt(0);
        unsigned nloc = b.st[0], nx = b.st[1];
        if (nloc == 0u) { xcd_barrier_complete(bar, b.x, nloc, nx); b.st[0] = nloc; b.st[1] = nx; }
        const unsigned old = xb_add(&bar[XB_XSUB(b.x)], 1u);
        const unsigned gen = old / nloc;
        if (old + 1u == (gen + 1u) * nloc) {
            __builtin_amdgcn_fence(__ATOMIC_RELEASE, "agent");
            asm volatile("s_waitcnt vmcnt(0)" ::: "memory");
            const unsigned og = xb_add(&bar[XB_TOP], 1u);
            const unsigned tg = og / nx;
            if (og + 1u == (tg + 1u) * nx) xb_add(&bar[XB_TOPGEN], 1u);
            else XB_SPIN(xb_ld(&bar[XB_TOPGEN]) == tg, bar);
            __builtin_amdgcn_fence(__ATOMIC_ACQUIRE, "agent");
            xb_add(&bar[XB_XGEN(b.x)], 1u);
            asm volatile("s_waitcnt vmcnt(0)" ::: "memory");
        } else {
            XB_SPIN(xb_ld(&bar[XB_XGEN(b.x)]) == gen, bar);
            __builtin_amdgcn_fence(__ATOMIC_ACQUIRE, "agent");
            asm volatile("s_waitcnt vmcnt(0)" ::: "memory");
        }
    }
    __syncthreads();
}
namespace pg8 {
#define PG8_LAS __attribute__((address_space(3)))
typedef unsigned short bf16_t;
typedef short bf16x8 __attribute__((ext_vector_type(8)));
typedef float f32x4 __attribute__((ext_vector_type(4)));
typedef unsigned u32x4 __attribute__((ext_vector_type(4)));
constexpr int BM = 256, BK = 64, HALF = 128, HTB = HALF * BK * 2  , STAGE_BYTES = 8 * HTB, NXCD = 8, WGM = 8;

__host__ __device__ __forceinline__ int lds_byte(int r, int c) { const int st = (r >> 4) * 2 + (c >> 5), rr = r & 15, cc = c & 31, ob = rr * 64 + cc * 2; return st * 1024 + (ob ^ (((ob >> 9) & 1) << 5)); }
__host__ __device__ __forceinline__ void stage_rc(int b, int& R, int& C) { const int st = b / 1024, sb = b % 1024, swz = sb ^ (((sb >> 9) & 1) << 5); R = (st >> 1) * 16 + swz / 64; C = (st & 1) * 32 + (swz % 64) / 2; }
__host__ __device__ __forceinline__ int perm32(int rho) { const int n = rho >> 4, i = rho & 15; return 8 * (i >> 2) + 4 * n + (i & 3); }

struct Unit { int pm, pn; };
struct Gemm { const bf16_t* A; const bf16_t* Bt; int M, N, K; const int* rows = nullptr; };

struct StaticOrder {
    int nM, nN, nwg, G, c;
    __host__ __device__ void init(int M, int N, int G_, int c_) { nM = M / BM; nN = N / BM; nwg = nM * nN; G = G_; c = c_; }
    __host__ __device__ bool next(int i, Unit& u) const {
        const long L = (long)i * G + c; if (L >= nwg) return false;
        int wgid = (int)L; { const int q = nwg / NXCD, r = nwg % NXCD, xcd = wgid % NXCD, off = wgid / NXCD; wgid = (xcd < r ? xcd * (q + 1) : r * (q + 1) + (xcd - r) * q) + off; }
        const int nig = WGM * nN, gid = wgid / nig, fm = gid * WGM, gsz = (nM - fm) < WGM ? (nM - fm) : WGM;
        u.pm = fm + ((wgid % nig) % gsz); u.pn = (wgid % nig) / gsz; return true;
    }
    __device__ __forceinline__ void a_ready(const Unit&) const {}
    __device__ __forceinline__ void done(const Unit&) const {}
};
__device__ __forceinline__ unsigned cvt_pk_bf16(float lo, float hi) { unsigned r; asm volatile("v_cvt_pk_bf16_f32 %0, %1, %2" : "=v"(r) : "v"(lo), "v"(hi)); return r; }
typedef float f32x2 __attribute__((ext_vector_type(2)));
template <class Epi, class Sched, bool STAMP = false, bool GATHER = false>
__device__ __forceinline__ void gemm_phase(PG8_LAS unsigned char* lds, const Gemm g, const Sched& S, const Epi& E, unsigned long long* stamps) {
    int tid_o_ = threadIdx.x; asm volatile("" : "+v"(tid_o_)); const int tid = tid_o_, wid = __builtin_amdgcn_readfirstlane(tid >> 6), lane = tid & 63, wr = wid >> 2, wc = wid & 3, fr = lane & 15, fq = lane >> 4;
    const int K = g.K, nt = K / BK;
    int ts_lo = 0, ts_hi = 0, nts = 0; const unsigned long long rt_entry = STAMP ? (unsigned long long)wall_clock64() : 0ull;
#define PG8_STAMP() do { if (STAMP && wid == 0 && nts < 64) { const unsigned long long _c = (unsigned long long)clock64(); \
        ts_lo = (lane == nts) ? (int)(unsigned)_c : ts_lo; ts_hi = (lane == nts) ? (int)(unsigned)(_c >> 32) : ts_hi; ++nts; } } while (0)
    PG8_STAMP();
    unsigned voffA[2], voffB[2]; int rA_[2]; unsigned cA_[2];
#pragma unroll
    for (int i = 0; i < 2; ++i) { int R, C; stage_rc(tid * 16 + i * 8192, R, C); const int Rb = Epi::PERM ? ((R & ~31) + perm32(R & 31)) : R;
        voffA[i] = (unsigned)(R * K + C) * 2u; voffB[i] = (unsigned)(Rb * K + C) * 2u; rA_[i] = R; cA_[i] = (unsigned)C * 2u; }
    unsigned gA[2][2], gN[2][2];
#define PG8_ROWS(u, dst) do { _Pragma("unroll") for (int h_ = 0; h_ < 2; ++h_) _Pragma("unroll") for (int i_ = 0; i_ < 2; ++i_) { const int as_ = g.rows[(u).pm * BM + h_ * HALF + rA_[i_]]; \
        dst[h_][i_] = (unsigned)(as_ < 0 ? 0 : as_ >> 1) * (unsigned)(K * 2) + cA_[i_]; } } while (0)
    const size_t kstep = (size_t)(BK * 2);
    const size_t hstep = (size_t)HALF * K * 2;
    const size_t tstep = 2 * hstep;
    const unsigned ldsw = (unsigned)wid * 1024u;
    const int aoff = lds_byte(wr * 64 + fr, fq * 8), boff = lds_byte(wc * 32 + fr, fq * 8);
#define PG8_SA(b, h) (((b) * 2 + (h)) * HTB)
#define PG8_SB(b, h) ((4 + (b) * 2 + (h)) * HTB)
#define PG8_STAGE(bufoff, gbase, voff) do { _Pragma("unroll") for (int _i = 0; _i < 2; ++_i) \
        __builtin_amdgcn_global_load_lds((const unsigned*)((const char*)(gbase) + (voff)[_i]), (PG8_LAS unsigned*)(lds + (bufoff) + ldsw + _i * 8192), 16, 0, 0); } while (0)
#define PG8_LDA(dst, b, h) do { _Pragma("unroll") for (int m = 0; m < 4; ++m) _Pragma("unroll") for (int k = 0; k < 2; ++k) dst[m][k] = *(const PG8_LAS bf16x8*)(lds + PG8_SA(b, h) + aoff + m * 2048 + k * 1024); } while (0)
#define PG8_LDB(dst, b, h) do { _Pragma("unroll") for (int n = 0; n < 2; ++n) _Pragma("unroll") for (int k = 0; k < 2; ++k) dst[n][k] = *(const PG8_LAS bf16x8*)(lds + PG8_SB(b, h) + boff + n * 2048 + k * 1024); } while (0)
#define PG8_MMA(ai, bj, At, Bt) do { __builtin_amdgcn_s_setprio(1); _Pragma("unroll") for (int m = 0; m < 4; ++m) _Pragma("unroll") for (int n = 0; n < 2; ++n) _Pragma("unroll") for (int k = 0; k < 2; ++k) \
        acc[ai][bj][m][n] = __builtin_amdgcn_mfma_f32_16x16x32_bf16(Bt[n][k], At[m][k], acc[ai][bj][m][n], 0, 0, 0); __builtin_amdgcn_s_setprio(0); } while (0)
#define PG8_WAIT_V(n) asm volatile("s_waitcnt vmcnt(" #n ")" ::: "memory")
#define PG8_WAIT_L(n) asm volatile("s_waitcnt lgkmcnt(" #n ")" ::: "memory")
#define PG8_BAR __builtin_amdgcn_s_barrier()
#define PG8_SCHED __builtin_amdgcn_sched_barrier(0)
    Unit cur, nxt; int ui = 0;
    if (!S.next(0, cur)) return;
    f32x4 acc[2][2][4][2];
#pragma unroll
    for (int a = 0; a < 2; ++a)
#pragma unroll
        for (int b = 0; b < 2; ++b)
#pragma unroll
            for (int m = 0; m < 4; ++m)
#pragma unroll
                for (int n = 0; n < 2; ++n) acc[a][b][m][n] = (f32x4){0.f, 0.f, 0.f, 0.f};
    bf16x8 At[4][2], B0[2][2], B1[2][2];
    const char* cA = (const char*)g.A + (GATHER ? (size_t)0 : (size_t)cur.pm * tstep); const char* cB = (const char*)g.Bt + (size_t)cur.pn * tstep;
    S.a_ready(cur);
    if (GATHER) { PG8_ROWS(cur, gA); _Pragma("unroll") for (int h_ = 0; h_ < 2; ++h_) _Pragma("unroll") for (int i_ = 0; i_ < 2; ++i_) gN[h_][i_] = gA[h_][i_]; }
    const size_t hstepA = GATHER ? (size_t)0 : hstep;
#define PG8_VA(h) (GATHER ? gA[h] : voffA)
    PG8_STAGE(PG8_SB(0, 0), cB, voffB); PG8_STAGE(PG8_SA(0, 0), cA, PG8_VA(0)); PG8_STAGE(PG8_SB(0, 1), cB + hstep, voffB); PG8_STAGE(PG8_SA(0, 1), cA + hstepA, PG8_VA(1));
    if (wr == 1) PG8_BAR;
    PG8_WAIT_V(4); PG8_BAR;
    PG8_STAGE(PG8_SB(1, 0), cB + kstep, voffB); PG8_STAGE(PG8_SA(1, 0), cA + kstep, PG8_VA(0)); PG8_STAGE(PG8_SB(1, 1), cB + hstep + kstep, voffB);
    PG8_WAIT_V(6); PG8_BAR;
    PG8_STAMP();
    for (;;) {
        const bool has_next = S.next(ui + 1, nxt);
        if (GATHER && has_next && wid == 0) __builtin_amdgcn_global_load_lds((const unsigned*)(g.rows + (size_t)nxt.pm * BM + lane * 4), (PG8_LAS unsigned*)(lds + STAGE_BYTES + 4096 + ((ui + 1) & 1) * 1024), 16, 0, 0);
        const char* nA = (has_next && !GATHER) ? (const char*)g.A + (size_t)nxt.pm * tstep : cA; const char* nB = has_next ? (const char*)g.Bt + (size_t)nxt.pn * tstep : cB;
        for (int t = 0; t < nt; t += 2) {
            const bool last = (t == nt - 2);
            const char* a1 = cA + (size_t)(t + 1) * kstep;
            const char* a2 = last ? nA : cA + (size_t)(t + 2) * kstep; const char* b2 = last ? nB : cB + (size_t)(t + 2) * kstep;
            const char* a3 = a2 + kstep; const char* b3 = b2 + kstep;
            if (last && has_next) S.a_ready(nxt);
            if (GATHER && last && has_next) { const PG8_LAS int* rl_ = (const PG8_LAS int*)(lds + STAGE_BYTES + 4096 + ((ui + 1) & 1) * 1024);
                _Pragma("unroll") for (int h_ = 0; h_ < 2; ++h_) _Pragma("unroll") for (int i_ = 0; i_ < 2; ++i_) { const int as_ = rl_[h_ * HALF + rA_[i_]]; gN[h_][i_] = (unsigned)(as_ < 0 ? 0 : as_ >> 1) * (unsigned)(K * 2) + cA_[i_]; } }
            unsigned v2_[2][2];
            if (GATHER) { _Pragma("unroll") for (int h_ = 0; h_ < 2; ++h_) _Pragma("unroll") for (int i_ = 0; i_ < 2; ++i_) v2_[h_][i_] = last ? gN[h_][i_] : gA[h_][i_]; }
#define PG8_V2(h) (GATHER ? v2_[h] : voffA)
            PG8_LDB(B0, 0, 0); PG8_SCHED; PG8_LDA(At, 0, 0); PG8_STAGE(PG8_SA(1, 1), a1 + hstepA, PG8_VA(1));
            PG8_WAIT_L(8); PG8_BAR; PG8_WAIT_L(0); PG8_MMA(0, 0, At, B0); PG8_BAR; PG8_SCHED;
            PG8_LDB(B1, 0, 1); PG8_STAGE(PG8_SB(0, 0), b2, voffB);
            PG8_BAR; PG8_WAIT_L(0); PG8_MMA(0, 1, At, B1); PG8_BAR;
            PG8_LDA(At, 0, 1); PG8_STAGE(PG8_SA(0, 0), a2, PG8_V2(0));
            PG8_BAR; PG8_WAIT_L(0); PG8_MMA(1, 0, At, B0); PG8_BAR; PG8_SCHED;
            PG8_STAGE(PG8_SB(0, 1), b2 + hstep, voffB);
            PG8_WAIT_V(6); PG8_BAR; PG8_MMA(1, 1, At, B1); PG8_BAR;
            PG8_LDB(B0, 1, 0); PG8_SCHED; PG8_LDA(At, 1, 0); PG8_STAGE(PG8_SA(0, 1), a2 + hstepA, PG8_V2(1));
            PG8_WAIT_L(8); PG8_BAR; PG8_WAIT_L(0); PG8_MMA(0, 0, At, B0); PG8_BAR; PG8_SCHED;
            PG8_LDB(B1, 1, 1); PG8_STAGE(PG8_SB(1, 0), b3, voffB);
            PG8_BAR; PG8_WAIT_L(0); PG8_MMA(0, 1, At, B1); PG8_BAR;
            PG8_LDA(At, 1, 1); PG8_STAGE(PG8_SA(1, 0), a3, PG8_V2(0));
            PG8_BAR; PG8_WAIT_L(0); PG8_MMA(1, 0, At, B0); PG8_BAR; PG8_SCHED;
            PG8_STAGE(PG8_SB(1, 1), b3 + hstep, voffB);
            PG8_WAIT_V(6); PG8_BAR; PG8_MMA(1, 1, At, B1); PG8_BAR;
        }
        PG8_STAMP();
        if constexpr (!Epi::AFTER_DRAIN) { E(acc, cur, wr, wc, fr, fq); S.done(cur); }
        PG8_STAMP();
        if (!has_next) break;
#pragma unroll
        for (int a = 0; a < 2; ++a)
#pragma unroll
            for (int b = 0; b < 2; ++b)
#pragma unroll
                for (int m = 0; m < 4; ++m)
#pragma unroll
                    for (int n = 0; n < 2; ++n) acc[a][b][m][n] = (f32x4){0.f, 0.f, 0.f, 0.f};
        cur = nxt; cA = nA; cB = nB; ++ui;
        if (GATHER) { _Pragma("unroll") for (int h_ = 0; h_ < 2; ++h_) _Pragma("unroll") for (int i_ = 0; i_ < 2; ++i_) gA[h_][i_] = gN[h_][i_]; }
    }
    PG8_WAIT_V(0);
    if (wr == 0) PG8_BAR;
    PG8_BAR;
    if constexpr (Epi::AFTER_DRAIN) { E.fused(acc, cur, wr, wc, fr, fq, lds, wid, lane); S.done(cur); }
    PG8_STAMP();
    if (STAMP && wid == 0) { stamps[lane] = lane < nts ? (((unsigned long long)(unsigned)ts_hi << 32) | (unsigned)ts_lo) : 0ull;
        if (lane == 62) stamps[62] = rt_entry; if (lane == 63) stamps[63] = (unsigned long long)wall_clock64(); }
#undef PG8_STAMP
#undef PG8_SA
#undef PG8_SB
#undef PG8_STAGE
#undef PG8_LDA
#undef PG8_LDB
#undef PG8_MMA
#undef PG8_WAIT_V
#undef PG8_WAIT_L
#undef PG8_BAR
#undef PG8_SCHED
#undef PG8_ROWS
#undef PG8_VA
#undef PG8_V2
}
}

namespace mk {
#define MLAS __attribute__((address_space(3)))
typedef unsigned short bf16_t;
typedef float f32x4 __attribute__((ext_vector_type(4)));
typedef unsigned u32x4 __attribute__((ext_vector_type(4)));
typedef unsigned u32x2 __attribute__((ext_vector_type(2)));

constexpr int D = 1024, NB = 16, SEQ = 4096, LC = 256, TL = NB * SEQ, TC = NB * LC, TT = TL + TC;
constexpr int INC = 4096, NE = 32, DFF = 512, NCH = 34, PMAX = 147456, NT = 512;
constexpr int LDS_BYTES = 150 * 1024, LDS_CTL = LDS_BYTES - 256;
constexpr int C_QA = 0, C_KA = 512, C_VA = 1024, C_QB = 1536, C_KB = 2048, C_VB = 2560, C_GF = 3072, C_GB = 3584;

constexpr size_t al256(size_t x) { return (x + 255) & ~(size_t)255; }
constexpr size_t WS_BAR = 0;
constexpr size_t WS_CNT = 16384;
constexpr size_t WS_ZERO_BYTES = 16384 + 16384;
constexpr size_t WS_MOD = WS_ZERO_BYTES;
constexpr size_t WS_WIN = al256(WS_MOD + (size_t)2 * 17 * 6144 * 4);
constexpr size_t WS_WOUT = WS_WIN + (size_t)2 * 4096 * 1024 * 2;
constexpr size_t WS_WGU = WS_WOUT + (size_t)2 * 1024 * 1024 * 2;
constexpr size_t WS_WDN = WS_WGU + (size_t)32 * 1024 * 1024 * 2;
constexpr size_t WS_CTX = WS_WDN + (size_t)32 * 1024 * 512 * 2;
constexpr size_t WS_H = WS_CTX + (size_t)TC * D * 4;
constexpr size_t WS_PROJ = WS_H + (size_t)TT * D * 2;
constexpr size_t WS_XS = WS_PROJ;
constexpr size_t WS_ACT = WS_PROJ + (size_t)PMAX * D * 2;
constexpr size_t WS_XB = WS_PROJ + (size_t)TT * INC * 2;
constexpr size_t WS_ST = WS_PROJ + (size_t)TT * INC * 2;
constexpr size_t WS_KC = WS_ST;
constexpr size_t WS_VT = WS_KC + (size_t)128 * 4096 * 64 * 2;
constexpr size_t WS_KCC = WS_VT + (size_t)128 * 4096 * 64 * 2;
constexpr size_t WS_VTC = WS_KCC + (size_t)128 * 256 * 64 * 2;
static_assert(WS_VTC + (size_t)128 * 256 * 64 * 2 <= WS_ST + (size_t)NB * 4 * 2 * NCH * 16384 * 2, "NA operand copies fit in the state region");
constexpr size_t WS_TOKE = WS_ST + (size_t)NB * 4 * 2 * NCH * 16384 * 2;
constexpr size_t WS_TOKR = WS_TOKE + (size_t)TT * 2 * 4;
constexpr size_t WS_TOKW = WS_TOKR + (size_t)TT * 2 * 4;
constexpr size_t WS_RINFO = WS_TOKW + (size_t)TT * 2 * 4;
constexpr size_t WS_RW = WS_RINFO + (size_t)PMAX * 4;
constexpr size_t WS_BLKE = WS_RW + (size_t)PMAX * 4;
constexpr size_t WS_RWT = WS_BLKE + 4096;
constexpr size_t WS_BLKB = WS_RWT + (size_t)2 * 32 * 1024 * 2;
constexpr size_t WS_ROPE = WS_BLKB + (size_t)1024 * 32 * 4;
constexpr size_t WS_END = WS_ROPE + (size_t)64 * 32 * 8;
static_assert(WS_ACT + (size_t)PMAX * DFF * 2 <= WS_ST && WS_XB == WS_ST && (size_t)TL * D * 2 <= (size_t)NB * 4 * 2 * NCH * 16384 * 2, "ys | act fit in the proj region, xb in the state region");
static_assert((size_t)TT * 2 * D * 2 <= (size_t)PMAX * D * 2, "y2 fits in xs region");
static_assert(WS_END <= (size_t)1 << 30, "workspace must fit in 1 GiB");

struct Args {
    const float* x; const float* c; const float* ctx; const float* c_ctx; const float* ada_w; const float* ada_b;
    const float* norm_mix_w; const float* norm_ffn_w; const float* w_in; const float* na_q_norm; const float* na_k_norm;
    const float* na_rpb; const float* ret_decay; const float* w_out; const float* router_w; const float* router_bias;
    const float* w_gate; const float* w_up; const float* w_down;
    float* out; unsigned char* ws; int ph_lo, ph_hi;
};

#define LDS_BARRIER() do { asm volatile("s_waitcnt lgkmcnt(0)" ::: "memory"); __builtin_amdgcn_s_barrier(); asm volatile("" ::: "memory"); } while (0)
__device__ __forceinline__ int otid() { int t = threadIdx.x; asm volatile("" : "+v"(t)); return t; }
__device__ __forceinline__ float bf2f(bf16_t v) { return __uint_as_float(((unsigned)v) << 16); }
__device__ __forceinline__ bf16_t f2bf(float f) { unsigned u = __float_as_uint(f); u += 0x7FFFu + ((u >> 16) & 1u); return (bf16_t)(u >> 16); }
typedef float f32x2_t __attribute__((ext_vector_type(2)));
typedef __bf16 bf16x2_t __attribute__((ext_vector_type(2)));
__device__ __forceinline__ unsigned pack2(float lo, float hi) { const f32x2_t v = {lo, hi}; return __builtin_bit_cast(unsigned, __builtin_convertvector(v, bf16x2_t)); }
__device__ __forceinline__ float lo16(unsigned w) { return __uint_as_float(w << 16); }
__device__ __forceinline__ float hi16(unsigned w) { return __uint_as_float(w & 0xffff0000u); }
__device__ __forceinline__ float siluf(float v) { return v * __builtin_amdgcn_rcpf(1.0f + __builtin_amdgcn_exp2f(-1.4426950408889634f * v)); }
__device__ __forceinline__ float wave_sum(float v) {
#pragma unroll
    for (int o = 32; o >= 1; o >>= 1) v += __shfl_xor(v, o);
    return v;
}

typedef short bf16x8 __attribute__((ext_vector_type(8)));
typedef float f32x16 __attribute__((ext_vector_type(16)));
__device__ __forceinline__ unsigned off_b(unsigned row, unsigned ch) { return 256u * row + 16u * (ch ^ (((row & 3) << 2) | ((row >> 2) & 3))); }
__device__ __forceinline__ unsigned tr_addr(unsigned row0, unsigned c, unsigned lane) { const unsigned blk = (lane >> 4) & 1, q = (lane & 15) >> 2, p = lane & 3; return off_b(row0 + q, 4 * c + 2 * blk + (p >> 1)) + 8 * (p & 1); }
__device__ __forceinline__ bf16x8 mkfrag(u32x2 lo, u32x2 hi) { const u32x4 w = {lo.x, lo.y, hi.x, hi.y}; return __builtin_bit_cast(bf16x8, w); }
__device__ __forceinline__ int st_frag_idx(int d, int e) { return (((d >> 5) * 4 + (e >> 5)) * 64 + (e & 31) + 32 * ((d >> 2) & 1)) * 16 + (d & 3) + 4 * ((d & 31) >> 3); }
__device__ __forceinline__ const float* modp(const Args& a, int l, int r, int k6) { return (const float*)(a.ws + WS_MOD) + ((size_t)l * 17 + r) * 6144 + k6 * 1024; }

__device__ __forceinline__ void cvt_addr(const Args& a, bool with_dense, int le, bf16_t* wgu, bf16_t* wdn, int t, int tid, const float*& lp, bf16_t*& sp) {
    const float* src; bf16_t* dst; int ldn, ldk, k0, n0, nd0;
    if (with_dense && t < 2560) {
        if (t < 2048) { const int l = t >> 10, tt = t & 1023; k0 = (tt >> 6) * 64; n0 = (tt & 63) * 64; nd0 = n0; src = a.w_in + (size_t)l * D * INC; ldn = INC; dst = (bf16_t*)(a.ws + WS_WIN) + (size_t)l * INC * D; ldk = D; }
        else { const int t2 = t - 2048, l = t2 >> 8, tt = t2 & 255; k0 = (tt >> 4) * 64; n0 = (tt & 15) * 64; nd0 = n0; src = a.w_out + (size_t)l * D * D; ldn = D; dst = (bf16_t*)(a.ws + WS_WOUT) + (size_t)l * D * D; ldk = D; }
    } else {
        const int te = with_dense ? t - 2560 : t, which = te >> 12, tt = te & 4095, e = tt >> 7, r = tt & 127;
        if (which < 2) { k0 = (r >> 3) * 64; n0 = (r & 7) * 64; nd0 = (n0 >> 7) * 256 + which * 128 + (n0 & 127); src = (which == 0 ? a.w_gate : a.w_up) + ((size_t)le * NE + e) * D * DFF; ldn = DFF; dst = wgu + (size_t)e * 1024 * D; ldk = D; }
        else { k0 = (r >> 4) * 64; n0 = (r & 15) * 64; nd0 = n0; src = a.w_down + ((size_t)le * NE + e) * DFF * D; ldn = D; dst = wdn + (size_t)e * 1024 * DFF; ldk = DFF; }
    }
    lp = src + (size_t)(k0 + (tid >> 3)) * ldn + n0 + (tid & 7) * 8;
    sp = dst + (size_t)(nd0 + (tid >> 3)) * ldk + k0 + (tid & 7) * 8;
}
__device__ __forceinline__ void convert_weights(const Args& a, bool with_dense, int le, MLAS unsigned char* lds, int idx, int stride, int t_lo, int t_hi, bf16_t* wgu, bf16_t* wdn) {
    MLAS float* tl = (MLAS float*)lds; const int tid = otid();
    const int N = t_hi;
    const float* lp; bf16_t* sp;
    f32x4 v0 = {0.f, 0.f, 0.f, 0.f}, v1 = v0;
    if (t_lo + idx < N) { cvt_addr(a, with_dense, le, wgu, wdn, t_lo + idx, tid, lp, sp); v0 = *(const f32x4*)lp; v1 = *(const f32x4*)(lp + 4); }
    for (int t = t_lo + idx; t < N; t += stride) {
        cvt_addr(a, with_dense, le, wgu, wdn, t, tid, lp, sp);
        LDS_BARRIER();
        { const int kk = tid >> 3, nn0 = (tid & 7) * 8;
#pragma unroll
          for (int j = 0; j < 4; ++j) { tl[kk * 65 + nn0 + j] = v0[j]; tl[kk * 65 + nn0 + 4 + j] = v1[j]; } }
        { const int tn = t + stride < N ? t + stride : t; const float* lpn; bf16_t* spn; cvt_addr(a, with_dense, le, wgu, wdn, tn, tid, lpn, spn); (void)spn; v0 = *(const f32x4*)lpn; v1 = *(const f32x4*)(lpn + 4); }
        LDS_BARRIER();
        { const int n = tid >> 3, kc = (tid & 7) * 8;
          u32x4 w;
          w.x = pack2(tl[(kc + 0) * 65 + n], tl[(kc + 1) * 65 + n]); w.y = pack2(tl[(kc + 2) * 65 + n], tl[(kc + 3) * 65 + n]);
          w.z = pack2(tl[(kc + 4) * 65 + n], tl[(kc + 5) * 65 + n]); w.w = pack2(tl[(kc + 6) * 65 + n], tl[(kc + 7) * 65 + n]);
          *(u32x4*)sp = w; }
    }
    __syncthreads();
}
#ifndef CV_BUB
#define CV_BUB 64
#endif
__device__ __forceinline__ bf16_t* wgu_of(const Args& a, int l) { return l == 0 ? (bf16_t*)(a.ws + WS_WGU) : (bf16_t*)a.out + (size_t)TL * D; }
__device__ __forceinline__ bf16_t* wdn_of(const Args& a, int l) { return l == 0 ? (bf16_t*)(a.ws + WS_WDN) : (bf16_t*)a.out + (size_t)TL * D + (size_t)NE * 1024 * D; }
__device__ __forceinline__ int cv_rem(int nb) { return (TT / 256) * (D / 256) % nb; }
__device__ __forceinline__ int cv_nbub(int nb) { const int rem = cv_rem(nb); const int n = rem > 0 ? (nb - rem) * CV_BUB : 0; return n < 3 * 4096 ? n : 3 * 4096; }
__device__ __forceinline__ void convert_small(const Args& a, int bid, int nb) {
    const int tid = otid();
    if (bid == nb - 2) { float* rt = (float*)(a.ws + WS_ROPE);
        for (int i = tid; i < 64 * 32; i += NT) { const float ang = (float)(i >> 5) * exp2f(-(float)(i & 31) * (13.287712379549449f / 32.0f)); float sn, cs; sincosf(ang, &sn, &cs); rt[2 * i] = cs; rt[2 * i + 1] = sn; } }
    if (bid == nb - 1) { bf16_t* rh = (bf16_t*)(a.ws + WS_RWT); bf16_t* rl = rh + 32 * 1024;
        for (int i = tid; i < 32 * 1024; i += NT) { const int e = i >> 10, k = i & 1023; const float w = a.router_w[k * NE + e]; const bf16_t hi = f2bf(w); rh[i] = hi; rl[i] = f2bf(w - bf2f(hi)); } }
}
__device__ __forceinline__ void compute_mod(const Args& a, MLAS unsigned char* lds, int bid, int nb) {
    MLAS float* sc = (MLAS float*)lds;
    MLAS float* red = (MLAS float*)(lds + 17 * 1024 * 4);
    const int tid = otid();
    if (bid >= 192) return;
    for (int i = tid; i < 17 * 1024; i += NT) { const int r = i >> 10, k = i & 1023; const float v = r < 16 ? a.c[r * 1024 + k] : a.c_ctx[k]; sc[i] = v / (1.0f + expf(-v)); }
    __syncthreads();
    for (int u = bid; u < 192; u += nb) {
        const int l = u / 96, n = (u % 96) * 64 + (tid & 63), kp = tid >> 6;
        float acc[17];
#pragma unroll
        for (int r = 0; r < 17; ++r) acc[r] = 0.f;
        const float* w = a.ada_w + (size_t)l * D * 6144 + n;
        for (int k = kp * 128; k < kp * 128 + 128; ++k) { const float wv = w[(size_t)k * 6144];
#pragma unroll
            for (int r = 0; r < 17; ++r) acc[r] += sc[r * 1024 + k] * wv; }
#pragma unroll
        for (int r = 0; r < 17; ++r) red[(kp * 17 + r) * 64 + (tid & 63)] = acc[r];
        __syncthreads();
        for (int i = tid; i < 17 * 64; i += NT) { const int r = i >> 6, cc = i & 63, nn = (u % 96) * 64 + cc; float s = a.ada_b[l * 6144 + nn];
#pragma unroll
            for (int p = 0; p < 8; ++p) s += red[(p * 17 + r) * 64 + cc];
            ((float*)(a.ws + WS_MOD))[((size_t)l * 17 + r) * 6144 + nn] = s; }
        __syncthreads();
    }
}

__device__ __forceinline__ void load_row_f32(const float* src, int e0, int e1, float (&v)[16]) {
    const f32x4 x0 = *(const f32x4*)(src + e0), x1 = *(const f32x4*)(src + e0 + 4), x2 = *(const f32x4*)(src + e1), x3 = *(const f32x4*)(src + e1 + 4);
#pragma unroll
    for (int j = 0; j < 4; ++j) { v[j] = x0[j]; v[4 + j] = x1[j]; v[8 + j] = x2[j]; v[12 + j] = x3[j]; }
}
__device__ __forceinline__ void load_row_bf16(const bf16_t* src, int e0, int e1, float (&v)[16]) {
    const u32x4 w0 = *(const u32x4*)(src + e0), w1 = *(const u32x4*)(src + e1);
#pragma unroll
    for (int j = 0; j < 4; ++j) { v[2 * j] = lo16(w0[j]); v[2 * j + 1] = hi16(w0[j]); v[8 + 2 * j] = lo16(w1[j]); v[8 + 2 * j + 1] = hi16(w1[j]); }
}
__device__ __forceinline__ void moe_combine(const bf16_t* ys, int2 pp, float2 ww, int i, const float (&mg)[16], int e0, int e1, float (&v)[16]) {
    const int p0 = __builtin_amdgcn_readlane(pp.x, i), p1 = __builtin_amdgcn_readlane(pp.y, i);
    const float w0 = __uint_as_float(__builtin_amdgcn_readlane(__float_as_uint(ww.x), i)), w1 = __uint_as_float(__builtin_amdgcn_readlane(__float_as_uint(ww.y), i));
    const bf16_t* ya = ys + (size_t)p0 * D; const bf16_t* yb = ys + (size_t)p1 * D;
    const u32x4 a0 = *(const u32x4*)(ya + e0), a1 = *(const u32x4*)(ya + e1), b0 = *(const u32x4*)(yb + e0), b1 = *(const u32x4*)(yb + e1);
#pragma unroll
    for (int j = 0; j < 4; ++j) {
        v[2 * j] += mg[2 * j] * (w0 * lo16(a0[j]) + w1 * lo16(b0[j])); v[2 * j + 1] += mg[2 * j + 1] * (w0 * hi16(a0[j]) + w1 * hi16(b0[j]));
        v[8 + 2 * j] += mg[8 + 2 * j] * (w0 * lo16(a1[j]) + w1 * lo16(b1[j])); v[8 + 2 * j + 1] += mg[8 + 2 * j + 1] * (w0 * hi16(a1[j]) + w1 * hi16(b1[j])); }
}
__device__ __forceinline__ void phase_norm1(const Args& a, int l, int bid, int nb) {
    const int tid = otid(), lane = tid & 63, wave = __builtin_amdgcn_readfirstlane(tid >> 6);
    const int e0 = lane * 8, e1 = 512 + lane * 8;
    float wn[16];
    { const float* w = a.norm_mix_w + l * D;
#pragma unroll
      for (int j = 0; j < 8; ++j) { wn[j] = w[e0 + j]; wn[8 + j] = w[e1 + j]; } }
    float msc[16], msh[16], mg[16]; int cur_r = -1;
    bf16_t* hb = (bf16_t*)(a.ws + WS_H);
    const bf16_t* y2 = (const bf16_t*)(a.ws + WS_XS);
    const int rper = (TT + nb * 8 - 1) / (nb * 8), row_lo = (bid * 8 + wave) * rper, row_hi = min(row_lo + rper, TT);
    int2 pp = {0, 0}; float2 ww = {0.f, 0.f};
    if (l > 0 && row_lo + lane < row_hi) { pp = *(const int2*)((const int*)(a.ws + WS_TOKR) + (size_t)(row_lo + lane) * 2); ww = *(const float2*)((const float*)(a.ws + WS_TOKW) + (size_t)(row_lo + lane) * 2); }
    for (int row = row_lo; row < row_hi; ++row) {
        const int r = row < TL ? row / SEQ : 16;
        if (r != cur_r) { cur_r = r; const float* sh = modp(a, l, r, 0); const float* sc = modp(a, l, r, 1);
#pragma unroll
            for (int j = 0; j < 8; ++j) { msh[j] = sh[e0 + j]; msh[8 + j] = sh[e1 + j]; msc[j] = 1.0f + sc[e0 + j]; msc[8 + j] = 1.0f + sc[e1 + j]; }
            if (l > 0) { const float* g = modp(a, l - 1, r, 5);
#pragma unroll
                for (int j = 0; j < 8; ++j) { mg[j] = g[e0 + j]; mg[8 + j] = g[e1 + j]; } } }
        float v[16];
        if (l == 0) load_row_f32(row < TL ? a.x + (size_t)row * D : a.ctx + (size_t)(row - TL) * D, e0, e1, v);
        else if (row < TL) load_row_bf16((const bf16_t*)(a.ws + WS_XB) + (size_t)row * D, e0, e1, v);
        else load_row_f32((const float*)(a.ws + WS_CTX) + (size_t)(row - TL) * D, e0, e1, v);
        if (l > 0) {
            moe_combine(y2, pp, ww, row - row_lo, mg, e0, e1, v);
            if (row < TL) { bf16_t* dst = (bf16_t*)a.out + (size_t)row * D;
                *(u32x4*)(dst + e0) = (u32x4){pack2(v[0], v[1]), pack2(v[2], v[3]), pack2(v[4], v[5]), pack2(v[6], v[7])};
                *(u32x4*)(dst + e1) = (u32x4){pack2(v[8], v[9]), pack2(v[10], v[11]), pack2(v[12], v[13]), pack2(v[14], v[15])}; }
        }
        float ss = 0.f;
#pragma unroll
        for (int j = 0; j < 16; ++j) ss += v[j] * v[j];
        ss = wave_sum(ss);
        const float rs = rsqrtf(ss * (1.0f / D) + 1e-6f);
        float y[16];
#pragma unroll
        for (int j = 0; j < 16; ++j) y[j] = v[j] * rs * wn[j] * msc[j] + msh[j];
        bf16_t* hp = hb + (size_t)row * D;
        *(u32x4*)(hp + e0) = (u32x4){pack2(y[0], y[1]), pack2(y[2], y[3]), pack2(y[4], y[5]), pack2(y[6], y[7])};
        *(u32x4*)(hp + e1) = (u32x4){pack2(y[8], y[9]), pack2(y[10], y[11]), pack2(y[12], y[13]), pack2(y[14], y[15])};
    }
}
__device__ __forceinline__ void phase_final(const Args& a, int bid, int nb) {
    const int tid = otid(), lane = tid & 63, wave = __builtin_amdgcn_readfirstlane(tid >> 6);
    const int e0 = lane * 8, e1 = 512 + lane * 8;
    float mg[16]; int cur_r = -1;
    const bf16_t* y2 = (const bf16_t*)(a.ws + WS_XS);
    const int rper = (TL + nb * 8 - 1) / (nb * 8), row_lo = (bid * 8 + wave) * rper, row_hi = min(row_lo + rper, TL);
    int2 pp = {0, 0}; float2 ww = {0.f, 0.f};
    if (row_lo + lane < row_hi) { pp = *(const int2*)((const int*)(a.ws + WS_TOKR) + (size_t)(row_lo + lane) * 2); ww = *(const float2*)((const float*)(a.ws + WS_TOKW) + (size_t)(row_lo + lane) * 2); }
    for (int row = row_lo; row < row_hi; ++row) {
        const int r = row / SEQ;
        if (r != cur_r) { cur_r = r; const float* g = modp(a, 1, r, 5);
#pragma unroll
            for (int j = 0; j < 8; ++j) { mg[j] = g[e0 + j]; mg[8 + j] = g[e1 + j]; } }
        float* src = a.out + (size_t)row * D;
        float v[16];
        load_row_bf16((const bf16_t*)(a.ws + WS_XB) + (size_t)row * D, e0, e1, v);
        moe_combine(y2, pp, ww, row - row_lo, mg, e0, e1, v);
        *(f32x4*)(src + e0) = (f32x4){v[0], v[1], v[2], v[3]}; *(f32x4*)(src + e0 + 4) = (f32x4){v[4], v[5], v[6], v[7]};
        *(f32x4*)(src + e1) = (f32x4){v[8], v[9], v[10], v[11]}; *(f32x4*)(src + e1 + 4) = (f32x4){v[12], v[13], v[14], v[15]};
    }
}

constexpr int VP = 516;
__device__ __forceinline__ void phase_prep(const Args& a, int l, MLAS unsigned char* lds, int bid, int nb) {
    const int tid = otid(), lane = tid & 63, wave = tid >> 6;
    const bf16_t* proj = (const bf16_t*)(a.ws + WS_PROJ);
    MLAS bf16_t* Vs = (MLAS bf16_t*)lds;
    float wk[8];
    { const float* w = a.na_k_norm + l * 64 + (lane & 7) * 8;
#pragma unroll
      for (int j = 0; j < 8; ++j) wk[j] = w[j]; }
    for (int u = bid; u < TT / 64; u += nb) {
        const int R0 = u * 64; const bool lat = R0 < TL;
        const int b = lat ? R0 / SEQ : (R0 - TL) / LC, t0 = lat ? R0 % SEQ : (R0 - TL) % LC, tlen = lat ? SEQ : LC;
        bf16_t* kc = (bf16_t*)(a.ws + (lat ? WS_KC : WS_KCC)); bf16_t* vt = (bf16_t*)(a.ws + (lat ? WS_VT : WS_VTC));
        __syncthreads();
#pragma unroll
        for (int rr = 0; rr < 8; ++rr) {
            const int rl = wave * 8 + rr, row = R0 + rl, t = t0 + rl;
            const bf16_t* p = proj + (size_t)row * INC;
            const u32x4 kw = *(const u32x4*)(p + C_KA + lane * 8), vw = *(const u32x4*)(p + C_VA + lane * 8);
            float f[8];
#pragma unroll
            for (int j = 0; j < 4; ++j) { f[2 * j] = lo16(kw[j]); f[2 * j + 1] = hi16(kw[j]); }
            float ss = 0.f;
#pragma unroll
            for (int j = 0; j < 8; ++j) ss += f[j] * f[j];
            ss += __shfl_xor(ss, 1); ss += __shfl_xor(ss, 2); ss += __shfl_xor(ss, 4);
            const float rs = rsqrtf(ss * (1.0f / 64.0f) + 1e-6f);
            *(u32x4*)(kc + (((size_t)b * 8 + (lane >> 3)) * tlen + t) * 64 + (lane & 7) * 8) =
                (u32x4){pack2(f[0] * rs * wk[0], f[1] * rs * wk[1]), pack2(f[2] * rs * wk[2], f[3] * rs * wk[3]), pack2(f[4] * rs * wk[4], f[5] * rs * wk[5]), pack2(f[6] * rs * wk[6], f[7] * rs * wk[7])};
            *(MLAS u32x2*)(Vs + rl * VP + lane * 8) = (u32x2){vw.x, vw.y}; *(MLAS u32x2*)(Vs + rl * VP + lane * 8 + 4) = (u32x2){vw.z, vw.w};
        }
        __syncthreads();
#pragma unroll
        for (int i = 0; i < 8; ++i) { const int idx = tid + i * NT, d = idx & 63, tc = (idx >> 6) & 7, h = idx >> 9;
            const MLAS bf16_t* vp = Vs + (tc * 8) * VP + h * 64 + d;
            const u32x4 w = {(unsigned)vp[0] | ((unsigned)vp[VP] << 16), (unsigned)vp[2 * VP] | ((unsigned)vp[3 * VP] << 16), (unsigned)vp[4 * VP] | ((unsigned)vp[5 * VP] << 16), (unsigned)vp[6 * VP] | ((unsigned)vp[7 * VP] << 16)};
            const int tk = t0 + tc * 8;
            *(u32x4*)(vt + ((((size_t)b * 8 + h) * (tlen >> 4) + (tk >> 4)) * 64 + d) * 16 + (tk & 15)) = w; }
    }
}

__device__ __forceinline__ int chunk_row0(int b, int c) { return c < 2 ? TL + b * LC + c * 128 : b * SEQ + (c - 2) * 128; }
__device__ __forceinline__ size_t st_index(int b, int h, int dir, int c) { return ((((size_t)b * 4 + h) * 2 + dir) * NCH + c) * 16384; }
constexpr int RP = 136;
__device__ __forceinline__ void load_rope_pair(const bf16_t* p, int a2, int fc, int tok, const MLAS float* rope, float (&y1)[8], float (&y2)[8]) {
    const u32x4 w0 = *(const u32x4*)(p + (a2 * 8 + fc) * 8), w1 = *(const u32x4*)(p + (a2 * 8 + fc + 4) * 8);
#pragma unroll
    for (int j = 0; j < 4; ++j) { y1[2 * j] = lo16(w0[j]); y1[2 * j + 1] = hi16(w0[j]); y2[2 * j] = lo16(w1[j]); y2[2 * j + 1] = hi16(w1[j]); }
    if (tok >= 0) {
        const int pos = a2 == 0 ? (tok >> 6) : (tok & 63);
        const MLAS f32x4* tp = (const MLAS f32x4*)(rope + (pos * 32 + fc * 8) * 2);
#pragma unroll
        for (int q = 0; q < 4; ++q) { const f32x4 cs = tp[q];
            const float u0 = y1[2 * q] * cs[0] - y2[2 * q] * cs[1], v0 = y1[2 * q] * cs[1] + y2[2 * q] * cs[0];
            const float u1 = y1[2 * q + 1] * cs[2] - y2[2 * q + 1] * cs[3], v1 = y1[2 * q + 1] * cs[3] + y2[2 * q + 1] * cs[2];
            y1[2 * q] = u0; y2[2 * q] = v0; y1[2 * q + 1] = u1; y2[2 * q + 1] = v1; }
    }
}
__device__ __forceinline__ void rope_pair_regs(const u32x4 w0, const u32x4 w1, int a2, int fc, int tok, const MLAS float* rope, float (&y1)[8], float (&y2)[8]) {
#pragma unroll
    for (int j = 0; j < 4; ++j) { y1[2 * j] = lo16(w0[j]); y1[2 * j + 1] = hi16(w0[j]); y2[2 * j] = lo16(w1[j]); y2[2 * j + 1] = hi16(w1[j]); }
    if (tok >= 0) {
        const int pos = a2 == 0 ? (tok >> 6) : (tok & 63);
        const MLAS f32x4* tp = (const MLAS f32x4*)(rope + (pos * 32 + fc * 8) * 2);
#pragma unroll
        for (int q = 0; q < 4; ++q) { const f32x4 cs = tp[q];
            const float u0 = y1[2 * q] * cs[0] - y2[2 * q] * cs[1], v0 = y1[2 * q] * cs[1] + y2[2 * q] * cs[0];
            const float u1 = y1[2 * q + 1] * cs[2] - y2[2 * q + 1] * cs[3], v1 = y1[2 * q + 1] * cs[3] + y2[2 * q + 1] * cs[2];
            y1[2 * q] = u0; y2[2 * q] = v0; y1[2 * q + 1] = u1; y2[2 * q + 1] = v1; }
    }
}
__device__ __forceinline__ u32x4 pack8(const float (&y)[8], float sc) { return (u32x4){pack2(y[0] * sc, y[1] * sc), pack2(y[2] * sc, y[3] * sc), pack2(y[4] * sc, y[5] * sc), pack2(y[6] * sc, y[7] * sc)}; }
constexpr float RET_KSCALE = 0.08838834764831845f;
constexpr int LDS_ROPE = 98304;
__device__ __forceinline__ void phase_ret_a(const Args& a, int l, MLAS unsigned char* lds, int bid, int nb) {
    const int tid = otid(), lane = tid & 63, wave = __builtin_amdgcn_readfirstlane(tid >> 6);
    const bf16_t* proj = (const bf16_t*)(a.ws + WS_PROJ); bf16_t* st = (bf16_t*)(a.ws + WS_ST);
    const unsigned ldsb = (unsigned)(size_t)lds;
    const int dir = wave >> 2, dt = wave & 3, hh = lane >> 5;
    MLAS float* rope = (MLAS float*)(lds + LDS_ROPE);
    for (int i = tid; i < 64 * 32 * 2; i += NT) rope[i] = ((const float*)(a.ws + WS_ROPE))[i];
#define RA_LOAD(u_) do { const int b_ = (u_) / (NCH * 4), c_ = ((u_) >> 2) % NCH, h_ = (u_) & 3, row0_ = chunk_row0(b_, c_); _Pragma("unroll") for (int i = 0; i < 2; ++i) { const int idx = tid + i * NT, row = idx >> 3, ch0 = ((idx >> 2) & 1) * 8 + (idx & 3); \
        const bf16_t* src = proj + (size_t)(row0_ + row) * INC + h_ * 128; \
        raw[i][0] = *(const u32x4*)(src + C_KB + ch0 * 8); raw[i][1] = *(const u32x4*)(src + C_KB + (ch0 + 4) * 8); raw[i][2] = *(const u32x4*)(src + C_VB + ch0 * 8); raw[i][3] = *(const u32x4*)(src + C_VB + (ch0 + 4) * 8); } } while (0)
    u32x4 raw[2][4];
    if (bid < NB * NCH * 4) RA_LOAD(bid);
    LDS_BARRIER();
    for (int u = bid; u < NB * NCH * 4; u += nb) {
        const int b = u / (NCH * 4), c = (u >> 2) % NCH, h = u & 3;
        const float lgf = -expf(a.ret_decay[l * 8 + h]), lgb = -expf(a.ret_decay[l * 8 + 4 + h]);
        LDS_BARRIER();
#pragma unroll
        for (int i = 0; i < 2; ++i) { const int idx = tid + i * NT, row = idx >> 3, a2 = (idx >> 2) & 1, fc = idx & 3, ch0 = a2 * 8 + fc;
            float y1[8], y2[8];
            rope_pair_regs(raw[i][0], raw[i][1], a2, fc, c >= 2 ? (c - 2) * 128 + row : -1, rope, y1, y2);
            const float wf = __expf((float)(127 - row) * lgf) * RET_KSCALE, wb = __expf((float)row * lgb) * RET_KSCALE;
            const unsigned o0 = off_b(row, ch0), o1 = off_b(row, ch0 + 4);
            *(MLAS u32x4*)(lds + o0) = pack8(y1, wf); *(MLAS u32x4*)(lds + o1) = pack8(y2, wf);
            *(MLAS u32x4*)(lds + 32768 + o0) = pack8(y1, wb); *(MLAS u32x4*)(lds + 32768 + o1) = pack8(y2, wb);
            *(MLAS u32x4*)(lds + 65536 + o0) = raw[i][2]; *(MLAS u32x4*)(lds + 65536 + o1) = raw[i][3]; }
        { const int un_ = u + nb < NB * NCH * 4 ? u + nb : u; RA_LOAD(un_); }
        LDS_BARRIER();
        f32x16 acc[4];
#pragma unroll
        for (int et = 0; et < 4; ++et)
#pragma unroll
            for (int r = 0; r < 16; ++r) acc[et][r] = 0.f;
        unsigned aK[2], aV[4][2];
#pragma unroll
        for (int t = 0; t < 2; ++t) { aK[t] = ldsb + dir * 32768 + tr_addr(8 * hh + 4 * t, dt, lane);
#pragma unroll
            for (int et = 0; et < 4; ++et) aV[et][t] = ldsb + 65536 + tr_addr(8 * hh + 4 * t, et, lane); }
#pragma unroll
        for (int ks = 0; ks < 8; ++ks) {
            u32x2 r0, r1, r2, r3, r4, r5, r6, r7, r8, r9; const unsigned ko = ks * 4096;
            asm volatile("ds_read_b64_tr_b16 %0, %10\n\tds_read_b64_tr_b16 %1, %11\n\tds_read_b64_tr_b16 %2, %12\n\tds_read_b64_tr_b16 %3, %13\n\tds_read_b64_tr_b16 %4, %14\n\t"
                         "ds_read_b64_tr_b16 %5, %15\n\tds_read_b64_tr_b16 %6, %16\n\tds_read_b64_tr_b16 %7, %17\n\tds_read_b64_tr_b16 %8, %18\n\tds_read_b64_tr_b16 %9, %19\n\ts_waitcnt lgkmcnt(0)"
                         : "=&v"(r0), "=&v"(r1), "=&v"(r2), "=&v"(r3), "=&v"(r4), "=&v"(r5), "=&v"(r6), "=&v"(r7), "=&v"(r8), "=&v"(r9)
                         : "v"(aK[0] + ko), "v"(aK[1] + ko), "v"(aV[0][0] + ko), "v"(aV[0][1] + ko), "v"(aV[1][0] + ko), "v"(aV[1][1] + ko), "v"(aV[2][0] + ko), "v"(aV[2][1] + ko), "v"(aV[3][0] + ko), "v"(aV[3][1] + ko) : "memory");
            const bf16x8 A = mkfrag(r0, r1);
            acc[0] = __builtin_amdgcn_mfma_f32_32x32x16_bf16(A, mkfrag(r2, r3), acc[0], 0, 0, 0);
            acc[1] = __builtin_amdgcn_mfma_f32_32x32x16_bf16(A, mkfrag(r4, r5), acc[1], 0, 0, 0);
            acc[2] = __builtin_amdgcn_mfma_f32_32x32x16_bf16(A, mkfrag(r6, r7), acc[2], 0, 0, 0);
            acc[3] = __builtin_amdgcn_mfma_f32_32x32x16_bf16(A, mkfrag(r8, r9), acc[3], 0, 0, 0);
        }
        bf16_t* o = st + st_index(b, h, dir, c);
#pragma unroll
        for (int et = 0; et < 4; ++et) { bf16_t* p = o + ((dt * 4 + et) * 64 + lane) * 16;
            *(u32x4*)p = (u32x4){pack2(acc[et][0], acc[et][1]), pack2(acc[et][2], acc[et][3]), pack2(acc[et][4], acc[et][5]), pack2(acc[et][6], acc[et][7])};
            *(u32x4*)(p + 8) = (u32x4){pack2(acc[et][8], acc[et][9]), pack2(acc[et][10], acc[et][11]), pack2(acc[et][12], acc[et][13]), pack2(acc[et][14], acc[et][15])}; }
    }
#undef RA_LOAD
}
__device__ __forceinline__ void phase_scan(const Args& a, int l, int bid, int nb) {
    bf16_t* st = (bf16_t*)(a.ws + WS_ST);
#pragma unroll 1
    for (int idx = bid * NT + otid(); idx < NB * 4 * 2 * 2048; idx += nb * NT) {
        const int chain = idx >> 11, v8 = idx & 2047, dir = chain & 1, h = (chain >> 1) & 3;
        const float dec = expf(-128.0f * expf(a.ret_decay[l * 8 + dir * 4 + h]));
        bf16_t* p = st + (size_t)chain * NCH * 16384 + v8 * 8;
        float S[8];
#pragma unroll
        for (int j = 0; j < 8; ++j) S[j] = 0.f;
#pragma unroll 1
        for (int half = 0; half < 2; ++half) {
            u32x4 ls[NCH / 2];
#pragma unroll
            for (int i = 0; i < NCH / 2; ++i) { const int ii = half * (NCH / 2) + i, c = dir == 0 ? ii : (ii < 2 ? 1 - ii : NCH + 1 - ii); ls[i] = *(const u32x4*)(p + (size_t)c * 16384); }
#pragma unroll
            for (int i = 0; i < NCH / 2; ++i) { const int ii = half * (NCH / 2) + i, c = dir == 0 ? ii : (ii < 2 ? 1 - ii : NCH + 1 - ii);
                *(u32x4*)(p + (size_t)c * 16384) = (u32x4){pack2(S[0], S[1]), pack2(S[2], S[3]), pack2(S[4], S[5]), pack2(S[6], S[7])};
#pragma unroll
                for (int t = 0; t < 4; ++t) { S[2 * t] = S[2 * t] * dec + lo16(ls[i][t]); S[2 * t + 1] = S[2 * t + 1] * dec + hi16(ls[i][t]); } }
        }
    }
}
__device__ __forceinline__ void phase_ret_b(const Args& a, int l, MLAS unsigned char* lds, int bid, int nb) {
    const int tid = otid(), lane = tid & 63, wave = __builtin_amdgcn_readfirstlane(tid >> 6);
    const bf16_t* proj = (const bf16_t*)(a.ws + WS_PROJ); const bf16_t* st = (const bf16_t*)(a.ws + WS_ST); bf16_t* mix = (bf16_t*)(a.ws + WS_H);
    const unsigned ldsb = (unsigned)(size_t)lds;
    const int dir = wave >> 2, it = wave & 3, hh = lane >> 5, il = it * 32 + (lane & 31);
    const int c_lo = l == 0 ? 0 : 2, ncu = NCH - c_lo;
    MLAS float* rope = (MLAS float*)(lds + LDS_ROPE);
    for (int i = tid; i < 64 * 32 * 2; i += NT) rope[i] = ((const float*)(a.ws + WS_ROPE))[i];
#define RB_DECODE(u_, b_, c_, h_, row0_) const int b_ = (u_) / (ncu * 4), c_ = c_lo + ((u_) >> 2) % ncu, h_ = (u_) & 3, row0_ = chunk_row0(b_, c_)
#define RB_LOAD(u_) do { RB_DECODE(u_, b_, c_, h_, row0_); (void)c_; _Pragma("unroll") for (int i = 0; i < 2; ++i) { const int idx = tid + i * NT, row = idx >> 3, ch0 = ((idx >> 2) & 1) * 8 + (idx & 3); \
        const bf16_t* src = proj + (size_t)(row0_ + row) * INC + h_ * 128; \
        raw[i][0] = *(const u32x4*)(src + C_QB + ch0 * 8); raw[i][1] = *(const u32x4*)(src + C_QB + (ch0 + 4) * 8); raw[i][2] = *(const u32x4*)(src + C_KB + ch0 * 8); raw[i][3] = *(const u32x4*)(src + C_KB + (ch0 + 4) * 8); \
        raw[i][4] = *(const u32x4*)(src + C_VB + ch0 * 8); raw[i][5] = *(const u32x4*)(src + C_VB + (ch0 + 4) * 8); } } while (0)
    u32x4 raw[2][6];
    if (bid < NB * ncu * 4) RB_LOAD(bid);
    LDS_BARRIER();
    for (int u = bid; u < NB * ncu * 4; u += nb) {
        RB_DECODE(u, b, c, h, row0);
        const float lg = -expf(a.ret_decay[l * 8 + dir * 4 + h]);
        LDS_BARRIER();
#pragma unroll
        for (int i = 0; i < 2; ++i) { const int idx = tid + i * NT, row = idx >> 3, a2 = (idx >> 2) & 1, fc = idx & 3, ch0 = a2 * 8 + fc;
            const int tok = c >= 2 ? (c - 2) * 128 + row : -1;
            const unsigned o0 = off_b(row, ch0), o1 = off_b(row, ch0 + 4);
            float y1[8], y2[8];
            rope_pair_regs(raw[i][0], raw[i][1], a2, fc, tok, rope, y1, y2);
            *(MLAS u32x4*)(lds + o0) = pack8(y1, 1.0f); *(MLAS u32x4*)(lds + o1) = pack8(y2, 1.0f);
            rope_pair_regs(raw[i][2], raw[i][3], a2, fc, tok, rope, y1, y2);
            *(MLAS u32x4*)(lds + 32768 + o0) = pack8(y1, RET_KSCALE); *(MLAS u32x4*)(lds + 32768 + o1) = pack8(y2, RET_KSCALE);
            *(MLAS u32x4*)(lds + 65536 + o0) = raw[i][4]; *(MLAS u32x4*)(lds + 65536 + o1) = raw[i][5]; }
        LDS_BARRIER();
        f32x16 acc[4];
#pragma unroll
        for (int et = 0; et < 4; ++et)
#pragma unroll
            for (int r = 0; r < 16; ++r) acc[et][r] = 0.f;
        {
            const bf16_t* sp = st + st_index(b, h, dir, c) + lane * 16;
#pragma unroll
            for (int dt = 0; dt < 4; ++dt)
#pragma unroll
                for (int s2 = 0; s2 < 2; ++s2) {
                    const u32x2 q0 = *(const MLAS u32x2*)(lds + off_b(il, 4 * dt + 2 * s2) + 8 * hh), q1 = *(const MLAS u32x2*)(lds + off_b(il, 4 * dt + 2 * s2 + 1) + 8 * hh);
                    const bf16x8 Bq = mkfrag(q0, q1);
#pragma unroll
                    for (int et = 0; et < 4; ++et) { const bf16x8 A = __builtin_bit_cast(bf16x8, *(const u32x4*)(sp + (dt * 4 + et) * 1024 + 8 * s2));
                        acc[et] = __builtin_amdgcn_mfma_f32_32x32x16_bf16(A, Bq, acc[et], 0, 0, 0); }
                }
            const float qdec = __expf((float)(dir == 0 ? il + 1 : 128 - il) * lg);
#pragma unroll
            for (int et = 0; et < 4; ++et)
#pragma unroll
                for (int r = 0; r < 16; ++r) acc[et][r] *= qdec;
        }
        bf16x8 Qn[8];
#pragma unroll
        for (int ks = 0; ks < 8; ++ks) Qn[ks] = *(const MLAS bf16x8*)(lds + off_b(il, 2 * ks + hh));
        const int jt_lo = dir == 0 ? 0 : it, jt_hi = dir == 0 ? it : 3;
        for (int jt = jt_lo; jt <= jt_hi; ++jt) {
            f32x16 sc;
#pragma unroll
            for (int r = 0; r < 16; ++r) sc[r] = 0.f;
#pragma unroll
            for (int ks = 0; ks < 8; ++ks) { const bf16x8 A = *(const MLAS bf16x8*)(lds + 32768 + off_b(jt * 32 + (lane & 31), 2 * ks + hh));
                sc = __builtin_amdgcn_mfma_f32_32x32x16_bf16(A, Qn[ks], sc, 0, 0, 0); }
            unsigned pk[8];
#pragma unroll
            for (int r = 0; r < 16; r += 2) {
                const int j0 = jt * 32 + (r & 3) + 8 * (r >> 2) + 4 * hh, j1 = j0 + 1;
                const int d0 = dir == 0 ? il - j0 : j0 - il, d1 = dir == 0 ? il - j1 : j1 - il;
                const float p0 = d0 >= 0 ? sc[r] * __expf((float)d0 * lg) : 0.f, p1 = d1 >= 0 ? sc[r + 1] * __expf((float)d1 * lg) : 0.f;
                pk[r >> 1] = pack2(p0, p1);
            }
            const bf16x8 P0 = __builtin_bit_cast(bf16x8, (u32x4){pk[0], pk[1], pk[2], pk[3]}), P1 = __builtin_bit_cast(bf16x8, (u32x4){pk[4], pk[5], pk[6], pk[7]});
#pragma unroll
            for (int et = 0; et < 4; ++et) {
                u32x2 r0, r1, r2, r3;
                const unsigned a0 = ldsb + 65536 + tr_addr(jt * 32 + 4 * hh, et, lane), a1 = ldsb + 65536 + tr_addr(jt * 32 + 8 + 4 * hh, et, lane);
                const unsigned a2 = ldsb + 65536 + tr_addr(jt * 32 + 16 + 4 * hh, et, lane), a3 = ldsb + 65536 + tr_addr(jt * 32 + 24 + 4 * hh, et, lane);
                asm volatile("ds_read_b64_tr_b16 %0, %4\n\tds_read_b64_tr_b16 %1, %5\n\tds_read_b64_tr_b16 %2, %6\n\tds_read_b64_tr_b16 %3, %7\n\ts_waitcnt lgkmcnt(0)"
                             : "=&v"(r0), "=&v"(r1), "=&v"(r2), "=&v"(r3) : "v"(a0), "v"(a1), "v"(a2), "v"(a3) : "memory");
                acc[et] = __builtin_amdgcn_mfma_f32_32x32x16_bf16(mkfrag(r0, r1), P0, acc[et], 0, 0, 0);
                acc[et] = __builtin_amdgcn_mfma_f32_32x32x16_bf16(mkfrag(r2, r3), P1, acc[et], 0, 0, 0);
            }
        }
        u32x4 gfr[4], gbr[4];
        { const bf16_t* gp = proj + (size_t)(row0 + (tid >> 2)) * INC + h * 128;
#pragma unroll
          for (int k = 0; k < 4; ++k) { const int ch = (tid & 3) * 4 + k; gfr[k] = *(const u32x4*)(gp + C_GF + ch * 8); gbr[k] = *(const u32x4*)(gp + C_GB + ch * 8); } }
        float s1 = 0.f;
#pragma unroll
        for (int et = 0; et < 4; ++et)
#pragma unroll
            for (int r = 0; r < 16; ++r) s1 += acc[et][r];
        s1 += __shfl_xor(s1, 32);
        const float mean = s1 * (1.0f / 128.0f);
        float s2 = 0.f;
#pragma unroll
        for (int et = 0; et < 4; ++et)
#pragma unroll
            for (int r = 0; r < 16; ++r) { const float dlt = acc[et][r] - mean; s2 += dlt * dlt; }
        s2 += __shfl_xor(s2, 32);
        const float rstd = rsqrtf(s2 * (1.0f / 128.0f) + 1e-5f);
        LDS_BARRIER();
#pragma unroll
        for (int et = 0; et < 4; ++et)
#pragma unroll
            for (int g = 0; g < 4; ++g) {
                const u32x2 w = {pack2((acc[et][4 * g] - mean) * rstd, (acc[et][4 * g + 1] - mean) * rstd), pack2((acc[et][4 * g + 2] - mean) * rstd, (acc[et][4 * g + 3] - mean) * rstd)};
                *(MLAS u32x2*)(lds + dir * 32768 + off_b(il, 4 * et + g) + 8 * hh) = w; }
        { const int un_ = u + nb < NB * ncu * 4 ? u + nb : u; RB_LOAD(un_); }
        LDS_BARRIER();
        {
            const int i = tid >> 2, part = tid & 3;
            bf16_t* op = mix + (size_t)(row0 + i) * D + 512 + h * 128;
#pragma unroll
            for (int k = 0; k < 4; ++k) { const int ch = part * 4 + k;
                const u32x4 of = *(const MLAS u32x4*)(lds + off_b(i, ch)), ob = *(const MLAS u32x4*)(lds + 32768 + off_b(i, ch));
                const u32x4 gf = gfr[k], gb = gbr[k];
                u32x4 o;
#pragma unroll
                for (int t = 0; t < 4; ++t) o[t] = pack2(lo16(of[t]) * siluf(lo16(gf[t])) + lo16(ob[t]) * siluf(lo16(gb[t])), hi16(of[t]) * siluf(hi16(gf[t])) + hi16(ob[t]) * siluf(hi16(gb[t])));
                *(u32x4*)(op + ch * 8) = o; }
        }
    }
#undef RB_DECODE
#undef RB_LOAD
}

constexpr int NA_OP = 72;
__device__ __forceinline__ int perm16(int x) { return (x & 3) | ((x & 4) << 1) | ((x & 8) >> 1); }
__device__ __forceinline__ void phase_na(const Args& a, int l, MLAS unsigned char* lds, int bid, int nb) {
    const int tid = otid(), lane = tid & 63, wave = __builtin_amdgcn_readfirstlane(tid >> 6);
    const bf16_t* proj = (const bf16_t*)(a.ws + WS_PROJ); bf16_t* mix = (bf16_t*)(a.ws + WS_H);
    const bf16_t* KC = (const bf16_t*)(a.ws + WS_KC); const bf16_t* VT = (const bf16_t*)(a.ws + WS_VT);
    const bf16_t* KCC = (const bf16_t*)(a.ws + WS_KCC); const bf16_t* VTC = (const bf16_t*)(a.ws + WS_VTC);
    MLAS float* rpb = (MLAS float*)lds;
    MLAS bf16_t* ost = (MLAS bf16_t*)(lds + 8192) + wave * 64 * NA_OP;
    const int n_lat = NB * 8 * 8, n_ctx = l == 0 ? NB * 4 : 0;
    const int hh = lane >> 5, ql = lane & 31;
    for (int u0 = bid; u0 < n_lat + n_ctx; u0 += nb) {
        int u = u0;
        if (nb == 256 && u0 < n_lat) { const int x = bid & 7, j = bid >> 3, i = u0 >> 8; u = ((i * 32 + x * 4 + (j >> 3)) << 3) + (j & 7); }
        const bool is_ctx = u >= n_lat;
        const int v = is_ctx ? u - n_lat : u;
        const int b = is_ctx ? v >> 2 : v >> 6, h = is_ctx ? 2 * (v & 3) + (wave >> 2) : (v >> 3) & 7;
        const int r = (v & 7) * 8 + wave;
        const int qrow0 = is_ctx ? TL + b * LC + (wave & 3) * 64 : b * SEQ + r * 64;
        const size_t bh = (size_t)b * 8 + h;
        __syncthreads();
        if (!is_ctx) for (int i = tid; i < 15 * 128; i += NT) { const int dr = i >> 7, x = (i & 127) - 48; rpb[i] = (x >= 0 && x < 31) ? a.na_rpb[((size_t)l * 8 + h) * 465 + dr * 31 + x] * 1.4426950408889634f : 0.f; }
        __syncthreads();
        bf16x8 Qf[2][4];
#pragma unroll
        for (int qt = 0; qt < 2; ++qt) {
            u32x4 qw[4]; float ss = 0.f;
#pragma unroll
            for (int ks = 0; ks < 4; ++ks) { qw[ks] = *(const u32x4*)(proj + (size_t)(qrow0 + 32 * qt + ql) * INC + C_QA + h * 64 + 16 * ks + 8 * hh);
#pragma unroll
                for (int t = 0; t < 4; ++t) { const float x0 = lo16(qw[ks][t]), x1 = hi16(qw[ks][t]); ss += x0 * x0 + x1 * x1; } }
            ss += __shfl_xor(ss, 32);
            const float rs = rsqrtf(ss * (1.0f / 64.0f) + 1e-6f) * 0.18033688011112042f;
#pragma unroll
            for (int ks = 0; ks < 4; ++ks) { const f32x4 w0 = *(const f32x4*)(a.na_q_norm + l * 64 + 16 * ks + 8 * hh), w1 = *(const f32x4*)(a.na_q_norm + l * 64 + 16 * ks + 8 * hh + 4);
                const u32x4 o = {pack2(lo16(qw[ks][0]) * rs * w0[0], hi16(qw[ks][0]) * rs * w0[1]), pack2(lo16(qw[ks][1]) * rs * w0[2], hi16(qw[ks][1]) * rs * w0[3]),
                                 pack2(lo16(qw[ks][2]) * rs * w1[0], hi16(qw[ks][2]) * rs * w1[1]), pack2(lo16(qw[ks][3]) * rs * w1[2], hi16(qw[ks][3]) * rs * w1[3])};
                Qf[qt][ks] = __builtin_bit_cast(bf16x8, o); }
        }
        f32x16 O[2][2];
#pragma unroll
        for (int qt = 0; qt < 2; ++qt)
#pragma unroll
            for (int i = 0; i < 16; ++i) { O[qt][0][i] = 0.f; O[qt][1][i] = 0.f; }
        float lsum[2] = {0.f, 0.f};
        const int r0 = min(max(r - 4, 0), 56);
        const int kslot = 16 * (ql >> 4) + perm16(ql & 15);
        const bf16_t* kl = KC + (bh * SEQ + (size_t)(r0 + (ql >> 4)) * 64 + perm16(ql & 15)) * 64 + 8 * hh;
        const bf16_t* vl = VT + ((bh * 256 + (size_t)r0 * 4) * 64 + ql) * 16 + 8 * hh;
        const bf16_t* kx = KCC + (bh * LC + kslot) * 64 + 8 * hh;
        const bf16_t* vx = VTC + ((bh * 16) * 64 + ql) * 16 + 8 * hh;
#define NA_PTRS(t, kp, vp, vstep) do { if ((t) < 16) { const int ip_ = (t) >> 2, ct_ = (t) & 3; kp = kl + (size_t)(2 * ip_ * 64 + 16 * ct_) * 64; vp = vl + (2 * ip_ * 4 + ct_) * 1024; vstep = 4096; } \
        else { kp = kx + (size_t)(32 * ((t) - 16)) * 64; vp = vx + ((t) - 16) * 2048; vstep = 1024; } } while (0)
#define NA_LOADS(kp, vp, vstep, Kd, Vd) do { _Pragma("unroll") for (int ks_ = 0; ks_ < 4; ++ks_) Kd[ks_] = *(const u32x4*)(kp + 16 * ks_); \
        Vd[0] = *(const u32x4*)(vp); Vd[1] = *(const u32x4*)(vp + vstep); Vd[2] = *(const u32x4*)(vp + 512); Vd[3] = *(const u32x4*)(vp + 512 + vstep); } while (0)
        const int t_lo = is_ctx ? 16 : 0;
        u32x4 Kn[4], Vn[4];
        { const bf16_t* kp; const bf16_t* vp; int vstep; NA_PTRS(t_lo, kp, vp, vstep); NA_LOADS(kp, vp, vstep, Kn, Vn); }
#pragma unroll 1
        for (int t = t_lo; t < 24; ++t) {
            u32x4 Kc[4], Vc[4];
#pragma unroll
            for (int i = 0; i < 4; ++i) { Kc[i] = Kn[i]; Vc[i] = Vn[i]; }
            if (t + 1 < 24) { const bf16_t* kp; const bf16_t* vp; int vstep; NA_PTRS(t + 1, kp, vp, vstep); NA_LOADS(kp, vp, vstep, Kn, Vn); }
            const int ip = t >> 2, ct = t & 3;
#pragma unroll
            for (int qt = 0; qt < 2; ++qt) {
                if (t < 16 && (unsigned)(ct - qt) > 2u) continue;
                f32x16 sc;
#pragma unroll
                for (int i = 0; i < 16; ++i) sc[i] = 0.f;
#pragma unroll
                for (int ks = 0; ks < 4; ++ks) sc = __builtin_amdgcn_mfma_f32_32x32x16_bf16(__builtin_bit_cast(bf16x8, Kc[ks]), Qf[qt][ks], sc, 0, 0, 0);
                unsigned pk[8];
                if (t < 16) {
                    const int q = qt * 32 + ql, c0 = min(max(q - 8, 0), 48);
#pragma unroll
                    for (int rr = 0; rr < 16; rr += 2) {
                        const int wi = 2 * ip + (rr >> 3), col = 16 * ct + (rr & 3) + 4 * ((rr >> 2) & 1) + 8 * hh;
                        const MLAS float* bp = rpb + (r0 + wi - r + 7) * 128 + (col - q + 63);
                        const float b0 = bp[0], b1 = bp[1];
                        const float e0 = __builtin_amdgcn_exp2f(sc[rr] + b0), e1 = __builtin_amdgcn_exp2f(sc[rr + 1] + b1);
                        const float p0 = (unsigned)(col - c0) < 16u ? e0 : 0.f, p1 = (unsigned)(col + 1 - c0) < 16u ? e1 : 0.f;
                        lsum[qt] += p0 + p1; pk[rr >> 1] = pack2(p0, p1);
                    }
                } else {
#pragma unroll
                    for (int rr = 0; rr < 16; rr += 2) { const float p0 = __builtin_amdgcn_exp2f(sc[rr]), p1 = __builtin_amdgcn_exp2f(sc[rr + 1]); lsum[qt] += p0 + p1; pk[rr >> 1] = pack2(p0, p1); }
                }
                const bf16x8 P0 = __builtin_bit_cast(bf16x8, (u32x4){pk[0], pk[1], pk[2], pk[3]}), P1 = __builtin_bit_cast(bf16x8, (u32x4){pk[4], pk[5], pk[6], pk[7]});
                O[qt][0] = __builtin_amdgcn_mfma_f32_32x32x16_bf16(__builtin_bit_cast(bf16x8, Vc[0]), P0, O[qt][0], 0, 0, 0);
                O[qt][0] = __builtin_amdgcn_mfma_f32_32x32x16_bf16(__builtin_bit_cast(bf16x8, Vc[1]), P1, O[qt][0], 0, 0, 0);
                O[qt][1] = __builtin_amdgcn_mfma_f32_32x32x16_bf16(__builtin_bit_cast(bf16x8, Vc[2]), P0, O[qt][1], 0, 0, 0);
                O[qt][1] = __builtin_amdgcn_mfma_f32_32x32x16_bf16(__builtin_bit_cast(bf16x8, Vc[3]), P1, O[qt][1], 0, 0, 0);
            }
        }
#undef NA_PTRS
#undef NA_LOADS
#pragma unroll
        for (int qt = 0; qt < 2; ++qt) {
            const float inv = 1.0f / (lsum[qt] + __shfl_xor(lsum[qt], 32));
#pragma unroll
            for (int g4 = 0; g4 < 4; ++g4) {
                *(MLAS u32x2*)(ost + (32 * qt + ql) * NA_OP + 8 * g4 + 4 * hh) = (u32x2){pack2(O[qt][0][4 * g4] * inv, O[qt][0][4 * g4 + 1] * inv), pack2(O[qt][0][4 * g4 + 2] * inv, O[qt][0][4 * g4 + 3] * inv)};
                *(MLAS u32x2*)(ost + (32 * qt + ql) * NA_OP + 32 + 8 * g4 + 4 * hh) = (u32x2){pack2(O[qt][1][4 * g4] * inv, O[qt][1][4 * g4 + 1] * inv), pack2(O[qt][1][4 * g4 + 2] * inv, O[qt][1][4 * g4 + 3] * inv)};
            }
        }
#pragma unroll
        for (int k = 0; k < 8; ++k) { const int idx = lane + 64 * k, row = idx >> 3, ch = idx & 7;
            *(u32x4*)(mix + (size_t)(qrow0 + row) * D + h * 64 + ch * 8) = *(const MLAS u32x4*)(ost + row * NA_OP + ch * 8); }
    }
}

constexpr int N2P = 1032;
typedef float f32x4v __attribute__((ext_vector_type(4)));
__device__ __forceinline__ void phase_norm2(const Args& a, int l, MLAS unsigned char* lds, int bid, int nb) {
    const int tid = otid(), lane = tid & 63, wave = __builtin_amdgcn_readfirstlane(tid >> 6);
    const int e0 = lane * 8, e1 = 512 + lane * 8;
    MLAS bf16_t* Ahi = (MLAS bf16_t*)lds; MLAS bf16_t* Alo = Ahi + 16 * N2P; MLAS float* part = (MLAS float*)(Alo + 16 * N2P);
    MLAS float* tsc = part + 8 * 16 * 32; MLAS float* tsh = tsc + 1024; int cur_r = -1;
    bf16_t* hb = (bf16_t*)(a.ws + WS_H);
    int* tok_e = (int*)(a.ws + WS_TOKE); int* tok_r = (int*)(a.ws + WS_TOKR); float* tok_w = (float*)(a.ws + WS_TOKW);
    unsigned* cnt = (unsigned*)(a.ws + WS_CNT) + l * 2048;
    MLAS unsigned* lcnt = (MLAS unsigned*)(tsh + 1024);
    if (tid < NE) lcnt[tid] = 0u;
    const int nrows = l == 0 ? TT : TL;
    bf16x8 Bh[4][2], Bl[4][2];
    { const bf16_t* rh = (const bf16_t*)(a.ws + WS_RWT); const bf16_t* rl = rh + 32 * 1024;
#pragma unroll
      for (int ks = 0; ks < 4; ++ks)
#pragma unroll
        for (int nt = 0; nt < 2; ++nt) { const int o = (nt * 16 + (lane & 15)) * 1024 + 128 * wave + 32 * ks + 8 * (lane >> 4);
            Bh[ks][nt] = __builtin_bit_cast(bf16x8, *(const u32x4*)(rh + o)); Bl[ks][nt] = __builtin_bit_cast(bf16x8, *(const u32x4*)(rl + o)); } }
    const float rbias = a.router_bias[lane & 31];
#define N2_BAR() do { asm volatile("s_waitcnt lgkmcnt(0)" ::: "memory"); __builtin_amdgcn_s_barrier(); asm volatile("" ::: "memory"); } while (0)
#define N2_LOAD(bt, dst) do { _Pragma("unroll") for (int jr_ = 0; jr_ < 2; ++jr_) { const int row_ = (bt) * 16 + 2 * wave + jr_; \
        if (row_ < TL) { const bf16_t* sb_ = (const bf16_t*)(a.ws + WS_XB) + (size_t)row_ * D; dst[jr_][0] = __builtin_bit_cast(f32x4, *(const u32x4*)(sb_ + e0)); dst[jr_][1] = __builtin_bit_cast(f32x4, *(const u32x4*)(sb_ + e1)); } \
        else { const float* src_ = (const float*)(a.ws + WS_CTX) + (size_t)(row_ - TL) * D; \
        dst[jr_][0] = *(const f32x4*)(src_ + e0); dst[jr_][1] = *(const f32x4*)(src_ + e0 + 4); dst[jr_][2] = *(const f32x4*)(src_ + e1); dst[jr_][3] = *(const f32x4*)(src_ + e1 + 4); } } } while (0)
    f32x4 vc[2][4];
    const int nbatch = nrows / 16;
    const int per = (nbatch + nb - 1) / nb, b_lo = bid * per, b_hi = min(b_lo + per, nbatch);
    if (b_lo < b_hi) N2_LOAD(b_lo, vc);
    for (int batch = b_lo; batch < b_hi; ++batch) {
        const int R0 = batch * 16, r = R0 < TL ? R0 / SEQ : 16;
        N2_BAR();
        if (r != cur_r) { cur_r = r; const float* sh = modp(a, l, r, 3); const float* sc = modp(a, l, r, 4); const float* w = a.norm_ffn_w + l * D;
            for (int k = tid; k < D; k += NT) { tsc[k] = (1.0f + sc[k]) * w[k]; tsh[k] = sh[k]; }
            N2_BAR(); }
#pragma unroll
        for (int jr = 0; jr < 2; ++jr) {
            const int m = 2 * wave + jr, row = R0 + m;
            float v[16];
            if (R0 < TL) { const u32x4 w0 = __builtin_bit_cast(u32x4, vc[jr][0]), w1 = __builtin_bit_cast(u32x4, vc[jr][1]);
#pragma unroll
                for (int j = 0; j < 4; ++j) { v[2 * j] = lo16(w0[j]); v[2 * j + 1] = hi16(w0[j]); v[8 + 2 * j] = lo16(w1[j]); v[8 + 2 * j + 1] = hi16(w1[j]); } }
            else {
#pragma unroll
                for (int j = 0; j < 4; ++j) { v[j] = vc[jr][0][j]; v[4 + j] = vc[jr][1][j]; v[8 + j] = vc[jr][2][j]; v[12 + j] = vc[jr][3][j]; } }
            float ss = 0.f;
#pragma unroll
            for (int j = 0; j < 16; ++j) ss += v[j] * v[j];
            ss = wave_sum(ss);
            const float rs = rsqrtf(ss * (1.0f / D) + 1e-6f);
            unsigned ph[8], pl[8];
            float msc[16], msh[16];
#pragma unroll
            for (int q = 0; q < 2; ++q) { const f32x4 c0 = *(const MLAS f32x4*)(tsc + e0 + 4 * q), c1 = *(const MLAS f32x4*)(tsc + e1 + 4 * q), h0 = *(const MLAS f32x4*)(tsh + e0 + 4 * q), h1 = *(const MLAS f32x4*)(tsh + e1 + 4 * q);
#pragma unroll
                for (int j = 0; j < 4; ++j) { msc[4 * q + j] = c0[j]; msc[8 + 4 * q + j] = c1[j]; msh[4 * q + j] = h0[j]; msh[8 + 4 * q + j] = h1[j]; } }
#pragma unroll
            for (int j = 0; j < 16; j += 2) {
                const float y0 = v[j] * rs * msc[j] + msh[j], y1 = v[j + 1] * rs * msc[j + 1] + msh[j + 1];
                const bf16_t h0 = f2bf(y0), h1 = f2bf(y1);
                ph[j >> 1] = (unsigned)h0 | ((unsigned)h1 << 16); pl[j >> 1] = pack2(y0 - bf2f(h0), y1 - bf2f(h1)); }
            bf16_t* hp = hb + (size_t)row * D;
            *(u32x4*)(hp + e0) = (u32x4){ph[0], ph[1], ph[2], ph[3]}; *(u32x4*)(hp + e1) = (u32x4){ph[4], ph[5], ph[6], ph[7]};
            *(MLAS u32x4*)(Ahi + m * N2P + e0) = (u32x4){ph[0], ph[1], ph[2], ph[3]}; *(MLAS u32x4*)(Ahi + m * N2P + e1) = (u32x4){ph[4], ph[5], ph[6], ph[7]};
            *(MLAS u32x4*)(Alo + m * N2P + e0) = (u32x4){pl[0], pl[1], pl[2], pl[3]}; *(MLAS u32x4*)(Alo + m * N2P + e1) = (u32x4){pl[4], pl[5], pl[6], pl[7]};
        }
        if (batch + 1 < b_hi) N2_LOAD(batch + 1, vc);
        N2_BAR();
        {
            f32x4v acc0 = {0.f, 0.f, 0.f, 0.f}, acc1 = {0.f, 0.f, 0.f, 0.f};
#pragma unroll
            for (int ks = 0; ks < 4; ++ks) {
                const int o = (lane & 15) * N2P + 128 * wave + 32 * ks + 8 * (lane >> 4);
                const bf16x8 ah = *(const MLAS bf16x8*)(Ahi + o), al = *(const MLAS bf16x8*)(Alo + o);
                acc0 = __builtin_amdgcn_mfma_f32_16x16x32_bf16(ah, Bh[ks][0], acc0, 0, 0, 0); acc0 = __builtin_amdgcn_mfma_f32_16x16x32_bf16(al, Bh[ks][0], acc0, 0, 0, 0); acc0 = __builtin_amdgcn_mfma_f32_16x16x32_bf16(ah, Bl[ks][0], acc0, 0, 0, 0);
                acc1 = __builtin_amdgcn_mfma_f32_16x16x32_bf16(ah, Bh[ks][1], acc1, 0, 0, 0); acc1 = __builtin_amdgcn_mfma_f32_16x16x32_bf16(al, Bh[ks][1], acc1, 0, 0, 0); acc1 = __builtin_amdgcn_mfma_f32_16x16x32_bf16(ah, Bl[ks][1], acc1, 0, 0, 0);
            }
#pragma unroll
            for (int rg = 0; rg < 4; ++rg) { const int m = 4 * (lane >> 4) + rg; part[(wave * 16 + m) * 32 + (lane & 15)] = acc0[rg]; part[(wave * 16 + m) * 32 + 16 + (lane & 15)] = acc1[rg]; }
        }
        N2_BAR();
        {
            const int m = tid >> 5, ex = tid & 31, hb32 = lane & 32, row = R0 + m;
            float acc = 0.f;
#pragma unroll
            for (int w8 = 0; w8 < 8; ++w8) acc += part[(w8 * 16 + m) * 32 + ex];
            const float sg = 1.0f / (1.0f + __expf(-acc)), ssel = sg + rbias;
            float best = -1e30f; int grp = 0;
#pragma unroll
            for (int g = 0; g < 8; ++g) {
                const float v0 = __shfl(ssel, hb32 + g * 4), v1 = __shfl(ssel, hb32 + g * 4 + 1), v2 = __shfl(ssel, hb32 + g * 4 + 2), v3 = __shfl(ssel, hb32 + g * 4 + 3);
                const float hi01 = fmaxf(v0, v1), lo01 = fminf(v0, v1), hi23 = fmaxf(v2, v3), lo23 = fminf(v2, v3);
                const float top = fmaxf(hi01, hi23), second = fmaxf(fminf(hi01, hi23), hi01 >= hi23 ? lo01 : lo23);
                const float gs = top + second;
                if (gs > best) { best = gs; grp = g; }
            }
            float w4[4], s4[4];
#pragma unroll
            for (int j = 0; j < 4; ++j) { w4[j] = __shfl(ssel, hb32 + grp * 4 + j); s4[j] = __shfl(sg, hb32 + grp * 4 + j); }
            int i0 = 0;
#pragma unroll
            for (int j = 1; j < 4; ++j) if (w4[j] > w4[i0]) i0 = j;
            int i1 = i0 == 0 ? 1 : 0;
#pragma unroll
            for (int j = 0; j < 4; ++j) if (j != i0 && j != i1 && w4[j] > w4[i1]) i1 = j;
            float g0 = 0.f, g1 = 0.f;
#pragma unroll
            for (int j = 0; j < 4; ++j) { g0 = (j == i0) ? s4[j] : g0; g1 = (j == i1) ? s4[j] : g1; }
            const float inv = 1.0f / (g0 + g1);
            if (ex < 2) {
                const int e = grp * 4 + (ex == 0 ? i0 : i1);
                const unsigned rank = __hip_atomic_fetch_add(lcnt + e, 1u, __ATOMIC_RELAXED, __HIP_MEMORY_SCOPE_WORKGROUP);
                tok_e[row * 2 + ex] = e; tok_r[row * 2 + ex] = (int)rank; tok_w[row * 2 + ex] = (ex == 0 ? g0 : g1) * inv;
            }
        }
    }
    N2_BAR();
    if (tid < NE) ((int*)(a.ws + WS_BLKB))[bid * NE + tid] = (int)atomicAdd(cnt + tid * 32, lcnt[tid]);
#undef N2_BAR
#undef N2_LOAD
}
__device__ __forceinline__ void phase_gather(const Args& a, int l, MLAS unsigned char* lds, int bid, int nb) {
    const int tid = otid(), lane = tid & 63, wave = tid >> 6;
    MLAS int* pbase = (MLAS int*)lds;
    MLAS int* cn = pbase + 64;
    const unsigned* cnt = (const unsigned*)(a.ws + WS_CNT) + l * 2048; const int* blkb = (const int*)(a.ws + WS_BLKB);
    if (tid == 0) { int acc = 0; for (int e = 0; e < NE; ++e) { const int c = (int)__hip_atomic_load(cnt + e * 32, __ATOMIC_RELAXED, __HIP_MEMORY_SCOPE_AGENT); cn[e] = c; pbase[e] = acc; acc += (c + 255) & ~255; } pbase[NE] = acc; }
    __syncthreads();
    int* rinfo = (int*)(a.ws + WS_RINFO); float* rw = (float*)(a.ws + WS_RW); int* blke = (int*)(a.ws + WS_BLKE);
    if (bid == 0) {
        for (int e = 0; e < NE; ++e) {
            for (int p = pbase[e] + cn[e] + tid; p < pbase[e + 1]; p += NT) { rinfo[p] = -1; rw[p] = 0.f; }
            for (int blk = (pbase[e] >> 8) + tid; blk < (pbase[e + 1] >> 8); blk += NT) blke[blk] = e;
        }
        if (tid == 0) blke[1023] = (pbase[NE] >> 8) * 4;
    }
    const int* tok_e = (const int*)(a.ws + WS_TOKE); const int* tok_r = (const int*)(a.ws + WS_TOKR); const float* tok_w = (const float*)(a.ws + WS_TOKW);
    const int nas = (l == 0 ? TT : TL) * 2, per_ = ((l == 0 ? TT : TL) / 16 + nb - 1) / nb;
    for (int as = bid * NT + tid; as < nas; as += nb * NT) {
        const int t = as >> 1, e = tok_e[as], pos = pbase[e] + blkb[((t >> 4) / per_) * NE + e] + tok_r[as];
        rinfo[pos] = as; ((int*)(a.ws + WS_TOKR))[as] = pos;
    }
}

using pg8::Unit;
struct EpiStoreBf16 {
    static constexpr bool PERM = true, AFTER_DRAIN = false;
    bf16_t* O; int ldc; bf16_t* kc_lat; bf16_t* vt_lat; bf16_t* kc_ctx; bf16_t* vt_ctx; const float* knw; MLAS unsigned char* sp;
    __device__ __forceinline__ void operator()(const f32x4 (&acc)[2][2][4][2], const Unit& u, int wr, int wc, int fr, int fq) const {
        const int row0 = u.pm * 256 + wr * 64 + fr;
        if (u.pn < 2 || u.pn > 5) {
            const int col0 = u.pn * 256 + wc * 32 + 8 * fq;
#pragma unroll
            for (int ai = 0; ai < 2; ++ai)
#pragma unroll
                for (int m = 0; m < 4; ++m) { bf16_t* rowp = O + (size_t)(row0 + ai * 128 + m * 16) * ldc + col0;
#pragma unroll
                    for (int bj = 0; bj < 2; ++bj) { const f32x4 v0 = acc[ai][bj][m][0], v1 = acc[ai][bj][m][1];
                        *(u32x4*)(rowp + bj * 128) = (u32x4){pg8::cvt_pk_bf16(v0[0], v0[1]), pg8::cvt_pk_bf16(v0[2], v0[3]), pg8::cvt_pk_bf16(v1[0], v1[1]), pg8::cvt_pk_bf16(v1[2], v1[3])}; } }
            return;
        }
        const bool lat = u.pm < 256;
        if (u.pn < 4) {
            MLAS float* part = (MLAS float*)sp;
            float ss[2][4][2];
#pragma unroll
            for (int ai = 0; ai < 2; ++ai)
#pragma unroll
                for (int m = 0; m < 4; ++m)
#pragma unroll
                    for (int bj = 0; bj < 2; ++bj) { const f32x4 v0 = acc[ai][bj][m][0], v1 = acc[ai][bj][m][1];
                        float q = (v0[0] * v0[0] + v0[1] * v0[1]) + (v0[2] * v0[2] + v0[3] * v0[3]) + (v1[0] * v1[0] + v1[1] * v1[1]) + (v1[2] * v1[2] + v1[3] * v1[3]);
                        q += __shfl_xor(q, 16); q += __shfl_xor(q, 32); ss[ai][m][bj] = q;
                        if (fq == 0) part[((((ai * 4 + m) * 2 + bj) * 2 + wr) * 16 + fr) * 4 + wc] = q; }
            asm volatile("s_waitcnt lgkmcnt(0)" ::: "memory"); __builtin_amdgcn_s_barrier(); asm volatile("" ::: "memory");
            const f32x4 w0 = *(const f32x4*)(knw + (wc & 1) * 32 + 8 * fq), w1 = *(const f32x4*)(knw + (wc & 1) * 32 + 8 * fq + 4);
#pragma unroll
            for (int ai = 0; ai < 2; ++ai)
#pragma unroll
                for (int m = 0; m < 4; ++m) { const int row = row0 + ai * 128 + m * 16;
                    const int b = lat ? row >> 12 : (row - TL) >> 8, t = lat ? row & (SEQ - 1) : (row - TL) & (LC - 1), tlen = lat ? SEQ : LC;
                    bf16_t* kb = (lat ? kc_lat : kc_ctx);
#pragma unroll
                    for (int bj = 0; bj < 2; ++bj) {
                        const float other = part[((((ai * 4 + m) * 2 + bj) * 2 + wr) * 16 + fr) * 4 + (wc ^ 1)];
                        const float rs = rsqrtf((ss[ai][m][bj] + other) * (1.0f / 64.0f) + 1e-6f);
                        const f32x4 v0 = acc[ai][bj][m][0] * rs * w0, v1 = acc[ai][bj][m][1] * rs * w1;
                        const int head = (u.pn - 2) * 4 + 2 * bj + (wc >> 1);
                        *(u32x4*)(kb + (((size_t)b * 8 + head) * tlen + t) * 64 + (wc & 1) * 32 + 8 * fq) = (u32x4){pg8::cvt_pk_bf16(v0[0], v0[1]), pg8::cvt_pk_bf16(v0[2], v0[3]), pg8::cvt_pk_bf16(v1[0], v1[1]), pg8::cvt_pk_bf16(v1[2], v1[3])}; } }
            return;
        }
        {
            MLAS bf16_t* gb = (MLAS bf16_t*)(sp + wr * 8192);
            bf16_t* vb = lat ? vt_lat : vt_ctx; const int ngrp = lat ? SEQ / 16 : LC / 16;
#pragma unroll
            for (int ai = 0; ai < 2; ++ai)
#pragma unroll
                for (int m = 0; m < 4; ++m) {
#pragma unroll
                    for (int bj = 0; bj < 2; ++bj)
#pragma unroll
                        for (int n = 0; n < 2; ++n) { const f32x4 v = acc[ai][bj][m][n]; const int c = bj * 128 + wc * 32 + 8 * fq + 4 * n;
                            const unsigned p01 = pg8::cvt_pk_bf16(v[0], v[1]), p23 = pg8::cvt_pk_bf16(v[2], v[3]);
                            gb[(c + 0) * 16 + fr] = (bf16_t)(p01 & 0xffffu); gb[(c + 1) * 16 + fr] = (bf16_t)(p01 >> 16);
                            gb[(c + 2) * 16 + fr] = (bf16_t)(p23 & 0xffffu); gb[(c + 3) * 16 + fr] = (bf16_t)(p23 >> 16); }
                    asm volatile("s_waitcnt lgkmcnt(0)" ::: "memory"); __builtin_amdgcn_s_barrier(); asm volatile("" ::: "memory");
                    const int rowb = u.pm * 256 + ai * 128 + wr * 64 + m * 16;
                    const int b = lat ? rowb >> 12 : (rowb - TL) >> 8, g16 = (lat ? rowb & (SEQ - 1) : (rowb - TL) & (LC - 1)) >> 4;
#pragma unroll
                    for (int k = 0; k < 2; ++k) { const int qd = wc * 64 + fr + 16 * fq + 256 * k, c = qd >> 1, half = qd & 1;
                        const u32x4 w = *(const MLAS u32x4*)(gb + c * 16 + 8 * half);
                        const int head = (u.pn - 4) * 4 + (c >> 6), d = c & 63;
                        *(u32x4*)(vb + ((((size_t)b * 8 + head) * ngrp + g16) * 64 + d) * 16 + 8 * half) = w; }
                    asm volatile("s_waitcnt lgkmcnt(0)" ::: "memory"); __builtin_amdgcn_s_barrier(); asm volatile("" ::: "memory");
                }
        }
    }
};
struct EpiResGate {
    static constexpr bool PERM = true, AFTER_DRAIN = false;
    const void* xin_lat; const float* xin_ctx; bf16_t* out_lat; float* out_ctx; const float* modl; int in_bf16;
    __device__ __forceinline__ void operator()(const f32x4 (&acc)[2][2][4][2], const Unit& u, int wr, int wc, int fr, int fq) const {
        const bool lat = u.pm < 256; const int r = lat ? (u.pm >> 4) : 16;
        const int rowt = (lat ? u.pm : u.pm - 256) * 256 + wr * 64 + fr, col0 = u.pn * 256 + wc * 32 + 8 * fq;
        const float* g = modl + (size_t)r * 6144 + 2 * 1024 + col0;
        f32x4 gv[2][2];
#pragma unroll
        for (int bj = 0; bj < 2; ++bj)
#pragma unroll
            for (int n = 0; n < 2; ++n) gv[bj][n] = *(const f32x4*)(g + bj * 128 + 4 * n);
#pragma unroll
        for (int ai = 0; ai < 2; ++ai)
#pragma unroll
            for (int m = 0; m < 4; ++m) { const size_t off = (size_t)(rowt + ai * 128 + m * 16) * D + col0;
#pragma unroll
                for (int bj = 0; bj < 2; ++bj) {
                    f32x4 x0, x1;
                    if (!lat) { x0 = *(const f32x4*)(xin_ctx + off + bj * 128); x1 = *(const f32x4*)(xin_ctx + off + bj * 128 + 4); }
                    else if (in_bf16) { const u32x4 w = *(const u32x4*)((const bf16_t*)xin_lat + off + bj * 128); x0 = (f32x4){lo16(w.x), hi16(w.x), lo16(w.y), hi16(w.y)}; x1 = (f32x4){lo16(w.z), hi16(w.z), lo16(w.w), hi16(w.w)}; }
                    else { x0 = *(const f32x4*)((const float*)xin_lat + off + bj * 128); x1 = *(const f32x4*)((const float*)xin_lat + off + bj * 128 + 4); }
                    x0 += gv[bj][0] * acc[ai][bj][m][0]; x1 += gv[bj][1] * acc[ai][bj][m][1];
                    if (lat) *(u32x4*)(out_lat + off + bj * 128) = (u32x4){pack2(x0[0], x0[1]), pack2(x0[2], x0[3]), pack2(x1[0], x1[1]), pack2(x1[2], x1[3])};
                    else { *(f32x4*)(out_ctx + off + bj * 128) = x0; *(f32x4*)(out_ctx + off + bj * 128 + 4) = x1; } } }
    }
};
struct EpiSwiglu {
    static constexpr bool PERM = true, AFTER_DRAIN = false;
    bf16_t* act;
    __device__ __forceinline__ void operator()(const f32x4 (&acc)[2][2][4][2], const Unit& u, int wr, int wc, int fr, int fq) const {
        const int row0 = u.pm * 256 + wr * 64 + fr, col0 = (u.pn & 3) * 128 + wc * 32 + 8 * fq;
#pragma unroll
        for (int ai = 0; ai < 2; ++ai)
#pragma unroll
            for (int m = 0; m < 4; ++m) { float r[8];
#pragma unroll
                for (int n = 0; n < 2; ++n)
#pragma unroll
                    for (int j = 0; j < 4; ++j) { const float gt = acc[ai][0][m][n][j]; r[n * 4 + j] = siluf(gt) * acc[ai][1][m][n][j]; }
                *(u32x4*)(act + (size_t)(row0 + ai * 128 + m * 16) * DFF + col0) = (u32x4){pg8::cvt_pk_bf16(r[0], r[1]), pg8::cvt_pk_bf16(r[2], r[3]), pg8::cvt_pk_bf16(r[4], r[5]), pg8::cvt_pk_bf16(r[6], r[7])}; }
    }
};
struct EpiDown {
    static constexpr bool PERM = true, AFTER_DRAIN = false;
    bf16_t* ys;
    __device__ __forceinline__ void operator()(const f32x4 (&acc)[2][2][4][2], const Unit& u, int wr, int wc, int fr, int fq) const {
        const int row0 = u.pm * 256 + wr * 64 + fr, col0 = (u.pn & 3) * 256 + wc * 32 + 8 * fq;
#pragma unroll
        for (int ai = 0; ai < 2; ++ai)
#pragma unroll
            for (int m = 0; m < 4; ++m) { bf16_t* rowp = ys + (size_t)(row0 + ai * 128 + m * 16) * D + col0;
#pragma unroll
                for (int bj = 0; bj < 2; ++bj) { const f32x4 v0 = acc[ai][bj][m][0], v1 = acc[ai][bj][m][1];
                    *(u32x4*)(rowp + bj * 128) = (u32x4){pg8::cvt_pk_bf16(v0[0], v0[1]), pg8::cvt_pk_bf16(v0[2], v0[3]), pg8::cvt_pk_bf16(v1[0], v1[1]), pg8::cvt_pk_bf16(v1[2], v1[3])}; } }
    }
};
struct MoeOrder {
    const MLAS int* blke; int nunits, G, c;
    __device__ __forceinline__ bool next(int i, Unit& u) const { const int x = c & 7, j = c >> 3; int L;
        if (G == 256) { const int rb = i * 64 + (j >> 2) * 8 + x; L = rb * 4 + (j & 3); } else L = i * G + c;
        if (L >= nunits) return false; u.pm = L >> 2; u.pn = blke[L >> 2] * 4 + (L & 3); return true; }
    __device__ __forceinline__ void a_ready(const Unit&) const {}
    __device__ __forceinline__ void done(const Unit&) const {}
};

typedef const Args __attribute__((address_space(4))) CArgs;
#define MK_LOAD_ARGS(a, p) do { (a).x = (p)->x; (a).c = (p)->c; (a).ctx = (p)->ctx; (a).c_ctx = (p)->c_ctx; (a).ada_w = (p)->ada_w; (a).ada_b = (p)->ada_b; (a).norm_mix_w = (p)->norm_mix_w; (a).norm_ffn_w = (p)->norm_ffn_w; (a).w_in = (p)->w_in; (a).na_q_norm = (p)->na_q_norm; (a).na_k_norm = (p)->na_k_norm; (a).na_rpb = (p)->na_rpb; (a).ret_decay = (p)->ret_decay; (a).w_out = (p)->w_out; (a).router_w = (p)->router_w; (a).router_bias = (p)->router_bias; (a).w_gate = (p)->w_gate; (a).w_up = (p)->w_up; (a).w_down = (p)->w_down; (a).out = (p)->out; (a).ws = (p)->ws; (a).ph_lo = (p)->ph_lo; (a).ph_hi = (p)->ph_hi; } while (0)
#ifndef MK_SINGLE
#define MK_SINGLE 1
#endif
constexpr int NPHASES = 24;
#ifndef MK_PROBE_MASK
#define MK_PROBE_MASK 0
#endif
#ifndef MK_BAR2
#define MK_BAR2 0
#endif
#ifndef MK_PROBE_MULT
#define MK_PROBE_MULT 4
#endif
enum { K_PRO = 0, K_NORM1, K_GEMM_IN, K_PREP, K_NA, K_RET_A, K_SCAN, K_RET_B, K_GEMM_OUT, K_NORM2, K_GATHER, K_MOE1, K_MOE2, K_FINAL };
__global__ void __launch_bounds__(NT, 2) fwd(Args ka) {
    extern __shared__ __attribute__((aligned(16))) unsigned char lds_raw[];
    MLAS unsigned char* lds = (MLAS unsigned char*)lds_raw;
    const int tid = threadIdx.x, nb = gridDim.x;
    volatile MLAS unsigned* ctl = (volatile MLAS unsigned*)(lds + LDS_CTL);
    if (tid < 4) ctl[tid] = 0u;
    __syncthreads();
    const bool multi = MK_SINGLE != 0;
    XcdBarrier bar; bar.bar = (unsigned*)(ka.ws + WS_BAR); bar.x = 0; bar.st = ctl;
    if (multi) bar = xcd_barrier_post((unsigned*)(ka.ws + WS_BAR), ctl);
    int ph = 0;
#if MK_SINGLE
#define MK_GUARD 1
#define MK_SEAM(kind) ((kind) != K_FINAL)
#else
#define MK_GUARD (ph >= ka.ph_lo && ph < ka.ph_hi)
#define MK_SEAM(kind) (ph + 1 < ka.ph_hi)
#endif
#define PHASE(kind, ...) do { if (MK_GUARD) { CArgs* ap_ = (CArgs*)__builtin_amdgcn_kernarg_segment_ptr(); asm volatile("" : "+s"(ap_)); Args a; MK_LOAD_ARGS(a, ap_); int bid = blockIdx.x; asm volatile("" : "+s"(bid)); unsigned long long t0_ = 0; if ((MK_PROBE_MASK >> (kind)) & 1) t0_ = wall_clock64(); { __VA_ARGS__; } if ((MK_PROBE_MASK >> (kind)) & 1) { const unsigned long long d_ = wall_clock64() - t0_; while (wall_clock64() - t0_ < d_ * (MK_PROBE_MULT + 1)) __builtin_amdgcn_s_sleep(8); } if (MK_SEAM(kind)) { XcdBarrier b_ = bar; asm volatile("" : "+s"(b_.bar), "+s"(b_.x)); xcd_barrier(b_); if (MK_BAR2) { xcd_barrier(b_); xcd_barrier(b_); } } } ++ph; } while (0)
    PHASE(K_PRO, { convert_small(a, bid, nb); convert_weights(a, true, 0, lds, bid, nb, 0, 2560 + 3 * 4096, wgu_of(a, 0), wdn_of(a, 0)); compute_mod(a, lds, bid, nb); });
#define MK_LAYER(l) do { \
        PHASE(K_NORM1, { phase_norm1(a, l, bid, nb); if (l == 1) convert_weights(a, false, 1, lds, bid, nb, cv_nbub(nb), 3 * 4096, wgu_of(a, 1), wdn_of(a, 1)); }); \
        PHASE(K_GEMM_IN, { pg8::Gemm g{(const bf16_t*)(a.ws + WS_H), (const bf16_t*)(a.ws + WS_WIN) + (size_t)l * INC * D, TT, INC, D}; \
                pg8::StaticOrder S; S.init(TT, INC, nb, bid); \
                EpiStoreBf16 E{(bf16_t*)(a.ws + WS_PROJ), INC, (bf16_t*)(a.ws + WS_KC), (bf16_t*)(a.ws + WS_VT), (bf16_t*)(a.ws + WS_KCC), (bf16_t*)(a.ws + WS_VTC), a.na_k_norm + l * 64, lds + 131072}; \
                pg8::gemm_phase<EpiStoreBf16, pg8::StaticOrder>(lds, g, S, E, nullptr); }); \
        PHASE(K_NA, phase_na(a, l, lds, bid, nb)); \
        PHASE(K_RET_A, phase_ret_a(a, l, lds, bid, nb)); \
        PHASE(K_SCAN, phase_scan(a, l, bid, nb)); \
        PHASE(K_RET_B, phase_ret_b(a, l, lds, bid, nb)); \
        PHASE(K_GEMM_OUT, { const int M = l == 0 ? TT : TL; \
                pg8::Gemm g{(const bf16_t*)(a.ws + WS_H), (const bf16_t*)(a.ws + WS_WOUT) + (size_t)l * D * D, M, D, D}; \
                pg8::StaticOrder S; S.init(M, D, nb, bid); \
                EpiResGate E{l == 0 ? (const void*)a.x : (const void*)a.out, a.ctx, (bf16_t*)(a.ws + WS_XB), (float*)(a.ws + WS_CTX), (const float*)(a.ws + WS_MOD) + (size_t)l * 17 * 6144, l}; \
                pg8::gemm_phase<EpiResGate, pg8::StaticOrder>(lds, g, S, E, nullptr); \
                if (l == 0 && bid >= cv_rem(nb)) convert_weights(a, false, 1, lds, bid - cv_rem(nb), nb - cv_rem(nb), 0, cv_nbub(nb), wgu_of(a, 1), wdn_of(a, 1)); }); \
        PHASE(K_NORM2, phase_norm2(a, l, lds, bid, nb)); \
        PHASE(K_GATHER, phase_gather(a, l, lds, bid, nb)); \
        PHASE(K_MOE1, { MLAS int* blke = (MLAS int*)(lds + 131072); { const int* gb_ = (const int*)(a.ws + WS_BLKE); for (int i_ = otid(); i_ < 1024; i_ += NT) blke[i_] = gb_[i_]; __syncthreads(); } \
                pg8::Gemm g{(const bf16_t*)(a.ws + WS_H), (const bf16_t*)wgu_of(a, l), PMAX, NE * 1024, D, (const int*)(a.ws + WS_RINFO)}; \
                MoeOrder S{blke, blke[1023], nb, bid}; \
                EpiSwiglu E{(bf16_t*)(a.ws + WS_ACT)}; \
                pg8::gemm_phase<EpiSwiglu, MoeOrder, false, true>(lds, g, S, E, nullptr); }); \
        PHASE(K_MOE2, { MLAS int* blke = (MLAS int*)(lds + 131072); { const int* gb_ = (const int*)(a.ws + WS_BLKE); for (int i_ = otid(); i_ < 1024; i_ += NT) blke[i_] = gb_[i_]; __syncthreads(); } \
                pg8::Gemm g{(const bf16_t*)(a.ws + WS_ACT), (const bf16_t*)wdn_of(a, l), PMAX, NE * 1024, DFF}; \
                MoeOrder S{blke, blke[1023], nb, bid}; \
                EpiDown E{(bf16_t*)(a.ws + WS_XS)}; \
                pg8::gemm_phase<EpiDown, MoeOrder>(lds, g, S, E, nullptr); }); \
    } while (0)
    MK_LAYER(0);
    MK_LAYER(1);
#undef MK_LAYER
    PHASE(K_FINAL, phase_final(a, bid, nb));
#undef PHASE
}
}

extern "C" void kernel_launch(void* const* d_in, const int* in_sizes, int n_in, void* d_out, int out_size, void* d_ws, size_t ws_size, hipStream_t stream) {
    using namespace mk;
    static int grid = 0;
    if (grid == 0) {
        if (n_in != 19 || in_sizes[0] != TL * D || out_size != TL * D || ws_size < WS_END) {
            fprintf(stderr, "kernel_launch: unexpected shapes / workspace (n_in %d, in0 %d, out %d, ws %zu, need %zu); nothing launched\n", n_in, n_in > 0 ? in_sizes[0] : -1, out_size, ws_size, (size_t)WS_END);
            grid = -1; return; }
        int dev = 0, cus = 0, per_cu = 0;
        if (hipGetDevice(&dev) != hipSuccess || hipDeviceGetAttribute(&cus, hipDeviceAttributeMultiprocessorCount, dev) != hipSuccess) { grid = -1; return; }
        if (hipFuncSetAttribute((const void*)fwd, hipFuncAttributeMaxDynamicSharedMemorySize, LDS_BYTES) != hipSuccess) { fprintf(stderr, "kernel_launch: hipFuncSetAttribute failed\n"); grid = -1; return; }
        if (hipOccupancyMaxActiveBlocksPerMultiprocessor(&per_cu, (const void*)fwd, NT, LDS_BYTES) != hipSuccess || per_cu < 1) { fprintf(stderr, "kernel_launch: occupancy query says %d\n", per_cu); (void)hipGetLastError(); grid = -1; return; }
        grid = cus;
    }
    if (grid < 0) return;
    (void)hipMemsetAsync((char*)d_ws + WS_BAR, 0, WS_ZERO_BYTES, stream);
    Args a{};
    a.x = (const float*)d_in[0]; a.c = (const float*)d_in[1]; a.ctx = (const float*)d_in[2]; a.c_ctx = (const float*)d_in[3]; a.ada_w = (const float*)d_in[4]; a.ada_b = (const float*)d_in[5];
    a.norm_mix_w = (const float*)d_in[6]; a.norm_ffn_w = (const float*)d_in[7]; a.w_in = (const float*)d_in[8]; a.na_q_norm = (const float*)d_in[9]; a.na_k_norm = (const float*)d_in[10];
    a.na_rpb = (const float*)d_in[11]; a.ret_decay = (const float*)d_in[12]; a.w_out = (const float*)d_in[13]; a.router_w = (const float*)d_in[14]; a.router_bias = (const float*)d_in[15];
    a.w_gate = (const float*)d_in[16]; a.w_up = (const float*)d_in[17]; a.w_down = (const float*)d_in[18];
    a.out = (float*)d_out; a.ws = (unsigned char*)d_ws;
#if MK_SINGLE
    a.ph_lo = 0; a.ph_hi = NPHASES;
    hipLaunchKernelGGL(fwd, dim3(grid), dim3(NT), LDS_BYTES, stream, a);
#else
    for (int ph = 0; ph < NPHASES; ++ph) { a.ph_lo = ph; a.ph_hi = ph + 1; hipLaunchKernelGGL(fwd, dim3(grid), dim3(NT), LDS_BYTES, stream, a); }
#endif
}
```

```cpp
#include <hip/hip_runtime.h>
#include <cstdio>
#include <cstdint>

#define XB_TMO      128
#define XB_XCNT(j)  (256  + 64 * (j))
#define XB_XSUB(j)  (1280 + 64 * (j))
#define XB_XGEN(j)  (2304 + 64 * (j))
#define XB_TOP      3328
#define XB_TOPGEN   3392
#define XCD_BAR_WORDS 3456
#define XB_SPIN_CAP (1u << 18)
#define LAS __attribute__((address_space(3)))

__device__ __forceinline__ unsigned xb_ld(unsigned* p)              { return __hip_atomic_load(p, __ATOMIC_RELAXED, __HIP_MEMORY_SCOPE_AGENT); }
__device__ __forceinline__ unsigned xb_add(unsigned* p, unsigned v) { return __hip_atomic_fetch_add(p, v, __ATOMIC_RELAXED, __HIP_MEMORY_SCOPE_AGENT); }
__device__ __forceinline__ unsigned xb_xcc_id() { return (unsigned)__builtin_amdgcn_s_getreg((3 << 11) | 20) & 0xFu; }
#define XB_SPIN(cond, bar) do { unsigned _sp = 0; while (cond) { __builtin_amdgcn_s_sleep(1); \
    if ((++_sp & 255u) == 0u) { if (xb_ld(&(bar)[XB_TMO])) break; if (_sp > XB_SPIN_CAP) { atomicAdd(&(bar)[XB_TMO], 1u); break; } } } } while (0)

struct XcdBarrier {
    unsigned* bar; unsigned x;
    volatile LAS unsigned* st;
};

__device__ __forceinline__ XcdBarrier xcd_barrier_post(unsigned* bar, volatile LAS unsigned* st) {
    XcdBarrier b; b.bar = bar; b.x = xb_xcc_id(); b.st = st;
    if (threadIdx.x == 0) (void)xb_add(&bar[XB_XCNT(b.x)], 1u);
    return b;
}
__device__ __forceinline__ void xcd_barrier_complete(unsigned* bar, unsigned x, unsigned& nloc, unsigned& nx) {
    const unsigned G = gridDim.x * gridDim.y * gridDim.z;
    unsigned sum, cnt, mine, sp = 0u;
    for (;;) {
        sum = 0u; cnt = 0u; mine = 0u;
#pragma unroll
        for (unsigned j = 0; j < 16; ++j) { const unsigned c = xb_ld(&bar[XB_XCNT(j)]); sum += c; cnt += (c > 0u) ? 1u : 0u; mine = (j == x) ? c : mine; }
        if (sum == G) break;
        __builtin_amdgcn_s_sleep(1);
        if ((++sp & 255u) == 0u) { if (xb_ld(&bar[XB_TMO])) break; if (sp > XB_SPIN_CAP) { atomicAdd(&bar[XB_TMO], 1u); break; } }
    }
    nloc = mine > 0u ? mine : 1u; nx = cnt > 0u ? cnt : 1u;
}

__device__ __forceinline__ void xcd_barrier(const XcdBarrier& b) {
    asm volatile("s_waitcnt vmcnt(0)" ::: "memory");
    __syncthreads();
    if (threadIdx.x == 0) {
        unsigned* bar = b.bar;
        __builtin_amdgcn_s_waitcnt(0);
        unsigned nloc = b.st[0], nx = b.st[1];
        if (nloc == 0u) { xcd_barrier_complete(bar, b.x, nloc, nx); b.st[0] = nloc; b.st[1] = nx; }
        const unsigned old = xb_add(&bar[XB_XSUB(b.x)], 1u);
        const unsigned gen = old / nloc;
        if (old + 1u == (gen + 1u) * nloc) {
            __builtin_amdgcn_fence(__ATOMIC_RELEASE, "agent");
            asm volatile("s_waitcnt vmcnt(0)" ::: "memory");
            const unsigned og = xb_add(&bar[XB_TOP], 1u);
            const unsigned tg = og / nx;
            if (og + 1u == (tg + 1u) * nx) xb_add(&bar[XB_TOPGEN], 1u);
            else XB_SPIN(xb_ld(&bar[XB_TOPGEN]) == tg, bar);
            __builtin_amdgcn_fence(__ATOMIC_ACQUIRE, "agent");
            xb_add(&bar[XB_XGEN(b.x)], 1u);
            asm volatile("s_waitcnt vmcnt(0)" ::: "memory");
        } else {
            XB_SPIN(xb_ld(&bar[XB_XGEN(b.x)]) == gen, bar);
            __builtin_amdgcn_fence(__ATOMIC_ACQUIRE, "agent");
            asm volatile("s_waitcnt vmcnt(0)" ::: "memory");
        }
    }
    __syncthreads();
}
namespace pg8 {
#define PG8_LAS __attribute__((address_space(3)))
typedef unsigned short bf16_t;
typedef short bf16x8 __attribute__((ext_vector_type(8)));
typedef float f32x4 __attribute__((ext_vector_type(4)));
typedef unsigned u32x4 __attribute__((ext_vector_type(4)));
constexpr int BM = 256, BK = 64, HALF = 128, HTB = HALF * BK * 2  , STAGE_BYTES = 8 * HTB, NXCD = 8, WGM = 8;

__host__ __device__ __forceinline__ int lds_byte(int r, int c) { const int st = (r >> 4) * 2 + (c >> 5), rr = r & 15, cc = c & 31, ob = rr * 64 + cc * 2; return st * 1024 + (ob ^ (((ob >> 9) & 1) << 5)); }
__host__ __device__ __forceinline__ void stage_rc(int b, int& R, int& C) { const int st = b / 1024, sb = b % 1024, swz = sb ^ (((sb >> 9) & 1) << 5); R = (st >> 1) * 16 + swz / 64; C = (st & 1) * 32 + (swz % 64) / 2; }
typedef int i32x4 __attribute__((ext_vector_type(4)));
typedef int i32x8 __attribute__((ext_vector_type(8)));
__host__ __device__ __forceinline__ int perm32(int rho) { const int n = rho >> 4, i = rho & 15; return 8 * (i >> 2) + 4 * n + (i & 3); }

struct Unit { int pm, pn; };
struct Gemm { const bf16_t* A; const bf16_t* Bt; int M, N, K; const int* rows = nullptr; int sc = 0x7f7f7f7f; };

struct StaticOrder {
    int nM, nN, nwg, G, c;
    __host__ __device__ void init(int M, int N, int G_, int c_) { nM = M / BM; nN = N / BM; nwg = nM * nN; G = G_; c = c_; }
    __host__ __device__ bool next(int i, Unit& u) const {
        const long L = (long)i * G + c; if (L >= nwg) return false;
        int wgid = (int)L; { const int q = nwg / NXCD, r = nwg % NXCD, xcd = wgid % NXCD, off = wgid / NXCD; wgid = (xcd < r ? xcd * (q + 1) : r * (q + 1) + (xcd - r) * q) + off; }
        const int nig = WGM * nN, gid = wgid / nig, fm = gid * WGM, gsz = (nM - fm) < WGM ? (nM - fm) : WGM;
        u.pm = fm + ((wgid % nig) % gsz); u.pn = (wgid % nig) / gsz; return true;
    }
    __device__ __forceinline__ void a_ready(const Unit&) const {}
    __device__ __forceinline__ void done(const Unit&) const {}
};
__device__ __forceinline__ unsigned cvt_pk_bf16(float lo, float hi) { unsigned r; asm volatile("v_cvt_pk_bf16_f32 %0, %1, %2" : "=v"(r) : "v"(lo), "v"(hi)); return r; }
typedef float f32x2 __attribute__((ext_vector_type(2)));
template <class Epi, class Sched, bool STAMP = false, bool GATHER = false, int ES = 2>
__device__ __forceinline__ void gemm_phase(PG8_LAS unsigned char* lds, const Gemm g, const Sched& S, const Epi& E, unsigned long long* stamps) {
    int tid_o_ = threadIdx.x; asm volatile("" : "+v"(tid_o_)); const int tid = tid_o_, wid = __builtin_amdgcn_readfirstlane(tid >> 6), lane = tid & 63, wr = wid >> 2, wc = wid & 3, fr = lane & 15, fq = lane >> 4;
    const int K = g.K, nt = K * ES / (BK * 2);
    int ts_lo = 0, ts_hi = 0, nts = 0; const unsigned long long rt_entry = STAMP ? (unsigned long long)wall_clock64() : 0ull;
#define PG8_STAMP() do { if (STAMP && wid == 0 && nts < 64) { const unsigned long long _c = (unsigned long long)clock64(); \
        ts_lo = (lane == nts) ? (int)(unsigned)_c : ts_lo; ts_hi = (lane == nts) ? (int)(unsigned)(_c >> 32) : ts_hi; ++nts; } } while (0)
    PG8_STAMP();
    unsigned voffA[2], voffB[2]; int rA_[2]; unsigned cA_[2];
#pragma unroll
    for (int i = 0; i < 2; ++i) { int R, C; stage_rc(tid * 16 + i * 8192, R, C); C *= 2; const int Rb = Epi::PERM ? ((R & ~31) + perm32(R & 31)) : R;
        voffA[i] = (unsigned)(R * K * ES + C); voffB[i] = (unsigned)(Rb * K * ES + C); rA_[i] = R; cA_[i] = (unsigned)C; }
    unsigned gA[2][2], v2_[2][2];
#define PG8_ROWS(u, dst) do { _Pragma("unroll") for (int h_ = 0; h_ < 2; ++h_) _Pragma("unroll") for (int i_ = 0; i_ < 2; ++i_) { const int as_ = g.rows[(u).pm * BM + h_ * HALF + rA_[i_]]; \
        dst[h_][i_] = (unsigned)(as_ < 0 ? 0 : as_ >> 1) * (unsigned)(K * ES) + cA_[i_]; } } while (0)
    const size_t kstep = (size_t)(BK * 2);
    const size_t hstep = (size_t)HALF * K * ES;
    const size_t b64_ = (size_t)64 * K * ES;
    const size_t tstep = 2 * hstep;
    const unsigned ldsw = (unsigned)wid * 1024u;
    const int aoff = lds_byte(wr * 64 + fr, fq * 8), boff = lds_byte(wc * 32 + fr, fq * 8);
#define PG8_SA(b, h) (((b) * 2 + (h)) * HTB)
#define PG8_SB(b, h) ((4 + (b) * 2 + (h)) * HTB)
#define PG8_STAGE(bufoff, gbase, voff) do { _Pragma("unroll") for (int _i = 0; _i < 2; ++_i) { unsigned vo_ = (voff)[_i]; asm volatile("" : "+v"(vo_));     \
        __builtin_amdgcn_global_load_lds((const unsigned*)((const char*)(gbase) + vo_), (PG8_LAS unsigned*)(lds + (bufoff) + ldsw + _i * 8192), 16, 0, 0); } } while (0)
#define PG8_STAGEB(bufoff, gbase) do { unsigned vo_ = voffB[0]; asm volatile("" : "+v"(vo_));     \
        __builtin_amdgcn_global_load_lds((const unsigned*)((const char*)(gbase) + vo_), (PG8_LAS unsigned*)(lds + (bufoff) + ldsw), 16, 0, 0); \
        __builtin_amdgcn_global_load_lds((const unsigned*)((const char*)(gbase) + b64_ + vo_), (PG8_LAS unsigned*)(lds + (bufoff) + ldsw + 8192), 16, 0, 0); } while (0)
#define PG8_LDA(dst, b, h) do { _Pragma("unroll") for (int m = 0; m < 4; ++m) _Pragma("unroll") for (int k = 0; k < 2; ++k) dst[m][k] = *(const PG8_LAS bf16x8*)(lds + PG8_SA(b, h) + aoff + m * 2048 + k * 1024); } while (0)
#define PG8_LDB(dst, b, h) do { _Pragma("unroll") for (int n = 0; n < 2; ++n) _Pragma("unroll") for (int k = 0; k < 2; ++k) dst[n][k] = *(const PG8_LAS bf16x8*)(lds + PG8_SB(b, h) + boff + n * 2048 + k * 1024); } while (0)
#define PG8_CAT(f) __builtin_shufflevector(__builtin_bit_cast(i32x4, f[0]), __builtin_bit_cast(i32x4, f[1]), 0, 1, 2, 3, 4, 5, 6, 7)
#define PG8_MMA(ai, bj, At, Bt) do { __builtin_amdgcn_s_setprio(1); _Pragma("unroll") for (int m = 0; m < 4; ++m) _Pragma("unroll") for (int n = 0; n < 2; ++n) { \
        if constexpr (ES == 2) { _Pragma("unroll") for (int k = 0; k < 2; ++k) acc[ai][bj][m][n] = __builtin_amdgcn_mfma_f32_16x16x32_bf16(Bt[n][k], At[m][k], acc[ai][bj][m][n], 0, 0, 0); } \
        else { const i32x8 b8_ = PG8_CAT(Bt[n]), a8_ = PG8_CAT(At[m]); asm volatile("v_mfma_scale_f32_16x16x128_f8f6f4 %0, %1, %2, %0, %3, %3 op_sel_hi:[0,0,0]" : "+v"(acc[ai][bj][m][n]) : "v"(b8_), "v"(a8_), "v"(sc_)); } } __builtin_amdgcn_s_setprio(0); } while (0)
#define PG8_WAIT_V(n) asm volatile("s_waitcnt vmcnt(" #n ")" ::: "memory")
#define PG8_WAIT_L(n) asm volatile("s_waitcnt lgkmcnt(" #n ")" ::: "memory")
#define PG8_BAR __builtin_amdgcn_s_barrier()
#define PG8_SCHED __builtin_amdgcn_sched_barrier(0)
    const int sc_ = g.sc;
    Unit cur, nxt; int ui = 0;
    if (!S.next(0, cur)) return;
    f32x4 acc[2][2][4][2];
#pragma unroll
    for (int a = 0; a < 2; ++a)
#pragma unroll
        for (int b = 0; b < 2; ++b)
#pragma unroll
            for (int m = 0; m < 4; ++m)
#pragma unroll
                for (int n = 0; n < 2; ++n) acc[a][b][m][n] = (f32x4){0.f, 0.f, 0.f, 0.f};
    bf16x8 At[4][2], B0[2][2], B1[2][2];
    const char* cA = (const char*)g.A + (GATHER ? (size_t)0 : (size_t)cur.pm * tstep); const char* cB = (const char*)g.Bt + (size_t)cur.pn * tstep;
    S.a_ready(cur);
    if (GATHER) { PG8_ROWS(cur, gA); }
    const size_t hstepA = GATHER ? (size_t)0 : hstep;
#define PG8_VA(h) (GATHER ? gA[h] : voffA)
    PG8_STAGEB(PG8_SB(0, 0), cB); PG8_STAGE(PG8_SA(0, 0), cA, PG8_VA(0)); PG8_STAGEB(PG8_SB(0, 1), cB + hstep); PG8_STAGE(PG8_SA(0, 1), cA + hstepA, PG8_VA(1));
    if (wr == 1) PG8_BAR;
    PG8_WAIT_V(4); PG8_BAR;
    PG8_STAGEB(PG8_SB(1, 0), cB + kstep); PG8_STAGE(PG8_SA(1, 0), cA + kstep, PG8_VA(0)); PG8_STAGEB(PG8_SB(1, 1), cB + hstep + kstep);
    PG8_WAIT_V(6); PG8_BAR;
    PG8_STAMP();
    for (;;) {
        const bool has_next = S.next(ui + 1, nxt);
        if (GATHER && has_next && wid == 0) { unsigned lo_ = threadIdx.x; asm volatile("" : "+v"(lo_)); lo_ = (lo_ & 63u) * 16u;
            __builtin_amdgcn_global_load_lds((const unsigned*)((const char*)(g.rows + (size_t)nxt.pm * BM) + lo_), (PG8_LAS unsigned*)(lds + STAGE_BYTES + 4096 + ((ui + 1) & 1) * 1024), 16, 0, 0); }
        const char* nA = (has_next && !GATHER) ? (const char*)g.A + (size_t)nxt.pm * tstep : cA; const char* nB = has_next ? (const char*)g.Bt + (size_t)nxt.pn * tstep : cB;
        for (int t = 0; t < nt; t += 2) {
            const bool last = (t == nt - 2);
            const char* a1 = cA + (size_t)(t + 1) * kstep;
            const char* a2 = last ? nA : cA + (size_t)(t + 2) * kstep; const char* b2 = last ? nB : cB + (size_t)(t + 2) * kstep;
            const char* a3 = a2 + kstep; const char* b3 = b2 + kstep;
            if (last && has_next) S.a_ready(nxt);
            if (GATHER) { _Pragma("unroll") for (int h_ = 0; h_ < 2; ++h_) _Pragma("unroll") for (int i_ = 0; i_ < 2; ++i_) v2_[h_][i_] = gA[h_][i_]; }
            if (GATHER && last && has_next) { const PG8_LAS int* rl_ = (const PG8_LAS int*)(lds + STAGE_BYTES + 4096 + ((ui + 1) & 1) * 1024);
                int tq_ = threadIdx.x; asm volatile("" : "+v"(tq_));
                _Pragma("unroll") for (int i_ = 0; i_ < 2; ++i_) { int R_, C_; stage_rc(tq_ * 16 + i_ * 8192, R_, C_);
                    _Pragma("unroll") for (int h_ = 0; h_ < 2; ++h_) { const int as_ = rl_[h_ * HALF + R_]; v2_[h_][i_] = (unsigned)(as_ < 0 ? 0 : as_ >> 1) * (unsigned)(K * ES) + (unsigned)(C_ * 2); } } }
#define PG8_V2(h) (GATHER ? v2_[h] : voffA)
            PG8_LDB(B0, 0, 0); PG8_SCHED; PG8_LDA(At, 0, 0); PG8_STAGE(PG8_SA(1, 1), a1 + hstepA, PG8_VA(1));
            PG8_WAIT_L(8); PG8_BAR; PG8_WAIT_L(0); PG8_MMA(0, 0, At, B0); PG8_BAR; PG8_SCHED;
            PG8_LDB(B1, 0, 1); PG8_STAGEB(PG8_SB(0, 0), b2);
            PG8_BAR; PG8_WAIT_L(0); PG8_MMA(0, 1, At, B1); PG8_BAR;
            PG8_LDA(At, 0, 1); PG8_STAGE(PG8_SA(0, 0), a2, PG8_V2(0));
            PG8_BAR; PG8_WAIT_L(0); PG8_MMA(1, 0, At, B0); PG8_BAR; PG8_SCHED;
            PG8_STAGEB(PG8_SB(0, 1), b2 + hstep);
            PG8_WAIT_V(6); PG8_BAR; PG8_MMA(1, 1, At, B1); PG8_BAR;
            PG8_LDB(B0, 1, 0); PG8_SCHED; PG8_LDA(At, 1, 0); PG8_STAGE(PG8_SA(0, 1), a2 + hstepA, PG8_V2(1));
            PG8_WAIT_L(8); PG8_BAR; PG8_WAIT_L(0); PG8_MMA(0, 0, At, B0); PG8_BAR; PG8_SCHED;
            PG8_LDB(B1, 1, 1); PG8_STAGEB(PG8_SB(1, 0), b3);
            PG8_BAR; PG8_WAIT_L(0); PG8_MMA(0, 1, At, B1); PG8_BAR;
            PG8_LDA(At, 1, 1); PG8_STAGE(PG8_SA(1, 0), a3, PG8_V2(0));
            PG8_BAR; PG8_WAIT_L(0); PG8_MMA(1, 0, At, B0); PG8_BAR; PG8_SCHED;
            PG8_STAGEB(PG8_SB(1, 1), b3 + hstep);
            PG8_WAIT_V(6); PG8_BAR; PG8_MMA(1, 1, At, B1); PG8_BAR;
        }
        PG8_STAMP();
        if constexpr (ES == 1) asm volatile("s_nop 15\n\ts_nop 15\n\ts_nop 15" ::: "memory");
        if constexpr (!Epi::AFTER_DRAIN) { int te_ = threadIdx.x; asm volatile("" : "+v"(te_));
            E(acc, cur, __builtin_amdgcn_readfirstlane(te_ >> 8), __builtin_amdgcn_readfirstlane((te_ >> 6) & 3), te_ & 15, (te_ >> 4) & 3); S.done(cur); }
        PG8_STAMP();
        if (!has_next) break;
#pragma unroll
        for (int a = 0; a < 2; ++a)
#pragma unroll
            for (int b = 0; b < 2; ++b)
#pragma unroll
                for (int m = 0; m < 4; ++m)
#pragma unroll
                    for (int n = 0; n < 2; ++n) acc[a][b][m][n] = (f32x4){0.f, 0.f, 0.f, 0.f};
        cur = nxt; cA = nA; cB = nB; ++ui;
        if (GATHER) { _Pragma("unroll") for (int h_ = 0; h_ < 2; ++h_) _Pragma("unroll") for (int i_ = 0; i_ < 2; ++i_) gA[h_][i_] = v2_[h_][i_]; }
    }
    PG8_WAIT_V(0);
    if (wr == 0) PG8_BAR;
    PG8_BAR;
    if constexpr (Epi::AFTER_DRAIN) { E.fused(acc, cur, wr, wc, fr, fq, lds, wid, lane); S.done(cur); }
    PG8_STAMP();
    if (STAMP && wid == 0) { stamps[lane] = lane < nts ? (((unsigned long long)(unsigned)ts_hi << 32) | (unsigned)ts_lo) : 0ull;
        if (lane == 62) stamps[62] = rt_entry; if (lane == 63) stamps[63] = (unsigned long long)wall_clock64(); }
#undef PG8_STAMP
#undef PG8_SA
#undef PG8_SB
#undef PG8_STAGE
#undef PG8_STAGEB
#undef PG8_LDA
#undef PG8_LDB
#undef PG8_MMA
#undef PG8_CAT
#undef PG8_WAIT_V
#undef PG8_WAIT_L
#undef PG8_BAR
#undef PG8_SCHED
#undef PG8_ROWS
#undef PG8_VA
#undef PG8_V2
}
}

namespace mk {
#define MLAS __attribute__((address_space(3)))
typedef unsigned short bf16_t;
typedef float f32x4 __attribute__((ext_vector_type(4)));
typedef unsigned u32x4 __attribute__((ext_vector_type(4)));
typedef unsigned u32x2 __attribute__((ext_vector_type(2)));

constexpr int D = 1024, NB = 16, SEQ = 4096, LC = 256, TL = NB * SEQ, TC = NB * LC, TT = TL + TC;
constexpr int INC = 4096, NE = 32, DFF = 512, NCH = 34, PMAX = 147456, NT = 512;
constexpr int LDS_BYTES = 150 * 1024, LDS_CTL = LDS_BYTES - 256;
constexpr int C_QA = 0, C_KA = 512, C_VA = 1024, C_QB = 1536, C_KB = 2048, C_VB = 2560, C_GF = 3072, C_GB = 3584;

constexpr size_t al256(size_t x) { return (x + 255) & ~(size_t)255; }
constexpr size_t WS_BAR = 0;
constexpr size_t WS_CNT = 16384;
constexpr size_t WS_ZERO_BYTES = 16384 + 16384;
constexpr size_t WS_MOD = WS_ZERO_BYTES;
constexpr size_t WS_WIN = al256(WS_MOD + (size_t)2 * 17 * 6144 * 4);
constexpr size_t WS_WOUT = WS_WIN + (size_t)2 * 4096 * 1024 * 2;
constexpr size_t WS_WGU = WS_WOUT + (size_t)2 * 1024 * 1024 * 2;
constexpr size_t WS_WDN = WS_WGU + (size_t)32 * 1024 * 1024 * 2;
constexpr size_t WS_CTX = WS_WDN + (size_t)32 * 1024 * 512 * 2;
constexpr size_t WS_H = WS_CTX + (size_t)TC * D * 4;
constexpr size_t WS_PROJ = WS_H + (size_t)TT * D * 2;
constexpr size_t WS_XS = WS_PROJ;
constexpr size_t WS_ACT = WS_PROJ + (size_t)PMAX * D * 2;
constexpr size_t WS_XB = WS_PROJ + (size_t)TT * INC * 2;
constexpr size_t WS_ST = WS_PROJ + (size_t)TT * INC * 2;
constexpr size_t WS_KC = WS_ST;
constexpr size_t WS_VT = WS_KC + (size_t)128 * 4096 * 64 * 2;
constexpr size_t WS_KCC = WS_VT + (size_t)128 * 4096 * 64 * 2;
constexpr size_t WS_VTC = WS_KCC + (size_t)128 * 256 * 64 * 2;
static_assert(WS_VTC + (size_t)128 * 256 * 64 * 2 <= WS_ST + (size_t)NB * 4 * 2 * NCH * 16384 * 2, "NA operand copies fit in the state region");
constexpr size_t WS_TOKE = WS_ST + (size_t)NB * 4 * 2 * NCH * 16384 * 2;
constexpr size_t WS_TOKR = WS_TOKE + (size_t)TT * 2 * 4;
constexpr size_t WS_TOKW = WS_TOKR + (size_t)TT * 2 * 4;
constexpr size_t WS_RINFO = WS_TOKW + (size_t)TT * 2 * 4;
constexpr size_t WS_RW = WS_RINFO + (size_t)PMAX * 4;
constexpr size_t WS_BLKE = WS_RW + (size_t)PMAX * 4;
constexpr size_t WS_RWT = WS_BLKE + 4096;
constexpr size_t WS_BLKB = WS_RWT + (size_t)2 * 32 * 1024 * 2;
constexpr size_t WS_ROPE = WS_BLKB + (size_t)1024 * 32 * 4;
constexpr size_t WS_END = WS_ROPE + (size_t)64 * 32 * 8;
static_assert(WS_ACT + (size_t)PMAX * DFF * 2 <= WS_ST && WS_XB == WS_ST && (size_t)TL * D * 2 <= (size_t)NB * 4 * 2 * NCH * 16384 * 2, "ys | act fit in the proj region, xb in the state region");
static_assert((size_t)TT * 2 * D * 2 <= (size_t)PMAX * D * 2, "y2 fits in xs region");
static_assert(WS_END <= (size_t)1 << 30, "workspace must fit in 1 GiB");

struct Args {
    const float* x; const float* c; const float* ctx; const float* c_ctx; const float* ada_w; const float* ada_b;
    const float* norm_mix_w; const float* norm_ffn_w; const float* w_in; const float* na_q_norm; const float* na_k_norm;
    const float* na_rpb; const float* ret_decay; const float* w_out; const float* router_w; const float* router_bias;
    const float* w_gate; const float* w_up; const float* w_down;
    float* out; unsigned char* ws; int ph_lo, ph_hi;
};

#define LDS_BARRIER() do { asm volatile("s_waitcnt lgkmcnt(0)" ::: "memory"); __builtin_amdgcn_s_barrier(); asm volatile("" ::: "memory"); } while (0)
__device__ __forceinline__ int otid() { int t = threadIdx.x; asm volatile("" : "+v"(t)); return t; }
__device__ __forceinline__ float bf2f(bf16_t v) { return __uint_as_float(((unsigned)v) << 16); }
__device__ __forceinline__ bf16_t f2bf(float f) { unsigned u = __float_as_uint(f); u += 0x7FFFu + ((u >> 16) & 1u); return (bf16_t)(u >> 16); }
typedef float f32x2_t __attribute__((ext_vector_type(2)));
typedef __bf16 bf16x2_t __attribute__((ext_vector_type(2)));
__device__ __forceinline__ unsigned pack2(float lo, float hi) { const f32x2_t v = {lo, hi}; return __builtin_bit_cast(unsigned, __builtin_convertvector(v, bf16x2_t)); }
__device__ __forceinline__ unsigned pack4_fp8(float a, float b, float c, float d) {
    a = __builtin_amdgcn_fmed3f(a, -448.0f, 448.0f); b = __builtin_amdgcn_fmed3f(b, -448.0f, 448.0f); c = __builtin_amdgcn_fmed3f(c, -448.0f, 448.0f); d = __builtin_amdgcn_fmed3f(d, -448.0f, 448.0f);
    int p = __builtin_amdgcn_cvt_pk_fp8_f32(a, b, 0, false); p = __builtin_amdgcn_cvt_pk_fp8_f32(c, d, p, true); return (unsigned)p; }
constexpr float WG8_SCALE = 64.0f, WU8_SCALE = 512.0f, WDN8_SCALE = 32.0f;
constexpr int SC_MOE1 = 0x7c7c7c7c, SC_MOE2 = 0x7b7b7b7b;
__device__ __forceinline__ float lo16(unsigned w) { return __uint_as_float(w << 16); }
__device__ __forceinline__ float hi16(unsigned w) { return __uint_as_float(w & 0xffff0000u); }
__device__ __forceinline__ float siluf(float v) { return v * __builtin_amdgcn_rcpf(1.0f + __builtin_amdgcn_exp2f(-1.4426950408889634f * v)); }
__device__ __forceinline__ float wave_sum(float v) {
#pragma unroll
    for (int o = 32; o >= 1; o >>= 1) v += __shfl_xor(v, o);
    return v;
}

typedef short bf16x8 __attribute__((ext_vector_type(8)));
typedef float f32x16 __attribute__((ext_vector_type(16)));
__device__ __forceinline__ unsigned off_b(unsigned row, unsigned ch) { return 256u * row + 16u * (ch ^ (((row & 3) << 2) | ((row >> 2) & 3))); }
__device__ __forceinline__ unsigned tr_addr(unsigned row0, unsigned c, unsigned lane) { const unsigned blk = (lane >> 4) & 1, q = (lane & 15) >> 2, p = lane & 3; return off_b(row0 + q, 4 * c + 2 * blk + (p >> 1)) + 8 * (p & 1); }
__device__ __forceinline__ bf16x8 mkfrag(u32x2 lo, u32x2 hi) { const u32x4 w = {lo.x, lo.y, hi.x, hi.y}; return __builtin_bit_cast(bf16x8, w); }
__device__ __forceinline__ int st_frag_idx(int d, int e) { return (((d >> 5) * 4 + (e >> 5)) * 64 + (e & 31) + 32 * ((d >> 2) & 1)) * 16 + (d & 3) + 4 * ((d & 31) >> 3); }
__device__ __forceinline__ const float* modp(const Args& a, int l, int r, int k6) { return (const float*)(a.ws + WS_MOD) + ((size_t)l * 17 + r) * 6144 + k6 * 1024; }

__device__ __forceinline__ void cvt_addr(const Args& a, bool with_dense, int le, int t, int tid, const float*& lp, bf16_t*& sp) {
    const float* src; bf16_t* dst; int ldn, ldk, k0, n0, nd0;
    if (with_dense && t < 2560) {
        if (t < 2048) { const int l = t >> 10, tt = t & 1023; k0 = (tt >> 6) * 64; n0 = (tt & 63) * 64; nd0 = n0; src = a.w_in + (size_t)l * D * INC; ldn = INC; dst = (bf16_t*)(a.ws + WS_WIN) + (size_t)l * INC * D; ldk = D; }
        else { const int t2 = t - 2048, l = t2 >> 8, tt = t2 & 255; k0 = (tt >> 4) * 64; n0 = (tt & 15) * 64; nd0 = n0; src = a.w_out + (size_t)l * D * D; ldn = D; dst = (bf16_t*)(a.ws + WS_WOUT) + (size_t)l * D * D; ldk = D; }
    } else {
        const int te = with_dense ? t - 2560 : t, which = te >> 12, tt = te & 4095, e = tt >> 7, r = tt & 127;
        if (which < 2) { k0 = (r >> 3) * 64; n0 = (r & 7) * 64; nd0 = (n0 >> 7) * 256 + which * 128 + (n0 & 127); src = (which == 0 ? a.w_gate : a.w_up) + ((size_t)le * NE + e) * D * DFF; ldn = DFF; dst = (bf16_t*)(a.ws + WS_WGU + (size_t)e * 1024 * D); ldk = D; }
        else { k0 = (r >> 4) * 64; n0 = (r & 15) * 64; nd0 = n0; src = a.w_down + ((size_t)le * NE + e) * DFF * D; ldn = D; dst = (bf16_t*)(a.ws + WS_WDN + (size_t)e * 1024 * DFF); ldk = DFF; }
    }
    lp = src + (size_t)(k0 + (tid >> 3)) * ldn + n0 + (tid & 7) * 8;
    const size_t so = (size_t)(nd0 + (tid >> 3)) * ldk + k0 + (tid & 7) * 8;
    sp = (with_dense && t < 2560) ? dst + so : (bf16_t*)((unsigned char*)dst + so);
}
__device__ __forceinline__ void convert_weights(const Args& a, bool with_dense, int le, MLAS unsigned char* lds, int bid, int nb) {
    MLAS float* tl = (MLAS float*)lds; const int tid = otid();
    const int N = (with_dense ? 2560 : 0) + 3 * 4096;
    const float* lp; bf16_t* sp;
    f32x4 v0 = {0.f, 0.f, 0.f, 0.f}, v1 = v0;
    if (bid < N) { cvt_addr(a, with_dense, le, bid, tid, lp, sp); v0 = *(const f32x4*)lp; v1 = *(const f32x4*)(lp + 4); }
    for (int t = bid; t < N; t += nb) {
        cvt_addr(a, with_dense, le, t, tid, lp, sp);
        LDS_BARRIER();
        { const int kk = tid >> 3, nn0 = (tid & 7) * 8;
#pragma unroll
          for (int j = 0; j < 4; ++j) { tl[kk * 65 + nn0 + j] = v0[j]; tl[kk * 65 + nn0 + 4 + j] = v1[j]; } }
        { const int tn = t + nb < N ? t + nb : t; const float* lpn; bf16_t* spn; cvt_addr(a, with_dense, le, tn, tid, lpn, spn); (void)spn; v0 = *(const f32x4*)lpn; v1 = *(const f32x4*)(lpn + 4); }
        LDS_BARRIER();
        { const int n = tid >> 3, kc = (tid & 7) * 8;
          if (with_dense && t < 2560) { u32x4 w;
            w.x = pack2(tl[(kc + 0) * 65 + n], tl[(kc + 1) * 65 + n]); w.y = pack2(tl[(kc + 2) * 65 + n], tl[(kc + 3) * 65 + n]);
            w.z = pack2(tl[(kc + 4) * 65 + n], tl[(kc + 5) * 65 + n]); w.w = pack2(tl[(kc + 6) * 65 + n], tl[(kc + 7) * 65 + n]);
            *(u32x4*)sp = w; }
          else { u32x2 w;
            const int wh_ = (with_dense ? t - 2560 : t) >> 12; const float ws = wh_ == 0 ? WG8_SCALE : wh_ == 1 ? WU8_SCALE : WDN8_SCALE;
            w.x = pack4_fp8(ws * tl[(kc + 0) * 65 + n], ws * tl[(kc + 1) * 65 + n], ws * tl[(kc + 2) * 65 + n], ws * tl[(kc + 3) * 65 + n]);
            w.y = pack4_fp8(ws * tl[(kc + 4) * 65 + n], ws * tl[(kc + 5) * 65 + n], ws * tl[(kc + 6) * 65 + n], ws * tl[(kc + 7) * 65 + n]);
            *(u32x2*)sp = w; } }
    }
    __syncthreads();
}
__device__ __forceinline__ void convert_small(const Args& a, int bid, int nb) {
    const int tid = otid();
    if (bid == nb - 2) { float* rt = (float*)(a.ws + WS_ROPE);
        for (int i = tid; i < 64 * 32; i += NT) { const float ang = (float)(i >> 5) * exp2f(-(float)(i & 31) * (13.287712379549449f / 32.0f)); float sn, cs; sincosf(ang, &sn, &cs); rt[2 * i] = cs; rt[2 * i + 1] = sn; } }
    if (bid == nb - 1) { bf16_t* rh = (bf16_t*)(a.ws + WS_RWT); bf16_t* rl = rh + 32 * 1024;
        for (int i = tid; i < 32 * 1024; i += NT) { const int e = i >> 10, k = i & 1023; const float w = a.router_w[k * NE + e]; const bf16_t hi = f2bf(w); rh[i] = hi; rl[i] = f2bf(w - bf2f(hi)); } }
}
__device__ __forceinline__ void compute_mod(const Args& a, MLAS unsigned char* lds, int bid, int nb) {
    MLAS float* sc = (MLAS float*)lds;
    MLAS float* red = (MLAS float*)(lds + 17 * 1024 * 4);
    const int tid = otid();
    if (bid >= 192) return;
    for (int i = tid; i < 17 * 1024; i += NT) { const int r = i >> 10, k = i & 1023; const float v = r < 16 ? a.c[r * 1024 + k] : a.c_ctx[k]; sc[i] = v / (1.0f + expf(-v)); }
    __syncthreads();
    for (int u = bid; u < 192; u += nb) {
        const int l = u / 96, n = (u % 96) * 64 + (tid & 63), kp = tid >> 6;
        float acc[17];
#pragma unroll
        for (int r = 0; r < 17; ++r) acc[r] = 0.f;
        const float* w = a.ada_w + (size_t)l * D * 6144 + n;
        for (int k = kp * 128; k < kp * 128 + 128; ++k) { const float wv = w[(size_t)k * 6144];
#pragma unroll
            for (int r = 0; r < 17; ++r) acc[r] += sc[r * 1024 + k] * wv; }
#pragma unroll
        for (int r = 0; r < 17; ++r) red[(kp * 17 + r) * 64 + (tid & 63)] = acc[r];
        __syncthreads();
        for (int i = tid; i < 17 * 64; i += NT) { const int r = i >> 6, cc = i & 63, nn = (u % 96) * 64 + cc; float s = a.ada_b[l * 6144 + nn];
#pragma unroll
            for (int p = 0; p < 8; ++p) s += red[(p * 17 + r) * 64 + cc];
            ((float*)(a.ws + WS_MOD))[((size_t)l * 17 + r) * 6144 + nn] = s; }
        __syncthreads();
    }
}

__device__ __forceinline__ void load_row_f32(const float* src, int e0, int e1, float (&v)[16]) {
    const f32x4 x0 = *(const f32x4*)(src + e0), x1 = *(const f32x4*)(src + e0 + 4), x2 = *(const f32x4*)(src + e1), x3 = *(const f32x4*)(src + e1 + 4);
#pragma unroll
    for (int j = 0; j < 4; ++j) { v[j] = x0[j]; v[4 + j] = x1[j]; v[8 + j] = x2[j]; v[12 + j] = x3[j]; }
}
__device__ __forceinline__ void load_row_bf16(const bf16_t* src, int e0, int e1, float (&v)[16]) {
    const u32x4 w0 = *(const u32x4*)(src + e0), w1 = *(const u32x4*)(src + e1);
#pragma unroll
    for (int j = 0; j < 4; ++j) { v[2 * j] = lo16(w0[j]); v[2 * j + 1] = hi16(w0[j]); v[8 + 2 * j] = lo16(w1[j]); v[8 + 2 * j + 1] = hi16(w1[j]); }
}
__device__ __forceinline__ void moe_combine(const bf16_t* ys, int2 pp, float2 ww, int i, const float (&mg)[16], int e0, int e1, float (&v)[16]) {
    const int p0 = __builtin_amdgcn_readlane(pp.x, i), p1 = __builtin_amdgcn_readlane(pp.y, i);
    const float w0 = __uint_as_float(__builtin_amdgcn_readlane(__float_as_uint(ww.x), i)), w1 = __uint_as_float(__builtin_amdgcn_readlane(__float_as_uint(ww.y), i));
    const bf16_t* ya = ys + (size_t)p0 * D; const bf16_t* yb = ys + (size_t)p1 * D;
    const u32x4 a0 = *(const u32x4*)(ya + e0), a1 = *(const u32x4*)(ya + e1), b0 = *(const u32x4*)(yb + e0), b1 = *(const u32x4*)(yb + e1);
#pragma unroll
    for (int j = 0; j < 4; ++j) {
        v[2 * j] += mg[2 * j] * (w0 * lo16(a0[j]) + w1 * lo16(b0[j])); v[2 * j + 1] += mg[2 * j + 1] * (w0 * hi16(a0[j]) + w1 * hi16(b0[j]));
        v[8 + 2 * j] += mg[8 + 2 * j] * (w0 * lo16(a1[j]) + w1 * lo16(b1[j])); v[8 + 2 * j + 1] += mg[8 + 2 * j + 1] * (w0 * hi16(a1[j]) + w1 * hi16(b1[j])); }
}
__device__ __forceinline__ void phase_norm1(const Args& a, int l, int bid, int nb) {
    const int tid = otid(), lane = tid & 63, wave = __builtin_amdgcn_readfirstlane(tid >> 6);
    const int e0 = lane * 8, e1 = 512 + lane * 8;
    float wn[16];
    { const float* w = a.norm_mix_w + l * D;
#pragma unroll
      for (int j = 0; j < 8; ++j) { wn[j] = w[e0 + j]; wn[8 + j] = w[e1 + j]; } }
    float msc[16], msh[16], mg[16]; int cur_r = -1;
    bf16_t* hb = (bf16_t*)(a.ws + WS_H);
    const bf16_t* y2 = (const bf16_t*)(a.ws + WS_XS);
    const int rper = (TT + nb * 8 - 1) / (nb * 8), row_lo = (bid * 8 + wave) * rper, row_hi = min(row_lo + rper, TT);
    int2 pp = {0, 0}; float2 ww = {0.f, 0.f};
    if (l > 0 && row_lo + lane < row_hi) { pp = *(const int2*)((const int*)(a.ws + WS_TOKR) + (size_t)(row_lo + lane) * 2); ww = *(const float2*)((const float*)(a.ws + WS_TOKW) + (size_t)(row_lo + lane) * 2); }
    for (int row = row_lo; row < row_hi; ++row) {
        const int r = row < TL ? row / SEQ : 16;
        if (r != cur_r) { cur_r = r; const float* sh = modp(a, l, r, 0); const float* sc = modp(a, l, r, 1);
#pragma unroll
            for (int j = 0; j < 8; ++j) { msh[j] = sh[e0 + j]; msh[8 + j] = sh[e1 + j]; msc[j] = 1.0f + sc[e0 + j]; msc[8 + j] = 1.0f + sc[e1 + j]; }
            if (l > 0) { const float* g = modp(a, l - 1, r, 5);
#pragma unroll
                for (int j = 0; j < 8; ++j) { mg[j] = g[e0 + j]; mg[8 + j] = g[e1 + j]; } } }
        float v[16];
        if (l == 0) load_row_f32(row < TL ? a.x + (size_t)row * D : a.ctx + (size_t)(row - TL) * D, e0, e1, v);
        else if (row < TL) load_row_bf16((const bf16_t*)(a.ws + WS_XB) + (size_t)row * D, e0, e1, v);
        else load_row_f32((const float*)(a.ws + WS_CTX) + (size_t)(row - TL) * D, e0, e1, v);
        if (l > 0) {
            moe_combine(y2, pp, ww, row - row_lo, mg, e0, e1, v);
            if (row < TL) { bf16_t* dst = (bf16_t*)a.out + (size_t)row * D;
                *(u32x4*)(dst + e0) = (u32x4){pack2(v[0], v[1]), pack2(v[2], v[3]), pack2(v[4], v[5]), pack2(v[6], v[7])};
                *(u32x4*)(dst + e1) = (u32x4){pack2(v[8], v[9]), pack2(v[10], v[11]), pack2(v[12], v[13]), pack2(v[14], v[15])}; }
        }
        float ss = 0.f;
#pragma unroll
        for (int j = 0; j < 16; ++j) ss += v[j] * v[j];
        ss = wave_sum(ss);
        const float rs = rsqrtf(ss * (1.0f / D) + 1e-6f);
        float y[16];
#pragma unroll
        for (int j = 0; j < 16; ++j) y[j] = v[j] * rs * wn[j] * msc[j] + msh[j];
        bf16_t* hp = hb + (size_t)row * D;
        *(u32x4*)(hp + e0) = (u32x4){pack2(y[0], y[1]), pack2(y[2], y[3]), pack2(y[4], y[5]), pack2(y[6], y[7])};
        *(u32x4*)(hp + e1) = (u32x4){pack2(y[8], y[9]), pack2(y[10], y[11]), pack2(y[12], y[13]), pack2(y[14], y[15])};
    }
}
__device__ __forceinline__ void phase_final(const Args& a, int bid, int nb) {
    const int tid = otid(), lane = tid & 63, wave = __builtin_amdgcn_readfirstlane(tid >> 6);
    const int e0 = lane * 8, e1 = 512 + lane * 8;
    float mg[16]; int cur_r = -1;
    const bf16_t* y2 = (const bf16_t*)(a.ws + WS_XS);
    const int rper = (TL + nb * 8 - 1) / (nb * 8), row_lo = (bid * 8 + wave) * rper, row_hi = min(row_lo + rper, TL);
    int2 pp = {0, 0}; float2 ww = {0.f, 0.f};
    if (row_lo + lane < row_hi) { pp = *(const int2*)((const int*)(a.ws + WS_TOKR) + (size_t)(row_lo + lane) * 2); ww = *(const float2*)((const float*)(a.ws + WS_TOKW) + (size_t)(row_lo + lane) * 2); }
    for (int row = row_lo; row < row_hi; ++row) {
        const int r = row / SEQ;
        if (r != cur_r) { cur_r = r; const float* g = modp(a, 1, r, 5);
#pragma unroll
            for (int j = 0; j < 8; ++j) { mg[j] = g[e0 + j]; mg[8 + j] = g[e1 + j]; } }
        float* src = a.out + (size_t)row * D;
        float v[16];
        load_row_bf16((const bf16_t*)(a.ws + WS_XB) + (size_t)row * D, e0, e1, v);
        moe_combine(y2, pp, ww, row - row_lo, mg, e0, e1, v);
        *(f32x4*)(src + e0) = (f32x4){v[0], v[1], v[2], v[3]}; *(f32x4*)(src + e0 + 4) = (f32x4){v[4], v[5], v[6], v[7]};
        *(f32x4*)(src + e1) = (f32x4){v[8], v[9], v[10], v[11]}; *(f32x4*)(src + e1 + 4) = (f32x4){v[12], v[13], v[14], v[15]};
    }
}

constexpr int VP = 516;
__device__ __forceinline__ void phase_prep(const Args& a, int l, MLAS unsigned char* lds, int bid, int nb) {
    const int tid = otid(), lane = tid & 63, wave = tid >> 6;
    const bf16_t* proj = (const bf16_t*)(a.ws + WS_PROJ);
    MLAS bf16_t* Vs = (MLAS bf16_t*)lds;
    float wk[8];
    { const float* w = a.na_k_norm + l * 64 + (lane & 7) * 8;
#pragma unroll
      for (int j = 0; j < 8; ++j) wk[j] = w[j]; }
    for (int u = bid; u < TT / 64; u += nb) {
        const int R0 = u * 64; const bool lat = R0 < TL;
        const int b = lat ? R0 / SEQ : (R0 - TL) / LC, t0 = lat ? R0 % SEQ : (R0 - TL) % LC, tlen = lat ? SEQ : LC;
        bf16_t* kc = (bf16_t*)(a.ws + (lat ? WS_KC : WS_KCC)); bf16_t* vt = (bf16_t*)(a.ws + (lat ? WS_VT : WS_VTC));
        __syncthreads();
#pragma unroll
        for (int rr = 0; rr < 8; ++rr) {
            const int rl = wave * 8 + rr, row = R0 + rl, t = t0 + rl;
            const bf16_t* p = proj + (size_t)row * INC;
            const u32x4 kw = *(const u32x4*)(p + C_KA + lane * 8), vw = *(const u32x4*)(p + C_VA + lane * 8);
            float f[8];
#pragma unroll
            for (int j = 0; j < 4; ++j) { f[2 * j] = lo16(kw[j]); f[2 * j + 1] = hi16(kw[j]); }
            float ss = 0.f;
#pragma unroll
            for (int j = 0; j < 8; ++j) ss += f[j] * f[j];
            ss += __shfl_xor(ss, 1); ss += __shfl_xor(ss, 2); ss += __shfl_xor(ss, 4);
            const float rs = rsqrtf(ss * (1.0f / 64.0f) + 1e-6f);
            *(u32x4*)(kc + (((size_t)b * 8 + (lane >> 3)) * tlen + t) * 64 + (lane & 7) * 8) =
                (u32x4){pack2(f[0] * rs * wk[0], f[1] * rs * wk[1]), pack2(f[2] * rs * wk[2], f[3] * rs * wk[3]), pack2(f[4] * rs * wk[4], f[5] * rs * wk[5]), pack2(f[6] * rs * wk[6], f[7] * rs * wk[7])};
            *(MLAS u32x2*)(Vs + rl * VP + lane * 8) = (u32x2){vw.x, vw.y}; *(MLAS u32x2*)(Vs + rl * VP + lane * 8 + 4) = (u32x2){vw.z, vw.w};
        }
        __syncthreads();
#pragma unroll
        for (int i = 0; i < 8; ++i) { const int idx = tid + i * NT, d = idx & 63, tc = (idx >> 6) & 7, h = idx >> 9;
            const MLAS bf16_t* vp = Vs + (tc * 8) * VP + h * 64 + d;
            const u32x4 w = {(unsigned)vp[0] | ((unsigned)vp[VP] << 16), (unsigned)vp[2 * VP] | ((unsigned)vp[3 * VP] << 16), (unsigned)vp[4 * VP] | ((unsigned)vp[5 * VP] << 16), (unsigned)vp[6 * VP] | ((unsigned)vp[7 * VP] << 16)};
            const int tk = t0 + tc * 8;
            *(u32x4*)(vt + ((((size_t)b * 8 + h) * (tlen >> 4) + (tk >> 4)) * 64 + d) * 16 + (tk & 15)) = w; }
    }
}

__device__ __forceinline__ int chunk_row0(int b, int c) { return c < 2 ? TL + b * LC + c * 128 : b * SEQ + (c - 2) * 128; }
__device__ __forceinline__ size_t st_index(int b, int h, int dir, int c) { return ((((size_t)b * 4 + h) * 2 + dir) * NCH + c) * 16384; }
constexpr int RP = 136;
__device__ __forceinline__ void load_rope_pair(const bf16_t* p, int a2, int fc, int tok, const MLAS float* rope, float (&y1)[8], float (&y2)[8]) {
    const u32x4 w0 = *(const u32x4*)(p + (a2 * 8 + fc) * 8), w1 = *(const u32x4*)(p + (a2 * 8 + fc + 4) * 8);
#pragma unroll
    for (int j = 0; j < 4; ++j) { y1[2 * j] = lo16(w0[j]); y1[2 * j + 1] = hi16(w0[j]); y2[2 * j] = lo16(w1[j]); y2[2 * j + 1] = hi16(w1[j]); }
    if (tok >= 0) {
        const int pos = a2 == 0 ? (tok >> 6) : (tok & 63);
        const MLAS f32x4* tp = (const MLAS f32x4*)(rope + (pos * 32 + fc * 8) * 2);
#pragma unroll
        for (int q = 0; q < 4; ++q) { const f32x4 cs = tp[q];
            const float u0 = y1[2 * q] * cs[0] - y2[2 * q] * cs[1], v0 = y1[2 * q] * cs[1] + y2[2 * q] * cs[0];
            const float u1 = y1[2 * q + 1] * cs[2] - y2[2 * q + 1] * cs[3], v1 = y1[2 * q + 1] * cs[3] + y2[2 * q + 1] * cs[2];
            y1[2 * q] = u0; y2[2 * q] = v0; y1[2 * q + 1] = u1; y2[2 * q + 1] = v1; }
    }
}
__device__ __forceinline__ void rope_pair_regs(const u32x4 w0, const u32x4 w1, int a2, int fc, int tok, const MLAS float* rope, float (&y1)[8], float (&y2)[8]) {
#pragma unroll
    for (int j = 0; j < 4; ++j) { y1[2 * j] = lo16(w0[j]); y1[2 * j + 1] = hi16(w0[j]); y2[2 * j] = lo16(w1[j]); y2[2 * j + 1] = hi16(w1[j]); }
    if (tok >= 0) {
        const int pos = a2 == 0 ? (tok >> 6) : (tok & 63);
        const MLAS f32x4* tp = (const MLAS f32x4*)(rope + (pos * 32 + fc * 8) * 2);
#pragma unroll
        for (int q = 0; q < 4; ++q) { const f32x4 cs = tp[q];
            const float u0 = y1[2 * q] * cs[0] - y2[2 * q] * cs[1], v0 = y1[2 * q] * cs[1] + y2[2 * q] * cs[0];
            const float u1 = y1[2 * q + 1] * cs[2] - y2[2 * q + 1] * cs[3], v1 = y1[2 * q + 1] * cs[3] + y2[2 * q + 1] * cs[2];
            y1[2 * q] = u0; y2[2 * q] = v0; y1[2 * q + 1] = u1; y2[2 * q + 1] = v1; }
    }
}
__device__ __forceinline__ u32x4 pack8(const float (&y)[8], float sc) { return (u32x4){pack2(y[0] * sc, y[1] * sc), pack2(y[2] * sc, y[3] * sc), pack2(y[4] * sc, y[5] * sc), pack2(y[6] * sc, y[7] * sc)}; }
constexpr float RET_KSCALE = 0.08838834764831845f;
constexpr int LDS_ROPE = 98304;
__device__ __forceinline__ void phase_ret_a(const Args& a, int l, MLAS unsigned char* lds, int bid, int nb) {
    const int tid = otid(), lane = tid & 63, wave = __builtin_amdgcn_readfirstlane(tid >> 6);
    const bf16_t* proj = (const bf16_t*)(a.ws + WS_PROJ); bf16_t* st = (bf16_t*)(a.ws + WS_ST);
    const unsigned ldsb = (unsigned)(size_t)lds;
    const int dir = wave >> 2, dt = wave & 3, hh = lane >> 5;
    MLAS float* rope = (MLAS float*)(lds + LDS_ROPE);
    for (int i = tid; i < 64 * 32 * 2; i += NT) rope[i] = ((const float*)(a.ws + WS_ROPE))[i];
#define RA_LOAD(u_) do { const int b_ = (u_) / (NCH * 4), c_ = ((u_) >> 2) % NCH, h_ = (u_) & 3, row0_ = chunk_row0(b_, c_); _Pragma("unroll") for (int i = 0; i < 2; ++i) { const int idx = tid + i * NT, row = idx >> 3, ch0 = ((idx >> 2) & 1) * 8 + (idx & 3); \
        const bf16_t* src = proj + (size_t)(row0_ + row) * INC + h_ * 128; \
        raw[i][0] = *(const u32x4*)(src + C_KB + ch0 * 8); raw[i][1] = *(const u32x4*)(src + C_KB + (ch0 + 4) * 8); raw[i][2] = *(const u32x4*)(src + C_VB + ch0 * 8); raw[i][3] = *(const u32x4*)(src + C_VB + (ch0 + 4) * 8); } } while (0)
    u32x4 raw[2][4];
    if (bid < NB * NCH * 4) RA_LOAD(bid);
    LDS_BARRIER();
    for (int u = bid; u < NB * NCH * 4; u += nb) {
        const int b = u / (NCH * 4), c = (u >> 2) % NCH, h = u & 3;
        const float lgf = -expf(a.ret_decay[l * 8 + h]), lgb = -expf(a.ret_decay[l * 8 + 4 + h]);
        LDS_BARRIER();
#pragma unroll
        for (int i = 0; i < 2; ++i) { const int idx = tid + i * NT, row = idx >> 3, a2 = (idx >> 2) & 1, fc = idx & 3, ch0 = a2 * 8 + fc;
            float y1[8], y2[8];
            rope_pair_regs(raw[i][0], raw[i][1], a2, fc, c >= 2 ? (c - 2) * 128 + row : -1, rope, y1, y2);
            const float wf = __expf((float)(127 - row) * lgf) * RET_KSCALE, wb = __expf((float)row * lgb) * RET_KSCALE;
            const unsigned o0 = off_b(row, ch0), o1 = off_b(row, ch0 + 4);
            *(MLAS u32x4*)(lds + o0) = pack8(y1, wf); *(MLAS u32x4*)(lds + o1) = pack8(y2, wf);
            *(MLAS u32x4*)(lds + 32768 + o0) = pack8(y1, wb); *(MLAS u32x4*)(lds + 32768 + o1) = pack8(y2, wb);
            *(MLAS u32x4*)(lds + 65536 + o0) = raw[i][2]; *(MLAS u32x4*)(lds + 65536 + o1) = raw[i][3]; }
        { const int un_ = u + nb < NB * NCH * 4 ? u + nb : u; RA_LOAD(un_); }
        LDS_BARRIER();
        f32x16 acc[4];
#pragma unroll
        for (int et = 0; et < 4; ++et)
#pragma unroll
            for (int r = 0; r < 16; ++r) acc[et][r] = 0.f;
        unsigned aK[2], aV[4][2];
#pragma unroll
        for (int t = 0; t < 2; ++t) { aK[t] = ldsb + dir * 32768 + tr_addr(8 * hh + 4 * t, dt, lane);
#pragma unroll
            for (int et = 0; et < 4; ++et) aV[et][t] = ldsb + 65536 + tr_addr(8 * hh + 4 * t, et, lane); }
#pragma unroll
        for (int ks = 0; ks < 8; ++ks) {
            u32x2 r0, r1, r2, r3, r4, r5, r6, r7, r8, r9; const unsigned ko = ks * 4096;
            asm volatile("ds_read_b64_tr_b16 %0, %10\n\tds_read_b64_tr_b16 %1, %11\n\tds_read_b64_tr_b16 %2, %12\n\tds_read_b64_tr_b16 %3, %13\n\tds_read_b64_tr_b16 %4, %14\n\t"
                         "ds_read_b64_tr_b16 %5, %15\n\tds_read_b64_tr_b16 %6, %16\n\tds_read_b64_tr_b16 %7, %17\n\tds_read_b64_tr_b16 %8, %18\n\tds_read_b64_tr_b16 %9, %19\n\ts_waitcnt lgkmcnt(0)"
                         : "=&v"(r0), "=&v"(r1), "=&v"(r2), "=&v"(r3), "=&v"(r4), "=&v"(r5), "=&v"(r6), "=&v"(r7), "=&v"(r8), "=&v"(r9)
                         : "v"(aK[0] + ko), "v"(aK[1] + ko), "v"(aV[0][0] + ko), "v"(aV[0][1] + ko), "v"(aV[1][0] + ko), "v"(aV[1][1] + ko), "v"(aV[2][0] + ko), "v"(aV[2][1] + ko), "v"(aV[3][0] + ko), "v"(aV[3][1] + ko) : "memory");
            const bf16x8 A = mkfrag(r0, r1);
            acc[0] = __builtin_amdgcn_mfma_f32_32x32x16_bf16(A, mkfrag(r2, r3), acc[0], 0, 0, 0);
            acc[1] = __builtin_amdgcn_mfma_f32_32x32x16_bf16(A, mkfrag(r4, r5), acc[1], 0, 0, 0);
            acc[2] = __builtin_amdgcn_mfma_f32_32x32x16_bf16(A, mkfrag(r6, r7), acc[2], 0, 0, 0);
            acc[3] = __builtin_amdgcn_mfma_f32_32x32x16_bf16(A, mkfrag(r8, r9), acc[3], 0, 0, 0);
        }
        bf16_t* o = st + st_index(b, h, dir, c);
#pragma unroll
        for (int et = 0; et < 4; ++et) { bf16_t* p = o + ((dt * 4 + et) * 64 + lane) * 16;
            *(u32x4*)p = (u32x4){pack2(acc[et][0], acc[et][1]), pack2(acc[et][2], acc[et][3]), pack2(acc[et][4], acc[et][5]), pack2(acc[et][6], acc[et][7])};
            *(u32x4*)(p + 8) = (u32x4){pack2(acc[et][8], acc[et][9]), pack2(acc[et][10], acc[et][11]), pack2(acc[et][12], acc[et][13]), pack2(acc[et][14], acc[et][15])}; }
    }
#undef RA_LOAD
}
__device__ __forceinline__ void phase_scan(const Args& a, int l, int bid, int nb) {
    bf16_t* st = (bf16_t*)(a.ws + WS_ST);
#pragma unroll 1
    for (int idx = bid * NT + otid(); idx < NB * 4 * 2 * 2048; idx += nb * NT) {
        const int chain = idx >> 11, v8 = idx & 2047, dir = chain & 1, h = (chain >> 1) & 3;
        const float dec = expf(-128.0f * expf(a.ret_decay[l * 8 + dir * 4 + h]));
        bf16_t* p = st + (size_t)chain * NCH * 16384 + v8 * 8;
        float S[8];
#pragma unroll
        for (int j = 0; j < 8; ++j) S[j] = 0.f;
#pragma unroll 1
        for (int half = 0; half < 2; ++half) {
            u32x4 ls[NCH / 2];
#pragma unroll
            for (int i = 0; i < NCH / 2; ++i) { const int ii = half * (NCH / 2) + i, c = dir == 0 ? ii : (ii < 2 ? 1 - ii : NCH + 1 - ii); ls[i] = *(const u32x4*)(p + (size_t)c * 16384); }
#pragma unroll
            for (int i = 0; i < NCH / 2; ++i) { const int ii = half * (NCH / 2) + i, c = dir == 0 ? ii : (ii < 2 ? 1 - ii : NCH + 1 - ii);
                *(u32x4*)(p + (size_t)c * 16384) = (u32x4){pack2(S[0], S[1]), pack2(S[2], S[3]), pack2(S[4], S[5]), pack2(S[6], S[7])};
#pragma unroll
                for (int t = 0; t < 4; ++t) { S[2 * t] = S[2 * t] * dec + lo16(ls[i][t]); S[2 * t + 1] = S[2 * t + 1] * dec + hi16(ls[i][t]); } }
        }
    }
}
__device__ __forceinline__ void phase_ret_b(const Args& a, int l, MLAS unsigned char* lds, int bid, int nb) {
    const int tid = otid(), lane = tid & 63, wave = __builtin_amdgcn_readfirstlane(tid >> 6);
    const bf16_t* proj = (const bf16_t*)(a.ws + WS_PROJ); const bf16_t* st = (const bf16_t*)(a.ws + WS_ST); bf16_t* mix = (bf16_t*)(a.ws + WS_H);
    const unsigned ldsb = (unsigned)(size_t)lds;
    const int dir = wave >> 2, it = wave & 3, hh = lane >> 5, il = it * 32 + (lane & 31);
    const int c_lo = l == 0 ? 0 : 2, ncu = NCH - c_lo;
    MLAS float* rope = (MLAS float*)(lds + LDS_ROPE);
    for (int i = tid; i < 64 * 32 * 2; i += NT) rope[i] = ((const float*)(a.ws + WS_ROPE))[i];
#define RB_DECODE(u_, b_, c_, h_, row0_) const int b_ = (u_) / (ncu * 4), c_ = c_lo + ((u_) >> 2) % ncu, h_ = (u_) & 3, row0_ = chunk_row0(b_, c_)
#define RB_LOAD(u_) do { RB_DECODE(u_, b_, c_, h_, row0_); (void)c_; _Pragma("unroll") for (int i = 0; i < 2; ++i) { const int idx = tid + i * NT, row = idx >> 3, ch0 = ((idx >> 2) & 1) * 8 + (idx & 3); \
        const bf16_t* src = proj + (size_t)(row0_ + row) * INC + h_ * 128; \
        raw[i][0] = *(const u32x4*)(src + C_QB + ch0 * 8); raw[i][1] = *(const u32x4*)(src + C_QB + (ch0 + 4) * 8); raw[i][2] = *(const u32x4*)(src + C_KB + ch0 * 8); raw[i][3] = *(const u32x4*)(src + C_KB + (ch0 + 4) * 8); \
        raw[i][4] = *(const u32x4*)(src + C_VB + ch0 * 8); raw[i][5] = *(const u32x4*)(src + C_VB + (ch0 + 4) * 8); } } while (0)
    u32x4 raw[2][6];
    if (bid < NB * ncu * 4) RB_LOAD(bid);
    LDS_BARRIER();
    for (int u = bid; u < NB * ncu * 4; u += nb) {
        RB_DECODE(u, b, c, h, row0);
        const float lg = -expf(a.ret_decay[l * 8 + dir * 4 + h]);
        LDS_BARRIER();
#pragma unroll
        for (int i = 0; i < 2; ++i) { const int idx = tid + i * NT, row = idx >> 3, a2 = (idx >> 2) & 1, fc = idx & 3, ch0 = a2 * 8 + fc;
            const int tok = c >= 2 ? (c - 2) * 128 + row : -1;
            const unsigned o0 = off_b(row, ch0), o1 = off_b(row, ch0 + 4);
            float y1[8], y2[8];
            rope_pair_regs(raw[i][0], raw[i][1], a2, fc, tok, rope, y1, y2);
            *(MLAS u32x4*)(lds + o0) = pack8(y1, 1.0f); *(MLAS u32x4*)(lds + o1) = pack8(y2, 1.0f);
            rope_pair_regs(raw[i][2], raw[i][3], a2, fc, tok, rope, y1, y2);
            *(MLAS u32x4*)(lds + 32768 + o0) = pack8(y1, RET_KSCALE); *(MLAS u32x4*)(lds + 32768 + o1) = pack8(y2, RET_KSCALE);
            *(MLAS u32x4*)(lds + 65536 + o0) = raw[i][4]; *(MLAS u32x4*)(lds + 65536 + o1) = raw[i][5]; }
        LDS_BARRIER();
        f32x16 acc[4];
#pragma unroll
        for (int et = 0; et < 4; ++et)
#pragma unroll
            for (int r = 0; r < 16; ++r) acc[et][r] = 0.f;
        {
            const bf16_t* sp = st + st_index(b, h, dir, c) + lane * 16;
#pragma unroll
            for (int dt = 0; dt < 4; ++dt)
#pragma unroll
                for (int s2 = 0; s2 < 2; ++s2) {
                    const u32x2 q0 = *(const MLAS u32x2*)(lds + off_b(il, 4 * dt + 2 * s2) + 8 * hh), q1 = *(const MLAS u32x2*)(lds + off_b(il, 4 * dt + 2 * s2 + 1) + 8 * hh);
                    const bf16x8 Bq = mkfrag(q0, q1);
#pragma unroll
                    for (int et = 0; et < 4; ++et) { const bf16x8 A = __builtin_bit_cast(bf16x8, *(const u32x4*)(sp + (dt * 4 + et) * 1024 + 8 * s2));
                        acc[et] = __builtin_amdgcn_mfma_f32_32x32x16_bf16(A, Bq, acc[et], 0, 0, 0); }
                }
            const float qdec = __expf((float)(dir == 0 ? il + 1 : 128 - il) * lg);
#pragma unroll
            for (int et = 0; et < 4; ++et)
#pragma unroll
                for (int r = 0; r < 16; ++r) acc[et][r] *= qdec;
        }
        bf16x8 Qn[8];
#pragma unroll
        for (int ks = 0; ks < 8; ++ks) Qn[ks] = *(const MLAS bf16x8*)(lds + off_b(il, 2 * ks + hh));
        const int jt_lo = dir == 0 ? 0 : it, jt_hi = dir == 0 ? it : 3;
        for (int jt = jt_lo; jt <= jt_hi; ++jt) {
            f32x16 sc;
#pragma unroll
            for (int r = 0; r < 16; ++r) sc[r] = 0.f;
#pragma unroll
            for (int ks = 0; ks < 8; ++ks) { const bf16x8 A = *(const MLAS bf16x8*)(lds + 32768 + off_b(jt * 32 + (lane & 31), 2 * ks + hh));
                sc = __builtin_amdgcn_mfma_f32_32x32x16_bf16(A, Qn[ks], sc, 0, 0, 0); }
            unsigned pk[8];
#pragma unroll
            for (int r = 0; r < 16; r += 2) {
                const int j0 = jt * 32 + (r & 3) + 8 * (r >> 2) + 4 * hh, j1 = j0 + 1;
                const int d0 = dir == 0 ? il - j0 : j0 - il, d1 = dir == 0 ? il - j1 : j1 - il;
                const float p0 = d0 >= 0 ? sc[r] * __expf((float)d0 * lg) : 0.f, p1 = d1 >= 0 ? sc[r + 1] * __expf((float)d1 * lg) : 0.f;
                pk[r >> 1] = pack2(p0, p1);
            }
            const bf16x8 P0 = __builtin_bit_cast(bf16x8, (u32x4){pk[0], pk[1], pk[2], pk[3]}), P1 = __builtin_bit_cast(bf16x8, (u32x4){pk[4], pk[5], pk[6], pk[7]});
#pragma unroll
            for (int et = 0; et < 4; ++et) {
                u32x2 r0, r1, r2, r3;
                const unsigned a0 = ldsb + 65536 + tr_addr(jt * 32 + 4 * hh, et, lane), a1 = ldsb + 65536 + tr_addr(jt * 32 + 8 + 4 * hh, et, lane);
                const unsigned a2 = ldsb + 65536 + tr_addr(jt * 32 + 16 + 4 * hh, et, lane), a3 = ldsb + 65536 + tr_addr(jt * 32 + 24 + 4 * hh, et, lane);
                asm volatile("ds_read_b64_tr_b16 %0, %4\n\tds_read_b64_tr_b16 %1, %5\n\tds_read_b64_tr_b16 %2, %6\n\tds_read_b64_tr_b16 %3, %7\n\ts_waitcnt lgkmcnt(0)"
                             : "=&v"(r0), "=&v"(r1), "=&v"(r2), "=&v"(r3) : "v"(a0), "v"(a1), "v"(a2), "v"(a3) : "memory");
                acc[et] = __builtin_amdgcn_mfma_f32_32x32x16_bf16(mkfrag(r0, r1), P0, acc[et], 0, 0, 0);
                acc[et] = __builtin_amdgcn_mfma_f32_32x32x16_bf16(mkfrag(r2, r3), P1, acc[et], 0, 0, 0);
            }
        }
        u32x4 gfr[4], gbr[4];
        { const bf16_t* gp = proj + (size_t)(row0 + (tid >> 2)) * INC + h * 128;
#pragma unroll
          for (int k = 0; k < 4; ++k) { const int ch = (tid & 3) * 4 + k; gfr[k] = *(const u32x4*)(gp + C_GF + ch * 8); gbr[k] = *(const u32x4*)(gp + C_GB + ch * 8); } }
        float s1 = 0.f;
#pragma unroll
        for (int et = 0; et < 4; ++et)
#pragma unroll
            for (int r = 0; r < 16; ++r) s1 += acc[et][r];
        s1 += __shfl_xor(s1, 32);
        const float mean = s1 * (1.0f / 128.0f);
        float s2 = 0.f;
#pragma unroll
        for (int et = 0; et < 4; ++et)
#pragma unroll
            for (int r = 0; r < 16; ++r) { const float dlt = acc[et][r] - mean; s2 += dlt * dlt; }
        s2 += __shfl_xor(s2, 32);
        const float rstd = rsqrtf(s2 * (1.0f / 128.0f) + 1e-5f);
        LDS_BARRIER();
#pragma unroll
        for (int et = 0; et < 4; ++et)
#pragma unroll
            for (int g = 0; g < 4; ++g) {
                const u32x2 w = {pack2((acc[et][4 * g] - mean) * rstd, (acc[et][4 * g + 1] - mean) * rstd), pack2((acc[et][4 * g + 2] - mean) * rstd, (acc[et][4 * g + 3] - mean) * rstd)};
                *(MLAS u32x2*)(lds + dir * 32768 + off_b(il, 4 * et + g) + 8 * hh) = w; }
        { const int un_ = u + nb < NB * ncu * 4 ? u + nb : u; RB_LOAD(un_); }
        LDS_BARRIER();
        {
            const int i = tid >> 2, part = tid & 3;
            bf16_t* op = mix + (size_t)(row0 + i) * D + 512 + h * 128;
#pragma unroll
            for (int k = 0; k < 4; ++k) { const int ch = part * 4 + k;
                const u32x4 of = *(const MLAS u32x4*)(lds + off_b(i, ch)), ob = *(const MLAS u32x4*)(lds + 32768 + off_b(i, ch));
                const u32x4 gf = gfr[k], gb = gbr[k];
                u32x4 o;
#pragma unroll
                for (int t = 0; t < 4; ++t) o[t] = pack2(lo16(of[t]) * siluf(lo16(gf[t])) + lo16(ob[t]) * siluf(lo16(gb[t])), hi16(of[t]) * siluf(hi16(gf[t])) + hi16(ob[t]) * siluf(hi16(gb[t])));
                *(u32x4*)(op + ch * 8) = o; }
        }
    }
#undef RB_DECODE
#undef RB_LOAD
}

constexpr int NA_OP = 72;
__device__ __forceinline__ int perm16(int x) { return (x & 3) | ((x & 4) << 1) | ((x & 8) >> 1); }
__device__ __forceinline__ void phase_na(const Args& a, int l, MLAS unsigned char* lds, int bid, int nb) {
    const int tid = otid(), lane = tid & 63, wave = __builtin_amdgcn_readfirstlane(tid >> 6);
    const bf16_t* proj = (const bf16_t*)(a.ws + WS_PROJ); bf16_t* mix = (bf16_t*)(a.ws + WS_H);
    const bf16_t* KC = (const bf16_t*)(a.ws + WS_KC); const bf16_t* VT = (const bf16_t*)(a.ws + WS_VT);
    const bf16_t* KCC = (const bf16_t*)(a.ws + WS_KCC); const bf16_t* VTC = (const bf16_t*)(a.ws + WS_VTC);
    MLAS float* rpb = (MLAS float*)lds;
    MLAS bf16_t* ost = (MLAS bf16_t*)(lds + 8192) + wave * 64 * NA_OP;
    const int n_lat = NB * 8 * 8, n_ctx = l == 0 ? NB * 4 : 0;
    const int hh = lane >> 5, ql = lane & 31;
    for (int u0 = bid; u0 < n_lat + n_ctx; u0 += nb) {
        int u = u0;
        if (nb == 256 && u0 < n_lat) { const int x = bid & 7, j = bid >> 3, i = u0 >> 8; u = ((i * 32 + x * 4 + (j >> 3)) << 3) + (j & 7); }
        const bool is_ctx = u >= n_lat;
        const int v = is_ctx ? u - n_lat : u;
        const int b = is_ctx ? v >> 2 : v >> 6, h = is_ctx ? 2 * (v & 3) + (wave >> 2) : (v >> 3) & 7;
        const int r = (v & 7) * 8 + wave;
        const int qrow0 = is_ctx ? TL + b * LC + (wave & 3) * 64 : b * SEQ + r * 64;
        const size_t bh = (size_t)b * 8 + h;
        __syncthreads();
        if (!is_ctx) for (int i = tid; i < 15 * 128; i += NT) { const int dr = i >> 7, x = (i & 127) - 48; rpb[i] = (x >= 0 && x < 31) ? a.na_rpb[((size_t)l * 8 + h) * 465 + dr * 31 + x] * 1.4426950408889634f : 0.f; }
        __syncthreads();
        bf16x8 Qf[2][4];
#pragma unroll
        for (int qt = 0; qt < 2; ++qt) {
            u32x4 qw[4]; float ss = 0.f;
#pragma unroll
            for (int ks = 0; ks < 4; ++ks) { qw[ks] = *(const u32x4*)(proj + (size_t)(qrow0 + 32 * qt + ql) * INC + C_QA + h * 64 + 16 * ks + 8 * hh);
#pragma unroll
                for (int t = 0; t < 4; ++t) { const float x0 = lo16(qw[ks][t]), x1 = hi16(qw[ks][t]); ss += x0 * x0 + x1 * x1; } }
            ss += __shfl_xor(ss, 32);
            const float rs = rsqrtf(ss * (1.0f / 64.0f) + 1e-6f) * 0.18033688011112042f;
#pragma unroll
            for (int ks = 0; ks < 4; ++ks) { const f32x4 w0 = *(const f32x4*)(a.na_q_norm + l * 64 + 16 * ks + 8 * hh), w1 = *(const f32x4*)(a.na_q_norm + l * 64 + 16 * ks + 8 * hh + 4);
                const u32x4 o = {pack2(lo16(qw[ks][0]) * rs * w0[0], hi16(qw[ks][0]) * rs * w0[1]), pack2(lo16(qw[ks][1]) * rs * w0[2], hi16(qw[ks][1]) * rs * w0[3]),
                                 pack2(lo16(qw[ks][2]) * rs * w1[0], hi16(qw[ks][2]) * rs * w1[1]), pack2(lo16(qw[ks][3]) * rs * w1[2], hi16(qw[ks][3]) * rs * w1[3])};
                Qf[qt][ks] = __builtin_bit_cast(bf16x8, o); }
        }
        f32x16 O[2][2];
#pragma unroll
        for (int qt = 0; qt < 2; ++qt)
#pragma unroll
            for (int i = 0; i < 16; ++i) { O[qt][0][i] = 0.f; O[qt][1][i] = 0.f; }
        float lsum[2] = {0.f, 0.f};
        const int r0 = min(max(r - 4, 0), 56);
        const int kslot = 16 * (ql >> 4) + perm16(ql & 15);
        const bf16_t* kl = KC + (bh * SEQ + (size_t)(r0 + (ql >> 4)) * 64 + perm16(ql & 15)) * 64 + 8 * hh;
        const bf16_t* vl = VT + ((bh * 256 + (size_t)r0 * 4) * 64 + ql) * 16 + 8 * hh;
        const bf16_t* kx = KCC + (bh * LC + kslot) * 64 + 8 * hh;
        const bf16_t* vx = VTC + ((bh * 16) * 64 + ql) * 16 + 8 * hh;
#define NA_PTRS(t, kp, vp, vstep) do { if ((t) < 16) { const int ip_ = (t) >> 2, ct_ = (t) & 3; kp = kl + (size_t)(2 * ip_ * 64 + 16 * ct_) * 64; vp = vl + (2 * ip_ * 4 + ct_) * 1024; vstep = 4096; } \
        else { kp = kx + (size_t)(32 * ((t) - 16)) * 64; vp = vx + ((t) - 16) * 2048; vstep = 1024; } } while (0)
#define NA_LOADS(kp, vp, vstep, Kd, Vd) do { _Pragma("unroll") for (int ks_ = 0; ks_ < 4; ++ks_) Kd[ks_] = *(const u32x4*)(kp + 16 * ks_); \
        Vd[0] = *(const u32x4*)(vp); Vd[1] = *(const u32x4*)(vp + vstep); Vd[2] = *(const u32x4*)(vp + 512); Vd[3] = *(const u32x4*)(vp + 512 + vstep); } while (0)
        const int t_lo = is_ctx ? 16 : 0;
        u32x4 Kn[4], Vn[4];
        { const bf16_t* kp; const bf16_t* vp; int vstep; NA_PTRS(t_lo, kp, vp, vstep); NA_LOADS(kp, vp, vstep, Kn, Vn); }
#pragma unroll 1
        for (int t = t_lo; t < 24; ++t) {
            u32x4 Kc[4], Vc[4];
#pragma unroll
            for (int i = 0; i < 4; ++i) { Kc[i] = Kn[i]; Vc[i] = Vn[i]; }
            if (t + 1 < 24) { const bf16_t* kp; const bf16_t* vp; int vstep; NA_PTRS(t + 1, kp, vp, vstep); NA_LOADS(kp, vp, vstep, Kn, Vn); }
            const int ip = t >> 2, ct = t & 3;
#pragma unroll
            for (int qt = 0; qt < 2; ++qt) {
                if (t < 16 && (unsigned)(ct - qt) > 2u) continue;
                f32x16 sc;
#pragma unroll
                for (int i = 0; i < 16; ++i) sc[i] = 0.f;
#pragma unroll
                for (int ks = 0; ks < 4; ++ks) sc = __builtin_amdgcn_mfma_f32_32x32x16_bf16(__builtin_bit_cast(bf16x8, Kc[ks]), Qf[qt][ks], sc, 0, 0, 0);
                unsigned pk[8];
                if (t < 16) {
                    const int q = qt * 32 + ql, c0 = min(max(q - 8, 0), 48);
#pragma unroll
                    for (int rr = 0; rr < 16; rr += 2) {
                        const int wi = 2 * ip + (rr >> 3), col = 16 * ct + (rr & 3) + 4 * ((rr >> 2) & 1) + 8 * hh;
                        const MLAS float* bp = rpb + (r0 + wi - r + 7) * 128 + (col - q + 63);
                        const float b0 = bp[0], b1 = bp[1];
                        const float e0 = __builtin_amdgcn_exp2f(sc[rr] + b0), e1 = __builtin_amdgcn_exp2f(sc[rr + 1] + b1);
                        const float p0 = (unsigned)(col - c0) < 16u ? e0 : 0.f, p1 = (unsigned)(col + 1 - c0) < 16u ? e1 : 0.f;
                        lsum[qt] += p0 + p1; pk[rr >> 1] = pack2(p0, p1);
                    }
                } else {
#pragma unroll
                    for (int rr = 0; rr < 16; rr += 2) { const float p0 = __builtin_amdgcn_exp2f(sc[rr]), p1 = __builtin_amdgcn_exp2f(sc[rr + 1]); lsum[qt] += p0 + p1; pk[rr >> 1] = pack2(p0, p1); }
                }
                const bf16x8 P0 = __builtin_bit_cast(bf16x8, (u32x4){pk[0], pk[1], pk[2], pk[3]}), P1 = __builtin_bit_cast(bf16x8, (u32x4){pk[4], pk[5], pk[6], pk[7]});
                O[qt][0] = __builtin_amdgcn_mfma_f32_32x32x16_bf16(__builtin_bit_cast(bf16x8, Vc[0]), P0, O[qt][0], 0, 0, 0);
                O[qt][0] = __builtin_amdgcn_mfma_f32_32x32x16_bf16(__builtin_bit_cast(bf16x8, Vc[1]), P1, O[qt][0], 0, 0, 0);
                O[qt][1] = __builtin_amdgcn_mfma_f32_32x32x16_bf16(__builtin_bit_cast(bf16x8, Vc[2]), P0, O[qt][1], 0, 0, 0);
                O[qt][1] = __builtin_amdgcn_mfma_f32_32x32x16_bf16(__builtin_bit_cast(bf16x8, Vc[3]), P1, O[qt][1], 0, 0, 0);
            }
        }
#undef NA_PTRS
#undef NA_LOADS
#pragma unroll
        for (int qt = 0; qt < 2; ++qt) {
            const float inv = 1.0f / (lsum[qt] + __shfl_xor(lsum[qt], 32));
#pragma unroll
            for (int g4 = 0; g4 < 4; ++g4) {
                *(MLAS u32x2*)(ost + (32 * qt + ql) * NA_OP + 8 * g4 + 4 * hh) = (u32x2){pack2(O[qt][0][4 * g4] * inv, O[qt][0][4 * g4 + 1] * inv), pack2(O[qt][0][4 * g4 + 2] * inv, O[qt][0][4 * g4 + 3] * inv)};
                *(MLAS u32x2*)(ost + (32 * qt + ql) * NA_OP + 32 + 8 * g4 + 4 * hh) = (u32x2){pack2(O[qt][1][4 * g4] * inv, O[qt][1][4 * g4 + 1] * inv), pack2(O[qt][1][4 * g4 + 2] * inv, O[qt][1][4 * g4 + 3] * inv)};
            }
        }
#pragma unroll
        for (int k = 0; k < 8; ++k) { const int idx = lane + 64 * k, row = idx >> 3, ch = idx & 7;
            *(u32x4*)(mix + (size_t)(qrow0 + row) * D + h * 64 + ch * 8) = *(const MLAS u32x4*)(ost + row * NA_OP + ch * 8); }
    }
}

constexpr int N2P = 1032;
typedef float f32x4v __attribute__((ext_vector_type(4)));
__device__ __forceinline__ void phase_norm2(const Args& a, int l, MLAS unsigned char* lds, int bid, int nb) {
    const int tid = otid(), lane = tid & 63, wave = __builtin_amdgcn_readfirstlane(tid >> 6);
    const int e0 = lane * 8, e1 = 512 + lane * 8;
    MLAS bf16_t* Ahi = (MLAS bf16_t*)lds; MLAS bf16_t* Alo = Ahi + 16 * N2P; MLAS float* part = (MLAS float*)(Alo + 16 * N2P);
    MLAS float* tsc = part + 8 * 16 * 32; MLAS float* tsh = tsc + 1024; int cur_r = -1;
    bf16_t* hb = (bf16_t*)(a.ws + WS_H);
    int* tok_e = (int*)(a.ws + WS_TOKE); int* tok_r = (int*)(a.ws + WS_TOKR); float* tok_w = (float*)(a.ws + WS_TOKW);
    unsigned* cnt = (unsigned*)(a.ws + WS_CNT) + l * 2048;
    MLAS unsigned* lcnt = (MLAS unsigned*)(tsh + 1024);
    if (tid < NE) lcnt[tid] = 0u;
    const int nrows = l == 0 ? TT : TL;
    bf16x8 Bh[4][2], Bl[4][2];
    { const bf16_t* rh = (const bf16_t*)(a.ws + WS_RWT); const bf16_t* rl = rh + 32 * 1024;
#pragma unroll
      for (int ks = 0; ks < 4; ++ks)
#pragma unroll
        for (int nt = 0; nt < 2; ++nt) { const int o = (nt * 16 + (lane & 15)) * 1024 + 128 * wave + 32 * ks + 8 * (lane >> 4);
            Bh[ks][nt] = __builtin_bit_cast(bf16x8, *(const u32x4*)(rh + o)); Bl[ks][nt] = __builtin_bit_cast(bf16x8, *(const u32x4*)(rl + o)); } }
    const float rbias = a.router_bias[lane & 31];
#define N2_BAR() do { asm volatile("s_waitcnt lgkmcnt(0)" ::: "memory"); __builtin_amdgcn_s_barrier(); asm volatile("" ::: "memory"); } while (0)
#define N2_LOAD(bt, dst) do { _Pragma("unroll") for (int jr_ = 0; jr_ < 2; ++jr_) { const int row_ = (bt) * 16 + 2 * wave + jr_; \
        if (row_ < TL) { const bf16_t* sb_ = (const bf16_t*)(a.ws + WS_XB) + (size_t)row_ * D; dst[jr_][0] = __builtin_bit_cast(f32x4, *(const u32x4*)(sb_ + e0)); dst[jr_][1] = __builtin_bit_cast(f32x4, *(const u32x4*)(sb_ + e1)); } \
        else { const float* src_ = (const float*)(a.ws + WS_CTX) + (size_t)(row_ - TL) * D; \
        dst[jr_][0] = *(const f32x4*)(src_ + e0); dst[jr_][1] = *(const f32x4*)(src_ + e0 + 4); dst[jr_][2] = *(const f32x4*)(src_ + e1); dst[jr_][3] = *(const f32x4*)(src_ + e1 + 4); } } } while (0)
    f32x4 vc[2][4];
    const int nbatch = nrows / 16;
    const int per = (nbatch + nb - 1) / nb, b_lo = bid * per, b_hi = min(b_lo + per, nbatch);
    if (b_lo < b_hi) N2_LOAD(b_lo, vc);
    for (int batch = b_lo; batch < b_hi; ++batch) {
        const int R0 = batch * 16, r = R0 < TL ? R0 / SEQ : 16;
        N2_BAR();
        if (r != cur_r) { cur_r = r; const float* sh = modp(a, l, r, 3); const float* sc = modp(a, l, r, 4); const float* w = a.norm_ffn_w + l * D;
            for (int k = tid; k < D; k += NT) { tsc[k] = (1.0f + sc[k]) * w[k]; tsh[k] = sh[k]; }
            N2_BAR(); }
#pragma unroll
        for (int jr = 0; jr < 2; ++jr) {
            const int m = 2 * wave + jr, row = R0 + m;
            float v[16];
            if (R0 < TL) { const u32x4 w0 = __builtin_bit_cast(u32x4, vc[jr][0]), w1 = __builtin_bit_cast(u32x4, vc[jr][1]);
#pragma unroll
                for (int j = 0; j < 4; ++j) { v[2 * j] = lo16(w0[j]); v[2 * j + 1] = hi16(w0[j]); v[8 + 2 * j] = lo16(w1[j]); v[8 + 2 * j + 1] = hi16(w1[j]); } }
            else {
#pragma unroll
                for (int j = 0; j < 4; ++j) { v[j] = vc[jr][0][j]; v[4 + j] = vc[jr][1][j]; v[8 + j] = vc[jr][2][j]; v[12 + j] = vc[jr][3][j]; } }
            float ss = 0.f;
#pragma unroll
            for (int j = 0; j < 16; ++j) ss += v[j] * v[j];
            ss = wave_sum(ss);
            const float rs = rsqrtf(ss * (1.0f / D) + 1e-6f);
            unsigned ph[8], pl[8], p8[4]; float yk0 = 0.f, yk1 = 0.f;
            float msc[16], msh[16];
#pragma unroll
            for (int q = 0; q < 2; ++q) { const f32x4 c0 = *(const MLAS f32x4*)(tsc + e0 + 4 * q), c1 = *(const MLAS f32x4*)(tsc + e1 + 4 * q), h0 = *(const MLAS f32x4*)(tsh + e0 + 4 * q), h1 = *(const MLAS f32x4*)(tsh + e1 + 4 * q);
#pragma unroll
                for (int j = 0; j < 4; ++j) { msc[4 * q + j] = c0[j]; msc[8 + 4 * q + j] = c1[j]; msh[4 * q + j] = h0[j]; msh[8 + 4 * q + j] = h1[j]; } }
#pragma unroll
            for (int j = 0; j < 16; j += 2) {
                const float y0 = v[j] * rs * msc[j] + msh[j], y1 = v[j + 1] * rs * msc[j + 1] + msh[j + 1];
                const bf16_t h0 = f2bf(y0), h1 = f2bf(y1);
                ph[j >> 1] = (unsigned)h0 | ((unsigned)h1 << 16); pl[j >> 1] = pack2(y0 - bf2f(h0), y1 - bf2f(h1));
                if (j & 2) p8[j >> 2] = pack4_fp8(yk0, yk1, y0, y1); else { yk0 = y0; yk1 = y1; } }
            unsigned char* hp = (unsigned char*)hb + (size_t)row * D;
            *(u32x2*)(hp + e0) = (u32x2){p8[0], p8[1]}; *(u32x2*)(hp + e1) = (u32x2){p8[2], p8[3]};
            *(MLAS u32x4*)(Ahi + m * N2P + e0) = (u32x4){ph[0], ph[1], ph[2], ph[3]}; *(MLAS u32x4*)(Ahi + m * N2P + e1) = (u32x4){ph[4], ph[5], ph[6], ph[7]};
            *(MLAS u32x4*)(Alo + m * N2P + e0) = (u32x4){pl[0], pl[1], pl[2], pl[3]}; *(MLAS u32x4*)(Alo + m * N2P + e1) = (u32x4){pl[4], pl[5], pl[6], pl[7]};
        }
        if (batch + 1 < b_hi) N2_LOAD(batch + 1, vc);
        N2_BAR();
        {
            f32x4v acc0 = {0.f, 0.f, 0.f, 0.f}, acc1 = {0.f, 0.f, 0.f, 0.f};
#pragma unroll
            for (int ks = 0; ks < 4; ++ks) {
                const int o = (lane & 15) * N2P + 128 * wave + 32 * ks + 8 * (lane >> 4);
                const bf16x8 ah = *(const MLAS bf16x8*)(Ahi + o), al = *(const MLAS bf16x8*)(Alo + o);
                acc0 = __builtin_amdgcn_mfma_f32_16x16x32_bf16(ah, Bh[ks][0], acc0, 0, 0, 0); acc0 = __builtin_amdgcn_mfma_f32_16x16x32_bf16(al, Bh[ks][0], acc0, 0, 0, 0); acc0 = __builtin_amdgcn_mfma_f32_16x16x32_bf16(ah, Bl[ks][0], acc0, 0, 0, 0);
                acc1 = __builtin_amdgcn_mfma_f32_16x16x32_bf16(ah, Bh[ks][1], acc1, 0, 0, 0); acc1 = __builtin_amdgcn_mfma_f32_16x16x32_bf16(al, Bh[ks][1], acc1, 0, 0, 0); acc1 = __builtin_amdgcn_mfma_f32_16x16x32_bf16(ah, Bl[ks][1], acc1, 0, 0, 0);
            }
#pragma unroll
            for (int rg = 0; rg < 4; ++rg) { const int m = 4 * (lane >> 4) + rg; part[(wave * 16 + m) * 32 + (lane & 15)] = acc0[rg]; part[(wave * 16 + m) * 32 + 16 + (lane & 15)] = acc1[rg]; }
        }
        N2_BAR();
        {
            const int m = tid >> 5, ex = tid & 31, hb32 = lane & 32, row = R0 + m;
            float acc = 0.f;
#pragma unroll
            for (int w8 = 0; w8 < 8; ++w8) acc += part[(w8 * 16 + m) * 32 + ex];
            const float sg = 1.0f / (1.0f + __expf(-acc)), ssel = sg + rbias;
            float best = -1e30f; int grp = 0;
#pragma unroll
            for (int g = 0; g < 8; ++g) {
                const float v0 = __shfl(ssel, hb32 + g * 4), v1 = __shfl(ssel, hb32 + g * 4 + 1), v2 = __shfl(ssel, hb32 + g * 4 + 2), v3 = __shfl(ssel, hb32 + g * 4 + 3);
                const float hi01 = fmaxf(v0, v1), lo01 = fminf(v0, v1), hi23 = fmaxf(v2, v3), lo23 = fminf(v2, v3);
                const float top = fmaxf(hi01, hi23), second = fmaxf(fminf(hi01, hi23), hi01 >= hi23 ? lo01 : lo23);
                const float gs = top + second;
                if (gs > best) { best = gs; grp = g; }
            }
            float w4[4], s4[4];
#pragma unroll
            for (int j = 0; j < 4; ++j) { w4[j] = __shfl(ssel, hb32 + grp * 4 + j); s4[j] = __shfl(sg, hb32 + grp * 4 + j); }
            int i0 = 0;
#pragma unroll
            for (int j = 1; j < 4; ++j) if (w4[j] > w4[i0]) i0 = j;
            int i1 = i0 == 0 ? 1 : 0;
#pragma unroll
            for (int j = 0; j < 4; ++j) if (j != i0 && j != i1 && w4[j] > w4[i1]) i1 = j;
            float g0 = 0.f, g1 = 0.f;
#pragma unroll
            for (int j = 0; j < 4; ++j) { g0 = (j == i0) ? s4[j] : g0; g1 = (j == i1) ? s4[j] : g1; }
            const float inv = 1.0f / (g0 + g1);
            if (ex < 2) {
                const int e = grp * 4 + (ex == 0 ? i0 : i1);
                const unsigned rank = __hip_atomic_fetch_add(lcnt + e, 1u, __ATOMIC_RELAXED, __HIP_MEMORY_SCOPE_WORKGROUP);
                tok_e[row * 2 + ex] = e; tok_r[row * 2 + ex] = (int)rank; tok_w[row * 2 + ex] = (ex == 0 ? g0 : g1) * inv;
            }
        }
    }
    N2_BAR();
    if (tid < NE) ((int*)(a.ws + WS_BLKB))[bid * NE + tid] = (int)atomicAdd(cnt + tid * 32, lcnt[tid]);
#undef N2_BAR
#undef N2_LOAD
}
__device__ __forceinline__ void phase_gather(const Args& a, int l, MLAS unsigned char* lds, int bid, int nb) {
    const int tid = otid(), lane = tid & 63, wave = tid >> 6;
    MLAS int* pbase = (MLAS int*)lds;
    MLAS int* cn = pbase + 64;
    const unsigned* cnt = (const unsigned*)(a.ws + WS_CNT) + l * 2048; const int* blkb = (const int*)(a.ws + WS_BLKB);
    if (tid == 0) { int acc = 0; for (int e = 0; e < NE; ++e) { const int c = (int)__hip_atomic_load(cnt + e * 32, __ATOMIC_RELAXED, __HIP_MEMORY_SCOPE_AGENT); cn[e] = c; pbase[e] = acc; acc += (c + 255) & ~255; } pbase[NE] = acc; }
    __syncthreads();
    int* rinfo = (int*)(a.ws + WS_RINFO); float* rw = (float*)(a.ws + WS_RW); int* blke = (int*)(a.ws + WS_BLKE);
    if (bid == 0) {
        for (int e = 0; e < NE; ++e) {
            for (int p = pbase[e] + cn[e] + tid; p < pbase[e + 1]; p += NT) { rinfo[p] = -1; rw[p] = 0.f; }
            for (int blk = (pbase[e] >> 8) + tid; blk < (pbase[e + 1] >> 8); blk += NT) blke[blk] = e;
        }
        if (tid == 0) blke[1023] = (pbase[NE] >> 8) * 4;
    }
    const int* tok_e = (const int*)(a.ws + WS_TOKE); const int* tok_r = (const int*)(a.ws + WS_TOKR); const float* tok_w = (const float*)(a.ws + WS_TOKW);
    const int nas = (l == 0 ? TT : TL) * 2, per_ = ((l == 0 ? TT : TL) / 16 + nb - 1) / nb;
    for (int as = bid * NT + tid; as < nas; as += nb * NT) {
        const int t = as >> 1, e = tok_e[as], pos = pbase[e] + blkb[((t >> 4) / per_) * NE + e] + tok_r[as];
        rinfo[pos] = as; ((int*)(a.ws + WS_TOKR))[as] = pos;
    }
}

using pg8::Unit;
struct EpiStoreBf16 {
    static constexpr bool PERM = true, AFTER_DRAIN = false;
    bf16_t* O; int ldc; bf16_t* kc_lat; bf16_t* vt_lat; bf16_t* kc_ctx; bf16_t* vt_ctx; const float* knw; MLAS unsigned char* sp;
    __device__ __forceinline__ void operator()(const f32x4 (&acc)[2][2][4][2], const Unit& u, int wr, int wc, int fr, int fq) const {
        const int row0 = u.pm * 256 + wr * 64 + fr;
        if (u.pn < 2 || u.pn > 5) {
            const int col0 = u.pn * 256 + wc * 32 + 8 * fq;
#pragma unroll
            for (int ai = 0; ai < 2; ++ai)
#pragma unroll
                for (int m = 0; m < 4; ++m) { bf16_t* rowp = O + (size_t)(row0 + ai * 128 + m * 16) * ldc + col0;
#pragma unroll
                    for (int bj = 0; bj < 2; ++bj) { const f32x4 v0 = acc[ai][bj][m][0], v1 = acc[ai][bj][m][1];
                        *(u32x4*)(rowp + bj * 128) = (u32x4){pg8::cvt_pk_bf16(v0[0], v0[1]), pg8::cvt_pk_bf16(v0[2], v0[3]), pg8::cvt_pk_bf16(v1[0], v1[1]), pg8::cvt_pk_bf16(v1[2], v1[3])}; } }
            return;
        }
        const bool lat = u.pm < 256;
        if (u.pn < 4) {
            MLAS float* part = (MLAS float*)sp;
            float ss[2][4][2];
#pragma unroll
            for (int ai = 0; ai < 2; ++ai)
#pragma unroll
                for (int m = 0; m < 4; ++m)
#pragma unroll
                    for (int bj = 0; bj < 2; ++bj) { const f32x4 v0 = acc[ai][bj][m][0], v1 = acc[ai][bj][m][1];
                        float q = (v0[0] * v0[0] + v0[1] * v0[1]) + (v0[2] * v0[2] + v0[3] * v0[3]) + (v1[0] * v1[0] + v1[1] * v1[1]) + (v1[2] * v1[2] + v1[3] * v1[3]);
                        q += __shfl_xor(q, 16); q += __shfl_xor(q, 32); ss[ai][m][bj] = q;
                        if (fq == 0) part[((((ai * 4 + m) * 2 + bj) * 2 + wr) * 16 + fr) * 4 + wc] = q; }
            asm volatile("s_waitcnt lgkmcnt(0)" ::: "memory"); __builtin_amdgcn_s_barrier(); asm volatile("" ::: "memory");
            const f32x4 w0 = *(const f32x4*)(knw + (wc & 1) * 32 + 8 * fq), w1 = *(const f32x4*)(knw + (wc & 1) * 32 + 8 * fq + 4);
#pragma unroll
            for (int ai = 0; ai < 2; ++ai)
#pragma unroll
                for (int m = 0; m < 4; ++m) { const int row = row0 + ai * 128 + m * 16;
                    const int b = lat ? row >> 12 : (row - TL) >> 8, t = lat ? row & (SEQ - 1) : (row - TL) & (LC - 1), tlen = lat ? SEQ : LC;
                    bf16_t* kb = (lat ? kc_lat : kc_ctx);
#pragma unroll
                    for (int bj = 0; bj < 2; ++bj) {
                        const float other = part[((((ai * 4 + m) * 2 + bj) * 2 + wr) * 16 + fr) * 4 + (wc ^ 1)];
                        const float rs = rsqrtf((ss[ai][m][bj] + other) * (1.0f / 64.0f) + 1e-6f);
                        const f32x4 v0 = acc[ai][bj][m][0] * rs * w0, v1 = acc[ai][bj][m][1] * rs * w1;
                        const int head = (u.pn - 2) * 4 + 2 * bj + (wc >> 1);
                        *(u32x4*)(kb + (((size_t)b * 8 + head) * tlen + t) * 64 + (wc & 1) * 32 + 8 * fq) = (u32x4){pg8::cvt_pk_bf16(v0[0], v0[1]), pg8::cvt_pk_bf16(v0[2], v0[3]), pg8::cvt_pk_bf16(v1[0], v1[1]), pg8::cvt_pk_bf16(v1[2], v1[3])}; } }
            return;
        }
        {
            MLAS bf16_t* gb = (MLAS bf16_t*)(sp + wr * 8192);
            bf16_t* vb = lat ? vt_lat : vt_ctx; const int ngrp = lat ? SEQ / 16 : LC / 16;
#pragma unroll
            for (int ai = 0; ai < 2; ++ai)
#pragma unroll
                for (int m = 0; m < 4; ++m) {
#pragma unroll
                    for (int bj = 0; bj < 2; ++bj)
#pragma unroll
                        for (int n = 0; n < 2; ++n) { const f32x4 v = acc[ai][bj][m][n]; const int c = bj * 128 + wc * 32 + 8 * fq + 4 * n;
                            const unsigned p01 = pg8::cvt_pk_bf16(v[0], v[1]), p23 = pg8::cvt_pk_bf16(v[2], v[3]);
                            gb[(c + 0) * 16 + fr] = (bf16_t)(p01 & 0xffffu); gb[(c + 1) * 16 + fr] = (bf16_t)(p01 >> 16);
                            gb[(c + 2) * 16 + fr] = (bf16_t)(p23 & 0xffffu); gb[(c + 3) * 16 + fr] = (bf16_t)(p23 >> 16); }
                    asm volatile("s_waitcnt lgkmcnt(0)" ::: "memory"); __builtin_amdgcn_s_barrier(); asm volatile("" ::: "memory");
                    const int rowb = u.pm * 256 + ai * 128 + wr * 64 + m * 16;
                    const int b = lat ? rowb >> 12 : (rowb - TL) >> 8, g16 = (lat ? rowb & (SEQ - 1) : (rowb - TL) & (LC - 1)) >> 4;
#pragma unroll
                    for (int k = 0; k < 2; ++k) { const int qd = wc * 64 + fr + 16 * fq + 256 * k, c = qd >> 1, half = qd & 1;
                        const u32x4 w = *(const MLAS u32x4*)(gb + c * 16 + 8 * half);
                        const int head = (u.pn - 4) * 4 + (c >> 6), d = c & 63;
                        *(u32x4*)(vb + ((((size_t)b * 8 + head) * ngrp + g16) * 64 + d) * 16 + 8 * half) = w; }
                    asm volatile("s_waitcnt lgkmcnt(0)" ::: "memory"); __builtin_amdgcn_s_barrier(); asm volatile("" ::: "memory");
                }
        }
    }
};
struct EpiResGate {
    static constexpr bool PERM = true, AFTER_DRAIN = false;
    const void* xin_lat; const float* xin_ctx; bf16_t* out_lat; float* out_ctx; const float* modl; int in_bf16;
    __device__ __forceinline__ void operator()(const f32x4 (&acc)[2][2][4][2], const Unit& u, int wr, int wc, int fr, int fq) const {
        const bool lat = u.pm < 256; const int r = lat ? (u.pm >> 4) : 16;
        const int rowt = (lat ? u.pm : u.pm - 256) * 256 + wr * 64 + fr, col0 = u.pn * 256 + wc * 32 + 8 * fq;
        const float* g = modl + (size_t)r * 6144 + 2 * 1024 + col0;
        f32x4 gv[2][2];
#pragma unroll
        for (int bj = 0; bj < 2; ++bj)
#pragma unroll
            for (int n = 0; n < 2; ++n) gv[bj][n] = *(const f32x4*)(g + bj * 128 + 4 * n);
#pragma unroll
        for (int ai = 0; ai < 2; ++ai)
#pragma unroll
            for (int m = 0; m < 4; ++m) { const size_t off = (size_t)(rowt + ai * 128 + m * 16) * D + col0;
#pragma unroll
                for (int bj = 0; bj < 2; ++bj) {
                    f32x4 x0, x1;
                    if (!lat) { x0 = *(const f32x4*)(xin_ctx + off + bj * 128); x1 = *(const f32x4*)(xin_ctx + off + bj * 128 + 4); }
                    else if (in_bf16) { const u32x4 w = *(const u32x4*)((const bf16_t*)xin_lat + off + bj * 128); x0 = (f32x4){lo16(w.x), hi16(w.x), lo16(w.y), hi16(w.y)}; x1 = (f32x4){lo16(w.z), hi16(w.z), lo16(w.w), hi16(w.w)}; }
                    else { x0 = *(const f32x4*)((const float*)xin_lat + off + bj * 128); x1 = *(const f32x4*)((const float*)xin_lat + off + bj * 128 + 4); }
                    x0 += gv[bj][0] * acc[ai][bj][m][0]; x1 += gv[bj][1] * acc[ai][bj][m][1];
                    if (lat) *(u32x4*)(out_lat + off + bj * 128) = (u32x4){pack2(x0[0], x0[1]), pack2(x0[2], x0[3]), pack2(x1[0], x1[1]), pack2(x1[2], x1[3])};
                    else { *(f32x4*)(out_ctx + off + bj * 128) = x0; *(f32x4*)(out_ctx + off + bj * 128 + 4) = x1; } } }
    }
};
struct EpiSwiglu {
    static constexpr bool PERM = true, AFTER_DRAIN = false;
    bf16_t* act;
    __device__ __forceinline__ void operator()(const f32x4 (&acc)[2][2][4][2], const Unit& u, int wr, int wc, int fr, int fq) const {
        const int row0 = u.pm * 256 + wr * 64 + fr, col0 = (u.pn & 3) * 128 + wc * 32 + 8 * fq;
#pragma unroll
        for (int ai = 0; ai < 2; ++ai)
#pragma unroll
            for (int m = 0; m < 4; ++m) { float r[8];
#pragma unroll
                for (int n = 0; n < 2; ++n)
#pragma unroll
                    for (int j = 0; j < 4; ++j) { const float gt = acc[ai][0][m][n][j]; r[n * 4 + j] = siluf(gt) * acc[ai][1][m][n][j]; }
                *(u32x2*)((unsigned char*)act + (size_t)(row0 + ai * 128 + m * 16) * DFF + col0) = (u32x2){pack4_fp8(r[0], r[1], r[2], r[3]), pack4_fp8(r[4], r[5], r[6], r[7])}; }
    }
};
struct EpiDown {
    static constexpr bool PERM = true, AFTER_DRAIN = false;
    bf16_t* ys;
    __device__ __forceinline__ void operator()(const f32x4 (&acc)[2][2][4][2], const Unit& u, int wr, int wc, int fr, int fq) const {
        const int row0 = u.pm * 256 + wr * 64 + fr, col0 = (u.pn & 3) * 256 + wc * 32 + 8 * fq;
#pragma unroll
        for (int ai = 0; ai < 2; ++ai)
#pragma unroll
            for (int m = 0; m < 4; ++m) { bf16_t* rowp = ys + (size_t)(row0 + ai * 128 + m * 16) * D + col0;
#pragma unroll
                for (int bj = 0; bj < 2; ++bj) { const f32x4 v0 = acc[ai][bj][m][0], v1 = acc[ai][bj][m][1];
                    *(u32x4*)(rowp + bj * 128) = (u32x4){pg8::cvt_pk_bf16(v0[0], v0[1]), pg8::cvt_pk_bf16(v0[2], v0[3]), pg8::cvt_pk_bf16(v1[0], v1[1]), pg8::cvt_pk_bf16(v1[2], v1[3])}; } }
    }
};
struct MoeOrder {
    const MLAS int* blke; int nunits, G, c;
    __device__ __forceinline__ bool next(int i, Unit& u) const { const int x = c & 7, j = c >> 3; int L;
        if (G == 256) { const int rb = i * 64 + (j >> 2) * 8 + x; L = rb * 4 + (j & 3); } else L = i * G + c;
        if (L >= nunits) return false; u.pm = L >> 2; u.pn = blke[L >> 2] * 4 + (L & 3); return true; }
    __device__ __forceinline__ void a_ready(const Unit&) const {}
    __device__ __forceinline__ void done(const Unit&) const {}
};

typedef const Args __attribute__((address_space(4))) CArgs;
#define MK_LOAD_ARGS(a, p) do { (a).x = (p)->x; (a).c = (p)->c; (a).ctx = (p)->ctx; (a).c_ctx = (p)->c_ctx; (a).ada_w = (p)->ada_w; (a).ada_b = (p)->ada_b; (a).norm_mix_w = (p)->norm_mix_w; (a).norm_ffn_w = (p)->norm_ffn_w; (a).w_in = (p)->w_in; (a).na_q_norm = (p)->na_q_norm; (a).na_k_norm = (p)->na_k_norm; (a).na_rpb = (p)->na_rpb; (a).ret_decay = (p)->ret_decay; (a).w_out = (p)->w_out; (a).router_w = (p)->router_w; (a).router_bias = (p)->router_bias; (a).w_gate = (p)->w_gate; (a).w_up = (p)->w_up; (a).w_down = (p)->w_down; (a).out = (p)->out; (a).ws = (p)->ws; (a).ph_lo = (p)->ph_lo; (a).ph_hi = (p)->ph_hi; } while (0)
#ifndef MK_SINGLE
#define MK_SINGLE 1
#endif
constexpr int NPHASES = 24;
#ifndef MK_PROBE_MASK
#define MK_PROBE_MASK 0
#endif
#ifndef MK_BAR2
#define MK_BAR2 0
#endif
#ifndef MK_PROBE_MULT
#define MK_PROBE_MULT 4
#endif
enum { K_PRO = 0, K_NORM1, K_GEMM_IN, K_PREP, K_NA, K_RET_A, K_SCAN, K_RET_B, K_GEMM_OUT, K_NORM2, K_GATHER, K_MOE1, K_MOE2, K_FINAL };
__global__ void __launch_bounds__(NT, 2) fwd(Args ka) {
    extern __shared__ __attribute__((aligned(16))) unsigned char lds_raw[];
    MLAS unsigned char* lds = (MLAS unsigned char*)lds_raw;
    const int tid = threadIdx.x, nb = gridDim.x;
    volatile MLAS unsigned* ctl = (volatile MLAS unsigned*)(lds + LDS_CTL);
    if (tid < 4) ctl[tid] = 0u;
    __syncthreads();
    const bool multi = MK_SINGLE != 0;
    XcdBarrier bar; bar.bar = (unsigned*)(ka.ws + WS_BAR); bar.x = 0; bar.st = ctl;
    if (multi) bar = xcd_barrier_post((unsigned*)(ka.ws + WS_BAR), ctl);
    int ph = 0;
#if MK_SINGLE
#define MK_GUARD 1
#define MK_SEAM(kind) ((kind) != K_FINAL)
#else
#define MK_GUARD (ph >= ka.ph_lo && ph < ka.ph_hi)
#define MK_SEAM(kind) (ph + 1 < ka.ph_hi)
#endif
#define PHASE(kind, ...) do { if (MK_GUARD) { CArgs* ap_ = (CArgs*)__builtin_amdgcn_kernarg_segment_ptr(); asm volatile("" : "+s"(ap_)); Args a; MK_LOAD_ARGS(a, ap_); int bid = blockIdx.x; asm volatile("" : "+s"(bid)); unsigned long long t0_ = 0; if ((MK_PROBE_MASK >> (kind)) & 1) t0_ = wall_clock64(); { __VA_ARGS__; } if ((MK_PROBE_MASK >> (kind)) & 1) { const unsigned long long d_ = wall_clock64() - t0_; while (wall_clock64() - t0_ < d_ * (MK_PROBE_MULT + 1)) __builtin_amdgcn_s_sleep(8); } if (MK_SEAM(kind)) { XcdBarrier b_ = bar; asm volatile("" : "+s"(b_.bar), "+s"(b_.x)); xcd_barrier(b_); if (MK_BAR2) { xcd_barrier(b_); xcd_barrier(b_); } } } ++ph; } while (0)
    PHASE(K_PRO, { convert_small(a, bid, nb); convert_weights(a, true, 0, lds, bid, nb); compute_mod(a, lds, bid, nb); });
#define MK_LAYER(l) do { \
        PHASE(K_NORM1, { phase_norm1(a, l, bid, nb); if (l == 1) convert_weights(a, false, 1, lds, bid, nb); }); \
        PHASE(K_GEMM_IN, { pg8::Gemm g{(const bf16_t*)(a.ws + WS_H), (const bf16_t*)(a.ws + WS_WIN) + (size_t)l * INC * D, TT, INC, D}; \
                pg8::StaticOrder S; S.init(TT, INC, nb, bid); \
                EpiStoreBf16 E{(bf16_t*)(a.ws + WS_PROJ), INC, (bf16_t*)(a.ws + WS_KC), (bf16_t*)(a.ws + WS_VT), (bf16_t*)(a.ws + WS_KCC), (bf16_t*)(a.ws + WS_VTC), a.na_k_norm + l * 64, lds + 131072}; \
                pg8::gemm_phase<EpiStoreBf16, pg8::StaticOrder>(lds, g, S, E, nullptr); }); \
        PHASE(K_NA, phase_na(a, l, lds, bid, nb)); \
        PHASE(K_RET_A, phase_ret_a(a, l, lds, bid, nb)); \
        PHASE(K_SCAN, phase_scan(a, l, bid, nb)); \
        PHASE(K_RET_B, phase_ret_b(a, l, lds, bid, nb)); \
        PHASE(K_GEMM_OUT, { const int M = l == 0 ? TT : TL; \
                pg8::Gemm g{(const bf16_t*)(a.ws + WS_H), (const bf16_t*)(a.ws + WS_WOUT) + (size_t)l * D * D, M, D, D}; \
                pg8::StaticOrder S; S.init(M, D, nb, bid); \
                EpiResGate E{l == 0 ? (const void*)a.x : (const void*)a.out, a.ctx, (bf16_t*)(a.ws + WS_XB), (float*)(a.ws + WS_CTX), (const float*)(a.ws + WS_MOD) + (size_t)l * 17 * 6144, l}; \
                pg8::gemm_phase<EpiResGate, pg8::StaticOrder>(lds, g, S, E, nullptr); }); \
        PHASE(K_NORM2, phase_norm2(a, l, lds, bid, nb)); \
        PHASE(K_GATHER, phase_gather(a, l, lds, bid, nb)); \
        PHASE(K_MOE1, { MLAS int* blke = (MLAS int*)(lds + 131072); { const int* gb_ = (const int*)(a.ws + WS_BLKE); for (int i_ = otid(); i_ < 1024; i_ += NT) blke[i_] = gb_[i_]; __syncthreads(); } \
                pg8::Gemm g{(const bf16_t*)(a.ws + WS_H), (const bf16_t*)(a.ws + WS_WGU), PMAX, NE * 1024, D, (const int*)(a.ws + WS_RINFO), SC_MOE1}; \
                MoeOrder S{blke, blke[1023], nb, bid}; \
                EpiSwiglu E{(bf16_t*)(a.ws + WS_ACT)}; \
                pg8::gemm_phase<EpiSwiglu, MoeOrder, false, true, 1>(lds, g, S, E, nullptr); }); \
        PHASE(K_MOE2, { MLAS int* blke = (MLAS int*)(lds + 131072); { const int* gb_ = (const int*)(a.ws + WS_BLKE); for (int i_ = otid(); i_ < 1024; i_ += NT) blke[i_] = gb_[i_]; __syncthreads(); } \
                pg8::Gemm g{(const bf16_t*)(a.ws + WS_ACT), (const bf16_t*)(a.ws + WS_WDN), PMAX, NE * 1024, DFF, nullptr, SC_MOE2}; \
                MoeOrder S{blke, blke[1023], nb, bid}; \
                EpiDown E{(bf16_t*)(a.ws + WS_XS)}; \
                pg8::gemm_phase<EpiDown, MoeOrder, false, false, 1>(lds, g, S, E, nullptr); }); \
    } while (0)
    MK_LAYER(0);
    MK_LAYER(1);
#undef MK_LAYER
    PHASE(K_FINAL, phase_final(a, bid, nb));
#undef PHASE
}
}

extern "C" void kernel_launch(void* const* d_in, const int* in_sizes, int n_in, void* d_out, int out_size, void* d_ws, size_t ws_size, hipStream_t stream) {
    using namespace mk;
    static int grid = 0;
    if (grid == 0) {
        if (n_in != 19 || in_sizes[0] != TL * D || out_size != TL * D || ws_size < WS_END) {
            fprintf(stderr, "kernel_launch: unexpected shapes / workspace (n_in %d, in0 %d, out %d, ws %zu, need %zu); nothing launched\n", n_in, n_in > 0 ? in_sizes[0] : -1, out_size, ws_size, (size_t)WS_END);
            grid = -1; return; }
        int dev = 0, cus = 0, per_cu = 0;
        if (hipGetDevice(&dev) != hipSuccess || hipDeviceGetAttribute(&cus, hipDeviceAttributeMultiprocessorCount, dev) != hipSuccess) { grid = -1; return; }
        if (hipFuncSetAttribute((const void*)fwd, hipFuncAttributeMaxDynamicSharedMemorySize, LDS_BYTES) != hipSuccess) { fprintf(stderr, "kernel_launch: hipFuncSetAttribute failed\n"); grid = -1; return; }
        if (hipOccupancyMaxActiveBlocksPerMultiprocessor(&per_cu, (const void*)fwd, NT, LDS_BYTES) != hipSuccess || per_cu < 1) { fprintf(stderr, "kernel_launch: occupancy query says %d\n", per_cu); (void)hipGetLastError(); grid = -1; return; }
        grid = cus;
    }
    if (grid < 0) return;
    (void)hipMemsetAsync((char*)d_ws + WS_BAR, 0, WS_ZERO_BYTES, stream);
    Args a{};
    a.x = (const float*)d_in[0]; a.c = (const float*)d_in[1]; a.ctx = (const float*)d_in[2]; a.c_ctx = (const float*)d_in[3]; a.ada_w = (const float*)d_in[4]; a.ada_b = (const float*)d_in[5];
    a.norm_mix_w = (const float*)d_in[6]; a.norm_ffn_w = (const float*)d_in[7]; a.w_in = (const float*)d_in[8]; a.na_q_norm = (const float*)d_in[9]; a.na_k_norm = (const float*)d_in[10];
    a.na_rpb = (const float*)d_in[11]; a.ret_decay = (const float*)d_in[12]; a.w_out = (const float*)d_in[13]; a.router_w = (const float*)d_in[14]; a.router_bias = (const float*)d_in[15];
    a.w_gate = (const float*)d_in[16]; a.w_up = (const float*)d_in[17]; a.w_down = (const float*)d_in[18];
    a.out = (float*)d_out; a.ws = (unsigned char*)d_ws;
#if MK_SINGLE
    a.ph_lo = 0; a.ph_hi = NPHASES;
    hipLaunchKernelGGL(fwd, dim3(grid), dim3(NT), LDS_BYTES, stream, a);
#else
    for (int ph = 0; ph < NPHASES; ++ph) { a.ph_lo = ph; a.ph_hi = ph + 1; hipLaunchKernelGGL(fwd, dim3(grid), dim3(NT), LDS_BYTES, stream, a); }
#endif
}
```

```cpp
#include <hip/hip_runtime.h>
#include <cstdio>
#include <cstdint>

#define XB_TMO      128
#define XB_XCNT(j)  (256  + 64 * (j))
#define XB_XSUB(j)  (1280 + 64 * (j))
#define XB_XGEN(j)  (2304 + 64 * (j))
#define XB_TOP      3328
#define XB_TOPGEN   3392
#define XCD_BAR_WORDS 3456
#define XB_SPIN_CAP (1u << 18)
#define LAS __attribute__((address_space(3)))

__device__ __forceinline__ unsigned xb_ld(unsigned* p)              { return __hip_atomic_load(p, __ATOMIC_RELAXED, __HIP_MEMORY_SCOPE_AGENT); }
__device__ __forceinline__ unsigned xb_add(unsigned* p, unsigned v) { return __hip_atomic_fetch_add(p, v, __ATOMIC_RELAXED, __HIP_MEMORY_SCOPE_AGENT); }
__device__ __forceinline__ unsigned xb_xcc_id() { return (unsigned)__builtin_amdgcn_s_getreg((3 << 11) | 20) & 0xFu; }
#define XB_SPIN(cond, bar) do { unsigned _sp = 0; while (cond) { __builtin_amdgcn_s_sleep(1); \
    if ((++_sp & 255u) == 0u) { if (xb_ld(&(bar)[XB_TMO])) break; if (_sp > XB_SPIN_CAP) { atomicAdd(&(bar)[XB_TMO], 1u); break; } } } } while (0)

struct XcdBarrier {
    unsigned* bar; unsigned x;
    volatile LAS unsigned* st;
};

__device__ __forceinline__ XcdBarrier xcd_barrier_post(unsigned* bar, volatile LAS unsigned* st) {
    XcdBarrier b; b.bar = bar; b.x = xb_xcc_id(); b.st = st;
    if (threadIdx.x == 0) (void)xb_add(&bar[XB_XCNT(b.x)], 1u);
    return b;
}
__device__ __forceinline__ void xcd_barrier_complete(unsigned* bar, unsigned x, unsigned& nloc, unsigned& nx) {
    const unsigned G = gridDim.x * gridDim.y * gridDim.z;
    unsigned sum, cnt, mine, sp = 0u;
    for (;;) {
        sum = 0u; cnt = 0u; mine = 0u;
#pragma unroll
        for (unsigned j = 0; j < 16; ++j) { const unsigned c = xb_ld(&bar[XB_XCNT(j)]); sum += c; cnt += (c > 0u) ? 1u : 0u; mine = (j == x) ? c : mine; }
        if (sum == G) break;
        __builtin_amdgcn_s_sleep(1);
        if ((++sp & 255u) == 0u) { if (xb_ld(&bar[XB_TMO])) break; if (sp > XB_SPIN_CAP) { atomicAdd(&bar[XB_TMO], 1u); break; } }
    }
    nloc = mine > 0u ? mine : 1u; nx = cnt > 0u ? cnt : 1u;
}

__device__ __forceinline__ void xcd_barrier(const XcdBarrier& b) {
    asm volatile("s_waitcnt vmcnt(0)" ::: "memory");
    __syncthreads();
    if (threadIdx.x == 0) {
        unsigned* bar = b.bar;
        __builtin_amdgcn_s_waitcnt(0);
        unsigned nloc = b.st[0], nx = b.st[1];
        if (nloc == 0u) { xcd_barrier_complete(bar, b.x, nloc, nx); b.st[0] = nloc; b.st[1] = nx; }
        const unsigned old = xb_add(&bar[XB_XSUB(b.x)], 1u);
        const unsigned gen = old / nloc;
        if (old + 1u == (gen + 1u) * nloc) {
            __builtin_amdgcn_fence(__ATOMIC_RELEASE, "agent");
            asm volatile("s_waitcnt vmcnt(0)" ::: "memory");
            const unsigned og = xb_add(&bar[XB_TOP], 1u);
            const unsigned tg = og / nx;
            if (og + 1u == (tg + 1u) * nx) xb_add(&bar[XB_TOPGEN], 1u);
            else XB_SPIN(xb_ld(&bar[XB_TOPGEN]) == tg, bar);
            __builtin_amdgcn_fence(__ATOMIC_ACQUIRE, "agent");
            xb_add(&bar[XB_XGEN(b.x)], 1u);
            asm volatile("s_waitcnt vmcnt(0)" ::: "memory");
        } else {
            XB_SPIN(xb_ld(&bar[XB_XGEN(b.x)]) == gen, bar);
            __builtin_amdgcn_fence(__ATOMIC_ACQUIRE, "agent");
            asm volatile("s_waitcnt vmcnt(0)" ::: "memory");
        }
    }
    __syncthreads();
}
namespace pg8 {
#define PG8_LAS __attribute__((address_space(3)))
typedef unsigned short bf16_t;
typedef short bf16x8 __attribute__((ext_vector_type(8)));
typedef float f32x4 __attribute__((ext_vector_type(4)));
typedef unsigned u32x4 __attribute__((ext_vector_type(4)));
constexpr int BM = 256, BK = 64, HALF = 128, HTB = HALF * BK * 2  , STAGE_BYTES = 8 * HTB, NXCD = 8, WGM = 8;

__host__ __device__ __forceinline__ int lds_byte(int r, int c) { const int st = (r >> 4) * 2 + (c >> 5), rr = r & 15, cc = c & 31, ob = rr * 64 + cc * 2; return st * 1024 + (ob ^ (((ob >> 9) & 1) << 5)); }
__host__ __device__ __forceinline__ void stage_rc(int b, int& R, int& C) { const int st = b / 1024, sb = b % 1024, swz = sb ^ (((sb >> 9) & 1) << 5); R = (st >> 1) * 16 + swz / 64; C = (st & 1) * 32 + (swz % 64) / 2; }
typedef int i32x4 __attribute__((ext_vector_type(4)));
typedef int i32x8 __attribute__((ext_vector_type(8)));
__host__ __device__ __forceinline__ int perm32(int rho) { const int n = rho >> 4, i = rho & 15; return 8 * (i >> 2) + 4 * n + (i & 3); }

struct Unit { int pm, pn; };
struct Gemm { const bf16_t* A; const bf16_t* Bt; int M, N, K; const int* rows = nullptr; int sc = 0x7f7f7f7f; };

struct StaticOrder {
    int nM, nN, nwg, G, c;
    __host__ __device__ void init(int M, int N, int G_, int c_) { nM = M / BM; nN = N / BM; nwg = nM * nN; G = G_; c = c_; }
    __host__ __device__ bool next(int i, Unit& u) const {
        const long L = (long)i * G + c; if (L >= nwg) return false;
        int wgid = (int)L; { const int q = nwg / NXCD, r = nwg % NXCD, xcd = wgid % NXCD, off = wgid / NXCD; wgid = (xcd < r ? xcd * (q + 1) : r * (q + 1) + (xcd - r) * q) + off; }
        const int nig = WGM * nN, gid = wgid / nig, fm = gid * WGM, gsz = (nM - fm) < WGM ? (nM - fm) : WGM;
        u.pm = fm + ((wgid % nig) % gsz); u.pn = (wgid % nig) / gsz; return true;
    }
    __device__ __forceinline__ void a_ready(const Unit&) const {}
    __device__ __forceinline__ void done(const Unit&) const {}
};
__device__ __forceinline__ unsigned cvt_pk_bf16(float lo, float hi) { unsigned r; asm volatile("v_cvt_pk_bf16_f32 %0, %1, %2" : "=v"(r) : "v"(lo), "v"(hi)); return r; }
typedef float f32x2 __attribute__((ext_vector_type(2)));
template <class Epi, class Sched, bool STAMP = false, bool GATHER = false, int ES = 2>
__device__ __forceinline__ void gemm_phase(PG8_LAS unsigned char* lds, const Gemm g, const Sched& S, const Epi& E, unsigned long long* stamps) {
    int tid_o_ = threadIdx.x; asm volatile("" : "+v"(tid_o_)); const int tid = tid_o_, wid = __builtin_amdgcn_readfirstlane(tid >> 6), lane = tid & 63, wr = wid >> 2, wc = wid & 3, fr = lane & 15, fq = lane >> 4;
    const int K = g.K, nt = K * ES / (BK * 2);
    int ts_lo = 0, ts_hi = 0, nts = 0; const unsigned long long rt_entry = STAMP ? (unsigned long long)wall_clock64() : 0ull;
#define PG8_STAMP() do { if (STAMP && wid == 0 && nts < 64) { const unsigned long long _c = (unsigned long long)clock64(); \
        ts_lo = (lane == nts) ? (int)(unsigned)_c : ts_lo; ts_hi = (lane == nts) ? (int)(unsigned)(_c >> 32) : ts_hi; ++nts; } } while (0)
    PG8_STAMP();
    unsigned voffA[2], voffB[2]; int rA_[2]; unsigned cA_[2];
#pragma unroll
    for (int i = 0; i < 2; ++i) { int R, C; stage_rc(tid * 16 + i * 8192, R, C); C *= 2; const int Rb = Epi::PERM ? ((R & ~31) + perm32(R & 31)) : R;
        voffA[i] = (unsigned)(R * K * ES + C); voffB[i] = (unsigned)(Rb * K * ES + C); rA_[i] = R; cA_[i] = (unsigned)C; }
    unsigned gA[2][2], v2_[2][2];
#define PG8_ROWS(u, dst) do { _Pragma("unroll") for (int h_ = 0; h_ < 2; ++h_) _Pragma("unroll") for (int i_ = 0; i_ < 2; ++i_) { const int as_ = g.rows[(u).pm * BM + h_ * HALF + rA_[i_]]; \
        dst[h_][i_] = (unsigned)(as_ < 0 ? 0 : as_ >> 1) * (unsigned)(K * ES) + cA_[i_]; } } while (0)
    const size_t kstep = (size_t)(BK * 2);
    const size_t hstep = (size_t)HALF * K * ES;
    const size_t b64_ = (size_t)64 * K * ES;
    const size_t tstep = 2 * hstep;
    const unsigned ldsw = (unsigned)wid * 1024u;
    const int aoff = lds_byte(wr * 64 + fr, fq * 8), boff = lds_byte(wc * 32 + fr, fq * 8);
#define PG8_SA(b, h) (((b) * 2 + (h)) * HTB)
#define PG8_SB(b, h) ((4 + (b) * 2 + (h)) * HTB)
#define PG8_STAGE(bufoff, gbase, voff) do { _Pragma("unroll") for (int _i = 0; _i < 2; ++_i) { unsigned vo_ = (voff)[_i]; asm volatile("" : "+v"(vo_));     \
        __builtin_amdgcn_global_load_lds((const unsigned*)((const char*)(gbase) + vo_), (PG8_LAS unsigned*)(lds + (bufoff) + ldsw + _i * 8192), 16, 0, 0); } } while (0)
#define PG8_STAGEB(bufoff, gbase) do { unsigned vo_ = voffB[0]; asm volatile("" : "+v"(vo_));     \
        __builtin_amdgcn_global_load_lds((const unsigned*)((const char*)(gbase) + vo_), (PG8_LAS unsigned*)(lds + (bufoff) + ldsw), 16, 0, 0); \
        __builtin_amdgcn_global_load_lds((const unsigned*)((const char*)(gbase) + b64_ + vo_), (PG8_LAS unsigned*)(lds + (bufoff) + ldsw + 8192), 16, 0, 0); } while (0)
#define PG8_LDA(dst, b, h) do { _Pragma("unroll") for (int m = 0; m < 4; ++m) _Pragma("unroll") for (int k = 0; k < 2; ++k) dst[m][k] = *(const PG8_LAS bf16x8*)(lds + PG8_SA(b, h) + aoff + m * 2048 + k * 1024); } while (0)
#define PG8_LDB(dst, b, h) do { _Pragma("unroll") for (int n = 0; n < 2; ++n) _Pragma("unroll") for (int k = 0; k < 2; ++k) dst[n][k] = *(const PG8_LAS bf16x8*)(lds + PG8_SB(b, h) + boff + n * 2048 + k * 1024); } while (0)
#define PG8_CAT(f) __builtin_shufflevector(__builtin_bit_cast(i32x4, f[0]), __builtin_bit_cast(i32x4, f[1]), 0, 1, 2, 3, 4, 5, 6, 7)
#define PG8_MMA(ai, bj, At, Bt) do { __builtin_amdgcn_s_setprio(1); _Pragma("unroll") for (int m = 0; m < 4; ++m) _Pragma("unroll") for (int n = 0; n < 2; ++n) { \
        if constexpr (ES == 2) { _Pragma("unroll") for (int k = 0; k < 2; ++k) acc[ai][bj][m][n] = __builtin_amdgcn_mfma_f32_16x16x32_bf16(Bt[n][k], At[m][k], acc[ai][bj][m][n], 0, 0, 0); } \
        else { const i32x8 b8_ = PG8_CAT(Bt[n]), a8_ = PG8_CAT(At[m]); asm volatile("v_mfma_scale_f32_16x16x128_f8f6f4 %0, %1, %2, %0, %3, %3 op_sel_hi:[0,0,0]" : "+v"(acc[ai][bj][m][n]) : "v"(b8_), "v"(a8_), "v"(sc_)); } } __builtin_amdgcn_s_setprio(0); } while (0)
#define PG8_WAIT_V(n) asm volatile("s_waitcnt vmcnt(" #n ")" ::: "memory")
#define PG8_WAIT_L(n) asm volatile("s_waitcnt lgkmcnt(" #n ")" ::: "memory")
#define PG8_BAR __builtin_amdgcn_s_barrier()
#define PG8_SCHED __builtin_amdgcn_sched_barrier(0)
    const int sc_ = g.sc;
    Unit cur, nxt; int ui = 0;
    if (!S.next(0, cur)) return;
    f32x4 acc[2][2][4][2];
#pragma unroll
    for (int a = 0; a < 2; ++a)
#pragma unroll
        for (int b = 0; b < 2; ++b)
#pragma unroll
            for (int m = 0; m < 4; ++m)
#pragma unroll
                for (int n = 0; n < 2; ++n) acc[a][b][m][n] = (f32x4){0.f, 0.f, 0.f, 0.f};
    bf16x8 At[4][2], B0[2][2], B1[2][2];
    const char* cA = (const char*)g.A + (GATHER ? (size_t)0 : (size_t)cur.pm * tstep); const char* cB = (const char*)g.Bt + (size_t)cur.pn * tstep;
    S.a_ready(cur);
    if (GATHER) { PG8_ROWS(cur, gA); }
    const size_t hstepA = GATHER ? (size_t)0 : hstep;
#define PG8_VA(h) (GATHER ? gA[h] : voffA)
    PG8_STAGEB(PG8_SB(0, 0), cB); PG8_STAGE(PG8_SA(0, 0), cA, PG8_VA(0)); PG8_STAGEB(PG8_SB(0, 1), cB + hstep); PG8_STAGE(PG8_SA(0, 1), cA + hstepA, PG8_VA(1));
    if (wr == 1) PG8_BAR;
    PG8_WAIT_V(4); PG8_BAR;
    PG8_STAGEB(PG8_SB(1, 0), cB + kstep); PG8_STAGE(PG8_SA(1, 0), cA + kstep, PG8_VA(0)); PG8_STAGEB(PG8_SB(1, 1), cB + hstep + kstep);
    PG8_WAIT_V(6); PG8_BAR;
    PG8_STAMP();
    for (;;) {
        const bool has_next = S.next(ui + 1, nxt);
        if (GATHER && has_next && wid == 0) { unsigned lo_ = threadIdx.x; asm volatile("" : "+v"(lo_)); lo_ = (lo_ & 63u) * 16u;
            __builtin_amdgcn_global_load_lds((const unsigned*)((const char*)(g.rows + (size_t)nxt.pm * BM) + lo_), (PG8_LAS unsigned*)(lds + STAGE_BYTES + 4096 + ((ui + 1) & 1) * 1024), 16, 0, 0); }
        const char* nA = (has_next && !GATHER) ? (const char*)g.A + (size_t)nxt.pm * tstep : cA; const char* nB = has_next ? (const char*)g.Bt + (size_t)nxt.pn * tstep : cB;
        for (int t = 0; t < nt; t += 2) {
            const bool last = (t == nt - 2);
            const char* a1 = cA + (size_t)(t + 1) * kstep;
            const char* a2 = last ? nA : cA + (size_t)(t + 2) * kstep; const char* b2 = last ? nB : cB + (size_t)(t + 2) * kstep;
            const char* a3 = a2 + kstep; const char* b3 = b2 + kstep;
            if (last && has_next) S.a_ready(nxt);
            if (GATHER) { _Pragma("unroll") for (int h_ = 0; h_ < 2; ++h_) _Pragma("unroll") for (int i_ = 0; i_ < 2; ++i_) v2_[h_][i_] = gA[h_][i_]; }
            if (GATHER && last && has_next) { const PG8_LAS int* rl_ = (const PG8_LAS int*)(lds + STAGE_BYTES + 4096 + ((ui + 1) & 1) * 1024);
                int tq_ = threadIdx.x; asm volatile("" : "+v"(tq_));
                _Pragma("unroll") for (int i_ = 0; i_ < 2; ++i_) { int R_, C_; stage_rc(tq_ * 16 + i_ * 8192, R_, C_);
                    _Pragma("unroll") for (int h_ = 0; h_ < 2; ++h_) { const int as_ = rl_[h_ * HALF + R_]; v2_[h_][i_] = (unsigned)(as_ < 0 ? 0 : as_ >> 1) * (unsigned)(K * ES) + (unsigned)(C_ * 2); } } }
#define PG8_V2(h) (GATHER ? v2_[h] : voffA)
            PG8_LDB(B0, 0, 0); PG8_SCHED; PG8_LDA(At, 0, 0); PG8_STAGE(PG8_SA(1, 1), a1 + hstepA, PG8_VA(1));
            PG8_WAIT_L(8); PG8_BAR; PG8_WAIT_L(0); PG8_MMA(0, 0, At, B0); PG8_BAR; PG8_SCHED;
            PG8_LDB(B1, 0, 1); PG8_STAGEB(PG8_SB(0, 0), b2);
            PG8_BAR; PG8_WAIT_L(0); PG8_MMA(0, 1, At, B1); PG8_BAR;
            PG8_LDA(At, 0, 1); PG8_STAGE(PG8_SA(0, 0), a2, PG8_V2(0));
            PG8_BAR; PG8_WAIT_L(0); PG8_MMA(1, 0, At, B0); PG8_BAR; PG8_SCHED;
            PG8_STAGEB(PG8_SB(0, 1), b2 + hstep);
            PG8_WAIT_V(6); PG8_BAR; PG8_MMA(1, 1, At, B1); PG8_BAR;
            PG8_LDB(B0, 1, 0); PG8_SCHED; PG8_LDA(At, 1, 0); PG8_STAGE(PG8_SA(0, 1), a2 + hstepA, PG8_V2(1));
            PG8_WAIT_L(8); PG8_BAR; PG8_WAIT_L(0); PG8_MMA(0, 0, At, B0); PG8_BAR; PG8_SCHED;
            PG8_LDB(B1, 1, 1); PG8_STAGEB(PG8_SB(1, 0), b3);
            PG8_BAR; PG8_WAIT_L(0); PG8_MMA(0, 1, At, B1); PG8_BAR;
            PG8_LDA(At, 1, 1); PG8_STAGE(PG8_SA(1, 0), a3, PG8_V2(0));
            PG8_BAR; PG8_WAIT_L(0); PG8_MMA(1, 0, At, B0); PG8_BAR; PG8_SCHED;
            PG8_STAGEB(PG8_SB(1, 1), b3 + hstep);
            PG8_WAIT_V(6); PG8_BAR; PG8_MMA(1, 1, At, B1); PG8_BAR;
        }
        PG8_STAMP();
        if constexpr (ES == 1) asm volatile("s_nop 15\n\ts_nop 15\n\ts_nop 15" ::: "memory");
        if constexpr (!Epi::AFTER_DRAIN) { int te_ = threadIdx.x; asm volatile("" : "+v"(te_));
            E(acc, cur, __builtin_amdgcn_readfirstlane(te_ >> 8), __builtin_amdgcn_readfirstlane((te_ >> 6) & 3), te_ & 15, (te_ >> 4) & 3); S.done(cur); }
        PG8_STAMP();
        if (!has_next) break;
#pragma unroll
        for (int a = 0; a < 2; ++a)
#pragma unroll
            for (int b = 0; b < 2; ++b)
#pragma unroll
                for (int m = 0; m < 4; ++m)
#pragma unroll
                    for (int n = 0; n < 2; ++n) acc[a][b][m][n] = (f32x4){0.f, 0.f, 0.f, 0.f};
        cur = nxt; cA = nA; cB = nB; ++ui;
        if (GATHER) { _Pragma("unroll") for (int h_ = 0; h_ < 2; ++h_) _Pragma("unroll") for (int i_ = 0; i_ < 2; ++i_) gA[h_][i_] = v2_[h_][i_]; }
    }
    PG8_WAIT_V(0);
    if (wr == 0) PG8_BAR;
    PG8_BAR;
    if constexpr (Epi::AFTER_DRAIN) { E.fused(acc, cur, wr, wc, fr, fq, lds, wid, lane); S.done(cur); }
    PG8_STAMP();
    if (STAMP && wid == 0) { stamps[lane] = lane < nts ? (((unsigned long long)(unsigned)ts_hi << 32) | (unsigned)ts_lo) : 0ull;
        if (lane == 62) stamps[62] = rt_entry; if (lane == 63) stamps[63] = (unsigned long long)wall_clock64(); }
#undef PG8_STAMP
#undef PG8_SA
#undef PG8_SB
#undef PG8_STAGE
#undef PG8_STAGEB
#undef PG8_LDA
#undef PG8_LDB
#undef PG8_MMA
#undef PG8_CAT
#undef PG8_WAIT_V
#undef PG8_WAIT_L
#undef PG8_BAR
#undef PG8_SCHED
#undef PG8_ROWS
#undef PG8_VA
#undef PG8_V2
}
}

namespace mk {
#define MLAS __attribute__((address_space(3)))
typedef unsigned short bf16_t;
typedef float f32x4 __attribute__((ext_vector_type(4)));
typedef unsigned u32x4 __attribute__((ext_vector_type(4)));
typedef unsigned u32x2 __attribute__((ext_vector_type(2)));

constexpr int D = 1024, NB = 16, SEQ = 4096, LC = 256, TL = NB * SEQ, TC = NB * LC, TT = TL + TC;
constexpr int INC = 4096, NE = 32, DFF = 512, NCH = 34, PMAX = 147456, NT = 512;
constexpr int LDS_BYTES = 150 * 1024, LDS_CTL = LDS_BYTES - 256;
constexpr int C_QA = 0, C_KA = 512, C_VA = 1024, C_QB = 1536, C_KB = 2048, C_VB = 2560, C_GF = 3072, C_GB = 3584;

constexpr size_t al256(size_t x) { return (x + 255) & ~(size_t)255; }
constexpr size_t WS_BAR = 0;
constexpr size_t WS_CNT = 16384;
constexpr size_t WS_ZERO_BYTES = 16384 + 16384;
constexpr size_t WS_MOD = WS_ZERO_BYTES;
constexpr size_t WS_WIN = al256(WS_MOD + (size_t)2 * 17 * 6144 * 4);
constexpr size_t WS_WOUT = WS_WIN + (size_t)2 * 4096 * 1024 * 2;
constexpr size_t WS_WGU = WS_WOUT + (size_t)2 * 1024 * 1024 * 2;
constexpr size_t WS_WDN = WS_WGU + (size_t)32 * 1024 * 1024 * 2;
constexpr size_t WS_CTX = WS_WDN + (size_t)32 * 1024 * 512 * 2;
constexpr size_t WS_H = WS_CTX + (size_t)TC * D * 4;
constexpr size_t WS_PROJ = WS_H + (size_t)TT * D * 2;
constexpr size_t WS_XS = WS_PROJ;
constexpr size_t WS_ACT = WS_PROJ + (size_t)PMAX * D * 2;
constexpr size_t WS_XB = WS_PROJ + (size_t)TT * INC * 2;
constexpr size_t WS_ST = WS_PROJ + (size_t)TT * INC * 2;
constexpr size_t WS_KC = WS_ST;
constexpr size_t WS_VT = WS_KC + (size_t)128 * 4096 * 64 * 2;
constexpr size_t WS_KCC = WS_VT + (size_t)128 * 4096 * 64 * 2;
constexpr size_t WS_VTC = WS_KCC + (size_t)128 * 256 * 64 * 2;
static_assert(WS_VTC + (size_t)128 * 256 * 64 * 2 <= WS_ST + (size_t)NB * 4 * 2 * NCH * 16384 * 2, "NA operand copies fit in the state region");
constexpr size_t WS_TOKE = WS_ST + (size_t)NB * 4 * 2 * NCH * 16384 * 2;
constexpr size_t WS_TOKR = WS_TOKE + (size_t)TT * 2 * 4;
constexpr size_t WS_TOKW = WS_TOKR + (size_t)TT * 2 * 4;
constexpr size_t WS_RINFO = WS_TOKW + (size_t)TT * 2 * 4;
constexpr size_t WS_RW = WS_RINFO + (size_t)PMAX * 4;
constexpr size_t WS_BLKE = WS_RW + (size_t)PMAX * 4;
constexpr size_t WS_RWT = WS_BLKE + 4096;
constexpr size_t WS_BLKB = WS_RWT + (size_t)2 * 32 * 1024 * 2;
constexpr size_t WS_ROPE = WS_BLKB + (size_t)1024 * 32 * 4;
constexpr size_t WS_END = WS_ROPE + (size_t)64 * 32 * 8;
static_assert(WS_ACT + (size_t)PMAX * DFF * 2 <= WS_ST && WS_XB == WS_ST && (size_t)TL * D * 2 <= (size_t)NB * 4 * 2 * NCH * 16384 * 2, "ys | act fit in the proj region, xb in the state region");
static_assert((size_t)TT * 2 * D * 2 <= (size_t)PMAX * D * 2, "y2 fits in xs region");
static_assert(WS_END <= (size_t)1 << 30, "workspace must fit in 1 GiB");

struct Args {
    const float* x; const float* c; const float* ctx; const float* c_ctx; const float* ada_w; const float* ada_b;
    const float* norm_mix_w; const float* norm_ffn_w; const float* w_in; const float* na_q_norm; const float* na_k_norm;
    const float* na_rpb; const float* ret_decay; const float* w_out; const float* router_w; const float* router_bias;
    const float* w_gate; const float* w_up; const float* w_down;
    float* out; unsigned char* ws; int ph_lo, ph_hi;
};

#define LDS_BARRIER() do { asm volatile("s_waitcnt lgkmcnt(0)" ::: "memory"); __builtin_amdgcn_s_barrier(); asm volatile("" ::: "memory"); } while (0)
__device__ __forceinline__ int otid() { int t = threadIdx.x; asm volatile("" : "+v"(t)); return t; }
__device__ __forceinline__ float bf2f(bf16_t v) { return __uint_as_float(((unsigned)v) << 16); }
__device__ __forceinline__ bf16_t f2bf(float f) { unsigned u = __float_as_uint(f); u += 0x7FFFu + ((u >> 16) & 1u); return (bf16_t)(u >> 16); }
typedef float f32x2_t __attribute__((ext_vector_type(2)));
typedef __bf16 bf16x2_t __attribute__((ext_vector_type(2)));
__device__ __forceinline__ unsigned pack2(float lo, float hi) { const f32x2_t v = {lo, hi}; return __builtin_bit_cast(unsigned, __builtin_convertvector(v, bf16x2_t)); }
__device__ __forceinline__ unsigned pack4_fp8(float a, float b, float c, float d) {
    a = __builtin_amdgcn_fmed3f(a, -448.0f, 448.0f); b = __builtin_amdgcn_fmed3f(b, -448.0f, 448.0f); c = __builtin_amdgcn_fmed3f(c, -448.0f, 448.0f); d = __builtin_amdgcn_fmed3f(d, -448.0f, 448.0f);
    int p = __builtin_amdgcn_cvt_pk_fp8_f32(a, b, 0, false); p = __builtin_amdgcn_cvt_pk_fp8_f32(c, d, p, true); return (unsigned)p; }
constexpr float WG8_SCALE = 64.0f, WU8_SCALE = 512.0f, WDN8_SCALE = 32.0f;
constexpr int SC_MOE1 = 0x7c7c7c7c, SC_MOE2 = 0x7b7b7b7b, SC_IN8 = 0x7c7c7c7c;
constexpr float WIN8_SCALE = 64.0f;
constexpr size_t WS_WIN8 = WS_WGU + (size_t)32 * 1024 * 1024;
constexpr unsigned IN_TILES_BF16 = 0xFEDC7610u, IN_TILES_FP8 = 0xBA985432u;
__device__ __forceinline__ bool in_tile_fp8(int pn) { return (0x0F3Cu >> pn) & 1u; }
__device__ __forceinline__ float lo16(unsigned w) { return __uint_as_float(w << 16); }
__device__ __forceinline__ float hi16(unsigned w) { return __uint_as_float(w & 0xffff0000u); }
__device__ __forceinline__ float siluf(float v) { return v * __builtin_amdgcn_rcpf(1.0f + __builtin_amdgcn_exp2f(-1.4426950408889634f * v)); }
__device__ __forceinline__ float wave_sum(float v) {
#pragma unroll
    for (int o = 32; o >= 1; o >>= 1) v += __shfl_xor(v, o);
    return v;
}

typedef short bf16x8 __attribute__((ext_vector_type(8)));
typedef float f32x16 __attribute__((ext_vector_type(16)));
__device__ __forceinline__ unsigned off_b(unsigned row, unsigned ch) { return 256u * row + 16u * (ch ^ (((row & 3) << 2) | ((row >> 2) & 3))); }
__device__ __forceinline__ unsigned tr_addr(unsigned row0, unsigned c, unsigned lane) { const unsigned blk = (lane >> 4) & 1, q = (lane & 15) >> 2, p = lane & 3; return off_b(row0 + q, 4 * c + 2 * blk + (p >> 1)) + 8 * (p & 1); }
__device__ __forceinline__ bf16x8 mkfrag(u32x2 lo, u32x2 hi) { const u32x4 w = {lo.x, lo.y, hi.x, hi.y}; return __builtin_bit_cast(bf16x8, w); }
__device__ __forceinline__ int st_frag_idx(int d, int e) { return (((d >> 5) * 4 + (e >> 5)) * 64 + (e & 31) + 32 * ((d >> 2) & 1)) * 16 + (d & 3) + 4 * ((d & 31) >> 3); }
__device__ __forceinline__ const float* modp(const Args& a, int l, int r, int k6) { return (const float*)(a.ws + WS_MOD) + ((size_t)l * 17 + r) * 6144 + k6 * 1024; }

__device__ __forceinline__ bool cvt_is8(bool with_dense, int t) { return !(with_dense && t < 2560) || (t < 2048 && in_tile_fp8(((t & 63) * 64) >> 8)); }
__device__ __forceinline__ void cvt_addr(const Args& a, bool with_dense, int le, int t, int tid, const float*& lp, bf16_t*& sp) {
    const float* src; bf16_t* dst; int ldn, ldk, k0, n0, nd0;
    if (with_dense && t < 2560) {
        if (t < 2048) { const int l = t >> 10, tt = t & 1023; k0 = (tt >> 6) * 64; n0 = (tt & 63) * 64; nd0 = n0; src = a.w_in + (size_t)l * D * INC; ldn = INC; ldk = D;
            dst = in_tile_fp8(n0 >> 8) ? (bf16_t*)(a.ws + WS_WIN8 + (size_t)l * INC * D) : (bf16_t*)(a.ws + WS_WIN) + (size_t)l * INC * D; }
        else { const int t2 = t - 2048, l = t2 >> 8, tt = t2 & 255; k0 = (tt >> 4) * 64; n0 = (tt & 15) * 64; nd0 = n0; src = a.w_out + (size_t)l * D * D; ldn = D; dst = (bf16_t*)(a.ws + WS_WOUT) + (size_t)l * D * D; ldk = D; }
    } else {
        const int te = with_dense ? t - 2560 : t, which = te >> 12, tt = te & 4095, e = tt >> 7, r = tt & 127;
        if (which < 2) { k0 = (r >> 3) * 64; n0 = (r & 7) * 64; nd0 = (n0 >> 7) * 256 + which * 128 + (n0 & 127); src = (which == 0 ? a.w_gate : a.w_up) + ((size_t)le * NE + e) * D * DFF; ldn = DFF; dst = (bf16_t*)(a.ws + WS_WGU + (size_t)e * 1024 * D); ldk = D; }
        else { k0 = (r >> 4) * 64; n0 = (r & 15) * 64; nd0 = n0; src = a.w_down + ((size_t)le * NE + e) * DFF * D; ldn = D; dst = (bf16_t*)(a.ws + WS_WDN + (size_t)e * 1024 * DFF); ldk = DFF; }
    }
    lp = src + (size_t)(k0 + (tid >> 3)) * ldn + n0 + (tid & 7) * 8;
    const size_t so = (size_t)(nd0 + (tid >> 3)) * ldk + k0 + (tid & 7) * 8;
    sp = cvt_is8(with_dense, t) ? (bf16_t*)((unsigned char*)dst + so) : dst + so;
}
__device__ __forceinline__ void convert_weights(const Args& a, bool with_dense, int le, MLAS unsigned char* lds, int bid, int nb) {
    MLAS float* tl = (MLAS float*)lds; const int tid = otid();
    const int N = (with_dense ? 2560 : 0) + 3 * 4096;
    const float* lp; bf16_t* sp;
    f32x4 v0 = {0.f, 0.f, 0.f, 0.f}, v1 = v0;
    if (bid < N) { cvt_addr(a, with_dense, le, bid, tid, lp, sp); v0 = *(const f32x4*)lp; v1 = *(const f32x4*)(lp + 4); }
    for (int t = bid; t < N; t += nb) {
        cvt_addr(a, with_dense, le, t, tid, lp, sp);
        LDS_BARRIER();
        { const int kk = tid >> 3, nn0 = (tid & 7) * 8;
#pragma unroll
          for (int j = 0; j < 4; ++j) { tl[kk * 65 + nn0 + j] = v0[j]; tl[kk * 65 + nn0 + 4 + j] = v1[j]; } }
        { const int tn = t + nb < N ? t + nb : t; const float* lpn; bf16_t* spn; cvt_addr(a, with_dense, le, tn, tid, lpn, spn); (void)spn; v0 = *(const f32x4*)lpn; v1 = *(const f32x4*)(lpn + 4); }
        LDS_BARRIER();
        { const int n = tid >> 3, kc = (tid & 7) * 8;
          if (!cvt_is8(with_dense, t)) { u32x4 w;
            w.x = pack2(tl[(kc + 0) * 65 + n], tl[(kc + 1) * 65 + n]); w.y = pack2(tl[(kc + 2) * 65 + n], tl[(kc + 3) * 65 + n]);
            w.z = pack2(tl[(kc + 4) * 65 + n], tl[(kc + 5) * 65 + n]); w.w = pack2(tl[(kc + 6) * 65 + n], tl[(kc + 7) * 65 + n]);
            *(u32x4*)sp = w; }
          else { u32x2 w;
            const int wh_ = (with_dense ? t - 2560 : t) >> 12; const float ws = (with_dense && t < 2560) ? WIN8_SCALE : wh_ == 0 ? WG8_SCALE : wh_ == 1 ? WU8_SCALE : WDN8_SCALE;
            w.x = pack4_fp8(ws * tl[(kc + 0) * 65 + n], ws * tl[(kc + 1) * 65 + n], ws * tl[(kc + 2) * 65 + n], ws * tl[(kc + 3) * 65 + n]);
            w.y = pack4_fp8(ws * tl[(kc + 4) * 65 + n], ws * tl[(kc + 5) * 65 + n], ws * tl[(kc + 6) * 65 + n], ws * tl[(kc + 7) * 65 + n]);
            *(u32x2*)sp = w; } }
    }
    __syncthreads();
}
__device__ __forceinline__ void convert_small(const Args& a, int bid, int nb) {
    const int tid = otid();
    if (bid == nb - 2) { float* rt = (float*)(a.ws + WS_ROPE);
        for (int i = tid; i < 64 * 32; i += NT) { const float ang = (float)(i >> 5) * exp2f(-(float)(i & 31) * (13.287712379549449f / 32.0f)); float sn, cs; sincosf(ang, &sn, &cs); rt[2 * i] = cs; rt[2 * i + 1] = sn; } }
    if (bid == nb - 1) { bf16_t* rh = (bf16_t*)(a.ws + WS_RWT); bf16_t* rl = rh + 32 * 1024;
        for (int i = tid; i < 32 * 1024; i += NT) { const int e = i >> 10, k = i & 1023; const float w = a.router_w[k * NE + e]; const bf16_t hi = f2bf(w); rh[i] = hi; rl[i] = f2bf(w - bf2f(hi)); } }
}
__device__ __forceinline__ void compute_mod(const Args& a, MLAS unsigned char* lds, int bid, int nb) {
    MLAS float* sc = (MLAS float*)lds;
    MLAS float* red = (MLAS float*)(lds + 17 * 1024 * 4);
    const int tid = otid();
    if (bid >= 192) return;
    for (int i = tid; i < 17 * 1024; i += NT) { const int r = i >> 10, k = i & 1023; const float v = r < 16 ? a.c[r * 1024 + k] : a.c_ctx[k]; sc[i] = v / (1.0f + expf(-v)); }
    __syncthreads();
    for (int u = bid; u < 192; u += nb) {
        const int l = u / 96, n = (u % 96) * 64 + (tid & 63), kp = tid >> 6;
        float acc[17];
#pragma unroll
        for (int r = 0; r < 17; ++r) acc[r] = 0.f;
        const float* w = a.ada_w + (size_t)l * D * 6144 + n;
        for (int k = kp * 128; k < kp * 128 + 128; ++k) { const float wv = w[(size_t)k * 6144];
#pragma unroll
            for (int r = 0; r < 17; ++r) acc[r] += sc[r * 1024 + k] * wv; }
#pragma unroll
        for (int r = 0; r < 17; ++r) red[(kp * 17 + r) * 64 + (tid & 63)] = acc[r];
        __syncthreads();
        for (int i = tid; i < 17 * 64; i += NT) { const int r = i >> 6, cc = i & 63, nn = (u % 96) * 64 + cc; float s = a.ada_b[l * 6144 + nn];
#pragma unroll
            for (int p = 0; p < 8; ++p) s += red[(p * 17 + r) * 64 + cc];
            ((float*)(a.ws + WS_MOD))[((size_t)l * 17 + r) * 6144 + nn] = s; }
        __syncthreads();
    }
}

__device__ __forceinline__ void load_row_f32(const float* src, int e0, int e1, float (&v)[16]) {
    const f32x4 x0 = *(const f32x4*)(src + e0), x1 = *(const f32x4*)(src + e0 + 4), x2 = *(const f32x4*)(src + e1), x3 = *(const f32x4*)(src + e1 + 4);
#pragma unroll
    for (int j = 0; j < 4; ++j) { v[j] = x0[j]; v[4 + j] = x1[j]; v[8 + j] = x2[j]; v[12 + j] = x3[j]; }
}
__device__ __forceinline__ void load_row_bf16(const bf16_t* src, int e0, int e1, float (&v)[16]) {
    const u32x4 w0 = *(const u32x4*)(src + e0), w1 = *(const u32x4*)(src + e1);
#pragma unroll
    for (int j = 0; j < 4; ++j) { v[2 * j] = lo16(w0[j]); v[2 * j + 1] = hi16(w0[j]); v[8 + 2 * j] = lo16(w1[j]); v[8 + 2 * j + 1] = hi16(w1[j]); }
}
__device__ __forceinline__ void moe_combine(const bf16_t* ys, int2 pp, float2 ww, int i, const float (&mg)[16], int e0, int e1, float (&v)[16]) {
    const int p0 = __builtin_amdgcn_readlane(pp.x, i), p1 = __builtin_amdgcn_readlane(pp.y, i);
    const float w0 = __uint_as_float(__builtin_amdgcn_readlane(__float_as_uint(ww.x), i)), w1 = __uint_as_float(__builtin_amdgcn_readlane(__float_as_uint(ww.y), i));
    const bf16_t* ya = ys + (size_t)p0 * D; const bf16_t* yb = ys + (size_t)p1 * D;
    const u32x4 a0 = *(const u32x4*)(ya + e0), a1 = *(const u32x4*)(ya + e1), b0 = *(const u32x4*)(yb + e0), b1 = *(const u32x4*)(yb + e1);
#pragma unroll
    for (int j = 0; j < 4; ++j) {
        v[2 * j] += mg[2 * j] * (w0 * lo16(a0[j]) + w1 * lo16(b0[j])); v[2 * j + 1] += mg[2 * j + 1] * (w0 * hi16(a0[j]) + w1 * hi16(b0[j]));
        v[8 + 2 * j] += mg[8 + 2 * j] * (w0 * lo16(a1[j]) + w1 * lo16(b1[j])); v[8 + 2 * j + 1] += mg[8 + 2 * j + 1] * (w0 * hi16(a1[j]) + w1 * hi16(b1[j])); }
}
__device__ __forceinline__ unsigned char* h8_of(const Args& a) { return (unsigned char*)a.out + (size_t)TL * D * 2; }
__device__ __forceinline__ void phase_norm1(const Args& a, int l, int bid, int nb) {
    const int tid = otid(), lane = tid & 63, wave = __builtin_amdgcn_readfirstlane(tid >> 6);
    const int e0 = lane * 8, e1 = 512 + lane * 8;
    float wn[16];
    { const float* w = a.norm_mix_w + l * D;
#pragma unroll
      for (int j = 0; j < 8; ++j) { wn[j] = w[e0 + j]; wn[8 + j] = w[e1 + j]; } }
    float msc[16], msh[16], mg[16]; int cur_r = -1;
    bf16_t* hb = (bf16_t*)(a.ws + WS_H);
    const bf16_t* y2 = (const bf16_t*)(a.ws + WS_XS);
    const int rper = (TT + nb * 8 - 1) / (nb * 8), row_lo = (bid * 8 + wave) * rper, row_hi = min(row_lo + rper, TT);
    int2 pp = {0, 0}; float2 ww = {0.f, 0.f};
    if (l > 0 && row_lo + lane < row_hi) { pp = *(const int2*)((const int*)(a.ws + WS_TOKR) + (size_t)(row_lo + lane) * 2); ww = *(const float2*)((const float*)(a.ws + WS_TOKW) + (size_t)(row_lo + lane) * 2); }
    for (int row = row_lo; row < row_hi; ++row) {
        const int r = row < TL ? row / SEQ : 16;
        if (r != cur_r) { cur_r = r; const float* sh = modp(a, l, r, 0); const float* sc = modp(a, l, r, 1);
#pragma unroll
            for (int j = 0; j < 8; ++j) { msh[j] = sh[e0 + j]; msh[8 + j] = sh[e1 + j]; msc[j] = 1.0f + sc[e0 + j]; msc[8 + j] = 1.0f + sc[e1 + j]; }
            if (l > 0) { const float* g = modp(a, l - 1, r, 5);
#pragma unroll
                for (int j = 0; j < 8; ++j) { mg[j] = g[e0 + j]; mg[8 + j] = g[e1 + j]; } } }
        float v[16];
        if (l == 0) load_row_f32(row < TL ? a.x + (size_t)row * D : a.ctx + (size_t)(row - TL) * D, e0, e1, v);
        else if (row < TL) load_row_bf16((const bf16_t*)(a.ws + WS_XB) + (size_t)row * D, e0, e1, v);
        else load_row_f32((const float*)(a.ws + WS_CTX) + (size_t)(row - TL) * D, e0, e1, v);
        if (l > 0) {
            moe_combine(y2, pp, ww, row - row_lo, mg, e0, e1, v);
            if (row < TL) { bf16_t* dst = (bf16_t*)a.out + (size_t)row * D;
                *(u32x4*)(dst + e0) = (u32x4){pack2(v[0], v[1]), pack2(v[2], v[3]), pack2(v[4], v[5]), pack2(v[6], v[7])};
                *(u32x4*)(dst + e1) = (u32x4){pack2(v[8], v[9]), pack2(v[10], v[11]), pack2(v[12], v[13]), pack2(v[14], v[15])}; }
        }
        float ss = 0.f;
#pragma unroll
        for (int j = 0; j < 16; ++j) ss += v[j] * v[j];
        ss = wave_sum(ss);
        const float rs = rsqrtf(ss * (1.0f / D) + 1e-6f);
        float y[16];
#pragma unroll
        for (int j = 0; j < 16; ++j) y[j] = v[j] * rs * wn[j] * msc[j] + msh[j];
        bf16_t* hp = hb + (size_t)row * D;
        *(u32x4*)(hp + e0) = (u32x4){pack2(y[0], y[1]), pack2(y[2], y[3]), pack2(y[4], y[5]), pack2(y[6], y[7])};
        *(u32x4*)(hp + e1) = (u32x4){pack2(y[8], y[9]), pack2(y[10], y[11]), pack2(y[12], y[13]), pack2(y[14], y[15])};
        unsigned char* hp8 = h8_of(a) + (size_t)row * D;
        *(u32x2*)(hp8 + e0) = (u32x2){pack4_fp8(y[0], y[1], y[2], y[3]), pack4_fp8(y[4], y[5], y[6], y[7])};
        *(u32x2*)(hp8 + e1) = (u32x2){pack4_fp8(y[8], y[9], y[10], y[11]), pack4_fp8(y[12], y[13], y[14], y[15])};
    }
}
__device__ __forceinline__ void phase_final(const Args& a, int bid, int nb) {
    const int tid = otid(), lane = tid & 63, wave = __builtin_amdgcn_readfirstlane(tid >> 6);
    const int e0 = lane * 8, e1 = 512 + lane * 8;
    float mg[16]; int cur_r = -1;
    const bf16_t* y2 = (const bf16_t*)(a.ws + WS_XS);
    const int rper = (TL + nb * 8 - 1) / (nb * 8), row_lo = (bid * 8 + wave) * rper, row_hi = min(row_lo + rper, TL);
    int2 pp = {0, 0}; float2 ww = {0.f, 0.f};
    if (row_lo + lane < row_hi) { pp = *(const int2*)((const int*)(a.ws + WS_TOKR) + (size_t)(row_lo + lane) * 2); ww = *(const float2*)((const float*)(a.ws + WS_TOKW) + (size_t)(row_lo + lane) * 2); }
    for (int row = row_lo; row < row_hi; ++row) {
        const int r = row / SEQ;
        if (r != cur_r) { cur_r = r; const float* g = modp(a, 1, r, 5);
#pragma unroll
            for (int j = 0; j < 8; ++j) { mg[j] = g[e0 + j]; mg[8 + j] = g[e1 + j]; } }
        float* src = a.out + (size_t)row * D;
        float v[16];
        load_row_bf16((const bf16_t*)(a.ws + WS_XB) + (size_t)row * D, e0, e1, v);
        moe_combine(y2, pp, ww, row - row_lo, mg, e0, e1, v);
        *(f32x4*)(src + e0) = (f32x4){v[0], v[1], v[2], v[3]}; *(f32x4*)(src + e0 + 4) = (f32x4){v[4], v[5], v[6], v[7]};
        *(f32x4*)(src + e1) = (f32x4){v[8], v[9], v[10], v[11]}; *(f32x4*)(src + e1 + 4) = (f32x4){v[12], v[13], v[14], v[15]};
    }
}

constexpr int VP = 516;
__device__ __forceinline__ void phase_prep(const Args& a, int l, MLAS unsigned char* lds, int bid, int nb) {
    const int tid = otid(), lane = tid & 63, wave = tid >> 6;
    const bf16_t* proj = (const bf16_t*)(a.ws + WS_PROJ);
    MLAS bf16_t* Vs = (MLAS bf16_t*)lds;
    float wk[8];
    { const float* w = a.na_k_norm + l * 64 + (lane & 7) * 8;
#pragma unroll
      for (int j = 0; j < 8; ++j) wk[j] = w[j]; }
    for (int u = bid; u < TT / 64; u += nb) {
        const int R0 = u * 64; const bool lat = R0 < TL;
        const int b = lat ? R0 / SEQ : (R0 - TL) / LC, t0 = lat ? R0 % SEQ : (R0 - TL) % LC, tlen = lat ? SEQ : LC;
        bf16_t* kc = (bf16_t*)(a.ws + (lat ? WS_KC : WS_KCC)); bf16_t* vt = (bf16_t*)(a.ws + (lat ? WS_VT : WS_VTC));
        __syncthreads();
#pragma unroll
        for (int rr = 0; rr < 8; ++rr) {
            const int rl = wave * 8 + rr, row = R0 + rl, t = t0 + rl;
            const bf16_t* p = proj + (size_t)row * INC;
            const u32x4 kw = *(const u32x4*)(p + C_KA + lane * 8), vw = *(const u32x4*)(p + C_VA + lane * 8);
            float f[8];
#pragma unroll
            for (int j = 0; j < 4; ++j) { f[2 * j] = lo16(kw[j]); f[2 * j + 1] = hi16(kw[j]); }
            float ss = 0.f;
#pragma unroll
            for (int j = 0; j < 8; ++j) ss += f[j] * f[j];
            ss += __shfl_xor(ss, 1); ss += __shfl_xor(ss, 2); ss += __shfl_xor(ss, 4);
            const float rs = rsqrtf(ss * (1.0f / 64.0f) + 1e-6f);
            *(u32x4*)(kc + (((size_t)b * 8 + (lane >> 3)) * tlen + t) * 64 + (lane & 7) * 8) =
                (u32x4){pack2(f[0] * rs * wk[0], f[1] * rs * wk[1]), pack2(f[2] * rs * wk[2], f[3] * rs * wk[3]), pack2(f[4] * rs * wk[4], f[5] * rs * wk[5]), pack2(f[6] * rs * wk[6], f[7] * rs * wk[7])};
            *(MLAS u32x2*)(Vs + rl * VP + lane * 8) = (u32x2){vw.x, vw.y}; *(MLAS u32x2*)(Vs + rl * VP + lane * 8 + 4) = (u32x2){vw.z, vw.w};
        }
        __syncthreads();
#pragma unroll
        for (int i = 0; i < 8; ++i) { const int idx = tid + i * NT, d = idx & 63, tc = (idx >> 6) & 7, h = idx >> 9;
            const MLAS bf16_t* vp = Vs + (tc * 8) * VP + h * 64 + d;
            const u32x4 w = {(unsigned)vp[0] | ((unsigned)vp[VP] << 16), (unsigned)vp[2 * VP] | ((unsigned)vp[3 * VP] << 16), (unsigned)vp[4 * VP] | ((unsigned)vp[5 * VP] << 16), (unsigned)vp[6 * VP] | ((unsigned)vp[7 * VP] << 16)};
            const int tk = t0 + tc * 8;
            *(u32x4*)(vt + ((((size_t)b * 8 + h) * (tlen >> 4) + (tk >> 4)) * 64 + d) * 16 + (tk & 15)) = w; }
    }
}

__device__ __forceinline__ int chunk_row0(int b, int c) { return c < 2 ? TL + b * LC + c * 128 : b * SEQ + (c - 2) * 128; }
__device__ __forceinline__ size_t st_index(int b, int h, int dir, int c) { return ((((size_t)b * 4 + h) * 2 + dir) * NCH + c) * 16384; }
constexpr int RP = 136;
__device__ __forceinline__ void load_rope_pair(const bf16_t* p, int a2, int fc, int tok, const MLAS float* rope, float (&y1)[8], float (&y2)[8]) {
    const u32x4 w0 = *(const u32x4*)(p + (a2 * 8 + fc) * 8), w1 = *(const u32x4*)(p + (a2 * 8 + fc + 4) * 8);
#pragma unroll
    for (int j = 0; j < 4; ++j) { y1[2 * j] = lo16(w0[j]); y1[2 * j + 1] = hi16(w0[j]); y2[2 * j] = lo16(w1[j]); y2[2 * j + 1] = hi16(w1[j]); }
    if (tok >= 0) {
        const int pos = a2 == 0 ? (tok >> 6) : (tok & 63);
        const MLAS f32x4* tp = (const MLAS f32x4*)(rope + (pos * 32 + fc * 8) * 2);
#pragma unroll
        for (int q = 0; q < 4; ++q) { const f32x4 cs = tp[q];
            const float u0 = y1[2 * q] * cs[0] - y2[2 * q] * cs[1], v0 = y1[2 * q] * cs[1] + y2[2 * q] * cs[0];
            const float u1 = y1[2 * q + 1] * cs[2] - y2[2 * q + 1] * cs[3], v1 = y1[2 * q + 1] * cs[3] + y2[2 * q + 1] * cs[2];
            y1[2 * q] = u0; y2[2 * q] = v0; y1[2 * q + 1] = u1; y2[2 * q + 1] = v1; }
    }
}
__device__ __forceinline__ void rope_pair_regs(const u32x4 w0, const u32x4 w1, int a2, int fc, int tok, const MLAS float* rope, float (&y1)[8], float (&y2)[8]) {
#pragma unroll
    for (int j = 0; j < 4; ++j) { y1[2 * j] = lo16(w0[j]); y1[2 * j + 1] = hi16(w0[j]); y2[2 * j] = lo16(w1[j]); y2[2 * j + 1] = hi16(w1[j]); }
    if (tok >= 0) {
        const int pos = a2 == 0 ? (tok >> 6) : (tok & 63);
        const MLAS f32x4* tp = (const MLAS f32x4*)(rope + (pos * 32 + fc * 8) * 2);
#pragma unroll
        for (int q = 0; q < 4; ++q) { const f32x4 cs = tp[q];
            const float u0 = y1[2 * q] * cs[0] - y2[2 * q] * cs[1], v0 = y1[2 * q] * cs[1] + y2[2 * q] * cs[0];
            const float u1 = y1[2 * q + 1] * cs[2] - y2[2 * q + 1] * cs[3], v1 = y1[2 * q + 1] * cs[3] + y2[2 * q + 1] * cs[2];
            y1[2 * q] = u0; y2[2 * q] = v0; y1[2 * q + 1] = u1; y2[2 * q + 1] = v1; }
    }
}
__device__ __forceinline__ u32x4 pack8(const float (&y)[8], float sc) { return (u32x4){pack2(y[0] * sc, y[1] * sc), pack2(y[2] * sc, y[3] * sc), pack2(y[4] * sc, y[5] * sc), pack2(y[6] * sc, y[7] * sc)}; }
constexpr float RET_KSCALE = 0.08838834764831845f;
constexpr int LDS_ROPE = 98304;
__device__ __forceinline__ void phase_ret_a(const Args& a, int l, MLAS unsigned char* lds, int bid, int nb) {
    const int tid = otid(), lane = tid & 63, wave = __builtin_amdgcn_readfirstlane(tid >> 6);
    const bf16_t* proj = (const bf16_t*)(a.ws + WS_PROJ); bf16_t* st = (bf16_t*)(a.ws + WS_ST);
    const unsigned ldsb = (unsigned)(size_t)lds;
    const int dir = wave >> 2, dt = wave & 3, hh = lane >> 5;
    MLAS float* rope = (MLAS float*)(lds + LDS_ROPE);
    for (int i = tid; i < 64 * 32 * 2; i += NT) rope[i] = ((const float*)(a.ws + WS_ROPE))[i];
#define RA_LOAD(u_) do { const int b_ = (u_) / (NCH * 4), c_ = ((u_) >> 2) % NCH, h_ = (u_) & 3, row0_ = chunk_row0(b_, c_); _Pragma("unroll") for (int i = 0; i < 2; ++i) { const int idx = tid + i * NT, row = idx >> 3, ch0 = ((idx >> 2) & 1) * 8 + (idx & 3); \
        const bf16_t* src = proj + (size_t)(row0_ + row) * INC + h_ * 128; \
        raw[i][0] = *(const u32x4*)(src + C_KB + ch0 * 8); raw[i][1] = *(const u32x4*)(src + C_KB + (ch0 + 4) * 8); raw[i][2] = *(const u32x4*)(src + C_VB + ch0 * 8); raw[i][3] = *(const u32x4*)(src + C_VB + (ch0 + 4) * 8); } } while (0)
    u32x4 raw[2][4];
    if (bid < NB * NCH * 4) RA_LOAD(bid);
    LDS_BARRIER();
    for (int u = bid; u < NB * NCH * 4; u += nb) {
        const int b = u / (NCH * 4), c = (u >> 2) % NCH, h = u & 3;
        const float lgf = -expf(a.ret_decay[l * 8 + h]), lgb = -expf(a.ret_decay[l * 8 + 4 + h]);
        LDS_BARRIER();
#pragma unroll
        for (int i = 0; i < 2; ++i) { const int idx = tid + i * NT, row = idx >> 3, a2 = (idx >> 2) & 1, fc = idx & 3, ch0 = a2 * 8 + fc;
            float y1[8], y2[8];
            rope_pair_regs(raw[i][0], raw[i][1], a2, fc, c >= 2 ? (c - 2) * 128 + row : -1, rope, y1, y2);
            const float wf = __expf((float)(127 - row) * lgf) * RET_KSCALE, wb = __expf((float)row * lgb) * RET_KSCALE;
            const unsigned o0 = off_b(row, ch0), o1 = off_b(row, ch0 + 4);
            *(MLAS u32x4*)(lds + o0) = pack8(y1, wf); *(MLAS u32x4*)(lds + o1) = pack8(y2, wf);
            *(MLAS u32x4*)(lds + 32768 + o0) = pack8(y1, wb); *(MLAS u32x4*)(lds + 32768 + o1) = pack8(y2, wb);
            *(MLAS u32x4*)(lds + 65536 + o0) = raw[i][2]; *(MLAS u32x4*)(lds + 65536 + o1) = raw[i][3]; }
        { const int un_ = u + nb < NB * NCH * 4 ? u + nb : u; RA_LOAD(un_); }
        LDS_BARRIER();
        f32x16 acc[4];
#pragma unroll
        for (int et = 0; et < 4; ++et)
#pragma unroll
            for (int r = 0; r < 16; ++r) acc[et][r] = 0.f;
        unsigned aK[2], aV[4][2];
#pragma unroll
        for (int t = 0; t < 2; ++t) { aK[t] = ldsb + dir * 32768 + tr_addr(8 * hh + 4 * t, dt, lane);
#pragma unroll
            for (int et = 0; et < 4; ++et) aV[et][t] = ldsb + 65536 + tr_addr(8 * hh + 4 * t, et, lane); }
#pragma unroll
        for (int ks = 0; ks < 8; ++ks) {
            u32x2 r0, r1, r2, r3, r4, r5, r6, r7, r8, r9; const unsigned ko = ks * 4096;
            asm volatile("ds_read_b64_tr_b16 %0, %10\n\tds_read_b64_tr_b16 %1, %11\n\tds_read_b64_tr_b16 %2, %12\n\tds_read_b64_tr_b16 %3, %13\n\tds_read_b64_tr_b16 %4, %14\n\t"
                         "ds_read_b64_tr_b16 %5, %15\n\tds_read_b64_tr_b16 %6, %16\n\tds_read_b64_tr_b16 %7, %17\n\tds_read_b64_tr_b16 %8, %18\n\tds_read_b64_tr_b16 %9, %19\n\ts_waitcnt lgkmcnt(0)"
                         : "=&v"(r0), "=&v"(r1), "=&v"(r2), "=&v"(r3), "=&v"(r4), "=&v"(r5), "=&v"(r6), "=&v"(r7), "=&v"(r8), "=&v"(r9)
                         : "v"(aK[0] + ko), "v"(aK[1] + ko), "v"(aV[0][0] + ko), "v"(aV[0][1] + ko), "v"(aV[1][0] + ko), "v"(aV[1][1] + ko), "v"(aV[2][0] + ko), "v"(aV[2][1] + ko), "v"(aV[3][0] + ko), "v"(aV[3][1] + ko) : "memory");
            const bf16x8 A = mkfrag(r0, r1);
            acc[0] = __builtin_amdgcn_mfma_f32_32x32x16_bf16(A, mkfrag(r2, r3), acc[0], 0, 0, 0);
            acc[1] = __builtin_amdgcn_mfma_f32_32x32x16_bf16(A, mkfrag(r4, r5), acc[1], 0, 0, 0);
            acc[2] = __builtin_amdgcn_mfma_f32_32x32x16_bf16(A, mkfrag(r6, r7), acc[2], 0, 0, 0);
            acc[3] = __builtin_amdgcn_mfma_f32_32x32x16_bf16(A, mkfrag(r8, r9), acc[3], 0, 0, 0);
        }
        bf16_t* o = st + st_index(b, h, dir, c);
#pragma unroll
        for (int et = 0; et < 4; ++et) { bf16_t* p = o + ((dt * 4 + et) * 64 + lane) * 16;
            *(u32x4*)p = (u32x4){pack2(acc[et][0], acc[et][1]), pack2(acc[et][2], acc[et][3]), pack2(acc[et][4], acc[et][5]), pack2(acc[et][6], acc[et][7])};
            *(u32x4*)(p + 8) = (u32x4){pack2(acc[et][8], acc[et][9]), pack2(acc[et][10], acc[et][11]), pack2(acc[et][12], acc[et][13]), pack2(acc[et][14], acc[et][15])}; }
    }
#undef RA_LOAD
}
__device__ __forceinline__ void phase_scan(const Args& a, int l, int bid, int nb) {
    bf16_t* st = (bf16_t*)(a.ws + WS_ST);
#pragma unroll 1
    for (int idx = bid * NT + otid(); idx < NB * 4 * 2 * 2048; idx += nb * NT) {
        const int chain = idx >> 11, v8 = idx & 2047, dir = chain & 1, h = (chain >> 1) & 3;
        const float dec = expf(-128.0f * expf(a.ret_decay[l * 8 + dir * 4 + h]));
        bf16_t* p = st + (size_t)chain * NCH * 16384 + v8 * 8;
        float S[8];
#pragma unroll
        for (int j = 0; j < 8; ++j) S[j] = 0.f;
#pragma unroll 1
        for (int half = 0; half < 2; ++half) {
            u32x4 ls[NCH / 2];
#pragma unroll
            for (int i = 0; i < NCH / 2; ++i) { const int ii = half * (NCH / 2) + i, c = dir == 0 ? ii : (ii < 2 ? 1 - ii : NCH + 1 - ii); ls[i] = *(const u32x4*)(p + (size_t)c * 16384); }
#pragma unroll
            for (int i = 0; i < NCH / 2; ++i) { const int ii = half * (NCH / 2) + i, c = dir == 0 ? ii : (ii < 2 ? 1 - ii : NCH + 1 - ii);
                *(u32x4*)(p + (size_t)c * 16384) = (u32x4){pack2(S[0], S[1]), pack2(S[2], S[3]), pack2(S[4], S[5]), pack2(S[6], S[7])};
#pragma unroll
                for (int t = 0; t < 4; ++t) { S[2 * t] = S[2 * t] * dec + lo16(ls[i][t]); S[2 * t + 1] = S[2 * t + 1] * dec + hi16(ls[i][t]); } }
        }
    }
}
__device__ __forceinline__ void phase_ret_b(const Args& a, int l, MLAS unsigned char* lds, int bid, int nb) {
    const int tid = otid(), lane = tid & 63, wave = __builtin_amdgcn_readfirstlane(tid >> 6);
    const bf16_t* proj = (const bf16_t*)(a.ws + WS_PROJ); const bf16_t* st = (const bf16_t*)(a.ws + WS_ST); bf16_t* mix = (bf16_t*)(a.ws + WS_H);
    const unsigned ldsb = (unsigned)(size_t)lds;
    const int dir = wave >> 2, it = wave & 3, hh = lane >> 5, il = it * 32 + (lane & 31);
    const int c_lo = l == 0 ? 0 : 2, ncu = NCH - c_lo;
    MLAS float* rope = (MLAS float*)(lds + LDS_ROPE);
    for (int i = tid; i < 64 * 32 * 2; i += NT) rope[i] = ((const float*)(a.ws + WS_ROPE))[i];
#define RB_DECODE(u_, b_, c_, h_, row0_) const int b_ = (u_) / (ncu * 4), c_ = c_lo + ((u_) >> 2) % ncu, h_ = (u_) & 3, row0_ = chunk_row0(b_, c_)
#define RB_LOAD(u_) do { RB_DECODE(u_, b_, c_, h_, row0_); (void)c_; _Pragma("unroll") for (int i = 0; i < 2; ++i) { const int idx = tid + i * NT, row = idx >> 3, ch0 = ((idx >> 2) & 1) * 8 + (idx & 3); \
        const bf16_t* src = proj + (size_t)(row0_ + row) * INC + h_ * 128; \
        raw[i][0] = *(const u32x4*)(src + C_QB + ch0 * 8); raw[i][1] = *(const u32x4*)(src + C_QB + (ch0 + 4) * 8); raw[i][2] = *(const u32x4*)(src + C_KB + ch0 * 8); raw[i][3] = *(const u32x4*)(src + C_KB + (ch0 + 4) * 8); \
        raw[i][4] = *(const u32x4*)(src + C_VB + ch0 * 8); raw[i][5] = *(const u32x4*)(src + C_VB + (ch0 + 4) * 8); } } while (0)
    u32x4 raw[2][6];
    if (bid < NB * ncu * 4) RB_LOAD(bid);
    LDS_BARRIER();
    for (int u = bid; u < NB * ncu * 4; u += nb) {
        RB_DECODE(u, b, c, h, row0);
        const float lg = -expf(a.ret_decay[l * 8 + dir * 4 + h]);
        LDS_BARRIER();
#pragma unroll
        for (int i = 0; i < 2; ++i) { const int idx = tid + i * NT, row = idx >> 3, a2 = (idx >> 2) & 1, fc = idx & 3, ch0 = a2 * 8 + fc;
            const int tok = c >= 2 ? (c - 2) * 128 + row : -1;
            const unsigned o0 = off_b(row, ch0), o1 = off_b(row, ch0 + 4);
            float y1[8], y2[8];
            rope_pair_regs(raw[i][0], raw[i][1], a2, fc, tok, rope, y1, y2);
            *(MLAS u32x4*)(lds + o0) = pack8(y1, 1.0f); *(MLAS u32x4*)(lds + o1) = pack8(y2, 1.0f);
            rope_pair_regs(raw[i][2], raw[i][3], a2, fc, tok, rope, y1, y2);
            *(MLAS u32x4*)(lds + 32768 + o0) = pack8(y1, RET_KSCALE); *(MLAS u32x4*)(lds + 32768 + o1) = pack8(y2, RET_KSCALE);
            *(MLAS u32x4*)(lds + 65536 + o0) = raw[i][4]; *(MLAS u32x4*)(lds + 65536 + o1) = raw[i][5]; }
        LDS_BARRIER();
        f32x16 acc[4];
#pragma unroll
        for (int et = 0; et < 4; ++et)
#pragma unroll
            for (int r = 0; r < 16; ++r) acc[et][r] = 0.f;
        {
            const bf16_t* sp = st + st_index(b, h, dir, c) + lane * 16;
#pragma unroll
            for (int dt = 0; dt < 4; ++dt)
#pragma unroll
                for (int s2 = 0; s2 < 2; ++s2) {
                    const u32x2 q0 = *(const MLAS u32x2*)(lds + off_b(il, 4 * dt + 2 * s2) + 8 * hh), q1 = *(const MLAS u32x2*)(lds + off_b(il, 4 * dt + 2 * s2 + 1) + 8 * hh);
                    const bf16x8 Bq = mkfrag(q0, q1);
#pragma unroll
                    for (int et = 0; et < 4; ++et) { const bf16x8 A = __builtin_bit_cast(bf16x8, *(const u32x4*)(sp + (dt * 4 + et) * 1024 + 8 * s2));
                        acc[et] = __builtin_amdgcn_mfma_f32_32x32x16_bf16(A, Bq, acc[et], 0, 0, 0); }
                }
            const float qdec = __expf((float)(dir == 0 ? il + 1 : 128 - il) * lg);
#pragma unroll
            for (int et = 0; et < 4; ++et)
#pragma unroll
                for (int r = 0; r < 16; ++r) acc[et][r] *= qdec;
        }
        bf16x8 Qn[8];
#pragma unroll
        for (int ks = 0; ks < 8; ++ks) Qn[ks] = *(const MLAS bf16x8*)(lds + off_b(il, 2 * ks + hh));
        const int jt_lo = dir == 0 ? 0 : it, jt_hi = dir == 0 ? it : 3;
        for (int jt = jt_lo; jt <= jt_hi; ++jt) {
            f32x16 sc;
#pragma unroll
            for (int r = 0; r < 16; ++r) sc[r] = 0.f;
#pragma unroll
            for (int ks = 0; ks < 8; ++ks) { const bf16x8 A = *(const MLAS bf16x8*)(lds + 32768 + off_b(jt * 32 + (lane & 31), 2 * ks + hh));
                sc = __builtin_amdgcn_mfma_f32_32x32x16_bf16(A, Qn[ks], sc, 0, 0, 0); }
            unsigned pk[8];
#pragma unroll
            for (int r = 0; r < 16; r += 2) {
                const int j0 = jt * 32 + (r & 3) + 8 * (r >> 2) + 4 * hh, j1 = j0 + 1;
                const int d0 = dir == 0 ? il - j0 : j0 - il, d1 = dir == 0 ? il - j1 : j1 - il;
                const float p0 = d0 >= 0 ? sc[r] * __expf((float)d0 * lg) : 0.f, p1 = d1 >= 0 ? sc[r + 1] * __expf((float)d1 * lg) : 0.f;
                pk[r >> 1] = pack2(p0, p1);
            }
            const bf16x8 P0 = __builtin_bit_cast(bf16x8, (u32x4){pk[0], pk[1], pk[2], pk[3]}), P1 = __builtin_bit_cast(bf16x8, (u32x4){pk[4], pk[5], pk[6], pk[7]});
#pragma unroll
            for (int et = 0; et < 4; ++et) {
                u32x2 r0, r1, r2, r3;
                const unsigned a0 = ldsb + 65536 + tr_addr(jt * 32 + 4 * hh, et, lane), a1 = ldsb + 65536 + tr_addr(jt * 32 + 8 + 4 * hh, et, lane);
                const unsigned a2 = ldsb + 65536 + tr_addr(jt * 32 + 16 + 4 * hh, et, lane), a3 = ldsb + 65536 + tr_addr(jt * 32 + 24 + 4 * hh, et, lane);
                asm volatile("ds_read_b64_tr_b16 %0, %4\n\tds_read_b64_tr_b16 %1, %5\n\tds_read_b64_tr_b16 %2, %6\n\tds_read_b64_tr_b16 %3, %7\n\ts_waitcnt lgkmcnt(0)"
                             : "=&v"(r0), "=&v"(r1), "=&v"(r2), "=&v"(r3) : "v"(a0), "v"(a1), "v"(a2), "v"(a3) : "memory");
                acc[et] = __builtin_amdgcn_mfma_f32_32x32x16_bf16(mkfrag(r0, r1), P0, acc[et], 0, 0, 0);
                acc[et] = __builtin_amdgcn_mfma_f32_32x32x16_bf16(mkfrag(r2, r3), P1, acc[et], 0, 0, 0);
            }
        }
        u32x4 gfr[4], gbr[4];
        { const bf16_t* gp = proj + (size_t)(row0 + (tid >> 2)) * INC + h * 128;
#pragma unroll
          for (int k = 0; k < 4; ++k) { const int ch = (tid & 3) * 4 + k; gfr[k] = *(const u32x4*)(gp + C_GF + ch * 8); gbr[k] = *(const u32x4*)(gp + C_GB + ch * 8); } }
        float s1 = 0.f;
#pragma unroll
        for (int et = 0; et < 4; ++et)
#pragma unroll
            for (int r = 0; r < 16; ++r) s1 += acc[et][r];
        s1 += __shfl_xor(s1, 32);
        const float mean = s1 * (1.0f / 128.0f);
        float s2 = 0.f;
#pragma unroll
        for (int et = 0; et < 4; ++et)
#pragma unroll
            for (int r = 0; r < 16; ++r) { const float dlt = acc[et][r] - mean; s2 += dlt * dlt; }
        s2 += __shfl_xor(s2, 32);
        const float rstd = rsqrtf(s2 * (1.0f / 128.0f) + 1e-5f);
        LDS_BARRIER();
#pragma unroll
        for (int et = 0; et < 4; ++et)
#pragma unroll
            for (int g = 0; g < 4; ++g) {
                const u32x2 w = {pack2((acc[et][4 * g] - mean) * rstd, (acc[et][4 * g + 1] - mean) * rstd), pack2((acc[et][4 * g + 2] - mean) * rstd, (acc[et][4 * g + 3] - mean) * rstd)};
                *(MLAS u32x2*)(lds + dir * 32768 + off_b(il, 4 * et + g) + 8 * hh) = w; }
        { const int un_ = u + nb < NB * ncu * 4 ? u + nb : u; RB_LOAD(un_); }
        LDS_BARRIER();
        {
            const int i = tid >> 2, part = tid & 3;
            bf16_t* op = mix + (size_t)(row0 + i) * D + 512 + h * 128;
#pragma unroll
            for (int k = 0; k < 4; ++k) { const int ch = part * 4 + k;
                const u32x4 of = *(const MLAS u32x4*)(lds + off_b(i, ch)), ob = *(const MLAS u32x4*)(lds + 32768 + off_b(i, ch));
                const u32x4 gf = gfr[k], gb = gbr[k];
                u32x4 o;
#pragma unroll
                for (int t = 0; t < 4; ++t) o[t] = pack2(lo16(of[t]) * siluf(lo16(gf[t])) + lo16(ob[t]) * siluf(lo16(gb[t])), hi16(of[t]) * siluf(hi16(gf[t])) + hi16(ob[t]) * siluf(hi16(gb[t])));
                *(u32x4*)(op + ch * 8) = o; }
        }
    }
#undef RB_DECODE
#undef RB_LOAD
}

constexpr int NA_OP = 72;
__device__ __forceinline__ int perm16(int x) { return (x & 3) | ((x & 4) << 1) | ((x & 8) >> 1); }
__device__ __forceinline__ void phase_na(const Args& a, int l, MLAS unsigned char* lds, int bid, int nb) {
    const int tid = otid(), lane = tid & 63, wave = __builtin_amdgcn_readfirstlane(tid >> 6);
    const bf16_t* proj = (const bf16_t*)(a.ws + WS_PROJ); bf16_t* mix = (bf16_t*)(a.ws + WS_H);
    const bf16_t* KC = (const bf16_t*)(a.ws + WS_KC); const bf16_t* VT = (const bf16_t*)(a.ws + WS_VT);
    const bf16_t* KCC = (const bf16_t*)(a.ws + WS_KCC); const bf16_t* VTC = (const bf16_t*)(a.ws + WS_VTC);
    MLAS float* rpb = (MLAS float*)lds;
    MLAS bf16_t* ost = (MLAS bf16_t*)(lds + 8192) + wave * 64 * NA_OP;
    const int n_lat = NB * 8 * 8, n_ctx = l == 0 ? NB * 4 : 0;
    const int hh = lane >> 5, ql = lane & 31;
    for (int u0 = bid; u0 < n_lat + n_ctx; u0 += nb) {
        int u = u0;
        if (nb == 256 && u0 < n_lat) { const int x = bid & 7, j = bid >> 3, i = u0 >> 8; u = ((i * 32 + x * 4 + (j >> 3)) << 3) + (j & 7); }
        const bool is_ctx = u >= n_lat;
        const int v = is_ctx ? u - n_lat : u;
        const int b = is_ctx ? v >> 2 : v >> 6, h = is_ctx ? 2 * (v & 3) + (wave >> 2) : (v >> 3) & 7;
        const int r = (v & 7) * 8 + wave;
        const int qrow0 = is_ctx ? TL + b * LC + (wave & 3) * 64 : b * SEQ + r * 64;
        const size_t bh = (size_t)b * 8 + h;
        __syncthreads();
        if (!is_ctx) for (int i = tid; i < 15 * 128; i += NT) { const int dr = i >> 7, x = (i & 127) - 48; rpb[i] = (x >= 0 && x < 31) ? a.na_rpb[((size_t)l * 8 + h) * 465 + dr * 31 + x] * 1.4426950408889634f : 0.f; }
        __syncthreads();
        bf16x8 Qf[2][4];
#pragma unroll
        for (int qt = 0; qt < 2; ++qt) {
            u32x4 qw[4]; float ss = 0.f;
#pragma unroll
            for (int ks = 0; ks < 4; ++ks) { qw[ks] = *(const u32x4*)(proj + (size_t)(qrow0 + 32 * qt + ql) * INC + C_QA + h * 64 + 16 * ks + 8 * hh);
#pragma unroll
                for (int t = 0; t < 4; ++t) { const float x0 = lo16(qw[ks][t]), x1 = hi16(qw[ks][t]); ss += x0 * x0 + x1 * x1; } }
            ss += __shfl_xor(ss, 32);
            const float rs = rsqrtf(ss * (1.0f / 64.0f) + 1e-6f) * 0.18033688011112042f;
#pragma unroll
            for (int ks = 0; ks < 4; ++ks) { const f32x4 w0 = *(const f32x4*)(a.na_q_norm + l * 64 + 16 * ks + 8 * hh), w1 = *(const f32x4*)(a.na_q_norm + l * 64 + 16 * ks + 8 * hh + 4);
                const u32x4 o = {pack2(lo16(qw[ks][0]) * rs * w0[0], hi16(qw[ks][0]) * rs * w0[1]), pack2(lo16(qw[ks][1]) * rs * w0[2], hi16(qw[ks][1]) * rs * w0[3]),
                                 pack2(lo16(qw[ks][2]) * rs * w1[0], hi16(qw[ks][2]) * rs * w1[1]), pack2(lo16(qw[ks][3]) * rs * w1[2], hi16(qw[ks][3]) * rs * w1[3])};
                Qf[qt][ks] = __builtin_bit_cast(bf16x8, o); }
        }
        f32x16 O[2][2];
#pragma unroll
        for (int qt = 0; qt < 2; ++qt)
#pragma unroll
            for (int i = 0; i < 16; ++i) { O[qt][0][i] = 0.f; O[qt][1][i] = 0.f; }
        float lsum[2] = {0.f, 0.f};
        const int r0 = min(max(r - 4, 0), 56);
        const int kslot = 16 * (ql >> 4) + perm16(ql & 15);
        const bf16_t* kl = KC + (bh * SEQ + (size_t)(r0 + (ql >> 4)) * 64 + perm16(ql & 15)) * 64 + 8 * hh;
        const bf16_t* vl = VT + ((bh * 256 + (size_t)r0 * 4) * 64 + ql) * 16 + 8 * hh;
        const bf16_t* kx = KCC + (bh * LC + kslot) * 64 + 8 * hh;
        const bf16_t* vx = VTC + ((bh * 16) * 64 + ql) * 16 + 8 * hh;
#define NA_PTRS(t, kp, vp, vstep) do { if ((t) < 16) { const int ip_ = (t) >> 2, ct_ = (t) & 3; kp = kl + (size_t)(2 * ip_ * 64 + 16 * ct_) * 64; vp = vl + (2 * ip_ * 4 + ct_) * 1024; vstep = 4096; } \
        else { kp = kx + (size_t)(32 * ((t) - 16)) * 64; vp = vx + ((t) - 16) * 2048; vstep = 1024; } } while (0)
#define NA_LOADS(kp, vp, vstep, Kd, Vd) do { _Pragma("unroll") for (int ks_ = 0; ks_ < 4; ++ks_) Kd[ks_] = *(const u32x4*)(kp + 16 * ks_); \
        Vd[0] = *(const u32x4*)(vp); Vd[1] = *(const u32x4*)(vp + vstep); Vd[2] = *(const u32x4*)(vp + 512); Vd[3] = *(const u32x4*)(vp + 512 + vstep); } while (0)
        const int t_lo = is_ctx ? 16 : 0;
        u32x4 Kn[4], Vn[4];
        { const bf16_t* kp; const bf16_t* vp; int vstep; NA_PTRS(t_lo, kp, vp, vstep); NA_LOADS(kp, vp, vstep, Kn, Vn); }
#pragma unroll 1
        for (int t = t_lo; t < 24; ++t) {
            u32x4 Kc[4], Vc[4];
#pragma unroll
            for (int i = 0; i < 4; ++i) { Kc[i] = Kn[i]; Vc[i] = Vn[i]; }
            if (t + 1 < 24) { const bf16_t* kp; const bf16_t* vp; int vstep; NA_PTRS(t + 1, kp, vp, vstep); NA_LOADS(kp, vp, vstep, Kn, Vn); }
            const int ip = t >> 2, ct = t & 3;
#pragma unroll
            for (int qt = 0; qt < 2; ++qt) {
                if (t < 16 && (unsigned)(ct - qt) > 2u) continue;
                f32x16 sc;
#pragma unroll
                for (int i = 0; i < 16; ++i) sc[i] = 0.f;
#pragma unroll
                for (int ks = 0; ks < 4; ++ks) sc = __builtin_amdgcn_mfma_f32_32x32x16_bf16(__builtin_bit_cast(bf16x8, Kc[ks]), Qf[qt][ks], sc, 0, 0, 0);
                unsigned pk[8];
                if (t < 16) {
                    const int q = qt * 32 + ql, c0 = min(max(q - 8, 0), 48);
#pragma unroll
                    for (int rr = 0; rr < 16; rr += 2) {
                        const int wi = 2 * ip + (rr >> 3), col = 16 * ct + (rr & 3) + 4 * ((rr >> 2) & 1) + 8 * hh;
                        const MLAS float* bp = rpb + (r0 + wi - r + 7) * 128 + (col - q + 63);
                        const float b0 = bp[0], b1 = bp[1];
                        const float e0 = __builtin_amdgcn_exp2f(sc[rr] + b0), e1 = __builtin_amdgcn_exp2f(sc[rr + 1] + b1);
                        const float p0 = (unsigned)(col - c0) < 16u ? e0 : 0.f, p1 = (unsigned)(col + 1 - c0) < 16u ? e1 : 0.f;
                        lsum[qt] += p0 + p1; pk[rr >> 1] = pack2(p0, p1);
                    }
                } else {
#pragma unroll
                    for (int rr = 0; rr < 16; rr += 2) { const float p0 = __builtin_amdgcn_exp2f(sc[rr]), p1 = __builtin_amdgcn_exp2f(sc[rr + 1]); lsum[qt] += p0 + p1; pk[rr >> 1] = pack2(p0, p1); }
                }
                const bf16x8 P0 = __builtin_bit_cast(bf16x8, (u32x4){pk[0], pk[1], pk[2], pk[3]}), P1 = __builtin_bit_cast(bf16x8, (u32x4){pk[4], pk[5], pk[6], pk[7]});
                O[qt][0] = __builtin_amdgcn_mfma_f32_32x32x16_bf16(__builtin_bit_cast(bf16x8, Vc[0]), P0, O[qt][0], 0, 0, 0);
                O[qt][0] = __builtin_amdgcn_mfma_f32_32x32x16_bf16(__builtin_bit_cast(bf16x8, Vc[1]), P1, O[qt][0], 0, 0, 0);
                O[qt][1] = __builtin_amdgcn_mfma_f32_32x32x16_bf16(__builtin_bit_cast(bf16x8, Vc[2]), P0, O[qt][1], 0, 0, 0);
                O[qt][1] = __builtin_amdgcn_mfma_f32_32x32x16_bf16(__builtin_bit_cast(bf16x8, Vc[3]), P1, O[qt][1], 0, 0, 0);
            }
        }
#undef NA_PTRS
#undef NA_LOADS
#pragma unroll
        for (int qt = 0; qt < 2; ++qt) {
            const float inv = 1.0f / (lsum[qt] + __shfl_xor(lsum[qt], 32));
#pragma unroll
            for (int g4 = 0; g4 < 4; ++g4) {
                *(MLAS u32x2*)(ost + (32 * qt + ql) * NA_OP + 8 * g4 + 4 * hh) = (u32x2){pack2(O[qt][0][4 * g4] * inv, O[qt][0][4 * g4 + 1] * inv), pack2(O[qt][0][4 * g4 + 2] * inv, O[qt][0][4 * g4 + 3] * inv)};
                *(MLAS u32x2*)(ost + (32 * qt + ql) * NA_OP + 32 + 8 * g4 + 4 * hh) = (u32x2){pack2(O[qt][1][4 * g4] * inv, O[qt][1][4 * g4 + 1] * inv), pack2(O[qt][1][4 * g4 + 2] * inv, O[qt][1][4 * g4 + 3] * inv)};
            }
        }
#pragma unroll
        for (int k = 0; k < 8; ++k) { const int idx = lane + 64 * k, row = idx >> 3, ch = idx & 7;
            *(u32x4*)(mix + (size_t)(qrow0 + row) * D + h * 64 + ch * 8) = *(const MLAS u32x4*)(ost + row * NA_OP + ch * 8); }
    }
}

constexpr int N2P = 1032;
typedef float f32x4v __attribute__((ext_vector_type(4)));
__device__ __forceinline__ void phase_norm2(const Args& a, int l, MLAS unsigned char* lds, int bid, int nb) {
    const int tid = otid(), lane = tid & 63, wave = __builtin_amdgcn_readfirstlane(tid >> 6);
    const int e0 = lane * 8, e1 = 512 + lane * 8;
    MLAS bf16_t* Ahi = (MLAS bf16_t*)lds; MLAS bf16_t* Alo = Ahi + 16 * N2P; MLAS float* part = (MLAS float*)(Alo + 16 * N2P);
    MLAS float* tsc = part + 8 * 16 * 32; MLAS float* tsh = tsc + 1024; int cur_r = -1;
    bf16_t* hb = (bf16_t*)(a.ws + WS_H);
    int* tok_e = (int*)(a.ws + WS_TOKE); int* tok_r = (int*)(a.ws + WS_TOKR); float* tok_w = (float*)(a.ws + WS_TOKW);
    unsigned* cnt = (unsigned*)(a.ws + WS_CNT) + l * 2048;
    MLAS unsigned* lcnt = (MLAS unsigned*)(tsh + 1024);
    if (tid < NE) lcnt[tid] = 0u;
    const int nrows = l == 0 ? TT : TL;
    bf16x8 Bh[4][2], Bl[4][2];
    { const bf16_t* rh = (const bf16_t*)(a.ws + WS_RWT); const bf16_t* rl = rh + 32 * 1024;
#pragma unroll
      for (int ks = 0; ks < 4; ++ks)
#pragma unroll
        for (int nt = 0; nt < 2; ++nt) { const int o = (nt * 16 + (lane & 15)) * 1024 + 128 * wave + 32 * ks + 8 * (lane >> 4);
            Bh[ks][nt] = __builtin_bit_cast(bf16x8, *(const u32x4*)(rh + o)); Bl[ks][nt] = __builtin_bit_cast(bf16x8, *(const u32x4*)(rl + o)); } }
    const float rbias = a.router_bias[lane & 31];
#define N2_BAR() do { asm volatile("s_waitcnt lgkmcnt(0)" ::: "memory"); __builtin_amdgcn_s_barrier(); asm volatile("" ::: "memory"); } while (0)
#define N2_LOAD(bt, dst) do { _Pragma("unroll") for (int jr_ = 0; jr_ < 2; ++jr_) { const int row_ = (bt) * 16 + 2 * wave + jr_; \
        if (row_ < TL) { const bf16_t* sb_ = (const bf16_t*)(a.ws + WS_XB) + (size_t)row_ * D; dst[jr_][0] = __builtin_bit_cast(f32x4, *(const u32x4*)(sb_ + e0)); dst[jr_][1] = __builtin_bit_cast(f32x4, *(const u32x4*)(sb_ + e1)); } \
        else { const float* src_ = (const float*)(a.ws + WS_CTX) + (size_t)(row_ - TL) * D; \
        dst[jr_][0] = *(const f32x4*)(src_ + e0); dst[jr_][1] = *(const f32x4*)(src_ + e0 + 4); dst[jr_][2] = *(const f32x4*)(src_ + e1); dst[jr_][3] = *(const f32x4*)(src_ + e1 + 4); } } } while (0)
    f32x4 vc[2][4];
    const int nbatch = nrows / 16;
    const int per = (nbatch + nb - 1) / nb, b_lo = bid * per, b_hi = min(b_lo + per, nbatch);
    if (b_lo < b_hi) N2_LOAD(b_lo, vc);
    for (int batch = b_lo; batch < b_hi; ++batch) {
        const int R0 = batch * 16, r = R0 < TL ? R0 / SEQ : 16;
        N2_BAR();
        if (r != cur_r) { cur_r = r; const float* sh = modp(a, l, r, 3); const float* sc = modp(a, l, r, 4); const float* w = a.norm_ffn_w + l * D;
            for (int k = tid; k < D; k += NT) { tsc[k] = (1.0f + sc[k]) * w[k]; tsh[k] = sh[k]; }
            N2_BAR(); }
#pragma unroll
        for (int jr = 0; jr < 2; ++jr) {
            const int m = 2 * wave + jr, row = R0 + m;
            float v[16];
            if (R0 < TL) { const u32x4 w0 = __builtin_bit_cast(u32x4, vc[jr][0]), w1 = __builtin_bit_cast(u32x4, vc[jr][1]);
#pragma unroll
                for (int j = 0; j < 4; ++j) { v[2 * j] = lo16(w0[j]); v[2 * j + 1] = hi16(w0[j]); v[8 + 2 * j] = lo16(w1[j]); v[8 + 2 * j + 1] = hi16(w1[j]); } }
            else {
#pragma unroll
                for (int j = 0; j < 4; ++j) { v[j] = vc[jr][0][j]; v[4 + j] = vc[jr][1][j]; v[8 + j] = vc[jr][2][j]; v[12 + j] = vc[jr][3][j]; } }
            float ss = 0.f;
#pragma unroll
            for (int j = 0; j < 16; ++j) ss += v[j] * v[j];
            ss = wave_sum(ss);
            const float rs = rsqrtf(ss * (1.0f / D) + 1e-6f);
            unsigned ph[8], pl[8], p8[4]; float yk0 = 0.f, yk1 = 0.f;
            float msc[16], msh[16];
#pragma unroll
            for (int q = 0; q < 2; ++q) { const f32x4 c0 = *(const MLAS f32x4*)(tsc + e0 + 4 * q), c1 = *(const MLAS f32x4*)(tsc + e1 + 4 * q), h0 = *(const MLAS f32x4*)(tsh + e0 + 4 * q), h1 = *(const MLAS f32x4*)(tsh + e1 + 4 * q);
#pragma unroll
                for (int j = 0; j < 4; ++j) { msc[4 * q + j] = c0[j]; msc[8 + 4 * q + j] = c1[j]; msh[4 * q + j] = h0[j]; msh[8 + 4 * q + j] = h1[j]; } }
#pragma unroll
            for (int j = 0; j < 16; j += 2) {
                const float y0 = v[j] * rs * msc[j] + msh[j], y1 = v[j + 1] * rs * msc[j + 1] + msh[j + 1];
                const bf16_t h0 = f2bf(y0), h1 = f2bf(y1);
                ph[j >> 1] = (unsigned)h0 | ((unsigned)h1 << 16); pl[j >> 1] = pack2(y0 - bf2f(h0), y1 - bf2f(h1));
                if (j & 2) p8[j >> 2] = pack4_fp8(yk0, yk1, y0, y1); else { yk0 = y0; yk1 = y1; } }
            unsigned char* hp = (unsigned char*)hb + (size_t)row * D;
            *(u32x2*)(hp + e0) = (u32x2){p8[0], p8[1]}; *(u32x2*)(hp + e1) = (u32x2){p8[2], p8[3]};
            *(MLAS u32x4*)(Ahi + m * N2P + e0) = (u32x4){ph[0], ph[1], ph[2], ph[3]}; *(MLAS u32x4*)(Ahi + m * N2P + e1) = (u32x4){ph[4], ph[5], ph[6], ph[7]};
            *(MLAS u32x4*)(Alo + m * N2P + e0) = (u32x4){pl[0], pl[1], pl[2], pl[3]}; *(MLAS u32x4*)(Alo + m * N2P + e1) = (u32x4){pl[4], pl[5], pl[6], pl[7]};
        }
        if (batch + 1 < b_hi) N2_LOAD(batch + 1, vc);
        N2_BAR();
        {
            f32x4v acc0 = {0.f, 0.f, 0.f, 0.f}, acc1 = {0.f, 0.f, 0.f, 0.f};
#pragma unroll
            for (int ks = 0; ks < 4; ++ks) {
                const int o = (lane & 15) * N2P + 128 * wave + 32 * ks + 8 * (lane >> 4);
                const bf16x8 ah = *(const MLAS bf16x8*)(Ahi + o), al = *(const MLAS bf16x8*)(Alo + o);
                acc0 = __builtin_amdgcn_mfma_f32_16x16x32_bf16(ah, Bh[ks][0], acc0, 0, 0, 0); acc0 = __builtin_amdgcn_mfma_f32_16x16x32_bf16(al, Bh[ks][0], acc0, 0, 0, 0); acc0 = __builtin_amdgcn_mfma_f32_16x16x32_bf16(ah, Bl[ks][0], acc0, 0, 0, 0);
                acc1 = __builtin_amdgcn_mfma_f32_16x16x32_bf16(ah, Bh[ks][1], acc1, 0, 0, 0); acc1 = __builtin_amdgcn_mfma_f32_16x16x32_bf16(al, Bh[ks][1], acc1, 0, 0, 0); acc1 = __builtin_amdgcn_mfma_f32_16x16x32_bf16(ah, Bl[ks][1], acc1, 0, 0, 0);
            }
#pragma unroll
            for (int rg = 0; rg < 4; ++rg) { const int m = 4 * (lane >> 4) + rg; part[(wave * 16 + m) * 32 + (lane & 15)] = acc0[rg]; part[(wave * 16 + m) * 32 + 16 + (lane & 15)] = acc1[rg]; }
        }
        N2_BAR();
        {
            const int m = tid >> 5, ex = tid & 31, hb32 = lane & 32, row = R0 + m;
            float acc = 0.f;
#pragma unroll
            for (int w8 = 0; w8 < 8; ++w8) acc += part[(w8 * 16 + m) * 32 + ex];
            const float sg = 1.0f / (1.0f + __expf(-acc)), ssel = sg + rbias;
            float best = -1e30f; int grp = 0;
#pragma unroll
            for (int g = 0; g < 8; ++g) {
                const float v0 = __shfl(ssel, hb32 + g * 4), v1 = __shfl(ssel, hb32 + g * 4 + 1), v2 = __shfl(ssel, hb32 + g * 4 + 2), v3 = __shfl(ssel, hb32 + g * 4 + 3);
                const float hi01 = fmaxf(v0, v1), lo01 = fminf(v0, v1), hi23 = fmaxf(v2, v3), lo23 = fminf(v2, v3);
                const float top = fmaxf(hi01, hi23), second = fmaxf(fminf(hi01, hi23), hi01 >= hi23 ? lo01 : lo23);
                const float gs = top + second;
                if (gs > best) { best = gs; grp = g; }
            }
            float w4[4], s4[4];
#pragma unroll
            for (int j = 0; j < 4; ++j) { w4[j] = __shfl(ssel, hb32 + grp * 4 + j); s4[j] = __shfl(sg, hb32 + grp * 4 + j); }
            int i0 = 0;
#pragma unroll
            for (int j = 1; j < 4; ++j) if (w4[j] > w4[i0]) i0 = j;
            int i1 = i0 == 0 ? 1 : 0;
#pragma unroll
            for (int j = 0; j < 4; ++j) if (j != i0 && j != i1 && w4[j] > w4[i1]) i1 = j;
            float g0 = 0.f, g1 = 0.f;
#pragma unroll
            for (int j = 0; j < 4; ++j) { g0 = (j == i0) ? s4[j] : g0; g1 = (j == i1) ? s4[j] : g1; }
            const float inv = 1.0f / (g0 + g1);
            if (ex < 2) {
                const int e = grp * 4 + (ex == 0 ? i0 : i1);
                const unsigned rank = __hip_atomic_fetch_add(lcnt + e, 1u, __ATOMIC_RELAXED, __HIP_MEMORY_SCOPE_WORKGROUP);
                tok_e[row * 2 + ex] = e; tok_r[row * 2 + ex] = (int)rank; tok_w[row * 2 + ex] = (ex == 0 ? g0 : g1) * inv;
            }
        }
    }
    N2_BAR();
    if (tid < NE) ((int*)(a.ws + WS_BLKB))[bid * NE + tid] = (int)atomicAdd(cnt + tid * 32, lcnt[tid]);
#undef N2_BAR
#undef N2_LOAD
}
__device__ __forceinline__ void phase_gather(const Args& a, int l, MLAS unsigned char* lds, int bid, int nb) {
    const int tid = otid(), lane = tid & 63, wave = tid >> 6;
    MLAS int* pbase = (MLAS int*)lds;
    MLAS int* cn = pbase + 64;
    const unsigned* cnt = (const unsigned*)(a.ws + WS_CNT) + l * 2048; const int* blkb = (const int*)(a.ws + WS_BLKB);
    if (tid == 0) { int acc = 0; for (int e = 0; e < NE; ++e) { const int c = (int)__hip_atomic_load(cnt + e * 32, __ATOMIC_RELAXED, __HIP_MEMORY_SCOPE_AGENT); cn[e] = c; pbase[e] = acc; acc += (c + 255) & ~255; } pbase[NE] = acc; }
    __syncthreads();
    int* rinfo = (int*)(a.ws + WS_RINFO); float* rw = (float*)(a.ws + WS_RW); int* blke = (int*)(a.ws + WS_BLKE);
    if (bid == 0) {
        for (int e = 0; e < NE; ++e) {
            for (int p = pbase[e] + cn[e] + tid; p < pbase[e + 1]; p += NT) { rinfo[p] = -1; rw[p] = 0.f; }
            for (int blk = (pbase[e] >> 8) + tid; blk < (pbase[e + 1] >> 8); blk += NT) blke[blk] = e;
        }
        if (tid == 0) blke[1023] = (pbase[NE] >> 8) * 4;
    }
    const int* tok_e = (const int*)(a.ws + WS_TOKE); const int* tok_r = (const int*)(a.ws + WS_TOKR); const float* tok_w = (const float*)(a.ws + WS_TOKW);
    const int nas = (l == 0 ? TT : TL) * 2, per_ = ((l == 0 ? TT : TL) / 16 + nb - 1) / nb;
    for (int as = bid * NT + tid; as < nas; as += nb * NT) {
        const int t = as >> 1, e = tok_e[as], pos = pbase[e] + blkb[((t >> 4) / per_) * NE + e] + tok_r[as];
        rinfo[pos] = as; ((int*)(a.ws + WS_TOKR))[as] = pos;
    }
}

using pg8::Unit;
struct EpiStoreBf16 {
    static constexpr bool PERM = true, AFTER_DRAIN = false;
    bf16_t* O; int ldc; bf16_t* kc_lat; bf16_t* vt_lat; bf16_t* kc_ctx; bf16_t* vt_ctx; const float* knw; MLAS unsigned char* sp;
    __device__ __forceinline__ void operator()(const f32x4 (&acc)[2][2][4][2], const Unit& u, int wr, int wc, int fr, int fq) const {
        const int row0 = u.pm * 256 + wr * 64 + fr;
        if (u.pn < 2 || u.pn > 5) {
            const int col0 = u.pn * 256 + wc * 32 + 8 * fq;
#pragma unroll
            for (int ai = 0; ai < 2; ++ai)
#pragma unroll
                for (int m = 0; m < 4; ++m) { bf16_t* rowp = O + (size_t)(row0 + ai * 128 + m * 16) * ldc + col0;
#pragma unroll
                    for (int bj = 0; bj < 2; ++bj) { const f32x4 v0 = acc[ai][bj][m][0], v1 = acc[ai][bj][m][1];
                        *(u32x4*)(rowp + bj * 128) = (u32x4){pg8::cvt_pk_bf16(v0[0], v0[1]), pg8::cvt_pk_bf16(v0[2], v0[3]), pg8::cvt_pk_bf16(v1[0], v1[1]), pg8::cvt_pk_bf16(v1[2], v1[3])}; } }
            return;
        }
        const bool lat = u.pm < 256;
        if (u.pn < 4) {
            MLAS float* part = (MLAS float*)sp;
            float ss[2][4][2];
#pragma unroll
            for (int ai = 0; ai < 2; ++ai)
#pragma unroll
                for (int m = 0; m < 4; ++m)
#pragma unroll
                    for (int bj = 0; bj < 2; ++bj) { const f32x4 v0 = acc[ai][bj][m][0], v1 = acc[ai][bj][m][1];
                        float q = (v0[0] * v0[0] + v0[1] * v0[1]) + (v0[2] * v0[2] + v0[3] * v0[3]) + (v1[0] * v1[0] + v1[1] * v1[1]) + (v1[2] * v1[2] + v1[3] * v1[3]);
                        q += __shfl_xor(q, 16); q += __shfl_xor(q, 32); ss[ai][m][bj] = q;
                        if (fq == 0) part[((((ai * 4 + m) * 2 + bj) * 2 + wr) * 16 + fr) * 4 + wc] = q; }
            asm volatile("s_waitcnt lgkmcnt(0)" ::: "memory"); __builtin_amdgcn_s_barrier(); asm volatile("" ::: "memory");
            const f32x4 w0 = *(const f32x4*)(knw + (wc & 1) * 32 + 8 * fq), w1 = *(const f32x4*)(knw + (wc & 1) * 32 + 8 * fq + 4);
#pragma unroll
            for (int ai = 0; ai < 2; ++ai)
#pragma unroll
                for (int m = 0; m < 4; ++m) { const int row = row0 + ai * 128 + m * 16;
                    const int b = lat ? row >> 12 : (row - TL) >> 8, t = lat ? row & (SEQ - 1) : (row - TL) & (LC - 1), tlen = lat ? SEQ : LC;
                    bf16_t* kb = (lat ? kc_lat : kc_ctx);
#pragma unroll
                    for (int bj = 0; bj < 2; ++bj) {
                        const float other = part[((((ai * 4 + m) * 2 + bj) * 2 + wr) * 16 + fr) * 4 + (wc ^ 1)];
                        const float rs = rsqrtf((ss[ai][m][bj] + other) * (1.0f / 64.0f) + 1e-6f);
                        const f32x4 v0 = acc[ai][bj][m][0] * rs * w0, v1 = acc[ai][bj][m][1] * rs * w1;
                        const int head = (u.pn - 2) * 4 + 2 * bj + (wc >> 1);
                        *(u32x4*)(kb + (((size_t)b * 8 + head) * tlen + t) * 64 + (wc & 1) * 32 + 8 * fq) = (u32x4){pg8::cvt_pk_bf16(v0[0], v0[1]), pg8::cvt_pk_bf16(v0[2], v0[3]), pg8::cvt_pk_bf16(v1[0], v1[1]), pg8::cvt_pk_bf16(v1[2], v1[3])}; } }
            return;
        }
        {
            MLAS bf16_t* gb = (MLAS bf16_t*)(sp + wr * 8192);
            bf16_t* vb = lat ? vt_lat : vt_ctx; const int ngrp = lat ? SEQ / 16 : LC / 16;
#pragma unroll
            for (int ai = 0; ai < 2; ++ai)
#pragma unroll
                for (int m = 0; m < 4; ++m) {
#pragma unroll
                    for (int bj = 0; bj < 2; ++bj)
#pragma unroll
                        for (int n = 0; n < 2; ++n) { const f32x4 v = acc[ai][bj][m][n]; const int c = bj * 128 + wc * 32 + 8 * fq + 4 * n;
                            const unsigned p01 = pg8::cvt_pk_bf16(v[0], v[1]), p23 = pg8::cvt_pk_bf16(v[2], v[3]);
                            gb[(c + 0) * 16 + fr] = (bf16_t)(p01 & 0xffffu); gb[(c + 1) * 16 + fr] = (bf16_t)(p01 >> 16);
                            gb[(c + 2) * 16 + fr] = (bf16_t)(p23 & 0xffffu); gb[(c + 3) * 16 + fr] = (bf16_t)(p23 >> 16); }
                    asm volatile("s_waitcnt lgkmcnt(0)" ::: "memory"); __builtin_amdgcn_s_barrier(); asm volatile("" ::: "memory");
                    const int rowb = u.pm * 256 + ai * 128 + wr * 64 + m * 16;
                    const int b = lat ? rowb >> 12 : (rowb - TL) >> 8, g16 = (lat ? rowb & (SEQ - 1) : (rowb - TL) & (LC - 1)) >> 4;
#pragma unroll
                    for (int k = 0; k < 2; ++k) { const int qd = wc * 64 + fr + 16 * fq + 256 * k, c = qd >> 1, half = qd & 1;
                        const u32x4 w = *(const MLAS u32x4*)(gb + c * 16 + 8 * half);
                        const int head = (u.pn - 4) * 4 + (c >> 6), d = c & 63;
                        *(u32x4*)(vb + ((((size_t)b * 8 + head) * ngrp + g16) * 64 + d) * 16 + 8 * half) = w; }
                    asm volatile("s_waitcnt lgkmcnt(0)" ::: "memory"); __builtin_amdgcn_s_barrier(); asm volatile("" ::: "memory");
                }
        }
    }
};
struct EpiResGate {
    static constexpr bool PERM = true, AFTER_DRAIN = false;
    const void* xin_lat; const float* xin_ctx; bf16_t* out_lat; float* out_ctx; const float* modl; int in_bf16;
    __device__ __forceinline__ void operator()(const f32x4 (&acc)[2][2][4][2], const Unit& u, int wr, int wc, int fr, int fq) const {
        const bool lat = u.pm < 256; const int r = lat ? (u.pm >> 4) : 16;
        const int rowt = (lat ? u.pm : u.pm - 256) * 256 + wr * 64 + fr, col0 = u.pn * 256 + wc * 32 + 8 * fq;
        const float* g = modl + (size_t)r * 6144 + 2 * 1024 + col0;
        f32x4 gv[2][2];
#pragma unroll
        for (int bj = 0; bj < 2; ++bj)
#pragma unroll
            for (int n = 0; n < 2; ++n) gv[bj][n] = *(const f32x4*)(g + bj * 128 + 4 * n);
#pragma unroll
        for (int ai = 0; ai < 2; ++ai)
#pragma unroll
            for (int m = 0; m < 4; ++m) { const size_t off = (size_t)(rowt + ai * 128 + m * 16) * D + col0;
#pragma unroll
                for (int bj = 0; bj < 2; ++bj) {
                    f32x4 x0, x1;
                    if (!lat) { x0 = *(const f32x4*)(xin_ctx + off + bj * 128); x1 = *(const f32x4*)(xin_ctx + off + bj * 128 + 4); }
                    else if (in_bf16) { const u32x4 w = *(const u32x4*)((const bf16_t*)xin_lat + off + bj * 128); x0 = (f32x4){lo16(w.x), hi16(w.x), lo16(w.y), hi16(w.y)}; x1 = (f32x4){lo16(w.z), hi16(w.z), lo16(w.w), hi16(w.w)}; }
                    else { x0 = *(const f32x4*)((const float*)xin_lat + off + bj * 128); x1 = *(const f32x4*)((const float*)xin_lat + off + bj * 128 + 4); }
                    x0 += gv[bj][0] * acc[ai][bj][m][0]; x1 += gv[bj][1] * acc[ai][bj][m][1];
                    if (lat) *(u32x4*)(out_lat + off + bj * 128) = (u32x4){pack2(x0[0], x0[1]), pack2(x0[2], x0[3]), pack2(x1[0], x1[1]), pack2(x1[2], x1[3])};
                    else { *(f32x4*)(out_ctx + off + bj * 128) = x0; *(f32x4*)(out_ctx + off + bj * 128 + 4) = x1; } } }
    }
};
struct EpiSwiglu {
    static constexpr bool PERM = true, AFTER_DRAIN = false;
    bf16_t* act;
    __device__ __forceinline__ void operator()(const f32x4 (&acc)[2][2][4][2], const Unit& u, int wr, int wc, int fr, int fq) const {
        const int row0 = u.pm * 256 + wr * 64 + fr, col0 = (u.pn & 3) * 128 + wc * 32 + 8 * fq;
#pragma unroll
        for (int ai = 0; ai < 2; ++ai)
#pragma unroll
            for (int m = 0; m < 4; ++m) { float r[8];
#pragma unroll
                for (int n = 0; n < 2; ++n)
#pragma unroll
                    for (int j = 0; j < 4; ++j) { const float gt = acc[ai][0][m][n][j]; r[n * 4 + j] = siluf(gt) * acc[ai][1][m][n][j]; }
                *(u32x2*)((unsigned char*)act + (size_t)(row0 + ai * 128 + m * 16) * DFF + col0) = (u32x2){pack4_fp8(r[0], r[1], r[2], r[3]), pack4_fp8(r[4], r[5], r[6], r[7])}; }
    }
};
struct EpiDown {
    static constexpr bool PERM = true, AFTER_DRAIN = false;
    bf16_t* ys;
    __device__ __forceinline__ void operator()(const f32x4 (&acc)[2][2][4][2], const Unit& u, int wr, int wc, int fr, int fq) const {
        const int row0 = u.pm * 256 + wr * 64 + fr, col0 = (u.pn & 3) * 256 + wc * 32 + 8 * fq;
#pragma unroll
        for (int ai = 0; ai < 2; ++ai)
#pragma unroll
            for (int m = 0; m < 4; ++m) { bf16_t* rowp = ys + (size_t)(row0 + ai * 128 + m * 16) * D + col0;
#pragma unroll
                for (int bj = 0; bj < 2; ++bj) { const f32x4 v0 = acc[ai][bj][m][0], v1 = acc[ai][bj][m][1];
                    *(u32x4*)(rowp + bj * 128) = (u32x4){pg8::cvt_pk_bf16(v0[0], v0[1]), pg8::cvt_pk_bf16(v0[2], v0[3]), pg8::cvt_pk_bf16(v1[0], v1[1]), pg8::cvt_pk_bf16(v1[2], v1[3])}; } }
    }
};
struct SubsetOrder {
    pg8::StaticOrder base; unsigned map;
    __device__ __forceinline__ bool next(int i, Unit& u) const { if (!base.next(i, u)) return false; u.pn = (int)((map >> (4 * u.pn)) & 15u); return true; }
    __device__ __forceinline__ void a_ready(const Unit&) const {}
    __device__ __forceinline__ void done(const Unit&) const {}
};
struct MoeOrder {
    const MLAS int* blke; int nunits, G, c;
    __device__ __forceinline__ bool next(int i, Unit& u) const { const int x = c & 7, j = c >> 3; int L;
        if (G == 256) { const int rb = i * 64 + (j >> 2) * 8 + x; L = rb * 4 + (j & 3); } else L = i * G + c;
        if (L >= nunits) return false; u.pm = L >> 2; u.pn = blke[L >> 2] * 4 + (L & 3); return true; }
    __device__ __forceinline__ void a_ready(const Unit&) const {}
    __device__ __forceinline__ void done(const Unit&) const {}
};

typedef const Args __attribute__((address_space(4))) CArgs;
#define MK_LOAD_ARGS(a, p) do { (a).x = (p)->x; (a).c = (p)->c; (a).ctx = (p)->ctx; (a).c_ctx = (p)->c_ctx; (a).ada_w = (p)->ada_w; (a).ada_b = (p)->ada_b; (a).norm_mix_w = (p)->norm_mix_w; (a).norm_ffn_w = (p)->norm_ffn_w; (a).w_in = (p)->w_in; (a).na_q_norm = (p)->na_q_norm; (a).na_k_norm = (p)->na_k_norm; (a).na_rpb = (p)->na_rpb; (a).ret_decay = (p)->ret_decay; (a).w_out = (p)->w_out; (a).router_w = (p)->router_w; (a).router_bias = (p)->router_bias; (a).w_gate = (p)->w_gate; (a).w_up = (p)->w_up; (a).w_down = (p)->w_down; (a).out = (p)->out; (a).ws = (p)->ws; (a).ph_lo = (p)->ph_lo; (a).ph_hi = (p)->ph_hi; } while (0)
#ifndef MK_SINGLE
#define MK_SINGLE 1
#endif
constexpr int NPHASES = 24;
#ifndef MK_PROBE_MASK
#define MK_PROBE_MASK 0
#endif
#ifndef MK_BAR2
#define MK_BAR2 0
#endif
#ifndef MK_PROBE_MULT
#define MK_PROBE_MULT 4
#endif
enum { K_PRO = 0, K_NORM1, K_GEMM_IN, K_PREP, K_NA, K_RET_A, K_SCAN, K_RET_B, K_GEMM_OUT, K_NORM2, K_GATHER, K_MOE1, K_MOE2, K_FINAL };
__global__ void __launch_bounds__(NT, 2) fwd(Args ka) {
    extern __shared__ __attribute__((aligned(16))) unsigned char lds_raw[];
    MLAS unsigned char* lds = (MLAS unsigned char*)lds_raw;
    const int tid = threadIdx.x, nb = gridDim.x;
    volatile MLAS unsigned* ctl = (volatile MLAS unsigned*)(lds + LDS_CTL);
    if (tid < 4) ctl[tid] = 0u;
    __syncthreads();
    const bool multi = MK_SINGLE != 0;
    XcdBarrier bar; bar.bar = (unsigned*)(ka.ws + WS_BAR); bar.x = 0; bar.st = ctl;
    if (multi) bar = xcd_barrier_post((unsigned*)(ka.ws + WS_BAR), ctl);
    int ph = 0;
#if MK_SINGLE
#define MK_GUARD 1
#define MK_SEAM(kind) ((kind) != K_FINAL)
#else
#define MK_GUARD (ph >= ka.ph_lo && ph < ka.ph_hi)
#define MK_SEAM(kind) (ph + 1 < ka.ph_hi)
#endif
#define PHASE(kind, ...) do { if (MK_GUARD) { CArgs* ap_ = (CArgs*)__builtin_amdgcn_kernarg_segment_ptr(); asm volatile("" : "+s"(ap_)); Args a; MK_LOAD_ARGS(a, ap_); int bid = blockIdx.x; asm volatile("" : "+s"(bid)); unsigned long long t0_ = 0; if ((MK_PROBE_MASK >> (kind)) & 1) t0_ = wall_clock64(); { __VA_ARGS__; } if ((MK_PROBE_MASK >> (kind)) & 1) { const unsigned long long d_ = wall_clock64() - t0_; while (wall_clock64() - t0_ < d_ * (MK_PROBE_MULT + 1)) __builtin_amdgcn_s_sleep(8); } if (MK_SEAM(kind)) { XcdBarrier b_ = bar; asm volatile("" : "+s"(b_.bar), "+s"(b_.x)); xcd_barrier(b_); if (MK_BAR2) { xcd_barrier(b_); xcd_barrier(b_); } } } ++ph; } while (0)
    PHASE(K_PRO, { convert_small(a, bid, nb); convert_weights(a, true, 0, lds, bid, nb); compute_mod(a, lds, bid, nb); });
#define MK_LAYER(l) do { \
        PHASE(K_NORM1, { phase_norm1(a, l, bid, nb); if (l == 1) convert_weights(a, false, 1, lds, bid, nb); }); \
        PHASE(K_GEMM_IN, { EpiStoreBf16 E{(bf16_t*)(a.ws + WS_PROJ), INC, (bf16_t*)(a.ws + WS_KC), (bf16_t*)(a.ws + WS_VT), (bf16_t*)(a.ws + WS_KCC), (bf16_t*)(a.ws + WS_VTC), a.na_k_norm + l * 64, lds + 131072}; \
                { pg8::Gemm g{(const bf16_t*)(a.ws + WS_H), (const bf16_t*)(a.ws + WS_WIN) + (size_t)l * INC * D, TT, INC, D}; \
                  SubsetOrder S; S.base.init(TT, INC / 2, nb, bid); S.map = IN_TILES_BF16; \
                  pg8::gemm_phase<EpiStoreBf16, SubsetOrder>(lds, g, S, E, nullptr); } \
                { pg8::Gemm g{(const bf16_t*)h8_of(a), (const bf16_t*)(a.ws + WS_WIN8 + (size_t)l * INC * D), TT, INC, D, nullptr, SC_IN8}; \
                  SubsetOrder S; S.base.init(TT, INC / 2, nb, nb - 1 - bid); S.map = IN_TILES_FP8;     \
                  pg8::gemm_phase<EpiStoreBf16, SubsetOrder, false, false, 1>(lds, g, S, E, nullptr); } }); \
        PHASE(K_NA, phase_na(a, l, lds, bid, nb)); \
        PHASE(K_RET_A, phase_ret_a(a, l, lds, bid, nb)); \
        PHASE(K_SCAN, phase_scan(a, l, bid, nb)); \
        PHASE(K_RET_B, phase_ret_b(a, l, lds, bid, nb)); \
        PHASE(K_GEMM_OUT, { const int M = l == 0 ? TT : TL; \
                pg8::Gemm g{(const bf16_t*)(a.ws + WS_H), (const bf16_t*)(a.ws + WS_WOUT) + (size_t)l * D * D, M, D, D}; \
                pg8::StaticOrder S; S.init(M, D, nb, bid); \
                EpiResGate E{l == 0 ? (const void*)a.x : (const void*)a.out, a.ctx, (bf16_t*)(a.ws + WS_XB), (float*)(a.ws + WS_CTX), (const float*)(a.ws + WS_MOD) + (size_t)l * 17 * 6144, l}; \
                pg8::gemm_phase<EpiResGate, pg8::StaticOrder>(lds, g, S, E, nullptr); }); \
        PHASE(K_NORM2, phase_norm2(a, l, lds, bid, nb)); \
        PHASE(K_GATHER, phase_gather(a, l, lds, bid, nb)); \
        PHASE(K_MOE1, { MLAS int* blke = (MLAS int*)(lds + 131072); { const int* gb_ = (const int*)(a.ws + WS_BLKE); for (int i_ = otid(); i_ < 1024; i_ += NT) blke[i_] = gb_[i_]; __syncthreads(); } \
                pg8::Gemm g{(const bf16_t*)(a.ws + WS_H), (const bf16_t*)(a.ws + WS_WGU), PMAX, NE * 1024, D, (const int*)(a.ws + WS_RINFO), SC_MOE1}; \
                MoeOrder S{blke, blke[1023], nb, bid}; \
                EpiSwiglu E{(bf16_t*)(a.ws + WS_ACT)}; \
                pg8::gemm_phase<EpiSwiglu, MoeOrder, false, true, 1>(lds, g, S, E, nullptr); }); \
        PHASE(K_MOE2, { MLAS int* blke = (MLAS int*)(lds + 131072); { const int* gb_ = (const int*)(a.ws + WS_BLKE); for (int i_ = otid(); i_ < 1024; i_ += NT) blke[i_] = gb_[i_]; __syncthreads(); } \
                pg8::Gemm g{(const bf16_t*)(a.ws + WS_ACT), (const bf16_t*)(a.ws + WS_WDN), PMAX, NE * 1024, DFF, nullptr, SC_MOE2}; \
                MoeOrder S{blke, blke[1023], nb, bid}; \
                EpiDown E{(bf16_t*)(a.ws + WS_XS)}; \
                pg8::gemm_phase<EpiDown, MoeOrder, false, false, 1>(lds, g, S, E, nullptr); }); \
    } while (0)
    MK_LAYER(0);
    MK_LAYER(1);
#undef MK_LAYER
    PHASE(K_FINAL, phase_final(a, bid, nb));
#undef PHASE
}
}

extern "C" void kernel_launch(void* const* d_in, const int* in_sizes, int n_in, void* d_out, int out_size, void* d_ws, size_t ws_size, hipStream_t stream) {
    using namespace mk;
    static int grid = 0;
    if (grid == 0) {
        if (n_in != 19 || in_sizes[0] != TL * D || out_size != TL * D || ws_size < WS_END) {
            fprintf(stderr, "kernel_launch: unexpected shapes / workspace (n_in %d, in0 %d, out %d, ws %zu, need %zu); nothing launched\n", n_in, n_in > 0 ? in_sizes[0] : -1, out_size, ws_size, (size_t)WS_END);
            grid = -1; return; }
        int dev = 0, cus = 0, per_cu = 0;
        if (hipGetDevice(&dev) != hipSuccess || hipDeviceGetAttribute(&cus, hipDeviceAttributeMultiprocessorCount, dev) != hipSuccess) { grid = -1; return; }
        if (hipFuncSetAttribute((const void*)fwd, hipFuncAttributeMaxDynamicSharedMemorySize, LDS_BYTES) != hipSuccess) { fprintf(stderr, "kernel_launch: hipFuncSetAttribute failed\n"); grid = -1; return; }
        if (hipOccupancyMaxActiveBlocksPerMultiprocessor(&per_cu, (const void*)fwd, NT, LDS_BYTES) != hipSuccess || per_cu < 1) { fprintf(stderr, "kernel_launch: occupancy query says %d\n", per_cu); (void)hipGetLastError(); grid = -1; return; }
        grid = cus;
    }
    if (grid < 0) return;
    (void)hipMemsetAsync((char*)d_ws + WS_BAR, 0, WS_ZERO_BYTES, stream);
    Args a{};
    a.x = (const float*)d_in[0]; a.c = (const float*)d_in[1]; a.ctx = (const float*)d_in[2]; a.c_ctx = (const float*)d_in[3]; a.ada_w = (const float*)d_in[4]; a.ada_b = (const float*)d_in[5];
    a.norm_mix_w = (const float*)d_in[6]; a.norm_ffn_w = (const float*)d_in[7]; a.w_in = (const float*)d_in[8]; a.na_q_norm = (const float*)d_in[9]; a.na_k_norm = (const float*)d_in[10];
    a.na_rpb = (const float*)d_in[11]; a.ret_decay = (const float*)d_in[12]; a.w_out = (const float*)d_in[13]; a.router_w = (const float*)d_in[14]; a.router_bias = (const float*)d_in[15];
    a.w_gate = (const float*)d_in[16]; a.w_up = (const float*)d_in[17]; a.w_down = (const float*)d_in[18];
    a.out = (float*)d_out; a.ws = (unsigned char*)d_ws;
#if MK_SINGLE
    a.ph_lo = 0; a.ph_hi = NPHASES;
    hipLaunchKernelGGL(fwd, dim3(grid), dim3(NT), LDS_BYTES, stream, a);
#else
    for (int ph = 0; ph < NPHASES; ++ph) { a.ph_lo = ph; a.ph_hi = ph + 1; hipLaunchKernelGGL(fwd, dim3(grid), dim3(NT), LDS_BYTES, stream, a); }
#endif
}
```

```cpp
#include <hip/hip_runtime.h>
#include <cstdio>
#include <cstdint>

#define XB_TMO      128
#define XB_XCNT(j)  (256  + 64 * (j))
#define XB_XSUB(j)  (1280 + 64 * (j))
#define XB_XGEN(j)  (2304 + 64 * (j))
#define XB_TOP      3328
#define XB_TOPGEN   3392
#define XCD_BAR_WORDS 3456
#define XB_SPIN_CAP (1u << 18)
#define LAS __attribute__((address_space(3)))

__device__ __forceinline__ unsigned xb_ld(unsigned* p)              { return __hip_atomic_load(p, __ATOMIC_RELAXED, __HIP_MEMORY_SCOPE_AGENT); }
__device__ __forceinline__ unsigned xb_add(unsigned* p, unsigned v) { return __hip_atomic_fetch_add(p, v, __ATOMIC_RELAXED, __HIP_MEMORY_SCOPE_AGENT); }
__device__ __forceinline__ unsigned xb_xcc_id() { return (unsigned)__builtin_amdgcn_s_getreg((3 << 11) | 20) & 0xFu; }
#define XB_SPIN(cond, bar) do { unsigned _sp = 0; while (cond) { __builtin_amdgcn_s_sleep(1); \
    if ((++_sp & 255u) == 0u) { if (xb_ld(&(bar)[XB_TMO])) break; if (_sp > XB_SPIN_CAP) { atomicAdd(&(bar)[XB_TMO], 1u); break; } } } } while (0)

struct XcdBarrier {
    unsigned* bar; unsigned x;
    volatile LAS unsigned* st;
};

__device__ __forceinline__ XcdBarrier xcd_barrier_post(unsigned* bar, volatile LAS unsigned* st) {
    XcdBarrier b; b.bar = bar; b.x = xb_xcc_id(); b.st = st;
    if (threadIdx.x == 0) (void)xb_add(&bar[XB_XCNT(b.x)], 1u);
    return b;
}
__device__ __forceinline__ void xcd_barrier_complete(unsigned* bar, unsigned x, unsigned& nloc, unsigned& nx) {
    const unsigned G = gridDim.x * gridDim.y * gridDim.z;
    unsigned sum, cnt, mine, sp = 0u;
    for (;;) {
        sum = 0u; cnt = 0u; mine = 0u;
#pragma unroll
        for (unsigned j = 0; j < 16; ++j) { const unsigned c = xb_ld(&bar[XB_XCNT(j)]); sum += c; cnt += (c > 0u) ? 1u : 0u; mine = (j == x) ? c : mine; }
        if (sum == G) break;
        __builtin_amdgcn_s_sleep(1);
        if ((++sp & 255u) == 0u) { if (xb_ld(&bar[XB_TMO])) break; if (sp > XB_SPIN_CAP) { atomicAdd(&bar[XB_TMO], 1u); break; } }
    }
    nloc = mine > 0u ? mine : 1u; nx = cnt > 0u ? cnt : 1u;
}

__device__ __forceinline__ void xcd_barrier(const XcdBarrier& b) {
    asm volatile("s_waitcnt vmcnt(0)" ::: "memory");
    __syncthreads();
    if (threadIdx.x == 0) {
        unsigned* bar = b.bar;
        __builtin_amdgcn_s_waitcnt(0);
        unsigned nloc = b.st[0], nx = b.st[1];
        if (nloc == 0u) { xcd_barrier_complete(bar, b.x, nloc, nx); b.st[0] = nloc; b.st[1] = nx; }
        const unsigned old = xb_add(&bar[XB_XSUB(b.x)], 1u);
        const unsigned gen = old / nloc;
        if (old + 1u == (gen + 1u) * nloc) {
            __builtin_amdgcn_fence(__ATOMIC_RELEASE, "agent");
            asm volatile("s_waitcnt vmcnt(0)" ::: "memory");
            const unsigned og = xb_add(&bar[XB_TOP], 1u);
            const unsigned tg = og / nx;
            if (og + 1u == (tg + 1u) * nx) xb_add(&bar[XB_TOPGEN], 1u);
            else XB_SPIN(xb_ld(&bar[XB_TOPGEN]) == tg, bar);
            __builtin_amdgcn_fence(__ATOMIC_ACQUIRE, "agent");
            xb_add(&bar[XB_XGEN(b.x)], 1u);
            asm volatile("s_waitcnt vmcnt(0)" ::: "memory");
        } else {
            XB_SPIN(xb_ld(&bar[XB_XGEN(b.x)]) == gen, bar);
            __builtin_amdgcn_fence(__ATOMIC_ACQUIRE, "agent");
            asm volatile("s_waitcnt vmcnt(0)" ::: "memory");
        }
    }
    __syncthreads();
}
namespace pg8 {
#define PG8_LAS __attribute__((address_space(3)))
typedef unsigned short bf16_t;
typedef short bf16x8 __attribute__((ext_vector_type(8)));
typedef float f32x4 __attribute__((ext_vector_type(4)));
typedef unsigned u32x4 __attribute__((ext_vector_type(4)));
constexpr int BM = 256, BK = 64, HALF = 128, HTB = HALF * BK * 2  , STAGE_BYTES = 8 * HTB, NXCD = 8, WGM = 8;

__host__ __device__ __forceinline__ int lds_byte(int r, int c) { const int st = (r >> 4) * 2 + (c >> 5), rr = r & 15, cc = c & 31, ob = rr * 64 + cc * 2; return st * 1024 + (ob ^ (((ob >> 9) & 1) << 5)); }
__host__ __device__ __forceinline__ void stage_rc(int b, int& R, int& C) { const int st = b / 1024, sb = b % 1024, swz = sb ^ (((sb >> 9) & 1) << 5); R = (st >> 1) * 16 + swz / 64; C = (st & 1) * 32 + (swz % 64) / 2; }
typedef int i32x4 __attribute__((ext_vector_type(4)));
typedef int i32x8 __attribute__((ext_vector_type(8)));
__host__ __device__ __forceinline__ int perm32(int rho) { const int n = rho >> 4, i = rho & 15; return 8 * (i >> 2) + 4 * n + (i & 3); }

struct Unit { int pm, pn; };
struct Gemm { const bf16_t* A; const bf16_t* Bt; int M, N, K; const int* rows = nullptr; int sc = 0x7f7f7f7f; };

struct StaticOrder {
    int nM, nN, nwg, G, c;
    __host__ __device__ void init(int M, int N, int G_, int c_) { nM = M / BM; nN = N / BM; nwg = nM * nN; G = G_; c = c_; }
    __host__ __device__ bool next(int i, Unit& u) const {
        const long L = (long)i * G + c; if (L >= nwg) return false;
        int wgid = (int)L; { const int q = nwg / NXCD, r = nwg % NXCD, xcd = wgid % NXCD, off = wgid / NXCD; wgid = (xcd < r ? xcd * (q + 1) : r * (q + 1) + (xcd - r) * q) + off; }
        const int nig = WGM * nN, gid = wgid / nig, fm = gid * WGM, gsz = (nM - fm) < WGM ? (nM - fm) : WGM;
        u.pm = fm + ((wgid % nig) % gsz); u.pn = (wgid % nig) / gsz; return true;
    }
    __device__ __forceinline__ void a_ready(const Unit&) const {}
    __device__ __forceinline__ void done(const Unit&) const {}
};
__device__ __forceinline__ unsigned cvt_pk_bf16(float lo, float hi) { unsigned r; asm volatile("v_cvt_pk_bf16_f32 %0, %1, %2" : "=v"(r) : "v"(lo), "v"(hi)); return r; }
typedef float f32x2 __attribute__((ext_vector_type(2)));
template <class Epi, class Sched, bool STAMP = false, bool GATHER = false, int ES = 2>
__device__ __forceinline__ void gemm_phase(PG8_LAS unsigned char* lds, const Gemm g, const Sched& S, const Epi& E, unsigned long long* stamps) {
    int tid_o_ = threadIdx.x; asm volatile("" : "+v"(tid_o_)); const int tid = tid_o_, wid = __builtin_amdgcn_readfirstlane(tid >> 6), lane = tid & 63, wr = wid >> 2, wc = wid & 3, fr = lane & 15, fq = lane >> 4;
    const int K = g.K, nt = K * ES / (BK * 2);
    int ts_lo = 0, ts_hi = 0, nts = 0; const unsigned long long rt_entry = STAMP ? (unsigned long long)wall_clock64() : 0ull;
#define PG8_STAMP() do { if (STAMP && wid == 0 && nts < 64) { const unsigned long long _c = (unsigned long long)clock64(); \
        ts_lo = (lane == nts) ? (int)(unsigned)_c : ts_lo; ts_hi = (lane == nts) ? (int)(unsigned)(_c >> 32) : ts_hi; ++nts; } } while (0)
    PG8_STAMP();
    unsigned voffA[2], voffB[2]; int rA_[2]; unsigned cA_[2];
#pragma unroll
    for (int i = 0; i < 2; ++i) { int R, C; stage_rc(tid * 16 + i * 8192, R, C); C *= 2; const int Rb = Epi::PERM ? ((R & ~31) + perm32(R & 31)) : R;
        voffA[i] = (unsigned)(R * K * ES + C); voffB[i] = (unsigned)(Rb * K * ES + C); rA_[i] = R; cA_[i] = (unsigned)C; }
    unsigned gA[2][2], v2_[2][2];
#define PG8_ROWS(u, dst) do { _Pragma("unroll") for (int h_ = 0; h_ < 2; ++h_) _Pragma("unroll") for (int i_ = 0; i_ < 2; ++i_) { const int as_ = g.rows[(u).pm * BM + h_ * HALF + rA_[i_]]; \
        dst[h_][i_] = (unsigned)(as_ < 0 ? 0 : as_ >> 1) * (unsigned)(K * ES) + cA_[i_]; } } while (0)
    const size_t kstep = (size_t)(BK * 2);
    const size_t hstep = (size_t)HALF * K * ES;
    const size_t b64_ = (size_t)64 * K * ES;
    const size_t tstep = 2 * hstep;
    const unsigned ldsw = (unsigned)wid * 1024u;
    const int aoff = lds_byte(wr * 64 + fr, fq * 8), boff = lds_byte(wc * 32 + fr, fq * 8);
#define PG8_SA(b, h) (((b) * 2 + (h)) * HTB)
#define PG8_SB(b, h) ((4 + (b) * 2 + (h)) * HTB)
#define PG8_STAGE(bufoff, gbase, voff) do { _Pragma("unroll") for (int _i = 0; _i < 2; ++_i) { unsigned vo_ = (voff)[_i]; asm volatile("" : "+v"(vo_));     \
        __builtin_amdgcn_global_load_lds((const unsigned*)((const char*)(gbase) + vo_), (PG8_LAS unsigned*)(lds + (bufoff) + ldsw + _i * 8192), 16, 0, 0); } } while (0)
#define PG8_STAGEB(bufoff, gbase) do { unsigned vo_ = voffB[0]; asm volatile("" : "+v"(vo_));     \
        __builtin_amdgcn_global_load_lds((const unsigned*)((const char*)(gbase) + vo_), (PG8_LAS unsigned*)(lds + (bufoff) + ldsw), 16, 0, 0); \
        __builtin_amdgcn_global_load_lds((const unsigned*)((const char*)(gbase) + b64_ + vo_), (PG8_LAS unsigned*)(lds + (bufoff) + ldsw + 8192), 16, 0, 0); } while (0)
#define PG8_LDA(dst, b, h) do { _Pragma("unroll") for (int m = 0; m < 4; ++m) _Pragma("unroll") for (int k = 0; k < 2; ++k) dst[m][k] = *(const PG8_LAS bf16x8*)(lds + PG8_SA(b, h) + aoff + m * 2048 + k * 1024); } while (0)
#define PG8_LDB(dst, b, h) do { _Pragma("unroll") for (int n = 0; n < 2; ++n) _Pragma("unroll") for (int k = 0; k < 2; ++k) dst[n][k] = *(const PG8_LAS bf16x8*)(lds + PG8_SB(b, h) + boff + n * 2048 + k * 1024); } while (0)
#define PG8_CAT(f) __builtin_shufflevector(__builtin_bit_cast(i32x4, f[0]), __builtin_bit_cast(i32x4, f[1]), 0, 1, 2, 3, 4, 5, 6, 7)
#define PG8_MMA(ai, bj, At, Bt) do { __builtin_amdgcn_s_setprio(1); _Pragma("unroll") for (int m = 0; m < 4; ++m) _Pragma("unroll") for (int n = 0; n < 2; ++n) { \
        if constexpr (ES == 2) { _Pragma("unroll") for (int k = 0; k < 2; ++k) acc[ai][bj][m][n] = __builtin_amdgcn_mfma_f32_16x16x32_bf16(Bt[n][k], At[m][k], acc[ai][bj][m][n], 0, 0, 0); } \
        else { const i32x8 b8_ = PG8_CAT(Bt[n]), a8_ = PG8_CAT(At[m]); asm volatile("v_mfma_scale_f32_16x16x128_f8f6f4 %0, %1, %2, %0, %3, %3 op_sel_hi:[0,0,0]" : "+v"(acc[ai][bj][m][n]) : "v"(b8_), "v"(a8_), "v"(sc_)); } } __builtin_amdgcn_s_setprio(0); } while (0)
#define PG8_WAIT_V(n) asm volatile("s_waitcnt vmcnt(" #n ")" ::: "memory")
#define PG8_WAIT_L(n) asm volatile("s_waitcnt lgkmcnt(" #n ")" ::: "memory")
#define PG8_BAR __builtin_amdgcn_s_barrier()
#define PG8_SCHED __builtin_amdgcn_sched_barrier(0)
    const int sc_ = g.sc;
    Unit cur, nxt; int ui = 0;
    if (!S.next(0, cur)) return;
    f32x4 acc[2][2][4][2];
#pragma unroll
    for (int a = 0; a < 2; ++a)
#pragma unroll
        for (int b = 0; b < 2; ++b)
#pragma unroll
            for (int m = 0; m < 4; ++m)
#pragma unroll
                for (int n = 0; n < 2; ++n) acc[a][b][m][n] = (f32x4){0.f, 0.f, 0.f, 0.f};
    bf16x8 At[4][2], B0[2][2], B1[2][2];
    const char* cA = (const char*)g.A + (GATHER ? (size_t)0 : (size_t)cur.pm * tstep); const char* cB = (const char*)g.Bt + (size_t)cur.pn * tstep;
    S.a_ready(cur);
    if (GATHER) { PG8_ROWS(cur, gA); }
    const size_t hstepA = GATHER ? (size_t)0 : hstep;
#define PG8_VA(h) (GATHER ? gA[h] : voffA)
    PG8_STAGEB(PG8_SB(0, 0), cB); PG8_STAGE(PG8_SA(0, 0), cA, PG8_VA(0)); PG8_STAGEB(PG8_SB(0, 1), cB + hstep); PG8_STAGE(PG8_SA(0, 1), cA + hstepA, PG8_VA(1));
    if (wr == 1) PG8_BAR;
    PG8_WAIT_V(4); PG8_BAR;
    PG8_STAGEB(PG8_SB(1, 0), cB + kstep); PG8_STAGE(PG8_SA(1, 0), cA + kstep, PG8_VA(0)); PG8_STAGEB(PG8_SB(1, 1), cB + hstep + kstep);
    PG8_WAIT_V(6); PG8_BAR;
    PG8_STAMP();
    for (;;) {
        const bool has_next = S.next(ui + 1, nxt);
        if (GATHER && has_next && wid == 0) { unsigned lo_ = threadIdx.x; asm volatile("" : "+v"(lo_)); lo_ = (lo_ & 63u) * 16u;
            __builtin_amdgcn_global_load_lds((const unsigned*)((const char*)(g.rows + (size_t)nxt.pm * BM) + lo_), (PG8_LAS unsigned*)(lds + STAGE_BYTES + 4096 + ((ui + 1) & 1) * 1024), 16, 0, 0); }
        const char* nA = (has_next && !GATHER) ? (const char*)g.A + (size_t)nxt.pm * tstep : cA; const char* nB = has_next ? (const char*)g.Bt + (size_t)nxt.pn * tstep : cB;
        for (int t = 0; t < nt; t += 2) {
            const bool last = (t == nt - 2);
            const char* a1 = cA + (size_t)(t + 1) * kstep;
            const char* a2 = last ? nA : cA + (size_t)(t + 2) * kstep; const char* b2 = last ? nB : cB + (size_t)(t + 2) * kstep;
            const char* a3 = a2 + kstep; const char* b3 = b2 + kstep;
            if (last && has_next) S.a_ready(nxt);
            if (GATHER) { _Pragma("unroll") for (int h_ = 0; h_ < 2; ++h_) _Pragma("unroll") for (int i_ = 0; i_ < 2; ++i_) v2_[h_][i_] = gA[h_][i_]; }
            if (GATHER && last && has_next) { const PG8_LAS int* rl_ = (const PG8_LAS int*)(lds + STAGE_BYTES + 4096 + ((ui + 1) & 1) * 1024);
                int tq_ = threadIdx.x; asm volatile("" : "+v"(tq_));
                _Pragma("unroll") for (int i_ = 0; i_ < 2; ++i_) { int R_, C_; stage_rc(tq_ * 16 + i_ * 8192, R_, C_);
                    _Pragma("unroll") for (int h_ = 0; h_ < 2; ++h_) { const int as_ = rl_[h_ * HALF + R_]; v2_[h_][i_] = (unsigned)(as_ < 0 ? 0 : as_ >> 1) * (unsigned)(K * ES) + (unsigned)(C_ * 2); } } }
#define PG8_V2(h) (GATHER ? v2_[h] : voffA)
            PG8_LDB(B0, 0, 0); PG8_SCHED; PG8_LDA(At, 0, 0); PG8_STAGE(PG8_SA(1, 1), a1 + hstepA, PG8_VA(1));
            PG8_WAIT_L(8); PG8_BAR; PG8_WAIT_L(0); PG8_MMA(0, 0, At, B0); PG8_BAR; PG8_SCHED;
            PG8_LDB(B1, 0, 1); PG8_STAGEB(PG8_SB(0, 0), b2);
            PG8_BAR; PG8_WAIT_L(0); PG8_MMA(0, 1, At, B1); PG8_BAR;
            PG8_LDA(At, 0, 1); PG8_STAGE(PG8_SA(0, 0), a2, PG8_V2(0));
            PG8_BAR; PG8_WAIT_L(0); PG8_MMA(1, 0, At, B0); PG8_BAR; PG8_SCHED;
            PG8_STAGEB(PG8_SB(0, 1), b2 + hstep);
            PG8_WAIT_V(6); PG8_BAR; PG8_MMA(1, 1, At, B1); PG8_BAR;
            PG8_LDB(B0, 1, 0); PG8_SCHED; PG8_LDA(At, 1, 0); PG8_STAGE(PG8_SA(0, 1), a2 + hstepA, PG8_V2(1));
            PG8_WAIT_L(8); PG8_BAR; PG8_WAIT_L(0); PG8_MMA(0, 0, At, B0); PG8_BAR; PG8_SCHED;
            PG8_LDB(B1, 1, 1); PG8_STAGEB(PG8_SB(1, 0), b3);
            PG8_BAR; PG8_WAIT_L(0); PG8_MMA(0, 1, At, B1); PG8_BAR;
            PG8_LDA(At, 1, 1); PG8_STAGE(PG8_SA(1, 0), a3, PG8_V2(0));
            PG8_BAR; PG8_WAIT_L(0); PG8_MMA(1, 0, At, B0); PG8_BAR; PG8_SCHED;
            PG8_STAGEB(PG8_SB(1, 1), b3 + hstep);
            PG8_WAIT_V(6); PG8_BAR; PG8_MMA(1, 1, At, B1); PG8_BAR;
        }
        PG8_STAMP();
        if constexpr (ES == 1) asm volatile("s_nop 15\n\ts_nop 15\n\ts_nop 15" ::: "memory");
        if constexpr (!Epi::AFTER_DRAIN) { int te_ = threadIdx.x; asm volatile("" : "+v"(te_));
            E(acc, cur, __builtin_amdgcn_readfirstlane(te_ >> 8), __builtin_amdgcn_readfirstlane((te_ >> 6) & 3), te_ & 15, (te_ >> 4) & 3); S.done(cur); }
        PG8_STAMP();
        if (!has_next) break;
#pragma unroll
        for (int a = 0; a < 2; ++a)
#pragma unroll
            for (int b = 0; b < 2; ++b)
#pragma unroll
                for (int m = 0; m < 4; ++m)
#pragma unroll
                    for (int n = 0; n < 2; ++n) acc[a][b][m][n] = (f32x4){0.f, 0.f, 0.f, 0.f};
        cur = nxt; cA = nA; cB = nB; ++ui;
        if (GATHER) { _Pragma("unroll") for (int h_ = 0; h_ < 2; ++h_) _Pragma("unroll") for (int i_ = 0; i_ < 2; ++i_) gA[h_][i_] = v2_[h_][i_]; }
    }
    PG8_WAIT_V(0);
    if (wr == 0) PG8_BAR;
    PG8_BAR;
    if constexpr (Epi::AFTER_DRAIN) { E.fused(acc, cur, wr, wc, fr, fq, lds, wid, lane); S.done(cur); }
    PG8_STAMP();
    if (STAMP && wid == 0) { stamps[lane] = lane < nts ? (((unsigned long long)(unsigned)ts_hi << 32) | (unsigned)ts_lo) : 0ull;
        if (lane == 62) stamps[62] = rt_entry; if (lane == 63) stamps[63] = (unsigned long long)wall_clock64(); }
#undef PG8_STAMP
#undef PG8_SA
#undef PG8_SB
#undef PG8_STAGE
#undef PG8_STAGEB
#undef PG8_LDA
#undef PG8_LDB
#undef PG8_MMA
#undef PG8_CAT
#undef PG8_WAIT_V
#undef PG8_WAIT_L
#undef PG8_BAR
#undef PG8_SCHED
#undef PG8_ROWS
#undef PG8_VA
#undef PG8_V2
}
}

namespace mk {
#define MLAS __attribute__((address_space(3)))
typedef unsigned short bf16_t;
typedef float f32x4 __attribute__((ext_vector_type(4)));
typedef unsigned u32x4 __attribute__((ext_vector_type(4)));
typedef unsigned u32x2 __attribute__((ext_vector_type(2)));

constexpr int D = 1024, NB = 16, SEQ = 4096, LC = 256, TL = NB * SEQ, TC = NB * LC, TT = TL + TC;
constexpr int INC = 4096, NE = 32, DFF = 512, NCH = 34, PMAX = 147456, NT = 512;
constexpr int LDS_BYTES = 150 * 1024, LDS_CTL = LDS_BYTES - 256;
constexpr int C_QA = 0, C_KA = 512, C_VA = 1024, C_QB = 1536, C_KB = 2048, C_VB = 2560, C_GF = 3072, C_GB = 3584;

constexpr size_t al256(size_t x) { return (x + 255) & ~(size_t)255; }
constexpr size_t WS_BAR = 0;
constexpr size_t WS_CNT = 16384;
constexpr size_t WS_ZERO_BYTES = 16384 + 16384;
constexpr size_t WS_MOD = WS_ZERO_BYTES;
constexpr size_t WS_WIN = al256(WS_MOD + (size_t)2 * 17 * 6144 * 4);
constexpr size_t WS_WOUT = WS_WIN + (size_t)2 * 4096 * 1024 * 2;
constexpr size_t WS_WGU = WS_WOUT + (size_t)2 * 1024 * 1024 * 2;
constexpr size_t WS_WDN = WS_WGU + (size_t)32 * 1024 * 1024 * 2;
constexpr size_t WS_CTX = WS_WDN + (size_t)32 * 1024 * 512 * 2;
constexpr size_t WS_H = WS_CTX + (size_t)TC * D * 4;
constexpr size_t WS_PROJ = WS_H + (size_t)TT * D * 2;
constexpr size_t WS_XS = WS_PROJ;
constexpr size_t WS_ACT = WS_PROJ + (size_t)PMAX * D * 2;
constexpr size_t WS_XB = WS_PROJ + (size_t)TT * INC * 2;
constexpr size_t WS_ST = WS_PROJ + (size_t)TT * INC * 2;
constexpr size_t WS_KC = WS_ST;
constexpr size_t WS_VT = WS_KC + (size_t)128 * 4096 * 64 * 2;
constexpr size_t WS_KCC = WS_VT + (size_t)128 * 4096 * 64 * 2;
constexpr size_t WS_VTC = WS_KCC + (size_t)128 * 256 * 64 * 2;
static_assert(WS_VTC + (size_t)128 * 256 * 64 * 2 <= WS_ST + (size_t)NB * 4 * 2 * NCH * 16384 * 2, "NA operand copies fit in the state region");
constexpr size_t WS_TOKE = WS_ST + (size_t)NB * 4 * 2 * NCH * 16384 * 2;
constexpr size_t WS_TOKR = WS_TOKE + (size_t)TT * 2 * 4;
constexpr size_t WS_TOKW = WS_TOKR + (size_t)TT * 2 * 4;
constexpr size_t WS_RINFO = WS_TOKW + (size_t)TT * 2 * 4;
constexpr size_t WS_RW = WS_RINFO + (size_t)PMAX * 4;
constexpr size_t WS_BLKE = WS_RW + (size_t)PMAX * 4;
constexpr size_t WS_RWT = WS_BLKE + 4096;
constexpr size_t WS_BLKB = WS_RWT + (size_t)2 * 32 * 1024 * 2;
constexpr size_t WS_ROPE = WS_BLKB + (size_t)1024 * 32 * 4;
constexpr size_t WS_END = WS_ROPE + (size_t)64 * 32 * 8;
static_assert(WS_ACT + (size_t)PMAX * DFF * 2 <= WS_ST && WS_XB == WS_ST && (size_t)TL * D * 2 <= (size_t)NB * 4 * 2 * NCH * 16384 * 2, "ys | act fit in the proj region, xb in the state region");
static_assert((size_t)TT * 2 * D * 2 <= (size_t)PMAX * D * 2, "y2 fits in xs region");
static_assert(WS_END <= (size_t)1 << 30, "workspace must fit in 1 GiB");

struct Args {
    const float* x; const float* c; const float* ctx; const float* c_ctx; const float* ada_w; const float* ada_b;
    const float* norm_mix_w; const float* norm_ffn_w; const float* w_in; const float* na_q_norm; const float* na_k_norm;
    const float* na_rpb; const float* ret_decay; const float* w_out; const float* router_w; const float* router_bias;
    const float* w_gate; const float* w_up; const float* w_down;
    float* out; unsigned char* ws; int ph_lo, ph_hi;
};

#define LDS_BARRIER() do { asm volatile("s_waitcnt lgkmcnt(0)" ::: "memory"); __builtin_amdgcn_s_barrier(); asm volatile("" ::: "memory"); } while (0)
__device__ __forceinline__ int otid() { int t = threadIdx.x; asm volatile("" : "+v"(t)); return t; }
__device__ __forceinline__ float bf2f(bf16_t v) { return __uint_as_float(((unsigned)v) << 16); }
__device__ __forceinline__ bf16_t f2bf(float f) { unsigned u = __float_as_uint(f); u += 0x7FFFu + ((u >> 16) & 1u); return (bf16_t)(u >> 16); }
typedef float f32x2_t __attribute__((ext_vector_type(2)));
typedef __bf16 bf16x2_t __attribute__((ext_vector_type(2)));
__device__ __forceinline__ unsigned pack2(float lo, float hi) { const f32x2_t v = {lo, hi}; return __builtin_bit_cast(unsigned, __builtin_convertvector(v, bf16x2_t)); }
__device__ __forceinline__ unsigned pack4_fp8(float a, float b, float c, float d) {
    a = __builtin_amdgcn_fmed3f(a, -448.0f, 448.0f); b = __builtin_amdgcn_fmed3f(b, -448.0f, 448.0f); c = __builtin_amdgcn_fmed3f(c, -448.0f, 448.0f); d = __builtin_amdgcn_fmed3f(d, -448.0f, 448.0f);
    int p = __builtin_amdgcn_cvt_pk_fp8_f32(a, b, 0, false); p = __builtin_amdgcn_cvt_pk_fp8_f32(c, d, p, true); return (unsigned)p; }
constexpr float WG8_SCALE = 64.0f, WU8_SCALE = 512.0f, WDN8_SCALE = 32.0f;
constexpr int SC_MOE1 = 0x7c7c7c7c, SC_MOE2 = 0x7b7b7b7b, SC_IN8 = 0x7c7c7c7c;
constexpr float WIN8_SCALE = 64.0f;
constexpr size_t WS_WIN8 = WS_WGU + (size_t)32 * 1024 * 1024;
#ifndef IN_FP8_MASK
#define IN_FP8_MASK 0xFFFFu
#endif
constexpr unsigned IN_TILES_BF16 = 0xFEDC7610u, IN_TILES_FP8 = 0xBA985432u;
__device__ __forceinline__ bool in_tile_fp8(int pn) { return (IN_FP8_MASK >> pn) & 1u; }
__device__ __forceinline__ float lo16(unsigned w) { return __uint_as_float(w << 16); }
__device__ __forceinline__ float hi16(unsigned w) { return __uint_as_float(w & 0xffff0000u); }
__device__ __forceinline__ float siluf(float v) { return v * __builtin_amdgcn_rcpf(1.0f + __builtin_amdgcn_exp2f(-1.4426950408889634f * v)); }
__device__ __forceinline__ float wave_sum(float v) {
#pragma unroll
    for (int o = 32; o >= 1; o >>= 1) v += __shfl_xor(v, o);
    return v;
}

typedef short bf16x8 __attribute__((ext_vector_type(8)));
typedef float f32x16 __attribute__((ext_vector_type(16)));
__device__ __forceinline__ unsigned off_b(unsigned row, unsigned ch) { return 256u * row + 16u * (ch ^ (((row & 3) << 2) | ((row >> 2) & 3))); }
__device__ __forceinline__ unsigned tr_addr(unsigned row0, unsigned c, unsigned lane) { const unsigned blk = (lane >> 4) & 1, q = (lane & 15) >> 2, p = lane & 3; return off_b(row0 + q, 4 * c + 2 * blk + (p >> 1)) + 8 * (p & 1); }
__device__ __forceinline__ bf16x8 mkfrag(u32x2 lo, u32x2 hi) { const u32x4 w = {lo.x, lo.y, hi.x, hi.y}; return __builtin_bit_cast(bf16x8, w); }
__device__ __forceinline__ int st_frag_idx(int d, int e) { return (((d >> 5) * 4 + (e >> 5)) * 64 + (e & 31) + 32 * ((d >> 2) & 1)) * 16 + (d & 3) + 4 * ((d & 31) >> 3); }
__device__ __forceinline__ const float* modp(const Args& a, int l, int r, int k6) { return (const float*)(a.ws + WS_MOD) + ((size_t)l * 17 + r) * 6144 + k6 * 1024; }

__device__ __forceinline__ bool cvt_is8(bool with_dense, int t) { return !(with_dense && t < 2560) || (t < 2048 && in_tile_fp8(((t & 63) * 64) >> 8)); }
__device__ __forceinline__ void cvt_addr(const Args& a, bool with_dense, int le, int t, int tid, const float*& lp, bf16_t*& sp) {
    const float* src; bf16_t* dst; int ldn, ldk, k0, n0, nd0;
    if (with_dense && t < 2560) {
        if (t < 2048) { const int l = t >> 10, tt = t & 1023; k0 = (tt >> 6) * 64; n0 = (tt & 63) * 64; nd0 = n0; src = a.w_in + (size_t)l * D * INC; ldn = INC; ldk = D;
            dst = in_tile_fp8(n0 >> 8) ? (bf16_t*)(a.ws + WS_WIN8 + (size_t)l * INC * D) : (bf16_t*)(a.ws + WS_WIN) + (size_t)l * INC * D; }
        else { const int t2 = t - 2048, l = t2 >> 8, tt = t2 & 255; k0 = (tt >> 4) * 64; n0 = (tt & 15) * 64; nd0 = n0; src = a.w_out + (size_t)l * D * D; ldn = D; dst = (bf16_t*)(a.ws + WS_WOUT) + (size_t)l * D * D; ldk = D; }
    } else {
        const int te = with_dense ? t - 2560 : t, which = te >> 12, tt = te & 4095, e = tt >> 7, r = tt & 127;
        if (which < 2) { k0 = (r >> 3) * 64; n0 = (r & 7) * 64; nd0 = (n0 >> 7) * 256 + which * 128 + (n0 & 127); src = (which == 0 ? a.w_gate : a.w_up) + ((size_t)le * NE + e) * D * DFF; ldn = DFF; dst = (bf16_t*)(a.ws + WS_WGU + (size_t)e * 1024 * D); ldk = D; }
        else { k0 = (r >> 4) * 64; n0 = (r & 15) * 64; nd0 = n0; src = a.w_down + ((size_t)le * NE + e) * DFF * D; ldn = D; dst = (bf16_t*)(a.ws + WS_WDN + (size_t)e * 1024 * DFF); ldk = DFF; }
    }
    lp = src + (size_t)(k0 + (tid >> 3)) * ldn + n0 + (tid & 7) * 8;
    const size_t so = (size_t)(nd0 + (tid >> 3)) * ldk + k0 + (tid & 7) * 8;
    sp = cvt_is8(with_dense, t) ? (bf16_t*)((unsigned char*)dst + so) : dst + so;
}
__device__ __forceinline__ void convert_weights(const Args& a, bool with_dense, int le, MLAS unsigned char* lds, int bid, int nb) {
    MLAS float* tl = (MLAS float*)lds; const int tid = otid();
    const int N = (with_dense ? 2560 : 0) + 3 * 4096;
    const float* lp; bf16_t* sp;
    f32x4 v0 = {0.f, 0.f, 0.f, 0.f}, v1 = v0;
    if (bid < N) { cvt_addr(a, with_dense, le, bid, tid, lp, sp); v0 = *(const f32x4*)lp; v1 = *(const f32x4*)(lp + 4); }
    for (int t = bid; t < N; t += nb) {
        cvt_addr(a, with_dense, le, t, tid, lp, sp);
        LDS_BARRIER();
        { const int kk = tid >> 3, nn0 = (tid & 7) * 8;
#pragma unroll
          for (int j = 0; j < 4; ++j) { tl[kk * 65 + nn0 + j] = v0[j]; tl[kk * 65 + nn0 + 4 + j] = v1[j]; } }
        { const int tn = t + nb < N ? t + nb : t; const float* lpn; bf16_t* spn; cvt_addr(a, with_dense, le, tn, tid, lpn, spn); (void)spn; v0 = *(const f32x4*)lpn; v1 = *(const f32x4*)(lpn + 4); }
        LDS_BARRIER();
        { const int n = tid >> 3, kc = (tid & 7) * 8;
          if (!cvt_is8(with_dense, t)) { u32x4 w;
            w.x = pack2(tl[(kc + 0) * 65 + n], tl[(kc + 1) * 65 + n]); w.y = pack2(tl[(kc + 2) * 65 + n], tl[(kc + 3) * 65 + n]);
            w.z = pack2(tl[(kc + 4) * 65 + n], tl[(kc + 5) * 65 + n]); w.w = pack2(tl[(kc + 6) * 65 + n], tl[(kc + 7) * 65 + n]);
            *(u32x4*)sp = w; }
          else { u32x2 w;
            const int wh_ = (with_dense ? t - 2560 : t) >> 12; const float ws = (with_dense && t < 2560) ? WIN8_SCALE : wh_ == 0 ? WG8_SCALE : wh_ == 1 ? WU8_SCALE : WDN8_SCALE;
            w.x = pack4_fp8(ws * tl[(kc + 0) * 65 + n], ws * tl[(kc + 1) * 65 + n], ws * tl[(kc + 2) * 65 + n], ws * tl[(kc + 3) * 65 + n]);
            w.y = pack4_fp8(ws * tl[(kc + 4) * 65 + n], ws * tl[(kc + 5) * 65 + n], ws * tl[(kc + 6) * 65 + n], ws * tl[(kc + 7) * 65 + n]);
            *(u32x2*)sp = w; } }
    }
    __syncthreads();
}
__device__ __forceinline__ void convert_small(const Args& a, int bid, int nb) {
    const int tid = otid();
    if (bid == nb - 2) { float* rt = (float*)(a.ws + WS_ROPE);
        for (int i = tid; i < 64 * 32; i += NT) { const float ang = (float)(i >> 5) * exp2f(-(float)(i & 31) * (13.287712379549449f / 32.0f)); float sn, cs; sincosf(ang, &sn, &cs); rt[2 * i] = cs; rt[2 * i + 1] = sn; } }
    if (bid == nb - 1) { bf16_t* rh = (bf16_t*)(a.ws + WS_RWT); bf16_t* rl = rh + 32 * 1024;
        for (int i = tid; i < 32 * 1024; i += NT) { const int e = i >> 10, k = i & 1023; const float w = a.router_w[k * NE + e]; const bf16_t hi = f2bf(w); rh[i] = hi; rl[i] = f2bf(w - bf2f(hi)); } }
}
__device__ __forceinline__ void compute_mod(const Args& a, MLAS unsigned char* lds, int bid, int nb) {
    MLAS float* sc = (MLAS float*)lds;
    MLAS float* red = (MLAS float*)(lds + 17 * 1024 * 4);
    const int tid = otid();
    if (bid >= 192) return;
    for (int i = tid; i < 17 * 1024; i += NT) { const int r = i >> 10, k = i & 1023; const float v = r < 16 ? a.c[r * 1024 + k] : a.c_ctx[k]; sc[i] = v / (1.0f + expf(-v)); }
    __syncthreads();
    for (int u = bid; u < 192; u += nb) {
        const int l = u / 96, n = (u % 96) * 64 + (tid & 63), kp = tid >> 6;
        float acc[17];
#pragma unroll
        for (int r = 0; r < 17; ++r) acc[r] = 0.f;
        const float* w = a.ada_w + (size_t)l * D * 6144 + n;
        for (int k = kp * 128; k < kp * 128 + 128; ++k) { const float wv = w[(size_t)k * 6144];
#pragma unroll
            for (int r = 0; r < 17; ++r) acc[r] += sc[r * 1024 + k] * wv; }
#pragma unroll
        for (int r = 0; r < 17; ++r) red[(kp * 17 + r) * 64 + (tid & 63)] = acc[r];
        __syncthreads();
        for (int i = tid; i < 17 * 64; i += NT) { const int r = i >> 6, cc = i & 63, nn = (u % 96) * 64 + cc; float s = a.ada_b[l * 6144 + nn];
#pragma unroll
            for (int p = 0; p < 8; ++p) s += red[(p * 17 + r) * 64 + cc];
            ((float*)(a.ws + WS_MOD))[((size_t)l * 17 + r) * 6144 + nn] = s; }
        __syncthreads();
    }
}

__device__ __forceinline__ void load_row_f32(const float* src, int e0, int e1, float (&v)[16]) {
    const f32x4 x0 = *(const f32x4*)(src + e0), x1 = *(const f32x4*)(src + e0 + 4), x2 = *(const f32x4*)(src + e1), x3 = *(const f32x4*)(src + e1 + 4);
#pragma unroll
    for (int j = 0; j < 4; ++j) { v[j] = x0[j]; v[4 + j] = x1[j]; v[8 + j] = x2[j]; v[12 + j] = x3[j]; }
}
__device__ __forceinline__ void load_row_bf16(const bf16_t* src, int e0, int e1, float (&v)[16]) {
    const u32x4 w0 = *(const u32x4*)(src + e0), w1 = *(const u32x4*)(src + e1);
#pragma unroll
    for (int j = 0; j < 4; ++j) { v[2 * j] = lo16(w0[j]); v[2 * j + 1] = hi16(w0[j]); v[8 + 2 * j] = lo16(w1[j]); v[8 + 2 * j + 1] = hi16(w1[j]); }
}
__device__ __forceinline__ void moe_combine(const bf16_t* ys, int2 pp, float2 ww, int i, const float (&mg)[16], int e0, int e1, float (&v)[16]) {
    const int p0 = __builtin_amdgcn_readlane(pp.x, i), p1 = __builtin_amdgcn_readlane(pp.y, i);
    const float w0 = __uint_as_float(__builtin_amdgcn_readlane(__float_as_uint(ww.x), i)), w1 = __uint_as_float(__builtin_amdgcn_readlane(__float_as_uint(ww.y), i));
    const bf16_t* ya = ys + (size_t)p0 * D; const bf16_t* yb = ys + (size_t)p1 * D;
    const u32x4 a0 = *(const u32x4*)(ya + e0), a1 = *(const u32x4*)(ya + e1), b0 = *(const u32x4*)(yb + e0), b1 = *(const u32x4*)(yb + e1);
#pragma unroll
    for (int j = 0; j < 4; ++j) {
        v[2 * j] += mg[2 * j] * (w0 * lo16(a0[j]) + w1 * lo16(b0[j])); v[2 * j + 1] += mg[2 * j + 1] * (w0 * hi16(a0[j]) + w1 * hi16(b0[j]));
        v[8 + 2 * j] += mg[8 + 2 * j] * (w0 * lo16(a1[j]) + w1 * lo16(b1[j])); v[8 + 2 * j + 1] += mg[8 + 2 * j + 1] * (w0 * hi16(a1[j]) + w1 * hi16(b1[j])); }
}
__device__ __forceinline__ unsigned char* h8_of(const Args& a) { return (unsigned char*)a.out + (size_t)TL * D * 2; }
__device__ __forceinline__ void phase_norm1(const Args& a, int l, int bid, int nb) {
    const int tid = otid(), lane = tid & 63, wave = __builtin_amdgcn_readfirstlane(tid >> 6);
    const int e0 = lane * 8, e1 = 512 + lane * 8;
    float wn[16];
    { const float* w = a.norm_mix_w + l * D;
#pragma unroll
      for (int j = 0; j < 8; ++j) { wn[j] = w[e0 + j]; wn[8 + j] = w[e1 + j]; } }
    float msc[16], msh[16], mg[16]; int cur_r = -1;
    bf16_t* hb = (bf16_t*)(a.ws + WS_H);
    const bf16_t* y2 = (const bf16_t*)(a.ws + WS_XS);
    const int rper = (TT + nb * 8 - 1) / (nb * 8), row_lo = (bid * 8 + wave) * rper, row_hi = min(row_lo + rper, TT);
    int2 pp = {0, 0}; float2 ww = {0.f, 0.f};
    if (l > 0 && row_lo + lane < row_hi) { pp = *(const int2*)((const int*)(a.ws + WS_TOKR) + (size_t)(row_lo + lane) * 2); ww = *(const float2*)((const float*)(a.ws + WS_TOKW) + (size_t)(row_lo + lane) * 2); }
    for (int row = row_lo; row < row_hi; ++row) {
        const int r = row < TL ? row / SEQ : 16;
        if (r != cur_r) { cur_r = r; const float* sh = modp(a, l, r, 0); const float* sc = modp(a, l, r, 1);
#pragma unroll
            for (int j = 0; j < 8; ++j) { msh[j] = sh[e0 + j]; msh[8 + j] = sh[e1 + j]; msc[j] = 1.0f + sc[e0 + j]; msc[8 + j] = 1.0f + sc[e1 + j]; }
            if (l > 0) { const float* g = modp(a, l - 1, r, 5);
#pragma unroll
                for (int j = 0; j < 8; ++j) { mg[j] = g[e0 + j]; mg[8 + j] = g[e1 + j]; } } }
        float v[16];
        if (l == 0) load_row_f32(row < TL ? a.x + (size_t)row * D : a.ctx + (size_t)(row - TL) * D, e0, e1, v);
        else if (row < TL) load_row_bf16((const bf16_t*)(a.ws + WS_XB) + (size_t)row * D, e0, e1, v);
        else load_row_f32((const float*)(a.ws + WS_CTX) + (size_t)(row - TL) * D, e0, e1, v);
        if (l > 0) {
            moe_combine(y2, pp, ww, row - row_lo, mg, e0, e1, v);
            if (row < TL) { bf16_t* dst = (bf16_t*)a.out + (size_t)row * D;
                *(u32x4*)(dst + e0) = (u32x4){pack2(v[0], v[1]), pack2(v[2], v[3]), pack2(v[4], v[5]), pack2(v[6], v[7])};
                *(u32x4*)(dst + e1) = (u32x4){pack2(v[8], v[9]), pack2(v[10], v[11]), pack2(v[12], v[13]), pack2(v[14], v[15])}; }
        }
        float ss = 0.f;
#pragma unroll
        for (int j = 0; j < 16; ++j) ss += v[j] * v[j];
        ss = wave_sum(ss);
        const float rs = rsqrtf(ss * (1.0f / D) + 1e-6f);
        float y[16];
#pragma unroll
        for (int j = 0; j < 16; ++j) y[j] = v[j] * rs * wn[j] * msc[j] + msh[j];
        if (IN_FP8_MASK != 0xFFFFu) { bf16_t* hp = hb + (size_t)row * D;
        *(u32x4*)(hp + e0) = (u32x4){pack2(y[0], y[1]), pack2(y[2], y[3]), pack2(y[4], y[5]), pack2(y[6], y[7])};
        *(u32x4*)(hp + e1) = (u32x4){pack2(y[8], y[9]), pack2(y[10], y[11]), pack2(y[12], y[13]), pack2(y[14], y[15])}; }
        unsigned char* hp8 = h8_of(a) + (size_t)row * D;
        *(u32x2*)(hp8 + e0) = (u32x2){pack4_fp8(y[0], y[1], y[2], y[3]), pack4_fp8(y[4], y[5], y[6], y[7])};
        *(u32x2*)(hp8 + e1) = (u32x2){pack4_fp8(y[8], y[9], y[10], y[11]), pack4_fp8(y[12], y[13], y[14], y[15])};
    }
}
__device__ __forceinline__ void phase_final(const Args& a, int bid, int nb) {
    const int tid = otid(), lane = tid & 63, wave = __builtin_amdgcn_readfirstlane(tid >> 6);
    const int e0 = lane * 8, e1 = 512 + lane * 8;
    float mg[16]; int cur_r = -1;
    const bf16_t* y2 = (const bf16_t*)(a.ws + WS_XS);
    const int rper = (TL + nb * 8 - 1) / (nb * 8), row_lo = (bid * 8 + wave) * rper, row_hi = min(row_lo + rper, TL);
    int2 pp = {0, 0}; float2 ww = {0.f, 0.f};
    if (row_lo + lane < row_hi) { pp = *(const int2*)((const int*)(a.ws + WS_TOKR) + (size_t)(row_lo + lane) * 2); ww = *(const float2*)((const float*)(a.ws + WS_TOKW) + (size_t)(row_lo + lane) * 2); }
    for (int row = row_lo; row < row_hi; ++row) {
        const int r = row / SEQ;
        if (r != cur_r) { cur_r = r; const float* g = modp(a, 1, r, 5);
#pragma unroll
            for (int j = 0; j < 8; ++j) { mg[j] = g[e0 + j]; mg[8 + j] = g[e1 + j]; } }
        float* src = a.out + (size_t)row * D;
        float v[16];
        load_row_bf16((const bf16_t*)(a.ws + WS_XB) + (size_t)row * D, e0, e1, v);
        moe_combine(y2, pp, ww, row - row_lo, mg, e0, e1, v);
        *(f32x4*)(src + e0) = (f32x4){v[0], v[1], v[2], v[3]}; *(f32x4*)(src + e0 + 4) = (f32x4){v[4], v[5], v[6], v[7]};
        *(f32x4*)(src + e1) = (f32x4){v[8], v[9], v[10], v[11]}; *(f32x4*)(src + e1 + 4) = (f32x4){v[12], v[13], v[14], v[15]};
    }
}

constexpr int VP = 516;
__device__ __forceinline__ void phase_prep(const Args& a, int l, MLAS unsigned char* lds, int bid, int nb) {
    const int tid = otid(), lane = tid & 63, wave = tid >> 6;
    const bf16_t* proj = (const bf16_t*)(a.ws + WS_PROJ);
    MLAS bf16_t* Vs = (MLAS bf16_t*)lds;
    float wk[8];
    { const float* w = a.na_k_norm + l * 64 + (lane & 7) * 8;
#pragma unroll
      for (int j = 0; j < 8; ++j) wk[j] = w[j]; }
    for (int u = bid; u < TT / 64; u += nb) {
        const int R0 = u * 64; const bool lat = R0 < TL;
        const int b = lat ? R0 / SEQ : (R0 - TL) / LC, t0 = lat ? R0 % SEQ : (R0 - TL) % LC, tlen = lat ? SEQ : LC;
        bf16_t* kc = (bf16_t*)(a.ws + (lat ? WS_KC : WS_KCC)); bf16_t* vt = (bf16_t*)(a.ws + (lat ? WS_VT : WS_VTC));
        __syncthreads();
#pragma unroll
        for (int rr = 0; rr < 8; ++rr) {
            const int rl = wave * 8 + rr, row = R0 + rl, t = t0 + rl;
            const bf16_t* p = proj + (size_t)row * INC;
            const u32x4 kw = *(const u32x4*)(p + C_KA + lane * 8), vw = *(const u32x4*)(p + C_VA + lane * 8);
            float f[8];
#pragma unroll
            for (int j = 0; j < 4; ++j) { f[2 * j] = lo16(kw[j]); f[2 * j + 1] = hi16(kw[j]); }
            float ss = 0.f;
#pragma unroll
            for (int j = 0; j < 8; ++j) ss += f[j] * f[j];
            ss += __shfl_xor(ss, 1); ss += __shfl_xor(ss, 2); ss += __shfl_xor(ss, 4);
            const float rs = rsqrtf(ss * (1.0f / 64.0f) + 1e-6f);
            *(u32x4*)(kc + (((size_t)b * 8 + (lane >> 3)) * tlen + t) * 64 + (lane & 7) * 8) =
                (u32x4){pack2(f[0] * rs * wk[0], f[1] * rs * wk[1]), pack2(f[2] * rs * wk[2], f[3] * rs * wk[3]), pack2(f[4] * rs * wk[4], f[5] * rs * wk[5]), pack2(f[6] * rs * wk[6], f[7] * rs * wk[7])};
            *(MLAS u32x2*)(Vs + rl * VP + lane * 8) = (u32x2){vw.x, vw.y}; *(MLAS u32x2*)(Vs + rl * VP + lane * 8 + 4) = (u32x2){vw.z, vw.w};
        }
        __syncthreads();
#pragma unroll
        for (int i = 0; i < 8; ++i) { const int idx = tid + i * NT, d = idx & 63, tc = (idx >> 6) & 7, h = idx >> 9;
            const MLAS bf16_t* vp = Vs + (tc * 8) * VP + h * 64 + d;
            const u32x4 w = {(unsigned)vp[0] | ((unsigned)vp[VP] << 16), (unsigned)vp[2 * VP] | ((unsigned)vp[3 * VP] << 16), (unsigned)vp[4 * VP] | ((unsigned)vp[5 * VP] << 16), (unsigned)vp[6 * VP] | ((unsigned)vp[7 * VP] << 16)};
            const int tk = t0 + tc * 8;
            *(u32x4*)(vt + ((((size_t)b * 8 + h) * (tlen >> 4) + (tk >> 4)) * 64 + d) * 16 + (tk & 15)) = w; }
    }
}

__device__ __forceinline__ int chunk_row0(int b, int c) { return c < 2 ? TL + b * LC + c * 128 : b * SEQ + (c - 2) * 128; }
__device__ __forceinline__ size_t st_index(int b, int h, int dir, int c) { return ((((size_t)b * 4 + h) * 2 + dir) * NCH + c) * 16384; }
constexpr int RP = 136;
__device__ __forceinline__ void load_rope_pair(const bf16_t* p, int a2, int fc, int tok, const MLAS float* rope, float (&y1)[8], float (&y2)[8]) {
    const u32x4 w0 = *(const u32x4*)(p + (a2 * 8 + fc) * 8), w1 = *(const u32x4*)(p + (a2 * 8 + fc + 4) * 8);
#pragma unroll
    for (int j = 0; j < 4; ++j) { y1[2 * j] = lo16(w0[j]); y1[2 * j + 1] = hi16(w0[j]); y2[2 * j] = lo16(w1[j]); y2[2 * j + 1] = hi16(w1[j]); }
    if (tok >= 0) {
        const int pos = a2 == 0 ? (tok >> 6) : (tok & 63);
        const MLAS f32x4* tp = (const MLAS f32x4*)(rope + (pos * 32 + fc * 8) * 2);
#pragma unroll
        for (int q = 0; q < 4; ++q) { const f32x4 cs = tp[q];
            const float u0 = y1[2 * q] * cs[0] - y2[2 * q] * cs[1], v0 = y1[2 * q] * cs[1] + y2[2 * q] * cs[0];
            const float u1 = y1[2 * q + 1] * cs[2] - y2[2 * q + 1] * cs[3], v1 = y1[2 * q + 1] * cs[3] + y2[2 * q + 1] * cs[2];
            y1[2 * q] = u0; y2[2 * q] = v0; y1[2 * q + 1] = u1; y2[2 * q + 1] = v1; }
    }
}
__device__ __forceinline__ void rope_pair_regs(const u32x4 w0, const u32x4 w1, int a2, int fc, int tok, const MLAS float* rope, float (&y1)[8], float (&y2)[8]) {
#pragma unroll
    for (int j = 0; j < 4; ++j) { y1[2 * j] = lo16(w0[j]); y1[2 * j + 1] = hi16(w0[j]); y2[2 * j] = lo16(w1[j]); y2[2 * j + 1] = hi16(w1[j]); }
    if (tok >= 0) {
        const int pos = a2 == 0 ? (tok >> 6) : (tok & 63);
        const MLAS f32x4* tp = (const MLAS f32x4*)(rope + (pos * 32 + fc * 8) * 2);
#pragma unroll
        for (int q = 0; q < 4; ++q) { const f32x4 cs = tp[q];
            const float u0 = y1[2 * q] * cs[0] - y2[2 * q] * cs[1], v0 = y1[2 * q] * cs[1] + y2[2 * q] * cs[0];
            const float u1 = y1[2 * q + 1] * cs[2] - y2[2 * q + 1] * cs[3], v1 = y1[2 * q + 1] * cs[3] + y2[2 * q + 1] * cs[2];
            y1[2 * q] = u0; y2[2 * q] = v0; y1[2 * q + 1] = u1; y2[2 * q + 1] = v1; }
    }
}
__device__ __forceinline__ u32x4 pack8(const float (&y)[8], float sc) { return (u32x4){pack2(y[0] * sc, y[1] * sc), pack2(y[2] * sc, y[3] * sc), pack2(y[4] * sc, y[5] * sc), pack2(y[6] * sc, y[7] * sc)}; }
constexpr float RET_KSCALE = 0.08838834764831845f;
constexpr int LDS_ROPE = 98304;
__device__ __forceinline__ void phase_ret_a(const Args& a, int l, MLAS unsigned char* lds, int bid, int nb) {
    const int tid = otid(), lane = tid & 63, wave = __builtin_amdgcn_readfirstlane(tid >> 6);
    const bf16_t* proj = (const bf16_t*)(a.ws + WS_PROJ); bf16_t* st = (bf16_t*)(a.ws + WS_ST);
    const unsigned ldsb = (unsigned)(size_t)lds;
    const int dir = wave >> 2, dt = wave & 3, hh = lane >> 5;
    MLAS float* rope = (MLAS float*)(lds + LDS_ROPE);
    for (int i = tid; i < 64 * 32 * 2; i += NT) rope[i] = ((const float*)(a.ws + WS_ROPE))[i];
#define RA_LOAD(u_) do { const int b_ = (u_) / (NCH * 4), c_ = ((u_) >> 2) % NCH, h_ = (u_) & 3, row0_ = chunk_row0(b_, c_); _Pragma("unroll") for (int i = 0; i < 2; ++i) { const int idx = tid + i * NT, row = idx >> 3, ch0 = ((idx >> 2) & 1) * 8 + (idx & 3); \
        const bf16_t* src = proj + (size_t)(row0_ + row) * INC + h_ * 128; \
        raw[i][0] = *(const u32x4*)(src + C_KB + ch0 * 8); raw[i][1] = *(const u32x4*)(src + C_KB + (ch0 + 4) * 8); raw[i][2] = *(const u32x4*)(src + C_VB + ch0 * 8); raw[i][3] = *(const u32x4*)(src + C_VB + (ch0 + 4) * 8); } } while (0)
    u32x4 raw[2][4];
    if (bid < NB * NCH * 4) RA_LOAD(bid);
    LDS_BARRIER();
    for (int u = bid; u < NB * NCH * 4; u += nb) {
        const int b = u / (NCH * 4), c = (u >> 2) % NCH, h = u & 3;
        const float lgf = -expf(a.ret_decay[l * 8 + h]), lgb = -expf(a.ret_decay[l * 8 + 4 + h]);
        LDS_BARRIER();
#pragma unroll
        for (int i = 0; i < 2; ++i) { const int idx = tid + i * NT, row = idx >> 3, a2 = (idx >> 2) & 1, fc = idx & 3, ch0 = a2 * 8 + fc;
            float y1[8], y2[8];
            rope_pair_regs(raw[i][0], raw[i][1], a2, fc, c >= 2 ? (c - 2) * 128 + row : -1, rope, y1, y2);
            const float wf = __expf((float)(127 - row) * lgf) * RET_KSCALE, wb = __expf((float)row * lgb) * RET_KSCALE;
            const unsigned o0 = off_b(row, ch0), o1 = off_b(row, ch0 + 4);
            *(MLAS u32x4*)(lds + o0) = pack8(y1, wf); *(MLAS u32x4*)(lds + o1) = pack8(y2, wf);
            *(MLAS u32x4*)(lds + 32768 + o0) = pack8(y1, wb); *(MLAS u32x4*)(lds + 32768 + o1) = pack8(y2, wb);
            *(MLAS u32x4*)(lds + 65536 + o0) = raw[i][2]; *(MLAS u32x4*)(lds + 65536 + o1) = raw[i][3]; }
        { const int un_ = u + nb < NB * NCH * 4 ? u + nb : u; RA_LOAD(un_); }
        LDS_BARRIER();
        f32x16 acc[4];
#pragma unroll
        for (int et = 0; et < 4; ++et)
#pragma unroll
            for (int r = 0; r < 16; ++r) acc[et][r] = 0.f;
        unsigned aK[2], aV[4][2];
#pragma unroll
        for (int t = 0; t < 2; ++t) { aK[t] = ldsb + dir * 32768 + tr_addr(8 * hh + 4 * t, dt, lane);
#pragma unroll
            for (int et = 0; et < 4; ++et) aV[et][t] = ldsb + 65536 + tr_addr(8 * hh + 4 * t, et, lane); }
#pragma unroll
        for (int ks = 0; ks < 8; ++ks) {
            u32x2 r0, r1, r2, r3, r4, r5, r6, r7, r8, r9; const unsigned ko = ks * 4096;
            asm volatile("ds_read_b64_tr_b16 %0, %10\n\tds_read_b64_tr_b16 %1, %11\n\tds_read_b64_tr_b16 %2, %12\n\tds_read_b64_tr_b16 %3, %13\n\tds_read_b64_tr_b16 %4, %14\n\t"
                         "ds_read_b64_tr_b16 %5, %15\n\tds_read_b64_tr_b16 %6, %16\n\tds_read_b64_tr_b16 %7, %17\n\tds_read_b64_tr_b16 %8, %18\n\tds_read_b64_tr_b16 %9, %19\n\ts_waitcnt lgkmcnt(0)"
                         : "=&v"(r0), "=&v"(r1), "=&v"(r2), "=&v"(r3), "=&v"(r4), "=&v"(r5), "=&v"(r6), "=&v"(r7), "=&v"(r8), "=&v"(r9)
                         : "v"(aK[0] + ko), "v"(aK[1] + ko), "v"(aV[0][0] + ko), "v"(aV[0][1] + ko), "v"(aV[1][0] + ko), "v"(aV[1][1] + ko), "v"(aV[2][0] + ko), "v"(aV[2][1] + ko), "v"(aV[3][0] + ko), "v"(aV[3][1] + ko) : "memory");
            const bf16x8 A = mkfrag(r0, r1);
            acc[0] = __builtin_amdgcn_mfma_f32_32x32x16_bf16(A, mkfrag(r2, r3), acc[0], 0, 0, 0);
            acc[1] = __builtin_amdgcn_mfma_f32_32x32x16_bf16(A, mkfrag(r4, r5), acc[1], 0, 0, 0);
            acc[2] = __builtin_amdgcn_mfma_f32_32x32x16_bf16(A, mkfrag(r6, r7), acc[2], 0, 0, 0);
            acc[3] = __builtin_amdgcn_mfma_f32_32x32x16_bf16(A, mkfrag(r8, r9), acc[3], 0, 0, 0);
        }
        bf16_t* o = st + st_index(b, h, dir, c);
#pragma unroll
        for (int et = 0; et < 4; ++et) { bf16_t* p = o + ((dt * 4 + et) * 64 + lane) * 16;
            *(u32x4*)p = (u32x4){pack2(acc[et][0], acc[et][1]), pack2(acc[et][2], acc[et][3]), pack2(acc[et][4], acc[et][5]), pack2(acc[et][6], acc[et][7])};
            *(u32x4*)(p + 8) = (u32x4){pack2(acc[et][8], acc[et][9]), pack2(acc[et][10], acc[et][11]), pack2(acc[et][12], acc[et][13]), pack2(acc[et][14], acc[et][15])}; }
    }
#undef RA_LOAD
}
__device__ __forceinline__ void phase_scan(const Args& a, int l, int bid, int nb) {
    bf16_t* st = (bf16_t*)(a.ws + WS_ST);
#pragma unroll 1
    for (int idx = bid * NT + otid(); idx < NB * 4 * 2 * 2048; idx += nb * NT) {
        const int chain = idx >> 11, v8 = idx & 2047, dir = chain & 1, h = (chain >> 1) & 3;
        const float dec = expf(-128.0f * expf(a.ret_decay[l * 8 + dir * 4 + h]));
        bf16_t* p = st + (size_t)chain * NCH * 16384 + v8 * 8;
        float S[8];
#pragma unroll
        for (int j = 0; j < 8; ++j) S[j] = 0.f;
#pragma unroll 1
        for (int half = 0; half < 2; ++half) {
            u32x4 ls[NCH / 2];
#pragma unroll
            for (int i = 0; i < NCH / 2; ++i) { const int ii = half * (NCH / 2) + i, c = dir == 0 ? ii : (ii < 2 ? 1 - ii : NCH + 1 - ii); ls[i] = *(const u32x4*)(p + (size_t)c * 16384); }
#pragma unroll
            for (int i = 0; i < NCH / 2; ++i) { const int ii = half * (NCH / 2) + i, c = dir == 0 ? ii : (ii < 2 ? 1 - ii : NCH + 1 - ii);
                *(u32x4*)(p + (size_t)c * 16384) = (u32x4){pack2(S[0], S[1]), pack2(S[2], S[3]), pack2(S[4], S[5]), pack2(S[6], S[7])};
#pragma unroll
                for (int t = 0; t < 4; ++t) { S[2 * t] = S[2 * t] * dec + lo16(ls[i][t]); S[2 * t + 1] = S[2 * t + 1] * dec + hi16(ls[i][t]); } }
        }
    }
}
__device__ __forceinline__ void phase_ret_b(const Args& a, int l, MLAS unsigned char* lds, int bid, int nb) {
    const int tid = otid(), lane = tid & 63, wave = __builtin_amdgcn_readfirstlane(tid >> 6);
    const bf16_t* proj = (const bf16_t*)(a.ws + WS_PROJ); const bf16_t* st = (const bf16_t*)(a.ws + WS_ST); bf16_t* mix = (bf16_t*)(a.ws + WS_H);
    const unsigned ldsb = (unsigned)(size_t)lds;
    const int dir = wave >> 2, it = wave & 3, hh = lane >> 5, il = it * 32 + (lane & 31);
    const int c_lo = l == 0 ? 0 : 2, ncu = NCH - c_lo;
    MLAS float* rope = (MLAS float*)(lds + LDS_ROPE);
    for (int i = tid; i < 64 * 32 * 2; i += NT) rope[i] = ((const float*)(a.ws + WS_ROPE))[i];
#define RB_DECODE(u_, b_, c_, h_, row0_) const int b_ = (u_) / (ncu * 4), c_ = c_lo + ((u_) >> 2) % ncu, h_ = (u_) & 3, row0_ = chunk_row0(b_, c_)
#define RB_LOAD(u_) do { RB_DECODE(u_, b_, c_, h_, row0_); (void)c_; _Pragma("unroll") for (int i = 0; i < 2; ++i) { const int idx = tid + i * NT, row = idx >> 3, ch0 = ((idx >> 2) & 1) * 8 + (idx & 3); \
        const bf16_t* src = proj + (size_t)(row0_ + row) * INC + h_ * 128; \
        raw[i][0] = *(const u32x4*)(src + C_QB + ch0 * 8); raw[i][1] = *(const u32x4*)(src + C_QB + (ch0 + 4) * 8); raw[i][2] = *(const u32x4*)(src + C_KB + ch0 * 8); raw[i][3] = *(const u32x4*)(src + C_KB + (ch0 + 4) * 8); \
        raw[i][4] = *(const u32x4*)(src + C_VB + ch0 * 8); raw[i][5] = *(const u32x4*)(src + C_VB + (ch0 + 4) * 8); } } while (0)
    u32x4 raw[2][6];
    if (bid < NB * ncu * 4) RB_LOAD(bid);
    LDS_BARRIER();
    for (int u = bid; u < NB * ncu * 4; u += nb) {
        RB_DECODE(u, b, c, h, row0);
        const float lg = -expf(a.ret_decay[l * 8 + dir * 4 + h]);
        LDS_BARRIER();
#pragma unroll
        for (int i = 0; i < 2; ++i) { const int idx = tid + i * NT, row = idx >> 3, a2 = (idx >> 2) & 1, fc = idx & 3, ch0 = a2 * 8 + fc;
            const int tok = c >= 2 ? (c - 2) * 128 + row : -1;
            const unsigned o0 = off_b(row, ch0), o1 = off_b(row, ch0 + 4);
            float y1[8], y2[8];
            rope_pair_regs(raw[i][0], raw[i][1], a2, fc, tok, rope, y1, y2);
            *(MLAS u32x4*)(lds + o0) = pack8(y1, 1.0f); *(MLAS u32x4*)(lds + o1) = pack8(y2, 1.0f);
            rope_pair_regs(raw[i][2], raw[i][3], a2, fc, tok, rope, y1, y2);
            *(MLAS u32x4*)(lds + 32768 + o0) = pack8(y1, RET_KSCALE); *(MLAS u32x4*)(lds + 32768 + o1) = pack8(y2, RET_KSCALE);
            *(MLAS u32x4*)(lds + 65536 + o0) = raw[i][4]; *(MLAS u32x4*)(lds + 65536 + o1) = raw[i][5]; }
        LDS_BARRIER();
        f32x16 acc[4];
#pragma unroll
        for (int et = 0; et < 4; ++et)
#pragma unroll
            for (int r = 0; r < 16; ++r) acc[et][r] = 0.f;
        {
            const bf16_t* sp = st + st_index(b, h, dir, c) + lane * 16;
#pragma unroll
            for (int dt = 0; dt < 4; ++dt)
#pragma unroll
                for (int s2 = 0; s2 < 2; ++s2) {
                    const u32x2 q0 = *(const MLAS u32x2*)(lds + off_b(il, 4 * dt + 2 * s2) + 8 * hh), q1 = *(const MLAS u32x2*)(lds + off_b(il, 4 * dt + 2 * s2 + 1) + 8 * hh);
                    const bf16x8 Bq = mkfrag(q0, q1);
#pragma unroll
                    for (int et = 0; et < 4; ++et) { const bf16x8 A = __builtin_bit_cast(bf16x8, *(const u32x4*)(sp + (dt * 4 + et) * 1024 + 8 * s2));
                        acc[et] = __builtin_amdgcn_mfma_f32_32x32x16_bf16(A, Bq, acc[et], 0, 0, 0); }
                }
            const float qdec = __expf((float)(dir == 0 ? il + 1 : 128 - il) * lg);
#pragma unroll
            for (int et = 0; et < 4; ++et)
#pragma unroll
                for (int r = 0; r < 16; ++r) acc[et][r] *= qdec;
        }
        bf16x8 Qn[8];
#pragma unroll
        for (int ks = 0; ks < 8; ++ks) Qn[ks] = *(const MLAS bf16x8*)(lds + off_b(il, 2 * ks + hh));
        const int jt_lo = dir == 0 ? 0 : it, jt_hi = dir == 0 ? it : 3;
        for (int jt = jt_lo; jt <= jt_hi; ++jt) {
            f32x16 sc;
#pragma unroll
            for (int r = 0; r < 16; ++r) sc[r] = 0.f;
#pragma unroll
            for (int ks = 0; ks < 8; ++ks) { const bf16x8 A = *(const MLAS bf16x8*)(lds + 32768 + off_b(jt * 32 + (lane & 31), 2 * ks + hh));
                sc = __builtin_amdgcn_mfma_f32_32x32x16_bf16(A, Qn[ks], sc, 0, 0, 0); }
            unsigned pk[8];
#pragma unroll
            for (int r = 0; r < 16; r += 2) {
                const int j0 = jt * 32 + (r & 3) + 8 * (r >> 2) + 4 * hh, j1 = j0 + 1;
                const int d0 = dir == 0 ? il - j0 : j0 - il, d1 = dir == 0 ? il - j1 : j1 - il;
                const float p0 = d0 >= 0 ? sc[r] * __expf((float)d0 * lg) : 0.f, p1 = d1 >= 0 ? sc[r + 1] * __expf((float)d1 * lg) : 0.f;
                pk[r >> 1] = pack2(p0, p1);
            }
            const bf16x8 P0 = __builtin_bit_cast(bf16x8, (u32x4){pk[0], pk[1], pk[2], pk[3]}), P1 = __builtin_bit_cast(bf16x8, (u32x4){pk[4], pk[5], pk[6], pk[7]});
#pragma unroll
            for (int et = 0; et < 4; ++et) {
                u32x2 r0, r1, r2, r3;
                const unsigned a0 = ldsb + 65536 + tr_addr(jt * 32 + 4 * hh, et, lane), a1 = ldsb + 65536 + tr_addr(jt * 32 + 8 + 4 * hh, et, lane);
                const unsigned a2 = ldsb + 65536 + tr_addr(jt * 32 + 16 + 4 * hh, et, lane), a3 = ldsb + 65536 + tr_addr(jt * 32 + 24 + 4 * hh, et, lane);
                asm volatile("ds_read_b64_tr_b16 %0, %4\n\tds_read_b64_tr_b16 %1, %5\n\tds_read_b64_tr_b16 %2, %6\n\tds_read_b64_tr_b16 %3, %7\n\ts_waitcnt lgkmcnt(0)"
                             : "=&v"(r0), "=&v"(r1), "=&v"(r2), "=&v"(r3) : "v"(a0), "v"(a1), "v"(a2), "v"(a3) : "memory");
                acc[et] = __builtin_amdgcn_mfma_f32_32x32x16_bf16(mkfrag(r0, r1), P0, acc[et], 0, 0, 0);
                acc[et] = __builtin_amdgcn_mfma_f32_32x32x16_bf16(mkfrag(r2, r3), P1, acc[et], 0, 0, 0);
            }
        }
        u32x4 gfr[4], gbr[4];
        { const bf16_t* gp = proj + (size_t)(row0 + (tid >> 2)) * INC + h * 128;
#pragma unroll
          for (int k = 0; k < 4; ++k) { const int ch = (tid & 3) * 4 + k; gfr[k] = *(const u32x4*)(gp + C_GF + ch * 8); gbr[k] = *(const u32x4*)(gp + C_GB + ch * 8); } }
        float s1 = 0.f;
#pragma unroll
        for (int et = 0; et < 4; ++et)
#pragma unroll
            for (int r = 0; r < 16; ++r) s1 += acc[et][r];
        s1 += __shfl_xor(s1, 32);
        const float mean = s1 * (1.0f / 128.0f);
        float s2 = 0.f;
#pragma unroll
        for (int et = 0; et < 4; ++et)
#pragma unroll
            for (int r = 0; r < 16; ++r) { const float dlt = acc[et][r] - mean; s2 += dlt * dlt; }
        s2 += __shfl_xor(s2, 32);
        const float rstd = rsqrtf(s2 * (1.0f / 128.0f) + 1e-5f);
        LDS_BARRIER();
#pragma unroll
        for (int et = 0; et < 4; ++et)
#pragma unroll
            for (int g = 0; g < 4; ++g) {
                const u32x2 w = {pack2((acc[et][4 * g] - mean) * rstd, (acc[et][4 * g + 1] - mean) * rstd), pack2((acc[et][4 * g + 2] - mean) * rstd, (acc[et][4 * g + 3] - mean) * rstd)};
                *(MLAS u32x2*)(lds + dir * 32768 + off_b(il, 4 * et + g) + 8 * hh) = w; }
        { const int un_ = u + nb < NB * ncu * 4 ? u + nb : u; RB_LOAD(un_); }
        LDS_BARRIER();
        {
            const int i = tid >> 2, part = tid & 3;
            bf16_t* op = mix + (size_t)(row0 + i) * D + 512 + h * 128;
#pragma unroll
            for (int k = 0; k < 4; ++k) { const int ch = part * 4 + k;
                const u32x4 of = *(const MLAS u32x4*)(lds + off_b(i, ch)), ob = *(const MLAS u32x4*)(lds + 32768 + off_b(i, ch));
                const u32x4 gf = gfr[k], gb = gbr[k];
                u32x4 o;
#pragma unroll
                for (int t = 0; t < 4; ++t) o[t] = pack2(lo16(of[t]) * siluf(lo16(gf[t])) + lo16(ob[t]) * siluf(lo16(gb[t])), hi16(of[t]) * siluf(hi16(gf[t])) + hi16(ob[t]) * siluf(hi16(gb[t])));
                *(u32x4*)(op + ch * 8) = o; }
        }
    }
#undef RB_DECODE
#undef RB_LOAD
}

constexpr int NA_OP = 72;
__device__ __forceinline__ int perm16(int x) { return (x & 3) | ((x & 4) << 1) | ((x & 8) >> 1); }
__device__ __forceinline__ void phase_na(const Args& a, int l, MLAS unsigned char* lds, int bid, int nb) {
    const int tid = otid(), lane = tid & 63, wave = __builtin_amdgcn_readfirstlane(tid >> 6);
    const bf16_t* proj = (const bf16_t*)(a.ws + WS_PROJ); bf16_t* mix = (bf16_t*)(a.ws + WS_H);
    const bf16_t* KC = (const bf16_t*)(a.ws + WS_KC); const bf16_t* VT = (const bf16_t*)(a.ws + WS_VT);
    const bf16_t* KCC = (const bf16_t*)(a.ws + WS_KCC); const bf16_t* VTC = (const bf16_t*)(a.ws + WS_VTC);
    MLAS float* rpb = (MLAS float*)lds;
    MLAS bf16_t* ost = (MLAS bf16_t*)(lds + 8192) + wave * 64 * NA_OP;
    const int n_lat = NB * 8 * 8, n_ctx = l == 0 ? NB * 4 : 0;
    const int hh = lane >> 5, ql = lane & 31;
    for (int u0 = bid; u0 < n_lat + n_ctx; u0 += nb) {
        int u = u0;
        if (nb == 256 && u0 < n_lat) { const int x = bid & 7, j = bid >> 3, i = u0 >> 8; u = ((i * 32 + x * 4 + (j >> 3)) << 3) + (j & 7); }
        const bool is_ctx = u >= n_lat;
        const int v = is_ctx ? u - n_lat : u;
        const int b = is_ctx ? v >> 2 : v >> 6, h = is_ctx ? 2 * (v & 3) + (wave >> 2) : (v >> 3) & 7;
        const int r = (v & 7) * 8 + wave;
        const int qrow0 = is_ctx ? TL + b * LC + (wave & 3) * 64 : b * SEQ + r * 64;
        const size_t bh = (size_t)b * 8 + h;
        __syncthreads();
        if (!is_ctx) for (int i = tid; i < 15 * 128; i += NT) { const int dr = i >> 7, x = (i & 127) - 48; rpb[i] = (x >= 0 && x < 31) ? a.na_rpb[((size_t)l * 8 + h) * 465 + dr * 31 + x] * 1.4426950408889634f : 0.f; }
        __syncthreads();
        bf16x8 Qf[2][4];
#pragma unroll
        for (int qt = 0; qt < 2; ++qt) {
            u32x4 qw[4]; float ss = 0.f;
#pragma unroll
            for (int ks = 0; ks < 4; ++ks) { qw[ks] = *(const u32x4*)(proj + (size_t)(qrow0 + 32 * qt + ql) * INC + C_QA + h * 64 + 16 * ks + 8 * hh);
#pragma unroll
                for (int t = 0; t < 4; ++t) { const float x0 = lo16(qw[ks][t]), x1 = hi16(qw[ks][t]); ss += x0 * x0 + x1 * x1; } }
            ss += __shfl_xor(ss, 32);
            const float rs = rsqrtf(ss * (1.0f / 64.0f) + 1e-6f) * 0.18033688011112042f;
#pragma unroll
            for (int ks = 0; ks < 4; ++ks) { const f32x4 w0 = *(const f32x4*)(a.na_q_norm + l * 64 + 16 * ks + 8 * hh), w1 = *(const f32x4*)(a.na_q_norm + l * 64 + 16 * ks + 8 * hh + 4);
                const u32x4 o = {pack2(lo16(qw[ks][0]) * rs * w0[0], hi16(qw[ks][0]) * rs * w0[1]), pack2(lo16(qw[ks][1]) * rs * w0[2], hi16(qw[ks][1]) * rs * w0[3]),
                                 pack2(lo16(qw[ks][2]) * rs * w1[0], hi16(qw[ks][2]) * rs * w1[1]), pack2(lo16(qw[ks][3]) * rs * w1[2], hi16(qw[ks][3]) * rs * w1[3])};
                Qf[qt][ks] = __builtin_bit_cast(bf16x8, o); }
        }
        f32x16 O[2][2];
#pragma unroll
        for (int qt = 0; qt < 2; ++qt)
#pragma unroll
            for (int i = 0; i < 16; ++i) { O[qt][0][i] = 0.f; O[qt][1][i] = 0.f; }
        float lsum[2] = {0.f, 0.f};
        const int r0 = min(max(r - 4, 0), 56);
        const int kslot = 16 * (ql >> 4) + perm16(ql & 15);
        const bf16_t* kl = KC + (bh * SEQ + (size_t)(r0 + (ql >> 4)) * 64 + perm16(ql & 15)) * 64 + 8 * hh;
        const bf16_t* vl = VT + ((bh * 256 + (size_t)r0 * 4) * 64 + ql) * 16 + 8 * hh;
        const bf16_t* kx = KCC + (bh * LC + kslot) * 64 + 8 * hh;
        const bf16_t* vx = VTC + ((bh * 16) * 64 + ql) * 16 + 8 * hh;
#define NA_PTRS(t, kp, vp, vstep) do { if ((t) < 16) { const int ip_ = (t) >> 2, ct_ = (t) & 3; kp = kl + (size_t)(2 * ip_ * 64 + 16 * ct_) * 64; vp = vl + (2 * ip_ * 4 + ct_) * 1024; vstep = 4096; } \
        else { kp = kx + (size_t)(32 * ((t) - 16)) * 64; vp = vx + ((t) - 16) * 2048; vstep = 1024; } } while (0)
#define NA_LOADS(kp, vp, vstep, Kd, Vd) do { _Pragma("unroll") for (int ks_ = 0; ks_ < 4; ++ks_) Kd[ks_] = *(const u32x4*)(kp + 16 * ks_); \
        Vd[0] = *(const u32x4*)(vp); Vd[1] = *(const u32x4*)(vp + vstep); Vd[2] = *(const u32x4*)(vp + 512); Vd[3] = *(const u32x4*)(vp + 512 + vstep); } while (0)
        const int t_lo = is_ctx ? 16 : 0;
        u32x4 Kn[4], Vn[4];
        { const bf16_t* kp; const bf16_t* vp; int vstep; NA_PTRS(t_lo, kp, vp, vstep); NA_LOADS(kp, vp, vstep, Kn, Vn); }
#pragma unroll 1
        for (int t = t_lo; t < 24; ++t) {
            u32x4 Kc[4], Vc[4];
#pragma unroll
            for (int i = 0; i < 4; ++i) { Kc[i] = Kn[i]; Vc[i] = Vn[i]; }
            if (t + 1 < 24) { const bf16_t* kp; const bf16_t* vp; int vstep; NA_PTRS(t + 1, kp, vp, vstep); NA_LOADS(kp, vp, vstep, Kn, Vn); }
            const int ip = t >> 2, ct = t & 3;
#pragma unroll
            for (int qt = 0; qt < 2; ++qt) {
                if (t < 16 && (unsigned)(ct - qt) > 2u) continue;
                f32x16 sc;
#pragma unroll
                for (int i = 0; i < 16; ++i) sc[i] = 0.f;
#pragma unroll
                for (int ks = 0; ks < 4; ++ks) sc = __builtin_amdgcn_mfma_f32_32x32x16_bf16(__builtin_bit_cast(bf16x8, Kc[ks]), Qf[qt][ks], sc, 0, 0, 0);
                unsigned pk[8];
                if (t < 16) {
                    const int q = qt * 32 + ql, c0 = min(max(q - 8, 0), 48);
#pragma unroll
                    for (int rr = 0; rr < 16; rr += 2) {
                        const int wi = 2 * ip + (rr >> 3), col = 16 * ct + (rr & 3) + 4 * ((rr >> 2) & 1) + 8 * hh;
                        const MLAS float* bp = rpb + (r0 + wi - r + 7) * 128 + (col - q + 63);
                        const float b0 = bp[0], b1 = bp[1];
                        const float e0 = __builtin_amdgcn_exp2f(sc[rr] + b0), e1 = __builtin_amdgcn_exp2f(sc[rr + 1] + b1);
                        const float p0 = (unsigned)(col - c0) < 16u ? e0 : 0.f, p1 = (unsigned)(col + 1 - c0) < 16u ? e1 : 0.f;
                        lsum[qt] += p0 + p1; pk[rr >> 1] = pack2(p0, p1);
                    }
                } else {
#pragma unroll
                    for (int rr = 0; rr < 16; rr += 2) { const float p0 = __builtin_amdgcn_exp2f(sc[rr]), p1 = __builtin_amdgcn_exp2f(sc[rr + 1]); lsum[qt] += p0 + p1; pk[rr >> 1] = pack2(p0, p1); }
                }
                const bf16x8 P0 = __builtin_bit_cast(bf16x8, (u32x4){pk[0], pk[1], pk[2], pk[3]}), P1 = __builtin_bit_cast(bf16x8, (u32x4){pk[4], pk[5], pk[6], pk[7]});
                O[qt][0] = __builtin_amdgcn_mfma_f32_32x32x16_bf16(__builtin_bit_cast(bf16x8, Vc[0]), P0, O[qt][0], 0, 0, 0);
                O[qt][0] = __builtin_amdgcn_mfma_f32_32x32x16_bf16(__builtin_bit_cast(bf16x8, Vc[1]), P1, O[qt][0], 0, 0, 0);
                O[qt][1] = __builtin_amdgcn_mfma_f32_32x32x16_bf16(__builtin_bit_cast(bf16x8, Vc[2]), P0, O[qt][1], 0, 0, 0);
                O[qt][1] = __builtin_amdgcn_mfma_f32_32x32x16_bf16(__builtin_bit_cast(bf16x8, Vc[3]), P1, O[qt][1], 0, 0, 0);
            }
        }
#undef NA_PTRS
#undef NA_LOADS
#pragma unroll
        for (int qt = 0; qt < 2; ++qt) {
            const float inv = 1.0f / (lsum[qt] + __shfl_xor(lsum[qt], 32));
#pragma unroll
            for (int g4 = 0; g4 < 4; ++g4) {
                *(MLAS u32x2*)(ost + (32 * qt + ql) * NA_OP + 8 * g4 + 4 * hh) = (u32x2){pack2(O[qt][0][4 * g4] * inv, O[qt][0][4 * g4 + 1] * inv), pack2(O[qt][0][4 * g4 + 2] * inv, O[qt][0][4 * g4 + 3] * inv)};
                *(MLAS u32x2*)(ost + (32 * qt + ql) * NA_OP + 32 + 8 * g4 + 4 * hh) = (u32x2){pack2(O[qt][1][4 * g4] * inv, O[qt][1][4 * g4 + 1] * inv), pack2(O[qt][1][4 * g4 + 2] * inv, O[qt][1][4 * g4 + 3] * inv)};
            }
        }
#pragma unroll
        for (int k = 0; k < 8; ++k) { const int idx = lane + 64 * k, row = idx >> 3, ch = idx & 7;
            *(u32x4*)(mix + (size_t)(qrow0 + row) * D + h * 64 + ch * 8) = *(const MLAS u32x4*)(ost + row * NA_OP + ch * 8); }
    }
}

constexpr int N2P = 1032;
typedef float f32x4v __attribute__((ext_vector_type(4)));
__device__ __forceinline__ void phase_norm2(const Args& a, int l, MLAS unsigned char* lds, int bid, int nb) {
    const int tid = otid(), lane = tid & 63, wave = __builtin_amdgcn_readfirstlane(tid >> 6);
    const int e0 = lane * 8, e1 = 512 + lane * 8;
    MLAS bf16_t* Ahi = (MLAS bf16_t*)lds; MLAS bf16_t* Alo = Ahi + 16 * N2P; MLAS float* part = (MLAS float*)(Alo + 16 * N2P);
    MLAS float* tsc = part + 8 * 16 * 32; MLAS float* tsh = tsc + 1024; int cur_r = -1;
    bf16_t* hb = (bf16_t*)(a.ws + WS_H);
    int* tok_e = (int*)(a.ws + WS_TOKE); int* tok_r = (int*)(a.ws + WS_TOKR); float* tok_w = (float*)(a.ws + WS_TOKW);
    unsigned* cnt = (unsigned*)(a.ws + WS_CNT) + l * 2048;
    MLAS unsigned* lcnt = (MLAS unsigned*)(tsh + 1024);
    if (tid < NE) lcnt[tid] = 0u;
    const int nrows = l == 0 ? TT : TL;
    bf16x8 Bh[4][2], Bl[4][2];
    { const bf16_t* rh = (const bf16_t*)(a.ws + WS_RWT); const bf16_t* rl = rh + 32 * 1024;
#pragma unroll
      for (int ks = 0; ks < 4; ++ks)
#pragma unroll
        for (int nt = 0; nt < 2; ++nt) { const int o = (nt * 16 + (lane & 15)) * 1024 + 128 * wave + 32 * ks + 8 * (lane >> 4);
            Bh[ks][nt] = __builtin_bit_cast(bf16x8, *(const u32x4*)(rh + o)); Bl[ks][nt] = __builtin_bit_cast(bf16x8, *(const u32x4*)(rl + o)); } }
    const float rbias = a.router_bias[lane & 31];
#define N2_BAR() do { asm volatile("s_waitcnt lgkmcnt(0)" ::: "memory"); __builtin_amdgcn_s_barrier(); asm volatile("" ::: "memory"); } while (0)
#define N2_LOAD(bt, dst) do { _Pragma("unroll") for (int jr_ = 0; jr_ < 2; ++jr_) { const int row_ = (bt) * 16 + 2 * wave + jr_; \
        if (row_ < TL) { const bf16_t* sb_ = (const bf16_t*)(a.ws + WS_XB) + (size_t)row_ * D; dst[jr_][0] = __builtin_bit_cast(f32x4, *(const u32x4*)(sb_ + e0)); dst[jr_][1] = __builtin_bit_cast(f32x4, *(const u32x4*)(sb_ + e1)); } \
        else { const float* src_ = (const float*)(a.ws + WS_CTX) + (size_t)(row_ - TL) * D; \
        dst[jr_][0] = *(const f32x4*)(src_ + e0); dst[jr_][1] = *(const f32x4*)(src_ + e0 + 4); dst[jr_][2] = *(const f32x4*)(src_ + e1); dst[jr_][3] = *(const f32x4*)(src_ + e1 + 4); } } } while (0)
    f32x4 vc[2][4];
    const int nbatch = nrows / 16;
    const int per = (nbatch + nb - 1) / nb, b_lo = bid * per, b_hi = min(b_lo + per, nbatch);
    if (b_lo < b_hi) N2_LOAD(b_lo, vc);
    for (int batch = b_lo; batch < b_hi; ++batch) {
        const int R0 = batch * 16, r = R0 < TL ? R0 / SEQ : 16;
        N2_BAR();
        if (r != cur_r) { cur_r = r; const float* sh = modp(a, l, r, 3); const float* sc = modp(a, l, r, 4); const float* w = a.norm_ffn_w + l * D;
            for (int k = tid; k < D; k += NT) { tsc[k] = (1.0f + sc[k]) * w[k]; tsh[k] = sh[k]; }
            N2_BAR(); }
#pragma unroll
        for (int jr = 0; jr < 2; ++jr) {
            const int m = 2 * wave + jr, row = R0 + m;
            float v[16];
            if (R0 < TL) { const u32x4 w0 = __builtin_bit_cast(u32x4, vc[jr][0]), w1 = __builtin_bit_cast(u32x4, vc[jr][1]);
#pragma unroll
                for (int j = 0; j < 4; ++j) { v[2 * j] = lo16(w0[j]); v[2 * j + 1] = hi16(w0[j]); v[8 + 2 * j] = lo16(w1[j]); v[8 + 2 * j + 1] = hi16(w1[j]); } }
            else {
#pragma unroll
                for (int j = 0; j < 4; ++j) { v[j] = vc[jr][0][j]; v[4 + j] = vc[jr][1][j]; v[8 + j] = vc[jr][2][j]; v[12 + j] = vc[jr][3][j]; } }
            float ss = 0.f;
#pragma unroll
            for (int j = 0; j < 16; ++j) ss += v[j] * v[j];
            ss = wave_sum(ss);
            const float rs = rsqrtf(ss * (1.0f / D) + 1e-6f);
            unsigned ph[8], pl[8], p8[4]; float yk0 = 0.f, yk1 = 0.f;
            float msc[16], msh[16];
#pragma unroll
            for (int q = 0; q < 2; ++q) { const f32x4 c0 = *(const MLAS f32x4*)(tsc + e0 + 4 * q), c1 = *(const MLAS f32x4*)(tsc + e1 + 4 * q), h0 = *(const MLAS f32x4*)(tsh + e0 + 4 * q), h1 = *(const MLAS f32x4*)(tsh + e1 + 4 * q);
#pragma unroll
                for (int j = 0; j < 4; ++j) { msc[4 * q + j] = c0[j]; msc[8 + 4 * q + j] = c1[j]; msh[4 * q + j] = h0[j]; msh[8 + 4 * q + j] = h1[j]; } }
#pragma unroll
            for (int j = 0; j < 16; j += 2) {
                const float y0 = v[j] * rs * msc[j] + msh[j], y1 = v[j + 1] * rs * msc[j + 1] + msh[j + 1];
                const bf16_t h0 = f2bf(y0), h1 = f2bf(y1);
                ph[j >> 1] = (unsigned)h0 | ((unsigned)h1 << 16); pl[j >> 1] = pack2(y0 - bf2f(h0), y1 - bf2f(h1));
                if (j & 2) p8[j >> 2] = pack4_fp8(yk0, yk1, y0, y1); else { yk0 = y0; yk1 = y1; } }
            unsigned char* hp = (unsigned char*)hb + (size_t)row * D;
            *(u32x2*)(hp + e0) = (u32x2){p8[0], p8[1]}; *(u32x2*)(hp + e1) = (u32x2){p8[2], p8[3]};
            *(MLAS u32x4*)(Ahi + m * N2P + e0) = (u32x4){ph[0], ph[1], ph[2], ph[3]}; *(MLAS u32x4*)(Ahi + m * N2P + e1) = (u32x4){ph[4], ph[5], ph[6], ph[7]};
            *(MLAS u32x4*)(Alo + m * N2P + e0) = (u32x4){pl[0], pl[1], pl[2], pl[3]}; *(MLAS u32x4*)(Alo + m * N2P + e1) = (u32x4){pl[4], pl[5], pl[6], pl[7]};
        }
        if (batch + 1 < b_hi) N2_LOAD(batch + 1, vc);
        N2_BAR();
        {
            f32x4v acc0 = {0.f, 0.f, 0.f, 0.f}, acc1 = {0.f, 0.f, 0.f, 0.f};
#pragma unroll
            for (int ks = 0; ks < 4; ++ks) {
                const int o = (lane & 15) * N2P + 128 * wave + 32 * ks + 8 * (lane >> 4);
                const bf16x8 ah = *(const MLAS bf16x8*)(Ahi + o), al = *(const MLAS bf16x8*)(Alo + o);
                acc0 = __builtin_amdgcn_mfma_f32_16x16x32_bf16(ah, Bh[ks][0], acc0, 0, 0, 0); acc0 = __builtin_amdgcn_mfma_f32_16x16x32_bf16(al, Bh[ks][0], acc0, 0, 0, 0); acc0 = __builtin_amdgcn_mfma_f32_16x16x32_bf16(ah, Bl[ks][0], acc0, 0, 0, 0);
                acc1 = __builtin_amdgcn_mfma_f32_16x16x32_bf16(ah, Bh[ks][1], acc1, 0, 0, 0); acc1 = __builtin_amdgcn_mfma_f32_16x16x32_bf16(al, Bh[ks][1], acc1, 0, 0, 0); acc1 = __builtin_amdgcn_mfma_f32_16x16x32_bf16(ah, Bl[ks][1], acc1, 0, 0, 0);
            }
#pragma unroll
            for (int rg = 0; rg < 4; ++rg) { const int m = 4 * (lane >> 4) + rg; part[(wave * 16 + m) * 32 + (lane & 15)] = acc0[rg]; part[(wave * 16 + m) * 32 + 16 + (lane & 15)] = acc1[rg]; }
        }
        N2_BAR();
        {
            const int m = tid >> 5, ex = tid & 31, hb32 = lane & 32, row = R0 + m;
            float acc = 0.f;
#pragma unroll
            for (int w8 = 0; w8 < 8; ++w8) acc += part[(w8 * 16 + m) * 32 + ex];
            const float sg = 1.0f / (1.0f + __expf(-acc)), ssel = sg + rbias;
            float best = -1e30f; int grp = 0;
#pragma unroll
            for (int g = 0; g < 8; ++g) {
                const float v0 = __shfl(ssel, hb32 + g * 4), v1 = __shfl(ssel, hb32 + g * 4 + 1), v2 = __shfl(ssel, hb32 + g * 4 + 2), v3 = __shfl(ssel, hb32 + g * 4 + 3);
                const float hi01 = fmaxf(v0, v1), lo01 = fminf(v0, v1), hi23 = fmaxf(v2, v3), lo23 = fminf(v2, v3);
                const float top = fmaxf(hi01, hi23), second = fmaxf(fminf(hi01, hi23), hi01 >= hi23 ? lo01 : lo23);
                const float gs = top + second;
                if (gs > best) { best = gs; grp = g; }
            }
            float w4[4], s4[4];
#pragma unroll
            for (int j = 0; j < 4; ++j) { w4[j] = __shfl(ssel, hb32 + grp * 4 + j); s4[j] = __shfl(sg, hb32 + grp * 4 + j); }
            int i0 = 0;
#pragma unroll
            for (int j = 1; j < 4; ++j) if (w4[j] > w4[i0]) i0 = j;
            int i1 = i0 == 0 ? 1 : 0;
#pragma unroll
            for (int j = 0; j < 4; ++j) if (j != i0 && j != i1 && w4[j] > w4[i1]) i1 = j;
            float g0 = 0.f, g1 = 0.f;
#pragma unroll
            for (int j = 0; j < 4; ++j) { g0 = (j == i0) ? s4[j] : g0; g1 = (j == i1) ? s4[j] : g1; }
            const float inv = 1.0f / (g0 + g1);
            if (ex < 2) {
                const int e = grp * 4 + (ex == 0 ? i0 : i1);
                const unsigned rank = __hip_atomic_fetch_add(lcnt + e, 1u, __ATOMIC_RELAXED, __HIP_MEMORY_SCOPE_WORKGROUP);
                tok_e[row * 2 + ex] = e; tok_r[row * 2 + ex] = (int)rank; tok_w[row * 2 + ex] = (ex == 0 ? g0 : g1) * inv;
            }
        }
    }
    N2_BAR();
    if (tid < NE) ((int*)(a.ws + WS_BLKB))[bid * NE + tid] = (int)atomicAdd(cnt + tid * 32, lcnt[tid]);
#undef N2_BAR
#undef N2_LOAD
}
__device__ __forceinline__ void phase_gather(const Args& a, int l, MLAS unsigned char* lds, int bid, int nb) {
    const int tid = otid(), lane = tid & 63, wave = tid >> 6;
    MLAS int* pbase = (MLAS int*)lds;
    MLAS int* cn = pbase + 64;
    const unsigned* cnt = (const unsigned*)(a.ws + WS_CNT) + l * 2048; const int* blkb = (const int*)(a.ws + WS_BLKB);
    if (tid == 0) { int acc = 0; for (int e = 0; e < NE; ++e) { const int c = (int)__hip_atomic_load(cnt + e * 32, __ATOMIC_RELAXED, __HIP_MEMORY_SCOPE_AGENT); cn[e] = c; pbase[e] = acc; acc += (c + 255) & ~255; } pbase[NE] = acc; }
    __syncthreads();
    int* rinfo = (int*)(a.ws + WS_RINFO); float* rw = (float*)(a.ws + WS_RW); int* blke = (int*)(a.ws + WS_BLKE);
    if (bid == 0) {
        for (int e = 0; e < NE; ++e) {
            for (int p = pbase[e] + cn[e] + tid; p < pbase[e + 1]; p += NT) { rinfo[p] = -1; rw[p] = 0.f; }
            for (int blk = (pbase[e] >> 8) + tid; blk < (pbase[e + 1] >> 8); blk += NT) blke[blk] = e;
        }
        if (tid == 0) blke[1023] = (pbase[NE] >> 8) * 4;
    }
    const int* tok_e = (const int*)(a.ws + WS_TOKE); const int* tok_r = (const int*)(a.ws + WS_TOKR); const float* tok_w = (const float*)(a.ws + WS_TOKW);
    const int nas = (l == 0 ? TT : TL) * 2, per_ = ((l == 0 ? TT : TL) / 16 + nb - 1) / nb;
    for (int as = bid * NT + tid; as < nas; as += nb * NT) {
        const int t = as >> 1, e = tok_e[as], pos = pbase[e] + blkb[((t >> 4) / per_) * NE + e] + tok_r[as];
        rinfo[pos] = as; ((int*)(a.ws + WS_TOKR))[as] = pos;
    }
}

using pg8::Unit;
struct EpiStoreBf16 {
    static constexpr bool PERM = true, AFTER_DRAIN = false;
    bf16_t* O; int ldc; bf16_t* kc_lat; bf16_t* vt_lat; bf16_t* kc_ctx; bf16_t* vt_ctx; const float* knw; MLAS unsigned char* sp;
    __device__ __forceinline__ void operator()(const f32x4 (&acc)[2][2][4][2], const Unit& u, int wr, int wc, int fr, int fq) const {
        const int row0 = u.pm * 256 + wr * 64 + fr;
        if (u.pn < 2 || u.pn > 5) {
            const int col0 = u.pn * 256 + wc * 32 + 8 * fq;
#pragma unroll
            for (int ai = 0; ai < 2; ++ai)
#pragma unroll
                for (int m = 0; m < 4; ++m) { bf16_t* rowp = O + (size_t)(row0 + ai * 128 + m * 16) * ldc + col0;
#pragma unroll
                    for (int bj = 0; bj < 2; ++bj) { const f32x4 v0 = acc[ai][bj][m][0], v1 = acc[ai][bj][m][1];
                        *(u32x4*)(rowp + bj * 128) = (u32x4){pg8::cvt_pk_bf16(v0[0], v0[1]), pg8::cvt_pk_bf16(v0[2], v0[3]), pg8::cvt_pk_bf16(v1[0], v1[1]), pg8::cvt_pk_bf16(v1[2], v1[3])}; } }
            return;
        }
        const bool lat = u.pm < 256;
        if (u.pn < 4) {
            MLAS float* part = (MLAS float*)sp;
            float ss[2][4][2];
#pragma unroll
            for (int ai = 0; ai < 2; ++ai)
#pragma unroll
                for (int m = 0; m < 4; ++m)
#pragma unroll
                    for (int bj = 0; bj < 2; ++bj) { const f32x4 v0 = acc[ai][bj][m][0], v1 = acc[ai][bj][m][1];
                        float q = (v0[0] * v0[0] + v0[1] * v0[1]) + (v0[2] * v0[2] + v0[3] * v0[3]) + (v1[0] * v1[0] + v1[1] * v1[1]) + (v1[2] * v1[2] + v1[3] * v1[3]);
                        q += __shfl_xor(q, 16); q += __shfl_xor(q, 32); ss[ai][m][bj] = q;
                        if (fq == 0) part[((((ai * 4 + m) * 2 + bj) * 2 + wr) * 16 + fr) * 4 + wc] = q; }
            asm volatile("s_waitcnt lgkmcnt(0)" ::: "memory"); __builtin_amdgcn_s_barrier(); asm volatile("" ::: "memory");
            const f32x4 w0 = *(const f32x4*)(knw + (wc & 1) * 32 + 8 * fq), w1 = *(const f32x4*)(knw + (wc & 1) * 32 + 8 * fq + 4);
#pragma unroll
            for (int ai = 0; ai < 2; ++ai)
#pragma unroll
                for (int m = 0; m < 4; ++m) { const int row = row0 + ai * 128 + m * 16;
                    const int b = lat ? row >> 12 : (row - TL) >> 8, t = lat ? row & (SEQ - 1) : (row - TL) & (LC - 1), tlen = lat ? SEQ : LC;
                    bf16_t* kb = (lat ? kc_lat : kc_ctx);
#pragma unroll
                    for (int bj = 0; bj < 2; ++bj) {
                        const float other = part[((((ai * 4 + m) * 2 + bj) * 2 + wr) * 16 + fr) * 4 + (wc ^ 1)];
                        const float rs = rsqrtf((ss[ai][m][bj] + other) * (1.0f / 64.0f) + 1e-6f);
                        const f32x4 v0 = acc[ai][bj][m][0] * rs * w0, v1 = acc[ai][bj][m][1] * rs * w1;
                        const int head = (u.pn - 2) * 4 + 2 * bj + (wc >> 1);
                        *(u32x4*)(kb + (((size_t)b * 8 + head) * tlen + t) * 64 + (wc & 1) * 32 + 8 * fq) = (u32x4){pg8::cvt_pk_bf16(v0[0], v0[1]), pg8::cvt_pk_bf16(v0[2], v0[3]), pg8::cvt_pk_bf16(v1[0], v1[1]), pg8::cvt_pk_bf16(v1[2], v1[3])}; } }
            return;
        }
        {
            MLAS bf16_t* gb = (MLAS bf16_t*)(sp + wr * 8192);
            bf16_t* vb = lat ? vt_lat : vt_ctx; const int ngrp = lat ? SEQ / 16 : LC / 16;
#pragma unroll
            for (int ai = 0; ai < 2; ++ai)
#pragma unroll
                for (int m = 0; m < 4; ++m) {
#pragma unroll
                    for (int bj = 0; bj < 2; ++bj)
#pragma unroll
                        for (int n = 0; n < 2; ++n) { const f32x4 v = acc[ai][bj][m][n]; const int c = bj * 128 + wc * 32 + 8 * fq + 4 * n;
                            const unsigned p01 = pg8::cvt_pk_bf16(v[0], v[1]), p23 = pg8::cvt_pk_bf16(v[2], v[3]);
                            gb[(c + 0) * 16 + fr] = (bf16_t)(p01 & 0xffffu); gb[(c + 1) * 16 + fr] = (bf16_t)(p01 >> 16);
                            gb[(c + 2) * 16 + fr] = (bf16_t)(p23 & 0xffffu); gb[(c + 3) * 16 + fr] = (bf16_t)(p23 >> 16); }
                    asm volatile("s_waitcnt lgkmcnt(0)" ::: "memory"); __builtin_amdgcn_s_barrier(); asm volatile("" ::: "memory");
                    const int rowb = u.pm * 256 + ai * 128 + wr * 64 + m * 16;
                    const int b = lat ? rowb >> 12 : (rowb - TL) >> 8, g16 = (lat ? rowb & (SEQ - 1) : (rowb - TL) & (LC - 1)) >> 4;
#pragma unroll
                    for (int k = 0; k < 2; ++k) { const int qd = wc * 64 + fr + 16 * fq + 256 * k, c = qd >> 1, half = qd & 1;
                        const u32x4 w = *(const MLAS u32x4*)(gb + c * 16 + 8 * half);
                        const int head = (u.pn - 4) * 4 + (c >> 6), d = c & 63;
                        *(u32x4*)(vb + ((((size_t)b * 8 + head) * ngrp + g16) * 64 + d) * 16 + 8 * half) = w; }
                    asm volatile("s_waitcnt lgkmcnt(0)" ::: "memory"); __builtin_amdgcn_s_barrier(); asm volatile("" ::: "memory");
                }
        }
    }
};
struct EpiResGate {
    static constexpr bool PERM = true, AFTER_DRAIN = false;
    const void* xin_lat; const float* xin_ctx; bf16_t* out_lat; float* out_ctx; const float* modl; int in_bf16;
    __device__ __forceinline__ void operator()(const f32x4 (&acc)[2][2][4][2], const Unit& u, int wr, int wc, int fr, int fq) const {
        const bool lat = u.pm < 256; const int r = lat ? (u.pm >> 4) : 16;
        const int rowt = (lat ? u.pm : u.pm - 256) * 256 + wr * 64 + fr, col0 = u.pn * 256 + wc * 32 + 8 * fq;
        const float* g = modl + (size_t)r * 6144 + 2 * 1024 + col0;
        f32x4 gv[2][2];
#pragma unroll
        for (int bj = 0; bj < 2; ++bj)
#pragma unroll
            for (int n = 0; n < 2; ++n) gv[bj][n] = *(const f32x4*)(g + bj * 128 + 4 * n);
#pragma unroll
        for (int ai = 0; ai < 2; ++ai)
#pragma unroll
            for (int m = 0; m < 4; ++m) { const size_t off = (size_t)(rowt + ai * 128 + m * 16) * D + col0;
#pragma unroll
                for (int bj = 0; bj < 2; ++bj) {
                    f32x4 x0, x1;
                    if (!lat) { x0 = *(const f32x4*)(xin_ctx + off + bj * 128); x1 = *(const f32x4*)(xin_ctx + off + bj * 128 + 4); }
                    else if (in_bf16) { const u32x4 w = *(const u32x4*)((const bf16_t*)xin_lat + off + bj * 128); x0 = (f32x4){lo16(w.x), hi16(w.x), lo16(w.y), hi16(w.y)}; x1 = (f32x4){lo16(w.z), hi16(w.z), lo16(w.w), hi16(w.w)}; }
                    else { x0 = *(const f32x4*)((const float*)xin_lat + off + bj * 128); x1 = *(const f32x4*)((const float*)xin_lat + off + bj * 128 + 4); }
                    x0 += gv[bj][0] * acc[ai][bj][m][0]; x1 += gv[bj][1] * acc[ai][bj][m][1];
                    if (lat) *(u32x4*)(out_lat + off + bj * 128) = (u32x4){pack2(x0[0], x0[1]), pack2(x0[2], x0[3]), pack2(x1[0], x1[1]), pack2(x1[2], x1[3])};
                    else { *(f32x4*)(out_ctx + off + bj * 128) = x0; *(f32x4*)(out_ctx + off + bj * 128 + 4) = x1; } } }
    }
};
struct EpiSwiglu {
    static constexpr bool PERM = true, AFTER_DRAIN = false;
    bf16_t* act;
    __device__ __forceinline__ void operator()(const f32x4 (&acc)[2][2][4][2], const Unit& u, int wr, int wc, int fr, int fq) const {
        const int row0 = u.pm * 256 + wr * 64 + fr, col0 = (u.pn & 3) * 128 + wc * 32 + 8 * fq;
#pragma unroll
        for (int ai = 0; ai < 2; ++ai)
#pragma unroll
            for (int m = 0; m < 4; ++m) { float r[8];
#pragma unroll
                for (int n = 0; n < 2; ++n)
#pragma unroll
                    for (int j = 0; j < 4; ++j) { const float gt = acc[ai][0][m][n][j]; r[n * 4 + j] = siluf(gt) * acc[ai][1][m][n][j]; }
                *(u32x2*)((unsigned char*)act + (size_t)(row0 + ai * 128 + m * 16) * DFF + col0) = (u32x2){pack4_fp8(r[0], r[1], r[2], r[3]), pack4_fp8(r[4], r[5], r[6], r[7])}; }
    }
};
struct EpiDown {
    static constexpr bool PERM = true, AFTER_DRAIN = false;
    bf16_t* ys;
    __device__ __forceinline__ void operator()(const f32x4 (&acc)[2][2][4][2], const Unit& u, int wr, int wc, int fr, int fq) const {
        const int row0 = u.pm * 256 + wr * 64 + fr, col0 = (u.pn & 3) * 256 + wc * 32 + 8 * fq;
#pragma unroll
        for (int ai = 0; ai < 2; ++ai)
#pragma unroll
            for (int m = 0; m < 4; ++m) { bf16_t* rowp = ys + (size_t)(row0 + ai * 128 + m * 16) * D + col0;
#pragma unroll
                for (int bj = 0; bj < 2; ++bj) { const f32x4 v0 = acc[ai][bj][m][0], v1 = acc[ai][bj][m][1];
                    *(u32x4*)(rowp + bj * 128) = (u32x4){pg8::cvt_pk_bf16(v0[0], v0[1]), pg8::cvt_pk_bf16(v0[2], v0[3]), pg8::cvt_pk_bf16(v1[0], v1[1]), pg8::cvt_pk_bf16(v1[2], v1[3])}; } }
    }
};
struct SubsetOrder {
    pg8::StaticOrder base; unsigned map;
    __device__ __forceinline__ bool next(int i, Unit& u) const { if (!base.next(i, u)) return false; u.pn = (int)((map >> (4 * u.pn)) & 15u); return true; }
    __device__ __forceinline__ void a_ready(const Unit&) const {}
    __device__ __forceinline__ void done(const Unit&) const {}
};
struct MoeOrder {
    const MLAS int* blke; int nunits, G, c;
    __device__ __forceinline__ bool next(int i, Unit& u) const { const int x = c & 7, j = c >> 3; int L;
        if (G == 256) { const int rb = i * 64 + (j >> 2) * 8 + x; L = rb * 4 + (j & 3); } else L = i * G + c;
        if (L >= nunits) return false; u.pm = L >> 2; u.pn = blke[L >> 2] * 4 + (L & 3); return true; }
    __device__ __forceinline__ void a_ready(const Unit&) const {}
    __device__ __forceinline__ void done(const Unit&) const {}
};

typedef const Args __attribute__((address_space(4))) CArgs;
#define MK_LOAD_ARGS(a, p) do { (a).x = (p)->x; (a).c = (p)->c; (a).ctx = (p)->ctx; (a).c_ctx = (p)->c_ctx; (a).ada_w = (p)->ada_w; (a).ada_b = (p)->ada_b; (a).norm_mix_w = (p)->norm_mix_w; (a).norm_ffn_w = (p)->norm_ffn_w; (a).w_in = (p)->w_in; (a).na_q_norm = (p)->na_q_norm; (a).na_k_norm = (p)->na_k_norm; (a).na_rpb = (p)->na_rpb; (a).ret_decay = (p)->ret_decay; (a).w_out = (p)->w_out; (a).router_w = (p)->router_w; (a).router_bias = (p)->router_bias; (a).w_gate = (p)->w_gate; (a).w_up = (p)->w_up; (a).w_down = (p)->w_down; (a).out = (p)->out; (a).ws = (p)->ws; (a).ph_lo = (p)->ph_lo; (a).ph_hi = (p)->ph_hi; } while (0)
#ifndef MK_SINGLE
#define MK_SINGLE 1
#endif
constexpr int NPHASES = 24;
#ifndef MK_PROBE_MASK
#define MK_PROBE_MASK 0
#endif
#ifndef MK_BAR2
#define MK_BAR2 0
#endif
#ifndef MK_PROBE_MULT
#define MK_PROBE_MULT 4
#endif
enum { K_PRO = 0, K_NORM1, K_GEMM_IN, K_PREP, K_NA, K_RET_A, K_SCAN, K_RET_B, K_GEMM_OUT, K_NORM2, K_GATHER, K_MOE1, K_MOE2, K_FINAL };
__global__ void __launch_bounds__(NT, 2) fwd(Args ka) {
    extern __shared__ __attribute__((aligned(16))) unsigned char lds_raw[];
    MLAS unsigned char* lds = (MLAS unsigned char*)lds_raw;
    const int tid = threadIdx.x, nb = gridDim.x;
    volatile MLAS unsigned* ctl = (volatile MLAS unsigned*)(lds + LDS_CTL);
    if (tid < 4) ctl[tid] = 0u;
    __syncthreads();
    const bool multi = MK_SINGLE != 0;
    XcdBarrier bar; bar.bar = (unsigned*)(ka.ws + WS_BAR); bar.x = 0; bar.st = ctl;
    if (multi) bar = xcd_barrier_post((unsigned*)(ka.ws + WS_BAR), ctl);
    int ph = 0;
#if MK_SINGLE
#define MK_GUARD 1
#define MK_SEAM(kind) ((kind) != K_FINAL)
#else
#define MK_GUARD (ph >= ka.ph_lo && ph < ka.ph_hi)
#define MK_SEAM(kind) (ph + 1 < ka.ph_hi)
#endif
#define PHASE(kind, ...) do { if (MK_GUARD) { CArgs* ap_ = (CArgs*)__builtin_amdgcn_kernarg_segment_ptr(); asm volatile("" : "+s"(ap_)); Args a; MK_LOAD_ARGS(a, ap_); int bid = blockIdx.x; asm volatile("" : "+s"(bid)); unsigned long long t0_ = 0; if ((MK_PROBE_MASK >> (kind)) & 1) t0_ = wall_clock64(); { __VA_ARGS__; } if ((MK_PROBE_MASK >> (kind)) & 1) { const unsigned long long d_ = wall_clock64() - t0_; while (wall_clock64() - t0_ < d_ * (MK_PROBE_MULT + 1)) __builtin_amdgcn_s_sleep(8); } if (MK_SEAM(kind)) { XcdBarrier b_ = bar; asm volatile("" : "+s"(b_.bar), "+s"(b_.x)); xcd_barrier(b_); if (MK_BAR2) { xcd_barrier(b_); xcd_barrier(b_); } } } ++ph; } while (0)
    PHASE(K_PRO, { convert_small(a, bid, nb); convert_weights(a, true, 0, lds, bid, nb); compute_mod(a, lds, bid, nb); });
#define MK_LAYER(l) do { \
        PHASE(K_NORM1, { phase_norm1(a, l, bid, nb); if (l == 1) convert_weights(a, false, 1, lds, bid, nb); }); \
        PHASE(K_GEMM_IN, { EpiStoreBf16 E{(bf16_t*)(a.ws + WS_PROJ), INC, (bf16_t*)(a.ws + WS_KC), (bf16_t*)(a.ws + WS_VT), (bf16_t*)(a.ws + WS_KCC), (bf16_t*)(a.ws + WS_VTC), a.na_k_norm + l * 64, lds + 131072}; \
                if (IN_FP8_MASK == 0xFFFFu) { pg8::Gemm g{(const bf16_t*)h8_of(a), (const bf16_t*)(a.ws + WS_WIN8 + (size_t)l * INC * D), TT, INC, D, nullptr, SC_IN8}; \
                  pg8::StaticOrder S; S.init(TT, INC, nb, bid); \
                  pg8::gemm_phase<EpiStoreBf16, pg8::StaticOrder, false, false, 1>(lds, g, S, E, nullptr); } \
                else { \
                { pg8::Gemm g{(const bf16_t*)(a.ws + WS_H), (const bf16_t*)(a.ws + WS_WIN) + (size_t)l * INC * D, TT, INC, D}; \
                  SubsetOrder S; S.base.init(TT, INC / 2, nb, bid); S.map = IN_TILES_BF16; \
                  pg8::gemm_phase<EpiStoreBf16, SubsetOrder>(lds, g, S, E, nullptr); } \
                { pg8::Gemm g{(const bf16_t*)h8_of(a), (const bf16_t*)(a.ws + WS_WIN8 + (size_t)l * INC * D), TT, INC, D, nullptr, SC_IN8}; \
                  SubsetOrder S; S.base.init(TT, INC / 2, nb, nb - 1 - bid); S.map = IN_TILES_FP8;     \
                  pg8::gemm_phase<EpiStoreBf16, SubsetOrder, false, false, 1>(lds, g, S, E, nullptr); } } }); \
        PHASE(K_NA, phase_na(a, l, lds, bid, nb)); \
        PHASE(K_RET_A, phase_ret_a(a, l, lds, bid, nb)); \
        PHASE(K_SCAN, phase_scan(a, l, bid, nb)); \
        PHASE(K_RET_B, phase_ret_b(a, l, lds, bid, nb)); \
        PHASE(K_GEMM_OUT, { const int M = l == 0 ? TT : TL; \
                pg8::Gemm g{(const bf16_t*)(a.ws + WS_H), (const bf16_t*)(a.ws + WS_WOUT) + (size_t)l * D * D, M, D, D}; \
                pg8::StaticOrder S; S.init(M, D, nb, bid); \
                EpiResGate E{l == 0 ? (const void*)a.x : (const void*)a.out, a.ctx, (bf16_t*)(a.ws + WS_XB), (float*)(a.ws + WS_CTX), (const float*)(a.ws + WS_MOD) + (size_t)l * 17 * 6144, l}; \
                pg8::gemm_phase<EpiResGate, pg8::StaticOrder>(lds, g, S, E, nullptr); }); \
        PHASE(K_NORM2, phase_norm2(a, l, lds, bid, nb)); \
        PHASE(K_GATHER, phase_gather(a, l, lds, bid, nb)); \
        PHASE(K_MOE1, { MLAS int* blke = (MLAS int*)(lds + 131072); { const int* gb_ = (const int*)(a.ws + WS_BLKE); for (int i_ = otid(); i_ < 1024; i_ += NT) blke[i_] = gb_[i_]; __syncthreads(); } \
                pg8::Gemm g{(const bf16_t*)(a.ws + WS_H), (const bf16_t*)(a.ws + WS_WGU), PMAX, NE * 1024, D, (const int*)(a.ws + WS_RINFO), SC_MOE1}; \
                MoeOrder S{blke, blke[1023], nb, bid}; \
                EpiSwiglu E{(bf16_t*)(a.ws + WS_ACT)}; \
                pg8::gemm_phase<EpiSwiglu, MoeOrder, false, true, 1>(lds, g, S, E, nullptr); }); \
        PHASE(K_MOE2, { MLAS int* blke = (MLAS int*)(lds + 131072); { const int* gb_ = (const int*)(a.ws + WS_BLKE); for (int i_ = otid(); i_ < 1024; i_ += NT) blke[i_] = gb_[i_]; __syncthreads(); } \
                pg8::Gemm g{(const bf16_t*)(a.ws + WS_ACT), (const bf16_t*)(a.ws + WS_WDN), PMAX, NE * 1024, DFF, nullptr, SC_MOE2}; \
                MoeOrder S{blke, blke[1023], nb, bid}; \
                EpiDown E{(bf16_t*)(a.ws + WS_XS)}; \
                pg8::gemm_phase<EpiDown, MoeOrder, false, false, 1>(lds, g, S, E, nullptr); }); \
    } while (0)
    MK_LAYER(0);
    MK_LAYER(1);
#undef MK_LAYER
    PHASE(K_FINAL, phase_final(a, bid, nb));
#undef PHASE
}
}

extern "C" void kernel_launch(void* const* d_in, const int* in_sizes, int n_in, void* d_out, int out_size, void* d_ws, size_t ws_size, hipStream_t stream) {
    using namespace mk;
    static int grid = 0;
    if (grid == 0) {
        if (n_in != 19 || in_sizes[0] != TL * D || out_size != TL * D || ws_size < WS_END) {
            fprintf(stderr, "kernel_launch: unexpected shapes / workspace (n_in %d, in0 %d, out %d, ws %zu, need %zu); nothing launched\n", n_in, n_in > 0 ? in_sizes[0] : -1, out_size, ws_size, (size_t)WS_END);
            grid = -1; return; }
        int dev = 0, cus = 0, per_cu = 0;
        if (hipGetDevice(&dev) != hipSuccess || hipDeviceGetAttribute(&cus, hipDeviceAttributeMultiprocessorCount, dev) != hipSuccess) { grid = -1; return; }
        if (hipFuncSetAttribute((const void*)fwd, hipFuncAttributeMaxDynamicSharedMemorySize, LDS_BYTES) != hipSuccess) { fprintf(stderr, "kernel_launch: hipFuncSetAttribute failed\n"); grid = -1; return; }
        if (hipOccupancyMaxActiveBlocksPerMultiprocessor(&per_cu, (const void*)fwd, NT, LDS_BYTES) != hipSuccess || per_cu < 1) { fprintf(stderr, "kernel_launch: occupancy query says %d\n", per_cu); (void)hipGetLastError(); grid = -1; return; }
        grid = cus;
    }
    if (grid < 0) return;
    (void)hipMemsetAsync((char*)d_ws + WS_BAR, 0, WS_ZERO_BYTES, stream);
    Args a{};
    a.x = (const float*)d_in[0]; a.c = (const float*)d_in[1]; a.ctx = (const float*)d_in[2]; a.c_ctx = (const float*)d_in[3]; a.ada_w = (const float*)d_in[4]; a.ada_b = (const float*)d_in[5];
    a.norm_mix_w = (const float*)d_in[6]; a.norm_ffn_w = (const float*)d_in[7]; a.w_in = (const float*)d_in[8]; a.na_q_norm = (const float*)d_in[9]; a.na_k_norm = (const float*)d_in[10];
    a.na_rpb = (const float*)d_in[11]; a.ret_decay = (const float*)d_in[12]; a.w_out = (const float*)d_in[13]; a.router_w = (const float*)d_in[14]; a.router_bias = (const float*)d_in[15];
    a.w_gate = (const float*)d_in[16]; a.w_up = (const float*)d_in[17]; a.w_down = (const float*)d_in[18];
    a.out = (float*)d_out; a.ws = (unsigned char*)d_ws;
#if MK_SINGLE
    a.ph_lo = 0; a.ph_hi = NPHASES;
    hipLaunchKernelGGL(fwd, dim3(grid), dim3(NT), LDS_BYTES, stream, a);
#else
    for (int ph = 0; ph < NPHASES; ++ph) { a.ph_lo = ph; a.ph_hi = ph + 1; hipLaunchKernelGGL(fwd, dim3(grid), dim3(NT), LDS_BYTES, stream, a); }
#endif
}
```

```cpp
#include <hip/hip_runtime.h>
#include <cstdio>
#include <cstdint>

#define XB_TMO      128
#define XB_XCNT(j)  (256  + 64 * (j))
#define XB_XSUB(j)  (1280 + 64 * (j))
#define XB_XGEN(j)  (2304 + 64 * (j))
#define XB_TOP      3328
#define XB_TOPGEN   3392
#define XCD_BAR_WORDS 3456
#define XB_SPIN_CAP (1u << 18)
#define LAS __attribute__((address_space(3)))

__device__ __forceinline__ unsigned xb_ld(unsigned* p)              { return __hip_atomic_load(p, __ATOMIC_RELAXED, __HIP_MEMORY_SCOPE_AGENT); }
__device__ __forceinline__ unsigned xb_add(unsigned* p, unsigned v) { return __hip_atomic_fetch_add(p, v, __ATOMIC_RELAXED, __HIP_MEMORY_SCOPE_AGENT); }
__device__ __forceinline__ unsigned xb_xcc_id() { return (unsigned)__builtin_amdgcn_s_getreg((3 << 11) | 20) & 0xFu; }
#define XB_SPIN(cond, bar) do { unsigned _sp = 0; while (cond) { __builtin_amdgcn_s_sleep(1); \
    if ((++_sp & 255u) == 0u) { if (xb_ld(&(bar)[XB_TMO])) break; if (_sp > XB_SPIN_CAP) { atomicAdd(&(bar)[XB_TMO], 1u); break; } } } } while (0)

struct XcdBarrier {
    unsigned* bar; unsigned x;
    volatile LAS unsigned* st;
};

__device__ __forceinline__ XcdBarrier xcd_barrier_post(unsigned* bar, volatile LAS unsigned* st) {
    XcdBarrier b; b.bar = bar; b.x = xb_xcc_id(); b.st = st;
    if (threadIdx.x == 0) (void)xb_add(&bar[XB_XCNT(b.x)], 1u);
    return b;
}
__device__ __forceinline__ void xcd_barrier_complete(unsigned* bar, unsigned x, unsigned& nloc, unsigned& nx) {
    const unsigned G = gridDim.x * gridDim.y * gridDim.z;
    unsigned sum, cnt, mine, sp = 0u;
    for (;;) {
        sum = 0u; cnt = 0u; mine = 0u;
#pragma unroll
        for (unsigned j = 0; j < 16; ++j) { const unsigned c = xb_ld(&bar[XB_XCNT(j)]); sum += c; cnt += (c > 0u) ? 1u : 0u; mine = (j == x) ? c : mine; }
        if (sum == G) break;
        __builtin_amdgcn_s_sleep(1);
        if ((++sp & 255u) == 0u) { if (xb_ld(&bar[XB_TMO])) break; if (sp > XB_SPIN_CAP) { atomicAdd(&bar[XB_TMO], 1u); break; } }
    }
    nloc = mine > 0u ? mine : 1u; nx = cnt > 0u ? cnt : 1u;
}

__device__ __forceinline__ void xcd_barrier(const XcdBarrier& b) {
    asm volatile("s_waitcnt vmcnt(0)" ::: "memory");
    __syncthreads();
    if (threadIdx.x == 0) {
        unsigned* bar = b.bar;
        __builtin_amdgcn_s_waitcnt(0);
        unsigned nloc = b.st[0], nx = b.st[1];
        if (nloc == 0u) { xcd_barrier_complete(bar, b.x, nloc, nx); b.st[0] = nloc; b.st[1] = nx; }
        const unsigned old = xb_add(&bar[XB_XSUB(b.x)], 1u);
        const unsigned gen = old / nloc;
        if (old + 1u == (gen + 1u) * nloc) {
            __builtin_amdgcn_fence(__ATOMIC_RELEASE, "agent");
            asm volatile("s_waitcnt vmcnt(0)" ::: "memory");
            const unsigned og = xb_add(&bar[XB_TOP], 1u);
            const unsigned tg = og / nx;
            if (og + 1u == (tg + 1u) * nx) xb_add(&bar[XB_TOPGEN], 1u);
            else XB_SPIN(xb_ld(&bar[XB_TOPGEN]) == tg, bar);
            __builtin_amdgcn_fence(__ATOMIC_ACQUIRE, "agent");
            xb_add(&bar[XB_XGEN(b.x)], 1u);
            asm volatile("s_waitcnt vmcnt(0)" ::: "memory");
        } else {
            XB_SPIN(xb_ld(&bar[XB_XGEN(b.x)]) == gen, bar);
            __builtin_amdgcn_fence(__ATOMIC_ACQUIRE, "agent");
            asm volatile("s_waitcnt vmcnt(0)" ::: "memory");
        }
    }
    __syncthreads();
}
namespace pg8 {
#define PG8_LAS __attribute__((address_space(3)))
typedef unsigned short bf16_t;
typedef short bf16x8 __attribute__((ext_vector_type(8)));
typedef float f32x4 __attribute__((ext_vector_type(4)));
typedef unsigned u32x4 __attribute__((ext_vector_type(4)));
constexpr int BM = 256, BK = 64, HALF = 128, HTB = HALF * BK * 2  , STAGE_BYTES = 8 * HTB, NXCD = 8, WGM = 8;

__host__ __device__ __forceinline__ int lds_byte(int r, int c) { const int st = (r >> 4) * 2 + (c >> 5), rr = r & 15, cc = c & 31, ob = rr * 64 + cc * 2; return st * 1024 + (ob ^ (((ob >> 9) & 1) << 5)); }
__host__ __device__ __forceinline__ void stage_rc(int b, int& R, int& C) { const int st = b / 1024, sb = b % 1024, swz = sb ^ (((sb >> 9) & 1) << 5); R = (st >> 1) * 16 + swz / 64; C = (st & 1) * 32 + (swz % 64) / 2; }
typedef int i32x4 __attribute__((ext_vector_type(4)));
typedef int i32x8 __attribute__((ext_vector_type(8)));
__host__ __device__ __forceinline__ int perm32(int rho) { const int n = rho >> 4, i = rho & 15; return 8 * (i >> 2) + 4 * n + (i & 3); }

struct Unit { int pm, pn; };
struct Gemm { const bf16_t* A; const bf16_t* Bt; int M, N, K; const int* rows = nullptr; int sc = 0x7f7f7f7f; };

struct StaticOrder {
    int nM, nN, nwg, G, c;
    __host__ __device__ void init(int M, int N, int G_, int c_) { nM = M / BM; nN = N / BM; nwg = nM * nN; G = G_; c = c_; }
    __host__ __device__ bool next(int i, Unit& u) const {
        const long L = (long)i * G + c; if (L >= nwg) return false;
        int wgid = (int)L; { const int q = nwg / NXCD, r = nwg % NXCD, xcd = wgid % NXCD, off = wgid / NXCD; wgid = (xcd < r ? xcd * (q + 1) : r * (q + 1) + (xcd - r) * q) + off; }
        const int nig = WGM * nN, gid = wgid / nig, fm = gid * WGM, gsz = (nM - fm) < WGM ? (nM - fm) : WGM;
        u.pm = fm + ((wgid % nig) % gsz); u.pn = (wgid % nig) / gsz; return true;
    }
    __device__ __forceinline__ void a_ready(const Unit&) const {}
    __device__ __forceinline__ void done(const Unit&) const {}
};
__device__ __forceinline__ unsigned cvt_pk_bf16(float lo, float hi) { unsigned r; asm volatile("v_cvt_pk_bf16_f32 %0, %1, %2" : "=v"(r) : "v"(lo), "v"(hi)); return r; }
typedef float f32x2 __attribute__((ext_vector_type(2)));
template <class Epi, class Sched, bool STAMP = false, bool GATHER = false, int ES = 2>
__device__ __forceinline__ void gemm_phase(PG8_LAS unsigned char* lds, const Gemm g, const Sched& S, const Epi& E, unsigned long long* stamps) {
    int tid_o_ = threadIdx.x; asm volatile("" : "+v"(tid_o_)); const int tid = tid_o_, wid = __builtin_amdgcn_readfirstlane(tid >> 6), lane = tid & 63, wr = wid >> 2, wc = wid & 3, fr = lane & 15, fq = lane >> 4;
    const int K = g.K, nt = K * ES / (BK * 2);
    int ts_lo = 0, ts_hi = 0, nts = 0; const unsigned long long rt_entry = STAMP ? (unsigned long long)wall_clock64() : 0ull;
#define PG8_STAMP() do { if (STAMP && wid == 0 && nts < 64) { const unsigned long long _c = (unsigned long long)clock64(); \
        ts_lo = (lane == nts) ? (int)(unsigned)_c : ts_lo; ts_hi = (lane == nts) ? (int)(unsigned)(_c >> 32) : ts_hi; ++nts; } } while (0)
    PG8_STAMP();
    unsigned voffA[2], voffB[2]; int rA_[2]; unsigned cA_[2];
#pragma unroll
    for (int i = 0; i < 2; ++i) { int R, C; stage_rc(tid * 16 + i * 8192, R, C); C *= 2; const int Rb = Epi::PERM ? ((R & ~31) + perm32(R & 31)) : R;
        voffA[i] = (unsigned)(R * K * ES + C); voffB[i] = (unsigned)(Rb * K * ES + C); rA_[i] = R; cA_[i] = (unsigned)C; }
    unsigned gA[2][2], v2_[2][2];
#define PG8_ROWS(u, dst) do { _Pragma("unroll") for (int h_ = 0; h_ < 2; ++h_) _Pragma("unroll") for (int i_ = 0; i_ < 2; ++i_) { const int as_ = g.rows[(u).pm * BM + h_ * HALF + rA_[i_]]; \
        dst[h_][i_] = (unsigned)(as_ < 0 ? 0 : as_ >> 1) * (unsigned)(K * ES) + cA_[i_]; } } while (0)
    const size_t kstep = (size_t)(BK * 2);
    const size_t hstep = (size_t)HALF * K * ES;
    const size_t b64_ = (size_t)64 * K * ES;
    const size_t tstep = 2 * hstep;
    const unsigned ldsw = (unsigned)wid * 1024u;
    const int aoff = lds_byte(wr * 64 + fr, fq * 8), boff = lds_byte(wc * 32 + fr, fq * 8);
#define PG8_SA(b, h) (((b) * 2 + (h)) * HTB)
#define PG8_SB(b, h) ((4 + (b) * 2 + (h)) * HTB)
#define PG8_STAGE(bufoff, gbase, voff) do { _Pragma("unroll") for (int _i = 0; _i < 2; ++_i) { unsigned vo_ = (voff)[_i]; asm volatile("" : "+v"(vo_));     \
        __builtin_amdgcn_global_load_lds((const unsigned*)((const char*)(gbase) + vo_), (PG8_LAS unsigned*)(lds + (bufoff) + ldsw + _i * 8192), 16, 0, 0); } } while (0)
#define PG8_STAGEB(bufoff, gbase) do { unsigned vo_ = voffB[0]; asm volatile("" : "+v"(vo_));     \
        __builtin_amdgcn_global_load_lds((const unsigned*)((const char*)(gbase) + vo_), (PG8_LAS unsigned*)(lds + (bufoff) + ldsw), 16, 0, 0); \
        __builtin_amdgcn_global_load_lds((const unsigned*)((const char*)(gbase) + b64_ + vo_), (PG8_LAS unsigned*)(lds + (bufoff) + ldsw + 8192), 16, 0, 0); } while (0)
#define PG8_LDA(dst, b, h) do { _Pragma("unroll") for (int m = 0; m < 4; ++m) _Pragma("unroll") for (int k = 0; k < 2; ++k) dst[m][k] = *(const PG8_LAS bf16x8*)(lds + PG8_SA(b, h) + aoff + m * 2048 + k * 1024); } while (0)
#define PG8_LDB(dst, b, h) do { _Pragma("unroll") for (int n = 0; n < 2; ++n) _Pragma("unroll") for (int k = 0; k < 2; ++k) dst[n][k] = *(const PG8_LAS bf16x8*)(lds + PG8_SB(b, h) + boff + n * 2048 + k * 1024); } while (0)
#define PG8_CAT(f) __builtin_shufflevector(__builtin_bit_cast(i32x4, f[0]), __builtin_bit_cast(i32x4, f[1]), 0, 1, 2, 3, 4, 5, 6, 7)
#define PG8_MMA(ai, bj, At, Bt) do { __builtin_amdgcn_s_setprio(1); _Pragma("unroll") for (int m = 0; m < 4; ++m) _Pragma("unroll") for (int n = 0; n < 2; ++n) { \
        if constexpr (ES == 2) { _Pragma("unroll") for (int k = 0; k < 2; ++k) acc[ai][bj][m][n] = __builtin_amdgcn_mfma_f32_16x16x32_bf16(Bt[n][k], At[m][k], acc[ai][bj][m][n], 0, 0, 0); } \
        else { const i32x8 b8_ = PG8_CAT(Bt[n]), a8_ = PG8_CAT(At[m]); asm volatile("v_mfma_scale_f32_16x16x128_f8f6f4 %0, %1, %2, %0, %3, %3 op_sel_hi:[0,0,0]" : "+v"(acc[ai][bj][m][n]) : "v"(b8_), "v"(a8_), "v"(sc_)); } } __builtin_amdgcn_s_setprio(0); } while (0)
#define PG8_WAIT_V(n) asm volatile("s_waitcnt vmcnt(" #n ")" ::: "memory")
#define PG8_WAIT_L(n) asm volatile("s_waitcnt lgkmcnt(" #n ")" ::: "memory")
#define PG8_BAR __builtin_amdgcn_s_barrier()
#define PG8_SCHED __builtin_amdgcn_sched_barrier(0)
    const int sc_ = g.sc;
    Unit cur, nxt; int ui = 0;
    if (!S.next(0, cur)) return;
    f32x4 acc[2][2][4][2];
#pragma unroll
    for (int a = 0; a < 2; ++a)
#pragma unroll
        for (int b = 0; b < 2; ++b)
#pragma unroll
            for (int m = 0; m < 4; ++m)
#pragma unroll
                for (int n = 0; n < 2; ++n) acc[a][b][m][n] = (f32x4){0.f, 0.f, 0.f, 0.f};
    bf16x8 At[4][2], B0[2][2], B1[2][2];
    const char* cA = (const char*)g.A + (GATHER ? (size_t)0 : (size_t)cur.pm * tstep); const char* cB = (const char*)g.Bt + (size_t)cur.pn * tstep;
    S.a_ready(cur);
    if (GATHER) { PG8_ROWS(cur, gA); }
    const size_t hstepA = GATHER ? (size_t)0 : hstep;
#define PG8_VA(h) (GATHER ? gA[h] : voffA)
    PG8_STAGEB(PG8_SB(0, 0), cB); PG8_STAGE(PG8_SA(0, 0), cA, PG8_VA(0)); PG8_STAGEB(PG8_SB(0, 1), cB + hstep); PG8_STAGE(PG8_SA(0, 1), cA + hstepA, PG8_VA(1));
    if (wr == 1) PG8_BAR;
    PG8_WAIT_V(4); PG8_BAR;
    PG8_STAGEB(PG8_SB(1, 0), cB + kstep); PG8_STAGE(PG8_SA(1, 0), cA + kstep, PG8_VA(0)); PG8_STAGEB(PG8_SB(1, 1), cB + hstep + kstep);
    PG8_WAIT_V(6); PG8_BAR;
    PG8_STAMP();
    for (;;) {
        const bool has_next = S.next(ui + 1, nxt);
        if (GATHER && has_next && wid == 0) { unsigned lo_ = threadIdx.x; asm volatile("" : "+v"(lo_)); lo_ = (lo_ & 63u) * 16u;
            __builtin_amdgcn_global_load_lds((const unsigned*)((const char*)(g.rows + (size_t)nxt.pm * BM) + lo_), (PG8_LAS unsigned*)(lds + STAGE_BYTES + 4096 + ((ui + 1) & 1) * 1024), 16, 0, 0); }
        const char* nA = (has_next && !GATHER) ? (const char*)g.A + (size_t)nxt.pm * tstep : cA; const char* nB = has_next ? (const char*)g.Bt + (size_t)nxt.pn * tstep : cB;
        for (int t = 0; t < nt; t += 2) {
            const bool last = (t == nt - 2);
            const char* a1 = cA + (size_t)(t + 1) * kstep;
            const char* a2 = last ? nA : cA + (size_t)(t + 2) * kstep; const char* b2 = last ? nB : cB + (size_t)(t + 2) * kstep;
            const char* a3 = a2 + kstep; const char* b3 = b2 + kstep;
            if (last && has_next) S.a_ready(nxt);
            if (GATHER) { _Pragma("unroll") for (int h_ = 0; h_ < 2; ++h_) _Pragma("unroll") for (int i_ = 0; i_ < 2; ++i_) v2_[h_][i_] = gA[h_][i_]; }
            if (GATHER && last && has_next) { const PG8_LAS int* rl_ = (const PG8_LAS int*)(lds + STAGE_BYTES + 4096 + ((ui + 1) & 1) * 1024);
                int tq_ = threadIdx.x; asm volatile("" : "+v"(tq_));
                _Pragma("unroll") for (int i_ = 0; i_ < 2; ++i_) { int R_, C_; stage_rc(tq_ * 16 + i_ * 8192, R_, C_);
                    _Pragma("unroll") for (int h_ = 0; h_ < 2; ++h_) { const int as_ = rl_[h_ * HALF + R_]; v2_[h_][i_] = (unsigned)(as_ < 0 ? 0 : as_ >> 1) * (unsigned)(K * ES) + (unsigned)(C_ * 2); } } }
#define PG8_V2(h) (GATHER ? v2_[h] : voffA)
            PG8_LDB(B0, 0, 0); PG8_SCHED; PG8_LDA(At, 0, 0); PG8_STAGE(PG8_SA(1, 1), a1 + hstepA, PG8_VA(1));
            PG8_WAIT_L(8); PG8_BAR; PG8_WAIT_L(0); PG8_MMA(0, 0, At, B0); PG8_BAR; PG8_SCHED;
            PG8_LDB(B1, 0, 1); PG8_STAGEB(PG8_SB(0, 0), b2);
            PG8_BAR; PG8_WAIT_L(0); PG8_MMA(0, 1, At, B1); PG8_BAR;
            PG8_LDA(At, 0, 1); PG8_STAGE(PG8_SA(0, 0), a2, PG8_V2(0));
            PG8_BAR; PG8_WAIT_L(0); PG8_MMA(1, 0, At, B0); PG8_BAR; PG8_SCHED;
            PG8_STAGEB(PG8_SB(0, 1), b2 + hstep);
            PG8_WAIT_V(6); PG8_BAR; PG8_MMA(1, 1, At, B1); PG8_BAR;
            PG8_LDB(B0, 1, 0); PG8_SCHED; PG8_LDA(At, 1, 0); PG8_STAGE(PG8_SA(0, 1), a2 + hstepA, PG8_V2(1));
            PG8_WAIT_L(8); PG8_BAR; PG8_WAIT_L(0); PG8_MMA(0, 0, At, B0); PG8_BAR; PG8_SCHED;
            PG8_LDB(B1, 1, 1); PG8_STAGEB(PG8_SB(1, 0), b3);
            PG8_BAR; PG8_WAIT_L(0); PG8_MMA(0, 1, At, B1); PG8_BAR;
            PG8_LDA(At, 1, 1); PG8_STAGE(PG8_SA(1, 0), a3, PG8_V2(0));
            PG8_BAR; PG8_WAIT_L(0); PG8_MMA(1, 0, At, B0); PG8_BAR; PG8_SCHED;
            PG8_STAGEB(PG8_SB(1, 1), b3 + hstep);
            PG8_WAIT_V(6); PG8_BAR; PG8_MMA(1, 1, At, B1); PG8_BAR;
        }
        PG8_STAMP();
        if constexpr (ES == 1) asm volatile("s_nop 15\n\ts_nop 15\n\ts_nop 15" ::: "memory");
        if constexpr (!Epi::AFTER_DRAIN) { int te_ = threadIdx.x; asm volatile("" : "+v"(te_));
            E(acc, cur, __builtin_amdgcn_readfirstlane(te_ >> 8), __builtin_amdgcn_readfirstlane((te_ >> 6) & 3), te_ & 15, (te_ >> 4) & 3); S.done(cur); }
        PG8_STAMP();
        if (!has_next) break;
#pragma unroll
        for (int a = 0; a < 2; ++a)
#pragma unroll
            for (int b = 0; b < 2; ++b)
#pragma unroll
                for (int m = 0; m < 4; ++m)
#pragma unroll
                    for (int n = 0; n < 2; ++n) acc[a][b][m][n] = (f32x4){0.f, 0.f, 0.f, 0.f};
        cur = nxt; cA = nA; cB = nB; ++ui;
        if (GATHER) { _Pragma("unroll") for (int h_ = 0; h_ < 2; ++h_) _Pragma("unroll") for (int i_ = 0; i_ < 2; ++i_) gA[h_][i_] = v2_[h_][i_]; }
    }
    PG8_WAIT_V(0);
    if (wr == 0) PG8_BAR;
    PG8_BAR;
    if constexpr (Epi::AFTER_DRAIN) { E.fused(acc, cur, wr, wc, fr, fq, lds, wid, lane); S.done(cur); }
    PG8_STAMP();
    if (STAMP && wid == 0) { stamps[lane] = lane < nts ? (((unsigned long long)(unsigned)ts_hi << 32) | (unsigned)ts_lo) : 0ull;
        if (lane == 62) stamps[62] = rt_entry; if (lane == 63) stamps[63] = (unsigned long long)wall_clock64(); }
#undef PG8_STAMP
#undef PG8_SA
#undef PG8_SB
#undef PG8_STAGE
#undef PG8_STAGEB
#undef PG8_LDA
#undef PG8_LDB
#undef PG8_MMA
#undef PG8_CAT
#undef PG8_WAIT_V
#undef PG8_WAIT_L
#undef PG8_BAR
#undef PG8_SCHED
#undef PG8_ROWS
#undef PG8_VA
#undef PG8_V2
}
}

namespace mk {
#define MLAS __attribute__((address_space(3)))
typedef unsigned short bf16_t;
typedef float f32x4 __attribute__((ext_vector_type(4)));
typedef unsigned u32x4 __attribute__((ext_vector_type(4)));
typedef unsigned u32x2 __attribute__((ext_vector_type(2)));

constexpr int D = 1024, NB = 16, SEQ = 4096, LC = 256, TL = NB * SEQ, TC = NB * LC, TT = TL + TC;
constexpr int INC = 4096, NE = 32, DFF = 512, NCH = 34, PMAX = 147456, NT = 512;
constexpr int LDS_BYTES = 150 * 1024, LDS_CTL = LDS_BYTES - 256;
constexpr int C_QA = 0, C_KA = 512, C_VA = 1024, C_QB = 1536, C_KB = 2048, C_VB = 2560, C_GF = 3072, C_GB = 3584;

constexpr size_t al256(size_t x) { return (x + 255) & ~(size_t)255; }
constexpr size_t WS_BAR = 0;
constexpr size_t WS_CNT = 16384;
constexpr size_t WS_ZERO_BYTES = 16384 + 16384;
constexpr size_t WS_MOD = WS_ZERO_BYTES;
constexpr size_t WS_WIN = al256(WS_MOD + (size_t)2 * 17 * 6144 * 4);
constexpr size_t WS_WOUT = WS_WIN + (size_t)2 * 4096 * 1024 * 2;
constexpr size_t WS_WGU = WS_WOUT + (size_t)2 * 1024 * 1024 * 2;
constexpr size_t WS_WDN = WS_WGU + (size_t)32 * 1024 * 1024 * 2;
constexpr size_t WS_CTX = WS_WDN + (size_t)32 * 1024 * 512 * 2;
constexpr size_t WS_H = WS_CTX + (size_t)TC * D * 4;
constexpr size_t WS_PROJ = WS_H + (size_t)TT * D * 2;
constexpr size_t WS_XS = WS_PROJ;
constexpr size_t WS_ACT = WS_PROJ + (size_t)PMAX * D * 2;
constexpr size_t WS_XB = WS_PROJ + (size_t)TT * INC * 2;
constexpr size_t WS_ST = WS_PROJ + (size_t)TT * INC * 2;
constexpr size_t WS_KC = WS_ST;
constexpr size_t WS_VT = WS_KC + (size_t)128 * 4096 * 64 * 2;
constexpr size_t WS_KCC = WS_VT + (size_t)128 * 4096 * 64 * 2;
constexpr size_t WS_VTC = WS_KCC + (size_t)128 * 256 * 64 * 2;
static_assert(WS_VTC + (size_t)128 * 256 * 64 * 2 <= WS_ST + (size_t)NB * 4 * 2 * NCH * 16384 * 2, "NA operand copies fit in the state region");
constexpr size_t WS_TOKE = WS_ST + (size_t)NB * 4 * 2 * NCH * 16384 * 2;
constexpr size_t WS_TOKR = WS_TOKE + (size_t)TT * 2 * 4;
constexpr size_t WS_TOKW = WS_TOKR + (size_t)TT * 2 * 4;
constexpr size_t WS_RINFO = WS_TOKW + (size_t)TT * 2 * 4;
constexpr size_t WS_RW = WS_RINFO + (size_t)PMAX * 4;
constexpr size_t WS_BLKE = WS_RW + (size_t)PMAX * 4;
constexpr size_t WS_RWT = WS_BLKE + 4096;
constexpr size_t WS_BLKB = WS_RWT + (size_t)2 * 32 * 1024 * 2;
constexpr size_t WS_ROPE = WS_BLKB + (size_t)1024 * 32 * 4;
constexpr size_t WS_END = WS_ROPE + (size_t)64 * 32 * 8;
static_assert(WS_ACT + (size_t)PMAX * DFF * 2 <= WS_ST && WS_XB == WS_ST && (size_t)TL * D * 2 <= (size_t)NB * 4 * 2 * NCH * 16384 * 2, "ys | act fit in the proj region, xb in the state region");
static_assert((size_t)TT * 2 * D * 2 <= (size_t)PMAX * D * 2, "y2 fits in xs region");
static_assert(WS_END <= (size_t)1 << 30, "workspace must fit in 1 GiB");

struct Args {
    const float* x; const float* c; const float* ctx; const float* c_ctx; const float* ada_w; const float* ada_b;
    const float* norm_mix_w; const float* norm_ffn_w; const float* w_in; const float* na_q_norm; const float* na_k_norm;
    const float* na_rpb; const float* ret_decay; const float* w_out; const float* router_w; const float* router_bias;
    const float* w_gate; const float* w_up; const float* w_down;
    float* out; unsigned char* ws; int ph_lo, ph_hi;
};

#define LDS_BARRIER() do { asm volatile("s_waitcnt lgkmcnt(0)" ::: "memory"); __builtin_amdgcn_s_barrier(); asm volatile("" ::: "memory"); } while (0)
__device__ __forceinline__ int otid() { int t = threadIdx.x; asm volatile("" : "+v"(t)); return t; }
__device__ __forceinline__ float bf2f(bf16_t v) { return __uint_as_float(((unsigned)v) << 16); }
__device__ __forceinline__ bf16_t f2bf(float f) { unsigned u = __float_as_uint(f); u += 0x7FFFu + ((u >> 16) & 1u); return (bf16_t)(u >> 16); }
typedef float f32x2_t __attribute__((ext_vector_type(2)));
typedef __bf16 bf16x2_t __attribute__((ext_vector_type(2)));
__device__ __forceinline__ unsigned pack2(float lo, float hi) { const f32x2_t v = {lo, hi}; return __builtin_bit_cast(unsigned, __builtin_convertvector(v, bf16x2_t)); }
__device__ __forceinline__ unsigned pack4_fp8(float a, float b, float c, float d) {
    a = __builtin_amdgcn_fmed3f(a, -448.0f, 448.0f); b = __builtin_amdgcn_fmed3f(b, -448.0f, 448.0f); c = __builtin_amdgcn_fmed3f(c, -448.0f, 448.0f); d = __builtin_amdgcn_fmed3f(d, -448.0f, 448.0f);
    int p = __builtin_amdgcn_cvt_pk_fp8_f32(a, b, 0, false); p = __builtin_amdgcn_cvt_pk_fp8_f32(c, d, p, true); return (unsigned)p; }
constexpr float WG8_SCALE = 64.0f, WU8_SCALE = 512.0f, WDN8_SCALE = 32.0f;
constexpr int SC_MOE1 = 0x7c7c7c7c, SC_MOE2 = 0x7b7b7b7b, SC_IN8 = 0x7c7c7c7c;
constexpr float WIN8_SCALE = 64.0f;
constexpr size_t WS_WIN8 = WS_WGU + (size_t)32 * 1024 * 1024;
#ifndef OUT_FP8
#define OUT_FP8 1
#endif
constexpr float MIX8_SCALE = 8.0f, WOUT8_SCALE = 128.0f; constexpr int SC_OUT8 = 0x7a7a7a7a;
constexpr size_t WS_WOUT8 = WS_WGU + (size_t)32 * 1024 * 1024 + (size_t)2 * 4096 * 1024;
#ifndef IN_FP8_MASK
#define IN_FP8_MASK 0xFFFFu
#endif
constexpr unsigned IN_TILES_BF16 = 0xFEDC7610u, IN_TILES_FP8 = 0xBA985432u;
__device__ __forceinline__ bool in_tile_fp8(int pn) { return (IN_FP8_MASK >> pn) & 1u; }
__device__ __forceinline__ float lo16(unsigned w) { return __uint_as_float(w << 16); }
__device__ __forceinline__ float hi16(unsigned w) { return __uint_as_float(w & 0xffff0000u); }
__device__ __forceinline__ float siluf(float v) { return v * __builtin_amdgcn_rcpf(1.0f + __builtin_amdgcn_exp2f(-1.4426950408889634f * v)); }
__device__ __forceinline__ float wave_sum(float v) {
#pragma unroll
    for (int o = 32; o >= 1; o >>= 1) v += __shfl_xor(v, o);
    return v;
}

typedef short bf16x8 __attribute__((ext_vector_type(8)));
typedef float f32x16 __attribute__((ext_vector_type(16)));
__device__ __forceinline__ unsigned off_b(unsigned row, unsigned ch) { return 256u * row + 16u * (ch ^ (((row & 3) << 2) | ((row >> 2) & 3))); }
__device__ __forceinline__ unsigned tr_addr(unsigned row0, unsigned c, unsigned lane) { const unsigned blk = (lane >> 4) & 1, q = (lane & 15) >> 2, p = lane & 3; return off_b(row0 + q, 4 * c + 2 * blk + (p >> 1)) + 8 * (p & 1); }
__device__ __forceinline__ bf16x8 mkfrag(u32x2 lo, u32x2 hi) { const u32x4 w = {lo.x, lo.y, hi.x, hi.y}; return __builtin_bit_cast(bf16x8, w); }
__device__ __forceinline__ int st_frag_idx(int d, int e) { return (((d >> 5) * 4 + (e >> 5)) * 64 + (e & 31) + 32 * ((d >> 2) & 1)) * 16 + (d & 3) + 4 * ((d & 31) >> 3); }
__device__ __forceinline__ const float* modp(const Args& a, int l, int r, int k6) { return (const float*)(a.ws + WS_MOD) + ((size_t)l * 17 + r) * 6144 + k6 * 1024; }

__device__ __forceinline__ bool cvt_is8(bool with_dense, int t) { return !(with_dense && t < 2560) || (t < 2048 ? in_tile_fp8(((t & 63) * 64) >> 8) : OUT_FP8 != 0); }
__device__ __forceinline__ void cvt_addr(const Args& a, bool with_dense, int le, int t, int tid, const float*& lp, bf16_t*& sp) {
    const float* src; bf16_t* dst; int ldn, ldk, k0, n0, nd0;
    if (with_dense && t < 2560) {
        if (t < 2048) { const int l = t >> 10, tt = t & 1023; k0 = (tt >> 6) * 64; n0 = (tt & 63) * 64; nd0 = n0; src = a.w_in + (size_t)l * D * INC; ldn = INC; ldk = D;
            dst = in_tile_fp8(n0 >> 8) ? (bf16_t*)(a.ws + WS_WIN8 + (size_t)l * INC * D) : (bf16_t*)(a.ws + WS_WIN) + (size_t)l * INC * D; }
        else { const int t2 = t - 2048, l = t2 >> 8, tt = t2 & 255; k0 = (tt >> 4) * 64; n0 = (tt & 15) * 64; nd0 = n0; src = a.w_out + (size_t)l * D * D; ldn = D; dst = OUT_FP8 ? (bf16_t*)(a.ws + WS_WOUT8 + (size_t)l * D * D) : (bf16_t*)(a.ws + WS_WOUT) + (size_t)l * D * D; ldk = D; }
    } else {
        const int te = with_dense ? t - 2560 : t, which = te >> 12, tt = te & 4095, e = tt >> 7, r = tt & 127;
        if (which < 2) { k0 = (r >> 3) * 64; n0 = (r & 7) * 64; nd0 = (n0 >> 7) * 256 + which * 128 + (n0 & 127); src = (which == 0 ? a.w_gate : a.w_up) + ((size_t)le * NE + e) * D * DFF; ldn = DFF; dst = (bf16_t*)(a.ws + WS_WGU + (size_t)e * 1024 * D); ldk = D; }
        else { k0 = (r >> 4) * 64; n0 = (r & 15) * 64; nd0 = n0; src = a.w_down + ((size_t)le * NE + e) * DFF * D; ldn = D; dst = (bf16_t*)(a.ws + WS_WDN + (size_t)e * 1024 * DFF); ldk = DFF; }
    }
    lp = src + (size_t)(k0 + (tid >> 3)) * ldn + n0 + (tid & 7) * 8;
    const size_t so = (size_t)(nd0 + (tid >> 3)) * ldk + k0 + (tid & 7) * 8;
    sp = cvt_is8(with_dense, t) ? (bf16_t*)((unsigned char*)dst + so) : dst + so;
}
__device__ __forceinline__ void convert_weights(const Args& a, bool with_dense, int le, MLAS unsigned char* lds, int bid, int nb) {
    MLAS float* tl = (MLAS float*)lds; const int tid = otid();
    const int N = (with_dense ? 2560 : 0) + 3 * 4096;
    const float* lp; bf16_t* sp;
    f32x4 v0 = {0.f, 0.f, 0.f, 0.f}, v1 = v0;
    if (bid < N) { cvt_addr(a, with_dense, le, bid, tid, lp, sp); v0 = *(const f32x4*)lp; v1 = *(const f32x4*)(lp + 4); }
    for (int t = bid; t < N; t += nb) {
        cvt_addr(a, with_dense, le, t, tid, lp, sp);
        LDS_BARRIER();
        { const int kk = tid >> 3, nn0 = (tid & 7) * 8;
#pragma unroll
          for (int j = 0; j < 4; ++j) { tl[kk * 65 + nn0 + j] = v0[j]; tl[kk * 65 + nn0 + 4 + j] = v1[j]; } }
        { const int tn = t + nb < N ? t + nb : t; const float* lpn; bf16_t* spn; cvt_addr(a, with_dense, le, tn, tid, lpn, spn); (void)spn; v0 = *(const f32x4*)lpn; v1 = *(const f32x4*)(lpn + 4); }
        LDS_BARRIER();
        { const int n = tid >> 3, kc = (tid & 7) * 8;
          if (!cvt_is8(with_dense, t)) { u32x4 w;
            w.x = pack2(tl[(kc + 0) * 65 + n], tl[(kc + 1) * 65 + n]); w.y = pack2(tl[(kc + 2) * 65 + n], tl[(kc + 3) * 65 + n]);
            w.z = pack2(tl[(kc + 4) * 65 + n], tl[(kc + 5) * 65 + n]); w.w = pack2(tl[(kc + 6) * 65 + n], tl[(kc + 7) * 65 + n]);
            *(u32x4*)sp = w; }
          else { u32x2 w;
            const int wh_ = (with_dense ? t - 2560 : t) >> 12; const float ws = (with_dense && t < 2048) ? WIN8_SCALE : (with_dense && t < 2560) ? WOUT8_SCALE : wh_ == 0 ? WG8_SCALE : wh_ == 1 ? WU8_SCALE : WDN8_SCALE;
            w.x = pack4_fp8(ws * tl[(kc + 0) * 65 + n], ws * tl[(kc + 1) * 65 + n], ws * tl[(kc + 2) * 65 + n], ws * tl[(kc + 3) * 65 + n]);
            w.y = pack4_fp8(ws * tl[(kc + 4) * 65 + n], ws * tl[(kc + 5) * 65 + n], ws * tl[(kc + 6) * 65 + n], ws * tl[(kc + 7) * 65 + n]);
            *(u32x2*)sp = w; } }
    }
    __syncthreads();
}
__device__ __forceinline__ void convert_small(const Args& a, int bid, int nb) {
    const int tid = otid();
    if (bid == nb - 2) { float* rt = (float*)(a.ws + WS_ROPE);
        for (int i = tid; i < 64 * 32; i += NT) { const float ang = (float)(i >> 5) * exp2f(-(float)(i & 31) * (13.287712379549449f / 32.0f)); float sn, cs; sincosf(ang, &sn, &cs); rt[2 * i] = cs; rt[2 * i + 1] = sn; } }
    if (bid == nb - 1) { bf16_t* rh = (bf16_t*)(a.ws + WS_RWT); bf16_t* rl = rh + 32 * 1024;
        for (int i = tid; i < 32 * 1024; i += NT) { const int e = i >> 10, k = i & 1023; const float w = a.router_w[k * NE + e]; const bf16_t hi = f2bf(w); rh[i] = hi; rl[i] = f2bf(w - bf2f(hi)); } }
}
__device__ __forceinline__ void compute_mod(const Args& a, MLAS unsigned char* lds, int bid, int nb) {
    MLAS float* sc = (MLAS float*)lds;
    MLAS float* red = (MLAS float*)(lds + 17 * 1024 * 4);
    const int tid = otid();
    if (bid >= 192) return;
    for (int i = tid; i < 17 * 1024; i += NT) { const int r = i >> 10, k = i & 1023; const float v = r < 16 ? a.c[r * 1024 + k] : a.c_ctx[k]; sc[i] = v / (1.0f + expf(-v)); }
    __syncthreads();
    for (int u = bid; u < 192; u += nb) {
        const int l = u / 96, n = (u % 96) * 64 + (tid & 63), kp = tid >> 6;
        float acc[17];
#pragma unroll
        for (int r = 0; r < 17; ++r) acc[r] = 0.f;
        const float* w = a.ada_w + (size_t)l * D * 6144 + n;
        for (int k = kp * 128; k < kp * 128 + 128; ++k) { const float wv = w[(size_t)k * 6144];
#pragma unroll
            for (int r = 0; r < 17; ++r) acc[r] += sc[r * 1024 + k] * wv; }
#pragma unroll
        for (int r = 0; r < 17; ++r) red[(kp * 17 + r) * 64 + (tid & 63)] = acc[r];
        __syncthreads();
        for (int i = tid; i < 17 * 64; i += NT) { const int r = i >> 6, cc = i & 63, nn = (u % 96) * 64 + cc; float s = a.ada_b[l * 6144 + nn];
#pragma unroll
            for (int p = 0; p < 8; ++p) s += red[(p * 17 + r) * 64 + cc];
            ((float*)(a.ws + WS_MOD))[((size_t)l * 17 + r) * 6144 + nn] = s; }
        __syncthreads();
    }
}

__device__ __forceinline__ void load_row_f32(const float* src, int e0, int e1, float (&v)[16]) {
    const f32x4 x0 = *(const f32x4*)(src + e0), x1 = *(const f32x4*)(src + e0 + 4), x2 = *(const f32x4*)(src + e1), x3 = *(const f32x4*)(src + e1 + 4);
#pragma unroll
    for (int j = 0; j < 4; ++j) { v[j] = x0[j]; v[4 + j] = x1[j]; v[8 + j] = x2[j]; v[12 + j] = x3[j]; }
}
__device__ __forceinline__ void load_row_bf16(const bf16_t* src, int e0, int e1, float (&v)[16]) {
    const u32x4 w0 = *(const u32x4*)(src + e0), w1 = *(const u32x4*)(src + e1);
#pragma unroll
    for (int j = 0; j < 4; ++j) { v[2 * j] = lo16(w0[j]); v[2 * j + 1] = hi16(w0[j]); v[8 + 2 * j] = lo16(w1[j]); v[8 + 2 * j + 1] = hi16(w1[j]); }
}
__device__ __forceinline__ void moe_combine(const bf16_t* ys, int2 pp, float2 ww, int i, const float (&mg)[16], int e0, int e1, float (&v)[16]) {
    const int p0 = __builtin_amdgcn_readlane(pp.x, i), p1 = __builtin_amdgcn_readlane(pp.y, i);
    const float w0 = __uint_as_float(__builtin_amdgcn_readlane(__float_as_uint(ww.x), i)), w1 = __uint_as_float(__builtin_amdgcn_readlane(__float_as_uint(ww.y), i));
    const bf16_t* ya = ys + (size_t)p0 * D; const bf16_t* yb = ys + (size_t)p1 * D;
    const u32x4 a0 = *(const u32x4*)(ya + e0), a1 = *(const u32x4*)(ya + e1), b0 = *(const u32x4*)(yb + e0), b1 = *(const u32x4*)(yb + e1);
#pragma unroll
    for (int j = 0; j < 4; ++j) {
        v[2 * j] += mg[2 * j] * (w0 * lo16(a0[j]) + w1 * lo16(b0[j])); v[2 * j + 1] += mg[2 * j + 1] * (w0 * hi16(a0[j]) + w1 * hi16(b0[j]));
        v[8 + 2 * j] += mg[8 + 2 * j] * (w0 * lo16(a1[j]) + w1 * lo16(b1[j])); v[8 + 2 * j + 1] += mg[8 + 2 * j + 1] * (w0 * hi16(a1[j]) + w1 * hi16(b1[j])); }
}
__device__ __forceinline__ unsigned char* h8_of(const Args& a) { return (unsigned char*)a.out + (size_t)TL * D * 2; }
__device__ __forceinline__ void phase_norm1(const Args& a, int l, int bid, int nb) {
    const int tid = otid(), lane = tid & 63, wave = __builtin_amdgcn_readfirstlane(tid >> 6);
    const int e0 = lane * 8, e1 = 512 + lane * 8;
    float wn[16];
    { const float* w = a.norm_mix_w + l * D;
#pragma unroll
      for (int j = 0; j < 8; ++j) { wn[j] = w[e0 + j]; wn[8 + j] = w[e1 + j]; } }
    float msc[16], msh[16], mg[16]; int cur_r = -1;
    bf16_t* hb = (bf16_t*)(a.ws + WS_H);
    const bf16_t* y2 = (const bf16_t*)(a.ws + WS_XS);
    const int rper = (TT + nb * 8 - 1) / (nb * 8), row_lo = (bid * 8 + wave) * rper, row_hi = min(row_lo + rper, TT);
    int2 pp = {0, 0}; float2 ww = {0.f, 0.f};
    if (l > 0 && row_lo + lane < row_hi) { pp = *(const int2*)((const int*)(a.ws + WS_TOKR) + (size_t)(row_lo + lane) * 2); ww = *(const float2*)((const float*)(a.ws + WS_TOKW) + (size_t)(row_lo + lane) * 2); }
    for (int row = row_lo; row < row_hi; ++row) {
        const int r = row < TL ? row / SEQ : 16;
        if (r != cur_r) { cur_r = r; const float* sh = modp(a, l, r, 0); const float* sc = modp(a, l, r, 1);
#pragma unroll
            for (int j = 0; j < 8; ++j) { msh[j] = sh[e0 + j]; msh[8 + j] = sh[e1 + j]; msc[j] = 1.0f + sc[e0 + j]; msc[8 + j] = 1.0f + sc[e1 + j]; }
            if (l > 0) { const float* g = modp(a, l - 1, r, 5);
#pragma unroll
                for (int j = 0; j < 8; ++j) { mg[j] = g[e0 + j]; mg[8 + j] = g[e1 + j]; } } }
        float v[16];
        if (l == 0) load_row_f32(row < TL ? a.x + (size_t)row * D : a.ctx + (size_t)(row - TL) * D, e0, e1, v);
        else if (row < TL) load_row_bf16((const bf16_t*)(a.ws + WS_XB) + (size_t)row * D, e0, e1, v);
        else load_row_f32((const float*)(a.ws + WS_CTX) + (size_t)(row - TL) * D, e0, e1, v);
        if (l > 0) {
            moe_combine(y2, pp, ww, row - row_lo, mg, e0, e1, v);
            if (row < TL) { bf16_t* dst = (bf16_t*)a.out + (size_t)row * D;
                *(u32x4*)(dst + e0) = (u32x4){pack2(v[0], v[1]), pack2(v[2], v[3]), pack2(v[4], v[5]), pack2(v[6], v[7])};
                *(u32x4*)(dst + e1) = (u32x4){pack2(v[8], v[9]), pack2(v[10], v[11]), pack2(v[12], v[13]), pack2(v[14], v[15])}; }
        }
        float ss = 0.f;
#pragma unroll
        for (int j = 0; j < 16; ++j) ss += v[j] * v[j];
        ss = wave_sum(ss);
        const float rs = rsqrtf(ss * (1.0f / D) + 1e-6f);
        float y[16];
#pragma unroll
        for (int j = 0; j < 16; ++j) y[j] = v[j] * rs * wn[j] * msc[j] + msh[j];
        if (IN_FP8_MASK != 0xFFFFu) { bf16_t* hp = hb + (size_t)row * D;
        *(u32x4*)(hp + e0) = (u32x4){pack2(y[0], y[1]), pack2(y[2], y[3]), pack2(y[4], y[5]), pack2(y[6], y[7])};
        *(u32x4*)(hp + e1) = (u32x4){pack2(y[8], y[9]), pack2(y[10], y[11]), pack2(y[12], y[13]), pack2(y[14], y[15])}; }
        unsigned char* hp8 = h8_of(a) + (size_t)row * D;
        *(u32x2*)(hp8 + e0) = (u32x2){pack4_fp8(y[0], y[1], y[2], y[3]), pack4_fp8(y[4], y[5], y[6], y[7])};
        *(u32x2*)(hp8 + e1) = (u32x2){pack4_fp8(y[8], y[9], y[10], y[11]), pack4_fp8(y[12], y[13], y[14], y[15])};
    }
}
__device__ __forceinline__ void phase_final(const Args& a, int bid, int nb) {
    const int tid = otid(), lane = tid & 63, wave = __builtin_amdgcn_readfirstlane(tid >> 6);
    const int e0 = lane * 8, e1 = 512 + lane * 8;
    float mg[16]; int cur_r = -1;
    const bf16_t* y2 = (const bf16_t*)(a.ws + WS_XS);
    const int rper = (TL + nb * 8 - 1) / (nb * 8), row_lo = (bid * 8 + wave) * rper, row_hi = min(row_lo + rper, TL);
    int2 pp = {0, 0}; float2 ww = {0.f, 0.f};
    if (row_lo + lane < row_hi) { pp = *(const int2*)((const int*)(a.ws + WS_TOKR) + (size_t)(row_lo + lane) * 2); ww = *(const float2*)((const float*)(a.ws + WS_TOKW) + (size_t)(row_lo + lane) * 2); }
    for (int row = row_lo; row < row_hi; ++row) {
        const int r = row / SEQ;
        if (r != cur_r) { cur_r = r; const float* g = modp(a, 1, r, 5);
#pragma unroll
            for (int j = 0; j < 8; ++j) { mg[j] = g[e0 + j]; mg[8 + j] = g[e1 + j]; } }
        float* src = a.out + (size_t)row * D;
        float v[16];
        load_row_bf16((const bf16_t*)(a.ws + WS_XB) + (size_t)row * D, e0, e1, v);
        moe_combine(y2, pp, ww, row - row_lo, mg, e0, e1, v);
        *(f32x4*)(src + e0) = (f32x4){v[0], v[1], v[2], v[3]}; *(f32x4*)(src + e0 + 4) = (f32x4){v[4], v[5], v[6], v[7]};
        *(f32x4*)(src + e1) = (f32x4){v[8], v[9], v[10], v[11]}; *(f32x4*)(src + e1 + 4) = (f32x4){v[12], v[13], v[14], v[15]};
    }
}

constexpr int VP = 516;
__device__ __forceinline__ void phase_prep(const Args& a, int l, MLAS unsigned char* lds, int bid, int nb) {
    const int tid = otid(), lane = tid & 63, wave = tid >> 6;
    const bf16_t* proj = (const bf16_t*)(a.ws + WS_PROJ);
    MLAS bf16_t* Vs = (MLAS bf16_t*)lds;
    float wk[8];
    { const float* w = a.na_k_norm + l * 64 + (lane & 7) * 8;
#pragma unroll
      for (int j = 0; j < 8; ++j) wk[j] = w[j]; }
    for (int u = bid; u < TT / 64; u += nb) {
        const int R0 = u * 64; const bool lat = R0 < TL;
        const int b = lat ? R0 / SEQ : (R0 - TL) / LC, t0 = lat ? R0 % SEQ : (R0 - TL) % LC, tlen = lat ? SEQ : LC;
        bf16_t* kc = (bf16_t*)(a.ws + (lat ? WS_KC : WS_KCC)); bf16_t* vt = (bf16_t*)(a.ws + (lat ? WS_VT : WS_VTC));
        __syncthreads();
#pragma unroll
        for (int rr = 0; rr < 8; ++rr) {
            const int rl = wave * 8 + rr, row = R0 + rl, t = t0 + rl;
            const bf16_t* p = proj + (size_t)row * INC;
            const u32x4 kw = *(const u32x4*)(p + C_KA + lane * 8), vw = *(const u32x4*)(p + C_VA + lane * 8);
            float f[8];
#pragma unroll
            for (int j = 0; j < 4; ++j) { f[2 * j] = lo16(kw[j]); f[2 * j + 1] = hi16(kw[j]); }
            float ss = 0.f;
#pragma unroll
            for (int j = 0; j < 8; ++j) ss += f[j] * f[j];
            ss += __shfl_xor(ss, 1); ss += __shfl_xor(ss, 2); ss += __shfl_xor(ss, 4);
            const float rs = rsqrtf(ss * (1.0f / 64.0f) + 1e-6f);
            *(u32x4*)(kc + (((size_t)b * 8 + (lane >> 3)) * tlen + t) * 64 + (lane & 7) * 8) =
                (u32x4){pack2(f[0] * rs * wk[0], f[1] * rs * wk[1]), pack2(f[2] * rs * wk[2], f[3] * rs * wk[3]), pack2(f[4] * rs * wk[4], f[5] * rs * wk[5]), pack2(f[6] * rs * wk[6], f[7] * rs * wk[7])};
            *(MLAS u32x2*)(Vs + rl * VP + lane * 8) = (u32x2){vw.x, vw.y}; *(MLAS u32x2*)(Vs + rl * VP + lane * 8 + 4) = (u32x2){vw.z, vw.w};
        }
        __syncthreads();
#pragma unroll
        for (int i = 0; i < 8; ++i) { const int idx = tid + i * NT, d = idx & 63, tc = (idx >> 6) & 7, h = idx >> 9;
            const MLAS bf16_t* vp = Vs + (tc * 8) * VP + h * 64 + d;
            const u32x4 w = {(unsigned)vp[0] | ((unsigned)vp[VP] << 16), (unsigned)vp[2 * VP] | ((unsigned)vp[3 * VP] << 16), (unsigned)vp[4 * VP] | ((unsigned)vp[5 * VP] << 16), (unsigned)vp[6 * VP] | ((unsigned)vp[7 * VP] << 16)};
            const int tk = t0 + tc * 8;
            *(u32x4*)(vt + ((((size_t)b * 8 + h) * (tlen >> 4) + (tk >> 4)) * 64 + d) * 16 + (tk & 15)) = w; }
    }
}

__device__ __forceinline__ int chunk_row0(int b, int c) { return c < 2 ? TL + b * LC + c * 128 : b * SEQ + (c - 2) * 128; }
__device__ __forceinline__ size_t st_index(int b, int h, int dir, int c) { return ((((size_t)b * 4 + h) * 2 + dir) * NCH + c) * 16384; }
constexpr int RP = 136;
__device__ __forceinline__ void load_rope_pair(const bf16_t* p, int a2, int fc, int tok, const MLAS float* rope, float (&y1)[8], float (&y2)[8]) {
    const u32x4 w0 = *(const u32x4*)(p + (a2 * 8 + fc) * 8), w1 = *(const u32x4*)(p + (a2 * 8 + fc + 4) * 8);
#pragma unroll
    for (int j = 0; j < 4; ++j) { y1[2 * j] = lo16(w0[j]); y1[2 * j + 1] = hi16(w0[j]); y2[2 * j] = lo16(w1[j]); y2[2 * j + 1] = hi16(w1[j]); }
    if (tok >= 0) {
        const int pos = a2 == 0 ? (tok >> 6) : (tok & 63);
        const MLAS f32x4* tp = (const MLAS f32x4*)(rope + (pos * 32 + fc * 8) * 2);
#pragma unroll
        for (int q = 0; q < 4; ++q) { const f32x4 cs = tp[q];
            const float u0 = y1[2 * q] * cs[0] - y2[2 * q] * cs[1], v0 = y1[2 * q] * cs[1] + y2[2 * q] * cs[0];
            const float u1 = y1[2 * q + 1] * cs[2] - y2[2 * q + 1] * cs[3], v1 = y1[2 * q + 1] * cs[3] + y2[2 * q + 1] * cs[2];
            y1[2 * q] = u0; y2[2 * q] = v0; y1[2 * q + 1] = u1; y2[2 * q + 1] = v1; }
    }
}
__device__ __forceinline__ void rope_pair_regs(const u32x4 w0, const u32x4 w1, int a2, int fc, int tok, const MLAS float* rope, float (&y1)[8], float (&y2)[8]) {
#pragma unroll
    for (int j = 0; j < 4; ++j) { y1[2 * j] = lo16(w0[j]); y1[2 * j + 1] = hi16(w0[j]); y2[2 * j] = lo16(w1[j]); y2[2 * j + 1] = hi16(w1[j]); }
    if (tok >= 0) {
        const int pos = a2 == 0 ? (tok >> 6) : (tok & 63);
        const MLAS f32x4* tp = (const MLAS f32x4*)(rope + (pos * 32 + fc * 8) * 2);
#pragma unroll
        for (int q = 0; q < 4; ++q) { const f32x4 cs = tp[q];
            const float u0 = y1[2 * q] * cs[0] - y2[2 * q] * cs[1], v0 = y1[2 * q] * cs[1] + y2[2 * q] * cs[0];
            const float u1 = y1[2 * q + 1] * cs[2] - y2[2 * q + 1] * cs[3], v1 = y1[2 * q + 1] * cs[3] + y2[2 * q + 1] * cs[2];
            y1[2 * q] = u0; y2[2 * q] = v0; y1[2 * q + 1] = u1; y2[2 * q + 1] = v1; }
    }
}
__device__ __forceinline__ u32x4 pack8(const float (&y)[8], float sc) { return (u32x4){pack2(y[0] * sc, y[1] * sc), pack2(y[2] * sc, y[3] * sc), pack2(y[4] * sc, y[5] * sc), pack2(y[6] * sc, y[7] * sc)}; }
constexpr float RET_KSCALE = 0.08838834764831845f;
constexpr int LDS_ROPE = 98304;
__device__ __forceinline__ void phase_ret_a(const Args& a, int l, MLAS unsigned char* lds, int bid, int nb) {
    const int tid = otid(), lane = tid & 63, wave = __builtin_amdgcn_readfirstlane(tid >> 6);
    const bf16_t* proj = (const bf16_t*)(a.ws + WS_PROJ); bf16_t* st = (bf16_t*)(a.ws + WS_ST);
    const unsigned ldsb = (unsigned)(size_t)lds;
    const int dir = wave >> 2, dt = wave & 3, hh = lane >> 5;
    MLAS float* rope = (MLAS float*)(lds + LDS_ROPE);
    for (int i = tid; i < 64 * 32 * 2; i += NT) rope[i] = ((const float*)(a.ws + WS_ROPE))[i];
#define RA_LOAD(u_) do { const int b_ = (u_) / (NCH * 4), c_ = ((u_) >> 2) % NCH, h_ = (u_) & 3, row0_ = chunk_row0(b_, c_); _Pragma("unroll") for (int i = 0; i < 2; ++i) { const int idx = tid + i * NT, row = idx >> 3, ch0 = ((idx >> 2) & 1) * 8 + (idx & 3); \
        const bf16_t* src = proj + (size_t)(row0_ + row) * INC + h_ * 128; \
        raw[i][0] = *(const u32x4*)(src + C_KB + ch0 * 8); raw[i][1] = *(const u32x4*)(src + C_KB + (ch0 + 4) * 8); raw[i][2] = *(const u32x4*)(src + C_VB + ch0 * 8); raw[i][3] = *(const u32x4*)(src + C_VB + (ch0 + 4) * 8); } } while (0)
    u32x4 raw[2][4];
    if (bid < NB * NCH * 4) RA_LOAD(bid);
    LDS_BARRIER();
    for (int u = bid; u < NB * NCH * 4; u += nb) {
        const int b = u / (NCH * 4), c = (u >> 2) % NCH, h = u & 3;
        const float lgf = -expf(a.ret_decay[l * 8 + h]), lgb = -expf(a.ret_decay[l * 8 + 4 + h]);
        LDS_BARRIER();
#pragma unroll
        for (int i = 0; i < 2; ++i) { const int idx = tid + i * NT, row = idx >> 3, a2 = (idx >> 2) & 1, fc = idx & 3, ch0 = a2 * 8 + fc;
            float y1[8], y2[8];
            rope_pair_regs(raw[i][0], raw[i][1], a2, fc, c >= 2 ? (c - 2) * 128 + row : -1, rope, y1, y2);
            const float wf = __expf((float)(127 - row) * lgf) * RET_KSCALE, wb = __expf((float)row * lgb) * RET_KSCALE;
            const unsigned o0 = off_b(row, ch0), o1 = off_b(row, ch0 + 4);
            *(MLAS u32x4*)(lds + o0) = pack8(y1, wf); *(MLAS u32x4*)(lds + o1) = pack8(y2, wf);
            *(MLAS u32x4*)(lds + 32768 + o0) = pack8(y1, wb); *(MLAS u32x4*)(lds + 32768 + o1) = pack8(y2, wb);
            *(MLAS u32x4*)(lds + 65536 + o0) = raw[i][2]; *(MLAS u32x4*)(lds + 65536 + o1) = raw[i][3]; }
        { const int un_ = u + nb < NB * NCH * 4 ? u + nb : u; RA_LOAD(un_); }
        LDS_BARRIER();
        f32x16 acc[4];
#pragma unroll
        for (int et = 0; et < 4; ++et)
#pragma unroll
            for (int r = 0; r < 16; ++r) acc[et][r] = 0.f;
        unsigned aK[2], aV[4][2];
#pragma unroll
        for (int t = 0; t < 2; ++t) { aK[t] = ldsb + dir * 32768 + tr_addr(8 * hh + 4 * t, dt, lane);
#pragma unroll
            for (int et = 0; et < 4; ++et) aV[et][t] = ldsb + 65536 + tr_addr(8 * hh + 4 * t, et, lane); }
#pragma unroll
        for (int ks = 0; ks < 8; ++ks) {
            u32x2 r0, r1, r2, r3, r4, r5, r6, r7, r8, r9; const unsigned ko = ks * 4096;
            asm volatile("ds_read_b64_tr_b16 %0, %10\n\tds_read_b64_tr_b16 %1, %11\n\tds_read_b64_tr_b16 %2, %12\n\tds_read_b64_tr_b16 %3, %13\n\tds_read_b64_tr_b16 %4, %14\n\t"
                         "ds_read_b64_tr_b16 %5, %15\n\tds_read_b64_tr_b16 %6, %16\n\tds_read_b64_tr_b16 %7, %17\n\tds_read_b64_tr_b16 %8, %18\n\tds_read_b64_tr_b16 %9, %19\n\ts_waitcnt lgkmcnt(0)"
                         : "=&v"(r0), "=&v"(r1), "=&v"(r2), "=&v"(r3), "=&v"(r4), "=&v"(r5), "=&v"(r6), "=&v"(r7), "=&v"(r8), "=&v"(r9)
                         : "v"(aK[0] + ko), "v"(aK[1] + ko), "v"(aV[0][0] + ko), "v"(aV[0][1] + ko), "v"(aV[1][0] + ko), "v"(aV[1][1] + ko), "v"(aV[2][0] + ko), "v"(aV[2][1] + ko), "v"(aV[3][0] + ko), "v"(aV[3][1] + ko) : "memory");
            const bf16x8 A = mkfrag(r0, r1);
            acc[0] = __builtin_amdgcn_mfma_f32_32x32x16_bf16(A, mkfrag(r2, r3), acc[0], 0, 0, 0);
            acc[1] = __builtin_amdgcn_mfma_f32_32x32x16_bf16(A, mkfrag(r4, r5), acc[1], 0, 0, 0);
            acc[2] = __builtin_amdgcn_mfma_f32_32x32x16_bf16(A, mkfrag(r6, r7), acc[2], 0, 0, 0);
            acc[3] = __builtin_amdgcn_mfma_f32_32x32x16_bf16(A, mkfrag(r8, r9), acc[3], 0, 0, 0);
        }
        bf16_t* o = st + st_index(b, h, dir, c);
#pragma unroll
        for (int et = 0; et < 4; ++et) { bf16_t* p = o + ((dt * 4 + et) * 64 + lane) * 16;
            *(u32x4*)p = (u32x4){pack2(acc[et][0], acc[et][1]), pack2(acc[et][2], acc[et][3]), pack2(acc[et][4], acc[et][5]), pack2(acc[et][6], acc[et][7])};
            *(u32x4*)(p + 8) = (u32x4){pack2(acc[et][8], acc[et][9]), pack2(acc[et][10], acc[et][11]), pack2(acc[et][12], acc[et][13]), pack2(acc[et][14], acc[et][15])}; }
    }
#undef RA_LOAD
}
__device__ __forceinline__ void phase_scan(const Args& a, int l, int bid, int nb) {
    bf16_t* st = (bf16_t*)(a.ws + WS_ST);
#pragma unroll 1
    for (int idx = bid * NT + otid(); idx < NB * 4 * 2 * 2048; idx += nb * NT) {
        const int chain = idx >> 11, v8 = idx & 2047, dir = chain & 1, h = (chain >> 1) & 3;
        const float dec = expf(-128.0f * expf(a.ret_decay[l * 8 + dir * 4 + h]));
        bf16_t* p = st + (size_t)chain * NCH * 16384 + v8 * 8;
        float S[8];
#pragma unroll
        for (int j = 0; j < 8; ++j) S[j] = 0.f;
#pragma unroll 1
        for (int half = 0; half < 2; ++half) {
            u32x4 ls[NCH / 2];
#pragma unroll
            for (int i = 0; i < NCH / 2; ++i) { const int ii = half * (NCH / 2) + i, c = dir == 0 ? ii : (ii < 2 ? 1 - ii : NCH + 1 - ii); ls[i] = *(const u32x4*)(p + (size_t)c * 16384); }
#pragma unroll
            for (int i = 0; i < NCH / 2; ++i) { const int ii = half * (NCH / 2) + i, c = dir == 0 ? ii : (ii < 2 ? 1 - ii : NCH + 1 - ii);
                *(u32x4*)(p + (size_t)c * 16384) = (u32x4){pack2(S[0], S[1]), pack2(S[2], S[3]), pack2(S[4], S[5]), pack2(S[6], S[7])};
#pragma unroll
                for (int t = 0; t < 4; ++t) { S[2 * t] = S[2 * t] * dec + lo16(ls[i][t]); S[2 * t + 1] = S[2 * t + 1] * dec + hi16(ls[i][t]); } }
        }
    }
}
__device__ __forceinline__ void phase_ret_b(const Args& a, int l, MLAS unsigned char* lds, int bid, int nb) {
    const int tid = otid(), lane = tid & 63, wave = __builtin_amdgcn_readfirstlane(tid >> 6);
    const bf16_t* proj = (const bf16_t*)(a.ws + WS_PROJ); const bf16_t* st = (const bf16_t*)(a.ws + WS_ST); bf16_t* mix = (bf16_t*)(a.ws + WS_H);
    const unsigned ldsb = (unsigned)(size_t)lds;
    const int dir = wave >> 2, it = wave & 3, hh = lane >> 5, il = it * 32 + (lane & 31);
    const int c_lo = l == 0 ? 0 : 2, ncu = NCH - c_lo;
    MLAS float* rope = (MLAS float*)(lds + LDS_ROPE);
    for (int i = tid; i < 64 * 32 * 2; i += NT) rope[i] = ((const float*)(a.ws + WS_ROPE))[i];
#define RB_DECODE(u_, b_, c_, h_, row0_) const int b_ = (u_) / (ncu * 4), c_ = c_lo + ((u_) >> 2) % ncu, h_ = (u_) & 3, row0_ = chunk_row0(b_, c_)
#define RB_LOAD(u_) do { RB_DECODE(u_, b_, c_, h_, row0_); (void)c_; _Pragma("unroll") for (int i = 0; i < 2; ++i) { const int idx = tid + i * NT, row = idx >> 3, ch0 = ((idx >> 2) & 1) * 8 + (idx & 3); \
        const bf16_t* src = proj + (size_t)(row0_ + row) * INC + h_ * 128; \
        raw[i][0] = *(const u32x4*)(src + C_QB + ch0 * 8); raw[i][1] = *(const u32x4*)(src + C_QB + (ch0 + 4) * 8); raw[i][2] = *(const u32x4*)(src + C_KB + ch0 * 8); raw[i][3] = *(const u32x4*)(src + C_KB + (ch0 + 4) * 8); \
        raw[i][4] = *(const u32x4*)(src + C_VB + ch0 * 8); raw[i][5] = *(const u32x4*)(src + C_VB + (ch0 + 4) * 8); } } while (0)
    u32x4 raw[2][6];
    if (bid < NB * ncu * 4) RB_LOAD(bid);
    LDS_BARRIER();
    for (int u = bid; u < NB * ncu * 4; u += nb) {
        RB_DECODE(u, b, c, h, row0);
        const float lg = -expf(a.ret_decay[l * 8 + dir * 4 + h]);
        LDS_BARRIER();
#pragma unroll
        for (int i = 0; i < 2; ++i) { const int idx = tid + i * NT, row = idx >> 3, a2 = (idx >> 2) & 1, fc = idx & 3, ch0 = a2 * 8 + fc;
            const int tok = c >= 2 ? (c - 2) * 128 + row : -1;
            const unsigned o0 = off_b(row, ch0), o1 = off_b(row, ch0 + 4);
            float y1[8], y2[8];
            rope_pair_regs(raw[i][0], raw[i][1], a2, fc, tok, rope, y1, y2);
            *(MLAS u32x4*)(lds + o0) = pack8(y1, 1.0f); *(MLAS u32x4*)(lds + o1) = pack8(y2, 1.0f);
            rope_pair_regs(raw[i][2], raw[i][3], a2, fc, tok, rope, y1, y2);
            *(MLAS u32x4*)(lds + 32768 + o0) = pack8(y1, RET_KSCALE); *(MLAS u32x4*)(lds + 32768 + o1) = pack8(y2, RET_KSCALE);
            *(MLAS u32x4*)(lds + 65536 + o0) = raw[i][4]; *(MLAS u32x4*)(lds + 65536 + o1) = raw[i][5]; }
        LDS_BARRIER();
        f32x16 acc[4];
#pragma unroll
        for (int et = 0; et < 4; ++et)
#pragma unroll
            for (int r = 0; r < 16; ++r) acc[et][r] = 0.f;
        {
            const bf16_t* sp = st + st_index(b, h, dir, c) + lane * 16;
#pragma unroll
            for (int dt = 0; dt < 4; ++dt)
#pragma unroll
                for (int s2 = 0; s2 < 2; ++s2) {
                    const u32x2 q0 = *(const MLAS u32x2*)(lds + off_b(il, 4 * dt + 2 * s2) + 8 * hh), q1 = *(const MLAS u32x2*)(lds + off_b(il, 4 * dt + 2 * s2 + 1) + 8 * hh);
                    const bf16x8 Bq = mkfrag(q0, q1);
#pragma unroll
                    for (int et = 0; et < 4; ++et) { const bf16x8 A = __builtin_bit_cast(bf16x8, *(const u32x4*)(sp + (dt * 4 + et) * 1024 + 8 * s2));
                        acc[et] = __builtin_amdgcn_mfma_f32_32x32x16_bf16(A, Bq, acc[et], 0, 0, 0); }
                }
            const float qdec = __expf((float)(dir == 0 ? il + 1 : 128 - il) * lg);
#pragma unroll
            for (int et = 0; et < 4; ++et)
#pragma unroll
                for (int r = 0; r < 16; ++r) acc[et][r] *= qdec;
        }
        bf16x8 Qn[8];
#pragma unroll
        for (int ks = 0; ks < 8; ++ks) Qn[ks] = *(const MLAS bf16x8*)(lds + off_b(il, 2 * ks + hh));
        const int jt_lo = dir == 0 ? 0 : it, jt_hi = dir == 0 ? it : 3;
        for (int jt = jt_lo; jt <= jt_hi; ++jt) {
            f32x16 sc;
#pragma unroll
            for (int r = 0; r < 16; ++r) sc[r] = 0.f;
#pragma unroll
            for (int ks = 0; ks < 8; ++ks) { const bf16x8 A = *(const MLAS bf16x8*)(lds + 32768 + off_b(jt * 32 + (lane & 31), 2 * ks + hh));
                sc = __builtin_amdgcn_mfma_f32_32x32x16_bf16(A, Qn[ks], sc, 0, 0, 0); }
            unsigned pk[8];
#pragma unroll
            for (int r = 0; r < 16; r += 2) {
                const int j0 = jt * 32 + (r & 3) + 8 * (r >> 2) + 4 * hh, j1 = j0 + 1;
                const int d0 = dir == 0 ? il - j0 : j0 - il, d1 = dir == 0 ? il - j1 : j1 - il;
                const float p0 = d0 >= 0 ? sc[r] * __expf((float)d0 * lg) : 0.f, p1 = d1 >= 0 ? sc[r + 1] * __expf((float)d1 * lg) : 0.f;
                pk[r >> 1] = pack2(p0, p1);
            }
            const bf16x8 P0 = __builtin_bit_cast(bf16x8, (u32x4){pk[0], pk[1], pk[2], pk[3]}), P1 = __builtin_bit_cast(bf16x8, (u32x4){pk[4], pk[5], pk[6], pk[7]});
#pragma unroll
            for (int et = 0; et < 4; ++et) {
                u32x2 r0, r1, r2, r3;
                const unsigned a0 = ldsb + 65536 + tr_addr(jt * 32 + 4 * hh, et, lane), a1 = ldsb + 65536 + tr_addr(jt * 32 + 8 + 4 * hh, et, lane);
                const unsigned a2 = ldsb + 65536 + tr_addr(jt * 32 + 16 + 4 * hh, et, lane), a3 = ldsb + 65536 + tr_addr(jt * 32 + 24 + 4 * hh, et, lane);
                asm volatile("ds_read_b64_tr_b16 %0, %4\n\tds_read_b64_tr_b16 %1, %5\n\tds_read_b64_tr_b16 %2, %6\n\tds_read_b64_tr_b16 %3, %7\n\ts_waitcnt lgkmcnt(0)"
                             : "=&v"(r0), "=&v"(r1), "=&v"(r2), "=&v"(r3) : "v"(a0), "v"(a1), "v"(a2), "v"(a3) : "memory");
                acc[et] = __builtin_amdgcn_mfma_f32_32x32x16_bf16(mkfrag(r0, r1), P0, acc[et], 0, 0, 0);
                acc[et] = __builtin_amdgcn_mfma_f32_32x32x16_bf16(mkfrag(r2, r3), P1, acc[et], 0, 0, 0);
            }
        }
        u32x4 gfr[4], gbr[4];
        { const bf16_t* gp = proj + (size_t)(row0 + (tid >> 2)) * INC + h * 128;
#pragma unroll
          for (int k = 0; k < 4; ++k) { const int ch = (tid & 3) * 4 + k; gfr[k] = *(const u32x4*)(gp + C_GF + ch * 8); gbr[k] = *(const u32x4*)(gp + C_GB + ch * 8); } }
        float s1 = 0.f;
#pragma unroll
        for (int et = 0; et < 4; ++et)
#pragma unroll
            for (int r = 0; r < 16; ++r) s1 += acc[et][r];
        s1 += __shfl_xor(s1, 32);
        const float mean = s1 * (1.0f / 128.0f);
        float s2 = 0.f;
#pragma unroll
        for (int et = 0; et < 4; ++et)
#pragma unroll
            for (int r = 0; r < 16; ++r) { const float dlt = acc[et][r] - mean; s2 += dlt * dlt; }
        s2 += __shfl_xor(s2, 32);
        const float rstd = rsqrtf(s2 * (1.0f / 128.0f) + 1e-5f);
        LDS_BARRIER();
#pragma unroll
        for (int et = 0; et < 4; ++et)
#pragma unroll
            for (int g = 0; g < 4; ++g) {
                const u32x2 w = {pack2((acc[et][4 * g] - mean) * rstd, (acc[et][4 * g + 1] - mean) * rstd), pack2((acc[et][4 * g + 2] - mean) * rstd, (acc[et][4 * g + 3] - mean) * rstd)};
                *(MLAS u32x2*)(lds + dir * 32768 + off_b(il, 4 * et + g) + 8 * hh) = w; }
        { const int un_ = u + nb < NB * ncu * 4 ? u + nb : u; RB_LOAD(un_); }
        LDS_BARRIER();
        {
            const int i = tid >> 2, part = tid & 3;
            bf16_t* op = mix + (size_t)(row0 + i) * D + 512 + h * 128;
#pragma unroll
            for (int k = 0; k < 4; ++k) { const int ch = part * 4 + k;
                const u32x4 of = *(const MLAS u32x4*)(lds + off_b(i, ch)), ob = *(const MLAS u32x4*)(lds + 32768 + off_b(i, ch));
                const u32x4 gf = gfr[k], gb = gbr[k];
                if (OUT_FP8) { float f[8];
#pragma unroll
                    for (int t = 0; t < 4; ++t) { f[2 * t] = MIX8_SCALE * (lo16(of[t]) * siluf(lo16(gf[t])) + lo16(ob[t]) * siluf(lo16(gb[t]))); f[2 * t + 1] = MIX8_SCALE * (hi16(of[t]) * siluf(hi16(gf[t])) + hi16(ob[t]) * siluf(hi16(gb[t]))); }
                    *(u32x2*)((unsigned char*)mix + (size_t)(row0 + i) * D + 512 + h * 128 + ch * 8) = (u32x2){pack4_fp8(f[0], f[1], f[2], f[3]), pack4_fp8(f[4], f[5], f[6], f[7])}; }
                else { u32x4 o;
#pragma unroll
                for (int t = 0; t < 4; ++t) o[t] = pack2(lo16(of[t]) * siluf(lo16(gf[t])) + lo16(ob[t]) * siluf(lo16(gb[t])), hi16(of[t]) * siluf(hi16(gf[t])) + hi16(ob[t]) * siluf(hi16(gb[t])));
                *(u32x4*)(op + ch * 8) = o; } }
        }
    }
#undef RB_DECODE
#undef RB_LOAD
}

constexpr int NA_OP = 72;
__device__ __forceinline__ int perm16(int x) { return (x & 3) | ((x & 4) << 1) | ((x & 8) >> 1); }
__device__ __forceinline__ void phase_na(const Args& a, int l, MLAS unsigned char* lds, int bid, int nb) {
    const int tid = otid(), lane = tid & 63, wave = __builtin_amdgcn_readfirstlane(tid >> 6);
    const bf16_t* proj = (const bf16_t*)(a.ws + WS_PROJ); bf16_t* mix = (bf16_t*)(a.ws + WS_H);
    const bf16_t* KC = (const bf16_t*)(a.ws + WS_KC); const bf16_t* VT = (const bf16_t*)(a.ws + WS_VT);
    const bf16_t* KCC = (const bf16_t*)(a.ws + WS_KCC); const bf16_t* VTC = (const bf16_t*)(a.ws + WS_VTC);
    MLAS float* rpb = (MLAS float*)lds;
    MLAS bf16_t* ost = (MLAS bf16_t*)(lds + 8192) + wave * 64 * NA_OP;
    const int n_lat = NB * 8 * 8, n_ctx = l == 0 ? NB * 4 : 0;
    const int hh = lane >> 5, ql = lane & 31;
    for (int u0 = bid; u0 < n_lat + n_ctx; u0 += nb) {
        int u = u0;
        if (nb == 256 && u0 < n_lat) { const int x = bid & 7, j = bid >> 3, i = u0 >> 8; u = ((i * 32 + x * 4 + (j >> 3)) << 3) + (j & 7); }
        const bool is_ctx = u >= n_lat;
        const int v = is_ctx ? u - n_lat : u;
        const int b = is_ctx ? v >> 2 : v >> 6, h = is_ctx ? 2 * (v & 3) + (wave >> 2) : (v >> 3) & 7;
        const int r = (v & 7) * 8 + wave;
        const int qrow0 = is_ctx ? TL + b * LC + (wave & 3) * 64 : b * SEQ + r * 64;
        const size_t bh = (size_t)b * 8 + h;
        __syncthreads();
        if (!is_ctx) for (int i = tid; i < 15 * 128; i += NT) { const int dr = i >> 7, x = (i & 127) - 48; rpb[i] = (x >= 0 && x < 31) ? a.na_rpb[((size_t)l * 8 + h) * 465 + dr * 31 + x] * 1.4426950408889634f : 0.f; }
        __syncthreads();
        bf16x8 Qf[2][4];
#pragma unroll
        for (int qt = 0; qt < 2; ++qt) {
            u32x4 qw[4]; float ss = 0.f;
#pragma unroll
            for (int ks = 0; ks < 4; ++ks) { qw[ks] = *(const u32x4*)(proj + (size_t)(qrow0 + 32 * qt + ql) * INC + C_QA + h * 64 + 16 * ks + 8 * hh);
#pragma unroll
                for (int t = 0; t < 4; ++t) { const float x0 = lo16(qw[ks][t]), x1 = hi16(qw[ks][t]); ss += x0 * x0 + x1 * x1; } }
            ss += __shfl_xor(ss, 32);
            const float rs = rsqrtf(ss * (1.0f / 64.0f) + 1e-6f) * 0.18033688011112042f;
#pragma unroll
            for (int ks = 0; ks < 4; ++ks) { const f32x4 w0 = *(const f32x4*)(a.na_q_norm + l * 64 + 16 * ks + 8 * hh), w1 = *(const f32x4*)(a.na_q_norm + l * 64 + 16 * ks + 8 * hh + 4);
                const u32x4 o = {pack2(lo16(qw[ks][0]) * rs * w0[0], hi16(qw[ks][0]) * rs * w0[1]), pack2(lo16(qw[ks][1]) * rs * w0[2], hi16(qw[ks][1]) * rs * w0[3]),
                                 pack2(lo16(qw[ks][2]) * rs * w1[0], hi16(qw[ks][2]) * rs * w1[1]), pack2(lo16(qw[ks][3]) * rs * w1[2], hi16(qw[ks][3]) * rs * w1[3])};
                Qf[qt][ks] = __builtin_bit_cast(bf16x8, o); }
        }
        f32x16 O[2][2];
#pragma unroll
        for (int qt = 0; qt < 2; ++qt)
#pragma unroll
            for (int i = 0; i < 16; ++i) { O[qt][0][i] = 0.f; O[qt][1][i] = 0.f; }
        float lsum[2] = {0.f, 0.f};
        const int r0 = min(max(r - 4, 0), 56);
        const int kslot = 16 * (ql >> 4) + perm16(ql & 15);
        const bf16_t* kl = KC + (bh * SEQ + (size_t)(r0 + (ql >> 4)) * 64 + perm16(ql & 15)) * 64 + 8 * hh;
        const bf16_t* vl = VT + ((bh * 256 + (size_t)r0 * 4) * 64 + ql) * 16 + 8 * hh;
        const bf16_t* kx = KCC + (bh * LC + kslot) * 64 + 8 * hh;
        const bf16_t* vx = VTC + ((bh * 16) * 64 + ql) * 16 + 8 * hh;
#define NA_PTRS(t, kp, vp, vstep) do { if ((t) < 16) { const int ip_ = (t) >> 2, ct_ = (t) & 3; kp = kl + (size_t)(2 * ip_ * 64 + 16 * ct_) * 64; vp = vl + (2 * ip_ * 4 + ct_) * 1024; vstep = 4096; } \
        else { kp = kx + (size_t)(32 * ((t) - 16)) * 64; vp = vx + ((t) - 16) * 2048; vstep = 1024; } } while (0)
#define NA_LOADS(kp, vp, vstep, Kd, Vd) do { _Pragma("unroll") for (int ks_ = 0; ks_ < 4; ++ks_) Kd[ks_] = *(const u32x4*)(kp + 16 * ks_); \
        Vd[0] = *(const u32x4*)(vp); Vd[1] = *(const u32x4*)(vp + vstep); Vd[2] = *(const u32x4*)(vp + 512); Vd[3] = *(const u32x4*)(vp + 512 + vstep); } while (0)
        const int t_lo = is_ctx ? 16 : 0;
        u32x4 Kn[4], Vn[4];
        { const bf16_t* kp; const bf16_t* vp; int vstep; NA_PTRS(t_lo, kp, vp, vstep); NA_LOADS(kp, vp, vstep, Kn, Vn); }
#pragma unroll 1
        for (int t = t_lo; t < 24; ++t) {
            u32x4 Kc[4], Vc[4];
#pragma unroll
            for (int i = 0; i < 4; ++i) { Kc[i] = Kn[i]; Vc[i] = Vn[i]; }
            if (t + 1 < 24) { const bf16_t* kp; const bf16_t* vp; int vstep; NA_PTRS(t + 1, kp, vp, vstep); NA_LOADS(kp, vp, vstep, Kn, Vn); }
            const int ip = t >> 2, ct = t & 3;
#pragma unroll
            for (int qt = 0; qt < 2; ++qt) {
                if (t < 16 && (unsigned)(ct - qt) > 2u) continue;
                f32x16 sc;
#pragma unroll
                for (int i = 0; i < 16; ++i) sc[i] = 0.f;
#pragma unroll
                for (int ks = 0; ks < 4; ++ks) sc = __builtin_amdgcn_mfma_f32_32x32x16_bf16(__builtin_bit_cast(bf16x8, Kc[ks]), Qf[qt][ks], sc, 0, 0, 0);
                unsigned pk[8];
                if (t < 16) {
                    const int q = qt * 32 + ql, c0 = min(max(q - 8, 0), 48);
#pragma unroll
                    for (int rr = 0; rr < 16; rr += 2) {
                        const int wi = 2 * ip + (rr >> 3), col = 16 * ct + (rr & 3) + 4 * ((rr >> 2) & 1) + 8 * hh;
                        const MLAS float* bp = rpb + (r0 + wi - r + 7) * 128 + (col - q + 63);
                        const float b0 = bp[0], b1 = bp[1];
                        const float e0 = __builtin_amdgcn_exp2f(sc[rr] + b0), e1 = __builtin_amdgcn_exp2f(sc[rr + 1] + b1);
                        const float p0 = (unsigned)(col - c0) < 16u ? e0 : 0.f, p1 = (unsigned)(col + 1 - c0) < 16u ? e1 : 0.f;
                        lsum[qt] += p0 + p1; pk[rr >> 1] = pack2(p0, p1);
                    }
                } else {
#pragma unroll
                    for (int rr = 0; rr < 16; rr += 2) { const float p0 = __builtin_amdgcn_exp2f(sc[rr]), p1 = __builtin_amdgcn_exp2f(sc[rr + 1]); lsum[qt] += p0 + p1; pk[rr >> 1] = pack2(p0, p1); }
                }
                const bf16x8 P0 = __builtin_bit_cast(bf16x8, (u32x4){pk[0], pk[1], pk[2], pk[3]}), P1 = __builtin_bit_cast(bf16x8, (u32x4){pk[4], pk[5], pk[6], pk[7]});
                O[qt][0] = __builtin_amdgcn_mfma_f32_32x32x16_bf16(__builtin_bit_cast(bf16x8, Vc[0]), P0, O[qt][0], 0, 0, 0);
                O[qt][0] = __builtin_amdgcn_mfma_f32_32x32x16_bf16(__builtin_bit_cast(bf16x8, Vc[1]), P1, O[qt][0], 0, 0, 0);
                O[qt][1] = __builtin_amdgcn_mfma_f32_32x32x16_bf16(__builtin_bit_cast(bf16x8, Vc[2]), P0, O[qt][1], 0, 0, 0);
                O[qt][1] = __builtin_amdgcn_mfma_f32_32x32x16_bf16(__builtin_bit_cast(bf16x8, Vc[3]), P1, O[qt][1], 0, 0, 0);
            }
        }
#undef NA_PTRS
#undef NA_LOADS
#pragma unroll
        for (int qt = 0; qt < 2; ++qt) {
            const float inv = 1.0f / (lsum[qt] + __shfl_xor(lsum[qt], 32));
#pragma unroll
            for (int g4 = 0; g4 < 4; ++g4) {
                *(MLAS u32x2*)(ost + (32 * qt + ql) * NA_OP + 8 * g4 + 4 * hh) = (u32x2){pack2(O[qt][0][4 * g4] * inv, O[qt][0][4 * g4 + 1] * inv), pack2(O[qt][0][4 * g4 + 2] * inv, O[qt][0][4 * g4 + 3] * inv)};
                *(MLAS u32x2*)(ost + (32 * qt + ql) * NA_OP + 32 + 8 * g4 + 4 * hh) = (u32x2){pack2(O[qt][1][4 * g4] * inv, O[qt][1][4 * g4 + 1] * inv), pack2(O[qt][1][4 * g4 + 2] * inv, O[qt][1][4 * g4 + 3] * inv)};
            }
        }
#pragma unroll
        for (int k = 0; k < 8; ++k) { const int idx = lane + 64 * k, row = idx >> 3, ch = idx & 7;
            const u32x4 ow = *(const MLAS u32x4*)(ost + row * NA_OP + ch * 8);
            if (OUT_FP8) *(u32x2*)((unsigned char*)mix + (size_t)(qrow0 + row) * D + h * 64 + ch * 8) = (u32x2){pack4_fp8(MIX8_SCALE * lo16(ow.x), MIX8_SCALE * hi16(ow.x), MIX8_SCALE * lo16(ow.y), MIX8_SCALE * hi16(ow.y)), pack4_fp8(MIX8_SCALE * lo16(ow.z), MIX8_SCALE * hi16(ow.z), MIX8_SCALE * lo16(ow.w), MIX8_SCALE * hi16(ow.w))};
            else *(u32x4*)(mix + (size_t)(qrow0 + row) * D + h * 64 + ch * 8) = ow; }
    }
}

constexpr int N2P = 1032;
typedef float f32x4v __attribute__((ext_vector_type(4)));
__device__ __forceinline__ void phase_norm2(const Args& a, int l, MLAS unsigned char* lds, int bid, int nb) {
    const int tid = otid(), lane = tid & 63, wave = __builtin_amdgcn_readfirstlane(tid >> 6);
    const int e0 = lane * 8, e1 = 512 + lane * 8;
    MLAS bf16_t* Ahi = (MLAS bf16_t*)lds; MLAS bf16_t* Alo = Ahi + 16 * N2P; MLAS float* part = (MLAS float*)(Alo + 16 * N2P);
    MLAS float* tsc = part + 8 * 16 * 32; MLAS float* tsh = tsc + 1024; int cur_r = -1;
    bf16_t* hb = (bf16_t*)(a.ws + WS_H);
    int* tok_e = (int*)(a.ws + WS_TOKE); int* tok_r = (int*)(a.ws + WS_TOKR); float* tok_w = (float*)(a.ws + WS_TOKW);
    unsigned* cnt = (unsigned*)(a.ws + WS_CNT) + l * 2048;
    MLAS unsigned* lcnt = (MLAS unsigned*)(tsh + 1024);
    if (tid < NE) lcnt[tid] = 0u;
    const int nrows = l == 0 ? TT : TL;
    bf16x8 Bh[4][2], Bl[4][2];
    { const bf16_t* rh = (const bf16_t*)(a.ws + WS_RWT); const bf16_t* rl = rh + 32 * 1024;
#pragma unroll
      for (int ks = 0; ks < 4; ++ks)
#pragma unroll
        for (int nt = 0; nt < 2; ++nt) { const int o = (nt * 16 + (lane & 15)) * 1024 + 128 * wave + 32 * ks + 8 * (lane >> 4);
            Bh[ks][nt] = __builtin_bit_cast(bf16x8, *(const u32x4*)(rh + o)); Bl[ks][nt] = __builtin_bit_cast(bf16x8, *(const u32x4*)(rl + o)); } }
    const float rbias = a.router_bias[lane & 31];
#define N2_BAR() do { asm volatile("s_waitcnt lgkmcnt(0)" ::: "memory"); __builtin_amdgcn_s_barrier(); asm volatile("" ::: "memory"); } while (0)
#define N2_LOAD(bt, dst) do { _Pragma("unroll") for (int jr_ = 0; jr_ < 2; ++jr_) { const int row_ = (bt) * 16 + 2 * wave + jr_; \
        if (row_ < TL) { const bf16_t* sb_ = (const bf16_t*)(a.ws + WS_XB) + (size_t)row_ * D; dst[jr_][0] = __builtin_bit_cast(f32x4, *(const u32x4*)(sb_ + e0)); dst[jr_][1] = __builtin_bit_cast(f32x4, *(const u32x4*)(sb_ + e1)); } \
        else { const float* src_ = (const float*)(a.ws + WS_CTX) + (size_t)(row_ - TL) * D; \
        dst[jr_][0] = *(const f32x4*)(src_ + e0); dst[jr_][1] = *(const f32x4*)(src_ + e0 + 4); dst[jr_][2] = *(const f32x4*)(src_ + e1); dst[jr_][3] = *(const f32x4*)(src_ + e1 + 4); } } } while (0)
    f32x4 vc[2][4];
    const int nbatch = nrows / 16;
    const int per = (nbatch + nb - 1) / nb, b_lo = bid * per, b_hi = min(b_lo + per, nbatch);
    if (b_lo < b_hi) N2_LOAD(b_lo, vc);
    for (int batch = b_lo; batch < b_hi; ++batch) {
        const int R0 = batch * 16, r = R0 < TL ? R0 / SEQ : 16;
        N2_BAR();
        if (r != cur_r) { cur_r = r; const float* sh = modp(a, l, r, 3); const float* sc = modp(a, l, r, 4); const float* w = a.norm_ffn_w + l * D;
            for (int k = tid; k < D; k += NT) { tsc[k] = (1.0f + sc[k]) * w[k]; tsh[k] = sh[k]; }
            N2_BAR(); }
#pragma unroll
        for (int jr = 0; jr < 2; ++jr) {
            const int m = 2 * wave + jr, row = R0 + m;
            float v[16];
            if (R0 < TL) { const u32x4 w0 = __builtin_bit_cast(u32x4, vc[jr][0]), w1 = __builtin_bit_cast(u32x4, vc[jr][1]);
#pragma unroll
                for (int j = 0; j < 4; ++j) { v[2 * j] = lo16(w0[j]); v[2 * j + 1] = hi16(w0[j]); v[8 + 2 * j] = lo16(w1[j]); v[8 + 2 * j + 1] = hi16(w1[j]); } }
            else {
#pragma unroll
                for (int j = 0; j < 4; ++j) { v[j] = vc[jr][0][j]; v[4 + j] = vc[jr][1][j]; v[8 + j] = vc[jr][2][j]; v[12 + j] = vc[jr][3][j]; } }
            float ss = 0.f;
#pragma unroll
            for (int j = 0; j < 16; ++j) ss += v[j] * v[j];
            ss = wave_sum(ss);
            const float rs = rsqrtf(ss * (1.0f / D) + 1e-6f);
            unsigned ph[8], pl[8], p8[4]; float yk0 = 0.f, yk1 = 0.f;
            float msc[16], msh[16];
#pragma unroll
            for (int q = 0; q < 2; ++q) { const f32x4 c0 = *(const MLAS f32x4*)(tsc + e0 + 4 * q), c1 = *(const MLAS f32x4*)(tsc + e1 + 4 * q), h0 = *(const MLAS f32x4*)(tsh + e0 + 4 * q), h1 = *(const MLAS f32x4*)(tsh + e1 + 4 * q);
#pragma unroll
                for (int j = 0; j < 4; ++j) { msc[4 * q + j] = c0[j]; msc[8 + 4 * q + j] = c1[j]; msh[4 * q + j] = h0[j]; msh[8 + 4 * q + j] = h1[j]; } }
#pragma unroll
            for (int j = 0; j < 16; j += 2) {
                const float y0 = v[j] * rs * msc[j] + msh[j], y1 = v[j + 1] * rs * msc[j + 1] + msh[j + 1];
                const bf16_t h0 = f2bf(y0), h1 = f2bf(y1);
                ph[j >> 1] = (unsigned)h0 | ((unsigned)h1 << 16); pl[j >> 1] = pack2(y0 - bf2f(h0), y1 - bf2f(h1));
                if (j & 2) p8[j >> 2] = pack4_fp8(yk0, yk1, y0, y1); else { yk0 = y0; yk1 = y1; } }
            unsigned char* hp = (unsigned char*)hb + (size_t)row * D;
            *(u32x2*)(hp + e0) = (u32x2){p8[0], p8[1]}; *(u32x2*)(hp + e1) = (u32x2){p8[2], p8[3]};
            *(MLAS u32x4*)(Ahi + m * N2P + e0) = (u32x4){ph[0], ph[1], ph[2], ph[3]}; *(MLAS u32x4*)(Ahi + m * N2P + e1) = (u32x4){ph[4], ph[5], ph[6], ph[7]};
            *(MLAS u32x4*)(Alo + m * N2P + e0) = (u32x4){pl[0], pl[1], pl[2], pl[3]}; *(MLAS u32x4*)(Alo + m * N2P + e1) = (u32x4){pl[4], pl[5], pl[6], pl[7]};
        }
        if (batch + 1 < b_hi) N2_LOAD(batch + 1, vc);
        N2_BAR();
        {
            f32x4v acc0 = {0.f, 0.f, 0.f, 0.f}, acc1 = {0.f, 0.f, 0.f, 0.f};
#pragma unroll
            for (int ks = 0; ks < 4; ++ks) {
                const int o = (lane & 15) * N2P + 128 * wave + 32 * ks + 8 * (lane >> 4);
                const bf16x8 ah = *(const MLAS bf16x8*)(Ahi + o), al = *(const MLAS bf16x8*)(Alo + o);
                acc0 = __builtin_amdgcn_mfma_f32_16x16x32_bf16(ah, Bh[ks][0], acc0, 0, 0, 0); acc0 = __builtin_amdgcn_mfma_f32_16x16x32_bf16(al, Bh[ks][0], acc0, 0, 0, 0); acc0 = __builtin_amdgcn_mfma_f32_16x16x32_bf16(ah, Bl[ks][0], acc0, 0, 0, 0);
                acc1 = __builtin_amdgcn_mfma_f32_16x16x32_bf16(ah, Bh[ks][1], acc1, 0, 0, 0); acc1 = __builtin_amdgcn_mfma_f32_16x16x32_bf16(al, Bh[ks][1], acc1, 0, 0, 0); acc1 = __builtin_amdgcn_mfma_f32_16x16x32_bf16(ah, Bl[ks][1], acc1, 0, 0, 0);
            }
#pragma unroll
            for (int rg = 0; rg < 4; ++rg) { const int m = 4 * (lane >> 4) + rg; part[(wave * 16 + m) * 32 + (lane & 15)] = acc0[rg]; part[(wave * 16 + m) * 32 + 16 + (lane & 15)] = acc1[rg]; }
        }
        N2_BAR();
        {
            const int m = tid >> 5, ex = tid & 31, hb32 = lane & 32, row = R0 + m;
            float acc = 0.f;
#pragma unroll
            for (int w8 = 0; w8 < 8; ++w8) acc += part[(w8 * 16 + m) * 32 + ex];
            const float sg = 1.0f / (1.0f + __expf(-acc)), ssel = sg + rbias;
            float best = -1e30f; int grp = 0;
#pragma unroll
            for (int g = 0; g < 8; ++g) {
                const float v0 = __shfl(ssel, hb32 + g * 4), v1 = __shfl(ssel, hb32 + g * 4 + 1), v2 = __shfl(ssel, hb32 + g * 4 + 2), v3 = __shfl(ssel, hb32 + g * 4 + 3);
                const float hi01 = fmaxf(v0, v1), lo01 = fminf(v0, v1), hi23 = fmaxf(v2, v3), lo23 = fminf(v2, v3);
                const float top = fmaxf(hi01, hi23), second = fmaxf(fminf(hi01, hi23), hi01 >= hi23 ? lo01 : lo23);
                const float gs = top + second;
                if (gs > best) { best = gs; grp = g; }
            }
            float w4[4], s4[4];
#pragma unroll
            for (int j = 0; j < 4; ++j) { w4[j] = __shfl(ssel, hb32 + grp * 4 + j); s4[j] = __shfl(sg, hb32 + grp * 4 + j); }
            int i0 = 0;
#pragma unroll
            for (int j = 1; j < 4; ++j) if (w4[j] > w4[i0]) i0 = j;
            int i1 = i0 == 0 ? 1 : 0;
#pragma unroll
            for (int j = 0; j < 4; ++j) if (j != i0 && j != i1 && w4[j] > w4[i1]) i1 = j;
            float g0 = 0.f, g1 = 0.f;
#pragma unroll
            for (int j = 0; j < 4; ++j) { g0 = (j == i0) ? s4[j] : g0; g1 = (j == i1) ? s4[j] : g1; }
            const float inv = 1.0f / (g0 + g1);
            if (ex < 2) {
                const int e = grp * 4 + (ex == 0 ? i0 : i1);
                const unsigned rank = __hip_atomic_fetch_add(lcnt + e, 1u, __ATOMIC_RELAXED, __HIP_MEMORY_SCOPE_WORKGROUP);
                tok_e[row * 2 + ex] = e; tok_r[row * 2 + ex] = (int)rank; tok_w[row * 2 + ex] = (ex == 0 ? g0 : g1) * inv;
            }
        }
    }
    N2_BAR();
    if (tid < NE) ((int*)(a.ws + WS_BLKB))[bid * NE + tid] = (int)atomicAdd(cnt + tid * 32, lcnt[tid]);
#undef N2_BAR
#undef N2_LOAD
}
__device__ __forceinline__ void phase_gather(const Args& a, int l, MLAS unsigned char* lds, int bid, int nb) {
    const int tid = otid(), lane = tid & 63, wave = tid >> 6;
    MLAS int* pbase = (MLAS int*)lds;
    MLAS int* cn = pbase + 64;
    const unsigned* cnt = (const unsigned*)(a.ws + WS_CNT) + l * 2048; const int* blkb = (const int*)(a.ws + WS_BLKB);
    if (tid == 0) { int acc = 0; for (int e = 0; e < NE; ++e) { const int c = (int)__hip_atomic_load(cnt + e * 32, __ATOMIC_RELAXED, __HIP_MEMORY_SCOPE_AGENT); cn[e] = c; pbase[e] = acc; acc += (c + 255) & ~255; } pbase[NE] = acc; }
    __syncthreads();
    int* rinfo = (int*)(a.ws + WS_RINFO); float* rw = (float*)(a.ws + WS_RW); int* blke = (int*)(a.ws + WS_BLKE);
    if (bid == 0) {
        for (int e = 0; e < NE; ++e) {
            for (int p = pbase[e] + cn[e] + tid; p < pbase[e + 1]; p += NT) { rinfo[p] = -1; rw[p] = 0.f; }
            for (int blk = (pbase[e] >> 8) + tid; blk < (pbase[e + 1] >> 8); blk += NT) blke[blk] = e;
        }
        if (tid == 0) blke[1023] = (pbase[NE] >> 8) * 4;
    }
    const int* tok_e = (const int*)(a.ws + WS_TOKE); const int* tok_r = (const int*)(a.ws + WS_TOKR); const float* tok_w = (const float*)(a.ws + WS_TOKW);
    const int nas = (l == 0 ? TT : TL) * 2, per_ = ((l == 0 ? TT : TL) / 16 + nb - 1) / nb;
    for (int as = bid * NT + tid; as < nas; as += nb * NT) {
        const int t = as >> 1, e = tok_e[as], pos = pbase[e] + blkb[((t >> 4) / per_) * NE + e] + tok_r[as];
        rinfo[pos] = as; ((int*)(a.ws + WS_TOKR))[as] = pos;
    }
}

using pg8::Unit;
struct EpiStoreBf16 {
    static constexpr bool PERM = true, AFTER_DRAIN = false;
    bf16_t* O; int ldc; bf16_t* kc_lat; bf16_t* vt_lat; bf16_t* kc_ctx; bf16_t* vt_ctx; const float* knw; MLAS unsigned char* sp;
    __device__ __forceinline__ void operator()(const f32x4 (&acc)[2][2][4][2], const Unit& u, int wr, int wc, int fr, int fq) const {
        const int row0 = u.pm * 256 + wr * 64 + fr;
        if (u.pn < 2 || u.pn > 5) {
            const int col0 = u.pn * 256 + wc * 32 + 8 * fq;
#pragma unroll
            for (int ai = 0; ai < 2; ++ai)
#pragma unroll
                for (int m = 0; m < 4; ++m) { bf16_t* rowp = O + (size_t)(row0 + ai * 128 + m * 16) * ldc + col0;
#pragma unroll
                    for (int bj = 0; bj < 2; ++bj) { const f32x4 v0 = acc[ai][bj][m][0], v1 = acc[ai][bj][m][1];
                        *(u32x4*)(rowp + bj * 128) = (u32x4){pg8::cvt_pk_bf16(v0[0], v0[1]), pg8::cvt_pk_bf16(v0[2], v0[3]), pg8::cvt_pk_bf16(v1[0], v1[1]), pg8::cvt_pk_bf16(v1[2], v1[3])}; } }
            return;
        }
        const bool lat = u.pm < 256;
        if (u.pn < 4) {
            MLAS float* part = (MLAS float*)sp;
            float ss[2][4][2];
#pragma unroll
            for (int ai = 0; ai < 2; ++ai)
#pragma unroll
                for (int m = 0; m < 4; ++m)
#pragma unroll
                    for (int bj = 0; bj < 2; ++bj) { const f32x4 v0 = acc[ai][bj][m][0], v1 = acc[ai][bj][m][1];
                        float q = (v0[0] * v0[0] + v0[1] * v0[1]) + (v0[2] * v0[2] + v0[3] * v0[3]) + (v1[0] * v1[0] + v1[1] * v1[1]) + (v1[2] * v1[2] + v1[3] * v1[3]);
                        q += __shfl_xor(q, 16); q += __shfl_xor(q, 32); ss[ai][m][bj] = q;
                        if (fq == 0) part[((((ai * 4 + m) * 2 + bj) * 2 + wr) * 16 + fr) * 4 + wc] = q; }
            asm volatile("s_waitcnt lgkmcnt(0)" ::: "memory"); __builtin_amdgcn_s_barrier(); asm volatile("" ::: "memory");
            const f32x4 w0 = *(const f32x4*)(knw + (wc & 1) * 32 + 8 * fq), w1 = *(const f32x4*)(knw + (wc & 1) * 32 + 8 * fq + 4);
#pragma unroll
            for (int ai = 0; ai < 2; ++ai)
#pragma unroll
                for (int m = 0; m < 4; ++m) { const int row = row0 + ai * 128 + m * 16;
                    const int b = lat ? row >> 12 : (row - TL) >> 8, t = lat ? row & (SEQ - 1) : (row - TL) & (LC - 1), tlen = lat ? SEQ : LC;
                    bf16_t* kb = (lat ? kc_lat : kc_ctx);
#pragma unroll
                    for (int bj = 0; bj < 2; ++bj) {
                        const float other = part[((((ai * 4 + m) * 2 + bj) * 2 + wr) * 16 + fr) * 4 + (wc ^ 1)];
                        const float rs = rsqrtf((ss[ai][m][bj] + other) * (1.0f / 64.0f) + 1e-6f);
                        const f32x4 v0 = acc[ai][bj][m][0] * rs * w0, v1 = acc[ai][bj][m][1] * rs * w1;
                        const int head = (u.pn - 2) * 4 + 2 * bj + (wc >> 1);
                        *(u32x4*)(kb + (((size_t)b * 8 + head) * tlen + t) * 64 + (wc & 1) * 32 + 8 * fq) = (u32x4){pg8::cvt_pk_bf16(v0[0], v0[1]), pg8::cvt_pk_bf16(v0[2], v0[3]), pg8::cvt_pk_bf16(v1[0], v1[1]), pg8::cvt_pk_bf16(v1[2], v1[3])}; } }
            return;
        }
        {
            MLAS bf16_t* gb = (MLAS bf16_t*)(sp + wr * 8192);
            bf16_t* vb = lat ? vt_lat : vt_ctx; const int ngrp = lat ? SEQ / 16 : LC / 16;
#pragma unroll
            for (int ai = 0; ai < 2; ++ai)
#pragma unroll
                for (int m = 0; m < 4; ++m) {
#pragma unroll
                    for (int bj = 0; bj < 2; ++bj)
#pragma unroll
                        for (int n = 0; n < 2; ++n) { const f32x4 v = acc[ai][bj][m][n]; const int c = bj * 128 + wc * 32 + 8 * fq + 4 * n;
                            const unsigned p01 = pg8::cvt_pk_bf16(v[0], v[1]), p23 = pg8::cvt_pk_bf16(v[2], v[3]);
                            gb[(c + 0) * 16 + fr] = (bf16_t)(p01 & 0xffffu); gb[(c + 1) * 16 + fr] = (bf16_t)(p01 >> 16);
                            gb[(c + 2) * 16 + fr] = (bf16_t)(p23 & 0xffffu); gb[(c + 3) * 16 + fr] = (bf16_t)(p23 >> 16); }
                    asm volatile("s_waitcnt lgkmcnt(0)" ::: "memory"); __builtin_amdgcn_s_barrier(); asm volatile("" ::: "memory");
                    const int rowb = u.pm * 256 + ai * 128 + wr * 64 + m * 16;
                    const int b = lat ? rowb >> 12 : (rowb - TL) >> 8, g16 = (lat ? rowb & (SEQ - 1) : (rowb - TL) & (LC - 1)) >> 4;
#pragma unroll
                    for (int k = 0; k < 2; ++k) { const int qd = wc * 64 + fr + 16 * fq + 256 * k, c = qd >> 1, half = qd & 1;
                        const u32x4 w = *(const MLAS u32x4*)(gb + c * 16 + 8 * half);
                        const int head = (u.pn - 4) * 4 + (c >> 6), d = c & 63;
                        *(u32x4*)(vb + ((((size_t)b * 8 + head) * ngrp + g16) * 64 + d) * 16 + 8 * half) = w; }
                    asm volatile("s_waitcnt lgkmcnt(0)" ::: "memory"); __builtin_amdgcn_s_barrier(); asm volatile("" ::: "memory");
                }
        }
    }
};
struct EpiResGate {
    static constexpr bool PERM = true, AFTER_DRAIN = false;
    const void* xin_lat; const float* xin_ctx; bf16_t* out_lat; float* out_ctx; const float* modl; int in_bf16;
    __device__ __forceinline__ void operator()(const f32x4 (&acc)[2][2][4][2], const Unit& u, int wr, int wc, int fr, int fq) const {
        const bool lat = u.pm < 256; const int r = lat ? (u.pm >> 4) : 16;
        const int rowt = (lat ? u.pm : u.pm - 256) * 256 + wr * 64 + fr, col0 = u.pn * 256 + wc * 32 + 8 * fq;
        const float* g = modl + (size_t)r * 6144 + 2 * 1024 + col0;
        f32x4 gv[2][2];
#pragma unroll
        for (int bj = 0; bj < 2; ++bj)
#pragma unroll
            for (int n = 0; n < 2; ++n) gv[bj][n] = *(const f32x4*)(g + bj * 128 + 4 * n);
#pragma unroll
        for (int ai = 0; ai < 2; ++ai)
#pragma unroll
            for (int m = 0; m < 4; ++m) { const size_t off = (size_t)(rowt + ai * 128 + m * 16) * D + col0;
#pragma unroll
                for (int bj = 0; bj < 2; ++bj) {
                    f32x4 x0, x1;
                    if (!lat) { x0 = *(const f32x4*)(xin_ctx + off + bj * 128); x1 = *(const f32x4*)(xin_ctx + off + bj * 128 + 4); }
                    else if (in_bf16) { const u32x4 w = *(const u32x4*)((const bf16_t*)xin_lat + off + bj * 128); x0 = (f32x4){lo16(w.x), hi16(w.x), lo16(w.y), hi16(w.y)}; x1 = (f32x4){lo16(w.z), hi16(w.z), lo16(w.w), hi16(w.w)}; }
                    else { x0 = *(const f32x4*)((const float*)xin_lat + off + bj * 128); x1 = *(const f32x4*)((const float*)xin_lat + off + bj * 128 + 4); }
                    x0 += gv[bj][0] * acc[ai][bj][m][0]; x1 += gv[bj][1] * acc[ai][bj][m][1];
                    if (lat) *(u32x4*)(out_lat + off + bj * 128) = (u32x4){pack2(x0[0], x0[1]), pack2(x0[2], x0[3]), pack2(x1[0], x1[1]), pack2(x1[2], x1[3])};
                    else { *(f32x4*)(out_ctx + off + bj * 128) = x0; *(f32x4*)(out_ctx + off + bj * 128 + 4) = x1; } } }
    }
};
struct EpiSwiglu {
    static constexpr bool PERM = true, AFTER_DRAIN = false;
    bf16_t* act;
    __device__ __forceinline__ void operator()(const f32x4 (&acc)[2][2][4][2], const Unit& u, int wr, int wc, int fr, int fq) const {
        const int row0 = u.pm * 256 + wr * 64 + fr, col0 = (u.pn & 3) * 128 + wc * 32 + 8 * fq;
#pragma unroll
        for (int ai = 0; ai < 2; ++ai)
#pragma unroll
            for (int m = 0; m < 4; ++m) { float r[8];
#pragma unroll
                for (int n = 0; n < 2; ++n)
#pragma unroll
                    for (int j = 0; j < 4; ++j) { const float gt = acc[ai][0][m][n][j]; r[n * 4 + j] = siluf(gt) * acc[ai][1][m][n][j]; }
                *(u32x2*)((unsigned char*)act + (size_t)(row0 + ai * 128 + m * 16) * DFF + col0) = (u32x2){pack4_fp8(r[0], r[1], r[2], r[3]), pack4_fp8(r[4], r[5], r[6], r[7])}; }
    }
};
struct EpiDown {
    static constexpr bool PERM = true, AFTER_DRAIN = false;
    bf16_t* ys;
    __device__ __forceinline__ void operator()(const f32x4 (&acc)[2][2][4][2], const Unit& u, int wr, int wc, int fr, int fq) const {
        const int row0 = u.pm * 256 + wr * 64 + fr, col0 = (u.pn & 3) * 256 + wc * 32 + 8 * fq;
#pragma unroll
        for (int ai = 0; ai < 2; ++ai)
#pragma unroll
            for (int m = 0; m < 4; ++m) { bf16_t* rowp = ys + (size_t)(row0 + ai * 128 + m * 16) * D + col0;
#pragma unroll
                for (int bj = 0; bj < 2; ++bj) { const f32x4 v0 = acc[ai][bj][m][0], v1 = acc[ai][bj][m][1];
                    *(u32x4*)(rowp + bj * 128) = (u32x4){pg8::cvt_pk_bf16(v0[0], v0[1]), pg8::cvt_pk_bf16(v0[2], v0[3]), pg8::cvt_pk_bf16(v1[0], v1[1]), pg8::cvt_pk_bf16(v1[2], v1[3])}; } }
    }
};
struct SubsetOrder {
    pg8::StaticOrder base; unsigned map;
    __device__ __forceinline__ bool next(int i, Unit& u) const { if (!base.next(i, u)) return false; u.pn = (int)((map >> (4 * u.pn)) & 15u); return true; }
    __device__ __forceinline__ void a_ready(const Unit&) const {}
    __device__ __forceinline__ void done(const Unit&) const {}
};
struct MoeOrder {
    const MLAS int* blke; int nunits, G, c;
    __device__ __forceinline__ bool next(int i, Unit& u) const { const int x = c & 7, j = c >> 3; int L;
        if (G == 256) { const int rb = i * 64 + (j >> 2) * 8 + x; L = rb * 4 + (j & 3); } else L = i * G + c;
        if (L >= nunits) return false; u.pm = L >> 2; u.pn = blke[L >> 2] * 4 + (L & 3); return true; }
    __device__ __forceinline__ void a_ready(const Unit&) const {}
    __device__ __forceinline__ void done(const Unit&) const {}
};

typedef const Args __attribute__((address_space(4))) CArgs;
#define MK_LOAD_ARGS(a, p) do { (a).x = (p)->x; (a).c = (p)->c; (a).ctx = (p)->ctx; (a).c_ctx = (p)->c_ctx; (a).ada_w = (p)->ada_w; (a).ada_b = (p)->ada_b; (a).norm_mix_w = (p)->norm_mix_w; (a).norm_ffn_w = (p)->norm_ffn_w; (a).w_in = (p)->w_in; (a).na_q_norm = (p)->na_q_norm; (a).na_k_norm = (p)->na_k_norm; (a).na_rpb = (p)->na_rpb; (a).ret_decay = (p)->ret_decay; (a).w_out = (p)->w_out; (a).router_w = (p)->router_w; (a).router_bias = (p)->router_bias; (a).w_gate = (p)->w_gate; (a).w_up = (p)->w_up; (a).w_down = (p)->w_down; (a).out = (p)->out; (a).ws = (p)->ws; (a).ph_lo = (p)->ph_lo; (a).ph_hi = (p)->ph_hi; } while (0)
#ifndef MK_SINGLE
#define MK_SINGLE 1
#endif
constexpr int NPHASES = 24;
#ifndef MK_PROBE_MASK
#define MK_PROBE_MASK 0
#endif
#ifndef MK_BAR2
#define MK_BAR2 0
#endif
#ifndef MK_PROBE_MULT
#define MK_PROBE_MULT 4
#endif
enum { K_PRO = 0, K_NORM1, K_GEMM_IN, K_PREP, K_NA, K_RET_A, K_SCAN, K_RET_B, K_GEMM_OUT, K_NORM2, K_GATHER, K_MOE1, K_MOE2, K_FINAL };
__global__ void __launch_bounds__(NT, 2) fwd(Args ka) {
    extern __shared__ __attribute__((aligned(16))) unsigned char lds_raw[];
    MLAS unsigned char* lds = (MLAS unsigned char*)lds_raw;
    const int tid = threadIdx.x, nb = gridDim.x;
    volatile MLAS unsigned* ctl = (volatile MLAS unsigned*)(lds + LDS_CTL);
    if (tid < 4) ctl[tid] = 0u;
    __syncthreads();
    const bool multi = MK_SINGLE != 0;
    XcdBarrier bar; bar.bar = (unsigned*)(ka.ws + WS_BAR); bar.x = 0; bar.st = ctl;
    if (multi) bar = xcd_barrier_post((unsigned*)(ka.ws + WS_BAR), ctl);
    int ph = 0;
#if MK_SINGLE
#define MK_GUARD 1
#define MK_SEAM(kind) ((kind) != K_FINAL)
#else
#define MK_GUARD (ph >= ka.ph_lo && ph < ka.ph_hi)
#define MK_SEAM(kind) (ph + 1 < ka.ph_hi)
#endif
#define PHASE(kind, ...) do { if (MK_GUARD) { CArgs* ap_ = (CArgs*)__builtin_amdgcn_kernarg_segment_ptr(); asm volatile("" : "+s"(ap_)); Args a; MK_LOAD_ARGS(a, ap_); int bid = blockIdx.x; asm volatile("" : "+s"(bid)); unsigned long long t0_ = 0; if ((MK_PROBE_MASK >> (kind)) & 1) t0_ = wall_clock64(); { __VA_ARGS__; } if ((MK_PROBE_MASK >> (kind)) & 1) { const unsigned long long d_ = wall_clock64() - t0_; while (wall_clock64() - t0_ < d_ * (MK_PROBE_MULT + 1)) __builtin_amdgcn_s_sleep(8); } if (MK_SEAM(kind)) { XcdBarrier b_ = bar; asm volatile("" : "+s"(b_.bar), "+s"(b_.x)); xcd_barrier(b_); if (MK_BAR2) { xcd_barrier(b_); xcd_barrier(b_); } } } ++ph; } while (0)
    PHASE(K_PRO, { convert_small(a, bid, nb); convert_weights(a, true, 0, lds, bid, nb); compute_mod(a, lds, bid, nb); });
#define MK_LAYER(l) do { \
        PHASE(K_NORM1, { phase_norm1(a, l, bid, nb); if (l == 1) convert_weights(a, false, 1, lds, bid, nb); }); \
        PHASE(K_GEMM_IN, { EpiStoreBf16 E{(bf16_t*)(a.ws + WS_PROJ), INC, (bf16_t*)(a.ws + WS_KC), (bf16_t*)(a.ws + WS_VT), (bf16_t*)(a.ws + WS_KCC), (bf16_t*)(a.ws + WS_VTC), a.na_k_norm + l * 64, lds + 131072}; \
                if (IN_FP8_MASK == 0xFFFFu) { pg8::Gemm g{(const bf16_t*)h8_of(a), (const bf16_t*)(a.ws + WS_WIN8 + (size_t)l * INC * D), TT, INC, D, nullptr, SC_IN8}; \
                  pg8::StaticOrder S; S.init(TT, INC, nb, bid); \
                  pg8::gemm_phase<EpiStoreBf16, pg8::StaticOrder, false, false, 1>(lds, g, S, E, nullptr); } \
                else { \
                { pg8::Gemm g{(const bf16_t*)(a.ws + WS_H), (const bf16_t*)(a.ws + WS_WIN) + (size_t)l * INC * D, TT, INC, D}; \
                  SubsetOrder S; S.base.init(TT, INC / 2, nb, bid); S.map = IN_TILES_BF16; \
                  pg8::gemm_phase<EpiStoreBf16, SubsetOrder>(lds, g, S, E, nullptr); } \
                { pg8::Gemm g{(const bf16_t*)h8_of(a), (const bf16_t*)(a.ws + WS_WIN8 + (size_t)l * INC * D), TT, INC, D, nullptr, SC_IN8}; \
                  SubsetOrder S; S.base.init(TT, INC / 2, nb, nb - 1 - bid); S.map = IN_TILES_FP8;     \
                  pg8::gemm_phase<EpiStoreBf16, SubsetOrder, false, false, 1>(lds, g, S, E, nullptr); } } }); \
        PHASE(K_NA, phase_na(a, l, lds, bid, nb)); \
        PHASE(K_RET_A, phase_ret_a(a, l, lds, bid, nb)); \
        PHASE(K_SCAN, phase_scan(a, l, bid, nb)); \
        PHASE(K_RET_B, phase_ret_b(a, l, lds, bid, nb)); \
        PHASE(K_GEMM_OUT, { const int M = l == 0 ? TT : TL; \
                pg8::Gemm g{(const bf16_t*)(a.ws + WS_H), OUT_FP8 ? (const bf16_t*)(a.ws + WS_WOUT8 + (size_t)l * D * D) : (const bf16_t*)(a.ws + WS_WOUT) + (size_t)l * D * D, M, D, D, nullptr, SC_OUT8}; \
                pg8::StaticOrder S; S.init(M, D, nb, bid); \
                EpiResGate E{l == 0 ? (const void*)a.x : (const void*)a.out, a.ctx, (bf16_t*)(a.ws + WS_XB), (float*)(a.ws + WS_CTX), (const float*)(a.ws + WS_MOD) + (size_t)l * 17 * 6144, l}; \
                pg8::gemm_phase<EpiResGate, pg8::StaticOrder, false, false, OUT_FP8 ? 1 : 2>(lds, g, S, E, nullptr); }); \
        PHASE(K_NORM2, phase_norm2(a, l, lds, bid, nb)); \
        PHASE(K_GATHER, phase_gather(a, l, lds, bid, nb)); \
        PHASE(K_MOE1, { MLAS int* blke = (MLAS int*)(lds + 131072); { const int* gb_ = (const int*)(a.ws + WS_BLKE); for (int i_ = otid(); i_ < 1024; i_ += NT) blke[i_] = gb_[i_]; __syncthreads(); } \
                pg8::Gemm g{(const bf16_t*)(a.ws + WS_H), (const bf16_t*)(a.ws + WS_WGU), PMAX, NE * 1024, D, (const int*)(a.ws + WS_RINFO), SC_MOE1}; \
                MoeOrder S{blke, blke[1023], nb, bid}; \
                EpiSwiglu E{(bf16_t*)(a.ws + WS_ACT)}; \
                pg8::gemm_phase<EpiSwiglu, MoeOrder, false, true, 1>(lds, g, S, E, nullptr); }); \
        PHASE(K_MOE2, { MLAS int* blke = (MLAS int*)(lds + 131072); { const int* gb_ = (const int*)(a.ws + WS_BLKE); for (int i_ = otid(); i_ < 1024; i_ += NT) blke[i_] = gb_[i_]; __syncthreads(); } \
                pg8::Gemm g{(const bf16_t*)(a.ws + WS_ACT), (const bf16_t*)(a.ws + WS_WDN), PMAX, NE * 1024, DFF, nullptr, SC_MOE2}; \
                MoeOrder S{blke, blke[1023], nb, bid}; \
                EpiDown E{(bf16_t*)(a.ws + WS_XS)}; \
                pg8::gemm_phase<EpiDown, MoeOrder, false, false, 1>(lds, g, S, E, nullptr); }); \
    } while (0)
    MK_LAYER(0);
    MK_LAYER(1);
#undef MK_LAYER
    PHASE(K_FINAL, phase_final(a, bid, nb));
#undef PHASE
}
}

extern "C" void kernel_launch(void* const* d_in, const int* in_sizes, int n_in, void* d_out, int out_size, void* d_ws, size_t ws_size, hipStream_t stream) {
    using namespace mk;
    static int grid = 0;
    if (grid == 0) {
        if (n_in != 19 || in_sizes[0] != TL * D || out_size != TL * D || ws_size < WS_END) {
            fprintf(stderr, "kernel_launch: unexpected shapes / workspace (n_in %d, in0 %d, out %d, ws %zu, need %zu); nothing launched\n", n_in, n_in > 0 ? in_sizes[0] : -1, out_size, ws_size, (size_t)WS_END);
            grid = -1; return; }
        int dev = 0, cus = 0, per_cu = 0;
        if (hipGetDevice(&dev) != hipSuccess || hipDeviceGetAttribute(&cus, hipDeviceAttributeMultiprocessorCount, dev) != hipSuccess) { grid = -1; return; }
        if (hipFuncSetAttribute((const void*)fwd, hipFuncAttributeMaxDynamicSharedMemorySize, LDS_BYTES) != hipSuccess) { fprintf(stderr, "kernel_launch: hipFuncSetAttribute failed\n"); grid = -1; return; }
        if (hipOccupancyMaxActiveBlocksPerMultiprocessor(&per_cu, (const void*)fwd, NT, LDS_BYTES) != hipSuccess || per_cu < 1) { fprintf(stderr, "kernel_launch: occupancy query says %d\n", per_cu); (void)hipGetLastError(); grid = -1; return; }
        grid = cus;
    }
    if (grid < 0) return;
    (void)hipMemsetAsync((char*)d_ws + WS_BAR, 0, WS_ZERO_BYTES, stream);
    Args a{};
    a.x = (const float*)d_in[0]; a.c = (const float*)d_in[1]; a.ctx = (const float*)d_in[2]; a.c_ctx = (const float*)d_in[3]; a.ada_w = (const float*)d_in[4]; a.ada_b = (const float*)d_in[5];
    a.norm_mix_w = (const float*)d_in[6]; a.norm_ffn_w = (const float*)d_in[7]; a.w_in = (const float*)d_in[8]; a.na_q_norm = (const float*)d_in[9]; a.na_k_norm = (const float*)d_in[10];
    a.na_rpb = (const float*)d_in[11]; a.ret_decay = (const float*)d_in[12]; a.w_out = (const float*)d_in[13]; a.router_w = (const float*)d_in[14]; a.router_bias = (const float*)d_in[15];
    a.w_gate = (const float*)d_in[16]; a.w_up = (const float*)d_in[17]; a.w_down = (const float*)d_in[18];
    a.out = (float*)d_out; a.ws = (unsigned char*)d_ws;
#if MK_SINGLE
    a.ph_lo = 0; a.ph_hi = NPHASES;
    hipLaunchKernelGGL(fwd, dim3(grid), dim3(NT), LDS_BYTES, stream, a);
#else
    for (int ph = 0; ph < NPHASES; ++ph) { a.ph_lo = ph; a.ph_hi = ph + 1; hipLaunchKernelGGL(fwd, dim3(grid), dim3(NT), LDS_BYTES, stream, a); }
#endif
}
```

```cpp
#include <hip/hip_runtime.h>
#include <cstdio>
#include <cstdint>


#define XB_TMO      128
#define XB_XCNT(j)  (256  + 64 * (j))
#define XB_XSUB(j)  (1280 + 64 * (j))
#define XB_XGEN(j)  (2304 + 64 * (j))
#define XB_TOP      3328
#define XB_TOPGEN   3392
#define XCD_BAR_WORDS 3456
#define XB_SPIN_CAP (1u << 18)
#define LAS __attribute__((address_space(3)))

__device__ __forceinline__ unsigned xb_ld(unsigned* p)              { return __hip_atomic_load(p, __ATOMIC_RELAXED, __HIP_MEMORY_SCOPE_AGENT); }
__device__ __forceinline__ unsigned xb_add(unsigned* p, unsigned v) { return __hip_atomic_fetch_add(p, v, __ATOMIC_RELAXED, __HIP_MEMORY_SCOPE_AGENT); }
__device__ __forceinline__ unsigned xb_xcc_id() { return (unsigned)__builtin_amdgcn_s_getreg((3 << 11) | 20) & 0xFu; }
#define XB_SPIN(cond, bar) do { unsigned _sp = 0; while (cond) { __builtin_amdgcn_s_sleep(1); \
    if ((++_sp & 255u) == 0u) { if (xb_ld(&(bar)[XB_TMO])) break; if (_sp > XB_SPIN_CAP) { atomicAdd(&(bar)[XB_TMO], 1u); break; } } } } while (0)

struct XcdBarrier {
    unsigned* bar; unsigned x;
    volatile LAS unsigned* st;
};

__device__ __forceinline__ XcdBarrier xcd_barrier_post(unsigned* bar, volatile LAS unsigned* st) {
    XcdBarrier b; b.bar = bar; b.x = xb_xcc_id(); b.st = st;
    if (threadIdx.x == 0) (void)xb_add(&bar[XB_XCNT(b.x)], 1u);
    return b;
}
__device__ __forceinline__ void xcd_barrier_complete(unsigned* bar, unsigned x, unsigned& nloc, unsigned& nx) {
    const unsigned G = gridDim.x * gridDim.y * gridDim.z;
    unsigned sum, cnt, mine, sp = 0u;
    for (;;) {
        sum = 0u; cnt = 0u; mine = 0u;
#pragma unroll
        for (unsigned j = 0; j < 16; ++j) { const unsigned c = xb_ld(&bar[XB_XCNT(j)]); sum += c; cnt += (c > 0u) ? 1u : 0u; mine = (j == x) ? c : mine; }
        if (sum == G) break;
        __builtin_amdgcn_s_sleep(1);
        if ((++sp & 255u) == 0u) { if (xb_ld(&bar[XB_TMO])) break; if (sp > XB_SPIN_CAP) { atomicAdd(&bar[XB_TMO], 1u); break; } }
    }
    nloc = mine > 0u ? mine : 1u; nx = cnt > 0u ? cnt : 1u;
}

__device__ __forceinline__ void xcd_barrier(const XcdBarrier& b) {
    asm volatile("s_waitcnt vmcnt(0)" ::: "memory");
    __syncthreads();
    if (threadIdx.x == 0) {
        unsigned* bar = b.bar;
        __builtin_amdgcn_s_waitcnt(0);
        unsigned nloc = b.st[0], nx = b.st[1];
        if (nloc == 0u) { xcd_barrier_complete(bar, b.x, nloc, nx); b.st[0] = nloc; b.st[1] = nx; }
        const unsigned old = xb_add(&bar[XB_XSUB(b.x)], 1u);
        const unsigned gen = old / nloc;
        if (old + 1u == (gen + 1u) * nloc) {
            __builtin_amdgcn_fence(__ATOMIC_RELEASE, "agent");
            asm volatile("s_waitcnt vmcnt(0)" ::: "memory");
            const unsigned og = xb_add(&bar[XB_TOP], 1u);
            const unsigned tg = og / nx;
            if (og + 1u == (tg + 1u) * nx) xb_add(&bar[XB_TOPGEN], 1u);
            else XB_SPIN(xb_ld(&bar[XB_TOPGEN]) == tg, bar);
            __builtin_amdgcn_fence(__ATOMIC_ACQUIRE, "agent");
            xb_add(&bar[XB_XGEN(b.x)], 1u);
            asm volatile("s_waitcnt vmcnt(0)" ::: "memory");
        } else {
            XB_SPIN(xb_ld(&bar[XB_XGEN(b.x)]) == gen, bar);
            __builtin_amdgcn_fence(__ATOMIC_ACQUIRE, "agent");
            asm volatile("s_waitcnt vmcnt(0)" ::: "memory");
        }
    }
    __syncthreads();
}
namespace pg8 {
#define PG8_LAS __attribute__((address_space(3)))
typedef unsigned short bf16_t;
typedef short bf16x8 __attribute__((ext_vector_type(8)));
typedef float f32x4 __attribute__((ext_vector_type(4)));
typedef unsigned u32x4 __attribute__((ext_vector_type(4)));
constexpr int BM = 256, BK = 64, HALF = 128, HTB = HALF * BK * 2  , STAGE_BYTES = 8 * HTB, NXCD = 8, WGM = 8;

__host__ __device__ __forceinline__ int lds_byte(int r, int c) { const int st = (r >> 4) * 2 + (c >> 5), rr = r & 15, cc = c & 31, ob = rr * 64 + cc * 2; return st * 1024 + (ob ^ (((ob >> 9) & 1) << 5)); }
__host__ __device__ __forceinline__ void stage_rc(int b, int& R, int& C) { const int st = b / 1024, sb = b % 1024, swz = sb ^ (((sb >> 9) & 1) << 5); R = (st >> 1) * 16 + swz / 64; C = (st & 1) * 32 + (swz % 64) / 2; }
typedef int i32x4 __attribute__((ext_vector_type(4)));
typedef int i32x8 __attribute__((ext_vector_type(8)));
__host__ __device__ __forceinline__ int perm32(int rho) { const int n = rho >> 4, i = rho & 15; return 8 * (i >> 2) + 4 * n + (i & 3); }

struct Unit { int pm, pn; };
struct Gemm { const bf16_t* A; const bf16_t* Bt; int M, N, K; const int* rows = nullptr; int sc = 0x7f7f7f7f; };

struct StaticOrder {
    int nM, nN, nwg, G, c;
    __host__ __device__ void init(int M, int N, int G_, int c_) { nM = M / BM; nN = N / BM; nwg = nM * nN; G = G_; c = c_; }
    __host__ __device__ bool next(int i, Unit& u) const {
        const long L = (long)i * G + c; if (L >= nwg) return false;
        int wgid = (int)L; { const int q = nwg / NXCD, r = nwg % NXCD, xcd = wgid % NXCD, off = wgid / NXCD; wgid = (xcd < r ? xcd * (q + 1) : r * (q + 1) + (xcd - r) * q) + off; }
        const int nig = WGM * nN, gid = wgid / nig, fm = gid * WGM, gsz = (nM - fm) < WGM ? (nM - fm) : WGM;
        u.pm = fm + ((wgid % nig) % gsz); u.pn = (wgid % nig) / gsz; return true;
    }
    __device__ __forceinline__ void a_ready(const Unit&) const {}
    __device__ __forceinline__ void done(const Unit&) const {}
};
__device__ __forceinline__ unsigned cvt_pk_bf16(float lo, float hi) { unsigned r; asm volatile("v_cvt_pk_bf16_f32 %0, %1, %2" : "=v"(r) : "v"(lo), "v"(hi)); return r; }
typedef float f32x2 __attribute__((ext_vector_type(2)));
template <class Epi, class Sched, bool STAMP = false, bool GATHER = false, int ES = 2>
__device__ __forceinline__ void gemm_phase(PG8_LAS unsigned char* lds, const Gemm g, const Sched& S, const Epi& E, unsigned long long* stamps) {
    int tid_o_ = threadIdx.x; asm volatile("" : "+v"(tid_o_)); const int tid = tid_o_, wid = __builtin_amdgcn_readfirstlane(tid >> 6), lane = tid & 63, wr = wid >> 2, wc = wid & 3, fr = lane & 15, fq = lane >> 4;
    const int K = g.K, nt = K * ES / (BK * 2);
    int ts_lo = 0, ts_hi = 0, nts = 0; const unsigned long long rt_entry = STAMP ? (unsigned long long)wall_clock64() : 0ull;
#define PG8_STAMP() do { if (STAMP && wid == 0 && nts < 64) { const unsigned long long _c = (unsigned long long)clock64(); \
        ts_lo = (lane == nts) ? (int)(unsigned)_c : ts_lo; ts_hi = (lane == nts) ? (int)(unsigned)(_c >> 32) : ts_hi; ++nts; } } while (0)
    PG8_STAMP();
    unsigned voffA[2], voffB[2]; int rA_[2]; unsigned cA_[2];
#pragma unroll
    for (int i = 0; i < 2; ++i) { int R, C; stage_rc(tid * 16 + i * 8192, R, C); C *= 2; const int Rb = Epi::PERM ? ((R & ~31) + perm32(R & 31)) : R;
        voffA[i] = (unsigned)(R * K * ES + C); voffB[i] = (unsigned)(Rb * K * ES + C); rA_[i] = R; cA_[i] = (unsigned)C; }
    unsigned gA[2][2], v2_[2][2];
#define PG8_ROWS(u, dst) do { _Pragma("unroll") for (int h_ = 0; h_ < 2; ++h_) _Pragma("unroll") for (int i_ = 0; i_ < 2; ++i_) { const int as_ = g.rows[(u).pm * BM + h_ * HALF + rA_[i_]]; \
        dst[h_][i_] = (unsigned)(as_ < 0 ? 0 : as_ >> 1) * (unsigned)(K * ES) + cA_[i_]; } } while (0)
    const size_t kstep = (size_t)(BK * 2);
    const size_t hstep = (size_t)HALF * K * ES;
    const size_t b64_ = (size_t)64 * K * ES;
    const size_t tstep = 2 * hstep;
    const unsigned ldsw = (unsigned)wid * 1024u;
    const int aoff = lds_byte(wr * 64 + fr, fq * 8), boff = lds_byte(wc * 32 + fr, fq * 8);
#define PG8_SA(b, h) (((b) * 2 + (h)) * HTB)
#define PG8_SB(b, h) ((4 + (b) * 2 + (h)) * HTB)
#define PG8_STAGE(bufoff, gbase, voff) do { _Pragma("unroll") for (int _i = 0; _i < 2; ++_i) { unsigned vo_ = (voff)[_i]; asm volatile("" : "+v"(vo_));     \
        __builtin_amdgcn_global_load_lds((const unsigned*)((const char*)(gbase) + vo_), (PG8_LAS unsigned*)(lds + (bufoff) + ldsw + _i * 8192), 16, 0, 0); } } while (0)
#define PG8_STAGEB(bufoff, gbase) do { unsigned vo_ = voffB[0]; asm volatile("" : "+v"(vo_));     \
        __builtin_amdgcn_global_load_lds((const unsigned*)((const char*)(gbase) + vo_), (PG8_LAS unsigned*)(lds + (bufoff) + ldsw), 16, 0, 0); \
        __builtin_amdgcn_global_load_lds((const unsigned*)((const char*)(gbase) + b64_ + vo_), (PG8_LAS unsigned*)(lds + (bufoff) + ldsw + 8192), 16, 0, 0); } while (0)
#define PG8_LDA(dst, b, h) do { _Pragma("unroll") for (int m = 0; m < 4; ++m) _Pragma("unroll") for (int k = 0; k < 2; ++k) dst[m][k] = *(const PG8_LAS bf16x8*)(lds + PG8_SA(b, h) + aoff + m * 2048 + k * 1024); } while (0)
#define PG8_LDB(dst, b, h) do { _Pragma("unroll") for (int n = 0; n < 2; ++n) _Pragma("unroll") for (int k = 0; k < 2; ++k) dst[n][k] = *(const PG8_LAS bf16x8*)(lds + PG8_SB(b, h) + boff + n * 2048 + k * 1024); } while (0)
#define PG8_CAT(f) __builtin_shufflevector(__builtin_bit_cast(i32x4, f[0]), __builtin_bit_cast(i32x4, f[1]), 0, 1, 2, 3, 4, 5, 6, 7)
#define PG8_MMA(ai, bj, At, Bt) do { __builtin_amdgcn_s_setprio(1); _Pragma("unroll") for (int m = 0; m < 4; ++m) _Pragma("unroll") for (int n = 0; n < 2; ++n) { \
        if constexpr (ES == 2) { _Pragma("unroll") for (int k = 0; k < 2; ++k) acc[ai][bj][m][n] = __builtin_amdgcn_mfma_f32_16x16x32_bf16(Bt[n][k], At[m][k], acc[ai][bj][m][n], 0, 0, 0); } \
        else { const i32x8 b8_ = PG8_CAT(Bt[n]), a8_ = PG8_CAT(At[m]); asm volatile("v_mfma_scale_f32_16x16x128_f8f6f4 %0, %1, %2, %0, %3, %3 op_sel_hi:[0,0,0]" : "+v"(acc[ai][bj][m][n]) : "v"(b8_), "v"(a8_), "v"(sc_)); } } __builtin_amdgcn_s_setprio(0); } while (0)
#define PG8_WAIT_V(n) asm volatile("s_waitcnt vmcnt(" #n ")" ::: "memory")
#define PG8_WAIT_L(n) asm volatile("s_waitcnt lgkmcnt(" #n ")" ::: "memory")
#define PG8_BAR __builtin_amdgcn_s_barrier()
#define PG8_SCHED __builtin_amdgcn_sched_barrier(0)
    const int sc_ = g.sc;
    Unit cur, nxt; int ui = 0;
    if (!S.next(0, cur)) return;
    f32x4 acc[2][2][4][2];
#pragma unroll
    for (int a = 0; a < 2; ++a)
#pragma unroll
        for (int b = 0; b < 2; ++b)
#pragma unroll
            for (int m = 0; m < 4; ++m)
#pragma unroll
                for (int n = 0; n < 2; ++n) acc[a][b][m][n] = (f32x4){0.f, 0.f, 0.f, 0.f};
    bf16x8 At[4][2], B0[2][2], B1[2][2];
    const char* cA = (const char*)g.A + (GATHER ? (size_t)0 : (size_t)cur.pm * tstep); const char* cB = (const char*)g.Bt + (size_t)cur.pn * tstep;
    S.a_ready(cur);
    if (GATHER) { PG8_ROWS(cur, gA); }
    const size_t hstepA = GATHER ? (size_t)0 : hstep;
#define PG8_VA(h) (GATHER ? gA[h] : voffA)
    PG8_STAGEB(PG8_SB(0, 0), cB); PG8_STAGE(PG8_SA(0, 0), cA, PG8_VA(0)); PG8_STAGEB(PG8_SB(0, 1), cB + hstep); PG8_STAGE(PG8_SA(0, 1), cA + hstepA, PG8_VA(1));
    if (wr == 1) PG8_BAR;
    PG8_WAIT_V(4); PG8_BAR;
    PG8_STAGEB(PG8_SB(1, 0), cB + kstep); PG8_STAGE(PG8_SA(1, 0), cA + kstep, PG8_VA(0)); PG8_STAGEB(PG8_SB(1, 1), cB + hstep + kstep);
    PG8_WAIT_V(6); PG8_BAR;
    PG8_STAMP();
    for (;;) {
        const bool has_next = S.next(ui + 1, nxt);
        if (GATHER && has_next && wid == 0) { unsigned lo_ = threadIdx.x; asm volatile("" : "+v"(lo_)); lo_ = (lo_ & 63u) * 16u;
            __builtin_amdgcn_global_load_lds((const unsigned*)((const char*)(g.rows + (size_t)nxt.pm * BM) + lo_), (PG8_LAS unsigned*)(lds + STAGE_BYTES + 4096 + ((ui + 1) & 1) * 1024), 16, 0, 0); }
        const char* nA = (has_next && !GATHER) ? (const char*)g.A + (size_t)nxt.pm * tstep : cA; const char* nB = has_next ? (const char*)g.Bt + (size_t)nxt.pn * tstep : cB;
        for (int t = 0; t < nt; t += 2) {
            const bool last = (t == nt - 2);
            const char* a1 = cA + (size_t)(t + 1) * kstep;
            const char* a2 = last ? nA : cA + (size_t)(t + 2) * kstep; const char* b2 = last ? nB : cB + (size_t)(t + 2) * kstep;
            const char* a3 = a2 + kstep; const char* b3 = b2 + kstep;
            if (last && has_next) S.a_ready(nxt);
            if (GATHER) { _Pragma("unroll") for (int h_ = 0; h_ < 2; ++h_) _Pragma("unroll") for (int i_ = 0; i_ < 2; ++i_) v2_[h_][i_] = gA[h_][i_]; }
            if (GATHER && last && has_next) { const PG8_LAS int* rl_ = (const PG8_LAS int*)(lds + STAGE_BYTES + 4096 + ((ui + 1) & 1) * 1024);
                int tq_ = threadIdx.x; asm volatile("" : "+v"(tq_));
                _Pragma("unroll") for (int i_ = 0; i_ < 2; ++i_) { int R_, C_; stage_rc(tq_ * 16 + i_ * 8192, R_, C_);
                    _Pragma("unroll") for (int h_ = 0; h_ < 2; ++h_) { const int as_ = rl_[h_ * HALF + R_]; v2_[h_][i_] = (unsigned)(as_ < 0 ? 0 : as_ >> 1) * (unsigned)(K * ES) + (unsigned)(C_ * 2); } } }
#define PG8_V2(h) (GATHER ? v2_[h] : voffA)
            PG8_LDB(B0, 0, 0); PG8_SCHED; PG8_LDA(At, 0, 0); PG8_STAGE(PG8_SA(1, 1), a1 + hstepA, PG8_VA(1));
            PG8_WAIT_L(8); PG8_BAR; PG8_WAIT_L(0); PG8_MMA(0, 0, At, B0); PG8_BAR; PG8_SCHED;
            PG8_LDB(B1, 0, 1); PG8_STAGEB(PG8_SB(0, 0), b2);
            PG8_BAR; PG8_WAIT_L(0); PG8_MMA(0, 1, At, B1); PG8_BAR;
            PG8_LDA(At, 0, 1); PG8_STAGE(PG8_SA(0, 0), a2, PG8_V2(0));
            PG8_BAR; PG8_WAIT_L(0); PG8_MMA(1, 0, At, B0); PG8_BAR; PG8_SCHED;
            PG8_STAGEB(PG8_SB(0, 1), b2 + hstep);
            PG8_WAIT_V(6); PG8_BAR; PG8_MMA(1, 1, At, B1); PG8_BAR;
            PG8_LDB(B0, 1, 0); PG8_SCHED; PG8_LDA(At, 1, 0); PG8_STAGE(PG8_SA(0, 1), a2 + hstepA, PG8_V2(1));
            PG8_WAIT_L(8); PG8_BAR; PG8_WAIT_L(0); PG8_MMA(0, 0, At, B0); PG8_BAR; PG8_SCHED;
            PG8_LDB(B1, 1, 1); PG8_STAGEB(PG8_SB(1, 0), b3);
            PG8_BAR; PG8_WAIT_L(0); PG8_MMA(0, 1, At, B1); PG8_BAR;
            PG8_LDA(At, 1, 1); PG8_STAGE(PG8_SA(1, 0), a3, PG8_V2(0));
            PG8_BAR; PG8_WAIT_L(0); PG8_MMA(1, 0, At, B0); PG8_BAR; PG8_SCHED;
            PG8_STAGEB(PG8_SB(1, 1), b3 + hstep);
            PG8_WAIT_V(6); PG8_BAR; PG8_MMA(1, 1, At, B1); PG8_BAR;
        }
        PG8_STAMP();
        if constexpr (ES == 1) asm volatile("s_nop 15\n\ts_nop 15\n\ts_nop 15" ::: "memory");
        if constexpr (!Epi::AFTER_DRAIN) { int te_ = threadIdx.x; asm volatile("" : "+v"(te_));
#ifndef PG8_EPI_REP
#define PG8_EPI_REP 1
#endif
            _Pragma("unroll 1") for (int er_ = 0; er_ < PG8_EPI_REP; ++er_) { asm volatile("" : "+v"(te_));
            E(acc, cur, __builtin_amdgcn_readfirstlane(te_ >> 8), __builtin_amdgcn_readfirstlane((te_ >> 6) & 3), te_ & 15, (te_ >> 4) & 3); } S.done(cur); }
        PG8_STAMP();
        if (!has_next) break;
#pragma unroll
        for (int a = 0; a < 2; ++a)
#pragma unroll
            for (int b = 0; b < 2; ++b)
#pragma unroll
                for (int m = 0; m < 4; ++m)
#pragma unroll
                    for (int n = 0; n < 2; ++n) acc[a][b][m][n] = (f32x4){0.f, 0.f, 0.f, 0.f};
        cur = nxt; cA = nA; cB = nB; ++ui;
        if (GATHER) { _Pragma("unroll") for (int h_ = 0; h_ < 2; ++h_) _Pragma("unroll") for (int i_ = 0; i_ < 2; ++i_) gA[h_][i_] = v2_[h_][i_]; }
    }
    PG8_WAIT_V(0);
    if (wr == 0) PG8_BAR;
    PG8_BAR;
    if constexpr (Epi::AFTER_DRAIN) { E.fused(acc, cur, wr, wc, fr, fq, lds, wid, lane); S.done(cur); }
    PG8_STAMP();
    if (STAMP && wid == 0) { stamps[lane] = lane < nts ? (((unsigned long long)(unsigned)ts_hi << 32) | (unsigned)ts_lo) : 0ull;
        if (lane == 62) stamps[62] = rt_entry; if (lane == 63) stamps[63] = (unsigned long long)wall_clock64(); }
#undef PG8_STAMP
#undef PG8_SA
#undef PG8_SB
#undef PG8_STAGE
#undef PG8_STAGEB
#undef PG8_LDA
#undef PG8_LDB
#undef PG8_MMA
#undef PG8_CAT
#undef PG8_WAIT_V
#undef PG8_WAIT_L
#undef PG8_BAR
#undef PG8_SCHED
#undef PG8_ROWS
#undef PG8_VA
#undef PG8_V2
}
}

namespace mk {
#define MLAS __attribute__((address_space(3)))
typedef unsigned short bf16_t;
typedef float f32x4 __attribute__((ext_vector_type(4)));
typedef unsigned u32x4 __attribute__((ext_vector_type(4)));
typedef unsigned u32x2 __attribute__((ext_vector_type(2)));

constexpr int D = 1024, NB = 16, SEQ = 4096, LC = 256, TL = NB * SEQ, TC = NB * LC, TT = TL + TC;
constexpr int INC = 4096, NE = 32, DFF = 512, NCH = 34, PMAX = 147456, NT = 512;
constexpr int LDS_BYTES = 150 * 1024, LDS_CTL = LDS_BYTES - 256;
constexpr int C_QA = 0, C_KA = 512, C_VA = 1024, C_QB = 1536, C_KB = 2048, C_VB = 2560, C_GF = 3072, C_GB = 3584;

constexpr size_t al256(size_t x) { return (x + 255) & ~(size_t)255; }
constexpr size_t WS_BAR = 0;
constexpr size_t WS_CNT = 16384;
constexpr size_t WS_ZERO_BYTES = 16384 + 16384;
constexpr size_t WS_MOD = WS_ZERO_BYTES;
constexpr size_t WS_WIN = al256(WS_MOD + (size_t)2 * 17 * 6144 * 4);
constexpr size_t WS_WOUT = WS_WIN + (size_t)2 * 4096 * 1024 * 2;
constexpr size_t WS_WGU = WS_WOUT + (size_t)2 * 1024 * 1024 * 2;
constexpr size_t WS_WDN = WS_WGU + (size_t)32 * 1024 * 1024 * 2;
constexpr size_t WS_CTX = WS_WDN + (size_t)32 * 1024 * 512 * 2;
constexpr size_t WS_H = WS_CTX + (size_t)TC * D * 4;
constexpr size_t WS_PROJ = WS_H + (size_t)TT * D * 2;
constexpr size_t WS_XS = WS_PROJ;
constexpr size_t WS_ACT = WS_PROJ + (size_t)PMAX * D * 2;
constexpr size_t WS_XB = WS_PROJ + (size_t)TT * INC * 2;
constexpr size_t WS_ST = WS_PROJ + (size_t)TT * INC * 2;
constexpr size_t WS_KC = WS_ST;
constexpr size_t WS_VT = WS_KC + (size_t)128 * 4096 * 64 * 2;
constexpr size_t WS_KCC = WS_VT + (size_t)128 * 4096 * 64 * 2;
constexpr size_t WS_VTC = WS_KCC + (size_t)128 * 256 * 64 * 2;
static_assert(WS_VTC + (size_t)128 * 256 * 64 * 2 <= WS_ST + (size_t)NB * 4 * 2 * NCH * 16384 * 2, "NA operand copies fit in the state region");
constexpr size_t WS_TOKE = WS_ST + (size_t)NB * 4 * 2 * NCH * 16384 * 2;
constexpr size_t WS_TOKR = WS_TOKE + (size_t)TT * 2 * 4;
constexpr size_t WS_TOKW = WS_TOKR + (size_t)TT * 2 * 4;
constexpr size_t WS_RINFO = WS_TOKW + (size_t)TT * 2 * 4;
constexpr size_t WS_RW = WS_RINFO + (size_t)PMAX * 4;
constexpr size_t WS_BLKE = WS_RW + (size_t)PMAX * 4;
constexpr size_t WS_RWT = WS_BLKE + 4096;
constexpr size_t WS_BLKB = WS_RWT + (size_t)2 * 32 * 1024 * 2;
constexpr size_t WS_ROPE = WS_BLKB + (size_t)1024 * 32 * 4;
constexpr size_t WS_END = WS_ROPE + (size_t)64 * 32 * 8;
static_assert(WS_ACT + (size_t)PMAX * DFF * 2 <= WS_ST && WS_XB == WS_ST && (size_t)TL * D * 2 <= (size_t)NB * 4 * 2 * NCH * 16384 * 2, "ys | act fit in the proj region, xb in the state region");
static_assert((size_t)TT * 2 * D * 2 <= (size_t)PMAX * D * 2, "y2 fits in xs region");
static_assert(WS_END <= (size_t)1 << 30, "workspace must fit in 1 GiB");

struct Args {
    const float* x; const float* c; const float* ctx; const float* c_ctx; const float* ada_w; const float* ada_b;
    const float* norm_mix_w; const float* norm_ffn_w; const float* w_in; const float* na_q_norm; const float* na_k_norm;
    const float* na_rpb; const float* ret_decay; const float* w_out; const float* router_w; const float* router_bias;
    const float* w_gate; const float* w_up; const float* w_down;
    float* out; unsigned char* ws; int ph_lo, ph_hi;
};

#define LDS_BARRIER() do { asm volatile("s_waitcnt lgkmcnt(0)" ::: "memory"); __builtin_amdgcn_s_barrier(); asm volatile("" ::: "memory"); } while (0)
__device__ __forceinline__ int otid() { int t = threadIdx.x; asm volatile("" : "+v"(t)); return t; }
__device__ __forceinline__ float bf2f(bf16_t v) { return __uint_as_float(((unsigned)v) << 16); }
__device__ __forceinline__ bf16_t f2bf(float f) { unsigned u = __float_as_uint(f); u += 0x7FFFu + ((u >> 16) & 1u); return (bf16_t)(u >> 16); }
typedef float f32x2_t __attribute__((ext_vector_type(2)));
typedef __bf16 bf16x2_t __attribute__((ext_vector_type(2)));
__device__ __forceinline__ unsigned pack2(float lo, float hi) { const f32x2_t v = {lo, hi}; return __builtin_bit_cast(unsigned, __builtin_convertvector(v, bf16x2_t)); }
__device__ __forceinline__ unsigned pack4_fp8(float a, float b, float c, float d) {
    a = __builtin_amdgcn_fmed3f(a, -448.0f, 448.0f); b = __builtin_amdgcn_fmed3f(b, -448.0f, 448.0f); c = __builtin_amdgcn_fmed3f(c, -448.0f, 448.0f); d = __builtin_amdgcn_fmed3f(d, -448.0f, 448.0f);
    int p = __builtin_amdgcn_cvt_pk_fp8_f32(a, b, 0, false); p = __builtin_amdgcn_cvt_pk_fp8_f32(c, d, p, true); return (unsigned)p; }
constexpr float WG8_SCALE = 64.0f, WU8_SCALE = 512.0f, WDN8_SCALE = 32.0f;
constexpr int SC_MOE1 = 0x7c7c7c7c, SC_MOE2 = 0x7b7b7b7b, SC_IN8 = 0x7c7c7c7c;
constexpr float WIN8_SCALE = 64.0f;
constexpr size_t WS_WIN8 = WS_WGU + (size_t)32 * 1024 * 1024;
#ifndef OUT_FP8
#define OUT_FP8 1
#endif
constexpr float MIX8_SCALE = 8.0f, WOUT8_SCALE = 128.0f; constexpr int SC_OUT8 = 0x7a7a7a7a;
constexpr size_t WS_WOUT8 = WS_WGU + (size_t)32 * 1024 * 1024 + (size_t)2 * 4096 * 1024;
#ifndef IN_FP8_MASK
#define IN_FP8_MASK 0xFFFFu
#endif
constexpr unsigned IN_TILES_BF16 = 0xFEDC7610u, IN_TILES_FP8 = 0xBA985432u;
__device__ __forceinline__ bool in_tile_fp8(int pn) { return (IN_FP8_MASK >> pn) & 1u; }
__device__ __forceinline__ float lo16(unsigned w) { return __uint_as_float(w << 16); }
__device__ __forceinline__ float hi16(unsigned w) { return __uint_as_float(w & 0xffff0000u); }
__device__ __forceinline__ float siluf(float v) { return v * __builtin_amdgcn_rcpf(1.0f + __builtin_amdgcn_exp2f(-1.4426950408889634f * v)); }
__device__ __forceinline__ float wave_sum(float v) {
#pragma unroll
    for (int o = 32; o >= 1; o >>= 1) v += __shfl_xor(v, o);
    return v;
}

typedef short bf16x8 __attribute__((ext_vector_type(8)));
typedef float f32x16 __attribute__((ext_vector_type(16)));
__device__ __forceinline__ unsigned off_b(unsigned row, unsigned ch) { return 256u * row + 16u * (ch ^ (((row & 3) << 2) | ((row >> 2) & 3))); }
__device__ __forceinline__ unsigned tr_addr(unsigned row0, unsigned c, unsigned lane) { const unsigned blk = (lane >> 4) & 1, q = (lane & 15) >> 2, p = lane & 3; return off_b(row0 + q, 4 * c + 2 * blk + (p >> 1)) + 8 * (p & 1); }
__device__ __forceinline__ bf16x8 mkfrag(u32x2 lo, u32x2 hi) { const u32x4 w = {lo.x, lo.y, hi.x, hi.y}; return __builtin_bit_cast(bf16x8, w); }
__device__ __forceinline__ int st_frag_idx(int d, int e) { return (((d >> 5) * 4 + (e >> 5)) * 64 + (e & 31) + 32 * ((d >> 2) & 1)) * 16 + (d & 3) + 4 * ((d & 31) >> 3); }
__device__ __forceinline__ const float* modp(const Args& a, int l, int r, int k6) { return (const float*)(a.ws + WS_MOD) + ((size_t)l * 17 + r) * 6144 + k6 * 1024; }

__device__ __forceinline__ bool cvt_is8(bool with_dense, int t) { return !(with_dense && t < 2560) || (t < 2048 ? in_tile_fp8(((t & 63) * 64) >> 8) : OUT_FP8 != 0); }
__device__ __forceinline__ void cvt_addr(const Args& a, bool with_dense, int le, int t, int tid, const float*& lp, bf16_t*& sp) {
    const float* src; bf16_t* dst; int ldn, ldk, k0, n0, nd0;
    if (with_dense && t < 2560) {
        if (t < 2048) { const int l = t >> 10, tt = t & 1023; k0 = (tt >> 6) * 64; n0 = (tt & 63) * 64; nd0 = n0; src = a.w_in + (size_t)l * D * INC; ldn = INC; ldk = D;
            dst = in_tile_fp8(n0 >> 8) ? (bf16_t*)(a.ws + WS_WIN8 + (size_t)l * INC * D) : (bf16_t*)(a.ws + WS_WIN) + (size_t)l * INC * D; }
        else { const int t2 = t - 2048, l = t2 >> 8, tt = t2 & 255; k0 = (tt >> 4) * 64; n0 = (tt & 15) * 64; nd0 = n0; src = a.w_out + (size_t)l * D * D; ldn = D; dst = OUT_FP8 ? (bf16_t*)(a.ws + WS_WOUT8 + (size_t)l * D * D) : (bf16_t*)(a.ws + WS_WOUT) + (size_t)l * D * D; ldk = D; }
    } else {
        const int te = with_dense ? t - 2560 : t, which = te >> 12, tt = te & 4095, e = tt >> 7, r = tt & 127;
        if (which < 2) { k0 = (r >> 3) * 64; n0 = (r & 7) * 64; nd0 = (n0 >> 7) * 256 + which * 128 + (n0 & 127); src = (which == 0 ? a.w_gate : a.w_up) + ((size_t)le * NE + e) * D * DFF; ldn = DFF; dst = (bf16_t*)(a.ws + WS_WGU + (size_t)e * 1024 * D); ldk = D; }
        else { k0 = (r >> 4) * 64; n0 = (r & 15) * 64; nd0 = n0; src = a.w_down + ((size_t)le * NE + e) * DFF * D; ldn = D; dst = (bf16_t*)(a.ws + WS_WDN + (size_t)e * 1024 * DFF); ldk = DFF; }
    }
    lp = src + (size_t)(k0 + (tid >> 3)) * ldn + n0 + (tid & 7) * 8;
    const size_t so = (size_t)(nd0 + (tid >> 3)) * ldk + k0 + (tid & 7) * 8;
    sp = cvt_is8(with_dense, t) ? (bf16_t*)((unsigned char*)dst + so) : dst + so;
}
__device__ __forceinline__ void convert_weights(const Args& a, bool with_dense, int le, MLAS unsigned char* lds, int bid, int nb) {
    MLAS float* tl = (MLAS float*)lds; const int tid = otid();
    const int N = (with_dense ? 2560 : 0) + 3 * 4096;
    const float* lp; bf16_t* sp;
    f32x4 v0 = {0.f, 0.f, 0.f, 0.f}, v1 = v0;
    if (bid < N) { cvt_addr(a, with_dense, le, bid, tid, lp, sp); v0 = *(const f32x4*)lp; v1 = *(const f32x4*)(lp + 4); }
    for (int t = bid; t < N; t += nb) {
        cvt_addr(a, with_dense, le, t, tid, lp, sp);
        LDS_BARRIER();
        { const int kk = tid >> 3, nn0 = (tid & 7) * 8;
#pragma unroll
          for (int j = 0; j < 4; ++j) { tl[kk * 65 + nn0 + j] = v0[j]; tl[kk * 65 + nn0 + 4 + j] = v1[j]; } }
        { const int tn = t + nb < N ? t + nb : t; const float* lpn; bf16_t* spn; cvt_addr(a, with_dense, le, tn, tid, lpn, spn); (void)spn; v0 = *(const f32x4*)lpn; v1 = *(const f32x4*)(lpn + 4); }
        LDS_BARRIER();
        { const int n = tid >> 3, kc = (tid & 7) * 8;
          if (!cvt_is8(with_dense, t)) { u32x4 w;
            w.x = pack2(tl[(kc + 0) * 65 + n], tl[(kc + 1) * 65 + n]); w.y = pack2(tl[(kc + 2) * 65 + n], tl[(kc + 3) * 65 + n]);
            w.z = pack2(tl[(kc + 4) * 65 + n], tl[(kc + 5) * 65 + n]); w.w = pack2(tl[(kc + 6) * 65 + n], tl[(kc + 7) * 65 + n]);
            *(u32x4*)sp = w; }
          else { u32x2 w;
            const int wh_ = (with_dense ? t - 2560 : t) >> 12; const float ws = (with_dense && t < 2048) ? WIN8_SCALE : (with_dense && t < 2560) ? WOUT8_SCALE : wh_ == 0 ? WG8_SCALE : wh_ == 1 ? WU8_SCALE : WDN8_SCALE;
            w.x = pack4_fp8(ws * tl[(kc + 0) * 65 + n], ws * tl[(kc + 1) * 65 + n], ws * tl[(kc + 2) * 65 + n], ws * tl[(kc + 3) * 65 + n]);
            w.y = pack4_fp8(ws * tl[(kc + 4) * 65 + n], ws * tl[(kc + 5) * 65 + n], ws * tl[(kc + 6) * 65 + n], ws * tl[(kc + 7) * 65 + n]);
            *(u32x2*)sp = w; } }
    }
    __syncthreads();
}
__device__ __forceinline__ void convert_small(const Args& a, int bid, int nb) {
    const int tid = otid();
    if (bid == nb - 2) { float* rt = (float*)(a.ws + WS_ROPE);
        for (int i = tid; i < 64 * 32; i += NT) { const float ang = (float)(i >> 5) * exp2f(-(float)(i & 31) * (13.287712379549449f / 32.0f)); float sn, cs; sincosf(ang, &sn, &cs); rt[2 * i] = cs; rt[2 * i + 1] = sn; } }
    if (bid == nb - 1) { bf16_t* rh = (bf16_t*)(a.ws + WS_RWT); bf16_t* rl = rh + 32 * 1024;
        for (int i = tid; i < 32 * 1024; i += NT) { const int e = i >> 10, k = i & 1023; const float w = a.router_w[k * NE + e]; const bf16_t hi = f2bf(w); rh[i] = hi; rl[i] = f2bf(w - bf2f(hi)); } }
}
__device__ __forceinline__ void compute_mod(const Args& a, MLAS unsigned char* lds, int bid, int nb) {
    MLAS float* sc = (MLAS float*)lds;
    MLAS float* red = (MLAS float*)(lds + 17 * 1024 * 4);
    const int tid = otid();
    if (bid >= 192) return;
    for (int i = tid; i < 17 * 1024; i += NT) { const int r = i >> 10, k = i & 1023; const float v = r < 16 ? a.c[r * 1024 + k] : a.c_ctx[k]; sc[i] = v / (1.0f + expf(-v)); }
    __syncthreads();
    for (int u = bid; u < 192; u += nb) {
        const int l = u / 96, n = (u % 96) * 64 + (tid & 63), kp = tid >> 6;
        float acc[17];
#pragma unroll
        for (int r = 0; r < 17; ++r) acc[r] = 0.f;
        const float* w = a.ada_w + (size_t)l * D * 6144 + n;
        for (int k = kp * 128; k < kp * 128 + 128; ++k) { const float wv = w[(size_t)k * 6144];
#pragma unroll
            for (int r = 0; r < 17; ++r) acc[r] += sc[r * 1024 + k] * wv; }
#pragma unroll
        for (int r = 0; r < 17; ++r) red[(kp * 17 + r) * 64 + (tid & 63)] = acc[r];
        __syncthreads();
        for (int i = tid; i < 17 * 64; i += NT) { const int r = i >> 6, cc = i & 63, nn = (u % 96) * 64 + cc; float s = a.ada_b[l * 6144 + nn];
#pragma unroll
            for (int p = 0; p < 8; ++p) s += red[(p * 17 + r) * 64 + cc];
            ((float*)(a.ws + WS_MOD))[((size_t)l * 17 + r) * 6144 + nn] = s; }
        __syncthreads();
    }
}

__device__ __forceinline__ void load_row_f32(const float* src, int e0, int e1, float (&v)[16]) {
    const f32x4 x0 = *(const f32x4*)(src + e0), x1 = *(const f32x4*)(src + e0 + 4), x2 = *(const f32x4*)(src + e1), x3 = *(const f32x4*)(src + e1 + 4);
#pragma unroll
    for (int j = 0; j < 4; ++j) { v[j] = x0[j]; v[4 + j] = x1[j]; v[8 + j] = x2[j]; v[12 + j] = x3[j]; }
}
__device__ __forceinline__ void load_row_bf16(const bf16_t* src, int e0, int e1, float (&v)[16]) {
    const u32x4 w0 = *(const u32x4*)(src + e0), w1 = *(const u32x4*)(src + e1);
#pragma unroll
    for (int j = 0; j < 4; ++j) { v[2 * j] = lo16(w0[j]); v[2 * j + 1] = hi16(w0[j]); v[8 + 2 * j] = lo16(w1[j]); v[8 + 2 * j + 1] = hi16(w1[j]); }
}
__device__ __forceinline__ void moe_combine(const bf16_t* ys, int2 pp, float2 ww, int i, const float (&mg)[16], int e0, int e1, float (&v)[16]) {
    const int p0 = __builtin_amdgcn_readlane(pp.x, i), p1 = __builtin_amdgcn_readlane(pp.y, i);
    const float w0 = __uint_as_float(__builtin_amdgcn_readlane(__float_as_uint(ww.x), i)), w1 = __uint_as_float(__builtin_amdgcn_readlane(__float_as_uint(ww.y), i));
    const bf16_t* ya = ys + (size_t)p0 * D; const bf16_t* yb = ys + (size_t)p1 * D;
    const u32x4 a0 = *(const u32x4*)(ya + e0), a1 = *(const u32x4*)(ya + e1), b0 = *(const u32x4*)(yb + e0), b1 = *(const u32x4*)(yb + e1);
#pragma unroll
    for (int j = 0; j < 4; ++j) {
        v[2 * j] += mg[2 * j] * (w0 * lo16(a0[j]) + w1 * lo16(b0[j])); v[2 * j + 1] += mg[2 * j + 1] * (w0 * hi16(a0[j]) + w1 * hi16(b0[j]));
        v[8 + 2 * j] += mg[8 + 2 * j] * (w0 * lo16(a1[j]) + w1 * lo16(b1[j])); v[8 + 2 * j + 1] += mg[8 + 2 * j + 1] * (w0 * hi16(a1[j]) + w1 * hi16(b1[j])); }
}
__device__ __forceinline__ unsigned char* h8_of(const Args& a) { return (unsigned char*)a.out + (size_t)TL * D * 2; }
__device__ __forceinline__ void phase_norm1(const Args& a, int l, int bid, int nb) {
    const int tid = otid(), lane = tid & 63, wave = __builtin_amdgcn_readfirstlane(tid >> 6);
    const int e0 = lane * 8, e1 = 512 + lane * 8;
    float wn[16];
    { const float* w = a.norm_mix_w + l * D;
#pragma unroll
      for (int j = 0; j < 8; ++j) { wn[j] = w[e0 + j]; wn[8 + j] = w[e1 + j]; } }
    float msc[16], msh[16], mg[16]; int cur_r = -1;
    bf16_t* hb = (bf16_t*)(a.ws + WS_H);
    const bf16_t* y2 = (const bf16_t*)(a.ws + WS_XS);
    const int rper = (TT + nb * 8 - 1) / (nb * 8), row_lo = (bid * 8 + wave) * rper, row_hi = min(row_lo + rper, TT);
    int2 pp = {0, 0}; float2 ww = {0.f, 0.f};
    if (l > 0 && row_lo + lane < row_hi) { pp = *(const int2*)((const int*)(a.ws + WS_TOKR) + (size_t)(row_lo + lane) * 2); ww = *(const float2*)((const float*)(a.ws + WS_TOKW) + (size_t)(row_lo + lane) * 2); }
    for (int row = row_lo; row < row_hi; ++row) {
        const int r = row < TL ? row / SEQ : 16;
        if (r != cur_r) { cur_r = r; const float* sh = modp(a, l, r, 0); const float* sc = modp(a, l, r, 1);
#pragma unroll
            for (int j = 0; j < 8; ++j) { msh[j] = sh[e0 + j]; msh[8 + j] = sh[e1 + j]; msc[j] = 1.0f + sc[e0 + j]; msc[8 + j] = 1.0f + sc[e1 + j]; }
            if (l > 0) { const float* g = modp(a, l - 1, r, 5);
#pragma unroll
                for (int j = 0; j < 8; ++j) { mg[j] = g[e0 + j]; mg[8 + j] = g[e1 + j]; } } }
        float v[16];
        if (l == 0) load_row_f32(row < TL ? a.x + (size_t)row * D : a.ctx + (size_t)(row - TL) * D, e0, e1, v);
        else if (row < TL) load_row_bf16((const bf16_t*)(a.ws + WS_XB) + (size_t)row * D, e0, e1, v);
        else load_row_f32((const float*)(a.ws + WS_CTX) + (size_t)(row - TL) * D, e0, e1, v);
        if (l > 0) {
            moe_combine(y2, pp, ww, row - row_lo, mg, e0, e1, v);
            if (row < TL) { bf16_t* dst = (bf16_t*)a.out + (size_t)row * D;
                *(u32x4*)(dst + e0) = (u32x4){pack2(v[0], v[1]), pack2(v[2], v[3]), pack2(v[4], v[5]), pack2(v[6], v[7])};
                *(u32x4*)(dst + e1) = (u32x4){pack2(v[8], v[9]), pack2(v[10], v[11]), pack2(v[12], v[13]), pack2(v[14], v[15])}; }
        }
        float ss = 0.f;
#pragma unroll
        for (int j = 0; j < 16; ++j) ss += v[j] * v[j];
        ss = wave_sum(ss);
        const float rs = rsqrtf(ss * (1.0f / D) + 1e-6f);
        float y[16];
#pragma unroll
        for (int j = 0; j < 16; ++j) y[j] = v[j] * rs * wn[j] * msc[j] + msh[j];
        if (IN_FP8_MASK != 0xFFFFu) { bf16_t* hp = hb + (size_t)row * D;
        *(u32x4*)(hp + e0) = (u32x4){pack2(y[0], y[1]), pack2(y[2], y[3]), pack2(y[4], y[5]), pack2(y[6], y[7])};
        *(u32x4*)(hp + e1) = (u32x4){pack2(y[8], y[9]), pack2(y[10], y[11]), pack2(y[12], y[13]), pack2(y[14], y[15])}; }
        unsigned char* hp8 = h8_of(a) + (size_t)row * D;
        *(u32x2*)(hp8 + e0) = (u32x2){pack4_fp8(y[0], y[1], y[2], y[3]), pack4_fp8(y[4], y[5], y[6], y[7])};
        *(u32x2*)(hp8 + e1) = (u32x2){pack4_fp8(y[8], y[9], y[10], y[11]), pack4_fp8(y[12], y[13], y[14], y[15])};
    }
}
__device__ __forceinline__ void phase_final(const Args& a, int bid, int nb) {
    const int tid = otid(), lane = tid & 63, wave = __builtin_amdgcn_readfirstlane(tid >> 6);
    const int e0 = lane * 8, e1 = 512 + lane * 8;
    float mg[16]; int cur_r = -1;
    const bf16_t* y2 = (const bf16_t*)(a.ws + WS_XS);
    const int rper = (TL + nb * 8 - 1) / (nb * 8), row_lo = (bid * 8 + wave) * rper, row_hi = min(row_lo + rper, TL);
    int2 pp = {0, 0}; float2 ww = {0.f, 0.f};
    if (row_lo + lane < row_hi) { pp = *(const int2*)((const int*)(a.ws + WS_TOKR) + (size_t)(row_lo + lane) * 2); ww = *(const float2*)((const float*)(a.ws + WS_TOKW) + (size_t)(row_lo + lane) * 2); }
    for (int row = row_lo; row < row_hi; ++row) {
        const int r = row / SEQ;
        if (r != cur_r) { cur_r = r; const float* g = modp(a, 1, r, 5);
#pragma unroll
            for (int j = 0; j < 8; ++j) { mg[j] = g[e0 + j]; mg[8 + j] = g[e1 + j]; } }
        float* src = a.out + (size_t)row * D;
        float v[16];
        load_row_bf16((const bf16_t*)(a.ws + WS_XB) + (size_t)row * D, e0, e1, v);
        moe_combine(y2, pp, ww, row - row_lo, mg, e0, e1, v);
        *(f32x4*)(src + e0) = (f32x4){v[0], v[1], v[2], v[3]}; *(f32x4*)(src + e0 + 4) = (f32x4){v[4], v[5], v[6], v[7]};
        *(f32x4*)(src + e1) = (f32x4){v[8], v[9], v[10], v[11]}; *(f32x4*)(src + e1 + 4) = (f32x4){v[12], v[13], v[14], v[15]};
    }
}

constexpr int VP = 516;
__device__ __forceinline__ void phase_prep(const Args& a, int l, MLAS unsigned char* lds, int bid, int nb) {
    const int tid = otid(), lane = tid & 63, wave = tid >> 6;
    const bf16_t* proj = (const bf16_t*)(a.ws + WS_PROJ);
    MLAS bf16_t* Vs = (MLAS bf16_t*)lds;
    float wk[8];
    { const float* w = a.na_k_norm + l * 64 + (lane & 7) * 8;
#pragma unroll
      for (int j = 0; j < 8; ++j) wk[j] = w[j]; }
    for (int u = bid; u < TT / 64; u += nb) {
        const int R0 = u * 64; const bool lat = R0 < TL;
        const int b = lat ? R0 / SEQ : (R0 - TL) / LC, t0 = lat ? R0 % SEQ : (R0 - TL) % LC, tlen = lat ? SEQ : LC;
        bf16_t* kc = (bf16_t*)(a.ws + (lat ? WS_KC : WS_KCC)); bf16_t* vt = (bf16_t*)(a.ws + (lat ? WS_VT : WS_VTC));
        __syncthreads();
#pragma unroll
        for (int rr = 0; rr < 8; ++rr) {
            const int rl = wave * 8 + rr, row = R0 + rl, t = t0 + rl;
            const bf16_t* p = proj + (size_t)row * INC;
            const u32x4 kw = *(const u32x4*)(p + C_KA + lane * 8), vw = *(const u32x4*)(p + C_VA + lane * 8);
            float f[8];
#pragma unroll
            for (int j = 0; j < 4; ++j) { f[2 * j] = lo16(kw[j]); f[2 * j + 1] = hi16(kw[j]); }
            float ss = 0.f;
#pragma unroll
            for (int j = 0; j < 8; ++j) ss += f[j] * f[j];
            ss += __shfl_xor(ss, 1); ss += __shfl_xor(ss, 2); ss += __shfl_xor(ss, 4);
            const float rs = rsqrtf(ss * (1.0f / 64.0f) + 1e-6f);
            *(u32x4*)(kc + (((size_t)b * 8 + (lane >> 3)) * tlen + t) * 64 + (lane & 7) * 8) =
                (u32x4){pack2(f[0] * rs * wk[0], f[1] * rs * wk[1]), pack2(f[2] * rs * wk[2], f[3] * rs * wk[3]), pack2(f[4] * rs * wk[4], f[5] * rs * wk[5]), pack2(f[6] * rs * wk[6], f[7] * rs * wk[7])};
            *(MLAS u32x2*)(Vs + rl * VP + lane * 8) = (u32x2){vw.x, vw.y}; *(MLAS u32x2*)(Vs + rl * VP + lane * 8 + 4) = (u32x2){vw.z, vw.w};
        }
        __syncthreads();
#pragma unroll
        for (int i = 0; i < 8; ++i) { const int idx = tid + i * NT, d = idx & 63, tc = (idx >> 6) & 7, h = idx >> 9;
            const MLAS bf16_t* vp = Vs + (tc * 8) * VP + h * 64 + d;
            const u32x4 w = {(unsigned)vp[0] | ((unsigned)vp[VP] << 16), (unsigned)vp[2 * VP] | ((unsigned)vp[3 * VP] << 16), (unsigned)vp[4 * VP] | ((unsigned)vp[5 * VP] << 16), (unsigned)vp[6 * VP] | ((unsigned)vp[7 * VP] << 16)};
            const int tk = t0 + tc * 8;
            *(u32x4*)(vt + ((((size_t)b * 8 + h) * (tlen >> 4) + (tk >> 4)) * 64 + d) * 16 + (tk & 15)) = w; }
    }
}

__device__ __forceinline__ int chunk_row0(int b, int c) { return c < 2 ? TL + b * LC + c * 128 : b * SEQ + (c - 2) * 128; }
__device__ __forceinline__ size_t st_index(int b, int h, int dir, int c) { return ((((size_t)b * 4 + h) * 2 + dir) * NCH + c) * 16384; }
constexpr int RP = 136;
__device__ __forceinline__ void load_rope_pair(const bf16_t* p, int a2, int fc, int tok, const MLAS float* rope, float (&y1)[8], float (&y2)[8]) {
    const u32x4 w0 = *(const u32x4*)(p + (a2 * 8 + fc) * 8), w1 = *(const u32x4*)(p + (a2 * 8 + fc + 4) * 8);
#pragma unroll
    for (int j = 0; j < 4; ++j) { y1[2 * j] = lo16(w0[j]); y1[2 * j + 1] = hi16(w0[j]); y2[2 * j] = lo16(w1[j]); y2[2 * j + 1] = hi16(w1[j]); }
    if (tok >= 0) {
        const int pos = a2 == 0 ? (tok >> 6) : (tok & 63);
        const MLAS f32x4* tp = (const MLAS f32x4*)(rope + (pos * 32 + fc * 8) * 2);
#pragma unroll
        for (int q = 0; q < 4; ++q) { const f32x4 cs = tp[q];
            const float u0 = y1[2 * q] * cs[0] - y2[2 * q] * cs[1], v0 = y1[2 * q] * cs[1] + y2[2 * q] * cs[0];
            const float u1 = y1[2 * q + 1] * cs[2] - y2[2 * q + 1] * cs[3], v1 = y1[2 * q + 1] * cs[3] + y2[2 * q + 1] * cs[2];
            y1[2 * q] = u0; y2[2 * q] = v0; y1[2 * q + 1] = u1; y2[2 * q + 1] = v1; }
    }
}
__device__ __forceinline__ void rope_pair_regs(const u32x4 w0, const u32x4 w1, int a2, int fc, int tok, const MLAS float* rope, float (&y1)[8], float (&y2)[8]) {
#pragma unroll
    for (int j = 0; j < 4; ++j) { y1[2 * j] = lo16(w0[j]); y1[2 * j + 1] = hi16(w0[j]); y2[2 * j] = lo16(w1[j]); y2[2 * j + 1] = hi16(w1[j]); }
    if (tok >= 0) {
        const int pos = a2 == 0 ? (tok >> 6) : (tok & 63);
        const MLAS f32x4* tp = (const MLAS f32x4*)(rope + (pos * 32 + fc * 8) * 2);
#pragma unroll
        for (int q = 0; q < 4; ++q) { const f32x4 cs = tp[q];
            const float u0 = y1[2 * q] * cs[0] - y2[2 * q] * cs[1], v0 = y1[2 * q] * cs[1] + y2[2 * q] * cs[0];
            const float u1 = y1[2 * q + 1] * cs[2] - y2[2 * q + 1] * cs[3], v1 = y1[2 * q + 1] * cs[3] + y2[2 * q + 1] * cs[2];
            y1[2 * q] = u0; y2[2 * q] = v0; y1[2 * q + 1] = u1; y2[2 * q + 1] = v1; }
    }
}
__device__ __forceinline__ u32x4 pack8(const float (&y)[8], float sc) { return (u32x4){pack2(y[0] * sc, y[1] * sc), pack2(y[2] * sc, y[3] * sc), pack2(y[4] * sc, y[5] * sc), pack2(y[6] * sc, y[7] * sc)}; }
constexpr float RET_KSCALE = 0.08838834764831845f;
constexpr int LDS_ROPE = 98304;
__device__ __forceinline__ void phase_ret_a(const Args& a, int l, MLAS unsigned char* lds, int bid, int nb) {
    const int tid = otid(), lane = tid & 63, wave = __builtin_amdgcn_readfirstlane(tid >> 6);
    const bf16_t* proj = (const bf16_t*)(a.ws + WS_PROJ); bf16_t* st = (bf16_t*)(a.ws + WS_ST);
    const unsigned ldsb = (unsigned)(size_t)lds;
    const int dir = wave >> 2, dt = wave & 3, hh = lane >> 5;
    MLAS float* rope = (MLAS float*)(lds + LDS_ROPE);
    for (int i = tid; i < 64 * 32 * 2; i += NT) rope[i] = ((const float*)(a.ws + WS_ROPE))[i];
#define RA_LOAD(u_) do { const int b_ = (u_) / (NCH * 4), c_ = ((u_) >> 2) % NCH, h_ = (u_) & 3, row0_ = chunk_row0(b_, c_); _Pragma("unroll") for (int i = 0; i < 2; ++i) { const int idx = tid + i * NT, row = idx >> 3, ch0 = ((idx >> 2) & 1) * 8 + (idx & 3); \
        const bf16_t* src = proj + (size_t)(row0_ + row) * INC + h_ * 128; \
        raw[i][0] = *(const u32x4*)(src + C_KB + ch0 * 8); raw[i][1] = *(const u32x4*)(src + C_KB + (ch0 + 4) * 8); raw[i][2] = *(const u32x4*)(src + C_VB + ch0 * 8); raw[i][3] = *(const u32x4*)(src + C_VB + (ch0 + 4) * 8); } } while (0)
    u32x4 raw[2][4];
    if (bid < NB * NCH * 4) RA_LOAD(bid);
    LDS_BARRIER();
    for (int u = bid; u < NB * NCH * 4; u += nb) {
        const int b = u / (NCH * 4), c = (u >> 2) % NCH, h = u & 3;
        const float lgf = -expf(a.ret_decay[l * 8 + h]), lgb = -expf(a.ret_decay[l * 8 + 4 + h]);
        LDS_BARRIER();
#pragma unroll
        for (int i = 0; i < 2; ++i) { const int idx = tid + i * NT, row = idx >> 3, a2 = (idx >> 2) & 1, fc = idx & 3, ch0 = a2 * 8 + fc;
            float y1[8], y2[8];
            rope_pair_regs(raw[i][0], raw[i][1], a2, fc, c >= 2 ? (c - 2) * 128 + row : -1, rope, y1, y2);
            const float wf = __expf((float)(127 - row) * lgf) * RET_KSCALE, wb = __expf((float)row * lgb) * RET_KSCALE;
            const unsigned o0 = off_b(row, ch0), o1 = off_b(row, ch0 + 4);
            *(MLAS u32x4*)(lds + o0) = pack8(y1, wf); *(MLAS u32x4*)(lds + o1) = pack8(y2, wf);
            *(MLAS u32x4*)(lds + 32768 + o0) = pack8(y1, wb); *(MLAS u32x4*)(lds + 32768 + o1) = pack8(y2, wb);
            *(MLAS u32x4*)(lds + 65536 + o0) = raw[i][2]; *(MLAS u32x4*)(lds + 65536 + o1) = raw[i][3]; }
        { const int un_ = u + nb < NB * NCH * 4 ? u + nb : u; RA_LOAD(un_); }
        LDS_BARRIER();
        f32x16 acc[4];
#pragma unroll
        for (int et = 0; et < 4; ++et)
#pragma unroll
            for (int r = 0; r < 16; ++r) acc[et][r] = 0.f;
        unsigned aK[2], aV[4][2];
#pragma unroll
        for (int t = 0; t < 2; ++t) { aK[t] = ldsb + dir * 32768 + tr_addr(8 * hh + 4 * t, dt, lane);
#pragma unroll
            for (int et = 0; et < 4; ++et) aV[et][t] = ldsb + 65536 + tr_addr(8 * hh + 4 * t, et, lane); }
#pragma unroll
        for (int ks = 0; ks < 8; ++ks) {
            u32x2 r0, r1, r2, r3, r4, r5, r6, r7, r8, r9; const unsigned ko = ks * 4096;
            asm volatile("ds_read_b64_tr_b16 %0, %10\n\tds_read_b64_tr_b16 %1, %11\n\tds_read_b64_tr_b16 %2, %12\n\tds_read_b64_tr_b16 %3, %13\n\tds_read_b64_tr_b16 %4, %14\n\t"
                         "ds_read_b64_tr_b16 %5, %15\n\tds_read_b64_tr_b16 %6, %16\n\tds_read_b64_tr_b16 %7, %17\n\tds_read_b64_tr_b16 %8, %18\n\tds_read_b64_tr_b16 %9, %19\n\ts_waitcnt lgkmcnt(0)"
                         : "=&v"(r0), "=&v"(r1), "=&v"(r2), "=&v"(r3), "=&v"(r4), "=&v"(r5), "=&v"(r6), "=&v"(r7), "=&v"(r8), "=&v"(r9)
                         : "v"(aK[0] + ko), "v"(aK[1] + ko), "v"(aV[0][0] + ko), "v"(aV[0][1] + ko), "v"(aV[1][0] + ko), "v"(aV[1][1] + ko), "v"(aV[2][0] + ko), "v"(aV[2][1] + ko), "v"(aV[3][0] + ko), "v"(aV[3][1] + ko) : "memory");
            const bf16x8 A = mkfrag(r0, r1);
            acc[0] = __builtin_amdgcn_mfma_f32_32x32x16_bf16(A, mkfrag(r2, r3), acc[0], 0, 0, 0);
            acc[1] = __builtin_amdgcn_mfma_f32_32x32x16_bf16(A, mkfrag(r4, r5), acc[1], 0, 0, 0);
            acc[2] = __builtin_amdgcn_mfma_f32_32x32x16_bf16(A, mkfrag(r6, r7), acc[2], 0, 0, 0);
            acc[3] = __builtin_amdgcn_mfma_f32_32x32x16_bf16(A, mkfrag(r8, r9), acc[3], 0, 0, 0);
        }
        bf16_t* o = st + st_index(b, h, dir, c);
#pragma unroll
        for (int et = 0; et < 4; ++et) { bf16_t* p = o + ((dt * 4 + et) * 64 + lane) * 16;
            *(u32x4*)p = (u32x4){pack2(acc[et][0], acc[et][1]), pack2(acc[et][2], acc[et][3]), pack2(acc[et][4], acc[et][5]), pack2(acc[et][6], acc[et][7])};
            *(u32x4*)(p + 8) = (u32x4){pack2(acc[et][8], acc[et][9]), pack2(acc[et][10], acc[et][11]), pack2(acc[et][12], acc[et][13]), pack2(acc[et][14], acc[et][15])}; }
    }
#undef RA_LOAD
}
__device__ __forceinline__ void phase_scan(const Args& a, int l, int bid, int nb) {
    bf16_t* st = (bf16_t*)(a.ws + WS_ST);
#pragma unroll 1
    for (int idx = bid * NT + otid(); idx < NB * 4 * 2 * 2048; idx += nb * NT) {
        const int chain = idx >> 11, v8 = idx & 2047, dir = chain & 1, h = (chain >> 1) & 3;
        const float dec = expf(-128.0f * expf(a.ret_decay[l * 8 + dir * 4 + h]));
        bf16_t* p = st + (size_t)chain * NCH * 16384 + v8 * 8;
        float S[8];
#pragma unroll
        for (int j = 0; j < 8; ++j) S[j] = 0.f;
#pragma unroll 1
        for (int half = 0; half < 2; ++half) {
            u32x4 ls[NCH / 2];
#pragma unroll
            for (int i = 0; i < NCH / 2; ++i) { const int ii = half * (NCH / 2) + i, c = dir == 0 ? ii : (ii < 2 ? 1 - ii : NCH + 1 - ii); ls[i] = *(const u32x4*)(p + (size_t)c * 16384); }
#pragma unroll
            for (int i = 0; i < NCH / 2; ++i) { const int ii = half * (NCH / 2) + i, c = dir == 0 ? ii : (ii < 2 ? 1 - ii : NCH + 1 - ii);
                *(u32x4*)(p + (size_t)c * 16384) = (u32x4){pack2(S[0], S[1]), pack2(S[2], S[3]), pack2(S[4], S[5]), pack2(S[6], S[7])};
#pragma unroll
                for (int t = 0; t < 4; ++t) { S[2 * t] = S[2 * t] * dec + lo16(ls[i][t]); S[2 * t + 1] = S[2 * t + 1] * dec + hi16(ls[i][t]); } }
        }
    }
}
__device__ __forceinline__ void phase_ret_b(const Args& a, int l, MLAS unsigned char* lds, int bid, int nb) {
    const int tid = otid(), lane = tid & 63, wave = __builtin_amdgcn_readfirstlane(tid >> 6);
    const bf16_t* proj = (const bf16_t*)(a.ws + WS_PROJ); const bf16_t* st = (const bf16_t*)(a.ws + WS_ST); bf16_t* mix = (bf16_t*)(a.ws + WS_H);
    const unsigned ldsb = (unsigned)(size_t)lds;
    const int dir = wave >> 2, it = wave & 3, hh = lane >> 5, il = it * 32 + (lane & 31);
    const int c_lo = l == 0 ? 0 : 2, ncu = NCH - c_lo;
    MLAS float* rope = (MLAS float*)(lds + LDS_ROPE);
    for (int i = tid; i < 64 * 32 * 2; i += NT) rope[i] = ((const float*)(a.ws + WS_ROPE))[i];
#define RB_DECODE(u_, b_, c_, h_, row0_) const int b_ = (u_) / (ncu * 4), c_ = c_lo + ((u_) >> 2) % ncu, h_ = (u_) & 3, row0_ = chunk_row0(b_, c_)
#define RB_LOAD(u_) do { RB_DECODE(u_, b_, c_, h_, row0_); (void)c_; _Pragma("unroll") for (int i = 0; i < 2; ++i) { const int idx = tid + i * NT, row = idx >> 3, ch0 = ((idx >> 2) & 1) * 8 + (idx & 3); \
        const bf16_t* src = proj + (size_t)(row0_ + row) * INC + h_ * 128; \
        raw[i][0] = *(const u32x4*)(src + C_QB + ch0 * 8); raw[i][1] = *(const u32x4*)(src + C_QB + (ch0 + 4) * 8); raw[i][2] = *(const u32x4*)(src + C_KB + ch0 * 8); raw[i][3] = *(const u32x4*)(src + C_KB + (ch0 + 4) * 8); \
        raw[i][4] = *(const u32x4*)(src + C_VB + ch0 * 8); raw[i][5] = *(const u32x4*)(src + C_VB + (ch0 + 4) * 8); } } while (0)
    u32x4 raw[2][6];
    if (bid < NB * ncu * 4) RB_LOAD(bid);
    LDS_BARRIER();
    for (int u = bid; u < NB * ncu * 4; u += nb) {
        RB_DECODE(u, b, c, h, row0);
        const float lg = -expf(a.ret_decay[l * 8 + dir * 4 + h]);
        LDS_BARRIER();
#pragma unroll
        for (int i = 0; i < 2; ++i) { const int idx = tid + i * NT, row = idx >> 3, a2 = (idx >> 2) & 1, fc = idx & 3, ch0 = a2 * 8 + fc;
            const int tok = c >= 2 ? (c - 2) * 128 + row : -1;
            const unsigned o0 = off_b(row, ch0), o1 = off_b(row, ch0 + 4);
            float y1[8], y2[8];
            rope_pair_regs(raw[i][0], raw[i][1], a2, fc, tok, rope, y1, y2);
            *(MLAS u32x4*)(lds + o0) = pack8(y1, 1.0f); *(MLAS u32x4*)(lds + o1) = pack8(y2, 1.0f);
            rope_pair_regs(raw[i][2], raw[i][3], a2, fc, tok, rope, y1, y2);
            *(MLAS u32x4*)(lds + 32768 + o0) = pack8(y1, RET_KSCALE); *(MLAS u32x4*)(lds + 32768 + o1) = pack8(y2, RET_KSCALE);
            *(MLAS u32x4*)(lds + 65536 + o0) = raw[i][4]; *(MLAS u32x4*)(lds + 65536 + o1) = raw[i][5]; }
        LDS_BARRIER();
        f32x16 acc[4];
#pragma unroll
        for (int et = 0; et < 4; ++et)
#pragma unroll
            for (int r = 0; r < 16; ++r) acc[et][r] = 0.f;
        {
            const bf16_t* sp = st + st_index(b, h, dir, c) + lane * 16;
#pragma unroll
            for (int dt = 0; dt < 4; ++dt)
#pragma unroll
                for (int s2 = 0; s2 < 2; ++s2) {
                    const u32x2 q0 = *(const MLAS u32x2*)(lds + off_b(il, 4 * dt + 2 * s2) + 8 * hh), q1 = *(const MLAS u32x2*)(lds + off_b(il, 4 * dt + 2 * s2 + 1) + 8 * hh);
                    const bf16x8 Bq = mkfrag(q0, q1);
#pragma unroll
                    for (int et = 0; et < 4; ++et) { const bf16x8 A = __builtin_bit_cast(bf16x8, *(const u32x4*)(sp + (dt * 4 + et) * 1024 + 8 * s2));
                        acc[et] = __builtin_amdgcn_mfma_f32_32x32x16_bf16(A, Bq, acc[et], 0, 0, 0); }
                }
            const float qdec = __expf((float)(dir == 0 ? il + 1 : 128 - il) * lg);
#pragma unroll
            for (int et = 0; et < 4; ++et)
#pragma unroll
                for (int r = 0; r < 16; ++r) acc[et][r] *= qdec;
        }
        bf16x8 Qn[8];
#pragma unroll
        for (int ks = 0; ks < 8; ++ks) Qn[ks] = *(const MLAS bf16x8*)(lds + off_b(il, 2 * ks + hh));
        const int jt_lo = dir == 0 ? 0 : it, jt_hi = dir == 0 ? it : 3;
        for (int jt = jt_lo; jt <= jt_hi; ++jt) {
            f32x16 sc;
#pragma unroll
            for (int r = 0; r < 16; ++r) sc[r] = 0.f;
#pragma unroll
            for (int ks = 0; ks < 8; ++ks) { const bf16x8 A = *(const MLAS bf16x8*)(lds + 32768 + off_b(jt * 32 + (lane & 31), 2 * ks + hh));
                sc = __builtin_amdgcn_mfma_f32_32x32x16_bf16(A, Qn[ks], sc, 0, 0, 0); }
            unsigned pk[8];
#pragma unroll
            for (int r = 0; r < 16; r += 2) {
                const int j0 = jt * 32 + (r & 3) + 8 * (r >> 2) + 4 * hh, j1 = j0 + 1;
                const int d0 = dir == 0 ? il - j0 : j0 - il, d1 = dir == 0 ? il - j1 : j1 - il;
                const float p0 = d0 >= 0 ? sc[r] * __expf((float)d0 * lg) : 0.f, p1 = d1 >= 0 ? sc[r + 1] * __expf((float)d1 * lg) : 0.f;
                pk[r >> 1] = pack2(p0, p1);
            }
            const bf16x8 P0 = __builtin_bit_cast(bf16x8, (u32x4){pk[0], pk[1], pk[2], pk[3]}), P1 = __builtin_bit_cast(bf16x8, (u32x4){pk[4], pk[5], pk[6], pk[7]});
#pragma unroll
            for (int et = 0; et < 4; ++et) {
                u32x2 r0, r1, r2, r3;
                const unsigned a0 = ldsb + 65536 + tr_addr(jt * 32 + 4 * hh, et, lane), a1 = ldsb + 65536 + tr_addr(jt * 32 + 8 + 4 * hh, et, lane);
                const unsigned a2 = ldsb + 65536 + tr_addr(jt * 32 + 16 + 4 * hh, et, lane), a3 = ldsb + 65536 + tr_addr(jt * 32 + 24 + 4 * hh, et, lane);
                asm volatile("ds_read_b64_tr_b16 %0, %4\n\tds_read_b64_tr_b16 %1, %5\n\tds_read_b64_tr_b16 %2, %6\n\tds_read_b64_tr_b16 %3, %7\n\ts_waitcnt lgkmcnt(0)"
                             : "=&v"(r0), "=&v"(r1), "=&v"(r2), "=&v"(r3) : "v"(a0), "v"(a1), "v"(a2), "v"(a3) : "memory");
                acc[et] = __builtin_amdgcn_mfma_f32_32x32x16_bf16(mkfrag(r0, r1), P0, acc[et], 0, 0, 0);
                acc[et] = __builtin_amdgcn_mfma_f32_32x32x16_bf16(mkfrag(r2, r3), P1, acc[et], 0, 0, 0);
            }
        }
        u32x4 gfr[4], gbr[4];
        { const bf16_t* gp = proj + (size_t)(row0 + (tid >> 2)) * INC + h * 128;
#pragma unroll
          for (int k = 0; k < 4; ++k) { const int ch = (tid & 3) * 4 + k; gfr[k] = *(const u32x4*)(gp + C_GF + ch * 8); gbr[k] = *(const u32x4*)(gp + C_GB + ch * 8); } }
        float s1 = 0.f;
#pragma unroll
        for (int et = 0; et < 4; ++et)
#pragma unroll
            for (int r = 0; r < 16; ++r) s1 += acc[et][r];
        s1 += __shfl_xor(s1, 32);
        const float mean = s1 * (1.0f / 128.0f);
        float s2 = 0.f;
#pragma unroll
        for (int et = 0; et < 4; ++et)
#pragma unroll
            for (int r = 0; r < 16; ++r) { const float dlt = acc[et][r] - mean; s2 += dlt * dlt; }
        s2 += __shfl_xor(s2, 32);
        const float rstd = rsqrtf(s2 * (1.0f / 128.0f) + 1e-5f);
        LDS_BARRIER();
#pragma unroll
        for (int et = 0; et < 4; ++et)
#pragma unroll
            for (int g = 0; g < 4; ++g) {
                const u32x2 w = {pack2((acc[et][4 * g] - mean) * rstd, (acc[et][4 * g + 1] - mean) * rstd), pack2((acc[et][4 * g + 2] - mean) * rstd, (acc[et][4 * g + 3] - mean) * rstd)};
                *(MLAS u32x2*)(lds + dir * 32768 + off_b(il, 4 * et + g) + 8 * hh) = w; }
        { const int un_ = u + nb < NB * ncu * 4 ? u + nb : u; RB_LOAD(un_); }
        LDS_BARRIER();
        {
            const int i = tid >> 2, part = tid & 3;
            bf16_t* op = mix + (size_t)(row0 + i) * D + 512 + h * 128;
#pragma unroll
            for (int k = 0; k < 4; ++k) { const int ch = part * 4 + k;
                const u32x4 of = *(const MLAS u32x4*)(lds + off_b(i, ch)), ob = *(const MLAS u32x4*)(lds + 32768 + off_b(i, ch));
                const u32x4 gf = gfr[k], gb = gbr[k];
                if (OUT_FP8) { float f[8];
#pragma unroll
                    for (int t = 0; t < 4; ++t) { f[2 * t] = MIX8_SCALE * (lo16(of[t]) * siluf(lo16(gf[t])) + lo16(ob[t]) * siluf(lo16(gb[t]))); f[2 * t + 1] = MIX8_SCALE * (hi16(of[t]) * siluf(hi16(gf[t])) + hi16(ob[t]) * siluf(hi16(gb[t]))); }
                    *(u32x2*)((unsigned char*)mix + (size_t)(row0 + i) * D + 512 + h * 128 + ch * 8) = (u32x2){pack4_fp8(f[0], f[1], f[2], f[3]), pack4_fp8(f[4], f[5], f[6], f[7])}; }
                else { u32x4 o;
#pragma unroll
                for (int t = 0; t < 4; ++t) o[t] = pack2(lo16(of[t]) * siluf(lo16(gf[t])) + lo16(ob[t]) * siluf(lo16(gb[t])), hi16(of[t]) * siluf(hi16(gf[t])) + hi16(ob[t]) * siluf(hi16(gb[t])));
                *(u32x4*)(op + ch * 8) = o; } }
        }
    }
#undef RB_DECODE
#undef RB_LOAD
}

constexpr int NA_OP = 72;
__device__ __forceinline__ int perm16(int x) { return (x & 3) | ((x & 4) << 1) | ((x & 8) >> 1); }
__device__ __forceinline__ void phase_na(const Args& a, int l, MLAS unsigned char* lds, int bid, int nb) {
    const int tid = otid(), lane = tid & 63, wave = __builtin_amdgcn_readfirstlane(tid >> 6);
    const bf16_t* proj = (const bf16_t*)(a.ws + WS_PROJ); bf16_t* mix = (bf16_t*)(a.ws + WS_H);
    const bf16_t* KC = (const bf16_t*)(a.ws + WS_KC); const bf16_t* VT = (const bf16_t*)(a.ws + WS_VT);
    const bf16_t* KCC = (const bf16_t*)(a.ws + WS_KCC); const bf16_t* VTC = (const bf16_t*)(a.ws + WS_VTC);
    MLAS float* rpb = (MLAS float*)lds;
    MLAS bf16_t* ost = (MLAS bf16_t*)(lds + 8192) + wave * 64 * NA_OP;
    const int n_lat = NB * 8 * 8, n_ctx = l == 0 ? NB * 4 : 0;
    const int hh = lane >> 5, ql = lane & 31;
    for (int u0 = bid; u0 < n_lat + n_ctx; u0 += nb) {
        int u = u0;
        if (nb == 256 && u0 < n_lat) { const int x = bid & 7, j = bid >> 3, i = u0 >> 8; u = ((i * 32 + x * 4 + (j >> 3)) << 3) + (j & 7); }
        const bool is_ctx = u >= n_lat;
        const int v = is_ctx ? u - n_lat : u;
        const int b = is_ctx ? v >> 2 : v >> 6, h = is_ctx ? 2 * (v & 3) + (wave >> 2) : (v >> 3) & 7;
        const int r = (v & 7) * 8 + wave;
        const int qrow0 = is_ctx ? TL + b * LC + (wave & 3) * 64 : b * SEQ + r * 64;
        const size_t bh = (size_t)b * 8 + h;
        __syncthreads();
        if (!is_ctx) for (int i = tid; i < 15 * 128; i += NT) { const int dr = i >> 7, x = (i & 127) - 48; rpb[i] = (x >= 0 && x < 31) ? a.na_rpb[((size_t)l * 8 + h) * 465 + dr * 31 + x] * 1.4426950408889634f : 0.f; }
        __syncthreads();
        bf16x8 Qf[2][4];
#pragma unroll
        for (int qt = 0; qt < 2; ++qt) {
            u32x4 qw[4]; float ss = 0.f;
#pragma unroll
            for (int ks = 0; ks < 4; ++ks) { qw[ks] = *(const u32x4*)(proj + (size_t)(qrow0 + 32 * qt + ql) * INC + C_QA + h * 64 + 16 * ks + 8 * hh);
#pragma unroll
                for (int t = 0; t < 4; ++t) { const float x0 = lo16(qw[ks][t]), x1 = hi16(qw[ks][t]); ss += x0 * x0 + x1 * x1; } }
            ss += __shfl_xor(ss, 32);
            const float rs = rsqrtf(ss * (1.0f / 64.0f) + 1e-6f) * 0.18033688011112042f;
#pragma unroll
            for (int ks = 0; ks < 4; ++ks) { const f32x4 w0 = *(const f32x4*)(a.na_q_norm + l * 64 + 16 * ks + 8 * hh), w1 = *(const f32x4*)(a.na_q_norm + l * 64 + 16 * ks + 8 * hh + 4);
                const u32x4 o = {pack2(lo16(qw[ks][0]) * rs * w0[0], hi16(qw[ks][0]) * rs * w0[1]), pack2(lo16(qw[ks][1]) * rs * w0[2], hi16(qw[ks][1]) * rs * w0[3]),
                                 pack2(lo16(qw[ks][2]) * rs * w1[0], hi16(qw[ks][2]) * rs * w1[1]), pack2(lo16(qw[ks][3]) * rs * w1[2], hi16(qw[ks][3]) * rs * w1[3])};
                Qf[qt][ks] = __builtin_bit_cast(bf16x8, o); }
        }
        f32x16 O[2][2];
#pragma unroll
        for (int qt = 0; qt < 2; ++qt)
#pragma unroll
            for (int i = 0; i < 16; ++i) { O[qt][0][i] = 0.f; O[qt][1][i] = 0.f; }
        float lsum[2] = {0.f, 0.f};
        const int r0 = min(max(r - 4, 0), 56);
        const int kslot = 16 * (ql >> 4) + perm16(ql & 15);
        const bf16_t* kl = KC + (bh * SEQ + (size_t)(r0 + (ql >> 4)) * 64 + perm16(ql & 15)) * 64 + 8 * hh;
        const bf16_t* vl = VT + ((bh * 256 + (size_t)r0 * 4) * 64 + ql) * 16 + 8 * hh;
        const bf16_t* kx = KCC + (bh * LC + kslot) * 64 + 8 * hh;
        const bf16_t* vx = VTC + ((bh * 16) * 64 + ql) * 16 + 8 * hh;
#define NA_PTRS(t, kp, vp, vstep) do { if ((t) < 16) { const int ip_ = (t) >> 2, ct_ = (t) & 3; kp = kl + (size_t)(2 * ip_ * 64 + 16 * ct_) * 64; vp = vl + (2 * ip_ * 4 + ct_) * 1024; vstep = 4096; } \
        else { kp = kx + (size_t)(32 * ((t) - 16)) * 64; vp = vx + ((t) - 16) * 2048; vstep = 1024; } } while (0)
#define NA_LOADS(kp, vp, vstep, Kd, Vd) do { _Pragma("unroll") for (int ks_ = 0; ks_ < 4; ++ks_) Kd[ks_] = *(const u32x4*)(kp + 16 * ks_); \
        Vd[0] = *(const u32x4*)(vp); Vd[1] = *(const u32x4*)(vp + vstep); Vd[2] = *(const u32x4*)(vp + 512); Vd[3] = *(const u32x4*)(vp + 512 + vstep); } while (0)
        const int t_lo = is_ctx ? 16 : 0;
        u32x4 Kn[4], Vn[4];
        { const bf16_t* kp; const bf16_t* vp; int vstep; NA_PTRS(t_lo, kp, vp, vstep); NA_LOADS(kp, vp, vstep, Kn, Vn); }
#pragma unroll 1
        for (int t = t_lo; t < 24; ++t) {
            u32x4 Kc[4], Vc[4];
#pragma unroll
            for (int i = 0; i < 4; ++i) { Kc[i] = Kn[i]; Vc[i] = Vn[i]; }
            if (t + 1 < 24) { const bf16_t* kp; const bf16_t* vp; int vstep; NA_PTRS(t + 1, kp, vp, vstep); NA_LOADS(kp, vp, vstep, Kn, Vn); }
            const int ip = t >> 2, ct = t & 3;
#pragma unroll
            for (int qt = 0; qt < 2; ++qt) {
                if (t < 16 && (unsigned)(ct - qt) > 2u) continue;
                f32x16 sc;
#pragma unroll
                for (int i = 0; i < 16; ++i) sc[i] = 0.f;
#pragma unroll
                for (int ks = 0; ks < 4; ++ks) sc = __builtin_amdgcn_mfma_f32_32x32x16_bf16(__builtin_bit_cast(bf16x8, Kc[ks]), Qf[qt][ks], sc, 0, 0, 0);
                unsigned pk[8];
                if (t < 16) {
                    const int q = qt * 32 + ql, c0 = min(max(q - 8, 0), 48);
#pragma unroll
                    for (int rr = 0; rr < 16; rr += 2) {
                        const int wi = 2 * ip + (rr >> 3), col = 16 * ct + (rr & 3) + 4 * ((rr >> 2) & 1) + 8 * hh;
                        const MLAS float* bp = rpb + (r0 + wi - r + 7) * 128 + (col - q + 63);
                        const float b0 = bp[0], b1 = bp[1];
                        const float e0 = __builtin_amdgcn_exp2f(sc[rr] + b0), e1 = __builtin_amdgcn_exp2f(sc[rr + 1] + b1);
                        const float p0 = (unsigned)(col - c0) < 16u ? e0 : 0.f, p1 = (unsigned)(col + 1 - c0) < 16u ? e1 : 0.f;
                        lsum[qt] += p0 + p1; pk[rr >> 1] = pack2(p0, p1);
                    }
                } else {
#pragma unroll
                    for (int rr = 0; rr < 16; rr += 2) { const float p0 = __builtin_amdgcn_exp2f(sc[rr]), p1 = __builtin_amdgcn_exp2f(sc[rr + 1]); lsum[qt] += p0 + p1; pk[rr >> 1] = pack2(p0, p1); }
                }
                const bf16x8 P0 = __builtin_bit_cast(bf16x8, (u32x4){pk[0], pk[1], pk[2], pk[3]}), P1 = __builtin_bit_cast(bf16x8, (u32x4){pk[4], pk[5], pk[6], pk[7]});
                O[qt][0] = __builtin_amdgcn_mfma_f32_32x32x16_bf16(__builtin_bit_cast(bf16x8, Vc[0]), P0, O[qt][0], 0, 0, 0);
                O[qt][0] = __builtin_amdgcn_mfma_f32_32x32x16_bf16(__builtin_bit_cast(bf16x8, Vc[1]), P1, O[qt][0], 0, 0, 0);
                O[qt][1] = __builtin_amdgcn_mfma_f32_32x32x16_bf16(__builtin_bit_cast(bf16x8, Vc[2]), P0, O[qt][1], 0, 0, 0);
                O[qt][1] = __builtin_amdgcn_mfma_f32_32x32x16_bf16(__builtin_bit_cast(bf16x8, Vc[3]), P1, O[qt][1], 0, 0, 0);
            }
        }
#undef NA_PTRS
#undef NA_LOADS
#pragma unroll
        for (int qt = 0; qt < 2; ++qt) {
            const float inv = 1.0f / (lsum[qt] + __shfl_xor(lsum[qt], 32));
#pragma unroll
            for (int g4 = 0; g4 < 4; ++g4) {
                *(MLAS u32x2*)(ost + (32 * qt + ql) * NA_OP + 8 * g4 + 4 * hh) = (u32x2){pack2(O[qt][0][4 * g4] * inv, O[qt][0][4 * g4 + 1] * inv), pack2(O[qt][0][4 * g4 + 2] * inv, O[qt][0][4 * g4 + 3] * inv)};
                *(MLAS u32x2*)(ost + (32 * qt + ql) * NA_OP + 32 + 8 * g4 + 4 * hh) = (u32x2){pack2(O[qt][1][4 * g4] * inv, O[qt][1][4 * g4 + 1] * inv), pack2(O[qt][1][4 * g4 + 2] * inv, O[qt][1][4 * g4 + 3] * inv)};
            }
        }
#pragma unroll
        for (int k = 0; k < 8; ++k) { const int idx = lane + 64 * k, row = idx >> 3, ch = idx & 7;
            const u32x4 ow = *(const MLAS u32x4*)(ost + row * NA_OP + ch * 8);
            if (OUT_FP8) *(u32x2*)((unsigned char*)mix + (size_t)(qrow0 + row) * D + h * 64 + ch * 8) = (u32x2){pack4_fp8(MIX8_SCALE * lo16(ow.x), MIX8_SCALE * hi16(ow.x), MIX8_SCALE * lo16(ow.y), MIX8_SCALE * hi16(ow.y)), pack4_fp8(MIX8_SCALE * lo16(ow.z), MIX8_SCALE * hi16(ow.z), MIX8_SCALE * lo16(ow.w), MIX8_SCALE * hi16(ow.w))};
            else *(u32x4*)(mix + (size_t)(qrow0 + row) * D + h * 64 + ch * 8) = ow; }
    }
}

constexpr int N2P = 1032;
typedef float f32x4v __attribute__((ext_vector_type(4)));
__device__ __forceinline__ void phase_norm2(const Args& a, int l, MLAS unsigned char* lds, int bid, int nb) {
    const int tid = otid(), lane = tid & 63, wave = __builtin_amdgcn_readfirstlane(tid >> 6);
    const int e0 = lane * 8, e1 = 512 + lane * 8;
    MLAS bf16_t* Ahi = (MLAS bf16_t*)lds; MLAS bf16_t* Alo = Ahi + 16 * N2P; MLAS float* part = (MLAS float*)(Alo + 16 * N2P);
    MLAS float* tsc = part + 8 * 16 * 32; MLAS float* tsh = tsc + 1024; int cur_r = -1;
    bf16_t* hb = (bf16_t*)(a.ws + WS_H);
    int* tok_e = (int*)(a.ws + WS_TOKE); int* tok_r = (int*)(a.ws + WS_TOKR); float* tok_w = (float*)(a.ws + WS_TOKW);
    unsigned* cnt = (unsigned*)(a.ws + WS_CNT) + l * 2048;
    MLAS unsigned* lcnt = (MLAS unsigned*)(tsh + 1024);
    if (tid < NE) lcnt[tid] = 0u;
    const int nrows = l == 0 ? TT : TL;
    bf16x8 Bh[4][2], Bl[4][2];
    { const bf16_t* rh = (const bf16_t*)(a.ws + WS_RWT); const bf16_t* rl = rh + 32 * 1024;
#pragma unroll
      for (int ks = 0; ks < 4; ++ks)
#pragma unroll
        for (int nt = 0; nt < 2; ++nt) { const int o = (nt * 16 + (lane & 15)) * 1024 + 128 * wave + 32 * ks + 8 * (lane >> 4);
            Bh[ks][nt] = __builtin_bit_cast(bf16x8, *(const u32x4*)(rh + o)); Bl[ks][nt] = __builtin_bit_cast(bf16x8, *(const u32x4*)(rl + o)); } }
    const float rbias = a.router_bias[lane & 31];
#define N2_BAR() do { asm volatile("s_waitcnt lgkmcnt(0)" ::: "memory"); __builtin_amdgcn_s_barrier(); asm volatile("" ::: "memory"); } while (0)
#define N2_LOAD(bt, dst) do { _Pragma("unroll") for (int jr_ = 0; jr_ < 2; ++jr_) { const int row_ = (bt) * 16 + 2 * wave + jr_; \
        if (row_ < TL) { const bf16_t* sb_ = (const bf16_t*)(a.ws + WS_XB) + (size_t)row_ * D; dst[jr_][0] = __builtin_bit_cast(f32x4, *(const u32x4*)(sb_ + e0)); dst[jr_][1] = __builtin_bit_cast(f32x4, *(const u32x4*)(sb_ + e1)); } \
        else { const float* src_ = (const float*)(a.ws + WS_CTX) + (size_t)(row_ - TL) * D; \
        dst[jr_][0] = *(const f32x4*)(src_ + e0); dst[jr_][1] = *(const f32x4*)(src_ + e0 + 4); dst[jr_][2] = *(const f32x4*)(src_ + e1); dst[jr_][3] = *(const f32x4*)(src_ + e1 + 4); } } } while (0)
    f32x4 vc[2][4];
    const int nbatch = nrows / 16;
    const int per = (nbatch + nb - 1) / nb, b_lo = bid * per, b_hi = min(b_lo + per, nbatch);
    if (b_lo < b_hi) N2_LOAD(b_lo, vc);
    for (int batch = b_lo; batch < b_hi; ++batch) {
        const int R0 = batch * 16, r = R0 < TL ? R0 / SEQ : 16;
        N2_BAR();
        if (r != cur_r) { cur_r = r; const float* sh = modp(a, l, r, 3); const float* sc = modp(a, l, r, 4); const float* w = a.norm_ffn_w + l * D;
            for (int k = tid; k < D; k += NT) { tsc[k] = (1.0f + sc[k]) * w[k]; tsh[k] = sh[k]; }
            N2_BAR(); }
#pragma unroll
        for (int jr = 0; jr < 2; ++jr) {
            const int m = 2 * wave + jr, row = R0 + m;
            float v[16];
            if (R0 < TL) { const u32x4 w0 = __builtin_bit_cast(u32x4, vc[jr][0]), w1 = __builtin_bit_cast(u32x4, vc[jr][1]);
#pragma unroll
                for (int j = 0; j < 4; ++j) { v[2 * j] = lo16(w0[j]); v[2 * j + 1] = hi16(w0[j]); v[8 + 2 * j] = lo16(w1[j]); v[8 + 2 * j + 1] = hi16(w1[j]); } }
            else {
#pragma unroll
                for (int j = 0; j < 4; ++j) { v[j] = vc[jr][0][j]; v[4 + j] = vc[jr][1][j]; v[8 + j] = vc[jr][2][j]; v[12 + j] = vc[jr][3][j]; } }
            float ss = 0.f;
#pragma unroll
            for (int j = 0; j < 16; ++j) ss += v[j] * v[j];
            ss = wave_sum(ss);
            const float rs = rsqrtf(ss * (1.0f / D) + 1e-6f);
            unsigned ph[8], pl[8], p8[4]; float yk0 = 0.f, yk1 = 0.f;
            float msc[16], msh[16];
#pragma unroll
            for (int q = 0; q < 2; ++q) { const f32x4 c0 = *(const MLAS f32x4*)(tsc + e0 + 4 * q), c1 = *(const MLAS f32x4*)(tsc + e1 + 4 * q), h0 = *(const MLAS f32x4*)(tsh + e0 + 4 * q), h1 = *(const MLAS f32x4*)(tsh + e1 + 4 * q);
#pragma unroll
                for (int j = 0; j < 4; ++j) { msc[4 * q + j] = c0[j]; msc[8 + 4 * q + j] = c1[j]; msh[4 * q + j] = h0[j]; msh[8 + 4 * q + j] = h1[j]; } }
#pragma unroll
            for (int j = 0; j < 16; j += 2) {
                const float y0 = v[j] * rs * msc[j] + msh[j], y1 = v[j + 1] * rs * msc[j + 1] + msh[j + 1];
                const bf16_t h0 = f2bf(y0), h1 = f2bf(y1);
                ph[j >> 1] = (unsigned)h0 | ((unsigned)h1 << 16); pl[j >> 1] = pack2(y0 - bf2f(h0), y1 - bf2f(h1));
                if (j & 2) p8[j >> 2] = pack4_fp8(yk0, yk1, y0, y1); else { yk0 = y0; yk1 = y1; } }
            unsigned char* hp = (unsigned char*)hb + (size_t)row * D;
            *(u32x2*)(hp + e0) = (u32x2){p8[0], p8[1]}; *(u32x2*)(hp + e1) = (u32x2){p8[2], p8[3]};
            *(MLAS u32x4*)(Ahi + m * N2P + e0) = (u32x4){ph[0], ph[1], ph[2], ph[3]}; *(MLAS u32x4*)(Ahi + m * N2P + e1) = (u32x4){ph[4], ph[5], ph[6], ph[7]};
            *(MLAS u32x4*)(Alo + m * N2P + e0) = (u32x4){pl[0], pl[1], pl[2], pl[3]}; *(MLAS u32x4*)(Alo + m * N2P + e1) = (u32x4){pl[4], pl[5], pl[6], pl[7]};
        }
        if (batch + 1 < b_hi) N2_LOAD(batch + 1, vc);
        N2_BAR();
        {
            f32x4v acc0 = {0.f, 0.f, 0.f, 0.f}, acc1 = {0.f, 0.f, 0.f, 0.f};
#pragma unroll
            for (int ks = 0; ks < 4; ++ks) {
                const int o = (lane & 15) * N2P + 128 * wave + 32 * ks + 8 * (lane >> 4);
                const bf16x8 ah = *(const MLAS bf16x8*)(Ahi + o), al = *(const MLAS bf16x8*)(Alo + o);
                acc0 = __builtin_amdgcn_mfma_f32_16x16x32_bf16(ah, Bh[ks][0], acc0, 0, 0, 0); acc0 = __builtin_amdgcn_mfma_f32_16x16x32_bf16(al, Bh[ks][0], acc0, 0, 0, 0); acc0 = __builtin_amdgcn_mfma_f32_16x16x32_bf16(ah, Bl[ks][0], acc0, 0, 0, 0);
                acc1 = __builtin_amdgcn_mfma_f32_16x16x32_bf16(ah, Bh[ks][1], acc1, 0, 0, 0); acc1 = __builtin_amdgcn_mfma_f32_16x16x32_bf16(al, Bh[ks][1], acc1, 0, 0, 0); acc1 = __builtin_amdgcn_mfma_f32_16x16x32_bf16(ah, Bl[ks][1], acc1, 0, 0, 0);
            }
#pragma unroll
            for (int rg = 0; rg < 4; ++rg) { const int m = 4 * (lane >> 4) + rg; part[(wave * 16 + m) * 32 + (lane & 15)] = acc0[rg]; part[(wave * 16 + m) * 32 + 16 + (lane & 15)] = acc1[rg]; }
        }
        N2_BAR();
        {
            const int m = tid >> 5, ex = tid & 31, hb32 = lane & 32, row = R0 + m;
            float acc = 0.f;
#pragma unroll
            for (int w8 = 0; w8 < 8; ++w8) acc += part[(w8 * 16 + m) * 32 + ex];
            const float sg = 1.0f / (1.0f + __expf(-acc)), ssel = sg + rbias;
            float best = -1e30f; int grp = 0;
#pragma unroll
            for (int g = 0; g < 8; ++g) {
                const float v0 = __shfl(ssel, hb32 + g * 4), v1 = __shfl(ssel, hb32 + g * 4 + 1), v2 = __shfl(ssel, hb32 + g * 4 + 2), v3 = __shfl(ssel, hb32 + g * 4 + 3);
                const float hi01 = fmaxf(v0, v1), lo01 = fminf(v0, v1), hi23 = fmaxf(v2, v3), lo23 = fminf(v2, v3);
                const float top = fmaxf(hi01, hi23), second = fmaxf(fminf(hi01, hi23), hi01 >= hi23 ? lo01 : lo23);
                const float gs = top + second;
                if (gs > best) { best = gs; grp = g; }
            }
            float w4[4], s4[4];
#pragma unroll
            for (int j = 0; j < 4; ++j) { w4[j] = __shfl(ssel, hb32 + grp * 4 + j); s4[j] = __shfl(sg, hb32 + grp * 4 + j); }
            int i0 = 0;
#pragma unroll
            for (int j = 1; j < 4; ++j) if (w4[j] > w4[i0]) i0 = j;
            int i1 = i0 == 0 ? 1 : 0;
#pragma unroll
            for (int j = 0; j < 4; ++j) if (j != i0 && j != i1 && w4[j] > w4[i1]) i1 = j;
            float g0 = 0.f, g1 = 0.f;
#pragma unroll
            for (int j = 0; j < 4; ++j) { g0 = (j == i0) ? s4[j] : g0; g1 = (j == i1) ? s4[j] : g1; }
            const float inv = 1.0f / (g0 + g1);
            if (ex < 2) {
                const int e = grp * 4 + (ex == 0 ? i0 : i1);
                const unsigned rank = __hip_atomic_fetch_add(lcnt + e, 1u, __ATOMIC_RELAXED, __HIP_MEMORY_SCOPE_WORKGROUP);
                tok_e[row * 2 + ex] = e; tok_r[row * 2 + ex] = (int)rank; tok_w[row * 2 + ex] = (ex == 0 ? g0 : g1) * inv;
            }
        }
    }
    N2_BAR();
    if (tid < NE) ((int*)(a.ws + WS_BLKB))[bid * NE + tid] = (int)atomicAdd(cnt + tid * 32, lcnt[tid]);
#undef N2_BAR
#undef N2_LOAD
}
__device__ __forceinline__ void phase_gather(const Args& a, int l, MLAS unsigned char* lds, int bid, int nb) {
    const int tid = otid(), lane = tid & 63, wave = tid >> 6;
    MLAS int* pbase = (MLAS int*)lds;
    MLAS int* cn = pbase + 64;
    const unsigned* cnt = (const unsigned*)(a.ws + WS_CNT) + l * 2048; const int* blkb = (const int*)(a.ws + WS_BLKB);
    if (tid == 0) { int acc = 0; for (int e = 0; e < NE; ++e) { const int c = (int)__hip_atomic_load(cnt + e * 32, __ATOMIC_RELAXED, __HIP_MEMORY_SCOPE_AGENT); cn[e] = c; pbase[e] = acc; acc += (c + 255) & ~255; } pbase[NE] = acc; }
    __syncthreads();
    int* rinfo = (int*)(a.ws + WS_RINFO); float* rw = (float*)(a.ws + WS_RW); int* blke = (int*)(a.ws + WS_BLKE);
    if (bid == 0) {
        for (int e = 0; e < NE; ++e) {
            for (int p = pbase[e] + cn[e] + tid; p < pbase[e + 1]; p += NT) { rinfo[p] = -1; rw[p] = 0.f; }
            for (int blk = (pbase[e] >> 8) + tid; blk < (pbase[e + 1] >> 8); blk += NT) blke[blk] = e;
        }
        if (tid == 0) blke[1023] = (pbase[NE] >> 8) * 4;
    }
    const int* tok_e = (const int*)(a.ws + WS_TOKE); const int* tok_r = (const int*)(a.ws + WS_TOKR); const float* tok_w = (const float*)(a.ws + WS_TOKW);
    const int nas = (l == 0 ? TT : TL) * 2, per_ = ((l == 0 ? TT : TL) / 16 + nb - 1) / nb;
    for (int as = bid * NT + tid; as < nas; as += nb * NT) {
        const int t = as >> 1, e = tok_e[as], pos = pbase[e] + blkb[((t >> 4) / per_) * NE + e] + tok_r[as];
        rinfo[pos] = as; ((int*)(a.ws + WS_TOKR))[as] = pos;
    }
}

using pg8::Unit;
struct EpiStoreBf16 {
    static constexpr bool PERM = true, AFTER_DRAIN = false;
    bf16_t* O; int ldc; bf16_t* kc_lat; bf16_t* vt_lat; bf16_t* kc_ctx; bf16_t* vt_ctx; const float* knw; MLAS unsigned char* sp;
    __device__ __forceinline__ void operator()(const f32x4 (&acc)[2][2][4][2], const Unit& u, int wr, int wc, int fr, int fq) const {
        const int row0 = u.pm * 256 + wr * 64 + fr;
        if (u.pn < 2 || u.pn > 5) {
            char* base = (char*)O + ((size_t)(u.pm * 256 + wr * 64) * ldc + u.pn * 256 + wc * 32) * 2;
            const unsigned lo = (unsigned)(fr * ldc + 8 * fq) * 2u;
#pragma unroll
            for (int ai = 0; ai < 2; ++ai)
#pragma unroll
                for (int m = 0; m < 4; ++m)
#pragma unroll
                    for (int bj = 0; bj < 2; ++bj) { const f32x4 v0 = acc[ai][bj][m][0], v1 = acc[ai][bj][m][1];
                        *(u32x4*)(base + (size_t)((ai * 128 + m * 16) * ldc + bj * 128) * 2 + lo) = (u32x4){pg8::cvt_pk_bf16(v0[0], v0[1]), pg8::cvt_pk_bf16(v0[2], v0[3]), pg8::cvt_pk_bf16(v1[0], v1[1]), pg8::cvt_pk_bf16(v1[2], v1[3])}; }
            return;
        }
        const bool lat = u.pm < 256;
        if (u.pn < 4) {
            MLAS float* part = (MLAS float*)sp;
            float ss[2][4][2];
#pragma unroll
            for (int ai = 0; ai < 2; ++ai)
#pragma unroll
                for (int m = 0; m < 4; ++m)
#pragma unroll
                    for (int bj = 0; bj < 2; ++bj) { const f32x4 v0 = acc[ai][bj][m][0], v1 = acc[ai][bj][m][1];
                        float q = (v0[0] * v0[0] + v0[1] * v0[1]) + (v0[2] * v0[2] + v0[3] * v0[3]) + (v1[0] * v1[0] + v1[1] * v1[1]) + (v1[2] * v1[2] + v1[3] * v1[3]);
                        q += __shfl_xor(q, 16); q += __shfl_xor(q, 32); ss[ai][m][bj] = q;
                        if (fq == 0) part[((((ai * 4 + m) * 2 + bj) * 2 + wr) * 16 + fr) * 4 + wc] = q; }
            asm volatile("s_waitcnt lgkmcnt(0)" ::: "memory"); __builtin_amdgcn_s_barrier(); asm volatile("" ::: "memory");
            const f32x4 w0 = *(const f32x4*)(knw + (wc & 1) * 32 + 8 * fq), w1 = *(const f32x4*)(knw + (wc & 1) * 32 + 8 * fq + 4);
#pragma unroll
            for (int ai = 0; ai < 2; ++ai)
#pragma unroll
                for (int m = 0; m < 4; ++m) { const int row = row0 + ai * 128 + m * 16;
                    const int b = lat ? row >> 12 : (row - TL) >> 8, t = lat ? row & (SEQ - 1) : (row - TL) & (LC - 1), tlen = lat ? SEQ : LC;
                    bf16_t* kb = (lat ? kc_lat : kc_ctx);
#pragma unroll
                    for (int bj = 0; bj < 2; ++bj) {
                        const float other = part[((((ai * 4 + m) * 2 + bj) * 2 + wr) * 16 + fr) * 4 + (wc ^ 1)];
                        const float rs = rsqrtf((ss[ai][m][bj] + other) * (1.0f / 64.0f) + 1e-6f);
                        const f32x4 v0 = acc[ai][bj][m][0] * rs * w0, v1 = acc[ai][bj][m][1] * rs * w1;
                        const int head = (u.pn - 2) * 4 + 2 * bj + (wc >> 1);
                        *(u32x4*)(kb + (((size_t)b * 8 + head) * tlen + t) * 64 + (wc & 1) * 32 + 8 * fq) = (u32x4){pg8::cvt_pk_bf16(v0[0], v0[1]), pg8::cvt_pk_bf16(v0[2], v0[3]), pg8::cvt_pk_bf16(v1[0], v1[1]), pg8::cvt_pk_bf16(v1[2], v1[3])}; } }
            return;
        }
        {
            MLAS bf16_t* gb = (MLAS bf16_t*)(sp + wr * 8192);
            bf16_t* vb = lat ? vt_lat : vt_ctx; const int ngrp = lat ? SEQ / 16 : LC / 16;
#pragma unroll
            for (int ai = 0; ai < 2; ++ai)
#pragma unroll
                for (int m = 0; m < 4; ++m) {
#pragma unroll
                    for (int bj = 0; bj < 2; ++bj)
#pragma unroll
                        for (int n = 0; n < 2; ++n) { const f32x4 v = acc[ai][bj][m][n]; const int c = bj * 128 + wc * 32 + 8 * fq + 4 * n;
                            const unsigned p01 = pg8::cvt_pk_bf16(v[0], v[1]), p23 = pg8::cvt_pk_bf16(v[2], v[3]);
                            gb[(c + 0) * 16 + fr] = (bf16_t)(p01 & 0xffffu); gb[(c + 1) * 16 + fr] = (bf16_t)(p01 >> 16);
                            gb[(c + 2) * 16 + fr] = (bf16_t)(p23 & 0xffffu); gb[(c + 3) * 16 + fr] = (bf16_t)(p23 >> 16); }
                    asm volatile("s_waitcnt lgkmcnt(0)" ::: "memory"); __builtin_amdgcn_s_barrier(); asm volatile("" ::: "memory");
                    const int rowb = u.pm * 256 + ai * 128 + wr * 64 + m * 16;
                    const int b = lat ? rowb >> 12 : (rowb - TL) >> 8, g16 = (lat ? rowb & (SEQ - 1) : (rowb - TL) & (LC - 1)) >> 4;
#pragma unroll
                    for (int k = 0; k < 2; ++k) { const int qd = wc * 64 + fr + 16 * fq + 256 * k, c = qd >> 1, half = qd & 1;
                        const u32x4 w = *(const MLAS u32x4*)(gb + c * 16 + 8 * half);
                        const int head = (u.pn - 4) * 4 + (c >> 6), d = c & 63;
                        *(u32x4*)(vb + ((((size_t)b * 8 + head) * ngrp + g16) * 64 + d) * 16 + 8 * half) = w; }
                    asm volatile("s_waitcnt lgkmcnt(0)" ::: "memory"); __builtin_amdgcn_s_barrier(); asm volatile("" ::: "memory");
                }
        }
    }
};
struct EpiResGate {
    static constexpr bool PERM = true, AFTER_DRAIN = false;
    const void* xin_lat; const float* xin_ctx; bf16_t* out_lat; float* out_ctx; const float* modl; int in_bf16;
    __device__ __forceinline__ void operator()(const f32x4 (&acc)[2][2][4][2], const Unit& u, int wr, int wc, int fr, int fq) const {
        const bool lat = u.pm < 256; const int r = lat ? (u.pm >> 4) : 16;
        const int rowt = (lat ? u.pm : u.pm - 256) * 256 + wr * 64 + fr, col0 = u.pn * 256 + wc * 32 + 8 * fq;
        const float* g = modl + (size_t)r * 6144 + 2 * 1024 + col0;
        f32x4 gv[2][2];
#pragma unroll
        for (int bj = 0; bj < 2; ++bj)
#pragma unroll
            for (int n = 0; n < 2; ++n) gv[bj][n] = *(const f32x4*)(g + bj * 128 + 4 * n);
#pragma unroll
        for (int ai = 0; ai < 2; ++ai)
#pragma unroll
            for (int m = 0; m < 4; ++m) { const size_t off = (size_t)(rowt + ai * 128 + m * 16) * D + col0;
#pragma unroll
                for (int bj = 0; bj < 2; ++bj) {
                    f32x4 x0, x1;
                    if (!lat) { x0 = *(const f32x4*)(xin_ctx + off + bj * 128); x1 = *(const f32x4*)(xin_ctx + off + bj * 128 + 4); }
                    else if (in_bf16) { const u32x4 w = *(const u32x4*)((const bf16_t*)xin_lat + off + bj * 128); x0 = (f32x4){lo16(w.x), hi16(w.x), lo16(w.y), hi16(w.y)}; x1 = (f32x4){lo16(w.z), hi16(w.z), lo16(w.w), hi16(w.w)}; }
                    else { x0 = *(const f32x4*)((const float*)xin_lat + off + bj * 128); x1 = *(const f32x4*)((const float*)xin_lat + off + bj * 128 + 4); }
                    x0 += gv[bj][0] * acc[ai][bj][m][0]; x1 += gv[bj][1] * acc[ai][bj][m][1];
                    if (lat) *(u32x4*)(out_lat + off + bj * 128) = (u32x4){pack2(x0[0], x0[1]), pack2(x0[2], x0[3]), pack2(x1[0], x1[1]), pack2(x1[2], x1[3])};
                    else { *(f32x4*)(out_ctx + off + bj * 128) = x0; *(f32x4*)(out_ctx + off + bj * 128 + 4) = x1; } } }
    }
};
struct EpiSwiglu {
    static constexpr bool PERM = true, AFTER_DRAIN = false;
    bf16_t* act;
    __device__ __forceinline__ void operator()(const f32x4 (&acc)[2][2][4][2], const Unit& u, int wr, int wc, int fr, int fq) const {
        unsigned char* base = (unsigned char*)act + (size_t)(u.pm * 256 + wr * 64) * DFF + (u.pn & 3) * 128 + wc * 32;
        const unsigned lo = (unsigned)(fr * DFF + 8 * fq);
#pragma unroll
        for (int ai = 0; ai < 2; ++ai)
#pragma unroll
            for (int m = 0; m < 4; ++m) { float r[8];
#pragma unroll
                for (int n = 0; n < 2; ++n)
#pragma unroll
                    for (int j = 0; j < 4; ++j) { const float gt = acc[ai][0][m][n][j]; r[n * 4 + j] = siluf(gt) * acc[ai][1][m][n][j]; }
                *(u32x2*)(base + (size_t)(ai * 128 + m * 16) * DFF + lo) = (u32x2){pack4_fp8(r[0], r[1], r[2], r[3]), pack4_fp8(r[4], r[5], r[6], r[7])}; }
    }
};
struct EpiDown {
    static constexpr bool PERM = true, AFTER_DRAIN = false;
    bf16_t* ys;
    __device__ __forceinline__ void operator()(const f32x4 (&acc)[2][2][4][2], const Unit& u, int wr, int wc, int fr, int fq) const {
        char* base = (char*)ys + ((size_t)(u.pm * 256 + wr * 64) * D + (u.pn & 3) * 256 + wc * 32) * 2;
        const unsigned lo = (unsigned)(fr * D + 8 * fq) * 2u;
#pragma unroll
        for (int ai = 0; ai < 2; ++ai)
#pragma unroll
            for (int m = 0; m < 4; ++m)
#pragma unroll
                for (int bj = 0; bj < 2; ++bj) { const f32x4 v0 = acc[ai][bj][m][0], v1 = acc[ai][bj][m][1];
                    *(u32x4*)(base + (size_t)((ai * 128 + m * 16) * D + bj * 128) * 2 + lo) = (u32x4){pg8::cvt_pk_bf16(v0[0], v0[1]), pg8::cvt_pk_bf16(v0[2], v0[3]), pg8::cvt_pk_bf16(v1[0], v1[1]), pg8::cvt_pk_bf16(v1[2], v1[3])}; }
    }
};
struct SubsetOrder {
    pg8::StaticOrder base; unsigned map;
    __device__ __forceinline__ bool next(int i, Unit& u) const { if (!base.next(i, u)) return false; u.pn = (int)((map >> (4 * u.pn)) & 15u); return true; }
    __device__ __forceinline__ void a_ready(const Unit&) const {}
    __device__ __forceinline__ void done(const Unit&) const {}
};
struct MoeOrder {
    const MLAS int* blke; int nunits, G, c;
    __device__ __forceinline__ bool next(int i, Unit& u) const { const int x = c & 7, j = c >> 3; int L;
        if (G == 256) { const int rb = i * 64 + (j >> 2) * 8 + x; L = rb * 4 + (j & 3); } else L = i * G + c;
        if (L >= nunits) return false; u.pm = L >> 2; u.pn = blke[L >> 2] * 4 + (L & 3); return true; }
    __device__ __forceinline__ void a_ready(const Unit&) const {}
    __device__ __forceinline__ void done(const Unit&) const {}
};

typedef const Args __attribute__((address_space(4))) CArgs;
#define MK_LOAD_ARGS(a, p) do { (a).x = (p)->x; (a).c = (p)->c; (a).ctx = (p)->ctx; (a).c_ctx = (p)->c_ctx; (a).ada_w = (p)->ada_w; (a).ada_b = (p)->ada_b; (a).norm_mix_w = (p)->norm_mix_w; (a).norm_ffn_w = (p)->norm_ffn_w; (a).w_in = (p)->w_in; (a).na_q_norm = (p)->na_q_norm; (a).na_k_norm = (p)->na_k_norm; (a).na_rpb = (p)->na_rpb; (a).ret_decay = (p)->ret_decay; (a).w_out = (p)->w_out; (a).router_w = (p)->router_w; (a).router_bias = (p)->router_bias; (a).w_gate = (p)->w_gate; (a).w_up = (p)->w_up; (a).w_down = (p)->w_down; (a).out = (p)->out; (a).ws = (p)->ws; (a).ph_lo = (p)->ph_lo; (a).ph_hi = (p)->ph_hi; } while (0)
#ifndef MK_SINGLE
#define MK_SINGLE 1
#endif
constexpr int NPHASES = 24;
#ifndef MK_PROBE_MASK
#define MK_PROBE_MASK 0
#endif
#ifndef MK_BAR2
#define MK_BAR2 0
#endif
#ifndef MK_PROBE_MULT
#define MK_PROBE_MULT 4
#endif
enum { K_PRO = 0, K_NORM1, K_GEMM_IN, K_PREP, K_NA, K_RET_A, K_SCAN, K_RET_B, K_GEMM_OUT, K_NORM2, K_GATHER, K_MOE1, K_MOE2, K_FINAL };
__global__ void __launch_bounds__(NT, 2) fwd(Args ka) {
    extern __shared__ __attribute__((aligned(16))) unsigned char lds_raw[];
    MLAS unsigned char* lds = (MLAS unsigned char*)lds_raw;
    const int tid = threadIdx.x, nb = gridDim.x;
    volatile MLAS unsigned* ctl = (volatile MLAS unsigned*)(lds + LDS_CTL);
    if (tid < 4) ctl[tid] = 0u;
    __syncthreads();
    const bool multi = MK_SINGLE != 0;
    XcdBarrier bar; bar.bar = (unsigned*)(ka.ws + WS_BAR); bar.x = 0; bar.st = ctl;
    if (multi) bar = xcd_barrier_post((unsigned*)(ka.ws + WS_BAR), ctl);
    int ph = 0;
#if MK_SINGLE
#define MK_GUARD 1
#define MK_SEAM(kind) ((kind) != K_FINAL)
#else
#define MK_GUARD (ph >= ka.ph_lo && ph < ka.ph_hi)
#define MK_SEAM(kind) (ph + 1 < ka.ph_hi)
#endif
#define PHASE(kind, ...) do { if (MK_GUARD) { CArgs* ap_ = (CArgs*)__builtin_amdgcn_kernarg_segment_ptr(); asm volatile("" : "+s"(ap_)); Args a; MK_LOAD_ARGS(a, ap_); int bid = blockIdx.x; asm volatile("" : "+s"(bid)); unsigned long long t0_ = 0; if ((MK_PROBE_MASK >> (kind)) & 1) t0_ = wall_clock64(); { __VA_ARGS__; } if ((MK_PROBE_MASK >> (kind)) & 1) { const unsigned long long d_ = wall_clock64() - t0_; while (wall_clock64() - t0_ < d_ * (MK_PROBE_MULT + 1)) __builtin_amdgcn_s_sleep(8); } if (MK_SEAM(kind)) { XcdBarrier b_ = bar; asm volatile("" : "+s"(b_.bar), "+s"(b_.x)); xcd_barrier(b_); if (MK_BAR2) { xcd_barrier(b_); xcd_barrier(b_); } } } ++ph; } while (0)
    PHASE(K_PRO, { convert_small(a, bid, nb); convert_weights(a, true, 0, lds, bid, nb); compute_mod(a, lds, bid, nb); });
#ifndef STG_IN
#define STG_IN 0
#endif
#define MK_STAGGER(ticks) do { if ((ticks) > 0) { const unsigned long long t0s_ = wall_clock64(), ds_ = (unsigned long long)(bid & 7) * (ticks); while (wall_clock64() - t0s_ < ds_) __builtin_amdgcn_s_sleep(2); } } while (0)
#define MK_LAYER(l) do { \
        PHASE(K_NORM1, { phase_norm1(a, l, bid, nb); if (l == 1) convert_weights(a, false, 1, lds, bid, nb); }); \
        PHASE(K_GEMM_IN, { MK_STAGGER(STG_IN); EpiStoreBf16 E{(bf16_t*)(a.ws + WS_PROJ), INC, (bf16_t*)(a.ws + WS_KC), (bf16_t*)(a.ws + WS_VT), (bf16_t*)(a.ws + WS_KCC), (bf16_t*)(a.ws + WS_VTC), a.na_k_norm + l * 64, lds + 131072}; \
                if (IN_FP8_MASK == 0xFFFFu) { pg8::Gemm g{(const bf16_t*)h8_of(a), (const bf16_t*)(a.ws + WS_WIN8 + (size_t)l * INC * D), TT, INC, D, nullptr, SC_IN8}; \
                  pg8::StaticOrder S; S.init(TT, INC, nb, bid); \
                  pg8::gemm_phase<EpiStoreBf16, pg8::StaticOrder, false, false, 1>(lds, g, S, E, nullptr); } \
                else { \
                { pg8::Gemm g{(const bf16_t*)(a.ws + WS_H), (const bf16_t*)(a.ws + WS_WIN) + (size_t)l * INC * D, TT, INC, D}; \
                  SubsetOrder S; S.base.init(TT, INC / 2, nb, bid); S.map = IN_TILES_BF16; \
                  pg8::gemm_phase<EpiStoreBf16, SubsetOrder>(lds, g, S, E, nullptr); } \
                { pg8::Gemm g{(const bf16_t*)h8_of(a), (const bf16_t*)(a.ws + WS_WIN8 + (size_t)l * INC * D), TT, INC, D, nullptr, SC_IN8}; \
                  SubsetOrder S; S.base.init(TT, INC / 2, nb, nb - 1 - bid); S.map = IN_TILES_FP8;     \
                  pg8::gemm_phase<EpiStoreBf16, SubsetOrder, false, false, 1>(lds, g, S, E, nullptr); } } }); \
        PHASE(K_NA, phase_na(a, l, lds, bid, nb)); \
        PHASE(K_RET_A, phase_ret_a(a, l, lds, bid, nb)); \
        PHASE(K_SCAN, phase_scan(a, l, bid, nb)); \
        PHASE(K_RET_B, phase_ret_b(a, l, lds, bid, nb)); \
        PHASE(K_GEMM_OUT, { const int M = l == 0 ? TT : TL; \
                pg8::Gemm g{(const bf16_t*)(a.ws + WS_H), OUT_FP8 ? (const bf16_t*)(a.ws + WS_WOUT8 + (size_t)l * D * D) : (const bf16_t*)(a.ws + WS_WOUT) + (size_t)l * D * D, M, D, D, nullptr, SC_OUT8}; \
                pg8::StaticOrder S; S.init(M, D, nb, bid); \
                EpiResGate E{l == 0 ? (const void*)a.x : (const void*)a.out, a.ctx, (bf16_t*)(a.ws + WS_XB), (float*)(a.ws + WS_CTX), (const float*)(a.ws + WS_MOD) + (size_t)l * 17 * 6144, l}; \
                pg8::gemm_phase<EpiResGate, pg8::StaticOrder, false, false, OUT_FP8 ? 1 : 2>(lds, g, S, E, nullptr); }); \
        PHASE(K_NORM2, phase_norm2(a, l, lds, bid, nb)); \
        PHASE(K_GATHER, phase_gather(a, l, lds, bid, nb)); \
        PHASE(K_MOE1, { MLAS int* blke = (MLAS int*)(lds + 131072); { const int* gb_ = (const int*)(a.ws + WS_BLKE); for (int i_ = otid(); i_ < 1024; i_ += NT) blke[i_] = gb_[i_]; __syncthreads(); } \
                pg8::Gemm g{(const bf16_t*)(a.ws + WS_H), (const bf16_t*)(a.ws + WS_WGU), PMAX, NE * 1024, D, (const int*)(a.ws + WS_RINFO), SC_MOE1}; \
                MoeOrder S{blke, blke[1023], nb, bid}; \
                EpiSwiglu E{(bf16_t*)(a.ws + WS_ACT)}; \
                pg8::gemm_phase<EpiSwiglu, MoeOrder, false, true, 1>(lds, g, S, E, nullptr); }); \
        PHASE(K_MOE2, { MLAS int* blke = (MLAS int*)(lds + 131072); { const int* gb_ = (const int*)(a.ws + WS_BLKE); for (int i_ = otid(); i_ < 1024; i_ += NT) blke[i_] = gb_[i_]; __syncthreads(); } \
                pg8::Gemm g{(const bf16_t*)(a.ws + WS_ACT), (const bf16_t*)(a.ws + WS_WDN), PMAX, NE * 1024, DFF, nullptr, SC_MOE2}; \
                MoeOrder S{blke, blke[1023], nb, bid}; \
                EpiDown E{(bf16_t*)(a.ws + WS_XS)}; \
                pg8::gemm_phase<EpiDown, MoeOrder, false, false, 1>(lds, g, S, E, nullptr); }); \
    } while (0)
    MK_LAYER(0);
    MK_LAYER(1);
#undef MK_LAYER
    PHASE(K_FINAL, phase_final(a, bid, nb));
#undef PHASE
}
}

extern "C" void kernel_launch(void* const* d_in, const int* in_sizes, int n_in, void* d_out, int out_size, void* d_ws, size_t ws_size, hipStream_t stream) {
    using namespace mk;
    static int grid = 0;
    if (grid == 0) {
        if (n_in != 19 || in_sizes[0] != TL * D || out_size != TL * D || ws_size < WS_END) {
            fprintf(stderr, "kernel_launch: unexpected shapes / workspace (n_in %d, in0 %d, out %d, ws %zu, need %zu); nothing launched\n", n_in, n_in > 0 ? in_sizes[0] : -1, out_size, ws_size, (size_t)WS_END);
            grid = -1; return; }
        int dev = 0, cus = 0, per_cu = 0;
        if (hipGetDevice(&dev) != hipSuccess || hipDeviceGetAttribute(&cus, hipDeviceAttributeMultiprocessorCount, dev) != hipSuccess) { grid = -1; return; }
        if (hipFuncSetAttribute((const void*)fwd, hipFuncAttributeMaxDynamicSharedMemorySize, LDS_BYTES) != hipSuccess) { fprintf(stderr, "kernel_launch: hipFuncSetAttribute failed\n"); grid = -1; return; }
        if (hipOccupancyMaxActiveBlocksPerMultiprocessor(&per_cu, (const void*)fwd, NT, LDS_BYTES) != hipSuccess || per_cu < 1) { fprintf(stderr, "kernel_launch: occupancy query says %d\n", per_cu); (void)hipGetLastError(); grid = -1; return; }
        grid = cus;
    }
    if (grid < 0) return;
    (void)hipMemsetAsync((char*)d_ws + WS_BAR, 0, WS_ZERO_BYTES, stream);
    Args a{};
    a.x = (const float*)d_in[0]; a.c = (const float*)d_in[1]; a.ctx = (const float*)d_in[2]; a.c_ctx = (const float*)d_in[3]; a.ada_w = (const float*)d_in[4]; a.ada_b = (const float*)d_in[5];
    a.norm_mix_w = (const float*)d_in[6]; a.norm_ffn_w = (const float*)d_in[7]; a.w_in = (const float*)d_in[8]; a.na_q_norm = (const float*)d_in[9]; a.na_k_norm = (const float*)d_in[10];
    a.na_rpb = (const float*)d_in[11]; a.ret_decay = (const float*)d_in[12]; a.w_out = (const float*)d_in[13]; a.router_w = (const float*)d_in[14]; a.router_bias = (const float*)d_in[15];
    a.w_gate = (const float*)d_in[16]; a.w_up = (const float*)d_in[17]; a.w_down = (const float*)d_in[18];
    a.out = (float*)d_out; a.ws = (unsigned char*)d_ws;
#if MK_SINGLE
    a.ph_lo = 0; a.ph_hi = NPHASES;
    hipLaunchKernelGGL(fwd, dim3(grid), dim3(NT), LDS_BYTES, stream, a);
#else
    for (int ph = 0; ph < NPHASES; ++ph) { a.ph_lo = ph; a.ph_hi = ph + 1; hipLaunchKernelGGL(fwd, dim3(grid), dim3(NT), LDS_BYTES, stream, a); }
#endif
}
```

```cpp
#include <hip/hip_runtime.h>
#include <cstdio>
#include <cstdint>


#define XB_TMO      128
#define XB_XCNT(j)  (256  + 64 * (j))
#define XB_XSUB(j)  (1280 + 64 * (j))
#define XB_XGEN(j)  (2304 + 64 * (j))
#define XB_TOP      3328
#define XB_TOPGEN   3392
#define XCD_BAR_WORDS 3456
#define XB_SPIN_CAP (1u << 18)
#define LAS __attribute__((address_space(3)))

__device__ __forceinline__ unsigned xb_ld(unsigned* p)              { return __hip_atomic_load(p, __ATOMIC_RELAXED, __HIP_MEMORY_SCOPE_AGENT); }
__device__ __forceinline__ unsigned xb_add(unsigned* p, unsigned v) { return __hip_atomic_fetch_add(p, v, __ATOMIC_RELAXED, __HIP_MEMORY_SCOPE_AGENT); }
__device__ __forceinline__ unsigned xb_xcc_id() { return (unsigned)__builtin_amdgcn_s_getreg((3 << 11) | 20) & 0xFu; }
#define XB_SPIN(cond, bar) do { unsigned _sp = 0; while (cond) { __builtin_amdgcn_s_sleep(1); \
    if ((++_sp & 255u) == 0u) { if (xb_ld(&(bar)[XB_TMO])) break; if (_sp > XB_SPIN_CAP) { atomicAdd(&(bar)[XB_TMO], 1u); break; } } } } while (0)

struct XcdBarrier {
    unsigned* bar; unsigned x;
    volatile LAS unsigned* st;
};

__device__ __forceinline__ XcdBarrier xcd_barrier_post(unsigned* bar, volatile LAS unsigned* st) {
    XcdBarrier b; b.bar = bar; b.x = xb_xcc_id(); b.st = st;
    if (threadIdx.x == 0) (void)xb_add(&bar[XB_XCNT(b.x)], 1u);
    return b;
}
__device__ __forceinline__ void xcd_barrier_complete(unsigned* bar, unsigned x, unsigned& nloc, unsigned& nx) {
    const unsigned G = gridDim.x * gridDim.y * gridDim.z;
    unsigned sum, cnt, mine, sp = 0u;
    for (;;) {
        sum = 0u; cnt = 0u; mine = 0u;
#pragma unroll
        for (unsigned j = 0; j < 16; ++j) { const unsigned c = xb_ld(&bar[XB_XCNT(j)]); sum += c; cnt += (c > 0u) ? 1u : 0u; mine = (j == x) ? c : mine; }
        if (sum == G) break;
        __builtin_amdgcn_s_sleep(1);
        if ((++sp & 255u) == 0u) { if (xb_ld(&bar[XB_TMO])) break; if (sp > XB_SPIN_CAP) { atomicAdd(&bar[XB_TMO], 1u); break; } }
    }
    nloc = mine > 0u ? mine : 1u; nx = cnt > 0u ? cnt : 1u;
}

__device__ __forceinline__ void xcd_barrier(const XcdBarrier& b) {
    asm volatile("s_waitcnt vmcnt(0)" ::: "memory");
    __syncthreads();
    if (threadIdx.x == 0) {
        unsigned* bar = b.bar;
        __builtin_amdgcn_s_waitcnt(0);
        unsigned nloc = b.st[0], nx = b.st[1];
        if (nloc == 0u) { xcd_barrier_complete(bar, b.x, nloc, nx); b.st[0] = nloc; b.st[1] = nx; }
        const unsigned old = xb_add(&bar[XB_XSUB(b.x)], 1u);
        const unsigned gen = old / nloc;
        if (old + 1u == (gen + 1u) * nloc) {
            __builtin_amdgcn_fence(__ATOMIC_RELEASE, "agent");
            asm volatile("s_waitcnt vmcnt(0)" ::: "memory");
            const unsigned og = xb_add(&bar[XB_TOP], 1u);
            const unsigned tg = og / nx;
            if (og + 1u == (tg + 1u) * nx) xb_add(&bar[XB_TOPGEN], 1u);
            else XB_SPIN(xb_ld(&bar[XB_TOPGEN]) == tg, bar);
            __builtin_amdgcn_fence(__ATOMIC_ACQUIRE, "agent");
            xb_add(&bar[XB_XGEN(b.x)], 1u);
            asm volatile("s_waitcnt vmcnt(0)" ::: "memory");
        } else {
            XB_SPIN(xb_ld(&bar[XB_XGEN(b.x)]) == gen, bar);
            __builtin_amdgcn_fence(__ATOMIC_ACQUIRE, "agent");
            asm volatile("s_waitcnt vmcnt(0)" ::: "memory");
        }
    }
    __syncthreads();
}
namespace pg8 {
#define PG8_LAS __attribute__((address_space(3)))
typedef unsigned short bf16_t;
typedef short bf16x8 __attribute__((ext_vector_type(8)));
typedef float f32x4 __attribute__((ext_vector_type(4)));
typedef unsigned u32x4 __attribute__((ext_vector_type(4)));
constexpr int BM = 256, BK = 64, HALF = 128, HTB = HALF * BK * 2  , STAGE_BYTES = 8 * HTB, NXCD = 8, WGM = 8;

__host__ __device__ __forceinline__ int lds_byte(int r, int c) { const int st = (r >> 4) * 2 + (c >> 5), rr = r & 15, cc = c & 31, ob = rr * 64 + cc * 2; return st * 1024 + (ob ^ (((ob >> 9) & 1) << 5)); }
__host__ __device__ __forceinline__ void stage_rc(int b, int& R, int& C) { const int st = b / 1024, sb = b % 1024, swz = sb ^ (((sb >> 9) & 1) << 5); R = (st >> 1) * 16 + swz / 64; C = (st & 1) * 32 + (swz % 64) / 2; }
typedef int i32x4 __attribute__((ext_vector_type(4)));
typedef int i32x8 __attribute__((ext_vector_type(8)));
__host__ __device__ __forceinline__ int perm32(int rho) { const int n = rho >> 4, i = rho & 15; return 8 * (i >> 2) + 4 * n + (i & 3); }

struct Unit { int pm, pn; };
struct Gemm { const bf16_t* A; const bf16_t* Bt; int M, N, K; const int* rows = nullptr; int sc = 0x7f7f7f7f; };

struct StaticOrder {
    int nM, nN, nwg, G, c;
    __host__ __device__ void init(int M, int N, int G_, int c_) { nM = M / BM; nN = N / BM; nwg = nM * nN; G = G_; c = c_; }
    __host__ __device__ bool next(int i, Unit& u) const {
        const long L = (long)i * G + c; if (L >= nwg) return false;
        int wgid = (int)L; { const int q = nwg / NXCD, r = nwg % NXCD, xcd = wgid % NXCD, off = wgid / NXCD; wgid = (xcd < r ? xcd * (q + 1) : r * (q + 1) + (xcd - r) * q) + off; }
        const int nig = WGM * nN, gid = wgid / nig, fm = gid * WGM, gsz = (nM - fm) < WGM ? (nM - fm) : WGM;
        u.pm = fm + ((wgid % nig) % gsz); u.pn = (wgid % nig) / gsz; return true;
    }
    __device__ __forceinline__ void a_ready(const Unit&) const {}
    __device__ __forceinline__ void done(const Unit&) const {}
};
__device__ __forceinline__ unsigned cvt_pk_bf16(float lo, float hi) { unsigned r; asm volatile("v_cvt_pk_bf16_f32 %0, %1, %2" : "=v"(r) : "v"(lo), "v"(hi)); return r; }
typedef float f32x2 __attribute__((ext_vector_type(2)));
template <class Epi, class Sched, bool STAMP = false, bool GATHER = false, int ES = 2>
__device__ __forceinline__ void gemm_phase(PG8_LAS unsigned char* lds, const Gemm g, const Sched& S, const Epi& E, unsigned long long* stamps) {
    int tid_o_ = threadIdx.x; asm volatile("" : "+v"(tid_o_)); const int tid = tid_o_, wid = __builtin_amdgcn_readfirstlane(tid >> 6), lane = tid & 63, wr = wid >> 2, wc = wid & 3, fr = lane & 15, fq = lane >> 4;
    const int K = g.K, nt = K * ES / (BK * 2);
    int ts_lo = 0, ts_hi = 0, nts = 0; const unsigned long long rt_entry = STAMP ? (unsigned long long)wall_clock64() : 0ull;
#define PG8_STAMP() do { if (STAMP && wid == 0 && nts < 64) { const unsigned long long _c = (unsigned long long)clock64(); \
        ts_lo = (lane == nts) ? (int)(unsigned)_c : ts_lo; ts_hi = (lane == nts) ? (int)(unsigned)(_c >> 32) : ts_hi; ++nts; } } while (0)
    PG8_STAMP();
    unsigned voffA[2], voffB[2]; int rA_[2]; unsigned cA_[2];
#pragma unroll
    for (int i = 0; i < 2; ++i) { int R, C; stage_rc(tid * 16 + i * 8192, R, C); C *= 2; const int Rb = Epi::PERM ? ((R & ~31) + perm32(R & 31)) : R;
        voffA[i] = (unsigned)(R * K * ES + C); voffB[i] = (unsigned)(Rb * K * ES + C); rA_[i] = R; cA_[i] = (unsigned)C; }
    unsigned gA[2][2], v2_[2][2];
#define PG8_ROWS(u, dst) do { _Pragma("unroll") for (int h_ = 0; h_ < 2; ++h_) _Pragma("unroll") for (int i_ = 0; i_ < 2; ++i_) { const int as_ = g.rows[(u).pm * BM + h_ * HALF + rA_[i_]]; \
        dst[h_][i_] = (unsigned)(as_ < 0 ? 0 : as_ >> 1) * (unsigned)(K * ES) + cA_[i_]; } } while (0)
    const size_t kstep = (size_t)(BK * 2);
    const size_t hstep = (size_t)HALF * K * ES;
    const size_t b64_ = (size_t)64 * K * ES;
    const size_t tstep = 2 * hstep;
    const unsigned ldsw = (unsigned)wid * 1024u;
    const int aoff = lds_byte(wr * 64 + fr, fq * 8), boff = lds_byte(wc * 32 + fr, fq * 8);
#define PG8_SA(b, h) (((b) * 2 + (h)) * HTB)
#define PG8_SB(b, h) ((4 + (b) * 2 + (h)) * HTB)
#define PG8_STAGE(bufoff, gbase, voff) do { _Pragma("unroll") for (int _i = 0; _i < 2; ++_i) { unsigned vo_ = (voff)[_i]; asm volatile("" : "+v"(vo_));     \
        __builtin_amdgcn_global_load_lds((const unsigned*)((const char*)(gbase) + vo_), (PG8_LAS unsigned*)(lds + (bufoff) + ldsw + _i * 8192), 16, 0, 0); } } while (0)
#define PG8_STAGEB(bufoff, gbase) do { unsigned vo_ = voffB[0]; asm volatile("" : "+v"(vo_));     \
        __builtin_amdgcn_global_load_lds((const unsigned*)((const char*)(gbase) + vo_), (PG8_LAS unsigned*)(lds + (bufoff) + ldsw), 16, 0, 0); \
        __builtin_amdgcn_global_load_lds((const unsigned*)((const char*)(gbase) + b64_ + vo_), (PG8_LAS unsigned*)(lds + (bufoff) + ldsw + 8192), 16, 0, 0); } while (0)
#define PG8_LDA(dst, b, h) do { _Pragma("unroll") for (int m = 0; m < 4; ++m) _Pragma("unroll") for (int k = 0; k < 2; ++k) dst[m][k] = *(const PG8_LAS bf16x8*)(lds + PG8_SA(b, h) + aoff + m * 2048 + k * 1024); } while (0)
#define PG8_LDB(dst, b, h) do { _Pragma("unroll") for (int n = 0; n < 2; ++n) _Pragma("unroll") for (int k = 0; k < 2; ++k) dst[n][k] = *(const PG8_LAS bf16x8*)(lds + PG8_SB(b, h) + boff + n * 2048 + k * 1024); } while (0)
#define PG8_CAT(f) __builtin_shufflevector(__builtin_bit_cast(i32x4, f[0]), __builtin_bit_cast(i32x4, f[1]), 0, 1, 2, 3, 4, 5, 6, 7)
#define PG8_MMA(ai, bj, At, Bt) do { __builtin_amdgcn_s_setprio(1); _Pragma("unroll") for (int m = 0; m < 4; ++m) _Pragma("unroll") for (int n = 0; n < 2; ++n) { \
        if constexpr (ES == 2) { _Pragma("unroll") for (int k = 0; k < 2; ++k) acc[ai][bj][m][n] = __builtin_amdgcn_mfma_f32_16x16x32_bf16(Bt[n][k], At[m][k], acc[ai][bj][m][n], 0, 0, 0); } \
        else { const i32x8 b8_ = PG8_CAT(Bt[n]), a8_ = PG8_CAT(At[m]); asm volatile("v_mfma_scale_f32_16x16x128_f8f6f4 %0, %1, %2, %0, %3, %3 op_sel_hi:[0,0,0]" : "+v"(acc[ai][bj][m][n]) : "v"(b8_), "v"(a8_), "v"(sc_)); } } __builtin_amdgcn_s_setprio(0); } while (0)
#define PG8_WAIT_V(n) asm volatile("s_waitcnt vmcnt(" #n ")" ::: "memory")
#define PG8_WAIT_L(n) asm volatile("s_waitcnt lgkmcnt(" #n ")" ::: "memory")
#define PG8_BAR __builtin_amdgcn_s_barrier()
#define PG8_SCHED __builtin_amdgcn_sched_barrier(0)
    const int sc_ = g.sc;
    Unit cur, nxt; int ui = 0;
    if (!S.next(0, cur)) return;
    f32x4 acc[2][2][4][2];
#pragma unroll
    for (int a = 0; a < 2; ++a)
#pragma unroll
        for (int b = 0; b < 2; ++b)
#pragma unroll
            for (int m = 0; m < 4; ++m)
#pragma unroll
                for (int n = 0; n < 2; ++n) acc[a][b][m][n] = (f32x4){0.f, 0.f, 0.f, 0.f};
    bf16x8 At[4][2], B0[2][2], B1[2][2];
    const char* cA = (const char*)g.A + (GATHER ? (size_t)0 : (size_t)cur.pm * tstep); const char* cB = (const char*)g.Bt + (size_t)cur.pn * tstep;
    S.a_ready(cur);
    if (GATHER) { PG8_ROWS(cur, gA); }
    const size_t hstepA = GATHER ? (size_t)0 : hstep;
#define PG8_VA(h) (GATHER ? gA[h] : voffA)
    PG8_STAGEB(PG8_SB(0, 0), cB); PG8_STAGE(PG8_SA(0, 0), cA, PG8_VA(0)); PG8_STAGEB(PG8_SB(0, 1), cB + hstep); PG8_STAGE(PG8_SA(0, 1), cA + hstepA, PG8_VA(1));
    if (wr == 1) PG8_BAR;
    PG8_WAIT_V(4); PG8_BAR;
    PG8_STAGEB(PG8_SB(1, 0), cB + kstep); PG8_STAGE(PG8_SA(1, 0), cA + kstep, PG8_VA(0)); PG8_STAGEB(PG8_SB(1, 1), cB + hstep + kstep);
    PG8_WAIT_V(6); PG8_BAR;
    PG8_STAMP();
    for (;;) {
        const bool has_next = S.next(ui + 1, nxt);
        if (GATHER && has_next && wid == 0) { unsigned lo_ = threadIdx.x; asm volatile("" : "+v"(lo_)); lo_ = (lo_ & 63u) * 16u;
            __builtin_amdgcn_global_load_lds((const unsigned*)((const char*)(g.rows + (size_t)nxt.pm * BM) + lo_), (PG8_LAS unsigned*)(lds + STAGE_BYTES + 4096 + ((ui + 1) & 1) * 1024), 16, 0, 0); }
        const char* nA = (has_next && !GATHER) ? (const char*)g.A + (size_t)nxt.pm * tstep : cA; const char* nB = has_next ? (const char*)g.Bt + (size_t)nxt.pn * tstep : cB;
        for (int t = 0; t < nt; t += 2) {
            const bool last = (t == nt - 2);
            const char* a1 = cA + (size_t)(t + 1) * kstep;
            const char* a2 = last ? nA : cA + (size_t)(t + 2) * kstep; const char* b2 = last ? nB : cB + (size_t)(t + 2) * kstep;
            const char* a3 = a2 + kstep; const char* b3 = b2 + kstep;
            if (last && has_next) S.a_ready(nxt);
            if (GATHER) { _Pragma("unroll") for (int h_ = 0; h_ < 2; ++h_) _Pragma("unroll") for (int i_ = 0; i_ < 2; ++i_) v2_[h_][i_] = gA[h_][i_]; }
            if (GATHER && last && has_next) { const PG8_LAS int* rl_ = (const PG8_LAS int*)(lds + STAGE_BYTES + 4096 + ((ui + 1) & 1) * 1024);
                int tq_ = threadIdx.x; asm volatile("" : "+v"(tq_));
                _Pragma("unroll") for (int i_ = 0; i_ < 2; ++i_) { int R_, C_; stage_rc(tq_ * 16 + i_ * 8192, R_, C_);
                    _Pragma("unroll") for (int h_ = 0; h_ < 2; ++h_) { const int as_ = rl_[h_ * HALF + R_]; v2_[h_][i_] = (unsigned)(as_ < 0 ? 0 : as_ >> 1) * (unsigned)(K * ES) + (unsigned)(C_ * 2); } } }
#define PG8_V2(h) (GATHER ? v2_[h] : voffA)
            PG8_LDB(B0, 0, 0); PG8_SCHED; PG8_LDA(At, 0, 0); PG8_STAGE(PG8_SA(1, 1), a1 + hstepA, PG8_VA(1));
            PG8_WAIT_L(8); PG8_BAR; PG8_WAIT_L(0); PG8_MMA(0, 0, At, B0); PG8_BAR; PG8_SCHED;
            PG8_LDB(B1, 0, 1); PG8_STAGEB(PG8_SB(0, 0), b2);
            PG8_BAR; PG8_WAIT_L(0); PG8_MMA(0, 1, At, B1); PG8_BAR;
            PG8_LDA(At, 0, 1); PG8_STAGE(PG8_SA(0, 0), a2, PG8_V2(0));
            PG8_BAR; PG8_WAIT_L(0); PG8_MMA(1, 0, At, B0); PG8_BAR; PG8_SCHED;
            PG8_STAGEB(PG8_SB(0, 1), b2 + hstep);
            PG8_WAIT_V(6); PG8_BAR; PG8_MMA(1, 1, At, B1); PG8_BAR;
            PG8_LDB(B0, 1, 0); PG8_SCHED; PG8_LDA(At, 1, 0); PG8_STAGE(PG8_SA(0, 1), a2 + hstepA, PG8_V2(1));
            PG8_WAIT_L(8); PG8_BAR; PG8_WAIT_L(0); PG8_MMA(0, 0, At, B0); PG8_BAR; PG8_SCHED;
            PG8_LDB(B1, 1, 1); PG8_STAGEB(PG8_SB(1, 0), b3);
            PG8_BAR; PG8_WAIT_L(0); PG8_MMA(0, 1, At, B1); PG8_BAR;
            PG8_LDA(At, 1, 1); PG8_STAGE(PG8_SA(1, 0), a3, PG8_V2(0));
            PG8_BAR; PG8_WAIT_L(0); PG8_MMA(1, 0, At, B0); PG8_BAR; PG8_SCHED;
            PG8_STAGEB(PG8_SB(1, 1), b3 + hstep);
            PG8_WAIT_V(6); PG8_BAR; PG8_MMA(1, 1, At, B1); PG8_BAR;
        }
        PG8_STAMP();
        if constexpr (ES == 1) asm volatile("s_nop 15\n\ts_nop 15\n\ts_nop 15"
            : "+v"(acc[1][0][0][0]), "+v"(acc[1][0][0][1]), "+v"(acc[1][0][1][0]), "+v"(acc[1][0][1][1]), "+v"(acc[1][0][2][0]), "+v"(acc[1][0][2][1]), "+v"(acc[1][0][3][0]), "+v"(acc[1][0][3][1]),
              "+v"(acc[1][1][0][0]), "+v"(acc[1][1][0][1]), "+v"(acc[1][1][1][0]), "+v"(acc[1][1][1][1]), "+v"(acc[1][1][2][0]), "+v"(acc[1][1][2][1]), "+v"(acc[1][1][3][0]), "+v"(acc[1][1][3][1]) :: "memory");
        if constexpr (!Epi::AFTER_DRAIN) { int te_ = threadIdx.x; asm volatile("" : "+v"(te_));
#ifndef PG8_EPI_REP
#define PG8_EPI_REP 1
#endif
            _Pragma("unroll 1") for (int er_ = 0; er_ < PG8_EPI_REP; ++er_) { asm volatile("" : "+v"(te_));
            E(acc, cur, __builtin_amdgcn_readfirstlane(te_ >> 8), __builtin_amdgcn_readfirstlane((te_ >> 6) & 3), te_ & 15, (te_ >> 4) & 3); } S.done(cur); }
        PG8_STAMP();
        if (!has_next) break;
#pragma unroll
        for (int a = 0; a < 2; ++a)
#pragma unroll
            for (int b = 0; b < 2; ++b)
#pragma unroll
                for (int m = 0; m < 4; ++m)
#pragma unroll
                    for (int n = 0; n < 2; ++n) acc[a][b][m][n] = (f32x4){0.f, 0.f, 0.f, 0.f};
        cur = nxt; cA = nA; cB = nB; ++ui;
        if (GATHER) { _Pragma("unroll") for (int h_ = 0; h_ < 2; ++h_) _Pragma("unroll") for (int i_ = 0; i_ < 2; ++i_) gA[h_][i_] = v2_[h_][i_]; }
    }
    PG8_WAIT_V(0);
    if (wr == 0) PG8_BAR;
    PG8_BAR;
    if constexpr (Epi::AFTER_DRAIN) { E.fused(acc, cur, wr, wc, fr, fq, lds, wid, lane); S.done(cur); }
    PG8_STAMP();
    if (STAMP && wid == 0) { stamps[lane] = lane < nts ? (((unsigned long long)(unsigned)ts_hi << 32) | (unsigned)ts_lo) : 0ull;
        if (lane == 62) stamps[62] = rt_entry; if (lane == 63) stamps[63] = (unsigned long long)wall_clock64(); }
#undef PG8_STAMP
#undef PG8_SA
#undef PG8_SB
#undef PG8_STAGE
#undef PG8_STAGEB
#undef PG8_LDA
#undef PG8_LDB
#undef PG8_MMA
#undef PG8_CAT
#undef PG8_WAIT_V
#undef PG8_WAIT_L
#undef PG8_BAR
#undef PG8_SCHED
#undef PG8_ROWS
#undef PG8_VA
#undef PG8_V2
}
}

namespace mk {
#define MLAS __attribute__((address_space(3)))
typedef unsigned short bf16_t;
typedef float f32x4 __attribute__((ext_vector_type(4)));
typedef unsigned u32x4 __attribute__((ext_vector_type(4)));
typedef unsigned u32x2 __attribute__((ext_vector_type(2)));

constexpr int D = 1024, NB = 16, SEQ = 4096, LC = 256, TL = NB * SEQ, TC = NB * LC, TT = TL + TC;
constexpr int INC = 4096, NE = 32, DFF = 512, NCH = 34, PMAX = 147456, NT = 512;
constexpr int LDS_BYTES = 150 * 1024, LDS_CTL = LDS_BYTES - 256;
constexpr int C_QA = 0, C_KA = 512, C_VA = 1024, C_QB = 1536, C_KB = 2048, C_VB = 2560, C_GF = 3072, C_GB = 3584;

constexpr size_t al256(size_t x) { return (x + 255) & ~(size_t)255; }
constexpr size_t WS_BAR = 0;
constexpr size_t WS_CNT = 16384;
constexpr size_t WS_ZERO_BYTES = 16384 + 16384;
constexpr size_t WS_MOD = WS_ZERO_BYTES;
constexpr size_t WS_WIN = al256(WS_MOD + (size_t)2 * 17 * 6144 * 4);
constexpr size_t WS_WOUT = WS_WIN + (size_t)2 * 4096 * 1024 * 2;
constexpr size_t WS_WGU = WS_WOUT + (size_t)2 * 1024 * 1024 * 2;
constexpr size_t WS_WDN = WS_WGU + (size_t)32 * 1024 * 1024 * 2;
constexpr size_t WS_CTX = WS_WDN + (size_t)32 * 1024 * 512 * 2;
constexpr size_t WS_H = WS_CTX + (size_t)TC * D * 4;
constexpr size_t WS_PROJ = WS_H + (size_t)TT * D * 2;
constexpr size_t WS_XS = WS_PROJ;
constexpr size_t WS_ACT = WS_PROJ + (size_t)PMAX * D * 2;
constexpr size_t WS_XB = WS_PROJ + (size_t)TT * INC * 2;
constexpr size_t WS_ST = WS_PROJ + (size_t)TT * INC * 2;
constexpr size_t WS_KC = WS_ST;
constexpr size_t WS_VT = WS_KC + (size_t)128 * 4096 * 64 * 2;
constexpr size_t WS_KCC = WS_VT + (size_t)128 * 4096 * 64 * 2;
constexpr size_t WS_VTC = WS_KCC + (size_t)128 * 256 * 64 * 2;
static_assert(WS_VTC + (size_t)128 * 256 * 64 * 2 <= WS_ST + (size_t)NB * 4 * 2 * NCH * 16384 * 2, "NA operand copies fit in the state region");
constexpr size_t WS_TOKE = WS_ST + (size_t)NB * 4 * 2 * NCH * 16384 * 2;
constexpr size_t WS_TOKR = WS_TOKE + (size_t)TT * 2 * 4;
constexpr size_t WS_TOKW = WS_TOKR + (size_t)TT * 2 * 4;
constexpr size_t WS_RINFO = WS_TOKW + (size_t)TT * 2 * 4;
constexpr size_t WS_RW = WS_RINFO + (size_t)PMAX * 4;
constexpr size_t WS_BLKE = WS_RW + (size_t)PMAX * 4;
constexpr size_t WS_RWT = WS_BLKE + 4096;
constexpr size_t WS_BLKB = WS_RWT + (size_t)2 * 32 * 1024 * 2;
constexpr size_t WS_ROPE = WS_BLKB + (size_t)1024 * 32 * 4;
constexpr size_t WS_END = WS_ROPE + (size_t)64 * 32 * 8;
static_assert(WS_ACT + (size_t)PMAX * DFF * 2 <= WS_ST && WS_XB == WS_ST && (size_t)TL * D * 2 <= (size_t)NB * 4 * 2 * NCH * 16384 * 2, "ys | act fit in the proj region, xb in the state region");
static_assert((size_t)TT * 2 * D * 2 <= (size_t)PMAX * D * 2, "y2 fits in xs region");
static_assert(WS_END <= (size_t)1 << 30, "workspace must fit in 1 GiB");

struct Args {
    const float* x; const float* c; const float* ctx; const float* c_ctx; const float* ada_w; const float* ada_b;
    const float* norm_mix_w; const float* norm_ffn_w; const float* w_in; const float* na_q_norm; const float* na_k_norm;
    const float* na_rpb; const float* ret_decay; const float* w_out; const float* router_w; const float* router_bias;
    const float* w_gate; const float* w_up; const float* w_down;
    float* out; unsigned char* ws; int ph_lo, ph_hi;
};

#define LDS_BARRIER() do { asm volatile("s_waitcnt lgkmcnt(0)" ::: "memory"); __builtin_amdgcn_s_barrier(); asm volatile("" ::: "memory"); } while (0)
__device__ __forceinline__ int otid() { int t = threadIdx.x; asm volatile("" : "+v"(t)); return t; }
__device__ __forceinline__ float bf2f(bf16_t v) { return __uint_as_float(((unsigned)v) << 16); }
__device__ __forceinline__ bf16_t f2bf(float f) { unsigned u = __float_as_uint(f); u += 0x7FFFu + ((u >> 16) & 1u); return (bf16_t)(u >> 16); }
typedef float f32x2_t __attribute__((ext_vector_type(2)));
typedef __bf16 bf16x2_t __attribute__((ext_vector_type(2)));
__device__ __forceinline__ unsigned pack2(float lo, float hi) { const f32x2_t v = {lo, hi}; return __builtin_bit_cast(unsigned, __builtin_convertvector(v, bf16x2_t)); }
__device__ __forceinline__ unsigned pack4_fp8(float a, float b, float c, float d) {
    a = __builtin_amdgcn_fmed3f(a, -448.0f, 448.0f); b = __builtin_amdgcn_fmed3f(b, -448.0f, 448.0f); c = __builtin_amdgcn_fmed3f(c, -448.0f, 448.0f); d = __builtin_amdgcn_fmed3f(d, -448.0f, 448.0f);
    int p = __builtin_amdgcn_cvt_pk_fp8_f32(a, b, 0, false); p = __builtin_amdgcn_cvt_pk_fp8_f32(c, d, p, true); return (unsigned)p; }
constexpr float WG8_SCALE = 64.0f, WU8_SCALE = 512.0f, WDN8_SCALE = 32.0f;
constexpr int SC_MOE1 = 0x7c7c7c7c, SC_MOE2 = 0x7b7b7b7b, SC_IN8 = 0x7c7c7c7c;
constexpr float WIN8_SCALE = 64.0f;
constexpr size_t WS_WIN8 = WS_WGU + (size_t)32 * 1024 * 1024;
#ifndef OUT_FP8
#define OUT_FP8 1
#endif
constexpr float MIX8_SCALE = 8.0f, WOUT8_SCALE = 128.0f; constexpr int SC_OUT8 = 0x7a7a7a7a;
constexpr size_t WS_WOUT8 = WS_WGU + (size_t)32 * 1024 * 1024 + (size_t)2 * 4096 * 1024;
#ifndef IN_FP8_MASK
#define IN_FP8_MASK 0xFFFFu
#endif
constexpr unsigned IN_TILES_BF16 = 0xFEDC7610u, IN_TILES_FP8 = 0xBA985432u;
__device__ __forceinline__ bool in_tile_fp8(int pn) { return (IN_FP8_MASK >> pn) & 1u; }
__device__ __forceinline__ float lo16(unsigned w) { return __uint_as_float(w << 16); }
__device__ __forceinline__ float hi16(unsigned w) { return __uint_as_float(w & 0xffff0000u); }
__device__ __forceinline__ float siluf(float v) { return v * __builtin_amdgcn_rcpf(1.0f + __builtin_amdgcn_exp2f(-1.4426950408889634f * v)); }
__device__ __forceinline__ float wave_sum(float v) {
#pragma unroll
    for (int o = 32; o >= 1; o >>= 1) v += __shfl_xor(v, o);
    return v;
}

typedef short bf16x8 __attribute__((ext_vector_type(8)));
typedef float f32x16 __attribute__((ext_vector_type(16)));
__device__ __forceinline__ unsigned off_b(unsigned row, unsigned ch) { return 256u * row + 16u * (ch ^ (((row & 3) << 2) | ((row >> 2) & 3))); }
__device__ __forceinline__ unsigned tr_addr(unsigned row0, unsigned c, unsigned lane) { const unsigned blk = (lane >> 4) & 1, q = (lane & 15) >> 2, p = lane & 3; return off_b(row0 + q, 4 * c + 2 * blk + (p >> 1)) + 8 * (p & 1); }
__device__ __forceinline__ bf16x8 mkfrag(u32x2 lo, u32x2 hi) { const u32x4 w = {lo.x, lo.y, hi.x, hi.y}; return __builtin_bit_cast(bf16x8, w); }
__device__ __forceinline__ int st_frag_idx(int d, int e) { return (((d >> 5) * 4 + (e >> 5)) * 64 + (e & 31) + 32 * ((d >> 2) & 1)) * 16 + (d & 3) + 4 * ((d & 31) >> 3); }
__device__ __forceinline__ const float* modp(const Args& a, int l, int r, int k6) { return (const float*)(a.ws + WS_MOD) + ((size_t)l * 17 + r) * 6144 + k6 * 1024; }

__device__ __forceinline__ bool cvt_is8(bool with_dense, int t) { return !(with_dense && t < 2560) || (t < 2048 ? in_tile_fp8(((t & 63) * 64) >> 8) : OUT_FP8 != 0); }
__device__ __forceinline__ void cvt_addr(const Args& a, bool with_dense, int le, int t, int tid, const float*& lp, bf16_t*& sp) {
    const float* src; bf16_t* dst; int ldn, ldk, k0, n0, nd0;
    if (with_dense && t < 2560) {
        if (t < 2048) { const int l = t >> 10, tt = t & 1023; k0 = (tt >> 6) * 64; n0 = (tt & 63) * 64; nd0 = n0; src = a.w_in + (size_t)l * D * INC; ldn = INC; ldk = D;
            dst = in_tile_fp8(n0 >> 8) ? (bf16_t*)(a.ws + WS_WIN8 + (size_t)l * INC * D) : (bf16_t*)(a.ws + WS_WIN) + (size_t)l * INC * D; }
        else { const int t2 = t - 2048, l = t2 >> 8, tt = t2 & 255; k0 = (tt >> 4) * 64; n0 = (tt & 15) * 64; nd0 = n0; src = a.w_out + (size_t)l * D * D; ldn = D; dst = OUT_FP8 ? (bf16_t*)(a.ws + WS_WOUT8 + (size_t)l * D * D) : (bf16_t*)(a.ws + WS_WOUT) + (size_t)l * D * D; ldk = D; }
    } else {
        const int te = with_dense ? t - 2560 : t, which = te >> 12, tt = te & 4095, e = tt >> 7, r = tt & 127;
        if (which < 2) { k0 = (r >> 3) * 64; n0 = (r & 7) * 64; nd0 = (n0 >> 7) * 256 + which * 128 + (n0 & 127); src = (which == 0 ? a.w_gate : a.w_up) + ((size_t)le * NE + e) * D * DFF; ldn = DFF; dst = (bf16_t*)(a.ws + WS_WGU + (size_t)e * 1024 * D); ldk = D; }
        else { k0 = (r >> 4) * 64; n0 = (r & 15) * 64; nd0 = n0; src = a.w_down + ((size_t)le * NE + e) * DFF * D; ldn = D; dst = (bf16_t*)(a.ws + WS_WDN + (size_t)e * 1024 * DFF); ldk = DFF; }
    }
    lp = src + (size_t)(k0 + (tid >> 3)) * ldn + n0 + (tid & 7) * 8;
    const size_t so = (size_t)(nd0 + (tid >> 3)) * ldk + k0 + (tid & 7) * 8;
    sp = cvt_is8(with_dense, t) ? (bf16_t*)((unsigned char*)dst + so) : dst + so;
}
__device__ __forceinline__ void convert_weights(const Args& a, bool with_dense, int le, MLAS unsigned char* lds, int bid, int nb) {
    MLAS float* tl = (MLAS float*)lds; const int tid = otid();
    const int N = (with_dense ? 2560 : 0) + 3 * 4096;
    const float* lp; bf16_t* sp;
    f32x4 v0 = {0.f, 0.f, 0.f, 0.f}, v1 = v0;
    if (bid < N) { cvt_addr(a, with_dense, le, bid, tid, lp, sp); v0 = *(const f32x4*)lp; v1 = *(const f32x4*)(lp + 4); }
    for (int t = bid; t < N; t += nb) {
        cvt_addr(a, with_dense, le, t, tid, lp, sp);
        LDS_BARRIER();
        { const int kk = tid >> 3, nn0 = (tid & 7) * 8;
#pragma unroll
          for (int j = 0; j < 4; ++j) { tl[kk * 65 + nn0 + j] = v0[j]; tl[kk * 65 + nn0 + 4 + j] = v1[j]; } }
        { const int tn = t + nb < N ? t + nb : t; const float* lpn; bf16_t* spn; cvt_addr(a, with_dense, le, tn, tid, lpn, spn); (void)spn; v0 = *(const f32x4*)lpn; v1 = *(const f32x4*)(lpn + 4); }
        LDS_BARRIER();
        { const int n = tid >> 3, kc = (tid & 7) * 8;
          if (!cvt_is8(with_dense, t)) { u32x4 w;
            w.x = pack2(tl[(kc + 0) * 65 + n], tl[(kc + 1) * 65 + n]); w.y = pack2(tl[(kc + 2) * 65 + n], tl[(kc + 3) * 65 + n]);
            w.z = pack2(tl[(kc + 4) * 65 + n], tl[(kc + 5) * 65 + n]); w.w = pack2(tl[(kc + 6) * 65 + n], tl[(kc + 7) * 65 + n]);
            *(u32x4*)sp = w; }
          else { u32x2 w;
            const int wh_ = (with_dense ? t - 2560 : t) >> 12; const float ws = (with_dense && t < 2048) ? WIN8_SCALE : (with_dense && t < 2560) ? WOUT8_SCALE : wh_ == 0 ? WG8_SCALE : wh_ == 1 ? WU8_SCALE : WDN8_SCALE;
            w.x = pack4_fp8(ws * tl[(kc + 0) * 65 + n], ws * tl[(kc + 1) * 65 + n], ws * tl[(kc + 2) * 65 + n], ws * tl[(kc + 3) * 65 + n]);
            w.y = pack4_fp8(ws * tl[(kc + 4) * 65 + n], ws * tl[(kc + 5) * 65 + n], ws * tl[(kc + 6) * 65 + n], ws * tl[(kc + 7) * 65 + n]);
            *(u32x2*)sp = w; } }
    }
    __syncthreads();
}
__device__ __forceinline__ void convert_small(const Args& a, int bid, int nb) {
    const int tid = otid();
    if (bid == nb - 2) { float* rt = (float*)(a.ws + WS_ROPE);
        for (int i = tid; i < 64 * 32; i += NT) { const float ang = (float)(i >> 5) * exp2f(-(float)(i & 31) * (13.287712379549449f / 32.0f)); float sn, cs; sincosf(ang, &sn, &cs); rt[2 * i] = cs; rt[2 * i + 1] = sn; } }
    if (bid == nb - 1) { bf16_t* rh = (bf16_t*)(a.ws + WS_RWT); bf16_t* rl = rh + 32 * 1024;
        for (int i = tid; i < 32 * 1024; i += NT) { const int e = i >> 10, k = i & 1023; const float w = a.router_w[k * NE + e]; const bf16_t hi = f2bf(w); rh[i] = hi; rl[i] = f2bf(w - bf2f(hi)); } }
}
__device__ __forceinline__ void compute_mod(const Args& a, MLAS unsigned char* lds, int bid, int nb) {
    MLAS float* sc = (MLAS float*)lds;
    MLAS float* red = (MLAS float*)(lds + 17 * 1024 * 4);
    const int tid = otid();
    if (bid >= 192) return;
    for (int i = tid; i < 17 * 1024; i += NT) { const int r = i >> 10, k = i & 1023; const float v = r < 16 ? a.c[r * 1024 + k] : a.c_ctx[k]; sc[i] = v / (1.0f + expf(-v)); }
    __syncthreads();
    for (int u = bid; u < 192; u += nb) {
        const int l = u / 96, n = (u % 96) * 64 + (tid & 63), kp = tid >> 6;
        float acc[17];
#pragma unroll
        for (int r = 0; r < 17; ++r) acc[r] = 0.f;
        const float* w = a.ada_w + (size_t)l * D * 6144 + n;
        for (int k = kp * 128; k < kp * 128 + 128; ++k) { const float wv = w[(size_t)k * 6144];
#pragma unroll
            for (int r = 0; r < 17; ++r) acc[r] += sc[r * 1024 + k] * wv; }
#pragma unroll
        for (int r = 0; r < 17; ++r) red[(kp * 17 + r) * 64 + (tid & 63)] = acc[r];
        __syncthreads();
        for (int i = tid; i < 17 * 64; i += NT) { const int r = i >> 6, cc = i & 63, nn = (u % 96) * 64 + cc; float s = a.ada_b[l * 6144 + nn];
#pragma unroll
            for (int p = 0; p < 8; ++p) s += red[(p * 17 + r) * 64 + cc];
            ((float*)(a.ws + WS_MOD))[((size_t)l * 17 + r) * 6144 + nn] = s; }
        __syncthreads();
    }
}

__device__ __forceinline__ void load_row_f32(const float* src, int e0, int e1, float (&v)[16]) {
    const f32x4 x0 = *(const f32x4*)(src + e0), x1 = *(const f32x4*)(src + e0 + 4), x2 = *(const f32x4*)(src + e1), x3 = *(const f32x4*)(src + e1 + 4);
#pragma unroll
    for (int j = 0; j < 4; ++j) { v[j] = x0[j]; v[4 + j] = x1[j]; v[8 + j] = x2[j]; v[12 + j] = x3[j]; }
}
__device__ __forceinline__ void load_row_bf16(const bf16_t* src, int e0, int e1, float (&v)[16]) {
    const u32x4 w0 = *(const u32x4*)(src + e0), w1 = *(const u32x4*)(src + e1);
#pragma unroll
    for (int j = 0; j < 4; ++j) { v[2 * j] = lo16(w0[j]); v[2 * j + 1] = hi16(w0[j]); v[8 + 2 * j] = lo16(w1[j]); v[8 + 2 * j + 1] = hi16(w1[j]); }
}
__device__ __forceinline__ void moe_combine(const bf16_t* ys, int2 pp, float2 ww, int i, const float (&mg)[16], int e0, int e1, float (&v)[16]) {
    const int p0 = __builtin_amdgcn_readlane(pp.x, i), p1 = __builtin_amdgcn_readlane(pp.y, i);
    const float w0 = __uint_as_float(__builtin_amdgcn_readlane(__float_as_uint(ww.x), i)), w1 = __uint_as_float(__builtin_amdgcn_readlane(__float_as_uint(ww.y), i));
    const bf16_t* ya = ys + (size_t)p0 * D; const bf16_t* yb = ys + (size_t)p1 * D;
    const u32x4 a0 = *(const u32x4*)(ya + e0), a1 = *(const u32x4*)(ya + e1), b0 = *(const u32x4*)(yb + e0), b1 = *(const u32x4*)(yb + e1);
#pragma unroll
    for (int j = 0; j < 4; ++j) {
        v[2 * j] += mg[2 * j] * (w0 * lo16(a0[j]) + w1 * lo16(b0[j])); v[2 * j + 1] += mg[2 * j + 1] * (w0 * hi16(a0[j]) + w1 * hi16(b0[j]));
        v[8 + 2 * j] += mg[8 + 2 * j] * (w0 * lo16(a1[j]) + w1 * lo16(b1[j])); v[8 + 2 * j + 1] += mg[8 + 2 * j + 1] * (w0 * hi16(a1[j]) + w1 * hi16(b1[j])); }
}
__device__ __forceinline__ unsigned char* h8_of(const Args& a) { return (unsigned char*)a.out + (size_t)TL * D * 2; }
__device__ __forceinline__ void phase_norm1(const Args& a, int l, int bid, int nb) {
    const int tid = otid(), lane = tid & 63, wave = __builtin_amdgcn_readfirstlane(tid >> 6);
    const int e0 = lane * 8, e1 = 512 + lane * 8;
    float wn[16];
    { const float* w = a.norm_mix_w + l * D;
#pragma unroll
      for (int j = 0; j < 8; ++j) { wn[j] = w[e0 + j]; wn[8 + j] = w[e1 + j]; } }
    float msc[16], msh[16], mg[16]; int cur_r = -1;
    bf16_t* hb = (bf16_t*)(a.ws + WS_H);
    const bf16_t* y2 = (const bf16_t*)(a.ws + WS_XS);
    const int rper = (TT + nb * 8 - 1) / (nb * 8), row_lo = (bid * 8 + wave) * rper, row_hi = min(row_lo + rper, TT);
    int2 pp = {0, 0}; float2 ww = {0.f, 0.f};
    if (l > 0 && row_lo + lane < row_hi) { pp = *(const int2*)((const int*)(a.ws + WS_TOKR) + (size_t)(row_lo + lane) * 2); ww = *(const float2*)((const float*)(a.ws + WS_TOKW) + (size_t)(row_lo + lane) * 2); }
    for (int row = row_lo; row < row_hi; ++row) {
        const int r = row < TL ? row / SEQ : 16;
        if (r != cur_r) { cur_r = r; const float* sh = modp(a, l, r, 0); const float* sc = modp(a, l, r, 1);
#pragma unroll
            for (int j = 0; j < 8; ++j) { msh[j] = sh[e0 + j]; msh[8 + j] = sh[e1 + j]; msc[j] = 1.0f + sc[e0 + j]; msc[8 + j] = 1.0f + sc[e1 + j]; }
            if (l > 0) { const float* g = modp(a, l - 1, r, 5);
#pragma unroll
                for (int j = 0; j < 8; ++j) { mg[j] = g[e0 + j]; mg[8 + j] = g[e1 + j]; } } }
        float v[16];
        if (l == 0) load_row_f32(row < TL ? a.x + (size_t)row * D : a.ctx + (size_t)(row - TL) * D, e0, e1, v);
        else if (row < TL) load_row_bf16((const bf16_t*)(a.ws + WS_XB) + (size_t)row * D, e0, e1, v);
        else load_row_f32((const float*)(a.ws + WS_CTX) + (size_t)(row - TL) * D, e0, e1, v);
        if (l > 0) {
            moe_combine(y2, pp, ww, row - row_lo, mg, e0, e1, v);
            if (row < TL) { bf16_t* dst = (bf16_t*)a.out + (size_t)row * D;
                *(u32x4*)(dst + e0) = (u32x4){pack2(v[0], v[1]), pack2(v[2], v[3]), pack2(v[4], v[5]), pack2(v[6], v[7])};
                *(u32x4*)(dst + e1) = (u32x4){pack2(v[8], v[9]), pack2(v[10], v[11]), pack2(v[12], v[13]), pack2(v[14], v[15])}; }
        }
        float ss = 0.f;
#pragma unroll
        for (int j = 0; j < 16; ++j) ss += v[j] * v[j];
        ss = wave_sum(ss);
        const float rs = rsqrtf(ss * (1.0f / D) + 1e-6f);
        float y[16];
#pragma unroll
        for (int j = 0; j < 16; ++j) y[j] = v[j] * rs * wn[j] * msc[j] + msh[j];
        if (IN_FP8_MASK != 0xFFFFu) { bf16_t* hp = hb + (size_t)row * D;
        *(u32x4*)(hp + e0) = (u32x4){pack2(y[0], y[1]), pack2(y[2], y[3]), pack2(y[4], y[5]), pack2(y[6], y[7])};
        *(u32x4*)(hp + e1) = (u32x4){pack2(y[8], y[9]), pack2(y[10], y[11]), pack2(y[12], y[13]), pack2(y[14], y[15])}; }
        unsigned char* hp8 = h8_of(a) + (size_t)row * D;
        *(u32x2*)(hp8 + e0) = (u32x2){pack4_fp8(y[0], y[1], y[2], y[3]), pack4_fp8(y[4], y[5], y[6], y[7])};
        *(u32x2*)(hp8 + e1) = (u32x2){pack4_fp8(y[8], y[9], y[10], y[11]), pack4_fp8(y[12], y[13], y[14], y[15])};
    }
}
__device__ __forceinline__ void phase_final(const Args& a, int bid, int nb) {
    const int tid = otid(), lane = tid & 63, wave = __builtin_amdgcn_readfirstlane(tid >> 6);
    const int e0 = lane * 8, e1 = 512 + lane * 8;
    float mg[16]; int cur_r = -1;
    const bf16_t* y2 = (const bf16_t*)(a.ws + WS_XS);
    const int rper = (TL + nb * 8 - 1) / (nb * 8), row_lo = (bid * 8 + wave) * rper, row_hi = min(row_lo + rper, TL);
    int2 pp = {0, 0}; float2 ww = {0.f, 0.f};
    if (row_lo + lane < row_hi) { pp = *(const int2*)((const int*)(a.ws + WS_TOKR) + (size_t)(row_lo + lane) * 2); ww = *(const float2*)((const float*)(a.ws + WS_TOKW) + (size_t)(row_lo + lane) * 2); }
    for (int row = row_lo; row < row_hi; ++row) {
        const int r = row / SEQ;
        if (r != cur_r) { cur_r = r; const float* g = modp(a, 1, r, 5);
#pragma unroll
            for (int j = 0; j < 8; ++j) { mg[j] = g[e0 + j]; mg[8 + j] = g[e1 + j]; } }
        float* src = a.out + (size_t)row * D;
        float v[16];
        load_row_bf16((const bf16_t*)(a.ws + WS_XB) + (size_t)row * D, e0, e1, v);
        moe_combine(y2, pp, ww, row - row_lo, mg, e0, e1, v);
        *(f32x4*)(src + e0) = (f32x4){v[0], v[1], v[2], v[3]}; *(f32x4*)(src + e0 + 4) = (f32x4){v[4], v[5], v[6], v[7]};
        *(f32x4*)(src + e1) = (f32x4){v[8], v[9], v[10], v[11]}; *(f32x4*)(src + e1 + 4) = (f32x4){v[12], v[13], v[14], v[15]};
    }
}

constexpr int VP = 516;
__device__ __forceinline__ void phase_prep(const Args& a, int l, MLAS unsigned char* lds, int bid, int nb) {
    const int tid = otid(), lane = tid & 63, wave = tid >> 6;
    const bf16_t* proj = (const bf16_t*)(a.ws + WS_PROJ);
    MLAS bf16_t* Vs = (MLAS bf16_t*)lds;
    float wk[8];
    { const float* w = a.na_k_norm + l * 64 + (lane & 7) * 8;
#pragma unroll
      for (int j = 0; j < 8; ++j) wk[j] = w[j]; }
    for (int u = bid; u < TT / 64; u += nb) {
        const int R0 = u * 64; const bool lat = R0 < TL;
        const int b = lat ? R0 / SEQ : (R0 - TL) / LC, t0 = lat ? R0 % SEQ : (R0 - TL) % LC, tlen = lat ? SEQ : LC;
        bf16_t* kc = (bf16_t*)(a.ws + (lat ? WS_KC : WS_KCC)); bf16_t* vt = (bf16_t*)(a.ws + (lat ? WS_VT : WS_VTC));
        __syncthreads();
#pragma unroll
        for (int rr = 0; rr < 8; ++rr) {
            const int rl = wave * 8 + rr, row = R0 + rl, t = t0 + rl;
            const bf16_t* p = proj + (size_t)row * INC;
            const u32x4 kw = *(const u32x4*)(p + C_KA + lane * 8), vw = *(const u32x4*)(p + C_VA + lane * 8);
            float f[8];
#pragma unroll
            for (int j = 0; j < 4; ++j) { f[2 * j] = lo16(kw[j]); f[2 * j + 1] = hi16(kw[j]); }
            float ss = 0.f;
#pragma unroll
            for (int j = 0; j < 8; ++j) ss += f[j] * f[j];
            ss += __shfl_xor(ss, 1); ss += __shfl_xor(ss, 2); ss += __shfl_xor(ss, 4);
            const float rs = rsqrtf(ss * (1.0f / 64.0f) + 1e-6f);
            *(u32x4*)(kc + (((size_t)b * 8 + (lane >> 3)) * tlen + t) * 64 + (lane & 7) * 8) =
                (u32x4){pack2(f[0] * rs * wk[0], f[1] * rs * wk[1]), pack2(f[2] * rs * wk[2], f[3] * rs * wk[3]), pack2(f[4] * rs * wk[4], f[5] * rs * wk[5]), pack2(f[6] * rs * wk[6], f[7] * rs * wk[7])};
            *(MLAS u32x2*)(Vs + rl * VP + lane * 8) = (u32x2){vw.x, vw.y}; *(MLAS u32x2*)(Vs + rl * VP + lane * 8 + 4) = (u32x2){vw.z, vw.w};
        }
        __syncthreads();
#pragma unroll
        for (int i = 0; i < 8; ++i) { const int idx = tid + i * NT, d = idx & 63, tc = (idx >> 6) & 7, h = idx >> 9;
            const MLAS bf16_t* vp = Vs + (tc * 8) * VP + h * 64 + d;
            const u32x4 w = {(unsigned)vp[0] | ((unsigned)vp[VP] << 16), (unsigned)vp[2 * VP] | ((unsigned)vp[3 * VP] << 16), (unsigned)vp[4 * VP] | ((unsigned)vp[5 * VP] << 16), (unsigned)vp[6 * VP] | ((unsigned)vp[7 * VP] << 16)};
            const int tk = t0 + tc * 8;
            *(u32x4*)(vt + ((((size_t)b * 8 + h) * (tlen >> 4) + (tk >> 4)) * 64 + d) * 16 + (tk & 15)) = w; }
    }
}

__device__ __forceinline__ int chunk_row0(int b, int c) { return c < 2 ? TL + b * LC + c * 128 : b * SEQ + (c - 2) * 128; }
__device__ __forceinline__ size_t st_index(int b, int h, int dir, int c) { return ((((size_t)b * 4 + h) * 2 + dir) * NCH + c) * 16384; }
constexpr int RP = 136;
__device__ __forceinline__ void load_rope_pair(const bf16_t* p, int a2, int fc, int tok, const MLAS float* rope, float (&y1)[8], float (&y2)[8]) {
    const u32x4 w0 = *(const u32x4*)(p + (a2 * 8 + fc) * 8), w1 = *(const u32x4*)(p + (a2 * 8 + fc + 4) * 8);
#pragma unroll
    for (int j = 0; j < 4; ++j) { y1[2 * j] = lo16(w0[j]); y1[2 * j + 1] = hi16(w0[j]); y2[2 * j] = lo16(w1[j]); y2[2 * j + 1] = hi16(w1[j]); }
    if (tok >= 0) {
        const int pos = a2 == 0 ? (tok >> 6) : (tok & 63);
        const MLAS f32x4* tp = (const MLAS f32x4*)(rope + (pos * 32 + fc * 8) * 2);
#pragma unroll
        for (int q = 0; q < 4; ++q) { const f32x4 cs = tp[q];
            const float u0 = y1[2 * q] * cs[0] - y2[2 * q] * cs[1], v0 = y1[2 * q] * cs[1] + y2[2 * q] * cs[0];
            const float u1 = y1[2 * q + 1] * cs[2] - y2[2 * q + 1] * cs[3], v1 = y1[2 * q + 1] * cs[3] + y2[2 * q + 1] * cs[2];
            y1[2 * q] = u0; y2[2 * q] = v0; y1[2 * q + 1] = u1; y2[2 * q + 1] = v1; }
    }
}
__device__ __forceinline__ void rope_pair_regs(const u32x4 w0, const u32x4 w1, int a2, int fc, int tok, const MLAS float* rope, float (&y1)[8], float (&y2)[8]) {
#pragma unroll
    for (int j = 0; j < 4; ++j) { y1[2 * j] = lo16(w0[j]); y1[2 * j + 1] = hi16(w0[j]); y2[2 * j] = lo16(w1[j]); y2[2 * j + 1] = hi16(w1[j]); }
    if (tok >= 0) {
        const int pos = a2 == 0 ? (tok >> 6) : (tok & 63);
        const MLAS f32x4* tp = (const MLAS f32x4*)(rope + (pos * 32 + fc * 8) * 2);
#pragma unroll
        for (int q = 0; q < 4; ++q) { const f32x4 cs = tp[q];
            const float u0 = y1[2 * q] * cs[0] - y2[2 * q] * cs[1], v0 = y1[2 * q] * cs[1] + y2[2 * q] * cs[0];
            const float u1 = y1[2 * q + 1] * cs[2] - y2[2 * q + 1] * cs[3], v1 = y1[2 * q + 1] * cs[3] + y2[2 * q + 1] * cs[2];
            y1[2 * q] = u0; y2[2 * q] = v0; y1[2 * q + 1] = u1; y2[2 * q + 1] = v1; }
    }
}
__device__ __forceinline__ u32x4 pack8(const float (&y)[8], float sc) { return (u32x4){pack2(y[0] * sc, y[1] * sc), pack2(y[2] * sc, y[3] * sc), pack2(y[4] * sc, y[5] * sc), pack2(y[6] * sc, y[7] * sc)}; }
constexpr float RET_KSCALE = 0.08838834764831845f;
constexpr int LDS_ROPE = 98304;
__device__ __forceinline__ void phase_ret_a(const Args& a, int l, MLAS unsigned char* lds, int bid, int nb) {
    const int tid = otid(), lane = tid & 63, wave = __builtin_amdgcn_readfirstlane(tid >> 6);
    const bf16_t* proj = (const bf16_t*)(a.ws + WS_PROJ); bf16_t* st = (bf16_t*)(a.ws + WS_ST);
    const unsigned ldsb = (unsigned)(size_t)lds;
    const int dir = wave >> 2, dt = wave & 3, hh = lane >> 5;
    MLAS float* rope = (MLAS float*)(lds + LDS_ROPE);
    for (int i = tid; i < 64 * 32 * 2; i += NT) rope[i] = ((const float*)(a.ws + WS_ROPE))[i];
#define RA_LOAD(u_) do { const int b_ = (u_) / (NCH * 4), c_ = ((u_) >> 2) % NCH, h_ = (u_) & 3, row0_ = chunk_row0(b_, c_); _Pragma("unroll") for (int i = 0; i < 2; ++i) { const int idx = tid + i * NT, row = idx >> 3, ch0 = ((idx >> 2) & 1) * 8 + (idx & 3); \
        const bf16_t* src = proj + (size_t)(row0_ + row) * INC + h_ * 128; \
        raw[i][0] = *(const u32x4*)(src + C_KB + ch0 * 8); raw[i][1] = *(const u32x4*)(src + C_KB + (ch0 + 4) * 8); raw[i][2] = *(const u32x4*)(src + C_VB + ch0 * 8); raw[i][3] = *(const u32x4*)(src + C_VB + (ch0 + 4) * 8); } } while (0)
    u32x4 raw[2][4];
    if (bid < NB * NCH * 4) RA_LOAD(bid);
    LDS_BARRIER();
    for (int u = bid; u < NB * NCH * 4; u += nb) {
        const int b = u / (NCH * 4), c = (u >> 2) % NCH, h = u & 3;
        const float lgf = -expf(a.ret_decay[l * 8 + h]), lgb = -expf(a.ret_decay[l * 8 + 4 + h]);
        LDS_BARRIER();
#pragma unroll
        for (int i = 0; i < 2; ++i) { const int idx = tid + i * NT, row = idx >> 3, a2 = (idx >> 2) & 1, fc = idx & 3, ch0 = a2 * 8 + fc;
            float y1[8], y2[8];
            rope_pair_regs(raw[i][0], raw[i][1], a2, fc, c >= 2 ? (c - 2) * 128 + row : -1, rope, y1, y2);
            const float wf = __expf((float)(127 - row) * lgf) * RET_KSCALE, wb = __expf((float)row * lgb) * RET_KSCALE;
            const unsigned o0 = off_b(row, ch0), o1 = off_b(row, ch0 + 4);
            *(MLAS u32x4*)(lds + o0) = pack8(y1, wf); *(MLAS u32x4*)(lds + o1) = pack8(y2, wf);
            *(MLAS u32x4*)(lds + 32768 + o0) = pack8(y1, wb); *(MLAS u32x4*)(lds + 32768 + o1) = pack8(y2, wb);
            *(MLAS u32x4*)(lds + 65536 + o0) = raw[i][2]; *(MLAS u32x4*)(lds + 65536 + o1) = raw[i][3]; }
        { const int un_ = u + nb < NB * NCH * 4 ? u + nb : u; RA_LOAD(un_); }
        LDS_BARRIER();
        f32x16 acc[4];
#pragma unroll
        for (int et = 0; et < 4; ++et)
#pragma unroll
            for (int r = 0; r < 16; ++r) acc[et][r] = 0.f;
        unsigned aK[2], aV[4][2];
#pragma unroll
        for (int t = 0; t < 2; ++t) { aK[t] = ldsb + dir * 32768 + tr_addr(8 * hh + 4 * t, dt, lane);
#pragma unroll
            for (int et = 0; et < 4; ++et) aV[et][t] = ldsb + 65536 + tr_addr(8 * hh + 4 * t, et, lane); }
#pragma unroll
        for (int ks = 0; ks < 8; ++ks) {
            u32x2 r0, r1, r2, r3, r4, r5, r6, r7, r8, r9; const unsigned ko = ks * 4096;
            asm volatile("ds_read_b64_tr_b16 %0, %10\n\tds_read_b64_tr_b16 %1, %11\n\tds_read_b64_tr_b16 %2, %12\n\tds_read_b64_tr_b16 %3, %13\n\tds_read_b64_tr_b16 %4, %14\n\t"
                         "ds_read_b64_tr_b16 %5, %15\n\tds_read_b64_tr_b16 %6, %16\n\tds_read_b64_tr_b16 %7, %17\n\tds_read_b64_tr_b16 %8, %18\n\tds_read_b64_tr_b16 %9, %19\n\ts_waitcnt lgkmcnt(0)"
                         : "=&v"(r0), "=&v"(r1), "=&v"(r2), "=&v"(r3), "=&v"(r4), "=&v"(r5), "=&v"(r6), "=&v"(r7), "=&v"(r8), "=&v"(r9)
                         : "v"(aK[0] + ko), "v"(aK[1] + ko), "v"(aV[0][0] + ko), "v"(aV[0][1] + ko), "v"(aV[1][0] + ko), "v"(aV[1][1] + ko), "v"(aV[2][0] + ko), "v"(aV[2][1] + ko), "v"(aV[3][0] + ko), "v"(aV[3][1] + ko) : "memory");
            const bf16x8 A = mkfrag(r0, r1);
            acc[0] = __builtin_amdgcn_mfma_f32_32x32x16_bf16(A, mkfrag(r2, r3), acc[0], 0, 0, 0);
            acc[1] = __builtin_amdgcn_mfma_f32_32x32x16_bf16(A, mkfrag(r4, r5), acc[1], 0, 0, 0);
            acc[2] = __builtin_amdgcn_mfma_f32_32x32x16_bf16(A, mkfrag(r6, r7), acc[2], 0, 0, 0);
            acc[3] = __builtin_amdgcn_mfma_f32_32x32x16_bf16(A, mkfrag(r8, r9), acc[3], 0, 0, 0);
        }
        bf16_t* o = st + st_index(b, h, dir, c);
#pragma unroll
        for (int et = 0; et < 4; ++et) { bf16_t* p = o + ((dt * 4 + et) * 64 + lane) * 16;
            *(u32x4*)p = (u32x4){pack2(acc[et][0], acc[et][1]), pack2(acc[et][2], acc[et][3]), pack2(acc[et][4], acc[et][5]), pack2(acc[et][6], acc[et][7])};
            *(u32x4*)(p + 8) = (u32x4){pack2(acc[et][8], acc[et][9]), pack2(acc[et][10], acc[et][11]), pack2(acc[et][12], acc[et][13]), pack2(acc[et][14], acc[et][15])}; }
    }
#undef RA_LOAD
}
__device__ __forceinline__ void phase_scan(const Args& a, int l, int bid, int nb) {
    bf16_t* st = (bf16_t*)(a.ws + WS_ST);
#pragma unroll 1
    for (int idx = bid * NT + otid(); idx < NB * 4 * 2 * 2048; idx += nb * NT) {
        const int chain = idx >> 11, v8 = idx & 2047, dir = chain & 1, h = (chain >> 1) & 3;
        const float dec = expf(-128.0f * expf(a.ret_decay[l * 8 + dir * 4 + h]));
        bf16_t* p = st + (size_t)chain * NCH * 16384 + v8 * 8;
        float S[8];
#pragma unroll
        for (int j = 0; j < 8; ++j) S[j] = 0.f;
#pragma unroll 1
        for (int half = 0; half < 2; ++half) {
            u32x4 ls[NCH / 2];
#pragma unroll
            for (int i = 0; i < NCH / 2; ++i) { const int ii = half * (NCH / 2) + i, c = dir == 0 ? ii : (ii < 2 ? 1 - ii : NCH + 1 - ii); ls[i] = *(const u32x4*)(p + (size_t)c * 16384); }
#pragma unroll
            for (int i = 0; i < NCH / 2; ++i) { const int ii = half * (NCH / 2) + i, c = dir == 0 ? ii : (ii < 2 ? 1 - ii : NCH + 1 - ii);
                *(u32x4*)(p + (size_t)c * 16384) = (u32x4){pack2(S[0], S[1]), pack2(S[2], S[3]), pack2(S[4], S[5]), pack2(S[6], S[7])};
#pragma unroll
                for (int t = 0; t < 4; ++t) { S[2 * t] = S[2 * t] * dec + lo16(ls[i][t]); S[2 * t + 1] = S[2 * t + 1] * dec + hi16(ls[i][t]); } }
        }
    }
}
__device__ __forceinline__ void phase_ret_b(const Args& a, int l, MLAS unsigned char* lds, int bid, int nb) {
    const int tid = otid(), lane = tid & 63, wave = __builtin_amdgcn_readfirstlane(tid >> 6);
    const bf16_t* proj = (const bf16_t*)(a.ws + WS_PROJ); const bf16_t* st = (const bf16_t*)(a.ws + WS_ST); bf16_t* mix = (bf16_t*)(a.ws + WS_H);
    const unsigned ldsb = (unsigned)(size_t)lds;
    const int dir = wave >> 2, it = wave & 3, hh = lane >> 5, il = it * 32 + (lane & 31);
    const int c_lo = l == 0 ? 0 : 2, ncu = NCH - c_lo;
    MLAS float* rope = (MLAS float*)(lds + LDS_ROPE);
    for (int i = tid; i < 64 * 32 * 2; i += NT) rope[i] = ((const float*)(a.ws + WS_ROPE))[i];
#define RB_DECODE(u_, b_, c_, h_, row0_) const int b_ = (u_) / (ncu * 4), c_ = c_lo + ((u_) >> 2) % ncu, h_ = (u_) & 3, row0_ = chunk_row0(b_, c_)
#define RB_LOAD(u_) do { RB_DECODE(u_, b_, c_, h_, row0_); (void)c_; _Pragma("unroll") for (int i = 0; i < 2; ++i) { const int idx = tid + i * NT, row = idx >> 3, ch0 = ((idx >> 2) & 1) * 8 + (idx & 3); \
        const bf16_t* src = proj + (size_t)(row0_ + row) * INC + h_ * 128; \
        raw[i][0] = *(const u32x4*)(src + C_QB + ch0 * 8); raw[i][1] = *(const u32x4*)(src + C_QB + (ch0 + 4) * 8); raw[i][2] = *(const u32x4*)(src + C_KB + ch0 * 8); raw[i][3] = *(const u32x4*)(src + C_KB + (ch0 + 4) * 8); \
        raw[i][4] = *(const u32x4*)(src + C_VB + ch0 * 8); raw[i][5] = *(const u32x4*)(src + C_VB + (ch0 + 4) * 8); } } while (0)
    u32x4 raw[2][6];
    if (bid < NB * ncu * 4) RB_LOAD(bid);
    LDS_BARRIER();
    for (int u = bid; u < NB * ncu * 4; u += nb) {
        RB_DECODE(u, b, c, h, row0);
        const float lg = -expf(a.ret_decay[l * 8 + dir * 4 + h]);
        LDS_BARRIER();
#pragma unroll
        for (int i = 0; i < 2; ++i) { const int idx = tid + i * NT, row = idx >> 3, a2 = (idx >> 2) & 1, fc = idx & 3, ch0 = a2 * 8 + fc;
            const int tok = c >= 2 ? (c - 2) * 128 + row : -1;
            const unsigned o0 = off_b(row, ch0), o1 = off_b(row, ch0 + 4);
            float y1[8], y2[8];
            rope_pair_regs(raw[i][0], raw[i][1], a2, fc, tok, rope, y1, y2);
            *(MLAS u32x4*)(lds + o0) = pack8(y1, 1.0f); *(MLAS u32x4*)(lds + o1) = pack8(y2, 1.0f);
            rope_pair_regs(raw[i][2], raw[i][3], a2, fc, tok, rope, y1, y2);
            *(MLAS u32x4*)(lds + 32768 + o0) = pack8(y1, RET_KSCALE); *(MLAS u32x4*)(lds + 32768 + o1) = pack8(y2, RET_KSCALE);
            *(MLAS u32x4*)(lds + 65536 + o0) = raw[i][4]; *(MLAS u32x4*)(lds + 65536 + o1) = raw[i][5]; }
        LDS_BARRIER();
        f32x16 acc[4];
#pragma unroll
        for (int et = 0; et < 4; ++et)
#pragma unroll
            for (int r = 0; r < 16; ++r) acc[et][r] = 0.f;
        {
            const bf16_t* sp = st + st_index(b, h, dir, c) + lane * 16;
#pragma unroll
            for (int dt = 0; dt < 4; ++dt)
#pragma unroll
                for (int s2 = 0; s2 < 2; ++s2) {
                    const u32x2 q0 = *(const MLAS u32x2*)(lds + off_b(il, 4 * dt + 2 * s2) + 8 * hh), q1 = *(const MLAS u32x2*)(lds + off_b(il, 4 * dt + 2 * s2 + 1) + 8 * hh);
                    const bf16x8 Bq = mkfrag(q0, q1);
#pragma unroll
                    for (int et = 0; et < 4; ++et) { const bf16x8 A = __builtin_bit_cast(bf16x8, *(const u32x4*)(sp + (dt * 4 + et) * 1024 + 8 * s2));
                        acc[et] = __builtin_amdgcn_mfma_f32_32x32x16_bf16(A, Bq, acc[et], 0, 0, 0); }
                }
            const float qdec = __expf((float)(dir == 0 ? il + 1 : 128 - il) * lg);
#pragma unroll
            for (int et = 0; et < 4; ++et)
#pragma unroll
                for (int r = 0; r < 16; ++r) acc[et][r] *= qdec;
        }
        bf16x8 Qn[8];
#pragma unroll
        for (int ks = 0; ks < 8; ++ks) Qn[ks] = *(const MLAS bf16x8*)(lds + off_b(il, 2 * ks + hh));
        const int jt_lo = dir == 0 ? 0 : it, jt_hi = dir == 0 ? it : 3;
        for (int jt = jt_lo; jt <= jt_hi; ++jt) {
            f32x16 sc;
#pragma unroll
            for (int r = 0; r < 16; ++r) sc[r] = 0.f;
#pragma unroll
            for (int ks = 0; ks < 8; ++ks) { const bf16x8 A = *(const MLAS bf16x8*)(lds + 32768 + off_b(jt * 32 + (lane & 31), 2 * ks + hh));
                sc = __builtin_amdgcn_mfma_f32_32x32x16_bf16(A, Qn[ks], sc, 0, 0, 0); }
            unsigned pk[8];
#pragma unroll
            for (int r = 0; r < 16; r += 2) {
                const int j0 = jt * 32 + (r & 3) + 8 * (r >> 2) + 4 * hh, j1 = j0 + 1;
                const int d0 = dir == 0 ? il - j0 : j0 - il, d1 = dir == 0 ? il - j1 : j1 - il;
                const float p0 = d0 >= 0 ? sc[r] * __expf((float)d0 * lg) : 0.f, p1 = d1 >= 0 ? sc[r + 1] * __expf((float)d1 * lg) : 0.f;
                pk[r >> 1] = pack2(p0, p1);
            }
            const bf16x8 P0 = __builtin_bit_cast(bf16x8, (u32x4){pk[0], pk[1], pk[2], pk[3]}), P1 = __builtin_bit_cast(bf16x8, (u32x4){pk[4], pk[5], pk[6], pk[7]});
#pragma unroll
            for (int et = 0; et < 4; ++et) {
                u32x2 r0, r1, r2, r3;
                const unsigned a0 = ldsb + 65536 + tr_addr(jt * 32 + 4 * hh, et, lane), a1 = ldsb + 65536 + tr_addr(jt * 32 + 8 + 4 * hh, et, lane);
                const unsigned a2 = ldsb + 65536 + tr_addr(jt * 32 + 16 + 4 * hh, et, lane), a3 = ldsb + 65536 + tr_addr(jt * 32 + 24 + 4 * hh, et, lane);
                asm volatile("ds_read_b64_tr_b16 %0, %4\n\tds_read_b64_tr_b16 %1, %5\n\tds_read_b64_tr_b16 %2, %6\n\tds_read_b64_tr_b16 %3, %7\n\ts_waitcnt lgkmcnt(0)"
                             : "=&v"(r0), "=&v"(r1), "=&v"(r2), "=&v"(r3) : "v"(a0), "v"(a1), "v"(a2), "v"(a3) : "memory");
                acc[et] = __builtin_amdgcn_mfma_f32_32x32x16_bf16(mkfrag(r0, r1), P0, acc[et], 0, 0, 0);
                acc[et] = __builtin_amdgcn_mfma_f32_32x32x16_bf16(mkfrag(r2, r3), P1, acc[et], 0, 0, 0);
            }
        }
        u32x4 gfr[4], gbr[4];
        { const bf16_t* gp = proj + (size_t)(row0 + (tid >> 2)) * INC + h * 128;
#pragma unroll
          for (int k = 0; k < 4; ++k) { const int ch = (tid & 3) * 4 + k; gfr[k] = *(const u32x4*)(gp + C_GF + ch * 8); gbr[k] = *(const u32x4*)(gp + C_GB + ch * 8); } }
        float s1 = 0.f;
#pragma unroll
        for (int et = 0; et < 4; ++et)
#pragma unroll
            for (int r = 0; r < 16; ++r) s1 += acc[et][r];
        s1 += __shfl_xor(s1, 32);
        const float mean = s1 * (1.0f / 128.0f);
        float s2 = 0.f;
#pragma unroll
        for (int et = 0; et < 4; ++et)
#pragma unroll
            for (int r = 0; r < 16; ++r) { const float dlt = acc[et][r] - mean; s2 += dlt * dlt; }
        s2 += __shfl_xor(s2, 32);
        const float rstd = rsqrtf(s2 * (1.0f / 128.0f) + 1e-5f);
        LDS_BARRIER();
#pragma unroll
        for (int et = 0; et < 4; ++et)
#pragma unroll
            for (int g = 0; g < 4; ++g) {
                const u32x2 w = {pack2((acc[et][4 * g] - mean) * rstd, (acc[et][4 * g + 1] - mean) * rstd), pack2((acc[et][4 * g + 2] - mean) * rstd, (acc[et][4 * g + 3] - mean) * rstd)};
                *(MLAS u32x2*)(lds + dir * 32768 + off_b(il, 4 * et + g) + 8 * hh) = w; }
        { const int un_ = u + nb < NB * ncu * 4 ? u + nb : u; RB_LOAD(un_); }
        LDS_BARRIER();
        {
            const int i = tid >> 2, part = tid & 3;
            bf16_t* op = mix + (size_t)(row0 + i) * D + 512 + h * 128;
#pragma unroll
            for (int k = 0; k < 4; ++k) { const int ch = part * 4 + k;
                const u32x4 of = *(const MLAS u32x4*)(lds + off_b(i, ch)), ob = *(const MLAS u32x4*)(lds + 32768 + off_b(i, ch));
                const u32x4 gf = gfr[k], gb = gbr[k];
                if (OUT_FP8) { float f[8];
#pragma unroll
                    for (int t = 0; t < 4; ++t) { f[2 * t] = MIX8_SCALE * (lo16(of[t]) * siluf(lo16(gf[t])) + lo16(ob[t]) * siluf(lo16(gb[t]))); f[2 * t + 1] = MIX8_SCALE * (hi16(of[t]) * siluf(hi16(gf[t])) + hi16(ob[t]) * siluf(hi16(gb[t]))); }
                    *(u32x2*)((unsigned char*)mix + (size_t)(row0 + i) * D + 512 + h * 128 + ch * 8) = (u32x2){pack4_fp8(f[0], f[1], f[2], f[3]), pack4_fp8(f[4], f[5], f[6], f[7])}; }
                else { u32x4 o;
#pragma unroll
                for (int t = 0; t < 4; ++t) o[t] = pack2(lo16(of[t]) * siluf(lo16(gf[t])) + lo16(ob[t]) * siluf(lo16(gb[t])), hi16(of[t]) * siluf(hi16(gf[t])) + hi16(ob[t]) * siluf(hi16(gb[t])));
                *(u32x4*)(op + ch * 8) = o; } }
        }
    }
#undef RB_DECODE
#undef RB_LOAD
}

constexpr int NA_OP = 72;
__device__ __forceinline__ int perm16(int x) { return (x & 3) | ((x & 4) << 1) | ((x & 8) >> 1); }
__device__ __forceinline__ void phase_na(const Args& a, int l, MLAS unsigned char* lds, int bid, int nb) {
    const int tid = otid(), lane = tid & 63, wave = __builtin_amdgcn_readfirstlane(tid >> 6);
    const bf16_t* proj = (const bf16_t*)(a.ws + WS_PROJ); bf16_t* mix = (bf16_t*)(a.ws + WS_H);
    const bf16_t* KC = (const bf16_t*)(a.ws + WS_KC); const bf16_t* VT = (const bf16_t*)(a.ws + WS_VT);
    const bf16_t* KCC = (const bf16_t*)(a.ws + WS_KCC); const bf16_t* VTC = (const bf16_t*)(a.ws + WS_VTC);
    MLAS float* rpb = (MLAS float*)lds;
    MLAS bf16_t* ost = (MLAS bf16_t*)(lds + 8192) + wave * 64 * NA_OP;
    const int n_lat = NB * 8 * 8, n_ctx = l == 0 ? NB * 4 : 0;
    const int hh = lane >> 5, ql = lane & 31;
    for (int u0 = bid; u0 < n_lat + n_ctx; u0 += nb) {
        int u = u0;
        if (nb == 256 && u0 < n_lat) { const int x = bid & 7, j = bid >> 3, i = u0 >> 8; u = ((i * 32 + x * 4 + (j >> 3)) << 3) + (j & 7); }
        const bool is_ctx = u >= n_lat;
        const int v = is_ctx ? u - n_lat : u;
        const int b = is_ctx ? v >> 2 : v >> 6, h = is_ctx ? 2 * (v & 3) + (wave >> 2) : (v >> 3) & 7;
        const int r = (v & 7) * 8 + wave;
        const int qrow0 = is_ctx ? TL + b * LC + (wave & 3) * 64 : b * SEQ + r * 64;
        const size_t bh = (size_t)b * 8 + h;
        __syncthreads();
        if (!is_ctx) for (int i = tid; i < 15 * 128; i += NT) { const int dr = i >> 7, x = (i & 127) - 48; rpb[i] = (x >= 0 && x < 31) ? a.na_rpb[((size_t)l * 8 + h) * 465 + dr * 31 + x] * 1.4426950408889634f : 0.f; }
        __syncthreads();
        bf16x8 Qf[2][4];
#pragma unroll
        for (int qt = 0; qt < 2; ++qt) {
            u32x4 qw[4]; float ss = 0.f;
#pragma unroll
            for (int ks = 0; ks < 4; ++ks) { qw[ks] = *(const u32x4*)(proj + (size_t)(qrow0 + 32 * qt + ql) * INC + C_QA + h * 64 + 16 * ks + 8 * hh);
#pragma unroll
                for (int t = 0; t < 4; ++t) { const float x0 = lo16(qw[ks][t]), x1 = hi16(qw[ks][t]); ss += x0 * x0 + x1 * x1; } }
            ss += __shfl_xor(ss, 32);
            const float rs = rsqrtf(ss * (1.0f / 64.0f) + 1e-6f) * 0.18033688011112042f;
#pragma unroll
            for (int ks = 0; ks < 4; ++ks) { const f32x4 w0 = *(const f32x4*)(a.na_q_norm + l * 64 + 16 * ks + 8 * hh), w1 = *(const f32x4*)(a.na_q_norm + l * 64 + 16 * ks + 8 * hh + 4);
                const u32x4 o = {pack2(lo16(qw[ks][0]) * rs * w0[0], hi16(qw[ks][0]) * rs * w0[1]), pack2(lo16(qw[ks][1]) * rs * w0[2], hi16(qw[ks][1]) * rs * w0[3]),
                                 pack2(lo16(qw[ks][2]) * rs * w1[0], hi16(qw[ks][2]) * rs * w1[1]), pack2(lo16(qw[ks][3]) * rs * w1[2], hi16(qw[ks][3]) * rs * w1[3])};
                Qf[qt][ks] = __builtin_bit_cast(bf16x8, o); }
        }
        f32x16 O[2][2];
#pragma unroll
        for (int qt = 0; qt < 2; ++qt)
#pragma unroll
            for (int i = 0; i < 16; ++i) { O[qt][0][i] = 0.f; O[qt][1][i] = 0.f; }
        float lsum[2] = {0.f, 0.f};
        const int r0 = min(max(r - 4, 0), 56);
        const int kslot = 16 * (ql >> 4) + perm16(ql & 15);
        const bf16_t* kl = KC + (bh * SEQ + (size_t)(r0 + (ql >> 4)) * 64 + perm16(ql & 15)) * 64 + 8 * hh;
        const bf16_t* vl = VT + ((bh * 256 + (size_t)r0 * 4) * 64 + ql) * 16 + 8 * hh;
        const bf16_t* kx = KCC + (bh * LC + kslot) * 64 + 8 * hh;
        const bf16_t* vx = VTC + ((bh * 16) * 64 + ql) * 16 + 8 * hh;
#define NA_PTRS(t, kp, vp, vstep) do { if ((t) < 16) { const int ip_ = (t) >> 2, ct_ = (t) & 3; kp = kl + (size_t)(2 * ip_ * 64 + 16 * ct_) * 64; vp = vl + (2 * ip_ * 4 + ct_) * 1024; vstep = 4096; } \
        else { kp = kx + (size_t)(32 * ((t) - 16)) * 64; vp = vx + ((t) - 16) * 2048; vstep = 1024; } } while (0)
#define NA_LOADS(kp, vp, vstep, Kd, Vd) do { _Pragma("unroll") for (int ks_ = 0; ks_ < 4; ++ks_) Kd[ks_] = *(const u32x4*)(kp + 16 * ks_); \
        Vd[0] = *(const u32x4*)(vp); Vd[1] = *(const u32x4*)(vp + vstep); Vd[2] = *(const u32x4*)(vp + 512); Vd[3] = *(const u32x4*)(vp + 512 + vstep); } while (0)
        const int t_lo = is_ctx ? 16 : 0;
        u32x4 Kn[4], Vn[4];
        { const bf16_t* kp; const bf16_t* vp; int vstep; NA_PTRS(t_lo, kp, vp, vstep); NA_LOADS(kp, vp, vstep, Kn, Vn); }
#pragma unroll 1
        for (int t = t_lo; t < 24; ++t) {
            u32x4 Kc[4], Vc[4];
#pragma unroll
            for (int i = 0; i < 4; ++i) { Kc[i] = Kn[i]; Vc[i] = Vn[i]; }
            if (t + 1 < 24) { const bf16_t* kp; const bf16_t* vp; int vstep; NA_PTRS(t + 1, kp, vp, vstep); NA_LOADS(kp, vp, vstep, Kn, Vn); }
            const int ip = t >> 2, ct = t & 3;
#pragma unroll
            for (int qt = 0; qt < 2; ++qt) {
                if (t < 16 && (unsigned)(ct - qt) > 2u) continue;
                f32x16 sc;
#pragma unroll
                for (int i = 0; i < 16; ++i) sc[i] = 0.f;
#pragma unroll
                for (int ks = 0; ks < 4; ++ks) sc = __builtin_amdgcn_mfma_f32_32x32x16_bf16(__builtin_bit_cast(bf16x8, Kc[ks]), Qf[qt][ks], sc, 0, 0, 0);
                unsigned pk[8];
                if (t < 16) {
                    const int q = qt * 32 + ql, c0 = min(max(q - 8, 0), 48);
#pragma unroll
                    for (int rr = 0; rr < 16; rr += 2) {
                        const int wi = 2 * ip + (rr >> 3), col = 16 * ct + (rr & 3) + 4 * ((rr >> 2) & 1) + 8 * hh;
                        const MLAS float* bp = rpb + (r0 + wi - r + 7) * 128 + (col - q + 63);
                        const float b0 = bp[0], b1 = bp[1];
                        const float e0 = __builtin_amdgcn_exp2f(sc[rr] + b0), e1 = __builtin_amdgcn_exp2f(sc[rr + 1] + b1);
                        const float p0 = (unsigned)(col - c0) < 16u ? e0 : 0.f, p1 = (unsigned)(col + 1 - c0) < 16u ? e1 : 0.f;
                        lsum[qt] += p0 + p1; pk[rr >> 1] = pack2(p0, p1);
                    }
                } else {
#pragma unroll
                    for (int rr = 0; rr < 16; rr += 2) { const float p0 = __builtin_amdgcn_exp2f(sc[rr]), p1 = __builtin_amdgcn_exp2f(sc[rr + 1]); lsum[qt] += p0 + p1; pk[rr >> 1] = pack2(p0, p1); }
                }
                const bf16x8 P0 = __builtin_bit_cast(bf16x8, (u32x4){pk[0], pk[1], pk[2], pk[3]}), P1 = __builtin_bit_cast(bf16x8, (u32x4){pk[4], pk[5], pk[6], pk[7]});
                O[qt][0] = __builtin_amdgcn_mfma_f32_32x32x16_bf16(__builtin_bit_cast(bf16x8, Vc[0]), P0, O[qt][0], 0, 0, 0);
                O[qt][0] = __builtin_amdgcn_mfma_f32_32x32x16_bf16(__builtin_bit_cast(bf16x8, Vc[1]), P1, O[qt][0], 0, 0, 0);
                O[qt][1] = __builtin_amdgcn_mfma_f32_32x32x16_bf16(__builtin_bit_cast(bf16x8, Vc[2]), P0, O[qt][1], 0, 0, 0);
                O[qt][1] = __builtin_amdgcn_mfma_f32_32x32x16_bf16(__builtin_bit_cast(bf16x8, Vc[3]), P1, O[qt][1], 0, 0, 0);
            }
        }
#undef NA_PTRS
#undef NA_LOADS
#pragma unroll
        for (int qt = 0; qt < 2; ++qt) {
            const float inv = 1.0f / (lsum[qt] + __shfl_xor(lsum[qt], 32));
#pragma unroll
            for (int g4 = 0; g4 < 4; ++g4) {
                *(MLAS u32x2*)(ost + (32 * qt + ql) * NA_OP + 8 * g4 + 4 * hh) = (u32x2){pack2(O[qt][0][4 * g4] * inv, O[qt][0][4 * g4 + 1] * inv), pack2(O[qt][0][4 * g4 + 2] * inv, O[qt][0][4 * g4 + 3] * inv)};
                *(MLAS u32x2*)(ost + (32 * qt + ql) * NA_OP + 32 + 8 * g4 + 4 * hh) = (u32x2){pack2(O[qt][1][4 * g4] * inv, O[qt][1][4 * g4 + 1] * inv), pack2(O[qt][1][4 * g4 + 2] * inv, O[qt][1][4 * g4 + 3] * inv)};
            }
        }
#pragma unroll
        for (int k = 0; k < 8; ++k) { const int idx = lane + 64 * k, row = idx >> 3, ch = idx & 7;
            const u32x4 ow = *(const MLAS u32x4*)(ost + row * NA_OP + ch * 8);
            if (OUT_FP8) *(u32x2*)((unsigned char*)mix + (size_t)(qrow0 + row) * D + h * 64 + ch * 8) = (u32x2){pack4_fp8(MIX8_SCALE * lo16(ow.x), MIX8_SCALE * hi16(ow.x), MIX8_SCALE * lo16(ow.y), MIX8_SCALE * hi16(ow.y)), pack4_fp8(MIX8_SCALE * lo16(ow.z), MIX8_SCALE * hi16(ow.z), MIX8_SCALE * lo16(ow.w), MIX8_SCALE * hi16(ow.w))};
            else *(u32x4*)(mix + (size_t)(qrow0 + row) * D + h * 64 + ch * 8) = ow; }
    }
}

constexpr int N2P = 1032;
typedef float f32x4v __attribute__((ext_vector_type(4)));
__device__ __forceinline__ void phase_norm2(const Args& a, int l, MLAS unsigned char* lds, int bid, int nb) {
    const int tid = otid(), lane = tid & 63, wave = __builtin_amdgcn_readfirstlane(tid >> 6);
    const int e0 = lane * 8, e1 = 512 + lane * 8;
    MLAS bf16_t* Ahi = (MLAS bf16_t*)lds; MLAS bf16_t* Alo = Ahi + 16 * N2P; MLAS float* part = (MLAS float*)(Alo + 16 * N2P);
    MLAS float* tsc = part + 8 * 16 * 32; MLAS float* tsh = tsc + 1024; int cur_r = -1;
    bf16_t* hb = (bf16_t*)(a.ws + WS_H);
    int* tok_e = (int*)(a.ws + WS_TOKE); int* tok_r = (int*)(a.ws + WS_TOKR); float* tok_w = (float*)(a.ws + WS_TOKW);
    unsigned* cnt = (unsigned*)(a.ws + WS_CNT) + l * 2048;
    MLAS unsigned* lcnt = (MLAS unsigned*)(tsh + 1024);
    if (tid < NE) lcnt[tid] = 0u;
    const int nrows = l == 0 ? TT : TL;
    bf16x8 Bh[4][2], Bl[4][2];
    { const bf16_t* rh = (const bf16_t*)(a.ws + WS_RWT); const bf16_t* rl = rh + 32 * 1024;
#pragma unroll
      for (int ks = 0; ks < 4; ++ks)
#pragma unroll
        for (int nt = 0; nt < 2; ++nt) { const int o = (nt * 16 + (lane & 15)) * 1024 + 128 * wave + 32 * ks + 8 * (lane >> 4);
            Bh[ks][nt] = __builtin_bit_cast(bf16x8, *(const u32x4*)(rh + o)); Bl[ks][nt] = __builtin_bit_cast(bf16x8, *(const u32x4*)(rl + o)); } }
    const float rbias = a.router_bias[lane & 31];
#define N2_BAR() do { asm volatile("s_waitcnt lgkmcnt(0)" ::: "memory"); __builtin_amdgcn_s_barrier(); asm volatile("" ::: "memory"); } while (0)
#define N2_LOAD(bt, dst) do { _Pragma("unroll") for (int jr_ = 0; jr_ < 2; ++jr_) { const int row_ = (bt) * 16 + 2 * wave + jr_; \
        if (row_ < TL) { const bf16_t* sb_ = (const bf16_t*)(a.ws + WS_XB) + (size_t)row_ * D; dst[jr_][0] = __builtin_bit_cast(f32x4, *(const u32x4*)(sb_ + e0)); dst[jr_][1] = __builtin_bit_cast(f32x4, *(const u32x4*)(sb_ + e1)); } \
        else { const float* src_ = (const float*)(a.ws + WS_CTX) + (size_t)(row_ - TL) * D; \
        dst[jr_][0] = *(const f32x4*)(src_ + e0); dst[jr_][1] = *(const f32x4*)(src_ + e0 + 4); dst[jr_][2] = *(const f32x4*)(src_ + e1); dst[jr_][3] = *(const f32x4*)(src_ + e1 + 4); } } } while (0)
    f32x4 vc[2][4];
    const int nbatch = nrows / 16;
    const int per = (nbatch + nb - 1) / nb, b_lo = bid * per, b_hi = min(b_lo + per, nbatch);
    if (b_lo < b_hi) N2_LOAD(b_lo, vc);
    for (int batch = b_lo; batch < b_hi; ++batch) {
        const int R0 = batch * 16, r = R0 < TL ? R0 / SEQ : 16;
        N2_BAR();
        if (r != cur_r) { cur_r = r; const float* sh = modp(a, l, r, 3); const float* sc = modp(a, l, r, 4); const float* w = a.norm_ffn_w + l * D;
            for (int k = tid; k < D; k += NT) { tsc[k] = (1.0f + sc[k]) * w[k]; tsh[k] = sh[k]; }
            N2_BAR(); }
#pragma unroll
        for (int jr = 0; jr < 2; ++jr) {
            const int m = 2 * wave + jr, row = R0 + m;
            float v[16];
            if (R0 < TL) { const u32x4 w0 = __builtin_bit_cast(u32x4, vc[jr][0]), w1 = __builtin_bit_cast(u32x4, vc[jr][1]);
#pragma unroll
                for (int j = 0; j < 4; ++j) { v[2 * j] = lo16(w0[j]); v[2 * j + 1] = hi16(w0[j]); v[8 + 2 * j] = lo16(w1[j]); v[8 + 2 * j + 1] = hi16(w1[j]); } }
            else {
#pragma unroll
                for (int j = 0; j < 4; ++j) { v[j] = vc[jr][0][j]; v[4 + j] = vc[jr][1][j]; v[8 + j] = vc[jr][2][j]; v[12 + j] = vc[jr][3][j]; } }
            float ss = 0.f;
#pragma unroll
            for (int j = 0; j < 16; ++j) ss += v[j] * v[j];
            ss = wave_sum(ss);
            const float rs = rsqrtf(ss * (1.0f / D) + 1e-6f);
            unsigned ph[8], pl[8], p8[4]; float yk0 = 0.f, yk1 = 0.f;
            float msc[16], msh[16];
#pragma unroll
            for (int q = 0; q < 2; ++q) { const f32x4 c0 = *(const MLAS f32x4*)(tsc + e0 + 4 * q), c1 = *(const MLAS f32x4*)(tsc + e1 + 4 * q), h0 = *(const MLAS f32x4*)(tsh + e0 + 4 * q), h1 = *(const MLAS f32x4*)(tsh + e1 + 4 * q);
#pragma unroll
                for (int j = 0; j < 4; ++j) { msc[4 * q + j] = c0[j]; msc[8 + 4 * q + j] = c1[j]; msh[4 * q + j] = h0[j]; msh[8 + 4 * q + j] = h1[j]; } }
#pragma unroll
            for (int j = 0; j < 16; j += 2) {
                const float y0 = v[j] * rs * msc[j] + msh[j], y1 = v[j + 1] * rs * msc[j + 1] + msh[j + 1];
                const bf16_t h0 = f2bf(y0), h1 = f2bf(y1);
                ph[j >> 1] = (unsigned)h0 | ((unsigned)h1 << 16); pl[j >> 1] = pack2(y0 - bf2f(h0), y1 - bf2f(h1));
                if (j & 2) p8[j >> 2] = pack4_fp8(yk0, yk1, y0, y1); else { yk0 = y0; yk1 = y1; } }
            unsigned char* hp = (unsigned char*)hb + (size_t)row * D;
            *(u32x2*)(hp + e0) = (u32x2){p8[0], p8[1]}; *(u32x2*)(hp + e1) = (u32x2){p8[2], p8[3]};
            *(MLAS u32x4*)(Ahi + m * N2P + e0) = (u32x4){ph[0], ph[1], ph[2], ph[3]}; *(MLAS u32x4*)(Ahi + m * N2P + e1) = (u32x4){ph[4], ph[5], ph[6], ph[7]};
            *(MLAS u32x4*)(Alo + m * N2P + e0) = (u32x4){pl[0], pl[1], pl[2], pl[3]}; *(MLAS u32x4*)(Alo + m * N2P + e1) = (u32x4){pl[4], pl[5], pl[6], pl[7]};
        }
        if (batch + 1 < b_hi) N2_LOAD(batch + 1, vc);
        N2_BAR();
        {
            f32x4v acc0 = {0.f, 0.f, 0.f, 0.f}, acc1 = {0.f, 0.f, 0.f, 0.f};
#pragma unroll
            for (int ks = 0; ks < 4; ++ks) {
                const int o = (lane & 15) * N2P + 128 * wave + 32 * ks + 8 * (lane >> 4);
                const bf16x8 ah = *(const MLAS bf16x8*)(Ahi + o), al = *(const MLAS bf16x8*)(Alo + o);
                acc0 = __builtin_amdgcn_mfma_f32_16x16x32_bf16(ah, Bh[ks][0], acc0, 0, 0, 0); acc0 = __builtin_amdgcn_mfma_f32_16x16x32_bf16(al, Bh[ks][0], acc0, 0, 0, 0); acc0 = __builtin_amdgcn_mfma_f32_16x16x32_bf16(ah, Bl[ks][0], acc0, 0, 0, 0);
                acc1 = __builtin_amdgcn_mfma_f32_16x16x32_bf16(ah, Bh[ks][1], acc1, 0, 0, 0); acc1 = __builtin_amdgcn_mfma_f32_16x16x32_bf16(al, Bh[ks][1], acc1, 0, 0, 0); acc1 = __builtin_amdgcn_mfma_f32_16x16x32_bf16(ah, Bl[ks][1], acc1, 0, 0, 0);
            }
#pragma unroll
            for (int rg = 0; rg < 4; ++rg) { const int m = 4 * (lane >> 4) + rg; part[(wave * 16 + m) * 32 + (lane & 15)] = acc0[rg]; part[(wave * 16 + m) * 32 + 16 + (lane & 15)] = acc1[rg]; }
        }
        N2_BAR();
        {
            const int m = tid >> 5, ex = tid & 31, hb32 = lane & 32, row = R0 + m;
            float acc = 0.f;
#pragma unroll
            for (int w8 = 0; w8 < 8; ++w8) acc += part[(w8 * 16 + m) * 32 + ex];
            const float sg = 1.0f / (1.0f + __expf(-acc)), ssel = sg + rbias;
            float best = -1e30f; int grp = 0;
#pragma unroll
            for (int g = 0; g < 8; ++g) {
                const float v0 = __shfl(ssel, hb32 + g * 4), v1 = __shfl(ssel, hb32 + g * 4 + 1), v2 = __shfl(ssel, hb32 + g * 4 + 2), v3 = __shfl(ssel, hb32 + g * 4 + 3);
                const float hi01 = fmaxf(v0, v1), lo01 = fminf(v0, v1), hi23 = fmaxf(v2, v3), lo23 = fminf(v2, v3);
                const float top = fmaxf(hi01, hi23), second = fmaxf(fminf(hi01, hi23), hi01 >= hi23 ? lo01 : lo23);
                const float gs = top + second;
                if (gs > best) { best = gs; grp = g; }
            }
            float w4[4], s4[4];
#pragma unroll
            for (int j = 0; j < 4; ++j) { w4[j] = __shfl(ssel, hb32 + grp * 4 + j); s4[j] = __shfl(sg, hb32 + grp * 4 + j); }
            int i0 = 0;
#pragma unroll
            for (int j = 1; j < 4; ++j) if (w4[j] > w4[i0]) i0 = j;
            int i1 = i0 == 0 ? 1 : 0;
#pragma unroll
            for (int j = 0; j < 4; ++j) if (j != i0 && j != i1 && w4[j] > w4[i1]) i1 = j;
            float g0 = 0.f, g1 = 0.f;
#pragma unroll
            for (int j = 0; j < 4; ++j) { g0 = (j == i0) ? s4[j] : g0; g1 = (j == i1) ? s4[j] : g1; }
            const float inv = 1.0f / (g0 + g1);
            if (ex < 2) {
                const int e = grp * 4 + (ex == 0 ? i0 : i1);
                const unsigned rank = __hip_atomic_fetch_add(lcnt + e, 1u, __ATOMIC_RELAXED, __HIP_MEMORY_SCOPE_WORKGROUP);
                tok_e[row * 2 + ex] = e; tok_r[row * 2 + ex] = (int)rank; tok_w[row * 2 + ex] = (ex == 0 ? g0 : g1) * inv;
            }
        }
    }
    N2_BAR();
    if (tid < NE) ((int*)(a.ws + WS_BLKB))[bid * NE + tid] = (int)atomicAdd(cnt + tid * 32, lcnt[tid]);
#undef N2_BAR
#undef N2_LOAD
}
__device__ __forceinline__ void phase_gather(const Args& a, int l, MLAS unsigned char* lds, int bid, int nb) {
    const int tid = otid(), lane = tid & 63, wave = tid >> 6;
    MLAS int* pbase = (MLAS int*)lds;
    MLAS int* cn = pbase + 64;
    const unsigned* cnt = (const unsigned*)(a.ws + WS_CNT) + l * 2048; const int* blkb = (const int*)(a.ws + WS_BLKB);
    if (tid == 0) { int acc = 0; for (int e = 0; e < NE; ++e) { const int c = (int)__hip_atomic_load(cnt + e * 32, __ATOMIC_RELAXED, __HIP_MEMORY_SCOPE_AGENT); cn[e] = c; pbase[e] = acc; acc += (c + 255) & ~255; } pbase[NE] = acc; }
    __syncthreads();
    int* rinfo = (int*)(a.ws + WS_RINFO); float* rw = (float*)(a.ws + WS_RW); int* blke = (int*)(a.ws + WS_BLKE);
    if (bid == 0) {
        for (int e = 0; e < NE; ++e) {
            for (int p = pbase[e] + cn[e] + tid; p < pbase[e + 1]; p += NT) { rinfo[p] = -1; rw[p] = 0.f; }
            for (int blk = (pbase[e] >> 8) + tid; blk < (pbase[e + 1] >> 8); blk += NT) blke[blk] = e;
        }
        if (tid == 0) blke[1023] = (pbase[NE] >> 8) * 4;
    }
    const int* tok_e = (const int*)(a.ws + WS_TOKE); const int* tok_r = (const int*)(a.ws + WS_TOKR); const float* tok_w = (const float*)(a.ws + WS_TOKW);
    const int nas = (l == 0 ? TT : TL) * 2, per_ = ((l == 0 ? TT : TL) / 16 + nb - 1) / nb;
    for (int as = bid * NT + tid; as < nas; as += nb * NT) {
        const int t = as >> 1, e = tok_e[as], pos = pbase[e] + blkb[((t >> 4) / per_) * NE + e] + tok_r[as];
        rinfo[pos] = as; ((int*)(a.ws + WS_TOKR))[as] = pos;
    }
}

using pg8::Unit;
struct EpiStoreBf16 {
    static constexpr bool PERM = true, AFTER_DRAIN = false;
    bf16_t* O; int ldc; bf16_t* kc_lat; bf16_t* vt_lat; bf16_t* kc_ctx; bf16_t* vt_ctx; const float* knw; MLAS unsigned char* sp;
    __device__ __forceinline__ void operator()(const f32x4 (&acc)[2][2][4][2], const Unit& u, int wr, int wc, int fr, int fq) const {
        const int row0 = u.pm * 256 + wr * 64 + fr;
        if (u.pn < 2 || u.pn > 5) {
            char* base = (char*)O + ((size_t)(u.pm * 256 + wr * 64) * ldc + u.pn * 256 + wc * 32) * 2;
            const unsigned lo = (unsigned)(fr * ldc + 8 * fq) * 2u;
#pragma unroll
            for (int ai = 0; ai < 2; ++ai)
#pragma unroll
                for (int m = 0; m < 4; ++m)
#pragma unroll
                    for (int bj = 0; bj < 2; ++bj) { const f32x4 v0 = acc[ai][bj][m][0], v1 = acc[ai][bj][m][1];
                        *(u32x4*)(base + (size_t)((ai * 128 + m * 16) * ldc + bj * 128) * 2 + lo) = (u32x4){pg8::cvt_pk_bf16(v0[0], v0[1]), pg8::cvt_pk_bf16(v0[2], v0[3]), pg8::cvt_pk_bf16(v1[0], v1[1]), pg8::cvt_pk_bf16(v1[2], v1[3])}; }
            return;
        }
        const bool lat = u.pm < 256;
        if (u.pn < 4) {
            MLAS float* part = (MLAS float*)sp;
            float ss[2][4][2];
#pragma unroll
            for (int ai = 0; ai < 2; ++ai)
#pragma unroll
                for (int m = 0; m < 4; ++m)
#pragma unroll
                    for (int bj = 0; bj < 2; ++bj) { const f32x4 v0 = acc[ai][bj][m][0], v1 = acc[ai][bj][m][1];
                        float q = (v0[0] * v0[0] + v0[1] * v0[1]) + (v0[2] * v0[2] + v0[3] * v0[3]) + (v1[0] * v1[0] + v1[1] * v1[1]) + (v1[2] * v1[2] + v1[3] * v1[3]);
                        q += __shfl_xor(q, 16); q += __shfl_xor(q, 32); ss[ai][m][bj] = q;
                        if (fq == 0) part[((((ai * 4 + m) * 2 + bj) * 2 + wr) * 16 + fr) * 4 + wc] = q; }
            asm volatile("s_waitcnt lgkmcnt(0)" ::: "memory"); __builtin_amdgcn_s_barrier(); asm volatile("" ::: "memory");
            const f32x4 w0 = *(const f32x4*)(knw + (wc & 1) * 32 + 8 * fq), w1 = *(const f32x4*)(knw + (wc & 1) * 32 + 8 * fq + 4);
#pragma unroll
            for (int ai = 0; ai < 2; ++ai)
#pragma unroll
                for (int m = 0; m < 4; ++m) { const int row = row0 + ai * 128 + m * 16;
                    const int b = lat ? row >> 12 : (row - TL) >> 8, t = lat ? row & (SEQ - 1) : (row - TL) & (LC - 1), tlen = lat ? SEQ : LC;
                    bf16_t* kb = (lat ? kc_lat : kc_ctx);
#pragma unroll
                    for (int bj = 0; bj < 2; ++bj) {
                        const float other = part[((((ai * 4 + m) * 2 + bj) * 2 + wr) * 16 + fr) * 4 + (wc ^ 1)];
                        const float rs = rsqrtf((ss[ai][m][bj] + other) * (1.0f / 64.0f) + 1e-6f);
                        const f32x4 v0 = acc[ai][bj][m][0] * rs * w0, v1 = acc[ai][bj][m][1] * rs * w1;
                        const int head = (u.pn - 2) * 4 + 2 * bj + (wc >> 1);
                        *(u32x4*)(kb + (((size_t)b * 8 + head) * tlen + t) * 64 + (wc & 1) * 32 + 8 * fq) = (u32x4){pg8::cvt_pk_bf16(v0[0], v0[1]), pg8::cvt_pk_bf16(v0[2], v0[3]), pg8::cvt_pk_bf16(v1[0], v1[1]), pg8::cvt_pk_bf16(v1[2], v1[3])}; } }
            return;
        }
        {
            MLAS bf16_t* gb = (MLAS bf16_t*)(sp + wr * 8192);
            bf16_t* vb = lat ? vt_lat : vt_ctx; const int ngrp = lat ? SEQ / 16 : LC / 16;
#pragma unroll
            for (int ai = 0; ai < 2; ++ai)
#pragma unroll
                for (int m = 0; m < 4; ++m) {
#pragma unroll
                    for (int bj = 0; bj < 2; ++bj)
#pragma unroll
                        for (int n = 0; n < 2; ++n) { const f32x4 v = acc[ai][bj][m][n]; const int c = bj * 128 + wc * 32 + 8 * fq + 4 * n;
                            const unsigned p01 = pg8::cvt_pk_bf16(v[0], v[1]), p23 = pg8::cvt_pk_bf16(v[2], v[3]);
                            gb[(c + 0) * 16 + fr] = (bf16_t)(p01 & 0xffffu); gb[(c + 1) * 16 + fr] = (bf16_t)(p01 >> 16);
                            gb[(c + 2) * 16 + fr] = (bf16_t)(p23 & 0xffffu); gb[(c + 3) * 16 + fr] = (bf16_t)(p23 >> 16); }
                    asm volatile("s_waitcnt lgkmcnt(0)" ::: "memory"); __builtin_amdgcn_s_barrier(); asm volatile("" ::: "memory");
                    const int rowb = u.pm * 256 + ai * 128 + wr * 64 + m * 16;
                    const int b = lat ? rowb >> 12 : (rowb - TL) >> 8, g16 = (lat ? rowb & (SEQ - 1) : (rowb - TL) & (LC - 1)) >> 4;
#pragma unroll
                    for (int k = 0; k < 2; ++k) { const int qd = wc * 64 + fr + 16 * fq + 256 * k, c = qd >> 1, half = qd & 1;
                        const u32x4 w = *(const MLAS u32x4*)(gb + c * 16 + 8 * half);
                        const int head = (u.pn - 4) * 4 + (c >> 6), d = c & 63;
                        *(u32x4*)(vb + ((((size_t)b * 8 + head) * ngrp + g16) * 64 + d) * 16 + 8 * half) = w; }
                    asm volatile("s_waitcnt lgkmcnt(0)" ::: "memory"); __builtin_amdgcn_s_barrier(); asm volatile("" ::: "memory");
                }
        }
    }
};
struct EpiResGate {
    static constexpr bool PERM = true, AFTER_DRAIN = false;
    const void* xin_lat; const float* xin_ctx; bf16_t* out_lat; float* out_ctx; const float* modl; int in_bf16;
    __device__ __forceinline__ void operator()(const f32x4 (&acc)[2][2][4][2], const Unit& u, int wr, int wc, int fr, int fq) const {
        const bool lat = u.pm < 256; const int r = lat ? (u.pm >> 4) : 16;
        const int rowt = (lat ? u.pm : u.pm - 256) * 256 + wr * 64 + fr, col0 = u.pn * 256 + wc * 32 + 8 * fq;
        const float* g = modl + (size_t)r * 6144 + 2 * 1024 + col0;
        f32x4 gv[2][2];
#pragma unroll
        for (int bj = 0; bj < 2; ++bj)
#pragma unroll
            for (int n = 0; n < 2; ++n) gv[bj][n] = *(const f32x4*)(g + bj * 128 + 4 * n);
#pragma unroll
        for (int ai = 0; ai < 2; ++ai)
#pragma unroll
            for (int m = 0; m < 4; ++m) { const size_t off = (size_t)(rowt + ai * 128 + m * 16) * D + col0;
#pragma unroll
                for (int bj = 0; bj < 2; ++bj) {
                    f32x4 x0, x1;
                    if (!lat) { x0 = *(const f32x4*)(xin_ctx + off + bj * 128); x1 = *(const f32x4*)(xin_ctx + off + bj * 128 + 4); }
                    else if (in_bf16) { const u32x4 w = *(const u32x4*)((const bf16_t*)xin_lat + off + bj * 128); x0 = (f32x4){lo16(w.x), hi16(w.x), lo16(w.y), hi16(w.y)}; x1 = (f32x4){lo16(w.z), hi16(w.z), lo16(w.w), hi16(w.w)}; }
                    else { x0 = *(const f32x4*)((const float*)xin_lat + off + bj * 128); x1 = *(const f32x4*)((const float*)xin_lat + off + bj * 128 + 4); }
                    x0 += gv[bj][0] * acc[ai][bj][m][0]; x1 += gv[bj][1] * acc[ai][bj][m][1];
                    if (lat) *(u32x4*)(out_lat + off + bj * 128) = (u32x4){pack2(x0[0], x0[1]), pack2(x0[2], x0[3]), pack2(x1[0], x1[1]), pack2(x1[2], x1[3])};
                    else { *(f32x4*)(out_ctx + off + bj * 128) = x0; *(f32x4*)(out_ctx + off + bj * 128 + 4) = x1; } } }
    }
};
struct EpiSwiglu {
    static constexpr bool PERM = true, AFTER_DRAIN = false;
    bf16_t* act;
    __device__ __forceinline__ void operator()(const f32x4 (&acc)[2][2][4][2], const Unit& u, int wr, int wc, int fr, int fq) const {
        unsigned char* base = (unsigned char*)act + (size_t)(u.pm * 256 + wr * 64) * DFF + (u.pn & 3) * 128 + wc * 32;
        const unsigned lo = (unsigned)(fr * DFF + 8 * fq);
#pragma unroll
        for (int ai = 0; ai < 2; ++ai)
#pragma unroll
            for (int m = 0; m < 4; ++m) { float r[8];
#pragma unroll
                for (int n = 0; n < 2; ++n)
#pragma unroll
                    for (int j = 0; j < 4; ++j) { const float gt = acc[ai][0][m][n][j]; r[n * 4 + j] = siluf(gt) * acc[ai][1][m][n][j]; }
                *(u32x2*)(base + (size_t)(ai * 128 + m * 16) * DFF + lo) = (u32x2){pack4_fp8(r[0], r[1], r[2], r[3]), pack4_fp8(r[4], r[5], r[6], r[7])}; }
    }
};
struct EpiDown {
    static constexpr bool PERM = true, AFTER_DRAIN = false;
    bf16_t* ys;
    __device__ __forceinline__ void operator()(const f32x4 (&acc)[2][2][4][2], const Unit& u, int wr, int wc, int fr, int fq) const {
        char* base = (char*)ys + ((size_t)(u.pm * 256 + wr * 64) * D + (u.pn & 3) * 256 + wc * 32) * 2;
        const unsigned lo = (unsigned)(fr * D + 8 * fq) * 2u;
#pragma unroll
        for (int ai = 0; ai < 2; ++ai)
#pragma unroll
            for (int m = 0; m < 4; ++m)
#pragma unroll
                for (int bj = 0; bj < 2; ++bj) { const f32x4 v0 = acc[ai][bj][m][0], v1 = acc[ai][bj][m][1];
                    *(u32x4*)(base + (size_t)((ai * 128 + m * 16) * D + bj * 128) * 2 + lo) = (u32x4){pg8::cvt_pk_bf16(v0[0], v0[1]), pg8::cvt_pk_bf16(v0[2], v0[3]), pg8::cvt_pk_bf16(v1[0], v1[1]), pg8::cvt_pk_bf16(v1[2], v1[3])}; }
    }
};
struct SubsetOrder {
    pg8::StaticOrder base; unsigned map;
    __device__ __forceinline__ bool next(int i, Unit& u) const { if (!base.next(i, u)) return false; u.pn = (int)((map >> (4 * u.pn)) & 15u); return true; }
    __device__ __forceinline__ void a_ready(const Unit&) const {}
    __device__ __forceinline__ void done(const Unit&) const {}
};
struct MoeOrder {
    const MLAS int* blke; int nunits, G, c;
    __device__ __forceinline__ bool next(int i, Unit& u) const { const int x = c & 7, j = c >> 3; int L;
        if (G == 256) { const int rb = i * 64 + (j >> 2) * 8 + x; L = rb * 4 + (j & 3); } else L = i * G + c;
        if (L >= nunits) return false; u.pm = L >> 2; u.pn = blke[L >> 2] * 4 + (L & 3); return true; }
    __device__ __forceinline__ void a_ready(const Unit&) const {}
    __device__ __forceinline__ void done(const Unit&) const {}
};

typedef const Args __attribute__((address_space(4))) CArgs;
#define MK_LOAD_ARGS(a, p) do { (a).x = (p)->x; (a).c = (p)->c; (a).ctx = (p)->ctx; (a).c_ctx = (p)->c_ctx; (a).ada_w = (p)->ada_w; (a).ada_b = (p)->ada_b; (a).norm_mix_w = (p)->norm_mix_w; (a).norm_ffn_w = (p)->norm_ffn_w; (a).w_in = (p)->w_in; (a).na_q_norm = (p)->na_q_norm; (a).na_k_norm = (p)->na_k_norm; (a).na_rpb = (p)->na_rpb; (a).ret_decay = (p)->ret_decay; (a).w_out = (p)->w_out; (a).router_w = (p)->router_w; (a).router_bias = (p)->router_bias; (a).w_gate = (p)->w_gate; (a).w_up = (p)->w_up; (a).w_down = (p)->w_down; (a).out = (p)->out; (a).ws = (p)->ws; (a).ph_lo = (p)->ph_lo; (a).ph_hi = (p)->ph_hi; } while (0)
#ifndef MK_SINGLE
#define MK_SINGLE 1
#endif
constexpr int NPHASES = 24;
#ifndef MK_PROBE_MASK
#define MK_PROBE_MASK 0
#endif
#ifndef MK_BAR2
#define MK_BAR2 0
#endif
#ifndef MK_PROBE_MULT
#define MK_PROBE_MULT 4
#endif
enum { K_PRO = 0, K_NORM1, K_GEMM_IN, K_PREP, K_NA, K_RET_A, K_SCAN, K_RET_B, K_GEMM_OUT, K_NORM2, K_GATHER, K_MOE1, K_MOE2, K_FINAL };
__global__ void __launch_bounds__(NT, 2) fwd(Args ka) {
    extern __shared__ __attribute__((aligned(16))) unsigned char lds_raw[];
    MLAS unsigned char* lds = (MLAS unsigned char*)lds_raw;
    const int tid = threadIdx.x, nb = gridDim.x;
    volatile MLAS unsigned* ctl = (volatile MLAS unsigned*)(lds + LDS_CTL);
    if (tid < 4) ctl[tid] = 0u;
    __syncthreads();
    const bool multi = MK_SINGLE != 0;
    XcdBarrier bar; bar.bar = (unsigned*)(ka.ws + WS_BAR); bar.x = 0; bar.st = ctl;
    if (multi) bar = xcd_barrier_post((unsigned*)(ka.ws + WS_BAR), ctl);
    int ph = 0;
#if MK_SINGLE
#define MK_GUARD 1
#define MK_SEAM(kind) ((kind) != K_FINAL)
#else
#define MK_GUARD (ph >= ka.ph_lo && ph < ka.ph_hi)
#define MK_SEAM(kind) (ph + 1 < ka.ph_hi)
#endif
#define PHASE(kind, ...) do { if (MK_GUARD) { CArgs* ap_ = (CArgs*)__builtin_amdgcn_kernarg_segment_ptr(); asm volatile("" : "+s"(ap_)); Args a; MK_LOAD_ARGS(a, ap_); int bid = blockIdx.x; asm volatile("" : "+s"(bid)); unsigned long long t0_ = 0; if ((MK_PROBE_MASK >> (kind)) & 1) t0_ = wall_clock64(); { __VA_ARGS__; } if ((MK_PROBE_MASK >> (kind)) & 1) { const unsigned long long d_ = wall_clock64() - t0_; while (wall_clock64() - t0_ < d_ * (MK_PROBE_MULT + 1)) __builtin_amdgcn_s_sleep(8); } if (MK_SEAM(kind)) { XcdBarrier b_ = bar; asm volatile("" : "+s"(b_.bar), "+s"(b_.x)); xcd_barrier(b_); if (MK_BAR2) { xcd_barrier(b_); xcd_barrier(b_); } } } ++ph; } while (0)
    PHASE(K_PRO, { convert_small(a, bid, nb); convert_weights(a, true, 0, lds, bid, nb); compute_mod(a, lds, bid, nb); });
#ifndef STG_IN
#define STG_IN 0
#endif
#define MK_STAGGER(ticks) do { if ((ticks) > 0) { const unsigned long long t0s_ = wall_clock64(), ds_ = (unsigned long long)(bid & 7) * (ticks); while (wall_clock64() - t0s_ < ds_) __builtin_amdgcn_s_sleep(2); } } while (0)
#define MK_LAYER(l) do { \
        PHASE(K_NORM1, { phase_norm1(a, l, bid, nb); if (l == 1) convert_weights(a, false, 1, lds, bid, nb); }); \
        PHASE(K_GEMM_IN, { MK_STAGGER(STG_IN); EpiStoreBf16 E{(bf16_t*)(a.ws + WS_PROJ), INC, (bf16_t*)(a.ws + WS_KC), (bf16_t*)(a.ws + WS_VT), (bf16_t*)(a.ws + WS_KCC), (bf16_t*)(a.ws + WS_VTC), a.na_k_norm + l * 64, lds + 131072}; \
                if (IN_FP8_MASK == 0xFFFFu) { pg8::Gemm g{(const bf16_t*)h8_of(a), (const bf16_t*)(a.ws + WS_WIN8 + (size_t)l * INC * D), TT, INC, D, nullptr, SC_IN8}; \
                  pg8::StaticOrder S; S.init(TT, INC, nb, bid); \
                  pg8::gemm_phase<EpiStoreBf16, pg8::StaticOrder, false, false, 1>(lds, g, S, E, nullptr); } \
                else { \
                { pg8::Gemm g{(const bf16_t*)(a.ws + WS_H), (const bf16_t*)(a.ws + WS_WIN) + (size_t)l * INC * D, TT, INC, D}; \
                  SubsetOrder S; S.base.init(TT, INC / 2, nb, bid); S.map = IN_TILES_BF16; \
                  pg8::gemm_phase<EpiStoreBf16, SubsetOrder>(lds, g, S, E, nullptr); } \
                { pg8::Gemm g{(const bf16_t*)h8_of(a), (const bf16_t*)(a.ws + WS_WIN8 + (size_t)l * INC * D), TT, INC, D, nullptr, SC_IN8}; \
                  SubsetOrder S; S.base.init(TT, INC / 2, nb, nb - 1 - bid); S.map = IN_TILES_FP8;     \
                  pg8::gemm_phase<EpiStoreBf16, SubsetOrder, false, false, 1>(lds, g, S, E, nullptr); } } }); \
        PHASE(K_NA, phase_na(a, l, lds, bid, nb)); \
        PHASE(K_RET_A, phase_ret_a(a, l, lds, bid, nb)); \
        PHASE(K_SCAN, phase_scan(a, l, bid, nb)); \
        PHASE(K_RET_B, phase_ret_b(a, l, lds, bid, nb)); \
        PHASE(K_GEMM_OUT, { const int M = l == 0 ? TT : TL; \
                pg8::Gemm g{(const bf16_t*)(a.ws + WS_H), OUT_FP8 ? (const bf16_t*)(a.ws + WS_WOUT8 + (size_t)l * D * D) : (const bf16_t*)(a.ws + WS_WOUT) + (size_t)l * D * D, M, D, D, nullptr, SC_OUT8}; \
                pg8::StaticOrder S; S.init(M, D, nb, bid); \
                EpiResGate E{l == 0 ? (const void*)a.x : (const void*)a.out, a.ctx, (bf16_t*)(a.ws + WS_XB), (float*)(a.ws + WS_CTX), (const float*)(a.ws + WS_MOD) + (size_t)l * 17 * 6144, l}; \
                pg8::gemm_phase<EpiResGate, pg8::StaticOrder, false, false, OUT_FP8 ? 1 : 2>(lds, g, S, E, nullptr); }); \
        PHASE(K_NORM2, phase_norm2(a, l, lds, bid, nb)); \
        PHASE(K_GATHER, phase_gather(a, l, lds, bid, nb)); \
        PHASE(K_MOE1, { MLAS int* blke = (MLAS int*)(lds + 131072); { const int* gb_ = (const int*)(a.ws + WS_BLKE); for (int i_ = otid(); i_ < 1024; i_ += NT) blke[i_] = gb_[i_]; __syncthreads(); } \
                pg8::Gemm g{(const bf16_t*)(a.ws + WS_H), (const bf16_t*)(a.ws + WS_WGU), PMAX, NE * 1024, D, (const int*)(a.ws + WS_RINFO), SC_MOE1}; \
                MoeOrder S{blke, blke[1023], nb, bid}; \
                EpiSwiglu E{(bf16_t*)(a.ws + WS_ACT)}; \
                pg8::gemm_phase<EpiSwiglu, MoeOrder, false, true, 1>(lds, g, S, E, nullptr); }); \
        PHASE(K_MOE2, { MLAS int* blke = (MLAS int*)(lds + 131072); { const int* gb_ = (const int*)(a.ws + WS_BLKE); for (int i_ = otid(); i_ < 1024; i_ += NT) blke[i_] = gb_[i_]; __syncthreads(); } \
                pg8::Gemm g{(const bf16_t*)(a.ws + WS_ACT), (const bf16_t*)(a.ws + WS_WDN), PMAX, NE * 1024, DFF, nullptr, SC_MOE2}; \
                MoeOrder S{blke, blke[1023], nb, bid}; \
                EpiDown E{(bf16_t*)(a.ws + WS_XS)}; \
                pg8::gemm_phase<EpiDown, MoeOrder, false, false, 1>(lds, g, S, E, nullptr); }); \
    } while (0)
    MK_LAYER(0);
    MK_LAYER(1);
#undef MK_LAYER
    PHASE(K_FINAL, phase_final(a, bid, nb));
#undef PHASE
}
}

extern "C" void kernel_launch(void* const* d_in, const int* in_sizes, int n_in, void* d_out, int out_size, void* d_ws, size_t ws_size, hipStream_t stream) {
    using namespace mk;
    static int grid = 0;
    if (grid == 0) {
        if (n_in != 19 || in_sizes[0] != TL * D || out_size != TL * D || ws_size < WS_END) {
            fprintf(stderr, "kernel_launch: unexpected shapes / workspace (n_in %d, in0 %d, out %d, ws %zu, need %zu); nothing launched\n", n_in, n_in > 0 ? in_sizes[0] : -1, out_size, ws_size, (size_t)WS_END);
            grid = -1; return; }
        int dev = 0, cus = 0, per_cu = 0;
        if (hipGetDevice(&dev) != hipSuccess || hipDeviceGetAttribute(&cus, hipDeviceAttributeMultiprocessorCount, dev) != hipSuccess) { grid = -1; return; }
        if (hipFuncSetAttribute((const void*)fwd, hipFuncAttributeMaxDynamicSharedMemorySize, LDS_BYTES) != hipSuccess) { fprintf(stderr, "kernel_launch: hipFuncSetAttribute failed\n"); grid = -1; return; }
        if (hipOccupancyMaxActiveBlocksPerMultiprocessor(&per_cu, (const void*)fwd, NT, LDS_BYTES) != hipSuccess || per_cu < 1) { fprintf(stderr, "kernel_launch: occupancy query says %d\n", per_cu); (void)hipGetLastError(); grid = -1; return; }
        grid = cus;
    }
    if (grid < 0) return;
    (void)hipMemsetAsync((char*)d_ws + WS_BAR, 0, WS_ZERO_BYTES, stream);
    Args a{};
    a.x = (const float*)d_in[0]; a.c = (const float*)d_in[1]; a.ctx = (const float*)d_in[2]; a.c_ctx = (const float*)d_in[3]; a.ada_w = (const float*)d_in[4]; a.ada_b = (const float*)d_in[5];
    a.norm_mix_w = (const float*)d_in[6]; a.norm_ffn_w = (const float*)d_in[7]; a.w_in = (const float*)d_in[8]; a.na_q_norm = (const float*)d_in[9]; a.na_k_norm = (const float*)d_in[10];
    a.na_rpb = (const float*)d_in[11]; a.ret_decay = (const float*)d_in[12]; a.w_out = (const float*)d_in[13]; a.router_w = (const float*)d_in[14]; a.router_bias = (const float*)d_in[15];
    a.w_gate = (const float*)d_in[16]; a.w_up = (const float*)d_in[17]; a.w_down = (const float*)d_in[18];
    a.out = (float*)d_out; a.ws = (unsigned char*)d_ws;
#if MK_SINGLE
    a.ph_lo = 0; a.ph_hi = NPHASES;
    hipLaunchKernelGGL(fwd, dim3(grid), dim3(NT), LDS_BYTES, stream, a);
#else
    for (int ph = 0; ph < NPHASES; ++ph) { a.ph_lo = ph; a.ph_hi = ph + 1; hipLaunchKernelGGL(fwd, dim3(grid), dim3(NT), LDS_BYTES, stream, a); }
#endif
}
```

```cpp
#include <hip/hip_runtime.h>
#include <cstdio>
#include <cstdint>


#define XB_TMO      128
#define XB_XCNT(j)  (256  + 64 * (j))
#define XB_XSUB(j)  (1280 + 64 * (j))
#define XB_XGEN(j)  (2304 + 64 * (j))
#define XB_TOP      3328
#define XB_TOPGEN   3392
#define XCD_BAR_WORDS 3456
#define XB_SPIN_CAP (1u << 18)
#define LAS __attribute__((address_space(3)))

__device__ __forceinline__ unsigned xb_ld(unsigned* p)              { return __hip_atomic_load(p, __ATOMIC_RELAXED, __HIP_MEMORY_SCOPE_AGENT); }
__device__ __forceinline__ unsigned xb_add(unsigned* p, unsigned v) { return __hip_atomic_fetch_add(p, v, __ATOMIC_RELAXED, __HIP_MEMORY_SCOPE_AGENT); }
__device__ __forceinline__ unsigned xb_xcc_id() { return (unsigned)__builtin_amdgcn_s_getreg((3 << 11) | 20) & 0xFu; }
#define XB_SPIN(cond, bar) do { unsigned _sp = 0; while (cond) { __builtin_amdgcn_s_sleep(1); \
    if ((++_sp & 255u) == 0u) { if (xb_ld(&(bar)[XB_TMO])) break; if (_sp > XB_SPIN_CAP) { atomicAdd(&(bar)[XB_TMO], 1u); break; } } } } while (0)

struct XcdBarrier {
    unsigned* bar; unsigned x;
    volatile LAS unsigned* st;
};

__device__ __forceinline__ XcdBarrier xcd_barrier_post(unsigned* bar, volatile LAS unsigned* st) {
    XcdBarrier b; b.bar = bar; b.x = xb_xcc_id(); b.st = st;
    if (threadIdx.x == 0) (void)xb_add(&bar[XB_XCNT(b.x)], 1u);
    return b;
}
__device__ __forceinline__ void xcd_barrier_complete(unsigned* bar, unsigned x, unsigned& nloc, unsigned& nx) {
    const unsigned G = gridDim.x * gridDim.y * gridDim.z;
    unsigned sum, cnt, mine, sp = 0u;
    for (;;) {
        sum = 0u; cnt = 0u; mine = 0u;
#pragma unroll
        for (unsigned j = 0; j < 16; ++j) { const unsigned c = xb_ld(&bar[XB_XCNT(j)]); sum += c; cnt += (c > 0u) ? 1u : 0u; mine = (j == x) ? c : mine; }
        if (sum == G) break;
        __builtin_amdgcn_s_sleep(1);
        if ((++sp & 255u) == 0u) { if (xb_ld(&bar[XB_TMO])) break; if (sp > XB_SPIN_CAP) { atomicAdd(&bar[XB_TMO], 1u); break; } }
    }
    nloc = mine > 0u ? mine : 1u; nx = cnt > 0u ? cnt : 1u;
}

__device__ __forceinline__ void xcd_barrier(const XcdBarrier& b) {
    asm volatile("s_waitcnt vmcnt(0)" ::: "memory");
    __syncthreads();
    if (threadIdx.x == 0) {
        unsigned* bar = b.bar;
        __builtin_amdgcn_s_waitcnt(0);
        unsigned nloc = b.st[0], nx = b.st[1];
        if (nloc == 0u) { xcd_barrier_complete(bar, b.x, nloc, nx); b.st[0] = nloc; b.st[1] = nx; }
        const unsigned old = xb_add(&bar[XB_XSUB(b.x)], 1u);
        const unsigned gen = old / nloc;
        if (old + 1u == (gen + 1u) * nloc) {
            __builtin_amdgcn_fence(__ATOMIC_RELEASE, "agent");
            asm volatile("s_waitcnt vmcnt(0)" ::: "memory");
            const unsigned og = xb_add(&bar[XB_TOP], 1u);
            const unsigned tg = og / nx;
            if (og + 1u == (tg + 1u) * nx) xb_add(&bar[XB_TOPGEN], 1u);
            else XB_SPIN(xb_ld(&bar[XB_TOPGEN]) == tg, bar);
            __builtin_amdgcn_fence(__ATOMIC_ACQUIRE, "agent");
            xb_add(&bar[XB_XGEN(b.x)], 1u);
            asm volatile("s_waitcnt vmcnt(0)" ::: "memory");
        } else {
            XB_SPIN(xb_ld(&bar[XB_XGEN(b.x)]) == gen, bar);
            __builtin_amdgcn_fence(__ATOMIC_ACQUIRE, "agent");
            asm volatile("s_waitcnt vmcnt(0)" ::: "memory");
        }
    }
    __syncthreads();
}
namespace pg8 {
#define PG8_LAS __attribute__((address_space(3)))
typedef unsigned short bf16_t;
typedef short bf16x8 __attribute__((ext_vector_type(8)));
typedef float f32x4 __attribute__((ext_vector_type(4)));
typedef unsigned u32x4 __attribute__((ext_vector_type(4)));
constexpr int BM = 256, BK = 64, HALF = 128, HTB = HALF * BK * 2  , STAGE_BYTES = 8 * HTB, NXCD = 8, WGM = 8;

__host__ __device__ __forceinline__ int lds_byte(int r, int c) { const int st = (r >> 4) * 2 + (c >> 5), rr = r & 15, cc = c & 31, ob = rr * 64 + cc * 2; return st * 1024 + (ob ^ (((ob >> 9) & 1) << 5)); }
__host__ __device__ __forceinline__ void stage_rc(int b, int& R, int& C) { const int st = b / 1024, sb = b % 1024, swz = sb ^ (((sb >> 9) & 1) << 5); R = (st >> 1) * 16 + swz / 64; C = (st & 1) * 32 + (swz % 64) / 2; }
typedef int i32x4 __attribute__((ext_vector_type(4)));
typedef int i32x8 __attribute__((ext_vector_type(8)));
__host__ __device__ __forceinline__ int perm32(int rho) { const int n = rho >> 4, i = rho & 15; return 8 * (i >> 2) + 4 * n + (i & 3); }

struct Unit { int pm, pn; };
struct Gemm { const bf16_t* A; const bf16_t* Bt; int M, N, K; const int* rows = nullptr; int sc = 0x7f7f7f7f; };

struct StaticOrder {
    int nM, nN, nwg, G, c;
    __host__ __device__ void init(int M, int N, int G_, int c_) { nM = M / BM; nN = N / BM; nwg = nM * nN; G = G_; c = c_; }
    __host__ __device__ bool next(int i, Unit& u) const {
        const long L = (long)i * G + c; if (L >= nwg) return false;
        int wgid = (int)L; { const int q = nwg / NXCD, r = nwg % NXCD, xcd = wgid % NXCD, off = wgid / NXCD; wgid = (xcd < r ? xcd * (q + 1) : r * (q + 1) + (xcd - r) * q) + off; }
        const int nig = WGM * nN, gid = wgid / nig, fm = gid * WGM, gsz = (nM - fm) < WGM ? (nM - fm) : WGM;
        u.pm = fm + ((wgid % nig) % gsz); u.pn = (wgid % nig) / gsz; return true;
    }
    __device__ __forceinline__ void a_ready(const Unit&) const {}
    __device__ __forceinline__ void done(const Unit&) const {}
};
__device__ __forceinline__ unsigned cvt_pk_bf16(float lo, float hi) { unsigned r; asm volatile("v_cvt_pk_bf16_f32 %0, %1, %2" : "=v"(r) : "v"(lo), "v"(hi)); return r; }
typedef float f32x2 __attribute__((ext_vector_type(2)));
template <class Epi, class Sched, bool STAMP = false, bool GATHER = false, int ES = 2>
__device__ __forceinline__ void gemm_phase(PG8_LAS unsigned char* lds, const Gemm g, const Sched& S, const Epi& E, unsigned long long* stamps) {
    int tid_o_ = threadIdx.x; asm volatile("" : "+v"(tid_o_)); const int tid = tid_o_, wid = __builtin_amdgcn_readfirstlane(tid >> 6), lane = tid & 63, wr = wid >> 2, wc = wid & 3, fr = lane & 15, fq = lane >> 4;
    const int K = g.K, nt = K * ES / (BK * 2);
    int ts_lo = 0, ts_hi = 0, nts = 0; const unsigned long long rt_entry = STAMP ? (unsigned long long)wall_clock64() : 0ull;
#define PG8_STAMP() do { if (STAMP && wid == 0 && nts < 64) { const unsigned long long _c = (unsigned long long)clock64(); \
        ts_lo = (lane == nts) ? (int)(unsigned)_c : ts_lo; ts_hi = (lane == nts) ? (int)(unsigned)(_c >> 32) : ts_hi; ++nts; } } while (0)
    PG8_STAMP();
    unsigned voffA[2], voffB[2]; int rA_[2]; unsigned cA_[2];
#pragma unroll
    for (int i = 0; i < 2; ++i) { int R, C; stage_rc(tid * 16 + i * 8192, R, C); C *= 2; const int Rb = Epi::PERM ? ((R & ~31) + perm32(R & 31)) : R;
        voffA[i] = (unsigned)(R * K * ES + C); voffB[i] = (unsigned)(Rb * K * ES + C); rA_[i] = R; cA_[i] = (unsigned)C; }
    unsigned gA[2][2], v2_[2][2];
#define PG8_ROWS(u, dst) do { _Pragma("unroll") for (int h_ = 0; h_ < 2; ++h_) _Pragma("unroll") for (int i_ = 0; i_ < 2; ++i_) { const int as_ = g.rows[(u).pm * BM + h_ * HALF + rA_[i_]]; \
        dst[h_][i_] = (unsigned)(as_ < 0 ? 0 : as_ >> 1) * (unsigned)(K * ES) + cA_[i_]; } } while (0)
    const size_t kstep = (size_t)(BK * 2);
    const size_t hstep = (size_t)HALF * K * ES;
    const size_t b64_ = (size_t)64 * K * ES;
    const size_t tstep = 2 * hstep;
    const unsigned ldsw = (unsigned)wid * 1024u;
    const int aoff = lds_byte(wr * 64 + fr, fq * 8), boff = lds_byte(wc * 32 + fr, fq * 8);
#define PG8_SA(b, h) (((b) * 2 + (h)) * HTB)
#define PG8_SB(b, h) ((4 + (b) * 2 + (h)) * HTB)
#define PG8_STAGE(bufoff, gbase, voff) do { _Pragma("unroll") for (int _i = 0; _i < 2; ++_i) { unsigned vo_ = (voff)[_i]; asm volatile("" : "+v"(vo_));     \
        __builtin_amdgcn_global_load_lds((const unsigned*)((const char*)(gbase) + vo_), (PG8_LAS unsigned*)(lds + (bufoff) + ldsw + _i * 8192), 16, 0, 0); } } while (0)
#define PG8_STAGEB(bufoff, gbase) do { unsigned vo_ = voffB[0]; asm volatile("" : "+v"(vo_));     \
        __builtin_amdgcn_global_load_lds((const unsigned*)((const char*)(gbase) + vo_), (PG8_LAS unsigned*)(lds + (bufoff) + ldsw), 16, 0, 0); \
        __builtin_amdgcn_global_load_lds((const unsigned*)((const char*)(gbase) + b64_ + vo_), (PG8_LAS unsigned*)(lds + (bufoff) + ldsw + 8192), 16, 0, 0); } while (0)
#define PG8_LDA(dst, b, h) do { _Pragma("unroll") for (int m = 0; m < 4; ++m) _Pragma("unroll") for (int k = 0; k < 2; ++k) dst[m][k] = *(const PG8_LAS bf16x8*)(lds + PG8_SA(b, h) + aoff + m * 2048 + k * 1024); } while (0)
#define PG8_LDB(dst, b, h) do { _Pragma("unroll") for (int n = 0; n < 2; ++n) _Pragma("unroll") for (int k = 0; k < 2; ++k) dst[n][k] = *(const PG8_LAS bf16x8*)(lds + PG8_SB(b, h) + boff + n * 2048 + k * 1024); } while (0)
#define PG8_CAT(f) __builtin_shufflevector(__builtin_bit_cast(i32x4, f[0]), __builtin_bit_cast(i32x4, f[1]), 0, 1, 2, 3, 4, 5, 6, 7)
#define PG8_MMA(ai, bj, At, Bt) do { __builtin_amdgcn_s_setprio(1); _Pragma("unroll") for (int m = 0; m < 4; ++m) _Pragma("unroll") for (int n = 0; n < 2; ++n) { \
        if constexpr (ES == 2) { _Pragma("unroll") for (int k = 0; k < 2; ++k) acc[ai][bj][m][n] = __builtin_amdgcn_mfma_f32_16x16x32_bf16(Bt[n][k], At[m][k], acc[ai][bj][m][n], 0, 0, 0); } \
        else { const i32x8 b8_ = PG8_CAT(Bt[n]), a8_ = PG8_CAT(At[m]); asm volatile("v_mfma_scale_f32_16x16x128_f8f6f4 %0, %1, %2, %0, %3, %3 op_sel_hi:[0,0,0]" : "+v"(acc[ai][bj][m][n]) : "v"(b8_), "v"(a8_), "v"(sc_)); } } __builtin_amdgcn_s_setprio(0); } while (0)
#define PG8_WAIT_V(n) asm volatile("s_waitcnt vmcnt(" #n ")" ::: "memory")
#define PG8_WAIT_L(n) asm volatile("s_waitcnt lgkmcnt(" #n ")" ::: "memory")
#define PG8_BAR __builtin_amdgcn_s_barrier()
#define PG8_SCHED __builtin_amdgcn_sched_barrier(0)
    const int sc_ = g.sc;
    Unit cur, nxt; int ui = 0;
    if (!S.next(0, cur)) return;
    f32x4 acc[2][2][4][2];
#pragma unroll
    for (int a = 0; a < 2; ++a)
#pragma unroll
        for (int b = 0; b < 2; ++b)
#pragma unroll
            for (int m = 0; m < 4; ++m)
#pragma unroll
                for (int n = 0; n < 2; ++n) acc[a][b][m][n] = (f32x4){0.f, 0.f, 0.f, 0.f};
    bf16x8 At[4][2], B0[2][2], B1[2][2];
    const char* cA = (const char*)g.A + (GATHER ? (size_t)0 : (size_t)cur.pm * tstep); const char* cB = (const char*)g.Bt + (size_t)cur.pn * tstep;
    S.a_ready(cur);
    if (GATHER) { PG8_ROWS(cur, gA); }
    const size_t hstepA = GATHER ? (size_t)0 : hstep;
#define PG8_VA(h) (GATHER ? gA[h] : voffA)
    PG8_STAGEB(PG8_SB(0, 0), cB); PG8_STAGE(PG8_SA(0, 0), cA, PG8_VA(0)); PG8_STAGEB(PG8_SB(0, 1), cB + hstep); PG8_STAGE(PG8_SA(0, 1), cA + hstepA, PG8_VA(1));
    if (wr == 1) PG8_BAR;
    PG8_WAIT_V(4); PG8_BAR;
    PG8_STAGEB(PG8_SB(1, 0), cB + kstep); PG8_STAGE(PG8_SA(1, 0), cA + kstep, PG8_VA(0)); PG8_STAGEB(PG8_SB(1, 1), cB + hstep + kstep);
    PG8_WAIT_V(6); PG8_BAR;
    PG8_STAMP();
    for (;;) {
        const bool has_next = S.next(ui + 1, nxt);
        if (GATHER && has_next && wid == 0) { unsigned lo_ = threadIdx.x; asm volatile("" : "+v"(lo_)); lo_ = (lo_ & 63u) * 16u;
            __builtin_amdgcn_global_load_lds((const unsigned*)((const char*)(g.rows + (size_t)nxt.pm * BM) + lo_), (PG8_LAS unsigned*)(lds + STAGE_BYTES + 4096 + ((ui + 1) & 1) * 1024), 16, 0, 0); }
        const char* nA = (has_next && !GATHER) ? (const char*)g.A + (size_t)nxt.pm * tstep : cA; const char* nB = has_next ? (const char*)g.Bt + (size_t)nxt.pn * tstep : cB;
        for (int t = 0; t < nt; t += 2) {
            const bool last = (t == nt - 2);
            const char* a1 = cA + (size_t)(t + 1) * kstep;
            const char* a2 = last ? nA : cA + (size_t)(t + 2) * kstep; const char* b2 = last ? nB : cB + (size_t)(t + 2) * kstep;
            const char* a3 = a2 + kstep; const char* b3 = b2 + kstep;
            if (last && has_next) S.a_ready(nxt);
            if (GATHER) { _Pragma("unroll") for (int h_ = 0; h_ < 2; ++h_) _Pragma("unroll") for (int i_ = 0; i_ < 2; ++i_) v2_[h_][i_] = gA[h_][i_]; }
            if (GATHER && last && has_next) { const PG8_LAS int* rl_ = (const PG8_LAS int*)(lds + STAGE_BYTES + 4096 + ((ui + 1) & 1) * 1024);
                int tq_ = threadIdx.x; asm volatile("" : "+v"(tq_));
                _Pragma("unroll") for (int i_ = 0; i_ < 2; ++i_) { int R_, C_; stage_rc(tq_ * 16 + i_ * 8192, R_, C_);
                    _Pragma("unroll") for (int h_ = 0; h_ < 2; ++h_) { const int as_ = rl_[h_ * HALF + R_]; v2_[h_][i_] = (unsigned)(as_ < 0 ? 0 : as_ >> 1) * (unsigned)(K * ES) + (unsigned)(C_ * 2); } } }
#define PG8_V2(h) (GATHER ? v2_[h] : voffA)
            PG8_LDB(B0, 0, 0); PG8_SCHED; PG8_LDA(At, 0, 0); PG8_STAGE(PG8_SA(1, 1), a1 + hstepA, PG8_VA(1));
            PG8_WAIT_L(8); PG8_BAR; PG8_WAIT_L(0); PG8_MMA(0, 0, At, B0); PG8_BAR; PG8_SCHED;
            PG8_LDB(B1, 0, 1); PG8_STAGEB(PG8_SB(0, 0), b2);
            PG8_BAR; PG8_WAIT_L(0); PG8_MMA(0, 1, At, B1); PG8_BAR;
            PG8_LDA(At, 0, 1); PG8_STAGE(PG8_SA(0, 0), a2, PG8_V2(0));
            PG8_BAR; PG8_WAIT_L(0); PG8_MMA(1, 0, At, B0); PG8_BAR; PG8_SCHED;
            PG8_STAGEB(PG8_SB(0, 1), b2 + hstep);
            PG8_WAIT_V(6); PG8_BAR; PG8_MMA(1, 1, At, B1); PG8_BAR;
            PG8_LDB(B0, 1, 0); PG8_SCHED; PG8_LDA(At, 1, 0); PG8_STAGE(PG8_SA(0, 1), a2 + hstepA, PG8_V2(1));
            PG8_WAIT_L(8); PG8_BAR; PG8_WAIT_L(0); PG8_MMA(0, 0, At, B0); PG8_BAR; PG8_SCHED;
            PG8_LDB(B1, 1, 1); PG8_STAGEB(PG8_SB(1, 0), b3);
            PG8_BAR; PG8_WAIT_L(0); PG8_MMA(0, 1, At, B1); PG8_BAR;
            PG8_LDA(At, 1, 1); PG8_STAGE(PG8_SA(1, 0), a3, PG8_V2(0));
            PG8_BAR; PG8_WAIT_L(0); PG8_MMA(1, 0, At, B0); PG8_BAR; PG8_SCHED;
            PG8_STAGEB(PG8_SB(1, 1), b3 + hstep);
            PG8_WAIT_V(6); PG8_BAR; PG8_MMA(1, 1, At, B1); PG8_BAR;
        }
        PG8_STAMP();
        if constexpr (ES == 1) asm volatile("s_nop 15\n\ts_nop 15\n\ts_nop 15"
            : "+v"(acc[1][0][0][0]), "+v"(acc[1][0][0][1]), "+v"(acc[1][0][1][0]), "+v"(acc[1][0][1][1]), "+v"(acc[1][0][2][0]), "+v"(acc[1][0][2][1]), "+v"(acc[1][0][3][0]), "+v"(acc[1][0][3][1]),
              "+v"(acc[1][1][0][0]), "+v"(acc[1][1][0][1]), "+v"(acc[1][1][1][0]), "+v"(acc[1][1][1][1]), "+v"(acc[1][1][2][0]), "+v"(acc[1][1][2][1]), "+v"(acc[1][1][3][0]), "+v"(acc[1][1][3][1]) :: "memory");
        if constexpr (!Epi::AFTER_DRAIN) { int te_ = threadIdx.x; asm volatile("" : "+v"(te_));
#ifndef PG8_EPI_REP
#define PG8_EPI_REP 1
#endif
            _Pragma("unroll 1") for (int er_ = 0; er_ < PG8_EPI_REP; ++er_) { asm volatile("" : "+v"(te_));
            E(acc, cur, __builtin_amdgcn_readfirstlane(te_ >> 8), __builtin_amdgcn_readfirstlane((te_ >> 6) & 3), te_ & 15, (te_ >> 4) & 3); } S.done(cur); }
        PG8_STAMP();
        if (!has_next) break;
#pragma unroll
        for (int a = 0; a < 2; ++a)
#pragma unroll
            for (int b = 0; b < 2; ++b)
#pragma unroll
                for (int m = 0; m < 4; ++m)
#pragma unroll
                    for (int n = 0; n < 2; ++n) acc[a][b][m][n] = (f32x4){0.f, 0.f, 0.f, 0.f};
        cur = nxt; cA = nA; cB = nB; ++ui;
        if (GATHER) { _Pragma("unroll") for (int h_ = 0; h_ < 2; ++h_) _Pragma("unroll") for (int i_ = 0; i_ < 2; ++i_) gA[h_][i_] = v2_[h_][i_]; }
    }
    PG8_WAIT_V(0);
    if (wr == 0) PG8_BAR;
    PG8_BAR;
    if constexpr (Epi::AFTER_DRAIN) { E.fused(acc, cur, wr, wc, fr, fq, lds, wid, lane); S.done(cur); }
    PG8_STAMP();
    if (STAMP && wid == 0) { stamps[lane] = lane < nts ? (((unsigned long long)(unsigned)ts_hi << 32) | (unsigned)ts_lo) : 0ull;
        if (lane == 62) stamps[62] = rt_entry; if (lane == 63) stamps[63] = (unsigned long long)wall_clock64(); }
#undef PG8_STAMP
#undef PG8_SA
#undef PG8_SB
#undef PG8_STAGE
#undef PG8_STAGEB
#undef PG8_LDA
#undef PG8_LDB
#undef PG8_MMA
#undef PG8_CAT
#undef PG8_WAIT_V
#undef PG8_WAIT_L
#undef PG8_BAR
#undef PG8_SCHED
#undef PG8_ROWS
#undef PG8_VA
#undef PG8_V2
}
}

namespace mk {
#define MLAS __attribute__((address_space(3)))
typedef unsigned short bf16_t;
typedef float f32x4 __attribute__((ext_vector_type(4)));
typedef unsigned u32x4 __attribute__((ext_vector_type(4)));
typedef unsigned u32x2 __attribute__((ext_vector_type(2)));

constexpr int D = 1024, NB = 16, SEQ = 4096, LC = 256, TL = NB * SEQ, TC = NB * LC, TT = TL + TC;
constexpr int INC = 4096, NE = 32, DFF = 512, NCH = 34, PMAX = 147456, NT = 512;
constexpr int LDS_BYTES = 150 * 1024, LDS_CTL = LDS_BYTES - 256;
constexpr int C_QA = 0, C_KA = 512, C_VA = 1024, C_QB = 1536, C_KB = 2048, C_VB = 2560, C_GF = 3072, C_GB = 3584;

constexpr size_t al256(size_t x) { return (x + 255) & ~(size_t)255; }
constexpr size_t WS_BAR = 0;
constexpr size_t WS_CNT = 16384;
constexpr size_t WS_ZERO_BYTES = 16384 + 16384;
constexpr size_t WS_MOD = WS_ZERO_BYTES;
constexpr size_t WS_WIN = al256(WS_MOD + (size_t)2 * 17 * 6144 * 4);
constexpr size_t WS_WOUT = WS_WIN + (size_t)2 * 4096 * 1024 * 2;
constexpr size_t WS_WGU = WS_WOUT + (size_t)2 * 1024 * 1024 * 2;
constexpr size_t WS_WDN = WS_WGU + (size_t)32 * 1024 * 1024 * 2;
constexpr size_t WS_CTX = WS_WDN + (size_t)32 * 1024 * 512 * 2;
constexpr size_t WS_H = WS_CTX + (size_t)TC * D * 4;
constexpr size_t WS_PROJ = WS_H + (size_t)TT * D * 2;
constexpr size_t WS_XS = WS_PROJ;
constexpr size_t WS_ACT = WS_PROJ + (size_t)PMAX * D * 2;
constexpr size_t WS_XB = WS_PROJ + (size_t)TT * INC * 2;
constexpr size_t WS_ST = WS_PROJ + (size_t)TT * INC * 2;
constexpr size_t WS_KC = WS_ST;
constexpr size_t WS_VT = WS_KC + (size_t)128 * 4096 * 64 * 2;
constexpr size_t WS_KCC = WS_VT + (size_t)128 * 4096 * 64 * 2;
constexpr size_t WS_VTC = WS_KCC + (size_t)128 * 256 * 64 * 2;
static_assert(WS_VTC + (size_t)128 * 256 * 64 * 2 <= WS_ST + (size_t)NB * 4 * 2 * NCH * 16384 * 2, "NA operand copies fit in the state region");
constexpr size_t WS_TOKE = WS_ST + (size_t)NB * 4 * 2 * NCH * 16384 * 2;
constexpr size_t WS_TOKR = WS_TOKE + (size_t)TT * 2 * 4;
constexpr size_t WS_TOKW = WS_TOKR + (size_t)TT * 2 * 4;
constexpr size_t WS_RINFO = WS_TOKW + (size_t)TT * 2 * 4;
constexpr size_t WS_RW = WS_RINFO + (size_t)PMAX * 4;
constexpr size_t WS_BLKE = WS_RW + (size_t)PMAX * 4;
constexpr size_t WS_RWT = WS_BLKE + 4096;
constexpr size_t WS_BLKB = WS_RWT + (size_t)2 * 32 * 1024 * 2;
constexpr size_t WS_ROPE = WS_BLKB + (size_t)1024 * 32 * 4;
constexpr size_t WS_END = WS_ROPE + (size_t)64 * 32 * 8;
static_assert(WS_ACT + (size_t)PMAX * DFF * 2 <= WS_ST && WS_XB == WS_ST && (size_t)TL * D * 2 <= (size_t)NB * 4 * 2 * NCH * 16384 * 2, "ys | act fit in the proj region, xb in the state region");
static_assert((size_t)TT * 2 * D * 2 <= (size_t)PMAX * D * 2, "y2 fits in xs region");
static_assert(WS_END <= (size_t)1 << 30, "workspace must fit in 1 GiB");

struct Args {
    const float* x; const float* c; const float* ctx; const float* c_ctx; const float* ada_w; const float* ada_b;
    const float* norm_mix_w; const float* norm_ffn_w; const float* w_in; const float* na_q_norm; const float* na_k_norm;
    const float* na_rpb; const float* ret_decay; const float* w_out; const float* router_w; const float* router_bias;
    const float* w_gate; const float* w_up; const float* w_down;
    float* out; unsigned char* ws; int ph_lo, ph_hi;
};

#define LDS_BARRIER() do { asm volatile("s_waitcnt lgkmcnt(0)" ::: "memory"); __builtin_amdgcn_s_barrier(); asm volatile("" ::: "memory"); } while (0)
__device__ __forceinline__ int otid() { int t = threadIdx.x; asm volatile("" : "+v"(t)); return t; }
__device__ __forceinline__ float bf2f(bf16_t v) { return __uint_as_float(((unsigned)v) << 16); }
__device__ __forceinline__ bf16_t f2bf(float f) { unsigned u = __float_as_uint(f); u += 0x7FFFu + ((u >> 16) & 1u); return (bf16_t)(u >> 16); }
typedef float f32x2_t __attribute__((ext_vector_type(2)));
typedef __bf16 bf16x2_t __attribute__((ext_vector_type(2)));
__device__ __forceinline__ unsigned pack2(float lo, float hi) { const f32x2_t v = {lo, hi}; return __builtin_bit_cast(unsigned, __builtin_convertvector(v, bf16x2_t)); }
__device__ __forceinline__ unsigned pack4_fp8(float a, float b, float c, float d) {
    a = __builtin_amdgcn_fmed3f(a, -448.0f, 448.0f); b = __builtin_amdgcn_fmed3f(b, -448.0f, 448.0f); c = __builtin_amdgcn_fmed3f(c, -448.0f, 448.0f); d = __builtin_amdgcn_fmed3f(d, -448.0f, 448.0f);
    int p = __builtin_amdgcn_cvt_pk_fp8_f32(a, b, 0, false); p = __builtin_amdgcn_cvt_pk_fp8_f32(c, d, p, true); return (unsigned)p; }
constexpr float WG8_SCALE = 64.0f, WU8_SCALE = 512.0f, WDN8_SCALE = 32.0f;
constexpr int SC_MOE1 = 0x7c7c7c7c, SC_MOE2 = 0x7b7b7b7b, SC_IN8 = 0x7c7c7c7c;
constexpr float WIN8_SCALE = 64.0f;
constexpr size_t WS_WIN8 = WS_WGU + (size_t)32 * 1024 * 1024;
#ifndef OUT_FP8
#define OUT_FP8 1
#endif
constexpr float MIX8_SCALE = 8.0f, WOUT8_SCALE = 128.0f; constexpr int SC_OUT8 = 0x7a7a7a7a;
constexpr size_t WS_WOUT8 = WS_WGU + (size_t)32 * 1024 * 1024 + (size_t)2 * 4096 * 1024;
#ifndef IN_FP8_MASK
#define IN_FP8_MASK 0xFFFFu
#endif
constexpr unsigned IN_TILES_BF16 = 0xFEDC7610u, IN_TILES_FP8 = 0xBA985432u;
__device__ __forceinline__ bool in_tile_fp8(int pn) { return (IN_FP8_MASK >> pn) & 1u; }
__device__ __forceinline__ float lo16(unsigned w) { return __uint_as_float(w << 16); }
__device__ __forceinline__ float hi16(unsigned w) { return __uint_as_float(w & 0xffff0000u); }
__device__ __forceinline__ float siluf(float v) { return v * __builtin_amdgcn_rcpf(1.0f + __builtin_amdgcn_exp2f(-1.4426950408889634f * v)); }
__device__ __forceinline__ float wave_sum(float v) {
#pragma unroll
    for (int o = 32; o >= 1; o >>= 1) v += __shfl_xor(v, o);
    return v;
}

typedef short bf16x8 __attribute__((ext_vector_type(8)));
typedef float f32x16 __attribute__((ext_vector_type(16)));
__device__ __forceinline__ unsigned off_b(unsigned row, unsigned ch) { return 256u * row + 16u * (ch ^ (((row & 3) << 2) | ((row >> 2) & 3))); }
__device__ __forceinline__ unsigned tr_addr(unsigned row0, unsigned c, unsigned lane) { const unsigned blk = (lane >> 4) & 1, q = (lane & 15) >> 2, p = lane & 3; return off_b(row0 + q, 4 * c + 2 * blk + (p >> 1)) + 8 * (p & 1); }
__device__ __forceinline__ bf16x8 mkfrag(u32x2 lo, u32x2 hi) { const u32x4 w = {lo.x, lo.y, hi.x, hi.y}; return __builtin_bit_cast(bf16x8, w); }
__device__ __forceinline__ int st_frag_idx(int d, int e) { return (((d >> 5) * 4 + (e >> 5)) * 64 + (e & 31) + 32 * ((d >> 2) & 1)) * 16 + (d & 3) + 4 * ((d & 31) >> 3); }
__device__ __forceinline__ const float* modp(const Args& a, int l, int r, int k6) { return (const float*)(a.ws + WS_MOD) + ((size_t)l * 17 + r) * 6144 + k6 * 1024; }

__device__ __forceinline__ bool cvt_is8(bool with_dense, int t) { return !(with_dense && t < 2560) || (t < 2048 ? in_tile_fp8(((t & 63) * 64) >> 8) : OUT_FP8 != 0); }
__device__ __forceinline__ void cvt_addr(const Args& a, bool with_dense, int le, int t, int tid, const float*& lp, bf16_t*& sp) {
    const float* src; bf16_t* dst; int ldn, ldk, k0, n0, nd0;
    if (with_dense && t < 2560) {
        if (t < 2048) { const int l = t >> 10, tt = t & 1023; k0 = (tt >> 6) * 64; n0 = (tt & 63) * 64; nd0 = n0; src = a.w_in + (size_t)l * D * INC; ldn = INC; ldk = D;
            dst = in_tile_fp8(n0 >> 8) ? (bf16_t*)(a.ws + WS_WIN8 + (size_t)l * INC * D) : (bf16_t*)(a.ws + WS_WIN) + (size_t)l * INC * D; }
        else { const int t2 = t - 2048, l = t2 >> 8, tt = t2 & 255; k0 = (tt >> 4) * 64; n0 = (tt & 15) * 64; nd0 = n0; src = a.w_out + (size_t)l * D * D; ldn = D; dst = OUT_FP8 ? (bf16_t*)(a.ws + WS_WOUT8 + (size_t)l * D * D) : (bf16_t*)(a.ws + WS_WOUT) + (size_t)l * D * D; ldk = D; }
    } else {
        const int te = with_dense ? t - 2560 : t, which = te >> 12, tt = te & 4095, e = tt >> 7, r = tt & 127;
        if (which < 2) { k0 = (r >> 3) * 64; n0 = (r & 7) * 64; nd0 = (n0 >> 7) * 256 + which * 128 + (n0 & 127); src = (which == 0 ? a.w_gate : a.w_up) + ((size_t)le * NE + e) * D * DFF; ldn = DFF; dst = (bf16_t*)(a.ws + WS_WGU + (size_t)e * 1024 * D); ldk = D; }
        else { k0 = (r >> 4) * 64; n0 = (r & 15) * 64; nd0 = n0; src = a.w_down + ((size_t)le * NE + e) * DFF * D; ldn = D; dst = (bf16_t*)(a.ws + WS_WDN + (size_t)e * 1024 * DFF); ldk = DFF; }
    }
    lp = src + (size_t)(k0 + (tid >> 3)) * ldn + n0 + (tid & 7) * 8;
    const size_t so = (size_t)(nd0 + (tid >> 3)) * ldk + k0 + (tid & 7) * 8;
    sp = cvt_is8(with_dense, t) ? (bf16_t*)((unsigned char*)dst + so) : dst + so;
}
__device__ __forceinline__ void convert_weights(const Args& a, bool with_dense, int le, MLAS unsigned char* lds, int bid, int nb) {
    MLAS float* tl = (MLAS float*)lds; const int tid = otid();
    const int N = (with_dense ? 2560 : 0) + 3 * 4096;
    const float* lp; bf16_t* sp;
    f32x4 v0 = {0.f, 0.f, 0.f, 0.f}, v1 = v0;
    if (bid < N) { cvt_addr(a, with_dense, le, bid, tid, lp, sp); v0 = *(const f32x4*)lp; v1 = *(const f32x4*)(lp + 4); }
    for (int t = bid; t < N; t += nb) {
        cvt_addr(a, with_dense, le, t, tid, lp, sp);
        LDS_BARRIER();
        { const int kk = tid >> 3, nn0 = (tid & 7) * 8;
#pragma unroll
          for (int j = 0; j < 4; ++j) { tl[kk * 65 + nn0 + j] = v0[j]; tl[kk * 65 + nn0 + 4 + j] = v1[j]; } }
        { const int tn = t + nb < N ? t + nb : t; const float* lpn; bf16_t* spn; cvt_addr(a, with_dense, le, tn, tid, lpn, spn); (void)spn; v0 = *(const f32x4*)lpn; v1 = *(const f32x4*)(lpn + 4); }
        LDS_BARRIER();
        { const int n = tid >> 3, kc = (tid & 7) * 8;
          if (!cvt_is8(with_dense, t)) { u32x4 w;
            w.x = pack2(tl[(kc + 0) * 65 + n], tl[(kc + 1) * 65 + n]); w.y = pack2(tl[(kc + 2) * 65 + n], tl[(kc + 3) * 65 + n]);
            w.z = pack2(tl[(kc + 4) * 65 + n], tl[(kc + 5) * 65 + n]); w.w = pack2(tl[(kc + 6) * 65 + n], tl[(kc + 7) * 65 + n]);
            *(u32x4*)sp = w; }
          else { u32x2 w;
            const int wh_ = (with_dense ? t - 2560 : t) >> 12; const float ws = (with_dense && t < 2048) ? WIN8_SCALE : (with_dense && t < 2560) ? WOUT8_SCALE : wh_ == 0 ? WG8_SCALE : wh_ == 1 ? WU8_SCALE : WDN8_SCALE;
            w.x = pack4_fp8(ws * tl[(kc + 0) * 65 + n], ws * tl[(kc + 1) * 65 + n], ws * tl[(kc + 2) * 65 + n], ws * tl[(kc + 3) * 65 + n]);
            w.y = pack4_fp8(ws * tl[(kc + 4) * 65 + n], ws * tl[(kc + 5) * 65 + n], ws * tl[(kc + 6) * 65 + n], ws * tl[(kc + 7) * 65 + n]);
            *(u32x2*)sp = w; } }
    }
    __syncthreads();
}
__device__ __forceinline__ void convert_small(const Args& a, int bid, int nb) {
    const int tid = otid();
    if (bid == nb - 2) { float* rt = (float*)(a.ws + WS_ROPE);
        for (int i = tid; i < 64 * 32; i += NT) { const float ang = (float)(i >> 5) * exp2f(-(float)(i & 31) * (13.287712379549449f / 32.0f)); float sn, cs; sincosf(ang, &sn, &cs); rt[2 * i] = cs; rt[2 * i + 1] = sn; } }
    if (bid == nb - 1) { bf16_t* rh = (bf16_t*)(a.ws + WS_RWT); bf16_t* rl = rh + 32 * 1024;
        for (int i = tid; i < 32 * 1024; i += NT) { const int e = i >> 10, k = i & 1023; const float w = a.router_w[k * NE + e]; const bf16_t hi = f2bf(w); rh[i] = hi; rl[i] = f2bf(w - bf2f(hi)); } }
}
__device__ __forceinline__ void compute_mod(const Args& a, MLAS unsigned char* lds, int bid, int nb) {
    MLAS float* sc = (MLAS float*)lds;
    MLAS float* red = (MLAS float*)(lds + 1024 * 20 * 4);
    const int tid = otid();
    if (bid >= 192) return;
    for (int i = tid; i < 17 * 1024; i += NT) { const int r = i >> 10, k = i & 1023; const float v = r < 16 ? a.c[r * 1024 + k] : a.c_ctx[k]; sc[k * 20 + r] = v / (1.0f + expf(-v)); }
    __syncthreads();
    for (int u = bid; u < 192; u += nb) {
        const int l = u / 96, n = (u % 96) * 64 + (tid & 63), kp = tid >> 6;
        float acc[17];
#pragma unroll
        for (int r = 0; r < 17; ++r) acc[r] = 0.f;
        const float* w = a.ada_w + (size_t)l * D * 6144 + n;
#pragma unroll 8
        for (int k = kp * 128; k < kp * 128 + 128; ++k) { const float wv = w[(size_t)k * 6144];
            const f32x4 s0 = *(const MLAS f32x4*)(sc + k * 20), s1 = *(const MLAS f32x4*)(sc + k * 20 + 4), s2 = *(const MLAS f32x4*)(sc + k * 20 + 8), s3 = *(const MLAS f32x4*)(sc + k * 20 + 12); const float s4 = sc[k * 20 + 16];
#pragma unroll
            for (int j = 0; j < 4; ++j) { acc[j] += s0[j] * wv; acc[4 + j] += s1[j] * wv; acc[8 + j] += s2[j] * wv; acc[12 + j] += s3[j] * wv; }
            acc[16] += s4 * wv; }
#pragma unroll
        for (int r = 0; r < 17; ++r) red[(kp * 17 + r) * 64 + (tid & 63)] = acc[r];
        __syncthreads();
        for (int i = tid; i < 17 * 64; i += NT) { const int r = i >> 6, cc = i & 63, nn = (u % 96) * 64 + cc; float s = a.ada_b[l * 6144 + nn];
#pragma unroll
            for (int p = 0; p < 8; ++p) s += red[(p * 17 + r) * 64 + cc];
            ((float*)(a.ws + WS_MOD))[((size_t)l * 17 + r) * 6144 + nn] = s; }
        __syncthreads();
    }
}

__device__ __forceinline__ void load_row_f32(const float* src, int e0, int e1, float (&v)[16]) {
    const f32x4 x0 = *(const f32x4*)(src + e0), x1 = *(const f32x4*)(src + e0 + 4), x2 = *(const f32x4*)(src + e1), x3 = *(const f32x4*)(src + e1 + 4);
#pragma unroll
    for (int j = 0; j < 4; ++j) { v[j] = x0[j]; v[4 + j] = x1[j]; v[8 + j] = x2[j]; v[12 + j] = x3[j]; }
}
__device__ __forceinline__ void load_row_bf16(const bf16_t* src, int e0, int e1, float (&v)[16]) {
    const u32x4 w0 = *(const u32x4*)(src + e0), w1 = *(const u32x4*)(src + e1);
#pragma unroll
    for (int j = 0; j < 4; ++j) { v[2 * j] = lo16(w0[j]); v[2 * j + 1] = hi16(w0[j]); v[8 + 2 * j] = lo16(w1[j]); v[8 + 2 * j + 1] = hi16(w1[j]); }
}
__device__ __forceinline__ void moe_combine(const bf16_t* ys, int2 pp, float2 ww, int i, const float (&mg)[16], int e0, int e1, float (&v)[16]) {
    const int p0 = __builtin_amdgcn_readlane(pp.x, i), p1 = __builtin_amdgcn_readlane(pp.y, i);
    const float w0 = __uint_as_float(__builtin_amdgcn_readlane(__float_as_uint(ww.x), i)), w1 = __uint_as_float(__builtin_amdgcn_readlane(__float_as_uint(ww.y), i));
    const bf16_t* ya = ys + (size_t)p0 * D; const bf16_t* yb = ys + (size_t)p1 * D;
    const u32x4 a0 = *(const u32x4*)(ya + e0), a1 = *(const u32x4*)(ya + e1), b0 = *(const u32x4*)(yb + e0), b1 = *(const u32x4*)(yb + e1);
#pragma unroll
    for (int j = 0; j < 4; ++j) {
        v[2 * j] += mg[2 * j] * (w0 * lo16(a0[j]) + w1 * lo16(b0[j])); v[2 * j + 1] += mg[2 * j + 1] * (w0 * hi16(a0[j]) + w1 * hi16(b0[j]));
        v[8 + 2 * j] += mg[8 + 2 * j] * (w0 * lo16(a1[j]) + w1 * lo16(b1[j])); v[8 + 2 * j + 1] += mg[8 + 2 * j + 1] * (w0 * hi16(a1[j]) + w1 * hi16(b1[j])); }
}
__device__ __forceinline__ unsigned char* h8_of(const Args& a) { return (unsigned char*)a.out + (size_t)TL * D * 2; }
__device__ __forceinline__ void phase_norm1(const Args& a, int l, int bid, int nb) {
    const int tid = otid(), lane = tid & 63, wave = __builtin_amdgcn_readfirstlane(tid >> 6);
    const int e0 = lane * 8, e1 = 512 + lane * 8;
    float wn[16];
    { const float* w = a.norm_mix_w + l * D;
#pragma unroll
      for (int j = 0; j < 8; ++j) { wn[j] = w[e0 + j]; wn[8 + j] = w[e1 + j]; } }
    float msc[16], msh[16], mg[16]; int cur_r = -1;
    bf16_t* hb = (bf16_t*)(a.ws + WS_H);
    const bf16_t* y2 = (const bf16_t*)(a.ws + WS_XS);
    const int rper = (TT + nb * 8 - 1) / (nb * 8), row_lo = (bid * 8 + wave) * rper, row_hi = min(row_lo + rper, TT);
    int2 pp = {0, 0}; float2 ww = {0.f, 0.f};
    if (l > 0 && row_lo + lane < row_hi) { pp = *(const int2*)((const int*)(a.ws + WS_TOKR) + (size_t)(row_lo + lane) * 2); ww = *(const float2*)((const float*)(a.ws + WS_TOKW) + (size_t)(row_lo + lane) * 2); }
    for (int row = row_lo; row < row_hi; ++row) {
        const int r = row < TL ? row / SEQ : 16;
        if (r != cur_r) { cur_r = r; const float* sh = modp(a, l, r, 0); const float* sc = modp(a, l, r, 1);
#pragma unroll
            for (int j = 0; j < 8; ++j) { msh[j] = sh[e0 + j]; msh[8 + j] = sh[e1 + j]; msc[j] = 1.0f + sc[e0 + j]; msc[8 + j] = 1.0f + sc[e1 + j]; }
            if (l > 0) { const float* g = modp(a, l - 1, r, 5);
#pragma unroll
                for (int j = 0; j < 8; ++j) { mg[j] = g[e0 + j]; mg[8 + j] = g[e1 + j]; } } }
        float v[16];
        if (l == 0) load_row_f32(row < TL ? a.x + (size_t)row * D : a.ctx + (size_t)(row - TL) * D, e0, e1, v);
        else if (row < TL) load_row_bf16((const bf16_t*)(a.ws + WS_XB) + (size_t)row * D, e0, e1, v);
        else load_row_f32((const float*)(a.ws + WS_CTX) + (size_t)(row - TL) * D, e0, e1, v);
        if (l > 0) {
            moe_combine(y2, pp, ww, row - row_lo, mg, e0, e1, v);
            if (row < TL) { bf16_t* dst = (bf16_t*)a.out + (size_t)row * D;
                *(u32x4*)(dst + e0) = (u32x4){pack2(v[0], v[1]), pack2(v[2], v[3]), pack2(v[4], v[5]), pack2(v[6], v[7])};
                *(u32x4*)(dst + e1) = (u32x4){pack2(v[8], v[9]), pack2(v[10], v[11]), pack2(v[12], v[13]), pack2(v[14], v[15])}; }
        }
        float ss = 0.f;
#pragma unroll
        for (int j = 0; j < 16; ++j) ss += v[j] * v[j];
        ss = wave_sum(ss);
        const float rs = rsqrtf(ss * (1.0f / D) + 1e-6f);
        float y[16];
#pragma unroll
        for (int j = 0; j < 16; ++j) y[j] = v[j] * rs * wn[j] * msc[j] + msh[j];
        if (IN_FP8_MASK != 0xFFFFu) { bf16_t* hp = hb + (size_t)row * D;
        *(u32x4*)(hp + e0) = (u32x4){pack2(y[0], y[1]), pack2(y[2], y[3]), pack2(y[4], y[5]), pack2(y[6], y[7])};
        *(u32x4*)(hp + e1) = (u32x4){pack2(y[8], y[9]), pack2(y[10], y[11]), pack2(y[12], y[13]), pack2(y[14], y[15])}; }
        unsigned char* hp8 = h8_of(a) + (size_t)row * D;
        *(u32x2*)(hp8 + e0) = (u32x2){pack4_fp8(y[0], y[1], y[2], y[3]), pack4_fp8(y[4], y[5], y[6], y[7])};
        *(u32x2*)(hp8 + e1) = (u32x2){pack4_fp8(y[8], y[9], y[10], y[11]), pack4_fp8(y[12], y[13], y[14], y[15])};
    }
}
__device__ __forceinline__ void phase_final(const Args& a, int bid, int nb) {
    const int tid = otid(), lane = tid & 63, wave = __builtin_amdgcn_readfirstlane(tid >> 6);
    const int e0 = lane * 8, e1 = 512 + lane * 8;
    float mg[16]; int cur_r = -1;
    const bf16_t* y2 = (const bf16_t*)(a.ws + WS_XS);
    const int rper = (TL + nb * 8 - 1) / (nb * 8), row_lo = (bid * 8 + wave) * rper, row_hi = min(row_lo + rper, TL);
    int2 pp = {0, 0}; float2 ww = {0.f, 0.f};
    if (row_lo + lane < row_hi) { pp = *(const int2*)((const int*)(a.ws + WS_TOKR) + (size_t)(row_lo + lane) * 2); ww = *(const float2*)((const float*)(a.ws + WS_TOKW) + (size_t)(row_lo + lane) * 2); }
    for (int row = row_lo; row < row_hi; ++row) {
        const int r = row / SEQ;
        if (r != cur_r) { cur_r = r; const float* g = modp(a, 1, r, 5);
#pragma unroll
            for (int j = 0; j < 8; ++j) { mg[j] = g[e0 + j]; mg[8 + j] = g[e1 + j]; } }
        float* src = a.out + (size_t)row * D;
        float v[16];
        load_row_bf16((const bf16_t*)(a.ws + WS_XB) + (size_t)row * D, e0, e1, v);
        moe_combine(y2, pp, ww, row - row_lo, mg, e0, e1, v);
        *(f32x4*)(src + e0) = (f32x4){v[0], v[1], v[2], v[3]}; *(f32x4*)(src + e0 + 4) = (f32x4){v[4], v[5], v[6], v[7]};
        *(f32x4*)(src + e1) = (f32x4){v[8], v[9], v[10], v[11]}; *(f32x4*)(src + e1 + 4) = (f32x4){v[12], v[13], v[14], v[15]};
    }
}

constexpr int VP = 516;
__device__ __forceinline__ void phase_prep(const Args& a, int l, MLAS unsigned char* lds, int bid, int nb) {
    const int tid = otid(), lane = tid & 63, wave = tid >> 6;
    const bf16_t* proj = (const bf16_t*)(a.ws + WS_PROJ);
    MLAS bf16_t* Vs = (MLAS bf16_t*)lds;
    float wk[8];
    { const float* w = a.na_k_norm + l * 64 + (lane & 7) * 8;
#pragma unroll
      for (int j = 0; j < 8; ++j) wk[j] = w[j]; }
    for (int u = bid; u < TT / 64; u += nb) {
        const int R0 = u * 64; const bool lat = R0 < TL;
        const int b = lat ? R0 / SEQ : (R0 - TL) / LC, t0 = lat ? R0 % SEQ : (R0 - TL) % LC, tlen = lat ? SEQ : LC;
        bf16_t* kc = (bf16_t*)(a.ws + (lat ? WS_KC : WS_KCC)); bf16_t* vt = (bf16_t*)(a.ws + (lat ? WS_VT : WS_VTC));
        __syncthreads();
#pragma unroll
        for (int rr = 0; rr < 8; ++rr) {
            const int rl = wave * 8 + rr, row = R0 + rl, t = t0 + rl;
            const bf16_t* p = proj + (size_t)row * INC;
            const u32x4 kw = *(const u32x4*)(p + C_KA + lane * 8), vw = *(const u32x4*)(p + C_VA + lane * 8);
            float f[8];
#pragma unroll
            for (int j = 0; j < 4; ++j) { f[2 * j] = lo16(kw[j]); f[2 * j + 1] = hi16(kw[j]); }
            float ss = 0.f;
#pragma unroll
            for (int j = 0; j < 8; ++j) ss += f[j] * f[j];
            ss += __shfl_xor(ss, 1); ss += __shfl_xor(ss, 2); ss += __shfl_xor(ss, 4);
            const float rs = rsqrtf(ss * (1.0f / 64.0f) + 1e-6f);
            *(u32x4*)(kc + (((size_t)b * 8 + (lane >> 3)) * tlen + t) * 64 + (lane & 7) * 8) =
                (u32x4){pack2(f[0] * rs * wk[0], f[1] * rs * wk[1]), pack2(f[2] * rs * wk[2], f[3] * rs * wk[3]), pack2(f[4] * rs * wk[4], f[5] * rs * wk[5]), pack2(f[6] * rs * wk[6], f[7] * rs * wk[7])};
            *(MLAS u32x2*)(Vs + rl * VP + lane * 8) = (u32x2){vw.x, vw.y}; *(MLAS u32x2*)(Vs + rl * VP + lane * 8 + 4) = (u32x2){vw.z, vw.w};
        }
        __syncthreads();
#pragma unroll
        for (int i = 0; i < 8; ++i) { const int idx = tid + i * NT, d = idx & 63, tc = (idx >> 6) & 7, h = idx >> 9;
            const MLAS bf16_t* vp = Vs + (tc * 8) * VP + h * 64 + d;
            const u32x4 w = {(unsigned)vp[0] | ((unsigned)vp[VP] << 16), (unsigned)vp[2 * VP] | ((unsigned)vp[3 * VP] << 16), (unsigned)vp[4 * VP] | ((unsigned)vp[5 * VP] << 16), (unsigned)vp[6 * VP] | ((unsigned)vp[7 * VP] << 16)};
            const int tk = t0 + tc * 8;
            *(u32x4*)(vt + ((((size_t)b * 8 + h) * (tlen >> 4) + (tk >> 4)) * 64 + d) * 16 + (tk & 15)) = w; }
    }
}

__device__ __forceinline__ int chunk_row0(int b, int c) { return c < 2 ? TL + b * LC + c * 128 : b * SEQ + (c - 2) * 128; }
__device__ __forceinline__ size_t st_index(int b, int h, int dir, int c) { return ((((size_t)b * 4 + h) * 2 + dir) * NCH + c) * 16384; }
constexpr int RP = 136;
__device__ __forceinline__ void load_rope_pair(const bf16_t* p, int a2, int fc, int tok, const MLAS float* rope, float (&y1)[8], float (&y2)[8]) {
    const u32x4 w0 = *(const u32x4*)(p + (a2 * 8 + fc) * 8), w1 = *(const u32x4*)(p + (a2 * 8 + fc + 4) * 8);
#pragma unroll
    for (int j = 0; j < 4; ++j) { y1[2 * j] = lo16(w0[j]); y1[2 * j + 1] = hi16(w0[j]); y2[2 * j] = lo16(w1[j]); y2[2 * j + 1] = hi16(w1[j]); }
    if (tok >= 0) {
        const int pos = a2 == 0 ? (tok >> 6) : (tok & 63);
        const MLAS f32x4* tp = (const MLAS f32x4*)(rope + (pos * 32 + fc * 8) * 2);
#pragma unroll
        for (int q = 0; q < 4; ++q) { const f32x4 cs = tp[q];
            const float u0 = y1[2 * q] * cs[0] - y2[2 * q] * cs[1], v0 = y1[2 * q] * cs[1] + y2[2 * q] * cs[0];
            const float u1 = y1[2 * q + 1] * cs[2] - y2[2 * q + 1] * cs[3], v1 = y1[2 * q + 1] * cs[3] + y2[2 * q + 1] * cs[2];
            y1[2 * q] = u0; y2[2 * q] = v0; y1[2 * q + 1] = u1; y2[2 * q + 1] = v1; }
    }
}
__device__ __forceinline__ void rope_pair_regs(const u32x4 w0, const u32x4 w1, int a2, int fc, int tok, const MLAS float* rope, float (&y1)[8], float (&y2)[8]) {
#pragma unroll
    for (int j = 0; j < 4; ++j) { y1[2 * j] = lo16(w0[j]); y1[2 * j + 1] = hi16(w0[j]); y2[2 * j] = lo16(w1[j]); y2[2 * j + 1] = hi16(w1[j]); }
    if (tok >= 0) {
        const int pos = a2 == 0 ? (tok >> 6) : (tok & 63);
        const MLAS f32x4* tp = (const MLAS f32x4*)(rope + (pos * 32 + fc * 8) * 2);
#pragma unroll
        for (int q = 0; q < 4; ++q) { const f32x4 cs = tp[q];
            const float u0 = y1[2 * q] * cs[0] - y2[2 * q] * cs[1], v0 = y1[2 * q] * cs[1] + y2[2 * q] * cs[0];
            const float u1 = y1[2 * q + 1] * cs[2] - y2[2 * q + 1] * cs[3], v1 = y1[2 * q + 1] * cs[3] + y2[2 * q + 1] * cs[2];
            y1[2 * q] = u0; y2[2 * q] = v0; y1[2 * q + 1] = u1; y2[2 * q + 1] = v1; }
    }
}
__device__ __forceinline__ u32x4 pack8(const float (&y)[8], float sc) { return (u32x4){pack2(y[0] * sc, y[1] * sc), pack2(y[2] * sc, y[3] * sc), pack2(y[4] * sc, y[5] * sc), pack2(y[6] * sc, y[7] * sc)}; }
constexpr float RET_KSCALE = 0.08838834764831845f;
constexpr int LDS_ROPE = 98304;
__device__ __forceinline__ void phase_ret_a(const Args& a, int l, MLAS unsigned char* lds, int bid, int nb) {
    const int tid = otid(), lane = tid & 63, wave = __builtin_amdgcn_readfirstlane(tid >> 6);
    const bf16_t* proj = (const bf16_t*)(a.ws + WS_PROJ); bf16_t* st = (bf16_t*)(a.ws + WS_ST);
    const unsigned ldsb = (unsigned)(size_t)lds;
    const int dir = wave >> 2, dt = wave & 3, hh = lane >> 5;
    MLAS float* rope = (MLAS float*)(lds + LDS_ROPE);
    for (int i = tid; i < 64 * 32 * 2; i += NT) rope[i] = ((const float*)(a.ws + WS_ROPE))[i];
#define RA_LOAD(u_) do { const int b_ = (u_) / (NCH * 4), c_ = ((u_) >> 2) % NCH, h_ = (u_) & 3, row0_ = chunk_row0(b_, c_); _Pragma("unroll") for (int i = 0; i < 2; ++i) { const int idx = tid + i * NT, row = idx >> 3, ch0 = ((idx >> 2) & 1) * 8 + (idx & 3); \
        const bf16_t* src = proj + (size_t)(row0_ + row) * INC + h_ * 128; \
        raw[i][0] = *(const u32x4*)(src + C_KB + ch0 * 8); raw[i][1] = *(const u32x4*)(src + C_KB + (ch0 + 4) * 8); raw[i][2] = *(const u32x4*)(src + C_VB + ch0 * 8); raw[i][3] = *(const u32x4*)(src + C_VB + (ch0 + 4) * 8); } } while (0)
    u32x4 raw[2][4];
    if (bid < NB * NCH * 4) RA_LOAD(bid);
    LDS_BARRIER();
    for (int u = bid; u < NB * NCH * 4; u += nb) {
        const int b = u / (NCH * 4), c = (u >> 2) % NCH, h = u & 3;
        const float lgf = -expf(a.ret_decay[l * 8 + h]), lgb = -expf(a.ret_decay[l * 8 + 4 + h]);
        LDS_BARRIER();
#pragma unroll
        for (int i = 0; i < 2; ++i) { const int idx = tid + i * NT, row = idx >> 3, a2 = (idx >> 2) & 1, fc = idx & 3, ch0 = a2 * 8 + fc;
            float y1[8], y2[8];
            rope_pair_regs(raw[i][0], raw[i][1], a2, fc, c >= 2 ? (c - 2) * 128 + row : -1, rope, y1, y2);
            const float wf = __expf((float)(127 - row) * lgf) * RET_KSCALE, wb = __expf((float)row * lgb) * RET_KSCALE;
            const unsigned o0 = off_b(row, ch0), o1 = off_b(row, ch0 + 4);
            *(MLAS u32x4*)(lds + o0) = pack8(y1, wf); *(MLAS u32x4*)(lds + o1) = pack8(y2, wf);
            *(MLAS u32x4*)(lds + 32768 + o0) = pack8(y1, wb); *(MLAS u32x4*)(lds + 32768 + o1) = pack8(y2, wb);
            *(MLAS u32x4*)(lds + 65536 + o0) = raw[i][2]; *(MLAS u32x4*)(lds + 65536 + o1) = raw[i][3]; }
        { const int un_ = u + nb < NB * NCH * 4 ? u + nb : u; RA_LOAD(un_); }
        LDS_BARRIER();
        f32x16 acc[4];
#pragma unroll
        for (int et = 0; et < 4; ++et)
#pragma unroll
            for (int r = 0; r < 16; ++r) acc[et][r] = 0.f;
        unsigned aK[2], aV[4][2];
#pragma unroll
        for (int t = 0; t < 2; ++t) { aK[t] = ldsb + dir * 32768 + tr_addr(8 * hh + 4 * t, dt, lane);
#pragma unroll
            for (int et = 0; et < 4; ++et) aV[et][t] = ldsb + 65536 + tr_addr(8 * hh + 4 * t, et, lane); }
#pragma unroll
        for (int ks = 0; ks < 8; ++ks) {
            u32x2 r0, r1, r2, r3, r4, r5, r6, r7, r8, r9; const unsigned ko = ks * 4096;
            asm volatile("ds_read_b64_tr_b16 %0, %10\n\tds_read_b64_tr_b16 %1, %11\n\tds_read_b64_tr_b16 %2, %12\n\tds_read_b64_tr_b16 %3, %13\n\tds_read_b64_tr_b16 %4, %14\n\t"
                         "ds_read_b64_tr_b16 %5, %15\n\tds_read_b64_tr_b16 %6, %16\n\tds_read_b64_tr_b16 %7, %17\n\tds_read_b64_tr_b16 %8, %18\n\tds_read_b64_tr_b16 %9, %19\n\ts_waitcnt lgkmcnt(0)"
                         : "=&v"(r0), "=&v"(r1), "=&v"(r2), "=&v"(r3), "=&v"(r4), "=&v"(r5), "=&v"(r6), "=&v"(r7), "=&v"(r8), "=&v"(r9)
                         : "v"(aK[0] + ko), "v"(aK[1] + ko), "v"(aV[0][0] + ko), "v"(aV[0][1] + ko), "v"(aV[1][0] + ko), "v"(aV[1][1] + ko), "v"(aV[2][0] + ko), "v"(aV[2][1] + ko), "v"(aV[3][0] + ko), "v"(aV[3][1] + ko) : "memory");
            const bf16x8 A = mkfrag(r0, r1);
            acc[0] = __builtin_amdgcn_mfma_f32_32x32x16_bf16(A, mkfrag(r2, r3), acc[0], 0, 0, 0);
            acc[1] = __builtin_amdgcn_mfma_f32_32x32x16_bf16(A, mkfrag(r4, r5), acc[1], 0, 0, 0);
            acc[2] = __builtin_amdgcn_mfma_f32_32x32x16_bf16(A, mkfrag(r6, r7), acc[2], 0, 0, 0);
            acc[3] = __builtin_amdgcn_mfma_f32_32x32x16_bf16(A, mkfrag(r8, r9), acc[3], 0, 0, 0);
        }
        bf16_t* o = st + st_index(b, h, dir, c);
#pragma unroll
        for (int et = 0; et < 4; ++et) { bf16_t* p = o + ((dt * 4 + et) * 64 + lane) * 16;
            *(u32x4*)p = (u32x4){pack2(acc[et][0], acc[et][1]), pack2(acc[et][2], acc[et][3]), pack2(acc[et][4], acc[et][5]), pack2(acc[et][6], acc[et][7])};
            *(u32x4*)(p + 8) = (u32x4){pack2(acc[et][8], acc[et][9]), pack2(acc[et][10], acc[et][11]), pack2(acc[et][12], acc[et][13]), pack2(acc[et][14], acc[et][15])}; }
    }
#undef RA_LOAD
}
__device__ __forceinline__ void phase_scan(const Args& a, int l, int bid, int nb) {
    bf16_t* st = (bf16_t*)(a.ws + WS_ST);
#pragma unroll 1
    for (int idx = bid * NT + otid(); idx < NB * 4 * 2 * 2048; idx += nb * NT) {
        const int chain = idx >> 11, v8 = idx & 2047, dir = chain & 1, h = (chain >> 1) & 3;
        const float dec = expf(-128.0f * expf(a.ret_decay[l * 8 + dir * 4 + h]));
        bf16_t* p = st + (size_t)chain * NCH * 16384 + v8 * 8;
        float S[8];
#pragma unroll
        for (int j = 0; j < 8; ++j) S[j] = 0.f;
#pragma unroll 1
        for (int half = 0; half < 2; ++half) {
            u32x4 ls[NCH / 2];
#pragma unroll
            for (int i = 0; i < NCH / 2; ++i) { const int ii = half * (NCH / 2) + i, c = dir == 0 ? ii : (ii < 2 ? 1 - ii : NCH + 1 - ii); ls[i] = *(const u32x4*)(p + (size_t)c * 16384); }
#pragma unroll
            for (int i = 0; i < NCH / 2; ++i) { const int ii = half * (NCH / 2) + i, c = dir == 0 ? ii : (ii < 2 ? 1 - ii : NCH + 1 - ii);
                *(u32x4*)(p + (size_t)c * 16384) = (u32x4){pack2(S[0], S[1]), pack2(S[2], S[3]), pack2(S[4], S[5]), pack2(S[6], S[7])};
#pragma unroll
                for (int t = 0; t < 4; ++t) { S[2 * t] = S[2 * t] * dec + lo16(ls[i][t]); S[2 * t + 1] = S[2 * t + 1] * dec + hi16(ls[i][t]); } }
        }
    }
}
__device__ __forceinline__ void phase_ret_b(const Args& a, int l, MLAS unsigned char* lds, int bid, int nb) {
    const int tid = otid(), lane = tid & 63, wave = __builtin_amdgcn_readfirstlane(tid >> 6);
    const bf16_t* proj = (const bf16_t*)(a.ws + WS_PROJ); const bf16_t* st = (const bf16_t*)(a.ws + WS_ST); bf16_t* mix = (bf16_t*)(a.ws + WS_H);
    const unsigned ldsb = (unsigned)(size_t)lds;
    const int dir = wave >> 2, it = wave & 3, hh = lane >> 5, il = it * 32 + (lane & 31);
    const int c_lo = l == 0 ? 0 : 2, ncu = NCH - c_lo;
    MLAS float* rope = (MLAS float*)(lds + LDS_ROPE);
    for (int i = tid; i < 64 * 32 * 2; i += NT) rope[i] = ((const float*)(a.ws + WS_ROPE))[i];
#define RB_DECODE(u_, b_, c_, h_, row0_) const int b_ = (u_) / (ncu * 4), c_ = c_lo + ((u_) >> 2) % ncu, h_ = (u_) & 3, row0_ = chunk_row0(b_, c_)
#define RB_LOAD(u_) do { RB_DECODE(u_, b_, c_, h_, row0_); (void)c_; _Pragma("unroll") for (int i = 0; i < 2; ++i) { const int idx = tid + i * NT, row = idx >> 3, ch0 = ((idx >> 2) & 1) * 8 + (idx & 3); \
        const bf16_t* src = proj + (size_t)(row0_ + row) * INC + h_ * 128; \
        raw[i][0] = *(const u32x4*)(src + C_QB + ch0 * 8); raw[i][1] = *(const u32x4*)(src + C_QB + (ch0 + 4) * 8); raw[i][2] = *(const u32x4*)(src + C_KB + ch0 * 8); raw[i][3] = *(const u32x4*)(src + C_KB + (ch0 + 4) * 8); \
        raw[i][4] = *(const u32x4*)(src + C_VB + ch0 * 8); raw[i][5] = *(const u32x4*)(src + C_VB + (ch0 + 4) * 8); } } while (0)
    u32x4 raw[2][6];
    if (bid < NB * ncu * 4) RB_LOAD(bid);
    LDS_BARRIER();
    for (int u = bid; u < NB * ncu * 4; u += nb) {
        RB_DECODE(u, b, c, h, row0);
        const float lg = -expf(a.ret_decay[l * 8 + dir * 4 + h]);
        LDS_BARRIER();
#pragma unroll
        for (int i = 0; i < 2; ++i) { const int idx = tid + i * NT, row = idx >> 3, a2 = (idx >> 2) & 1, fc = idx & 3, ch0 = a2 * 8 + fc;
            const int tok = c >= 2 ? (c - 2) * 128 + row : -1;
            const unsigned o0 = off_b(row, ch0), o1 = off_b(row, ch0 + 4);
            float y1[8], y2[8];
            rope_pair_regs(raw[i][0], raw[i][1], a2, fc, tok, rope, y1, y2);
            *(MLAS u32x4*)(lds + o0) = pack8(y1, 1.0f); *(MLAS u32x4*)(lds + o1) = pack8(y2, 1.0f);
            rope_pair_regs(raw[i][2], raw[i][3], a2, fc, tok, rope, y1, y2);
            *(MLAS u32x4*)(lds + 32768 + o0) = pack8(y1, RET_KSCALE); *(MLAS u32x4*)(lds + 32768 + o1) = pack8(y2, RET_KSCALE);
            *(MLAS u32x4*)(lds + 65536 + o0) = raw[i][4]; *(MLAS u32x4*)(lds + 65536 + o1) = raw[i][5]; }
        LDS_BARRIER();
        f32x16 acc[4];
#pragma unroll
        for (int et = 0; et < 4; ++et)
#pragma unroll
            for (int r = 0; r < 16; ++r) acc[et][r] = 0.f;
        {
            const bf16_t* sp = st + st_index(b, h, dir, c) + lane * 16;
#pragma unroll
            for (int dt = 0; dt < 4; ++dt)
#pragma unroll
                for (int s2 = 0; s2 < 2; ++s2) {
                    const u32x2 q0 = *(const MLAS u32x2*)(lds + off_b(il, 4 * dt + 2 * s2) + 8 * hh), q1 = *(const MLAS u32x2*)(lds + off_b(il, 4 * dt + 2 * s2 + 1) + 8 * hh);
                    const bf16x8 Bq = mkfrag(q0, q1);
#pragma unroll
                    for (int et = 0; et < 4; ++et) { const bf16x8 A = __builtin_bit_cast(bf16x8, *(const u32x4*)(sp + (dt * 4 + et) * 1024 + 8 * s2));
                        acc[et] = __builtin_amdgcn_mfma_f32_32x32x16_bf16(A, Bq, acc[et], 0, 0, 0); }
                }
            const float qdec = __expf((float)(dir == 0 ? il + 1 : 128 - il) * lg);
#pragma unroll
            for (int et = 0; et < 4; ++et)
#pragma unroll
                for (int r = 0; r < 16; ++r) acc[et][r] *= qdec;
        }
        bf16x8 Qn[8];
#pragma unroll
        for (int ks = 0; ks < 8; ++ks) Qn[ks] = *(const MLAS bf16x8*)(lds + off_b(il, 2 * ks + hh));
        const int jt_lo = dir == 0 ? 0 : it, jt_hi = dir == 0 ? it : 3;
        for (int jt = jt_lo; jt <= jt_hi; ++jt) {
            f32x16 sc;
#pragma unroll
            for (int r = 0; r < 16; ++r) sc[r] = 0.f;
#pragma unroll
            for (int ks = 0; ks < 8; ++ks) { const bf16x8 A = *(const MLAS bf16x8*)(lds + 32768 + off_b(jt * 32 + (lane & 31), 2 * ks + hh));
                sc = __builtin_amdgcn_mfma_f32_32x32x16_bf16(A, Qn[ks], sc, 0, 0, 0); }
            unsigned pk[8];
#pragma unroll
            for (int r = 0; r < 16; r += 2) {
                const int j0 = jt * 32 + (r & 3) + 8 * (r >> 2) + 4 * hh, j1 = j0 + 1;
                const int d0 = dir == 0 ? il - j0 : j0 - il, d1 = dir == 0 ? il - j1 : j1 - il;
                const float p0 = d0 >= 0 ? sc[r] * __expf((float)d0 * lg) : 0.f, p1 = d1 >= 0 ? sc[r + 1] * __expf((float)d1 * lg) : 0.f;
                pk[r >> 1] = pack2(p0, p1);
            }
            const bf16x8 P0 = __builtin_bit_cast(bf16x8, (u32x4){pk[0], pk[1], pk[2], pk[3]}), P1 = __builtin_bit_cast(bf16x8, (u32x4){pk[4], pk[5], pk[6], pk[7]});
#pragma unroll
            for (int et = 0; et < 4; ++et) {
                u32x2 r0, r1, r2, r3;
                const unsigned a0 = ldsb + 65536 + tr_addr(jt * 32 + 4 * hh, et, lane), a1 = ldsb + 65536 + tr_addr(jt * 32 + 8 + 4 * hh, et, lane);
                const unsigned a2 = ldsb + 65536 + tr_addr(jt * 32 + 16 + 4 * hh, et, lane), a3 = ldsb + 65536 + tr_addr(jt * 32 + 24 + 4 * hh, et, lane);
                asm volatile("ds_read_b64_tr_b16 %0, %4\n\tds_read_b64_tr_b16 %1, %5\n\tds_read_b64_tr_b16 %2, %6\n\tds_read_b64_tr_b16 %3, %7\n\ts_waitcnt lgkmcnt(0)"
                             : "=&v"(r0), "=&v"(r1), "=&v"(r2), "=&v"(r3) : "v"(a0), "v"(a1), "v"(a2), "v"(a3) : "memory");
                acc[et] = __builtin_amdgcn_mfma_f32_32x32x16_bf16(mkfrag(r0, r1), P0, acc[et], 0, 0, 0);
                acc[et] = __builtin_amdgcn_mfma_f32_32x32x16_bf16(mkfrag(r2, r3), P1, acc[et], 0, 0, 0);
            }
        }
        u32x4 gfr[4], gbr[4];
        { const bf16_t* gp = proj + (size_t)(row0 + (tid >> 2)) * INC + h * 128;
#pragma unroll
          for (int k = 0; k < 4; ++k) { const int ch = (tid & 3) * 4 + k; gfr[k] = *(const u32x4*)(gp + C_GF + ch * 8); gbr[k] = *(const u32x4*)(gp + C_GB + ch * 8); } }
        float s1 = 0.f;
#pragma unroll
        for (int et = 0; et < 4; ++et)
#pragma unroll
            for (int r = 0; r < 16; ++r) s1 += acc[et][r];
        s1 += __shfl_xor(s1, 32);
        const float mean = s1 * (1.0f / 128.0f);
        float s2 = 0.f;
#pragma unroll
        for (int et = 0; et < 4; ++et)
#pragma unroll
            for (int r = 0; r < 16; ++r) { const float dlt = acc[et][r] - mean; s2 += dlt * dlt; }
        s2 += __shfl_xor(s2, 32);
        const float rstd = rsqrtf(s2 * (1.0f / 128.0f) + 1e-5f);
        LDS_BARRIER();
#pragma unroll
        for (int et = 0; et < 4; ++et)
#pragma unroll
            for (int g = 0; g < 4; ++g) {
                const u32x2 w = {pack2((acc[et][4 * g] - mean) * rstd, (acc[et][4 * g + 1] - mean) * rstd), pack2((acc[et][4 * g + 2] - mean) * rstd, (acc[et][4 * g + 3] - mean) * rstd)};
                *(MLAS u32x2*)(lds + dir * 32768 + off_b(il, 4 * et + g) + 8 * hh) = w; }
        { const int un_ = u + nb < NB * ncu * 4 ? u + nb : u; RB_LOAD(un_); }
        LDS_BARRIER();
        {
            const int i = tid >> 2, part = tid & 3;
            bf16_t* op = mix + (size_t)(row0 + i) * D + 512 + h * 128;
#pragma unroll
            for (int k = 0; k < 4; ++k) { const int ch = part * 4 + k;
                const u32x4 of = *(const MLAS u32x4*)(lds + off_b(i, ch)), ob = *(const MLAS u32x4*)(lds + 32768 + off_b(i, ch));
                const u32x4 gf = gfr[k], gb = gbr[k];
                if (OUT_FP8) { float f[8];
#pragma unroll
                    for (int t = 0; t < 4; ++t) { f[2 * t] = MIX8_SCALE * (lo16(of[t]) * siluf(lo16(gf[t])) + lo16(ob[t]) * siluf(lo16(gb[t]))); f[2 * t + 1] = MIX8_SCALE * (hi16(of[t]) * siluf(hi16(gf[t])) + hi16(ob[t]) * siluf(hi16(gb[t]))); }
                    *(u32x2*)((unsigned char*)mix + (size_t)(row0 + i) * D + 512 + h * 128 + ch * 8) = (u32x2){pack4_fp8(f[0], f[1], f[2], f[3]), pack4_fp8(f[4], f[5], f[6], f[7])}; }
                else { u32x4 o;
#pragma unroll
                for (int t = 0; t < 4; ++t) o[t] = pack2(lo16(of[t]) * siluf(lo16(gf[t])) + lo16(ob[t]) * siluf(lo16(gb[t])), hi16(of[t]) * siluf(hi16(gf[t])) + hi16(ob[t]) * siluf(hi16(gb[t])));
                *(u32x4*)(op + ch * 8) = o; } }
        }
    }
#undef RB_DECODE
#undef RB_LOAD
}

constexpr int NA_OP = 72;
__device__ __forceinline__ int perm16(int x) { return (x & 3) | ((x & 4) << 1) | ((x & 8) >> 1); }
__device__ __forceinline__ void phase_na(const Args& a, int l, MLAS unsigned char* lds, int bid, int nb) {
    const int tid = otid(), lane = tid & 63, wave = __builtin_amdgcn_readfirstlane(tid >> 6);
    const bf16_t* proj = (const bf16_t*)(a.ws + WS_PROJ); bf16_t* mix = (bf16_t*)(a.ws + WS_H);
    const bf16_t* KC = (const bf16_t*)(a.ws + WS_KC); const bf16_t* VT = (const bf16_t*)(a.ws + WS_VT);
    const bf16_t* KCC = (const bf16_t*)(a.ws + WS_KCC); const bf16_t* VTC = (const bf16_t*)(a.ws + WS_VTC);
    MLAS float* rpb = (MLAS float*)lds;
    MLAS bf16_t* ost = (MLAS bf16_t*)(lds + 8192) + wave * 64 * NA_OP;
    const int n_lat = NB * 8 * 8, n_ctx = l == 0 ? NB * 4 : 0;
    const int hh = lane >> 5, ql = lane & 31;
    for (int u0 = bid; u0 < n_lat + n_ctx; u0 += nb) {
        int u = u0;
        if (nb == 256 && u0 < n_lat) { const int x = bid & 7, j = bid >> 3, i = u0 >> 8; u = ((i * 32 + x * 4 + (j >> 3)) << 3) + (j & 7); }
        const bool is_ctx = u >= n_lat;
        const int v = is_ctx ? u - n_lat : u;
        const int b = is_ctx ? v >> 2 : v >> 6, h = is_ctx ? 2 * (v & 3) + (wave >> 2) : (v >> 3) & 7;
        const int r = (v & 7) * 8 + wave;
        const int qrow0 = is_ctx ? TL + b * LC + (wave & 3) * 64 : b * SEQ + r * 64;
        const size_t bh = (size_t)b * 8 + h;
        __syncthreads();
        if (!is_ctx) for (int i = tid; i < 15 * 128; i += NT) { const int dr = i >> 7, x = (i & 127) - 48; rpb[i] = (x >= 0 && x < 31) ? a.na_rpb[((size_t)l * 8 + h) * 465 + dr * 31 + x] * 1.4426950408889634f : 0.f; }
        __syncthreads();
        bf16x8 Qf[2][4];
#pragma unroll
        for (int qt = 0; qt < 2; ++qt) {
            u32x4 qw[4]; float ss = 0.f;
#pragma unroll
            for (int ks = 0; ks < 4; ++ks) { qw[ks] = *(const u32x4*)(proj + (size_t)(qrow0 + 32 * qt + ql) * INC + C_QA + h * 64 + 16 * ks + 8 * hh);
#pragma unroll
                for (int t = 0; t < 4; ++t) { const float x0 = lo16(qw[ks][t]), x1 = hi16(qw[ks][t]); ss += x0 * x0 + x1 * x1; } }
            ss += __shfl_xor(ss, 32);
            const float rs = rsqrtf(ss * (1.0f / 64.0f) + 1e-6f) * 0.18033688011112042f;
#pragma unroll
            for (int ks = 0; ks < 4; ++ks) { const f32x4 w0 = *(const f32x4*)(a.na_q_norm + l * 64 + 16 * ks + 8 * hh), w1 = *(const f32x4*)(a.na_q_norm + l * 64 + 16 * ks + 8 * hh + 4);
                const u32x4 o = {pack2(lo16(qw[ks][0]) * rs * w0[0], hi16(qw[ks][0]) * rs * w0[1]), pack2(lo16(qw[ks][1]) * rs * w0[2], hi16(qw[ks][1]) * rs * w0[3]),
                                 pack2(lo16(qw[ks][2]) * rs * w1[0], hi16(qw[ks][2]) * rs * w1[1]), pack2(lo16(qw[ks][3]) * rs * w1[2], hi16(qw[ks][3]) * rs * w1[3])};
                Qf[qt][ks] = __builtin_bit_cast(bf16x8, o); }
        }
        f32x16 O[2][2];
#pragma unroll
        for (int qt = 0; qt < 2; ++qt)
#pragma unroll
            for (int i = 0; i < 16; ++i) { O[qt][0][i] = 0.f; O[qt][1][i] = 0.f; }
        float lsum[2] = {0.f, 0.f};
        const int r0 = min(max(r - 4, 0), 56);
        const int kslot = 16 * (ql >> 4) + perm16(ql & 15);
        const bf16_t* kl = KC + (bh * SEQ + (size_t)(r0 + (ql >> 4)) * 64 + perm16(ql & 15)) * 64 + 8 * hh;
        const bf16_t* vl = VT + ((bh * 256 + (size_t)r0 * 4) * 64 + ql) * 16 + 8 * hh;
        const bf16_t* kx = KCC + (bh * LC + kslot) * 64 + 8 * hh;
        const bf16_t* vx = VTC + ((bh * 16) * 64 + ql) * 16 + 8 * hh;
#define NA_PTRS(t, kp, vp, vstep) do { if ((t) < 16) { const int ip_ = (t) >> 2, ct_ = (t) & 3; kp = kl + (size_t)(2 * ip_ * 64 + 16 * ct_) * 64; vp = vl + (2 * ip_ * 4 + ct_) * 1024; vstep = 4096; } \
        else { kp = kx + (size_t)(32 * ((t) - 16)) * 64; vp = vx + ((t) - 16) * 2048; vstep = 1024; } } while (0)
#define NA_LOADS(kp, vp, vstep, Kd, Vd) do { _Pragma("unroll") for (int ks_ = 0; ks_ < 4; ++ks_) Kd[ks_] = *(const u32x4*)(kp + 16 * ks_); \
        Vd[0] = *(const u32x4*)(vp); Vd[1] = *(const u32x4*)(vp + vstep); Vd[2] = *(const u32x4*)(vp + 512); Vd[3] = *(const u32x4*)(vp + 512 + vstep); } while (0)
        const int t_lo = is_ctx ? 16 : 0;
        u32x4 Kn[4], Vn[4];
        { const bf16_t* kp; const bf16_t* vp; int vstep; NA_PTRS(t_lo, kp, vp, vstep); NA_LOADS(kp, vp, vstep, Kn, Vn); }
#pragma unroll 1
        for (int t = t_lo; t < 24; ++t) {
            u32x4 Kc[4], Vc[4];
#pragma unroll
            for (int i = 0; i < 4; ++i) { Kc[i] = Kn[i]; Vc[i] = Vn[i]; }
            if (t + 1 < 24) { const bf16_t* kp; const bf16_t* vp; int vstep; NA_PTRS(t + 1, kp, vp, vstep); NA_LOADS(kp, vp, vstep, Kn, Vn); }
            const int ip = t >> 2, ct = t & 3;
#pragma unroll
            for (int qt = 0; qt < 2; ++qt) {
                if (t < 16 && (unsigned)(ct - qt) > 2u) continue;
                f32x16 sc;
#pragma unroll
                for (int i = 0; i < 16; ++i) sc[i] = 0.f;
#pragma unroll
                for (int ks = 0; ks < 4; ++ks) sc = __builtin_amdgcn_mfma_f32_32x32x16_bf16(__builtin_bit_cast(bf16x8, Kc[ks]), Qf[qt][ks], sc, 0, 0, 0);
                unsigned pk[8];
                if (t < 16) {
                    const int q = qt * 32 + ql, c0 = min(max(q - 8, 0), 48);
#pragma unroll
                    for (int rr = 0; rr < 16; rr += 2) {
                        const int wi = 2 * ip + (rr >> 3), col = 16 * ct + (rr & 3) + 4 * ((rr >> 2) & 1) + 8 * hh;
                        const MLAS float* bp = rpb + (r0 + wi - r + 7) * 128 + (col - q + 63);
                        const float b0 = bp[0], b1 = bp[1];
                        const float e0 = __builtin_amdgcn_exp2f(sc[rr] + b0), e1 = __builtin_amdgcn_exp2f(sc[rr + 1] + b1);
                        const float p0 = (unsigned)(col - c0) < 16u ? e0 : 0.f, p1 = (unsigned)(col + 1 - c0) < 16u ? e1 : 0.f;
                        lsum[qt] += p0 + p1; pk[rr >> 1] = pack2(p0, p1);
                    }
                } else {
#pragma unroll
                    for (int rr = 0; rr < 16; rr += 2) { const float p0 = __builtin_amdgcn_exp2f(sc[rr]), p1 = __builtin_amdgcn_exp2f(sc[rr + 1]); lsum[qt] += p0 + p1; pk[rr >> 1] = pack2(p0, p1); }
                }
                const bf16x8 P0 = __builtin_bit_cast(bf16x8, (u32x4){pk[0], pk[1], pk[2], pk[3]}), P1 = __builtin_bit_cast(bf16x8, (u32x4){pk[4], pk[5], pk[6], pk[7]});
                O[qt][0] = __builtin_amdgcn_mfma_f32_32x32x16_bf16(__builtin_bit_cast(bf16x8, Vc[0]), P0, O[qt][0], 0, 0, 0);
                O[qt][0] = __builtin_amdgcn_mfma_f32_32x32x16_bf16(__builtin_bit_cast(bf16x8, Vc[1]), P1, O[qt][0], 0, 0, 0);
                O[qt][1] = __builtin_amdgcn_mfma_f32_32x32x16_bf16(__builtin_bit_cast(bf16x8, Vc[2]), P0, O[qt][1], 0, 0, 0);
                O[qt][1] = __builtin_amdgcn_mfma_f32_32x32x16_bf16(__builtin_bit_cast(bf16x8, Vc[3]), P1, O[qt][1], 0, 0, 0);
            }
        }
#undef NA_PTRS
#undef NA_LOADS
#pragma unroll
        for (int qt = 0; qt < 2; ++qt) {
            const float inv = 1.0f / (lsum[qt] + __shfl_xor(lsum[qt], 32));
#pragma unroll
            for (int g4 = 0; g4 < 4; ++g4) {
                *(MLAS u32x2*)(ost + (32 * qt + ql) * NA_OP + 8 * g4 + 4 * hh) = (u32x2){pack2(O[qt][0][4 * g4] * inv, O[qt][0][4 * g4 + 1] * inv), pack2(O[qt][0][4 * g4 + 2] * inv, O[qt][0][4 * g4 + 3] * inv)};
                *(MLAS u32x2*)(ost + (32 * qt + ql) * NA_OP + 32 + 8 * g4 + 4 * hh) = (u32x2){pack2(O[qt][1][4 * g4] * inv, O[qt][1][4 * g4 + 1] * inv), pack2(O[qt][1][4 * g4 + 2] * inv, O[qt][1][4 * g4 + 3] * inv)};
            }
        }
#pragma unroll
        for (int k = 0; k < 8; ++k) { const int idx = lane + 64 * k, row = idx >> 3, ch = idx & 7;
            const u32x4 ow = *(const MLAS u32x4*)(ost + row * NA_OP + ch * 8);
            if (OUT_FP8) *(u32x2*)((unsigned char*)mix + (size_t)(qrow0 + row) * D + h * 64 + ch * 8) = (u32x2){pack4_fp8(MIX8_SCALE * lo16(ow.x), MIX8_SCALE * hi16(ow.x), MIX8_SCALE * lo16(ow.y), MIX8_SCALE * hi16(ow.y)), pack4_fp8(MIX8_SCALE * lo16(ow.z), MIX8_SCALE * hi16(ow.z), MIX8_SCALE * lo16(ow.w), MIX8_SCALE * hi16(ow.w))};
            else *(u32x4*)(mix + (size_t)(qrow0 + row) * D + h * 64 + ch * 8) = ow; }
    }
}

constexpr int N2P = 1032;
typedef float f32x4v __attribute__((ext_vector_type(4)));
__device__ __forceinline__ void phase_norm2(const Args& a, int l, MLAS unsigned char* lds, int bid, int nb) {
    const int tid = otid(), lane = tid & 63, wave = __builtin_amdgcn_readfirstlane(tid >> 6);
    const int e0 = lane * 8, e1 = 512 + lane * 8;
    MLAS bf16_t* Ahi = (MLAS bf16_t*)lds; MLAS bf16_t* Alo = Ahi + 16 * N2P; MLAS float* part = (MLAS float*)(Alo + 16 * N2P);
    MLAS float* tsc = part + 8 * 16 * 32; MLAS float* tsh = tsc + 1024; int cur_r = -1;
    bf16_t* hb = (bf16_t*)(a.ws + WS_H);
    int* tok_e = (int*)(a.ws + WS_TOKE); int* tok_r = (int*)(a.ws + WS_TOKR); float* tok_w = (float*)(a.ws + WS_TOKW);
    unsigned* cnt = (unsigned*)(a.ws + WS_CNT) + l * 2048;
    MLAS unsigned* lcnt = (MLAS unsigned*)(tsh + 1024);
    if (tid < NE) lcnt[tid] = 0u;
    const int nrows = l == 0 ? TT : TL;
    bf16x8 Bh[4][2], Bl[4][2];
    { const bf16_t* rh = (const bf16_t*)(a.ws + WS_RWT); const bf16_t* rl = rh + 32 * 1024;
#pragma unroll
      for (int ks = 0; ks < 4; ++ks)
#pragma unroll
        for (int nt = 0; nt < 2; ++nt) { const int o = (nt * 16 + (lane & 15)) * 1024 + 128 * wave + 32 * ks + 8 * (lane >> 4);
            Bh[ks][nt] = __builtin_bit_cast(bf16x8, *(const u32x4*)(rh + o)); Bl[ks][nt] = __builtin_bit_cast(bf16x8, *(const u32x4*)(rl + o)); } }
    const float rbias = a.router_bias[lane & 31];
#define N2_BAR() do { asm volatile("s_waitcnt lgkmcnt(0)" ::: "memory"); __builtin_amdgcn_s_barrier(); asm volatile("" ::: "memory"); } while (0)
#define N2_LOAD(bt, dst) do { _Pragma("unroll") for (int jr_ = 0; jr_ < 2; ++jr_) { const int row_ = (bt) * 16 + 2 * wave + jr_; \
        if (row_ < TL) { const bf16_t* sb_ = (const bf16_t*)(a.ws + WS_XB) + (size_t)row_ * D; dst[jr_][0] = __builtin_bit_cast(f32x4, *(const u32x4*)(sb_ + e0)); dst[jr_][1] = __builtin_bit_cast(f32x4, *(const u32x4*)(sb_ + e1)); } \
        else { const float* src_ = (const float*)(a.ws + WS_CTX) + (size_t)(row_ - TL) * D; \
        dst[jr_][0] = *(const f32x4*)(src_ + e0); dst[jr_][1] = *(const f32x4*)(src_ + e0 + 4); dst[jr_][2] = *(const f32x4*)(src_ + e1); dst[jr_][3] = *(const f32x4*)(src_ + e1 + 4); } } } while (0)
    f32x4 vc[2][4];
    const int nbatch = nrows / 16;
    const int per = (nbatch + nb - 1) / nb, b_lo = bid * per, b_hi = min(b_lo + per, nbatch);
    if (b_lo < b_hi) N2_LOAD(b_lo, vc);
    for (int batch = b_lo; batch < b_hi; ++batch) {
        const int R0 = batch * 16, r = R0 < TL ? R0 / SEQ : 16;
        N2_BAR();
        if (r != cur_r) { cur_r = r; const float* sh = modp(a, l, r, 3); const float* sc = modp(a, l, r, 4); const float* w = a.norm_ffn_w + l * D;
            for (int k = tid; k < D; k += NT) { tsc[k] = (1.0f + sc[k]) * w[k]; tsh[k] = sh[k]; }
            N2_BAR(); }
#pragma unroll
        for (int jr = 0; jr < 2; ++jr) {
            const int m = 2 * wave + jr, row = R0 + m;
            float v[16];
            if (R0 < TL) { const u32x4 w0 = __builtin_bit_cast(u32x4, vc[jr][0]), w1 = __builtin_bit_cast(u32x4, vc[jr][1]);
#pragma unroll
                for (int j = 0; j < 4; ++j) { v[2 * j] = lo16(w0[j]); v[2 * j + 1] = hi16(w0[j]); v[8 + 2 * j] = lo16(w1[j]); v[8 + 2 * j + 1] = hi16(w1[j]); } }
            else {
#pragma unroll
                for (int j = 0; j < 4; ++j) { v[j] = vc[jr][0][j]; v[4 + j] = vc[jr][1][j]; v[8 + j] = vc[jr][2][j]; v[12 + j] = vc[jr][3][j]; } }
            float ss = 0.f;
#pragma unroll
            for (int j = 0; j < 16; ++j) ss += v[j] * v[j];
            ss = wave_sum(ss);
            const float rs = rsqrtf(ss * (1.0f / D) + 1e-6f);
            unsigned ph[8], pl[8], p8[4]; float yk0 = 0.f, yk1 = 0.f;
            float msc[16], msh[16];
#pragma unroll
            for (int q = 0; q < 2; ++q) { const f32x4 c0 = *(const MLAS f32x4*)(tsc + e0 + 4 * q), c1 = *(const MLAS f32x4*)(tsc + e1 + 4 * q), h0 = *(const MLAS f32x4*)(tsh + e0 + 4 * q), h1 = *(const MLAS f32x4*)(tsh + e1 + 4 * q);
#pragma unroll
                for (int j = 0; j < 4; ++j) { msc[4 * q + j] = c0[j]; msc[8 + 4 * q + j] = c1[j]; msh[4 * q + j] = h0[j]; msh[8 + 4 * q + j] = h1[j]; } }
#pragma unroll
            for (int j = 0; j < 16; j += 2) {
                const float y0 = v[j] * rs * msc[j] + msh[j], y1 = v[j + 1] * rs * msc[j + 1] + msh[j + 1];
                const bf16_t h0 = f2bf(y0), h1 = f2bf(y1);
                ph[j >> 1] = (unsigned)h0 | ((unsigned)h1 << 16); pl[j >> 1] = pack2(y0 - bf2f(h0), y1 - bf2f(h1));
                if (j & 2) p8[j >> 2] = pack4_fp8(yk0, yk1, y0, y1); else { yk0 = y0; yk1 = y1; } }
            unsigned char* hp = (unsigned char*)hb + (size_t)row * D;
            *(u32x2*)(hp + e0) = (u32x2){p8[0], p8[1]}; *(u32x2*)(hp + e1) = (u32x2){p8[2], p8[3]};
            *(MLAS u32x4*)(Ahi + m * N2P + e0) = (u32x4){ph[0], ph[1], ph[2], ph[3]}; *(MLAS u32x4*)(Ahi + m * N2P + e1) = (u32x4){ph[4], ph[5], ph[6], ph[7]};
            *(MLAS u32x4*)(Alo + m * N2P + e0) = (u32x4){pl[0], pl[1], pl[2], pl[3]}; *(MLAS u32x4*)(Alo + m * N2P + e1) = (u32x4){pl[4], pl[5], pl[6], pl[7]};
        }
        if (batch + 1 < b_hi) N2_LOAD(batch + 1, vc);
        N2_BAR();
        {
            f32x4v acc0 = {0.f, 0.f, 0.f, 0.f}, acc1 = {0.f, 0.f, 0.f, 0.f};
#pragma unroll
            for (int ks = 0; ks < 4; ++ks) {
                const int o = (lane & 15) * N2P + 128 * wave + 32 * ks + 8 * (lane >> 4);
                const bf16x8 ah = *(const MLAS bf16x8*)(Ahi + o), al = *(const MLAS bf16x8*)(Alo + o);
                acc0 = __builtin_amdgcn_mfma_f32_16x16x32_bf16(ah, Bh[ks][0], acc0, 0, 0, 0); acc0 = __builtin_amdgcn_mfma_f32_16x16x32_bf16(al, Bh[ks][0], acc0, 0, 0, 0); acc0 = __builtin_amdgcn_mfma_f32_16x16x32_bf16(ah, Bl[ks][0], acc0, 0, 0, 0);
                acc1 = __builtin_amdgcn_mfma_f32_16x16x32_bf16(ah, Bh[ks][1], acc1, 0, 0, 0); acc1 = __builtin_amdgcn_mfma_f32_16x16x32_bf16(al, Bh[ks][1], acc1, 0, 0, 0); acc1 = __builtin_amdgcn_mfma_f32_16x16x32_bf16(ah, Bl[ks][1], acc1, 0, 0, 0);
            }
#pragma unroll
            for (int rg = 0; rg < 4; ++rg) { const int m = 4 * (lane >> 4) + rg; part[(wave * 16 + m) * 32 + (lane & 15)] = acc0[rg]; part[(wave * 16 + m) * 32 + 16 + (lane & 15)] = acc1[rg]; }
        }
        N2_BAR();
        {
            const int m = tid >> 5, ex = tid & 31, hb32 = lane & 32, row = R0 + m;
            float acc = 0.f;
#pragma unroll
            for (int w8 = 0; w8 < 8; ++w8) acc += part[(w8 * 16 + m) * 32 + ex];
            const float sg = 1.0f / (1.0f + __expf(-acc)), ssel = sg + rbias;
            float best = -1e30f; int grp = 0;
#pragma unroll
            for (int g = 0; g < 8; ++g) {
                const float v0 = __shfl(ssel, hb32 + g * 4), v1 = __shfl(ssel, hb32 + g * 4 + 1), v2 = __shfl(ssel, hb32 + g * 4 + 2), v3 = __shfl(ssel, hb32 + g * 4 + 3);
                const float hi01 = fmaxf(v0, v1), lo01 = fminf(v0, v1), hi23 = fmaxf(v2, v3), lo23 = fminf(v2, v3);
                const float top = fmaxf(hi01, hi23), second = fmaxf(fminf(hi01, hi23), hi01 >= hi23 ? lo01 : lo23);
                const float gs = top + second;
                if (gs > best) { best = gs; grp = g; }
            }
            float w4[4], s4[4];
#pragma unroll
            for (int j = 0; j < 4; ++j) { w4[j] = __shfl(ssel, hb32 + grp * 4 + j); s4[j] = __shfl(sg, hb32 + grp * 4 + j); }
            int i0 = 0;
#pragma unroll
            for (int j = 1; j < 4; ++j) if (w4[j] > w4[i0]) i0 = j;
            int i1 = i0 == 0 ? 1 : 0;
#pragma unroll
            for (int j = 0; j < 4; ++j) if (j != i0 && j != i1 && w4[j] > w4[i1]) i1 = j;
            float g0 = 0.f, g1 = 0.f;
#pragma unroll
            for (int j = 0; j < 4; ++j) { g0 = (j == i0) ? s4[j] : g0; g1 = (j == i1) ? s4[j] : g1; }
            const float inv = 1.0f / (g0 + g1);
            if (ex < 2) {
                const int e = grp * 4 + (ex == 0 ? i0 : i1);
                const unsigned rank = __hip_atomic_fetch_add(lcnt + e, 1u, __ATOMIC_RELAXED, __HIP_MEMORY_SCOPE_WORKGROUP);
                tok_e[row * 2 + ex] = e; tok_r[row * 2 + ex] = (int)rank; tok_w[row * 2 + ex] = (ex == 0 ? g0 : g1) * inv;
            }
        }
    }
    N2_BAR();
    if (tid < NE) ((int*)(a.ws + WS_BLKB))[bid * NE + tid] = (int)atomicAdd(cnt + tid * 32, lcnt[tid]);
#undef N2_BAR
#undef N2_LOAD
}
__device__ __forceinline__ void phase_gather(const Args& a, int l, MLAS unsigned char* lds, int bid, int nb) {
    const int tid = otid(), lane = tid & 63, wave = tid >> 6;
    MLAS int* pbase = (MLAS int*)lds;
    MLAS int* cn = pbase + 64;
    const unsigned* cnt = (const unsigned*)(a.ws + WS_CNT) + l * 2048; const int* blkb = (const int*)(a.ws + WS_BLKB);
    if (tid == 0) { int acc = 0; for (int e = 0; e < NE; ++e) { const int c = (int)__hip_atomic_load(cnt + e * 32, __ATOMIC_RELAXED, __HIP_MEMORY_SCOPE_AGENT); cn[e] = c; pbase[e] = acc; acc += (c + 255) & ~255; } pbase[NE] = acc; }
    __syncthreads();
    int* rinfo = (int*)(a.ws + WS_RINFO); float* rw = (float*)(a.ws + WS_RW); int* blke = (int*)(a.ws + WS_BLKE);
    if (bid == 0) {
        for (int e = 0; e < NE; ++e) {
            for (int p = pbase[e] + cn[e] + tid; p < pbase[e + 1]; p += NT) { rinfo[p] = -1; rw[p] = 0.f; }
            for (int blk = (pbase[e] >> 8) + tid; blk < (pbase[e + 1] >> 8); blk += NT) blke[blk] = e;
        }
        if (tid == 0) blke[1023] = (pbase[NE] >> 8) * 4;
    }
    const int* tok_e = (const int*)(a.ws + WS_TOKE); const int* tok_r = (const int*)(a.ws + WS_TOKR); const float* tok_w = (const float*)(a.ws + WS_TOKW);
    const int nas = (l == 0 ? TT : TL) * 2, per_ = ((l == 0 ? TT : TL) / 16 + nb - 1) / nb;
    for (int as = bid * NT + tid; as < nas; as += nb * NT) {
        const int t = as >> 1, e = tok_e[as], pos = pbase[e] + blkb[((t >> 4) / per_) * NE + e] + tok_r[as];
        rinfo[pos] = as; ((int*)(a.ws + WS_TOKR))[as] = pos;
    }
}

using pg8::Unit;
struct EpiStoreBf16 {
    static constexpr bool PERM = true, AFTER_DRAIN = false;
    bf16_t* O; int ldc; bf16_t* kc_lat; bf16_t* vt_lat; bf16_t* kc_ctx; bf16_t* vt_ctx; const float* knw; MLAS unsigned char* sp;
    __device__ __forceinline__ void operator()(const f32x4 (&acc)[2][2][4][2], const Unit& u, int wr, int wc, int fr, int fq) const {
        const int row0 = u.pm * 256 + wr * 64 + fr;
        if (u.pn < 2 || u.pn > 5) {
            char* base = (char*)O + ((size_t)(u.pm * 256 + wr * 64) * ldc + u.pn * 256 + wc * 32) * 2;
            const unsigned lo = (unsigned)(fr * ldc + 8 * fq) * 2u;
#pragma unroll
            for (int ai = 0; ai < 2; ++ai)
#pragma unroll
                for (int m = 0; m < 4; ++m)
#pragma unroll
                    for (int bj = 0; bj < 2; ++bj) { const f32x4 v0 = acc[ai][bj][m][0], v1 = acc[ai][bj][m][1];
                        *(u32x4*)(base + (size_t)((ai * 128 + m * 16) * ldc + bj * 128) * 2 + lo) = (u32x4){pg8::cvt_pk_bf16(v0[0], v0[1]), pg8::cvt_pk_bf16(v0[2], v0[3]), pg8::cvt_pk_bf16(v1[0], v1[1]), pg8::cvt_pk_bf16(v1[2], v1[3])}; }
            return;
        }
        const bool lat = u.pm < 256;
        if (u.pn < 4) {
            MLAS float* part = (MLAS float*)sp;
            float ss[2][4][2];
#pragma unroll
            for (int ai = 0; ai < 2; ++ai)
#pragma unroll
                for (int m = 0; m < 4; ++m)
#pragma unroll
                    for (int bj = 0; bj < 2; ++bj) { const f32x4 v0 = acc[ai][bj][m][0], v1 = acc[ai][bj][m][1];
                        float q = (v0[0] * v0[0] + v0[1] * v0[1]) + (v0[2] * v0[2] + v0[3] * v0[3]) + (v1[0] * v1[0] + v1[1] * v1[1]) + (v1[2] * v1[2] + v1[3] * v1[3]);
                        q += __shfl_xor(q, 16); q += __shfl_xor(q, 32); ss[ai][m][bj] = q;
                        if (fq == 0) part[((((ai * 4 + m) * 2 + bj) * 2 + wr) * 16 + fr) * 4 + wc] = q; }
            asm volatile("s_waitcnt lgkmcnt(0)" ::: "memory"); __builtin_amdgcn_s_barrier(); asm volatile("" ::: "memory");
            const f32x4 w0 = *(const f32x4*)(knw + (wc & 1) * 32 + 8 * fq), w1 = *(const f32x4*)(knw + (wc & 1) * 32 + 8 * fq + 4);
#pragma unroll
            for (int ai = 0; ai < 2; ++ai)
#pragma unroll
                for (int m = 0; m < 4; ++m) { const int row = row0 + ai * 128 + m * 16;
                    const int b = lat ? row >> 12 : (row - TL) >> 8, t = lat ? row & (SEQ - 1) : (row - TL) & (LC - 1), tlen = lat ? SEQ : LC;
                    bf16_t* kb = (lat ? kc_lat : kc_ctx);
#pragma unroll
                    for (int bj = 0; bj < 2; ++bj) {
                        const float other = part[((((ai * 4 + m) * 2 + bj) * 2 + wr) * 16 + fr) * 4 + (wc ^ 1)];
                        const float rs = rsqrtf((ss[ai][m][bj] + other) * (1.0f / 64.0f) + 1e-6f);
                        const f32x4 v0 = acc[ai][bj][m][0] * rs * w0, v1 = acc[ai][bj][m][1] * rs * w1;
                        const int head = (u.pn - 2) * 4 + 2 * bj + (wc >> 1);
                        *(u32x4*)(kb + (((size_t)b * 8 + head) * tlen + t) * 64 + (wc & 1) * 32 + 8 * fq) = (u32x4){pg8::cvt_pk_bf16(v0[0], v0[1]), pg8::cvt_pk_bf16(v0[2], v0[3]), pg8::cvt_pk_bf16(v1[0], v1[1]), pg8::cvt_pk_bf16(v1[2], v1[3])}; } }
            return;
        }
        {
            MLAS bf16_t* gb = (MLAS bf16_t*)(sp + wr * 8192);
            bf16_t* vb = lat ? vt_lat : vt_ctx; const int ngrp = lat ? SEQ / 16 : LC / 16;
#pragma unroll
            for (int ai = 0; ai < 2; ++ai)
#pragma unroll
                for (int m = 0; m < 4; ++m) {
#pragma unroll
                    for (int bj = 0; bj < 2; ++bj)
#pragma unroll
                        for (int n = 0; n < 2; ++n) { const f32x4 v = acc[ai][bj][m][n]; const int c = bj * 128 + wc * 32 + 8 * fq + 4 * n;
                            const unsigned p01 = pg8::cvt_pk_bf16(v[0], v[1]), p23 = pg8::cvt_pk_bf16(v[2], v[3]);
                            gb[(c + 0) * 16 + fr] = (bf16_t)(p01 & 0xffffu); gb[(c + 1) * 16 + fr] = (bf16_t)(p01 >> 16);
                            gb[(c + 2) * 16 + fr] = (bf16_t)(p23 & 0xffffu); gb[(c + 3) * 16 + fr] = (bf16_t)(p23 >> 16); }
                    asm volatile("s_waitcnt lgkmcnt(0)" ::: "memory"); __builtin_amdgcn_s_barrier(); asm volatile("" ::: "memory");
                    const int rowb = u.pm * 256 + ai * 128 + wr * 64 + m * 16;
                    const int b = lat ? rowb >> 12 : (rowb - TL) >> 8, g16 = (lat ? rowb & (SEQ - 1) : (rowb - TL) & (LC - 1)) >> 4;
#pragma unroll
                    for (int k = 0; k < 2; ++k) { const int qd = wc * 64 + fr + 16 * fq + 256 * k, c = qd >> 1, half = qd & 1;
                        const u32x4 w = *(const MLAS u32x4*)(gb + c * 16 + 8 * half);
                        const int head = (u.pn - 4) * 4 + (c >> 6), d = c & 63;
                        *(u32x4*)(vb + ((((size_t)b * 8 + head) * ngrp + g16) * 64 + d) * 16 + 8 * half) = w; }
                    asm volatile("s_waitcnt lgkmcnt(0)" ::: "memory"); __builtin_amdgcn_s_barrier(); asm volatile("" ::: "memory");
                }
        }
    }
};
struct EpiResGate {
    static constexpr bool PERM = true, AFTER_DRAIN = false;
    const void* xin_lat; const float* xin_ctx; bf16_t* out_lat; float* out_ctx; const float* modl; int in_bf16;
    __device__ __forceinline__ void operator()(const f32x4 (&acc)[2][2][4][2], const Unit& u, int wr, int wc, int fr, int fq) const {
        const bool lat = u.pm < 256; const int r = lat ? (u.pm >> 4) : 16;
        const int rowt = (lat ? u.pm : u.pm - 256) * 256 + wr * 64 + fr, col0 = u.pn * 256 + wc * 32 + 8 * fq;
        const float* g = modl + (size_t)r * 6144 + 2 * 1024 + col0;
        f32x4 gv[2][2];
#pragma unroll
        for (int bj = 0; bj < 2; ++bj)
#pragma unroll
            for (int n = 0; n < 2; ++n) gv[bj][n] = *(const f32x4*)(g + bj * 128 + 4 * n);
#pragma unroll
        for (int ai = 0; ai < 2; ++ai)
#pragma unroll
            for (int m = 0; m < 4; ++m) { const size_t off = (size_t)(rowt + ai * 128 + m * 16) * D + col0;
#pragma unroll
                for (int bj = 0; bj < 2; ++bj) {
                    f32x4 x0, x1;
                    if (!lat) { x0 = *(const f32x4*)(xin_ctx + off + bj * 128); x1 = *(const f32x4*)(xin_ctx + off + bj * 128 + 4); }
                    else if (in_bf16) { const u32x4 w = *(const u32x4*)((const bf16_t*)xin_lat + off + bj * 128); x0 = (f32x4){lo16(w.x), hi16(w.x), lo16(w.y), hi16(w.y)}; x1 = (f32x4){lo16(w.z), hi16(w.z), lo16(w.w), hi16(w.w)}; }
                    else { x0 = *(const f32x4*)((const float*)xin_lat + off + bj * 128); x1 = *(const f32x4*)((const float*)xin_lat + off + bj * 128 + 4); }
                    x0 += gv[bj][0] * acc[ai][bj][m][0]; x1 += gv[bj][1] * acc[ai][bj][m][1];
                    if (lat) *(u32x4*)(out_lat + off + bj * 128) = (u32x4){pack2(x0[0], x0[1]), pack2(x0[2], x0[3]), pack2(x1[0], x1[1]), pack2(x1[2], x1[3])};
                    else { *(f32x4*)(out_ctx + off + bj * 128) = x0; *(f32x4*)(out_ctx + off + bj * 128 + 4) = x1; } } }
    }
};
struct EpiSwiglu {
    static constexpr bool PERM = true, AFTER_DRAIN = false;
    bf16_t* act;
    __device__ __forceinline__ void operator()(const f32x4 (&acc)[2][2][4][2], const Unit& u, int wr, int wc, int fr, int fq) const {
        unsigned char* base = (unsigned char*)act + (size_t)(u.pm * 256 + wr * 64) * DFF + (u.pn & 3) * 128 + wc * 32;
        const unsigned lo = (unsigned)(fr * DFF + 8 * fq);
#pragma unroll
        for (int ai = 0; ai < 2; ++ai)
#pragma unroll
            for (int m = 0; m < 4; ++m) { float r[8];
#pragma unroll
                for (int n = 0; n < 2; ++n)
#pragma unroll
                    for (int j = 0; j < 4; ++j) { const float gt = acc[ai][0][m][n][j]; r[n * 4 + j] = siluf(gt) * acc[ai][1][m][n][j]; }
                *(u32x2*)(base + (size_t)(ai * 128 + m * 16) * DFF + lo) = (u32x2){pack4_fp8(r[0], r[1], r[2], r[3]), pack4_fp8(r[4], r[5], r[6], r[7])}; }
    }
};
struct EpiDown {
    static constexpr bool PERM = true, AFTER_DRAIN = false;
    bf16_t* ys;
    __device__ __forceinline__ void operator()(const f32x4 (&acc)[2][2][4][2], const Unit& u, int wr, int wc, int fr, int fq) const {
        char* base = (char*)ys + ((size_t)(u.pm * 256 + wr * 64) * D + (u.pn & 3) * 256 + wc * 32) * 2;
        const unsigned lo = (unsigned)(fr * D + 8 * fq) * 2u;
#pragma unroll
        for (int ai = 0; ai < 2; ++ai)
#pragma unroll
            for (int m = 0; m < 4; ++m)
#pragma unroll
                for (int bj = 0; bj < 2; ++bj) { const f32x4 v0 = acc[ai][bj][m][0], v1 = acc[ai][bj][m][1];
                    *(u32x4*)(base + (size_t)((ai * 128 + m * 16) * D + bj * 128) * 2 + lo) = (u32x4){pg8::cvt_pk_bf16(v0[0], v0[1]), pg8::cvt_pk_bf16(v0[2], v0[3]), pg8::cvt_pk_bf16(v1[0], v1[1]), pg8::cvt_pk_bf16(v1[2], v1[3])}; }
    }
};
struct SubsetOrder {
    pg8::StaticOrder base; unsigned map;
    __device__ __forceinline__ bool next(int i, Unit& u) const { if (!base.next(i, u)) return false; u.pn = (int)((map >> (4 * u.pn)) & 15u); return true; }
    __device__ __forceinline__ void a_ready(const Unit&) const {}
    __device__ __forceinline__ void done(const Unit&) const {}
};
struct MoeOrder {
    const MLAS int* blke; int nunits, G, c;
    __device__ __forceinline__ bool next(int i, Unit& u) const { const int x = c & 7, j = c >> 3; int L;
        if (G == 256) { const int rb = i * 64 + (j >> 2) * 8 + x; L = rb * 4 + (j & 3); } else L = i * G + c;
        if (L >= nunits) return false; u.pm = L >> 2; u.pn = blke[L >> 2] * 4 + (L & 3); return true; }
    __device__ __forceinline__ void a_ready(const Unit&) const {}
    __device__ __forceinline__ void done(const Unit&) const {}
};

typedef const Args __attribute__((address_space(4))) CArgs;
#define MK_LOAD_ARGS(a, p) do { (a).x = (p)->x; (a).c = (p)->c; (a).ctx = (p)->ctx; (a).c_ctx = (p)->c_ctx; (a).ada_w = (p)->ada_w; (a).ada_b = (p)->ada_b; (a).norm_mix_w = (p)->norm_mix_w; (a).norm_ffn_w = (p)->norm_ffn_w; (a).w_in = (p)->w_in; (a).na_q_norm = (p)->na_q_norm; (a).na_k_norm = (p)->na_k_norm; (a).na_rpb = (p)->na_rpb; (a).ret_decay = (p)->ret_decay; (a).w_out = (p)->w_out; (a).router_w = (p)->router_w; (a).router_bias = (p)->router_bias; (a).w_gate = (p)->w_gate; (a).w_up = (p)->w_up; (a).w_down = (p)->w_down; (a).out = (p)->out; (a).ws = (p)->ws; (a).ph_lo = (p)->ph_lo; (a).ph_hi = (p)->ph_hi; } while (0)
#ifndef MK_SINGLE
#define MK_SINGLE 1
#endif
constexpr int NPHASES = 24;
#ifndef MK_PROBE_MASK
#define MK_PROBE_MASK 0
#endif
#ifndef MK_BAR2
#define MK_BAR2 0
#endif
#ifndef MK_PROBE_MULT
#define MK_PROBE_MULT 4
#endif
enum { K_PRO = 0, K_NORM1, K_GEMM_IN, K_PREP, K_NA, K_RET_A, K_SCAN, K_RET_B, K_GEMM_OUT, K_NORM2, K_GATHER, K_MOE1, K_MOE2, K_FINAL };
__global__ void __launch_bounds__(NT, 2) fwd(Args ka) {
    extern __shared__ __attribute__((aligned(16))) unsigned char lds_raw[];
    MLAS unsigned char* lds = (MLAS unsigned char*)lds_raw;
    const int tid = threadIdx.x, nb = gridDim.x;
    volatile MLAS unsigned* ctl = (volatile MLAS unsigned*)(lds + LDS_CTL);
    if (tid < 4) ctl[tid] = 0u;
    __syncthreads();
    const bool multi = MK_SINGLE != 0;
    XcdBarrier bar; bar.bar = (unsigned*)(ka.ws + WS_BAR); bar.x = 0; bar.st = ctl;
    if (multi) bar = xcd_barrier_post((unsigned*)(ka.ws + WS_BAR), ctl);
    int ph = 0;
#if MK_SINGLE
#define MK_GUARD 1
#define MK_SEAM(kind) ((kind) != K_FINAL)
#else
#define MK_GUARD (ph >= ka.ph_lo && ph < ka.ph_hi)
#define MK_SEAM(kind) (ph + 1 < ka.ph_hi)
#endif
#define PHASE(kind, ...) do { if (MK_GUARD) { CArgs* ap_ = (CArgs*)__builtin_amdgcn_kernarg_segment_ptr(); asm volatile("" : "+s"(ap_)); Args a; MK_LOAD_ARGS(a, ap_); int bid = blockIdx.x; asm volatile("" : "+s"(bid)); unsigned long long t0_ = 0; if ((MK_PROBE_MASK >> (kind)) & 1) t0_ = wall_clock64(); { __VA_ARGS__; } if ((MK_PROBE_MASK >> (kind)) & 1) { const unsigned long long d_ = wall_clock64() - t0_; while (wall_clock64() - t0_ < d_ * (MK_PROBE_MULT + 1)) __builtin_amdgcn_s_sleep(8); } if (MK_SEAM(kind)) { XcdBarrier b_ = bar; asm volatile("" : "+s"(b_.bar), "+s"(b_.x)); xcd_barrier(b_); if (MK_BAR2) { xcd_barrier(b_); xcd_barrier(b_); } } } ++ph; } while (0)
    PHASE(K_PRO, { convert_small(a, bid, nb); convert_weights(a, true, 0, lds, bid, nb); compute_mod(a, lds, bid, nb); });
#ifndef STG_IN
#define STG_IN 0
#endif
#define MK_STAGGER(ticks) do { if ((ticks) > 0) { const unsigned long long t0s_ = wall_clock64(), ds_ = (unsigned long long)(bid & 7) * (ticks); while (wall_clock64() - t0s_ < ds_) __builtin_amdgcn_s_sleep(2); } } while (0)
#define MK_LAYER(l) do { \
        PHASE(K_NORM1, { phase_norm1(a, l, bid, nb); if (l == 1) convert_weights(a, false, 1, lds, bid, nb); }); \
        PHASE(K_GEMM_IN, { MK_STAGGER(STG_IN); EpiStoreBf16 E{(bf16_t*)(a.ws + WS_PROJ), INC, (bf16_t*)(a.ws + WS_KC), (bf16_t*)(a.ws + WS_VT), (bf16_t*)(a.ws + WS_KCC), (bf16_t*)(a.ws + WS_VTC), a.na_k_norm + l * 64, lds + 131072}; \
                if (IN_FP8_MASK == 0xFFFFu) { pg8::Gemm g{(const bf16_t*)h8_of(a), (const bf16_t*)(a.ws + WS_WIN8 + (size_t)l * INC * D), TT, INC, D, nullptr, SC_IN8}; \
                  pg8::StaticOrder S; S.init(TT, INC, nb, bid); \
                  pg8::gemm_phase<EpiStoreBf16, pg8::StaticOrder, false, false, 1>(lds, g, S, E, nullptr); } \
                else { \
                { pg8::Gemm g{(const bf16_t*)(a.ws + WS_H), (const bf16_t*)(a.ws + WS_WIN) + (size_t)l * INC * D, TT, INC, D}; \
                  SubsetOrder S; S.base.init(TT, INC / 2, nb, bid); S.map = IN_TILES_BF16; \
                  pg8::gemm_phase<EpiStoreBf16, SubsetOrder>(lds, g, S, E, nullptr); } \
                { pg8::Gemm g{(const bf16_t*)h8_of(a), (const bf16_t*)(a.ws + WS_WIN8 + (size_t)l * INC * D), TT, INC, D, nullptr, SC_IN8}; \
                  SubsetOrder S; S.base.init(TT, INC / 2, nb, nb - 1 - bid); S.map = IN_TILES_FP8;     \
                  pg8::gemm_phase<EpiStoreBf16, SubsetOrder, false, false, 1>(lds, g, S, E, nullptr); } } }); \
        PHASE(K_NA, phase_na(a, l, lds, bid, nb)); \
        PHASE(K_RET_A, phase_ret_a(a, l, lds, bid, nb)); \
        PHASE(K_SCAN, phase_scan(a, l, bid, nb)); \
        PHASE(K_RET_B, phase_ret_b(a, l, lds, bid, nb)); \
        PHASE(K_GEMM_OUT, { const int M = l == 0 ? TT : TL; \
                pg8::Gemm g{(const bf16_t*)(a.ws + WS_H), OUT_FP8 ? (const bf16_t*)(a.ws + WS_WOUT8 + (size_t)l * D * D) : (const bf16_t*)(a.ws + WS_WOUT) + (size_t)l * D * D, M, D, D, nullptr, SC_OUT8}; \
                pg8::StaticOrder S; S.init(M, D, nb, bid); \
                EpiResGate E{l == 0 ? (const void*)a.x : (const void*)a.out, a.ctx, (bf16_t*)(a.ws + WS_XB), (float*)(a.ws + WS_CTX), (const float*)(a.ws + WS_MOD) + (size_t)l * 17 * 6144, l}; \
                pg8::gemm_phase<EpiResGate, pg8::StaticOrder, false, false, OUT_FP8 ? 1 : 2>(lds, g, S, E, nullptr); }); \
        PHASE(K_NORM2, phase_norm2(a, l, lds, bid, nb)); \
        PHASE(K_GATHER, phase_gather(a, l, lds, bid, nb)); \
        PHASE(K_MOE1, { MLAS int* blke = (MLAS int*)(lds + 131072); { const int* gb_ = (const int*)(a.ws + WS_BLKE); for (int i_ = otid(); i_ < 1024; i_ += NT) blke[i_] = gb_[i_]; __syncthreads(); } \
                pg8::Gemm g{(const bf16_t*)(a.ws + WS_H), (const bf16_t*)(a.ws + WS_WGU), PMAX, NE * 1024, D, (const int*)(a.ws + WS_RINFO), SC_MOE1}; \
                MoeOrder S{blke, blke[1023], nb, bid}; \
                EpiSwiglu E{(bf16_t*)(a.ws + WS_ACT)}; \
                pg8::gemm_phase<EpiSwiglu, MoeOrder, false, true, 1>(lds, g, S, E, nullptr); }); \
        PHASE(K_MOE2, { MLAS int* blke = (MLAS int*)(lds + 131072); { const int* gb_ = (const int*)(a.ws + WS_BLKE); for (int i_ = otid(); i_ < 1024; i_ += NT) blke[i_] = gb_[i_]; __syncthreads(); } \
                pg8::Gemm g{(const bf16_t*)(a.ws + WS_ACT), (const bf16_t*)(a.ws + WS_WDN), PMAX, NE * 1024, DFF, nullptr, SC_MOE2}; \
                MoeOrder S{blke, blke[1023], nb, bid}; \
                EpiDown E{(bf16_t*)(a.ws + WS_XS)}; \
                pg8::gemm_phase<EpiDown, MoeOrder, false, false, 1>(lds, g, S, E, nullptr); }); \
    } while (0)
    MK_LAYER(0);
    MK_LAYER(1);
#undef MK_LAYER
    PHASE(K_FINAL, phase_final(a, bid, nb));
#undef PHASE
}
}

extern "C" void kernel_launch(void* const* d_in, const int* in_sizes, int n_in, void* d_out, int out_size, void* d_ws, size_t ws_size, hipStream_t stream) {
    using namespace mk;
    static int grid = 0;
    if (grid == 0) {
        if (n_in != 19 || in_sizes[0] != TL * D || out_size != TL * D || ws_size < WS_END) {
            fprintf(stderr, "kernel_launch: unexpected shapes / workspace (n_in %d, in0 %d, out %d, ws %zu, need %zu); nothing launched\n", n_in, n_in > 0 ? in_sizes[0] : -1, out_size, ws_size, (size_t)WS_END);
            grid = -1; return; }
        int dev = 0, cus = 0, per_cu = 0;
        if (hipGetDevice(&dev) != hipSuccess || hipDeviceGetAttribute(&cus, hipDeviceAttributeMultiprocessorCount, dev) != hipSuccess) { grid = -1; return; }
        if (hipFuncSetAttribute((const void*)fwd, hipFuncAttributeMaxDynamicSharedMemorySize, LDS_BYTES) != hipSuccess) { fprintf(stderr, "kernel_launch: hipFuncSetAttribute failed\n"); grid = -1; return; }
        if (hipOccupancyMaxActiveBlocksPerMultiprocessor(&per_cu, (const void*)fwd, NT, LDS_BYTES) != hipSuccess || per_cu < 1) { fprintf(stderr, "kernel_launch: occupancy query says %d\n", per_cu); (void)hipGetLastError(); grid = -1; return; }
        grid = cus;
    }
    if (grid < 0) return;
    (void)hipMemsetAsync((char*)d_ws + WS_BAR, 0, WS_ZERO_BYTES, stream);
    Args a{};
    a.x = (const float*)d_in[0]; a.c = (const float*)d_in[1]; a.ctx = (const float*)d_in[2]; a.c_ctx = (const float*)d_in[3]; a.ada_w = (const float*)d_in[4]; a.ada_b = (const float*)d_in[5];
    a.norm_mix_w = (const float*)d_in[6]; a.norm_ffn_w = (const float*)d_in[7]; a.w_in = (const float*)d_in[8]; a.na_q_norm = (const float*)d_in[9]; a.na_k_norm = (const float*)d_in[10];
    a.na_rpb = (const float*)d_in[11]; a.ret_decay = (const float*)d_in[12]; a.w_out = (const float*)d_in[13]; a.router_w = (const float*)d_in[14]; a.router_bias = (const float*)d_in[15];
    a.w_gate = (const float*)d_in[16]; a.w_up = (const float*)d_in[17]; a.w_down = (const float*)d_in[18];
    a.out = (float*)d_out; a.ws = (unsigned char*)d_ws;
#if MK_SINGLE
    a.ph_lo = 0; a.ph_hi = NPHASES;
    hipLaunchKernelGGL(fwd, dim3(grid), dim3(NT), LDS_BYTES, stream, a);
#else
    for (int ph = 0; ph < NPHASES; ++ph) { a.ph_lo = ph; a.ph_hi = ph + 1; hipLaunchKernelGGL(fwd, dim3(grid), dim3(NT), LDS_BYTES, stream, a); }
#endif
}
```
